# Optimizing an MI355X kernel written in HIP

```python
import math
import jax, jax.numpy as jnp
from jax import lax
import numpy as np

D_MODEL = 1024
BATCH = 1
SEQ = 16384
DEPTH = 2

N_MIXERS = 2
N_GLA_LAYERS = (DEPTH + 1) // 2
N_MLA_LAYERS = DEPTH // 2
RMS_EPS = 1e-6

GLA_HEADS = 4
GLA_DK = D_MODEL // 2
GLA_DV = D_MODEL
GLA_HEAD_K = GLA_DK // GLA_HEADS
GLA_HEAD_V = GLA_DV // GLA_HEADS
GLA_GATE_RANK = 16
GLA_TAU = 16.0
GLA_CHUNK = 64
GLA_IN = 2 * GLA_DK + 2 * GLA_DV + 2 * GLA_GATE_RANK

MLA_HEADS = 16
MLA_Q_RANK = 256
MLA_KV_RANK = 128
MLA_NOPE = 128
MLA_ROPE = 64
MLA_V = 128
MLA_IN = MLA_Q_RANK + MLA_KV_RANK + MLA_ROPE
ROPE_BASE = 10000.0
Q_BLOCK = 128

N_EXPERTS = 16
EXPERT_FF = 2048
EC_CAPACITY_FACTOR = 2

kernel_name = 'bidir_gla_mla_ec_moe_hybrid'


def rms_norm(x, g):
    xf = x.astype(jnp.float32)
    y = xf * lax.rsqrt(jnp.mean(xf * xf, axis=-1, keepdims=True) + RMS_EPS)
    return (y * g.astype(jnp.float32)).astype(x.dtype)


def gla_chunked(q, k, v, g, strict):
    B, H, T, dk = q.shape
    dv = v.shape[-1]
    n = T // GLA_CHUNK

    def to_chunks(a):
        return jnp.moveaxis(a.reshape(B, H, n, GLA_CHUNK, a.shape[-1]), 2, 0)

    qc, kc, vc, gc = to_chunks(q), to_chunks(k), to_chunks(v), to_chunks(g)
    idx = jnp.arange(GLA_CHUNK)
    mask = (idx[:, None] > idx[None, :]) if strict else (idx[:, None] >= idx[None, :])

    def step(S, inp):
        qi, ki, vi, gi = inp
        qf = qi.astype(jnp.float32)
        kf = ki.astype(jnp.float32)
        vf = vi.astype(jnp.float32)
        G = jnp.cumsum(gi.astype(jnp.float32), axis=-2)
        o_inter = jnp.einsum('bhtk,bhkv->bhtv', qf * jnp.exp(G), S)
        diff = G[:, :, :, None, :] - G[:, :, None, :, :]
        decay = jnp.exp(jnp.where(mask[None, None, :, :, None], diff, -jnp.inf))
        attn = jnp.einsum('bhtk,bhsk,bhtsk->bhts', qf, kf, decay)
        o_intra = jnp.einsum('bhts,bhsv->bhtv', attn, vf)
        G_last = G[:, :, -1, :]
        S_new = jnp.exp(G_last)[..., None] * S + jnp.einsum(
            'bhsk,bhsv->bhkv', kf * jnp.exp(G_last[:, :, None, :] - G), vf)
        return S_new, o_inter + o_intra

    S0 = jnp.zeros((B, H, dk, dv), jnp.float32)
    _, o = lax.scan(step, S0, (qc, kc, vc, gc))
    return jnp.moveaxis(o, 0, 2).reshape(B, H, T, dv).astype(v.dtype)


def gla_mixer(h, w_in, w_gate_up_f, b_gate_f, w_gate_up_b, b_gate_b, head_norm, w_out):
    B, T, _ = h.shape
    proj = h @ w_in
    s1 = GLA_DK
    s2 = 2 * GLA_DK
    s3 = s2 + GLA_DV
    s4 = s3 + GLA_DV
    s5 = s4 + GLA_GATE_RANK
    q, k, v, r, gd_f, gd_b = jnp.split(proj, [s1, s2, s3, s4, s5], axis=-1)

    def heads(a, d):
        return a.reshape(B, T, GLA_HEADS, d).transpose(0, 2, 1, 3)

    log_a_f = jax.nn.log_sigmoid((gd_f @ w_gate_up_f + b_gate_f).astype(jnp.float32)) / GLA_TAU
    log_a_b = jax.nn.log_sigmoid((gd_b @ w_gate_up_b + b_gate_b).astype(jnp.float32)) / GLA_TAU
    qh = heads(q, GLA_HEAD_K) * (GLA_HEAD_K ** -0.5)
    kh = heads(k, GLA_HEAD_K)
    vh = heads(v, GLA_HEAD_V)
    gf = heads(log_a_f, GLA_HEAD_K)
    gb = heads(log_a_b, GLA_HEAD_K)
    o_fwd = gla_chunked(qh, kh, vh, gf, False)
    o_bwd = jnp.flip(gla_chunked(jnp.flip(qh, 2), jnp.flip(kh, 2), jnp.flip(vh, 2), jnp.flip(gb, 2), True), 2)
    o = (o_fwd + o_bwd).transpose(0, 2, 1, 3)
    o = rms_norm(o, head_norm).reshape(B, T, GLA_DV)
    return (o * jax.nn.silu(r)) @ w_out


def rope(x, cos, sin):
    half = x.shape[-1] // 2
    x1 = x[..., :half].astype(jnp.float32)
    x2 = x[..., half:].astype(jnp.float32)
    return jnp.concatenate([x1 * cos - x2 * sin, x1 * sin + x2 * cos], axis=-1).astype(x.dtype)


def mla_mixer(h, positions, w_in, q_norm, w_uq, kv_norm, w_ukv, w_out):
    B, T, _ = h.shape
    c_q, c_kv, k_r = jnp.split(h @ w_in, [MLA_Q_RANK, MLA_Q_RANK + MLA_KV_RANK], axis=-1)
    q = (rms_norm(c_q, q_norm) @ w_uq).reshape(B, T, MLA_HEADS, MLA_NOPE + MLA_ROPE)
    kv = (rms_norm(c_kv, kv_norm) @ w_ukv).reshape(B, T, MLA_HEADS, MLA_NOPE + MLA_V)
    q_nope, q_rope = q[..., :MLA_NOPE], q[..., MLA_NOPE:]
    k_nope, v = kv[..., :MLA_NOPE], kv[..., MLA_NOPE:]

    half = MLA_ROPE // 2
    inv_freq = ROPE_BASE ** (-jnp.arange(half, dtype=jnp.float32) / half)
    ang = positions.astype(jnp.float32)[..., None] * inv_freq
    cos, sin = jnp.cos(ang), jnp.sin(ang)
    q_rope = rope(q_rope, cos[:, :, None, :], sin[:, :, None, :])
    k_rope = rope(k_r, cos, sin)

    scale = (MLA_NOPE + MLA_ROPE) ** -0.5
    nb = T // Q_BLOCK
    qn_blocks = q_nope.reshape(B, nb, Q_BLOCK, MLA_HEADS, MLA_NOPE).transpose(1, 0, 3, 2, 4)
    qr_blocks = q_rope.reshape(B, nb, Q_BLOCK, MLA_HEADS, MLA_ROPE).transpose(1, 0, 3, 2, 4)
    k_nope_t = k_nope.transpose(0, 2, 1, 3)
    v_t = v.transpose(0, 2, 1, 3)

    def attend(blk):
        qn, qr = blk
        s = jnp.einsum('bhqd,bhkd->bhqk', qn, k_nope_t) + jnp.einsum('bhqr,bkr->bhqk', qr, k_rope)
        p = jax.nn.softmax(s.astype(jnp.float32) * scale, axis=-1)
        return jnp.einsum('bhqk,bhkd->bqhd', p.astype(v_t.dtype), v_t)

    o = lax.map(attend, (qn_blocks, qr_blocks))
    o = o.transpose(1, 0, 2, 3, 4).reshape(B, T, MLA_HEADS * MLA_V)
    return o @ w_out


def ec_moe(h, w_router, w_gate, w_up, w_down):
    B, T, D = h.shape
    cap = max(1, EC_CAPACITY_FACTOR * T // N_EXPERTS)
    aff = jax.nn.softmax((h @ w_router).astype(jnp.float32), axis=-1)
    top_aff, top_idx = lax.top_k(jnp.swapaxes(aff, 1, 2), cap)
    xs = jax.vmap(lambda hb, ib: hb[ib])(h, top_idx)
    a = jnp.einsum('becd,edf->becf', xs, w_gate)
    u = jnp.einsum('becd,edf->becf', xs, w_up)
    y = jnp.einsum('becf,efd->becd', jax.nn.silu(a) * u, w_down)
    y = y * top_aff[..., None].astype(y.dtype)
    return jax.vmap(lambda yb, ib: jnp.zeros((T, D), yb.dtype).at[ib.reshape(-1)].add(yb.reshape(-1, D)))(y, top_idx)


def setup_inputs(seed: int = 0) -> dict:
    key = jax.random.key(seed)
    ks = jax.random.split(key, 24)

    def nrm(k, shape, fan_in):
        return jax.random.normal(k, shape, jnp.float32) * (fan_in ** -0.5)

    def gain(k, shape):
        return 1.0 + 0.02 * jax.random.normal(k, shape, jnp.float32)

    return {
        'x': jax.random.normal(ks[0], (BATCH, SEQ, D_MODEL), jnp.float32),
        'positions': jnp.broadcast_to(jnp.arange(SEQ, dtype=jnp.int32)[None, :], (BATCH, SEQ)),
        'mix_norm': gain(ks[1], (DEPTH, D_MODEL)),
        'ffn_norm': gain(ks[2], (DEPTH, D_MODEL)),
        'final_norm': gain(ks[3], (D_MODEL,)),
        'gla_w_in': nrm(ks[4], (N_GLA_LAYERS, D_MODEL, GLA_IN), D_MODEL),
        'gla_w_gate_up_f': nrm(ks[5], (N_GLA_LAYERS, GLA_GATE_RANK, GLA_DK), GLA_GATE_RANK),
        'gla_b_gate_f': 0.1 * jax.random.normal(ks[6], (N_GLA_LAYERS, GLA_DK), jnp.float32),
        'gla_w_gate_up_b': nrm(ks[7], (N_GLA_LAYERS, GLA_GATE_RANK, GLA_DK), GLA_GATE_RANK),
        'gla_b_gate_b': 0.1 * jax.random.normal(ks[8], (N_GLA_LAYERS, GLA_DK), jnp.float32),
        'gla_head_norm': gain(ks[9], (N_GLA_LAYERS, GLA_HEAD_V)),
        'gla_w_out': nrm(ks[10], (N_GLA_LAYERS, GLA_DV, D_MODEL), GLA_DV),
        'mla_w_in': nrm(ks[11], (N_MLA_LAYERS, D_MODEL, MLA_IN), D_MODEL),
        'mla_q_norm': gain(ks[12], (N_MLA_LAYERS, MLA_Q_RANK)),
        'mla_w_uq': nrm(ks[13], (N_MLA_LAYERS, MLA_Q_RANK, MLA_HEADS * (MLA_NOPE + MLA_ROPE)), MLA_Q_RANK),
        'mla_kv_norm': gain(ks[14], (N_MLA_LAYERS, MLA_KV_RANK)),
        'mla_w_ukv': nrm(ks[15], (N_MLA_LAYERS, MLA_KV_RANK, MLA_HEADS * (MLA_NOPE + MLA_V)), MLA_KV_RANK),
        'mla_w_out': nrm(ks[16], (N_MLA_LAYERS, MLA_HEADS * MLA_V, D_MODEL), MLA_HEADS * MLA_V),
        'moe_w_router': nrm(ks[17], (DEPTH, D_MODEL, N_EXPERTS), D_MODEL),
        'moe_w_gate': nrm(ks[18], (DEPTH, N_EXPERTS, D_MODEL, EXPERT_FF), D_MODEL),
        'moe_w_up': nrm(ks[19], (DEPTH, N_EXPERTS, D_MODEL, EXPERT_FF), D_MODEL),
        'moe_w_down': nrm(ks[20], (DEPTH, N_EXPERTS, EXPERT_FF, D_MODEL), EXPERT_FF),
    }


def reference(x, positions, mix_norm, ffn_norm, final_norm,
              gla_w_in, gla_w_gate_up_f, gla_b_gate_f, gla_w_gate_up_b, gla_b_gate_b, gla_head_norm, gla_w_out,
              mla_w_in, mla_q_norm, mla_w_uq, mla_kv_norm, mla_w_ukv, mla_w_out,
              moe_w_router, moe_w_gate, moe_w_up, moe_w_down):
    h = x
    for i in range(DEPTH):
        j = i // N_MIXERS
        hn = rms_norm(h, mix_norm[i])
        if i % N_MIXERS == 0:
            h = h + gla_mixer(hn, gla_w_in[j], gla_w_gate_up_f[j], gla_b_gate_f[j], gla_w_gate_up_b[j],
                              gla_b_gate_b[j], gla_head_norm[j], gla_w_out[j])
        else:
            h = h + mla_mixer(hn, positions, mla_w_in[j], mla_q_norm[j], mla_w_uq[j], mla_kv_norm[j],
                              mla_w_ukv[j], mla_w_out[j])
        h = h + ec_moe(rms_norm(h, ffn_norm[i]), moe_w_router[i], moe_w_gate[i], moe_w_up[i], moe_w_down[i])
    return rms_norm(h, final_norm)
```

```cpp
#include <hip/hip_runtime.h>
#include <cstdio>
#include <cstdint>
#include <cmath>

constexpr int T = 16384, D = 1024, NE = 16, CAP = 2048, FF = 2048;
constexpr int GH = 4, GDK = 128, GDV = 256, GC = 64, GNC = T / GC;
constexpr int MH = 16, MDK = 192, MDV = 128;
constexpr float RMS_EPS = 1e-6f;

typedef unsigned short bf16_t;
typedef short bf16x8 __attribute__((ext_vector_type(8)));
typedef short s16x4 __attribute__((ext_vector_type(4)));
typedef float f32x4 __attribute__((ext_vector_type(4)));
typedef float f32x2 __attribute__((ext_vector_type(2)));
typedef float f32x16 __attribute__((ext_vector_type(16)));
typedef unsigned u32x4 __attribute__((ext_vector_type(4)));
typedef unsigned u32x2 __attribute__((ext_vector_type(2)));

constexpr size_t MiB = 1u << 20;
constexpr size_t WS_CTL = 0, CTL_ZERO_BYTES = 512 * 1024;
constexpr size_t WS_WGIN = 1 * MiB;
constexpr size_t WS_WV = 7 * MiB;
constexpr size_t WS_WGOUT = 9 * MiB;
constexpr size_t WS_WMIN = 11 * MiB;
constexpr size_t WS_WUQ = 12 * MiB;
constexpr size_t WS_WUKV = 14 * MiB;
constexpr size_t WS_WMOUT = 16 * MiB;
constexpr size_t WS_WGU = 20 * MiB;
constexpr size_t WS_WD = 148 * MiB;
constexpr size_t WS_AFF = 212 * MiB;
constexpr size_t WS_SEL = 213 * MiB;
constexpr size_t WS_IDX = 214 * MiB;
constexpr size_t WS_EGL = 215 * MiB;
constexpr size_t WS_CS = 216 * MiB;
constexpr size_t WS_XN = 220 * MiB;
constexpr size_t WS_HB = 252 * MiB;
constexpr size_t WS_AR = 316 * MiB;
constexpr size_t WS_END = 828 * MiB;
constexpr size_t AR_Q0 = WS_AR, AR_K0 = WS_AR + 16 * MiB, AR_GF = WS_AR + 32 * MiB, AR_GB = WS_AR + 64 * MiB, AR_SR = WS_AR + 96 * MiB, AR_VT = WS_AR + 128 * MiB;
constexpr size_t AR_QDF = WS_AR + 160 * MiB, AR_QDB = WS_AR + 176 * MiB, AR_KDF = WS_AR + 192 * MiB, AR_KDB = WS_AR + 208 * MiB, AR_KTF = WS_AR + 224 * MiB, AR_KTB = WS_AR + 240 * MiB;
constexpr size_t AR_U = WS_AR + 256 * MiB, AR_ST = WS_AR + 384 * MiB;
constexpr size_t AR_XS = WS_AR, AR_H = WS_AR + 64 * MiB, AR_Y = WS_AR + 192 * MiB;
constexpr size_t AR_CIN = WS_AR, AR_CQN = WS_AR + 32 * MiB, AR_CKVN = WS_AR + 40 * MiB, AR_Q = WS_AR + 48 * MiB, AR_K = WS_AR + 144 * MiB, AR_V = WS_AR + 240 * MiB, AR_O = WS_AR + 304 * MiB;

constexpr int LDS_BYTES = 147456;
constexpr int LDS_MISC = 135168;

__device__ __forceinline__ unsigned cvt_pk_bf16(float lo, float hi) { unsigned r; asm volatile("v_cvt_pk_bf16_f32 %0, %1, %2" : "=v"(r) : "v"(lo), "v"(hi)); return r; }
__device__ __forceinline__ float bf_lo(unsigned w) { return __uint_as_float(w << 16); }
__device__ __forceinline__ float bf_hi(unsigned w) { return __uint_as_float(w & 0xffff0000u); }
__device__ __forceinline__ float bf2f(bf16_t b) { return __uint_as_float(((unsigned)b) << 16); }
__device__ __forceinline__ bf16_t f2bf(float f) { return (bf16_t)(cvt_pk_bf16(f, 0.f) & 0xffffu); }
__device__ __forceinline__ float siluf(float x) { return x / (1.f + __expf(-x)); }
__device__ __forceinline__ float logsigf(float x) { return fminf(x, 0.f) - log1pf(__expf(-fabsf(x))); }
__device__ __forceinline__ void store8bf(bf16_t* p, f32x4 v0, f32x4 v1) {
    u32x4 w; w.x = cvt_pk_bf16(v0[0], v0[1]); w.y = cvt_pk_bf16(v0[2], v0[3]); w.z = cvt_pk_bf16(v1[0], v1[1]); w.w = cvt_pk_bf16(v1[2], v1[3]); *(u32x4*)p = w; }
__device__ __forceinline__ float wave_sum(float v) {
#pragma unroll
    for (int o = 1; o < 64; o <<= 1) v += __shfl_xor(v, o);
    return v; }
__device__ __forceinline__ float wave_max(float v) {
#pragma unroll
    for (int o = 1; o < 64; o <<= 1) v = fmaxf(v, __shfl_xor(v, o));
    return v; }
#define LAS __attribute__((address_space(3)))
#define LDS_WAIT() asm volatile("s_waitcnt lgkmcnt(0)" ::: "memory")
#define VM_WAIT() asm volatile("s_waitcnt vmcnt(0)" ::: "memory")

namespace pg8 {
#define PG8_LAS __attribute__((address_space(3)))
typedef unsigned short bf16_t;
typedef short bf16x8 __attribute__((ext_vector_type(8)));
typedef float f32x4 __attribute__((ext_vector_type(4)));
typedef unsigned u32x4 __attribute__((ext_vector_type(4)));
constexpr int BM = 256, BK = 64, HALF = 128, HTB = HALF * BK * 2  , STAGE_BYTES = 8 * HTB, NXCD = 8, WGM = 8;

__host__ __device__ __forceinline__ int lds_byte(int r, int c) { const int st = (r >> 4) * 2 + (c >> 5), rr = r & 15, cc = c & 31, ob = rr * 64 + cc * 2; return st * 1024 + (ob ^ (((ob >> 9) & 1) << 5)); }
__host__ __device__ __forceinline__ void stage_rc(int b, int& R, int& C) { const int st = b / 1024, sb = b % 1024, swz = sb ^ (((sb >> 9) & 1) << 5); R = (st >> 1) * 16 + swz / 64; C = (st & 1) * 32 + (swz % 64) / 2; }
__host__ __device__ __forceinline__ int perm32(int rho) { const int n = rho >> 4, i = rho & 15; return 8 * (i >> 2) + 4 * n + (i & 3); }

struct Unit { int pm, pn; };
struct Gemm { const bf16_t* A; const bf16_t* Bt; int M, N, K; };

struct StaticOrder {
    int nM, nN, nwg, G, c;
    __host__ __device__ void init(int M, int N, int G_, int c_) { nM = M / BM; nN = N / BM; nwg = nM * nN; G = G_; c = c_; }
    __host__ __device__ bool next(int i, Unit& u) const {
        const long L = (long)i * G + c; if (L >= nwg) return false;
        int wgid = (int)L; { const int q = nwg / NXCD, r = nwg % NXCD, xcd = wgid % NXCD, off = wgid / NXCD; wgid = (xcd < r ? xcd * (q + 1) : r * (q + 1) + (xcd - r) * q) + off; }
        const int nig = WGM * nN, gid = wgid / nig, fm = gid * WGM, gsz = (nM - fm) < WGM ? (nM - fm) : WGM;
        u.pm = fm + ((wgid % nig) % gsz); u.pn = (wgid % nig) / gsz; return true;
    }
    __device__ __forceinline__ void a_ready(const Unit&) const {}
    __device__ __forceinline__ void done(const Unit&) const {}
};

struct GroupedOrder : StaticOrder {
    int nNl;
    __host__ __device__ void init(int Mtot, int Nper, int G_, int c_) { StaticOrder::init(Mtot, Nper, G_, c_); nNl = Nper / BM; }
    __host__ __device__ bool next(int i, Unit& u) const { if (!StaticOrder::next(i, u)) return false; u.pn += (u.pm >> 3) * nNl; return true; }
};

#define EPI_LOOP_ROWS for (int ai = 0; ai < 2; ++ai) _Pragma("unroll") for (int m = 0; m < 4; ++m)

struct EpiGlaIn {
    static constexpr bool PERM = true, AFTER_DRAIN = false;
    bf16_t *Q0, *K0, *SR; float *GF, *GB; const float *bF, *bB;
    __device__ __forceinline__ void operator()(const f32x4 (&acc)[2][2][4][2], const Unit& u, int wr, int wc, int fr, int fq) const {
        const int row0 = u.pm * BM + wr * 64 + fr, pn = u.pn;
#pragma unroll
        EPI_LOOP_ROWS { const size_t row = (size_t)(row0 + ai * HALF + m * 16);
#pragma unroll
            for (int bj = 0; bj < 2; ++bj) { const int cl = bj * HALF + wc * 32 + 8 * fq; f32x4 v0 = acc[ai][bj][m][0], v1 = acc[ai][bj][m][1];
                if (pn < 2) { const float s = 0.08838834764831845f; store8bf(Q0 + row * 512 + pn * 256 + cl, v0 * s, v1 * s); }
                else if (pn < 4) { store8bf(K0 + row * 512 + (pn - 2) * 256 + cl, v0, v1); }
                else if (pn < 8) {
#pragma unroll
                    for (int j = 0; j < 4; ++j) { v0[j] = siluf(v0[j]); v1[j] = siluf(v1[j]); }
                    store8bf(SR + row * 1024 + (pn - 4) * 256 + cl, v0, v1); }
                else { float* G = pn < 10 ? GF : GB; const float* b = pn < 10 ? bF : bB; const int c = ((pn - 8) & 1) * 256 + cl;
                    const f32x4 b0 = *(const f32x4*)(b + c), b1 = *(const f32x4*)(b + c + 4); f32x4 o0, o1;
#pragma unroll
                    for (int j = 0; j < 4; ++j) { o0[j] = logsigf(v0[j] + b0[j]) * 0.0625f; o1[j] = logsigf(v1[j] + b1[j]) * 0.0625f; }
                    *(f32x4*)(G + row * 512 + c) = o0; *(f32x4*)(G + row * 512 + c + 4) = o1; } } }
    }
};
struct EpiBf {
    static constexpr bool PERM = true, AFTER_DRAIN = false;
    bf16_t* O; int ldc;
    __device__ __forceinline__ void operator()(const f32x4 (&acc)[2][2][4][2], const Unit& u, int wr, int wc, int fr, int fq) const {
        const int row0 = u.pm * BM + wr * 64 + fr;
#pragma unroll
        EPI_LOOP_ROWS { bf16_t* rowp = O + (size_t)(row0 + ai * HALF + m * 16) * ldc + u.pn * BM + wc * 32 + 8 * fq;
#pragma unroll
            for (int bj = 0; bj < 2; ++bj) store8bf(rowp + bj * HALF, acc[ai][bj][m][0], acc[ai][bj][m][1]); }
    }
};
struct EpiF32 {
    static constexpr bool PERM = false, AFTER_DRAIN = false;
    float* C; const float* base; int ldc;
    __device__ __forceinline__ void operator()(const f32x4 (&acc)[2][2][4][2], const Unit& u, int wr, int wc, int fr, int fq) const {
        const int row0 = u.pm * BM + wr * 64 + fr, col0 = u.pn * BM + wc * 32 + 4 * fq;
#pragma unroll
        EPI_LOOP_ROWS { const size_t off = (size_t)(row0 + ai * HALF + m * 16) * ldc + col0;
#pragma unroll
            for (int bj = 0; bj < 2; ++bj)
#pragma unroll
                for (int n = 0; n < 2; ++n) { f32x4 v = acc[ai][bj][m][n]; if (base) v = v + *(const f32x4*)(base + off + bj * HALF + n * 16); *(f32x4*)(C + off + bj * HALF + n * 16) = v; } }
    }
};
struct EpiQup {
    static constexpr bool PERM = true, AFTER_DRAIN = false;
    bf16_t* Q; const float* CS;
    __device__ __forceinline__ void operator()(const f32x4 (&acc)[2][2][4][2], const Unit& u, int wr, int wc, int fr, int fq) const {
        const int row0 = u.pm * BM + wr * 64 + fr, h = u.pn; const float QS = 0.07216878364870322f * 1.4426950408889634f;
#pragma unroll
        EPI_LOOP_ROWS { const size_t row = (size_t)(row0 + ai * HALF + m * 16); bf16_t* qrow = Q + ((size_t)h * T + row) * MDK;
            store8bf(qrow + wc * 32 + 8 * fq, acc[ai][0][m][0] * QS, acc[ai][0][m][1] * QS);
            if (wc < 2) { const int i0 = wc * 16 + 4 * fq; const f32x4 c = *(const f32x4*)(CS + row * 64 + i0), s = *(const f32x4*)(CS + row * 64 + 32 + i0);
                const f32x4 x1 = acc[ai][1][m][0], x2 = acc[ai][1][m][1];
                store8bf(qrow + 128 + wc * 32 + 8 * fq, (x1 * c - x2 * s) * QS, (x1 * s + x2 * c) * QS); } }
    }
};
struct EpiKVup {
    static constexpr bool PERM = true, AFTER_DRAIN = false;
    bf16_t *K, *V;
    __device__ __forceinline__ void operator()(const f32x4 (&acc)[2][2][4][2], const Unit& u, int wr, int wc, int fr, int fq) const {
        const int row0 = u.pm * BM + wr * 64 + fr, h = u.pn;
#pragma unroll
        EPI_LOOP_ROWS { const size_t row = (size_t)h * T + (size_t)(row0 + ai * HALF + m * 16);
            store8bf(K + row * MDK + wc * 32 + 8 * fq, acc[ai][0][m][0], acc[ai][0][m][1]);
            store8bf(V + row * MDV + wc * 32 + 8 * fq, acc[ai][1][m][0], acc[ai][1][m][1]); }
    }
};
struct EpiMoe1 {
    static constexpr bool PERM = true, AFTER_DRAIN = false;
    bf16_t* H;
    __device__ __forceinline__ void operator()(const f32x4 (&acc)[2][2][4][2], const Unit& u, int wr, int wc, int fr, int fq) const {
        const int row0 = u.pm * BM + wr * 64 + fr, j = u.pn & 15;
#pragma unroll
        EPI_LOOP_ROWS { bf16_t* rowp = H + (size_t)(row0 + ai * HALF + m * 16) * FF + 128 * j + 16 * wc + 4 * fq;
#pragma unroll
            for (int bj = 0; bj < 2; ++bj) { const f32x4 g = acc[ai][bj][m][0], uu = acc[ai][bj][m][1];
                u32x2 w; w.x = cvt_pk_bf16(siluf(g[0]) * uu[0], siluf(g[1]) * uu[1]); w.y = cvt_pk_bf16(siluf(g[2]) * uu[2], siluf(g[3]) * uu[3]);
                *(u32x2*)(rowp + 64 * bj) = w; } }
    }
};
struct EpiMoe2 {
    static constexpr bool PERM = true, AFTER_DRAIN = false;
    bf16_t* Y;
    __device__ __forceinline__ void operator()(const f32x4 (&acc)[2][2][4][2], const Unit& u, int wr, int wc, int fr, int fq) const {
        const int row0 = u.pm * BM + wr * 64 + fr, j = u.pn & 3;
#pragma unroll
        EPI_LOOP_ROWS { bf16_t* rowp = Y + (size_t)(row0 + ai * HALF + m * 16) * D + 256 * j + wc * 32 + 8 * fq;
#pragma unroll
            for (int bj = 0; bj < 2; ++bj) store8bf(rowp + bj * HALF, acc[ai][bj][m][0], acc[ai][bj][m][1]); }
    }
};

template <class Epi, class Sched, bool ALIGN_EPI = false, bool SP2 = false>
__device__ __forceinline__ void gemm_phase(PG8_LAS unsigned char* lds, const Gemm g, const Sched& S, const Epi& E) {
    const int tid = threadIdx.x, wid = __builtin_amdgcn_readfirstlane(tid >> 6), lane = tid & 63, wr = wid >> 2, wc = wid & 3, fr = lane & 15, fq = lane >> 4;
    int K = g.K; asm volatile("" : "+s"(K));
    const int nt = K / BK;
    unsigned voffA[2], voffB[2];
#pragma unroll
    for (int i = 0; i < 2; ++i) { int R, C; stage_rc(tid * 16 + i * 8192, R, C); const int Rb = Epi::PERM ? ((R & ~31) + perm32(R & 31)) : R;
        voffA[i] = (unsigned)(R * K + C) * 2u; voffB[i] = (unsigned)(Rb * K + C) * 2u; }
    const size_t kstep = (size_t)(BK * 2);
    const size_t hstep = (size_t)HALF * K * 2;
    const size_t tstep = 2 * hstep;
    const unsigned ldsw = (unsigned)wid * 1024u;
    const int aoff = lds_byte(wr * 64 + fr, fq * 8), boff = lds_byte(wc * 32 + fr, fq * 8);
#define PG8_SA(b, h) (((b) * 2 + (h)) * HTB)
#define PG8_SB(b, h) ((4 + (b) * 2 + (h)) * HTB)
#define PG8_STAGE(bufoff, gbase, voff) do { _Pragma("unroll") for (int _i = 0; _i < 2; ++_i) \
        __builtin_amdgcn_global_load_lds((const unsigned*)((const char*)(gbase) + (voff)[_i]), (PG8_LAS unsigned*)(lds + (bufoff) + ldsw + _i * 8192), 16, 0, 0); } while (0)
#define PG8_LDA(dst, b, h) do { _Pragma("unroll") for (int m = 0; m < 4; ++m) _Pragma("unroll") for (int k = 0; k < 2; ++k) dst[m][k] = *(const PG8_LAS bf16x8*)(lds + PG8_SA(b, h) + aoff + m * 2048 + k * 1024); } while (0)
#define PG8_LDB(dst, b, h) do { _Pragma("unroll") for (int n = 0; n < 2; ++n) _Pragma("unroll") for (int k = 0; k < 2; ++k) dst[n][k] = *(const PG8_LAS bf16x8*)(lds + PG8_SB(b, h) + boff + n * 2048 + k * 1024); } while (0)
#define PG8_MMA(ai, bj, At, Bt) do { __builtin_amdgcn_s_setprio(1); _Pragma("unroll") for (int m = 0; m < 4; ++m) _Pragma("unroll") for (int n = 0; n < 2; ++n) _Pragma("unroll") for (int k = 0; k < 2; ++k) \
        acc[ai][bj][m][n] = __builtin_amdgcn_mfma_f32_16x16x32_bf16(Bt[n][k], At[m][k], acc[ai][bj][m][n], 0, 0, 0); __builtin_amdgcn_s_setprio(0); } while (0)
#define PG8_WAIT_V(n) asm volatile("s_waitcnt vmcnt(" #n ")" ::: "memory")
#define PG8_WAIT_L(n) asm volatile("s_waitcnt lgkmcnt(" #n ")" ::: "memory")
#define PG8_BAR __builtin_amdgcn_s_barrier()
#define PG8_SCHED __builtin_amdgcn_sched_barrier(0)
    Unit cur, nxt; int ui = 0;
    if (!S.next(0, cur)) return;
    f32x4 acc[2][2][4][2];
#pragma unroll
    for (int a = 0; a < 2; ++a)
#pragma unroll
        for (int b = 0; b < 2; ++b)
#pragma unroll
            for (int m = 0; m < 4; ++m)
#pragma unroll
                for (int n = 0; n < 2; ++n) acc[a][b][m][n] = (f32x4){0.f, 0.f, 0.f, 0.f};
    bf16x8 At[4][2], B0[2][2], B1[2][2];
    const char* cA = (const char*)g.A + (size_t)cur.pm * tstep; const char* cB = (const char*)g.Bt + (size_t)cur.pn * tstep;
    S.a_ready(cur);
    if constexpr (SP2) {
        PG8_STAGE(PG8_SB(0, 0), cB, voffB); PG8_STAGE(PG8_SB(0, 1), cB + hstep, voffB); PG8_STAGE(PG8_SA(0, 0), cA, voffA); PG8_STAGE(PG8_SA(0, 1), cA + hstep, voffA);
        if (wr == 1) PG8_BAR;
        PG8_WAIT_V(2); PG8_BAR;
        PG8_STAGE(PG8_SB(1, 0), cB + kstep, voffB); PG8_STAGE(PG8_SA(1, 0), cA + kstep, voffA); PG8_STAGE(PG8_SB(1, 1), cB + hstep + kstep, voffB);
        PG8_WAIT_V(6); PG8_BAR;
    } else {
        PG8_STAGE(PG8_SB(0, 0), cB, voffB); PG8_STAGE(PG8_SA(0, 0), cA, voffA); PG8_STAGE(PG8_SB(0, 1), cB + hstep, voffB); PG8_STAGE(PG8_SA(0, 1), cA + hstep, voffA);
        if (wr == 1) PG8_BAR;
        PG8_WAIT_V(4); PG8_BAR;
        PG8_STAGE(PG8_SB(1, 0), cB + kstep, voffB); PG8_STAGE(PG8_SA(1, 0), cA + kstep, voffA); PG8_STAGE(PG8_SB(1, 1), cB + hstep + kstep, voffB);
        PG8_WAIT_V(6); PG8_BAR;
    }
    for (;;) {
        const bool has_next = S.next(ui + 1, nxt);
        const char* nA = has_next ? (const char*)g.A + (size_t)nxt.pm * tstep : cA; const char* nB = has_next ? (const char*)g.Bt + (size_t)nxt.pn * tstep : cB;
        for (int t = 0; t < nt; t += 2) {
            const bool last = (t == nt - 2);
            const char* a1 = cA + (size_t)(t + 1) * kstep;
            const char* a2 = last ? nA : cA + (size_t)(t + 2) * kstep; const char* b2 = last ? nB : cB + (size_t)(t + 2) * kstep;
            const char* a3 = a2 + kstep; const char* b3 = b2 + kstep;
            if (last && has_next) S.a_ready(nxt);
            if constexpr (SP2) {
            PG8_LDB(B0, 0, 0); PG8_LDB(B1, 0, 1); PG8_SCHED; PG8_LDA(At, 0, 0); PG8_STAGE(PG8_SA(1, 1), a1 + hstep, voffA);
            PG8_WAIT_V(8); PG8_WAIT_L(0); PG8_BAR; PG8_MMA(0, 0, At, B0); PG8_MMA(0, 1, At, B1); PG8_BAR; PG8_SCHED;
            PG8_LDA(At, 0, 1); PG8_STAGE(PG8_SB(0, 0), b2, voffB); PG8_STAGE(PG8_SB(0, 1), b2 + hstep, voffB); PG8_STAGE(PG8_SA(0, 0), a2, voffA);
            PG8_WAIT_V(8); PG8_WAIT_L(0); PG8_BAR; PG8_MMA(1, 0, At, B0); PG8_MMA(1, 1, At, B1); PG8_BAR; PG8_SCHED;
            PG8_LDB(B0, 1, 0); PG8_LDB(B1, 1, 1); PG8_SCHED; PG8_LDA(At, 1, 0); PG8_STAGE(PG8_SA(0, 1), a2 + hstep, voffA);
            PG8_WAIT_V(8); PG8_WAIT_L(0); PG8_BAR; PG8_MMA(0, 0, At, B0); PG8_MMA(0, 1, At, B1); PG8_BAR; PG8_SCHED;
            PG8_LDA(At, 1, 1); PG8_STAGE(PG8_SB(1, 0), b3, voffB); PG8_STAGE(PG8_SB(1, 1), b3 + hstep, voffB); PG8_STAGE(PG8_SA(1, 0), a3, voffA);
            PG8_WAIT_V(8); PG8_WAIT_L(0); PG8_BAR; PG8_MMA(1, 0, At, B0); PG8_MMA(1, 1, At, B1); PG8_BAR; PG8_SCHED;
            } else {
            PG8_LDB(B0, 0, 0); PG8_SCHED; PG8_LDA(At, 0, 0); PG8_STAGE(PG8_SA(1, 1), a1 + hstep, voffA);
            PG8_WAIT_L(8); PG8_BAR; PG8_WAIT_L(0); PG8_MMA(0, 0, At, B0); PG8_BAR; PG8_SCHED;
            PG8_LDB(B1, 0, 1); PG8_STAGE(PG8_SB(0, 0), b2, voffB);
            PG8_BAR; PG8_WAIT_L(0); PG8_MMA(0, 1, At, B1); PG8_BAR;
            PG8_LDA(At, 0, 1); PG8_STAGE(PG8_SA(0, 0), a2, voffA);
            PG8_BAR; PG8_WAIT_L(0); PG8_MMA(1, 0, At, B0); PG8_BAR; PG8_SCHED;
            PG8_STAGE(PG8_SB(0, 1), b2 + hstep, voffB);
            PG8_WAIT_V(6); PG8_BAR; PG8_MMA(1, 1, At, B1); PG8_BAR;
            PG8_LDB(B0, 1, 0); PG8_SCHED; PG8_LDA(At, 1, 0); PG8_STAGE(PG8_SA(0, 1), a2 + hstep, voffA);
            PG8_WAIT_L(8); PG8_BAR; PG8_WAIT_L(0); PG8_MMA(0, 0, At, B0); PG8_BAR; PG8_SCHED;
            PG8_LDB(B1, 1, 1); PG8_STAGE(PG8_SB(1, 0), b3, voffB);
            PG8_BAR; PG8_WAIT_L(0); PG8_MMA(0, 1, At, B1); PG8_BAR;
            PG8_LDA(At, 1, 1); PG8_STAGE(PG8_SA(1, 0), a3, voffA);
            PG8_BAR; PG8_WAIT_L(0); PG8_MMA(1, 0, At, B0); PG8_BAR; PG8_SCHED;
            PG8_STAGE(PG8_SB(1, 1), b3 + hstep, voffB);
            PG8_WAIT_V(6); PG8_BAR; PG8_MMA(1, 1, At, B1); PG8_BAR;
            }
        }
        if constexpr (ALIGN_EPI) { if (wr == 0) PG8_BAR; }
        if constexpr (!Epi::AFTER_DRAIN) { E(acc, cur, wr, wc, fr, fq); S.done(cur); }
        if (!has_next) break;
#pragma unroll
        for (int a = 0; a < 2; ++a)
#pragma unroll
            for (int b = 0; b < 2; ++b)
#pragma unroll
                for (int m = 0; m < 4; ++m)
#pragma unroll
                    for (int n = 0; n < 2; ++n) acc[a][b][m][n] = (f32x4){0.f, 0.f, 0.f, 0.f};
        cur = nxt; cA = nA; cB = nB; ++ui;
        if constexpr (ALIGN_EPI) { if (wr == 1) PG8_BAR; }
    }
    PG8_WAIT_V(0);
    if constexpr (!ALIGN_EPI) { if (wr == 0) PG8_BAR; }
    PG8_BAR;
    if constexpr (Epi::AFTER_DRAIN) { E.fused(acc, cur, wr, wc, fr, fq, lds, wid, lane); S.done(cur); }
#undef PG8_SA
#undef PG8_SB
#undef PG8_STAGE
#undef PG8_LDA
#undef PG8_LDB
#undef PG8_MMA
#undef PG8_WAIT_V
#undef PG8_WAIT_L
#undef PG8_BAR
#undef PG8_SCHED
}
}
#define XB_TMO      128
#define XB_XCNT(j)  (256  + 64 * (j))
#define XB_XSUB(j)  (1280 + 64 * (j))
#define XB_XGEN(j)  (2304 + 64 * (j))
#define XB_TOP      3328
#define XB_TOPGEN   3392
#define XCD_BAR_WORDS 3456
#define XB_SPIN_CAP (1u << 18)

__device__ __forceinline__ unsigned xb_ld(unsigned* p)              { return __hip_atomic_load(p, __ATOMIC_RELAXED, __HIP_MEMORY_SCOPE_AGENT); }
__device__ __forceinline__ unsigned xb_add(unsigned* p, unsigned v) { return __hip_atomic_fetch_add(p, v, __ATOMIC_RELAXED, __HIP_MEMORY_SCOPE_AGENT); }
__device__ __forceinline__ unsigned xb_xcc_id() { return (unsigned)__builtin_amdgcn_s_getreg((3 << 11) | 20) & 0xFu; }
#define XB_SPIN(cond, bar) do { unsigned _sp = 0; while (cond) { __builtin_amdgcn_s_sleep(1); \
    if ((++_sp & 255u) == 0u) { if (xb_ld(&(bar)[XB_TMO])) break; if (_sp > XB_SPIN_CAP) { atomicAdd(&(bar)[XB_TMO], 1u); break; } } } } while (0)

struct XcdBarrier {
    unsigned* bar; unsigned x;
    volatile LAS unsigned* st;
};

__device__ __forceinline__ XcdBarrier xcd_barrier_post(unsigned* bar, volatile LAS unsigned* st) {
    XcdBarrier b; b.bar = bar; b.x = xb_xcc_id(); b.st = st;
    if (threadIdx.x == 0) (void)xb_add(&bar[XB_XCNT(b.x)], 1u);
    return b;
}
__device__ __forceinline__ void xcd_barrier_complete(unsigned* bar, unsigned x, unsigned& nloc, unsigned& nx) {
    const unsigned G = gridDim.x * gridDim.y * gridDim.z;
    unsigned sum, cnt, mine, sp = 0u;
    for (;;) {
        sum = 0u; cnt = 0u; mine = 0u;
#pragma unroll
        for (unsigned j = 0; j < 16; ++j) { const unsigned c = xb_ld(&bar[XB_XCNT(j)]); sum += c; cnt += (c > 0u) ? 1u : 0u; mine = (j == x) ? c : mine; }
        if (sum == G) break;
        __builtin_amdgcn_s_sleep(1);
        if ((++sp & 255u) == 0u) { if (xb_ld(&bar[XB_TMO])) break; if (sp > XB_SPIN_CAP) { atomicAdd(&bar[XB_TMO], 1u); break; } }
    }
    nloc = mine > 0u ? mine : 1u; nx = cnt > 0u ? cnt : 1u;
}

__device__ __forceinline__ void xcd_barrier(const XcdBarrier& b) {
    asm volatile("s_waitcnt vmcnt(0)" ::: "memory");
    __syncthreads();
    if (threadIdx.x == 0) {
        unsigned* bar = b.bar;
        __builtin_amdgcn_s_waitcnt(0);
        unsigned nloc = b.st[0], nx = b.st[1];
        if (nloc == 0u) { xcd_barrier_complete(bar, b.x, nloc, nx); b.st[0] = nloc; b.st[1] = nx; }
        const unsigned old = xb_add(&bar[XB_XSUB(b.x)], 1u);
        const unsigned gen = old / nloc;
        if (old + 1u == (gen + 1u) * nloc) {
            __builtin_amdgcn_fence(__ATOMIC_RELEASE, "agent");
            asm volatile("s_waitcnt vmcnt(0)" ::: "memory");
            const unsigned og = xb_add(&bar[XB_TOP], 1u);
            const unsigned tg = og / nx;
            if (og + 1u == (tg + 1u) * nx) xb_add(&bar[XB_TOPGEN], 1u);
            else XB_SPIN(xb_ld(&bar[XB_TOPGEN]) == tg, bar);
            __builtin_amdgcn_fence(__ATOMIC_ACQUIRE, "agent");
            xb_add(&bar[XB_XGEN(b.x)], 1u);
            asm volatile("s_waitcnt vmcnt(0)" ::: "memory");
        } else {
            XB_SPIN(xb_ld(&bar[XB_XGEN(b.x)]) == gen, bar);
            __builtin_amdgcn_fence(__ATOMIC_ACQUIRE, "agent");
            asm volatile("s_waitcnt vmcnt(0)" ::: "memory");
        }
    }
    __syncthreads();
}

#ifndef PG8_SP2
#define PG8_SP2 true
#endif
#ifndef PG8_ALIGN
#define PG8_ALIGN true
#endif

struct Args { const void* in[22]; float* out; unsigned char* ws; float invf[32]; int ph_lo, ph_hi, li, pad; };
struct Ctx { int tid, lane, wave, gw, ngw, bid, nb; unsigned char* lds; };

struct MapId { int off; __device__ __forceinline__ int operator()(int n) const { return off + n; } };
struct MapGU { int which; __device__ __forceinline__ int operator()(int f) const { return 8 * (f >> 2) + 4 * which + (f & 3); } };
struct MapUq { __device__ __forceinline__ int operator()(int n) const { const int h = n / 192, j = n - h * 192;
    if (j < 128) return 256 * h + j; if (j < 160) { const int i = j - 128; return 256 * h + 128 + 8 * (i >> 2) + (i & 3); } const int i = j - 160; return 256 * h + 128 + 8 * (i >> 2) + 4 + (i & 3); } };
template <class RM>
__device__ __forceinline__ void tr_item(const float* W, int ldw, int k0, int n0, int nsub, bf16_t* WT, int ldt, const RM& rm, float* scr, int lane) {
#pragma unroll 8
    for (int i = 0; i < 32; ++i) { const int kk = 2 * i + (lane >> 5); scr[kk * 33 + (lane & 31)] = W[(size_t)(k0 + kk) * ldw + n0 + (lane & 31)]; }
    LDS_WAIT();
    const int c = lane & 7;
#pragma unroll
    for (int j = 0; j < 4; ++j) { const int n = (lane >> 3) + 8 * j; const float* s = scr + (8 * c) * 33 + n;
        u32x4 o; o.x = cvt_pk_bf16(s[0 * 33], s[1 * 33]); o.y = cvt_pk_bf16(s[2 * 33], s[3 * 33]); o.z = cvt_pk_bf16(s[4 * 33], s[5 * 33]); o.w = cvt_pk_bf16(s[6 * 33], s[7 * 33]);
        *(u32x4*)(WT + (size_t)rm(n0 - nsub + n) * ldt + k0 + 8 * c) = o; }
    LDS_WAIT();
}
template <class RM>
__device__ __forceinline__ void tr_job(const Ctx& C, int& base, const float* W, int ldw, int K, int ncol0, int ncols, bf16_t* WT, int ldt, const RM& rm) {
    const int nblk = ncols / 32, items = (K / 64) * nblk; float* scr = (float*)(C.lds + C.wave * 16384);
    int first = (C.gw - base % C.ngw + C.ngw) % C.ngw;
    for (int it = first; it < items; it += C.ngw) { const int kb = it / nblk, nb = it - kb * nblk; tr_item(W, ldw, 64 * kb, ncol0 + 32 * nb, ncol0, WT, ldt, rm, scr, C.lane); }
    base += items;
}
__device__ __forceinline__ void ph_convert_small(const Ctx& C, const Args& a, unsigned char* ws) {
    const float* w_in = (const float*)a.in[5]; int base = 0;
    bf16_t* WGIN = (bf16_t*)(ws + WS_WGIN);
    tr_job(C, base, w_in, 3104, 1024, 0, 1024, WGIN, 1024, MapId{0});
    tr_job(C, base, w_in, 3104, 1024, 1024, 1024, (bf16_t*)(ws + WS_WV), 1024, MapId{0});
    tr_job(C, base, w_in, 3104, 1024, 2048, 1024, WGIN, 1024, MapId{1024});
    tr_job(C, base, (const float*)a.in[11], 1024, 1024, 0, 1024, (bf16_t*)(ws + WS_WGOUT), 1024, MapId{0});
    tr_job(C, base, (const float*)a.in[12], 448, 1024, 0, 448, (bf16_t*)(ws + WS_WMIN), 1024, MapId{0});
    tr_job(C, base, (const float*)a.in[14], 3072, 256, 0, 3072, (bf16_t*)(ws + WS_WUQ), 256, MapUq{});
    tr_job(C, base, (const float*)a.in[16], 4096, 128, 0, 4096, (bf16_t*)(ws + WS_WUKV), 256, MapId{0});
    tr_job(C, base, (const float*)a.in[17], 1024, 2048, 0, 1024, (bf16_t*)(ws + WS_WMOUT), 2048, MapId{0});
    const int gt = C.bid * 512 + C.tid, ngt = C.nb * 512;
    for (int it = gt; it < 1024 * 128; it += ngt) { const int cp = it >> 7, k8 = it & 127, dir = cp >> 9, c = cp & 511;
        const float* wg = (const float*)a.in[dir ? 8 : 6]; float wj[16];
#pragma unroll
        for (int j = 0; j < 16; ++j) wj[j] = wg[j * 512 + c];
        float o[8];
#pragma unroll
        for (int kk = 0; kk < 8; ++kk) { const float* wr = w_in + (size_t)(8 * k8 + kk) * 3104 + 3072 + 16 * dir; float s = 0.f;
#pragma unroll
            for (int j4 = 0; j4 < 4; ++j4) { const f32x4 x = *(const f32x4*)(wr + 4 * j4); s += x[0] * wj[4 * j4] + x[1] * wj[4 * j4 + 1] + x[2] * wj[4 * j4 + 2] + x[3] * wj[4 * j4 + 3]; }
            o[kk] = s; }
        u32x4 w; w.x = cvt_pk_bf16(o[0], o[1]); w.y = cvt_pk_bf16(o[2], o[3]); w.z = cvt_pk_bf16(o[4], o[5]); w.w = cvt_pk_bf16(o[6], o[7]);
        *(u32x4*)(WGIN + (size_t)(2048 + cp) * 1024 + 8 * k8) = w; }
    const u32x4 z = {0u, 0u, 0u, 0u};
    for (int it = gt; it < 64 * 128; it += ngt) *(u32x4*)((bf16_t*)(ws + WS_WMIN) + (size_t)448 * 1024 + (size_t)it * 8) = z;
    for (int it = gt; it < 16 * 64 * 32; it += ngt) { const int h = it >> 11, r = (it >> 5) & 63, c8 = it & 31; *(u32x4*)((bf16_t*)(ws + WS_WUQ) + (size_t)(256 * h + 192 + r) * 256 + c8 * 8) = z; }
    for (int it = gt; it < 4096 * 16; it += ngt) { const int r = it >> 4, c8 = it & 15; *(u32x4*)((bf16_t*)(ws + WS_WUKV) + (size_t)r * 256 + 128 + c8 * 8) = z; }
}
__device__ __forceinline__ void ph_convert_moe(const Ctx& C, const Args& a, unsigned char* ws, int layer) {
    int base = 0;
    for (int e = 0; e < NE; ++e) {
        const size_t le = (size_t)(layer * NE + e);
        bf16_t* gu = (bf16_t*)(ws + WS_WGU) + (size_t)e * 4096 * 1024; bf16_t* wd = (bf16_t*)(ws + WS_WD) + (size_t)e * 1024 * 2048;
        tr_job(C, base, (const float*)a.in[19] + le * 1024 * 2048, 2048, 1024, 0, 2048, gu, 1024, MapGU{0});
        tr_job(C, base, (const float*)a.in[20] + le * 1024 * 2048, 2048, 1024, 0, 2048, gu, 1024, MapGU{1});
        tr_job(C, base, (const float*)a.in[21] + le * 2048 * 1024, 1024, 2048, 0, 1024, wd, 2048, MapId{0});
    }
}

__device__ __forceinline__ void row_load(const float* row, int lane, f32x4 (&v)[4]) {
#pragma unroll
    for (int j = 0; j < 4; ++j) v[j] = *(const f32x4*)(row + 256 * j + 4 * lane); }
__device__ __forceinline__ float row_rstd(const f32x4 (&v)[4]) { float s = 0.f;
#pragma unroll
    for (int j = 0; j < 4; ++j) s += (v[j][0] * v[j][0] + v[j][1] * v[j][1]) + (v[j][2] * v[j][2] + v[j][3] * v[j][3]);
    return 1.0f / sqrtf(wave_sum(s) * (1.0f / 1024.0f) + RMS_EPS); }
__device__ __forceinline__ void row_store_bf(bf16_t* row, int lane, const f32x4 (&v)[4]) {
#pragma unroll
    for (int j = 0; j < 4; ++j) { u32x2 w; w.x = cvt_pk_bf16(v[j][0], v[j][1]); w.y = cvt_pk_bf16(v[j][2], v[j][3]); *(u32x2*)(row + 256 * j + 4 * lane) = w; } }

__device__ __forceinline__ void ph_norm(const Ctx& C, const float* src, const float* gain, bf16_t* XN) {
    f32x4 g[4]; row_load(gain, C.lane, g);
    for (int t = C.gw; t < T; t += C.ngw) { f32x4 v[4]; row_load(src + (size_t)t * D, C.lane, v); const float r = row_rstd(v);
#pragma unroll
        for (int j = 0; j < 4; ++j) v[j] = v[j] * r * g[j];
        row_store_bf(XN + (size_t)t * D, C.lane, v); }
}
__device__ __forceinline__ void ph_router(const Ctx& C, const float* Hin, const float* gain, const float* Wr, bf16_t* XN, float* AFF) {
    f32x4* Wl = (f32x4*)C.lds;
    for (int idx = C.tid; idx < 4096; idx += 512) { const int l = idx & 63, e4 = (idx >> 6) & 3, i = (idx >> 8) & 3, j = idx >> 10; Wl[idx] = *(const f32x4*)(Wr + (size_t)(256 * j + 4 * l + i) * 16 + 4 * e4); }
    __syncthreads();
    f32x4 g[4]; row_load(gain, C.lane, g);
    for (int t = C.gw; t < T; t += C.ngw) {
        f32x4 v[4]; row_load(Hin + (size_t)t * D, C.lane, v); const float r = row_rstd(v);
#pragma unroll
        for (int j = 0; j < 4; ++j) v[j] = v[j] * r * g[j];
        row_store_bf(XN + (size_t)t * D, C.lane, v);
        float p[16];
#pragma unroll
        for (int e = 0; e < 16; ++e) p[e] = 0.f;
#pragma unroll
        for (int j = 0; j < 4; ++j)
#pragma unroll
            for (int i = 0; i < 4; ++i) { const float x = v[j][i];
#pragma unroll
                for (int e4 = 0; e4 < 4; ++e4) { const f32x4 w = Wl[((j * 4 + i) * 4 + e4) * 64 + C.lane]; p[4 * e4] += x * w[0]; p[4 * e4 + 1] += x * w[1]; p[4 * e4 + 2] += x * w[2]; p[4 * e4 + 3] += x * w[3]; } }
        float mx = -1e30f;
#pragma unroll
        for (int e = 0; e < 16; ++e) { p[e] = wave_sum(p[e]); mx = fmaxf(mx, p[e]); }
        float s = 0.f;
#pragma unroll
        for (int e = 0; e < 16; ++e) { p[e] = expf(p[e] - mx); s += p[e]; }
        const float inv = 1.0f / s; float mine = 0.f;
#pragma unroll
        for (int e = 0; e < 16; ++e) mine = (C.lane == e) ? p[e] * inv : mine;
        if (C.lane < 16) AFF[(size_t)t * 16 + C.lane] = mine;
    }
    __syncthreads();
}
__device__ __forceinline__ void ph_select(const Ctx& C, const float* AFF, int* SEL, int* IDX) {
    if (C.bid >= NE) return;
    const int e = C.bid; unsigned* vals = (unsigned*)C.lds; unsigned* hist = vals + T; unsigned* sh = hist + 256;
    for (int i = C.tid; i < T; i += 512) vals[i] = __float_as_uint(AFF[(size_t)i * 16 + e]);
    __syncthreads();
    unsigned prefix = 0u, mask = 0u, remaining = CAP;
    for (int pass = 0; pass < 4; ++pass) { const int shift = 24 - 8 * pass;
        if (C.tid < 256) hist[C.tid] = 0u;
        __syncthreads();
        for (int i = C.tid; i < T; i += 512) { const unsigned v = vals[i]; if ((v & mask) == prefix) atomicAdd(&hist[(v >> shift) & 255u], 1u); }
        __syncthreads();
        if (C.tid == 0) { unsigned cum = 0u; int d = 255; for (; d > 0; --d) { const unsigned c = hist[d]; if (cum + c >= remaining) break; cum += c; } sh[0] = (unsigned)d; sh[1] = remaining - cum; }
        __syncthreads();
        prefix |= sh[0] << shift; mask |= 255u << shift; remaining = sh[1];
        __syncthreads();
    }
    const unsigned thr = prefix, ntie = remaining;
    unsigned cg = 0u, ce = 0u;
    for (int i = 0; i < 32; ++i) { const unsigned v = vals[C.tid + 512 * i]; cg += v > thr; ce += v == thr; }
    unsigned sg = cg, se = ce;
#pragma unroll
    for (int o = 1; o < 64; o <<= 1) { const unsigned tg = __shfl_up(sg, o), te = __shfl_up(se, o); if (C.lane >= o) { sg += tg; se += te; } }
    if (C.lane == 63) { sh[16 + C.wave] = sg; sh[32 + C.wave] = se; }
    __syncthreads();
    unsigned og = 0u, oe = 0u, totg = 0u;
    for (int w = 0; w < 8; ++w) { const unsigned a = sh[16 + w], b = sh[32 + w]; if (w < C.wave) { og += a; oe += b; } totg += a; }
    unsigned pg = og + sg - cg, pe = oe + se - ce;
    for (int i = 0; i < 32; ++i) { const int t = C.tid + 512 * i; const unsigned v = vals[t]; int slot = -1;
        if (v > thr) slot = (int)pg++; else if (v == thr) { if (pe < ntie) slot = (int)(totg + pe); ++pe; }
        SEL[(size_t)t * 16 + e] = slot + 1; if (slot >= 0) IDX[e * CAP + slot] = t; }
}
__device__ __forceinline__ void ph_gather(const Ctx& C, const int* IDX, const bf16_t* XN, bf16_t* XS) {
    for (int r = C.gw; r < NE * CAP; r += C.ngw) { const int t = IDX[r]; const u32x4* s = (const u32x4*)(XN + (size_t)t * D); u32x4* d = (u32x4*)(XS + (size_t)r * D);
        const u32x4 a = s[C.lane], b = s[C.lane + 64]; d[C.lane] = a; d[C.lane + 64] = b; }
}
template <int MODE>
__device__ __forceinline__ void ph_combine(const Ctx& C, const float* Hin, const float* AFF, const int* SEL, const bf16_t* Y, float* Hout, const float* gain, bf16_t* XN, float* OUT) {
    f32x4 g[4]; row_load(gain, C.lane, g);
    for (int t = C.gw; t < T; t += C.ngw) {
        f32x4 v[4]; row_load(Hin + (size_t)t * D, C.lane, v);
        const int sel = SEL[(size_t)t * 16 + (C.lane & 15)]; const float af = AFF[(size_t)t * 16 + (C.lane & 15)];
#pragma unroll
        for (int e = 0; e < 16; ++e) { const int s = __builtin_amdgcn_readlane(sel, e);
            if (s) { const float a = __uint_as_float(__builtin_amdgcn_readlane(__float_as_uint(af), e)); const bf16_t* y = Y + ((size_t)e * CAP + (s - 1)) * D + 4 * C.lane;
#pragma unroll
                for (int j = 0; j < 4; ++j) { const u32x2 w = *(const u32x2*)(y + 256 * j); v[j][0] += a * bf_lo(w.x); v[j][1] += a * bf_hi(w.x); v[j][2] += a * bf_lo(w.y); v[j][3] += a * bf_hi(w.y); } } }
        if (MODE == 1) {
#pragma unroll
            for (int j = 0; j < 4; ++j) *(f32x4*)(Hout + (size_t)t * D + 256 * j + 4 * C.lane) = v[j]; }
        const float r = row_rstd(v);
#pragma unroll
        for (int j = 0; j < 4; ++j) v[j] = v[j] * r * g[j];
        if (MODE == 1) row_store_bf(XN + (size_t)t * D, C.lane, v);
        else {
#pragma unroll
            for (int j = 0; j < 4; ++j) *(f32x4*)(OUT + (size_t)t * D + 256 * j + 4 * C.lane) = v[j]; }
    }
}

#define MFMA32(a, b, c) __builtin_amdgcn_mfma_f32_32x32x16_bf16((a), (b), (c), 0, 0, 0)
__device__ __forceinline__ int crow(int r, int hi) { return (r & 3) + 8 * (r >> 2) + 4 * hi; }
__device__ __forceinline__ bf16x8 ldfrag(const bf16_t* p) { return *(const bf16x8*)p; }

__device__ __forceinline__ void ph_gla_prep(const Ctx& C, const bf16_t* Q0, const bf16_t* K0, const float* GF, const float* GB,
                                            bf16_t* QDF, bf16_t* QDB, bf16_t* KDF, bf16_t* KDB, bf16_t* KTF, bf16_t* KTB, float* EGL) {
    const int ch = C.tid;
    for (int c = C.bid; c < GNC; c += C.nb) { const int t0 = c * GC;
        { float G = 0.f;
#pragma unroll 2
          for (int i8 = 0; i8 < 8; ++i8) { unsigned pk[4];
#pragma unroll
            for (int ii = 0; ii < 8; ii += 2) { float kd[2];
#pragma unroll
                for (int u = 0; u < 2; ++u) { const size_t o = (size_t)(t0 + i8 * 8 + ii + u) * 512 + ch; G += GF[o]; const float q = bf2f(Q0[o]), k = bf2f(K0[o]);
                    QDF[o] = f2bf(q * __expf(G)); kd[u] = k * __expf(-G); KDF[o] = f2bf(kd[u]); }
                pk[ii >> 1] = cvt_pk_bf16(kd[0], kd[1]); }
            *(u32x4*)(KTF + (size_t)ch * T + t0 + i8 * 8) = (u32x4){pk[0], pk[1], pk[2], pk[3]}; }
          EGL[(size_t)c * 512 + ch] = __expf(G); }
        { float G = 0.f;
#pragma unroll 2
          for (int i8 = 7; i8 >= 0; --i8) { unsigned pk[4];
#pragma unroll
            for (int ii = 6; ii >= 0; ii -= 2) { float kd[2];
#pragma unroll
                for (int u = 1; u >= 0; --u) { const size_t o = (size_t)(t0 + i8 * 8 + ii + u) * 512 + ch; G += GB[o]; const float q = bf2f(Q0[o]), k = bf2f(K0[o]);
                    QDB[o] = f2bf(q * __expf(G)); kd[u] = k * __expf(-G); KDB[o] = f2bf(kd[u]); }
                pk[ii >> 1] = cvt_pk_bf16(kd[0], kd[1]); }
            *(u32x4*)(KTB + (size_t)ch * T + t0 + i8 * 8) = (u32x4){pk[0], pk[1], pk[2], pk[3]}; }
          EGL[(size_t)(GNC + c) * 512 + ch] = __expf(G); }
    }
}
__device__ __forceinline__ void ph_gla_u(const Ctx& C, const bf16_t* VT, const bf16_t* KTF, const bf16_t* KTB, const float* EGL, bf16_t* U) {
    const int r = C.lane & 31, hh = C.lane >> 5;
    for (int it = C.gw; it < 2 * GH * GNC * 8; it += C.ngw) { const int w = it & 7, unit = it >> 3, c = unit % GNC, h = (unit / GNC) % GH, dir = unit / (GNC * GH); const int t0 = c * GC;
        const bf16_t* KT = dir ? KTB : KTF; const bf16_t* ap = VT + (size_t)(256 * h + 32 * w + r) * T + t0 + 8 * hh;
        bf16x8 a[4];
#pragma unroll
        for (int s = 0; s < 4; ++s) a[s] = ldfrag(ap + 16 * s);
        bf16_t* Ub = U + ((size_t)(dir * GH + h) * GNC + c) * (GDV * GDK);
#pragma unroll
        for (int j = 0; j < 4; ++j) { f32x16 acc = {}; const bf16_t* bp = KT + (size_t)(128 * h + 32 * j + r) * T + t0 + 8 * hh;
#pragma unroll
            for (int s = 0; s < 4; ++s) acc = MFMA32(a[s], ldfrag(bp + 16 * s), acc);
            const float eg = EGL[(size_t)(dir * GNC + c) * 512 + 128 * h + 32 * j + r];
#pragma unroll
            for (int q = 0; q < 16; ++q) Ub[(size_t)(32 * w + crow(q, hh)) * GDK + 32 * j + r] = f2bf(acc[q] * eg); }
    }
}
__device__ __forceinline__ void ph_gla_scan(const Ctx& C, const bf16_t* U, const float* EGL, bf16_t* ST) {
    const int gt = C.bid * 512 + C.tid, ngt = C.nb * 512;
    for (int el = gt; el < 2 * GH * GDV * (GDK / 2); el += ngt) { const int dk2 = el & 63, dv = (el >> 6) & 255, h = (el >> 14) & 3, dir = el >> 16;
        const size_t eb = (size_t)(dir * GH + h) * GNC * (GDV * GDK) + (size_t)dv * GDK + 2 * dk2; const float* eg = EGL + (size_t)dir * GNC * 512 + 128 * h + 2 * dk2;
        float s0 = 0.f, s1 = 0.f;
#pragma unroll 8
        for (int i = 0; i < GNC; ++i) { const int c = dir ? GNC - 1 - i : i; const size_t o = eb + (size_t)c * (GDV * GDK);
            const unsigned u = *(const unsigned*)(U + o); const f32x2 d = *(const f32x2*)(eg + (size_t)c * 512);
            *(unsigned*)(ST + o) = cvt_pk_bf16(s0, s1);
            s0 = d[0] * s0 + bf_lo(u); s1 = d[1] * s1 + bf_hi(u); }
    }
}
__device__ __forceinline__ void ph_gla_out(const Ctx& C, const bf16_t* QDF, const bf16_t* QDB, const bf16_t* KDF, const bf16_t* KDB, const bf16_t* VT, const bf16_t* ST,
                                           const bf16_t* SR, const float* hnorm, bf16_t* OG) {
    constexpr int ACS = 72;
    bf16_t* AC = (bf16_t*)C.lds; float* SSQ = (float*)(C.lds + 64 * ACS * 2);
    const int w = C.wave, r = C.lane & 31, hh = C.lane >> 5;
    for (int unit = C.bid; unit < GH * GNC; unit += C.nb) { const int h = unit / GNC, c = unit % GNC, t0 = c * GC;
        {
            const int dir = w >> 2, ti = (w >> 1) & 1, si = w & 1;
            if (!((dir == 0 && ti == 0 && si == 1) || (dir == 1 && ti == 1 && si == 0))) {
                const bf16_t* qp = (dir ? QDB : QDF) + (size_t)(t0 + 32 * ti + r) * 512 + 128 * h + 8 * hh; const bf16_t* kp = (dir ? KDB : KDF) + (size_t)(t0 + 32 * si + r) * 512 + 128 * h + 8 * hh;
                f32x16 acc = {};
#pragma unroll
                for (int s = 0; s < 8; ++s) acc = MFMA32(ldfrag(qp + 16 * s), ldfrag(kp + 16 * s), acc);
#pragma unroll
                for (int q = 0; q < 16; ++q) { const int tl = 32 * ti + crow(q, hh), sl = 32 * si + r; const bool keep = dir ? (sl > tl) : (sl <= tl); if (keep) AC[tl * ACS + sl] = f2bf(acc[q]); }
            }
        }
        __syncthreads();
        f32x16 o0 = {}, o1 = {};
#pragma unroll
        for (int dir = 0; dir < 2; ++dir) { const bf16_t* qp = (dir ? QDB : QDF) + (size_t)(t0 + r) * 512 + 128 * h + 8 * hh;
            const bf16_t* sp = ST + ((size_t)(dir * GH + h) * GNC + c) * (GDV * GDK) + (size_t)(32 * w + r) * GDK + 8 * hh;
#pragma unroll
            for (int s = 0; s < 8; ++s) { const bf16x8 b = ldfrag(sp + 16 * s); o0 = MFMA32(ldfrag(qp + 16 * s), b, o0); o1 = MFMA32(ldfrag(qp + 32 * 512 + 16 * s), b, o1); } }
        { const bf16_t* vp = VT + (size_t)(256 * h + 32 * w + r) * T + t0 + 8 * hh;
#pragma unroll
            for (int s = 0; s < 4; ++s) { const bf16x8 b = ldfrag(vp + 16 * s); o0 = MFMA32(ldfrag(AC + r * ACS + 16 * s + 8 * hh), b, o0); o1 = MFMA32(ldfrag(AC + (32 + r) * ACS + 16 * s + 8 * hh), b, o1); } }
#pragma unroll
        for (int q = 0; q < 16; ++q) { float a = o0[q] * o0[q], b = o1[q] * o1[q];
#pragma unroll
            for (int of = 1; of < 32; of <<= 1) { a += __shfl_xor(a, of); b += __shfl_xor(b, of); }
            if (r == 0) { SSQ[w * 64 + crow(q, hh)] = a; SSQ[w * 64 + 32 + crow(q, hh)] = b; } }
        __syncthreads();
        const float gn = hnorm[32 * w + r];
#pragma unroll
        for (int q = 0; q < 16; ++q) { const int tl = crow(q, hh); float sa = 0.f, sb = 0.f;
#pragma unroll
            for (int ww = 0; ww < 8; ++ww) { sa += SSQ[ww * 64 + tl]; sb += SSQ[ww * 64 + 32 + tl]; }
            const float ra = 1.0f / sqrtf(sa * (1.0f / 256.0f) + RMS_EPS), rb = 1.0f / sqrtf(sb * (1.0f / 256.0f) + RMS_EPS);
            const size_t oa = (size_t)(t0 + tl) * 1024 + 256 * h + 32 * w + r, ob = oa + 32 * 1024;
            OG[oa] = f2bf(o0[q] * ra * gn * bf2f(SR[oa])); OG[ob] = f2bf(o1[q] * rb * gn * bf2f(SR[ob])); }
        __syncthreads();
    }
}

__device__ __forceinline__ void ph_mla_tok(const Ctx& C, const float* CIN, const int* pos, const float* qn, const float* kvn, const float* invf, bf16_t* CQN, bf16_t* CKVN, float* CS, bf16_t* K) {
    const int l = C.lane;
    f32x4 g0, g1;
    if (l < 32) { g0 = *(const f32x4*)(qn + 8 * l); g1 = *(const f32x4*)(qn + 8 * l + 4); }
    else if (l < 48) { g0 = *(const f32x4*)(kvn + 8 * (l - 32)); g1 = *(const f32x4*)(kvn + 8 * (l - 32) + 4); }
    else { g0 = (f32x4){1.f, 1.f, 1.f, 1.f}; g1 = g0; }
    const float fr = invf[l & 31];
    for (int t = C.gw; t < T; t += C.ngw) {
        const float* row = CIN + (size_t)t * 512; const f32x4 a = *(const f32x4*)(row + 8 * l), b = *(const f32x4*)(row + 8 * l + 4);
        const float ss = (a[0] * a[0] + a[1] * a[1]) + (a[2] * a[2] + a[3] * a[3]) + (b[0] * b[0] + b[1] * b[1]) + (b[2] * b[2] + b[3] * b[3]);
        const float sq = wave_sum(l < 32 ? ss : 0.f), sk = wave_sum((l >= 32 && l < 48) ? ss : 0.f);
        const float rq = 1.0f / sqrtf(sq * (1.0f / 256.0f) + RMS_EPS), rk = 1.0f / sqrtf(sk * (1.0f / 128.0f) + RMS_EPS);
        const float ang = (float)pos[t] * fr; const double rev = (double)ang * 0.15915494309189533577; const float fr01 = (float)(rev - rint(rev));
        const float cv = __builtin_amdgcn_cosf(fr01), sv = __builtin_amdgcn_sinf(fr01);
        if (l < 32) { CS[(size_t)t * 64 + l] = cv; CS[(size_t)t * 64 + 32 + l] = sv; }
        if (l < 32) store8bf(CQN + (size_t)t * 256 + 8 * l, a * rq * g0, b * rq * g1);
        else if (l < 48) store8bf(CKVN + (size_t)t * 256 + 8 * (l - 32), a * rk * g0, b * rk * g1);
        else { const u32x4 z = {0u, 0u, 0u, 0u}; *(u32x4*)(CKVN + (size_t)t * 256 + 128 + 8 * (l - 48)) = z; }
        f32x4 xa = a, xb = b;
        f32x4 pa, pb;
#pragma unroll
        for (int j = 0; j < 4; ++j) { pa[j] = __shfl(xa[j], (l + 4) & 63); pb[j] = __shfl(xb[j], (l + 4) & 63); }
        f32x4 c0, c1, s0, s1;
#pragma unroll
        for (int j = 0; j < 4; ++j) { const int i = 8 * (l & 3) + j; c0[j] = __shfl(cv, i); c1[j] = __shfl(cv, i + 4); s0[j] = __shfl(sv, i); s1[j] = __shfl(sv, i + 4); }
        if (l >= 48 && l < 52) {
            const f32x4 o1a = xa * c0 - pa * s0, o2a = xa * s0 + pa * c0, o1b = xb * c1 - pb * s1, o2b = xb * s1 + pb * c1;
            u32x4 w0, w1; w0.x = cvt_pk_bf16(o1a[0], o1a[1]); w0.y = cvt_pk_bf16(o1a[2], o1a[3]); w0.z = cvt_pk_bf16(o2a[0], o2a[1]); w0.w = cvt_pk_bf16(o2a[2], o2a[3]);
            w1.x = cvt_pk_bf16(o1b[0], o1b[1]); w1.y = cvt_pk_bf16(o1b[2], o1b[3]); w1.z = cvt_pk_bf16(o2b[0], o2b[1]); w1.w = cvt_pk_bf16(o2b[2], o2b[3]);
#pragma unroll
            for (int h = 0; h < MH; ++h) { bf16_t* kp = K + ((size_t)h * T + t) * MDK + 128 + 16 * (l & 3); *(u32x4*)kp = w0; *(u32x4*)(kp + 8) = w1; }
        }
    }
}

namespace att {
constexpr int NW = 8, QBLK = 32, KVBLK = 64;
#ifndef ATT_SDEPTH
#define ATT_SDEPTH 1
#endif
constexpr int SDEPTH = ATT_SDEPTH;
constexpr float THR2 = 11.5f;
constexpr int SHM_V = KVBLK * MDV * 2, SHM_K = KVBLK * 400, SHM_ATTN = 2 * SHM_V + 2 * SHM_K + NW * 64 * 4;
#define KSWZ(row, colB) ((row) * 400 + (colB))
#define SBAR() __builtin_amdgcn_sched_barrier(0)
__device__ __forceinline__ unsigned cvtpk(float lo, float hi) { unsigned r; asm volatile("v_cvt_pk_bf16_f32 %0, %1, %2" : "=v"(r) : "v"(lo), "v"(hi)); return r; }
__device__ __forceinline__ void partialSM(f32x16& p0, f32x16& p1, float& m_reg, float& mn, float& alpha) {
  float pmax = p0[0];
#pragma unroll
  for (int r = 1; r < 16; ++r) pmax = fmaxf(pmax, p0[r]);
#pragma unroll
  for (int r = 0; r < 16; ++r) pmax = fmaxf(pmax, p1[r]);
  { auto rr = __builtin_amdgcn_permlane32_swap(__float_as_uint(pmax), __float_as_uint(pmax), false, false);
    pmax = fmaxf(__uint_as_float(rr[0]), __uint_as_float(rr[1])); }
  if (__builtin_expect(__all(pmax - m_reg <= THR2), 1)) { mn = m_reg; alpha = 1.f; }
  else { mn = fmaxf(m_reg, pmax); alpha = __builtin_amdgcn_exp2f(m_reg - mn); m_reg = mn; }
#pragma unroll
  for (int r = 0; r < 16; ++r) p0[r] = p0[r] - mn;
#pragma unroll
  for (int r = 0; r < 16; ++r) p1[r] = p1[r] - mn;
#pragma unroll
  for (int r = 0; r < 16; ++r) p0[r] = __builtin_amdgcn_exp2f(p0[r]);
}
__device__ __forceinline__ void finishSM(f32x16& p0, f32x16& p1, float alpha, float& l_reg, bf16x8& pa0, bf16x8& pa1, bf16x8& pa2, bf16x8& pa3) {
#pragma unroll
  for (int r = 0; r < 16; ++r) p1[r] = __builtin_amdgcn_exp2f(p1[r]);
  float ps = 0;
#pragma unroll
  for (int r = 0; r < 16; ++r) ps += p0[r];
#pragma unroll
  for (int r = 0; r < 16; ++r) ps += p1[r];
  { auto rr = __builtin_amdgcn_permlane32_swap(__float_as_uint(ps), __float_as_uint(ps), false, false);
    ps = __uint_as_float(rr[0]) + __uint_as_float(rr[1]); }
  l_reg = l_reg * alpha + ps;
#define PK4(P, BASE, OUT) do { unsigned a0 = cvtpk(P[BASE + 0], P[BASE + 1]), a1 = cvtpk(P[BASE + 2], P[BASE + 3]);   \
    unsigned b0 = cvtpk(P[BASE + 4], P[BASE + 5]), b1 = cvtpk(P[BASE + 6], P[BASE + 7]);                              \
    auto r0 = __builtin_amdgcn_permlane32_swap(a0, b0, false, false); auto r1 = __builtin_amdgcn_permlane32_swap(a1, b1, false, false); \
    u32x4 w = {r0[0], r1[0], r0[1], r1[1]}; OUT = *reinterpret_cast<bf16x8*>(&w); } while (0)
  PK4(p0, 0, pa0); PK4(p0, 8, pa1); PK4(p1, 0, pa2); PK4(p1, 8, pa3);
#undef PK4
}
__device__ __forceinline__ void qkt(f32x16& p0, f32x16& p1, const char* Ks, const bf16x8* qr, int r32, int hi) {
  p0 = f32x16{}; p1 = f32x16{};
#pragma unroll
  for (int d0 = 0; d0 < 12; ++d0) { const int cb = (d0 * 16 + hi * 8) * 2;
    const bf16x8 b0 = *reinterpret_cast<const bf16x8*>(Ks + KSWZ(r32, cb));
    const bf16x8 b1 = *reinterpret_cast<const bf16x8*>(Ks + KSWZ(32 + r32, cb));
    p0 = __builtin_amdgcn_mfma_f32_32x32x16_bf16(b0, qr[d0], p0, 0, 0, 0);
    p1 = __builtin_amdgcn_mfma_f32_32x32x16_bf16(b1, qr[d0], p1, 0, 0, 0); }
}
__device__ __forceinline__ int v_st(int k, int c) { const int kk = (k & ~0xC) | ((k & 4) << 1) | ((k & 8) >> 1); return ((kk >> 3) * 4 + (c >> 5)) * 512 + ((kk & 7) * 32 + (c & 31)) * 2; }
__device__ __forceinline__ int v_rd_base(int lane) { return ((lane & 3) << 3) | (((lane >> 2) & 3) << 6) | (((lane >> 4) & 1) << 5) | (((lane >> 5) & 1) << 8); }
constexpr int v_rd_off(int d0, int ks, int half) { return d0 * 512 + ks * 4096 + half * 2048; }
template <int OFF> __device__ __forceinline__ s16x4 tr_read(int vb) {
  s16x4 r; asm volatile("ds_read_b64_tr_b16 %0, %1 offset:%2" : "=&v"(r) : "v"(vb), "i"(OFF) : "memory"); return r;
}
template <int D0> __device__ __forceinline__ void pv_one(f32x16& od, int vb, bf16x8 pa0, bf16x8 pa1, bf16x8 pa2, bf16x8 pa3) {
#define PK(L, H) (bf16x8){L[0], L[1], L[2], L[3], H[0], H[1], H[2], H[3]}
  { const s16x4 l0 = tr_read<v_rd_off(D0, 0, 0)>(vb), h0 = tr_read<v_rd_off(D0, 0, 1)>(vb), l1 = tr_read<v_rd_off(D0, 1, 0)>(vb), h1 = tr_read<v_rd_off(D0, 1, 1)>(vb);
    asm volatile("s_waitcnt lgkmcnt(0)" ::: "memory"); SBAR();
    od = __builtin_amdgcn_mfma_f32_32x32x16_bf16(pa0, PK(l0, h0), od, 0, 0, 0);
    od = __builtin_amdgcn_mfma_f32_32x32x16_bf16(pa1, PK(l1, h1), od, 0, 0, 0); }
  { const s16x4 l2 = tr_read<v_rd_off(D0, 2, 0)>(vb), h2 = tr_read<v_rd_off(D0, 2, 1)>(vb), l3 = tr_read<v_rd_off(D0, 3, 0)>(vb), h3 = tr_read<v_rd_off(D0, 3, 1)>(vb);
    asm volatile("s_waitcnt lgkmcnt(0)" ::: "memory"); SBAR();
    od = __builtin_amdgcn_mfma_f32_32x32x16_bf16(pa2, PK(l2, h2), od, 0, 0, 0);
    od = __builtin_amdgcn_mfma_f32_32x32x16_bf16(pa3, PK(l3, h3), od, 0, 0, 0); }
#undef PK
}
__device__ __forceinline__ void pv_d0(f32x16* o, int vb, bf16x8 pa0, bf16x8 pa1, bf16x8 pa2, bf16x8 pa3) {
  pv_one<0>(o[0], vb, pa0, pa1, pa2, pa3); pv_one<1>(o[1], vb, pa0, pa1, pa2, pa3); pv_one<2>(o[2], vb, pa0, pa1, pa2, pa3); pv_one<3>(o[3], vb, pa0, pa1, pa2, pa3);
}
__device__ __forceinline__ void attn_body(const bf16_t* __restrict__ Qb, const bf16_t* __restrict__ Kh, const bf16_t* __restrict__ Vh, bf16_t* __restrict__ Ob, int ldo, int seq, char* lds) {
  const int tid = threadIdx.x, wid = tid >> 6, lane = tid & 63, r32 = lane & 31, hi = lane >> 5;
  char* V_lds = lds; char* K_lds = lds + 2 * SHM_V;
  float* ws = (float*)(lds + 2 * SHM_V + 2 * SHM_K) + wid * 64; float* li_l = ws; float* al_l = ws + 32;
  float m_reg = -1e30f, l_reg = 0; f32x16 o[4] = {}; bf16x8 qr[12];
  const bf16_t* Qw = Qb + (size_t)(wid * QBLK + r32) * MDK + hi * 8;
#pragma unroll
  for (int d0 = 0; d0 < 12; ++d0) qr[d0] = *reinterpret_cast<const bf16x8*>(Qw + d0 * 16);
  const int sr = tid >> 4, sc = (tid & 15) * 8, vst0 = v_st(sr, sc), vst1 = v_st(32 + sr, sc);
  int kst[3];
#pragma unroll
  for (int i = 0; i < 3; ++i) { const int ck = tid + 512 * i, row = ck / 24, cc = ck - row * 24; kst[i] = KSWZ(row, cc * 16); }
  const int vb0 = (int)(uintptr_t)V_lds + v_rd_base(lane);
  const unsigned vo0 = (unsigned)(sr * MDV + sc), ko0 = (unsigned)(tid * 8);
  struct { bf16x8 vs0, vs1, ks0, ks1, ks2; } sr_[SDEPTH];
#define SLOAD(i, k0) do { const bf16_t* vt_ = Vh + (size_t)(k0) * MDV; const bf16_t* kt_ = Kh + (size_t)(k0) * MDK;                                         \
    sr_[i].vs0 = *reinterpret_cast<const bf16x8*>(vt_ + vo0); sr_[i].vs1 = *reinterpret_cast<const bf16x8*>(vt_ + 32 * MDV + vo0);                               \
    sr_[i].ks0 = *reinterpret_cast<const bf16x8*>(kt_ + ko0); sr_[i].ks1 = *reinterpret_cast<const bf16x8*>(kt_ + 4096 + ko0); sr_[i].ks2 = *reinterpret_cast<const bf16x8*>(kt_ + 8192 + ko0); } while (0)
#define SWRITE(b, i) do { *(bf16x8*)(V_lds + (b) * SHM_V + vst0) = sr_[i].vs0; *(bf16x8*)(V_lds + (b) * SHM_V + vst1) = sr_[i].vs1;               \
    *(bf16x8*)(K_lds + (b) * SHM_K + kst[0]) = sr_[i].ks0; *(bf16x8*)(K_lds + (b) * SHM_K + kst[1]) = sr_[i].ks1; *(bf16x8*)(K_lds + (b) * SHM_K + kst[2]) = sr_[i].ks2; } while (0)
#define SWAIT() do { if constexpr (SDEPTH == 2) asm volatile("s_waitcnt vmcnt(5)" ::: "memory"); else asm volatile("s_waitcnt vmcnt(0)" ::: "memory"); } while (0)
#define RESC(a) do { if (__any((a) < 1.f)) { if (hi == 0) al_l[r32] = (a); asm volatile("s_waitcnt lgkmcnt(0)" ::: "memory"); \
    _Pragma("unroll") for (int d = 0; d < 4; ++d) _Pragma("unroll") for (int r = 0; r < 16; ++r) o[d][r] *= al_l[crow(r, hi)]; } } while (0)
  f32x16 pA0, pA1, pB0, pB1; float mnA, mnB, alA, alB; bf16x8 pa0, pa1, pa2, pa3; const int NT = seq / KVBLK;
  constexpr int SE = 0, SO = SDEPTH - 1;
  SLOAD(SE, 0); asm volatile("s_waitcnt vmcnt(0)" ::: "memory"); SWRITE(0, SE); __syncthreads();
  qkt(pA0, pA1, K_lds, qr, r32, hi); partialSM(pA0, pA1, m_reg, mnA, alA);
  SLOAD(SO, KVBLK); if constexpr (SDEPTH == 2) { if (2 < NT) SLOAD(SE, 2 * KVBLK); }
  SWAIT(); SWRITE(1, SO); __syncthreads();
  for (int j = 1; j + 1 < NT; j += 2) {
    SBAR(); qkt(pB0, pB1, K_lds + SHM_K, qr, r32, hi);
    finishSM(pA0, pA1, alA, l_reg, pa0, pa1, pa2, pa3); SBAR();
    SLOAD(SO, (j + SDEPTH) * KVBLK); SBAR();
    pv_d0(o, vb0, pa0, pa1, pa2, pa3); partialSM(pB0, pB1, m_reg, mnB, alB);
    __syncthreads(); SWAIT(); SWRITE(0, SE);
    RESC(alB); __syncthreads();
    SBAR(); qkt(pA0, pA1, K_lds, qr, r32, hi);
    finishSM(pB0, pB1, alB, l_reg, pa0, pa1, pa2, pa3); SBAR();
    if (SDEPTH == 1 || j + 3 < NT) SLOAD(SE, (j + 1 + SDEPTH) * KVBLK); SBAR();
    pv_d0(o, vb0 + SHM_V, pa0, pa1, pa2, pa3); partialSM(pA0, pA1, m_reg, mnA, alA);
    __syncthreads(); SWAIT(); SWRITE(1, SO);
    RESC(alA); __syncthreads();
  }
  SBAR(); qkt(pB0, pB1, K_lds + SHM_K, qr, r32, hi);
  finishSM(pA0, pA1, alA, l_reg, pa0, pa1, pa2, pa3); SBAR();
  pv_d0(o, vb0, pa0, pa1, pa2, pa3); partialSM(pB0, pB1, m_reg, mnB, alB);
  __syncthreads(); RESC(alB);
  finishSM(pB0, pB1, alB, l_reg, pa0, pa1, pa2, pa3); SBAR();
  pv_d0(o, vb0 + SHM_V, pa0, pa1, pa2, pa3);
  if (hi == 0) li_l[r32] = l_reg; asm volatile("s_waitcnt lgkmcnt(0)" ::: "memory");
  float rli[16];
#pragma unroll
  for (int r = 0; r < 16; ++r) rli[r] = __builtin_amdgcn_rcpf(li_l[crow(r, hi)]);
  bf16_t* Ow = Ob + (size_t)(wid * QBLK) * ldo;
#pragma unroll
  for (int r = 0; r < 16; ++r) { const int orow = crow(r, hi);
#pragma unroll
    for (int d0 = 0; d0 < 4; ++d0) Ow[(size_t)orow * ldo + d0 * 32 + r32] = f2bf(o[d0][r] * rli[r]); }
#undef SLOAD
#undef SWRITE
#undef SWAIT
#undef RESC
}
}


#ifdef DBG
constexpr size_t WS_DBG = 256 * 1024;
__device__ __forceinline__ unsigned hash32(unsigned x) { x ^= x >> 16; x *= 0x7feb352dU; x ^= x >> 15; x *= 0x846ca68bU; x ^= x >> 16; return x; }
__device__ __forceinline__ void dbg_acc(float* acc, int slot, float got, float ref) { const float d = got - ref; atomicAdd(acc + 2 * slot, d * d); atomicAdd(acc + 2 * slot + 1, ref * ref); }
__device__ __forceinline__ float dotA(const bf16_t* a, const float* W, int K, int ldw, int n) { float s = 0.f; for (int k = 0; k < K; ++k) s += bf2f(a[k]) * W[(size_t)k * ldw + n]; return s; }
__device__ __forceinline__ void chk_p1(const Ctx& C, const Args& a, unsigned char* ws, float* acc) {
    const int gt = C.bid * 512 + C.tid; if (gt >= 6144) return;
    const unsigned hs = hash32(gt * 7919u + 13u); const int t = hs % T, kind = gt % 6; const unsigned c0 = hs >> 14;
    const bf16_t* xn = (const bf16_t*)(ws + WS_XN) + (size_t)t * 1024; const float* w_in = (const float*)a.in[5];
    if (kind == 0) { const int c = c0 % 512; dbg_acc(acc, 0, bf2f(((const bf16_t*)(ws + AR_Q0))[(size_t)t * 512 + c]), dotA(xn, w_in, 1024, 3104, c) * 0.08838834764831845f); }
    else if (kind == 1) { const int c = c0 % 512; dbg_acc(acc, 0, bf2f(((const bf16_t*)(ws + AR_K0))[(size_t)t * 512 + c]), dotA(xn, w_in, 1024, 3104, 512 + c)); }
    else if (kind == 2) { const int c = c0 % 1024; dbg_acc(acc, 0, bf2f(((const bf16_t*)(ws + AR_VT))[(size_t)c * T + t]), dotA(xn, w_in, 1024, 3104, 1024 + c)); }
    else if (kind == 3) { const int c = c0 % 1024; dbg_acc(acc, 0, bf2f(((const bf16_t*)(ws + AR_SR))[(size_t)t * 1024 + c]), siluf(dotA(xn, w_in, 1024, 3104, 2048 + c))); }
    else { const int dir = kind - 4, c = c0 % 512; const float* wg = (const float*)a.in[dir ? 8 : 6]; const float* bg = (const float*)a.in[dir ? 9 : 7]; float lg = bg[c];
        for (int j = 0; j < 16; ++j) lg += dotA(xn, w_in, 1024, 3104, 3072 + 16 * dir + j) * wg[j * 512 + c];
        dbg_acc(acc, 1, ((const float*)(ws + (dir ? AR_GB : AR_GF)))[(size_t)t * 512 + c], logsigf(lg) * 0.0625f); }
}
__device__ __forceinline__ void chk_gla(const Ctx& C, const Args& a, unsigned char* ws, float* acc) {
    if (C.bid >= 64) return;
    float* A = (float*)C.lds; float* O = A + 4096; float* red = O + 512;
    const unsigned hs = hash32(C.bid * 977u + 5u); const int t = hs % T, h = (hs >> 14) & 3;
    const bf16_t* Q0 = (const bf16_t*)(ws + AR_Q0); const bf16_t* K0 = (const bf16_t*)(ws + AR_K0); const float* GF = (const float*)(ws + AR_GF); const float* GB = (const float*)(ws + AR_GB);
    const bf16_t* VT = (const bf16_t*)(ws + AR_VT); const bf16_t* SR = (const bf16_t*)(ws + AR_SR); const bf16_t* OG = (const bf16_t*)(ws + WS_XN);
    for (int i = C.tid; i < 4096; i += 512) A[i] = 0.f;
    __syncthreads();
    const int dir = C.tid >> 8, sub = C.tid & 255;
    if (sub < 128) { const int k = sub, ch = 128 * h + k; const float q = bf2f(Q0[(size_t)t * 512 + ch]); float Dk = dir ? __expf(GB[(size_t)t * 512 + ch]) : 1.f;
        for (int i = 0; i < 2048; ++i) { const int s = dir ? t + 1 + i : t - i; const bool valid = s >= 0 && s < T; float w = 0.f;
            if (valid) { w = q * Dk * bf2f(K0[(size_t)s * 512 + ch]); Dk *= __expf((dir ? GB : GF)[(size_t)s * 512 + ch]); }
            w = wave_sum(w); if (C.lane == 0) atomicAdd(&A[dir * 2048 + i], w); } }
    __syncthreads();
    { float o = 0.f; for (int i = 0; i < 2048; ++i) { const int s = dir ? t + 1 + i : t - i; if (s >= 0 && s < T) o += A[dir * 2048 + i] * bf2f(VT[(size_t)(256 * h + sub) * T + s]); } O[dir * 256 + sub] = o; }
    __syncthreads();
    if (C.tid < 256) { const float o = O[C.tid] + O[256 + C.tid]; float ss = wave_sum(o * o); if (C.lane == 0) red[C.wave] = ss; }
    __syncthreads();
    if (C.tid < 256) { const float o = O[C.tid] + O[256 + C.tid]; const float ss = red[0] + red[1] + red[2] + red[3]; const float r = 1.0f / sqrtf(ss * (1.0f / 256.0f) + RMS_EPS);
        const size_t oi = (size_t)t * 1024 + 256 * h + C.tid; dbg_acc(acc, 2, bf2f(OG[oi]), o * r * ((const float*)a.in[10])[C.tid] * bf2f(SR[oi])); }
    __syncthreads();
}
__device__ __forceinline__ void chk_resid(const Ctx& C, const float* base, const bf16_t* A, int K, const float* W, const float* HAp, float* acc, int slot) {
    const int gt = C.bid * 512 + C.tid; if (gt >= 4096) return;
    const unsigned hs = hash32(gt * 31u + slot); const int t = hs % T, n = (hs >> 14) % 1024;
    dbg_acc(acc, slot, HAp[(size_t)t * 1024 + n], base[(size_t)t * 1024 + n] + dotA(A + (size_t)t * K, W, K, 1024, n));
}
__device__ __forceinline__ void chk_router(const Ctx& C, const float* Hin, const float* gain, const float* Wr, const bf16_t* XN, const float* AFF, float* acc, int slot) {
    const int gt = C.bid * 512 + C.tid; if (gt >= 512) return;
    const int t = hash32(gt * 101u + 7u) % T; const float* hr = Hin + (size_t)t * 1024; float ss = 0.f; for (int k = 0; k < 1024; ++k) ss += hr[k] * hr[k];
    const float r = 1.0f / sqrtf(ss / 1024.0f + RMS_EPS); float lg[16]; for (int e = 0; e < 16; ++e) lg[e] = 0.f;
    for (int k = 0; k < 1024; ++k) { const float xv = hr[k] * r * gain[k]; for (int e = 0; e < 16; ++e) lg[e] += xv * Wr[k * 16 + e]; if ((k & 63) == (gt & 63)) dbg_acc(acc, slot, bf2f(XN[(size_t)t * 1024 + k]), xv); }
    float mx = lg[0]; for (int e = 1; e < 16; ++e) mx = fmaxf(mx, lg[e]); float s = 0.f; for (int e = 0; e < 16; ++e) { lg[e] = expf(lg[e] - mx); s += lg[e]; }
    for (int e = 0; e < 16; ++e) dbg_acc(acc, slot, AFF[(size_t)t * 16 + e], lg[e] / s);
}
__device__ __forceinline__ void chk_select(const Ctx& C, const float* AFF, const int* SEL, const int* IDX, unsigned* dw) {
    const int gt = C.bid * 512 + C.tid;
    for (int p = gt; p < T * 16; p += C.nb * 512) { const int t = p >> 4, e = p & 15; const int s = SEL[p]; const unsigned b = __float_as_uint(AFF[p]);
        if (s > 0) { atomicAdd(&dw[e], 1u); atomicMax(&dw[16 + e], ~b); if (s > CAP || IDX[e * CAP + s - 1] != t) atomicAdd(&dw[48], 1u); } else { atomicMax(&dw[32 + e], b); if (s < 0) atomicAdd(&dw[48], 1u); } }
}
__device__ __forceinline__ void chk_moe_h(const Ctx& C, const Args& a, unsigned char* ws, int layer, float* acc, int slot) {
    const int gt = C.bid * 512 + C.tid; if (gt >= 2048) return;
    const unsigned hs = hash32(gt * 53u + 3u); const int e = hs & 15, sl = (hs >> 4) % CAP, f = (hs >> 15) % FF; const int t = ((const int*)(ws + WS_IDX))[e * CAP + sl];
    if (t < 0 || t >= T) { dbg_acc(acc, slot, 1e3f, 0.f); return; }
    const bf16_t* xn = (const bf16_t*)(ws + WS_XN) + (size_t)t * 1024; const size_t wo = (size_t)(layer * NE + e) * 1024 * 2048;
    const float g = dotA(xn, (const float*)a.in[19] + wo, 1024, 2048, f), u = dotA(xn, (const float*)a.in[20] + wo, 1024, 2048, f);
    dbg_acc(acc, slot, bf2f(((const bf16_t*)(ws + AR_H))[((size_t)e * CAP + sl) * FF + f]), siluf(g) * u);
    dbg_acc(acc, slot, bf2f(((const bf16_t*)(ws + AR_XS))[((size_t)e * CAP + sl) * 1024 + (f & 1023)]), bf2f(xn[f & 1023]));
}
__device__ __forceinline__ void chk_moe_y(const Ctx& C, const Args& a, unsigned char* ws, int layer, float* acc, int slot) {
    const int gt = C.bid * 512 + C.tid; if (gt >= 2048) return;
    const unsigned hs = hash32(gt * 59u + 11u); const int e = hs & 15, sl = (hs >> 4) % CAP, n = (hs >> 15) % 1024;
    const float ref = dotA((const bf16_t*)(ws + AR_H) + ((size_t)e * CAP + sl) * FF, (const float*)a.in[21] + (size_t)(layer * NE + e) * 2048 * 1024, 2048, 1024, n);
    dbg_acc(acc, slot, bf2f(((const bf16_t*)(ws + AR_Y))[((size_t)e * CAP + sl) * 1024 + n]), ref);
}
__device__ __forceinline__ void chk_combine(const Ctx& C, unsigned char* ws, const float* Hin, const float* Hout, float* acc, int slot) {
    const int gt = C.bid * 512 + C.tid; if (gt >= 4096) return;
    const unsigned hs = hash32(gt * 67u + 1u); const int t = hs % T, n = (hs >> 14) % 1024; float ref = Hin[(size_t)t * 1024 + n];
    for (int e = 0; e < 16; ++e) { const int s = ((const int*)(ws + WS_SEL))[t * 16 + e]; if (s > 0) ref += ((const float*)(ws + WS_AFF))[t * 16 + e] * bf2f(((const bf16_t*)(ws + AR_Y))[((size_t)e * CAP + s - 1) * 1024 + n]); }
    dbg_acc(acc, slot, Hout[(size_t)t * 1024 + n], ref);
}
__device__ __forceinline__ void chk_cin(const Ctx& C, const Args& a, unsigned char* ws, float* acc) {
    const int gt = C.bid * 512 + C.tid; if (gt >= 4096) return;
    const unsigned hs = hash32(gt * 71u + 9u); const int t = hs % T, n = (hs >> 14) % 448;
    dbg_acc(acc, 10, ((const float*)(ws + AR_CIN))[(size_t)t * 512 + n], dotA((const bf16_t*)(ws + WS_XN) + (size_t)t * 1024, (const float*)a.in[12], 1024, 448, n));
}
__device__ __forceinline__ void chk_tok(const Ctx& C, const Args& a, unsigned char* ws, float* acc) {
    const int gt = C.bid * 512 + C.tid; if (gt >= 1024) return;
    const unsigned hs = hash32(gt * 73u + 19u); const int t = hs % T, h = (hs >> 14) & 15; const float* row = (const float*)(ws + AR_CIN) + (size_t)t * 512;
    float sq = 0.f, sk = 0.f; for (int i = 0; i < 256; ++i) sq += row[i] * row[i]; for (int i = 0; i < 128; ++i) sk += row[256 + i] * row[256 + i];
    const float rq = 1.0f / sqrtf(sq / 256.0f + RMS_EPS), rk = 1.0f / sqrtf(sk / 128.0f + RMS_EPS);
    const int i = (hs >> 18) % 256; dbg_acc(acc, 11, bf2f(((const bf16_t*)(ws + AR_CQN))[(size_t)t * 256 + i]), row[i] * rq * ((const float*)a.in[13])[i]);
    const int j = i & 127; dbg_acc(acc, 11, bf2f(((const bf16_t*)(ws + AR_CKVN))[(size_t)t * 256 + j]), row[256 + j] * rk * ((const float*)a.in[15])[j]);
    dbg_acc(acc, 11, 1.f + bf2f(((const bf16_t*)(ws + AR_CKVN))[(size_t)t * 256 + 128 + j]), 1.f);
    const int f = i & 31; const float ang = (float)((const int*)a.in[1])[t] * a.invf[f]; double xr = (double)ang * 0.15915494309189533577; xr = (xr - rint(xr)) * 6.283185307179586477; double cd = 1.0, sd = xr, tc = 1.0, ts = xr; for (int n = 1; n < 16; ++n) { tc *= -xr * xr / ((2.0 * n - 1.0) * (2.0 * n)); ts *= -xr * xr / ((2.0 * n) * (2.0 * n + 1.0)); cd += tc; sd += ts; } const float cr = (float)cd, sr = (float)sd;
    dbg_acc(acc, 11, ((const float*)(ws + WS_CS))[(size_t)t * 64 + f], cr); dbg_acc(acc, 11, ((const float*)(ws + WS_CS))[(size_t)t * 64 + 32 + f], sr);
    const float x1 = row[384 + f], x2 = row[416 + f]; const bf16_t* kp = (const bf16_t*)(ws + AR_K) + ((size_t)h * T + t) * MDK + 128 + 8 * (f >> 2) + (f & 3);
    dbg_acc(acc, 11, bf2f(kp[0]), x1 * cr - x2 * sr); dbg_acc(acc, 11, bf2f(kp[4]), x1 * sr + x2 * cr);
}
__device__ __forceinline__ void chk_qkv(const Ctx& C, const Args& a, unsigned char* ws, float* acc) {
    const int gt = C.bid * 512 + C.tid; if (gt >= 4096) return;
    const unsigned hs = hash32(gt * 79u + 29u); const int t = hs % T, h = (hs >> 14) & 15, j = (hs >> 18) & 127, kind = gt & 3; const float QS = 0.07216878364870322f * 1.4426950408889634f;
    const bf16_t* cq = (const bf16_t*)(ws + AR_CQN) + (size_t)t * 256; const bf16_t* ck = (const bf16_t*)(ws + AR_CKVN) + (size_t)t * 256;
    const bf16_t* Q = (const bf16_t*)(ws + AR_Q) + ((size_t)h * T + t) * MDK; const bf16_t* K = (const bf16_t*)(ws + AR_K) + ((size_t)h * T + t) * MDK; const bf16_t* V = (const bf16_t*)(ws + AR_V) + ((size_t)h * T + t) * MDV;
    if (kind == 0) dbg_acc(acc, 12, bf2f(Q[j]), dotA(cq, (const float*)a.in[14], 256, 3072, 192 * h + j) * QS);
    else if (kind == 1) { const int f = j & 31; const float x1 = dotA(cq, (const float*)a.in[14], 256, 3072, 192 * h + 128 + f), x2 = dotA(cq, (const float*)a.in[14], 256, 3072, 192 * h + 160 + f);
        const float cr = ((const float*)(ws + WS_CS))[(size_t)t * 64 + f], sr = ((const float*)(ws + WS_CS))[(size_t)t * 64 + 32 + f]; const bf16_t* qp = Q + 128 + 8 * (f >> 2) + (f & 3);
        dbg_acc(acc, 12, bf2f(qp[0]), (x1 * cr - x2 * sr) * QS); dbg_acc(acc, 12, bf2f(qp[4]), (x1 * sr + x2 * cr) * QS); }
    else if (kind == 2) dbg_acc(acc, 12, bf2f(K[j]), dotA(ck, (const float*)a.in[16], 128, 4096, 256 * h + j));
    else dbg_acc(acc, 12, bf2f(V[j]), dotA(ck, (const float*)a.in[16], 128, 4096, 256 * h + 128 + j));
}
__device__ __forceinline__ void chk_attn(const Ctx& C, unsigned char* ws, float* acc) {
    if (C.bid >= 64) return;
    float* P = (float*)C.lds; float* red = P + T; float* qs = red + 32;
    const unsigned hs = hash32(C.bid * 991u + 77u); const int t = hs % T, h = (hs >> 14) & 15;
    const bf16_t* Q = (const bf16_t*)(ws + AR_Q) + ((size_t)h * T + t) * MDK; const bf16_t* K = (const bf16_t*)(ws + AR_K) + (size_t)h * T * MDK; const bf16_t* V = (const bf16_t*)(ws + AR_V) + (size_t)h * T * MDV;
    if (C.tid < MDK) qs[C.tid] = bf2f(Q[C.tid]);
    __syncthreads();
    float mx = -1e30f;
    for (int j = C.tid; j < T; j += 512) { float s = 0.f; for (int d = 0; d < MDK; ++d) s += qs[d] * bf2f(K[(size_t)j * MDK + d]); P[j] = s; mx = fmaxf(mx, s); }
    mx = wave_max(mx); if (C.lane == 0) red[C.wave] = mx;
    __syncthreads();
    mx = red[0]; for (int w = 1; w < 8; ++w) mx = fmaxf(mx, red[w]);
    float sm = 0.f; for (int j = C.tid; j < T; j += 512) { const float p = exp2f(P[j] - mx); P[j] = p; sm += p; }
    sm = wave_sum(sm);
    __syncthreads();
    if (C.lane == 0) red[8 + C.wave] = sm;
    __syncthreads();
    sm = 0.f; for (int w = 0; w < 8; ++w) sm += red[8 + w];
    if (C.tid < MDV) { float o = 0.f; for (int j = 0; j < T; ++j) o += P[j] * bf2f(V[(size_t)j * MDV + C.tid]); dbg_acc(acc, 13, bf2f(((const bf16_t*)(ws + AR_O))[(size_t)t * 2048 + 128 * h + C.tid]) * 100.f, o / sm * 100.f); }
    __syncthreads();
}
__device__ __forceinline__ void dbg_report(const Ctx& C, unsigned char* ws, float* out, int lo, int hi) {
    const float* acc = (const float*)(ws + WS_DBG); const unsigned* dw = (const unsigned*)(ws + WS_DBG + 1024);
    int code = 90;
    for (int s = lo; s < hi && code == 90; ++s) { float num = __hip_atomic_load(acc + 2 * s, __ATOMIC_RELAXED, __HIP_MEMORY_SCOPE_AGENT), den = __hip_atomic_load(acc + 2 * s + 1, __ATOMIC_RELAXED, __HIP_MEMORY_SCOPE_AGENT);
        if (s == 5) { unsigned viol = __hip_atomic_load(dw + 48, __ATOMIC_RELAXED, __HIP_MEMORY_SCOPE_AGENT); for (int e = 0; e < 16; ++e) { const unsigned cnt = __hip_atomic_load(dw + e, __ATOMIC_RELAXED, __HIP_MEMORY_SCOPE_AGENT), mn = ~__hip_atomic_load(dw + 16 + e, __ATOMIC_RELAXED, __HIP_MEMORY_SCOPE_AGENT), mxu = __hip_atomic_load(dw + 32 + e, __ATOMIC_RELAXED, __HIP_MEMORY_SCOPE_AGENT); if (cnt != CAP) viol += 1000; if (mn < mxu) viol += 1; }
            num = (float)viol; den = 1.f; if (viol == 0) continue; code = 10 * (s - lo) + (viol >= 1000 ? 0 : (viol >= 100 ? 1 : (viol >= 10 ? 2 : 3))); break; }
        if (den == 0.f && num == 0.f) continue;
        const float e = sqrtf(num / den);
        if (!(e < 0.03f)) { const int b = !(e < 1.f) ? 0 : (e >= 0.3f ? 1 : (e >= 0.1f ? 2 : 3)); code = 10 * (s - lo) + b; } }
    if (code == 90) { float worst = 0.f; for (int s = lo; s < hi; ++s) { if (s == 5) continue; const float num = acc[2 * s], den = acc[2 * s + 1]; if (den > 0.f) worst = fmaxf(worst, sqrtf(num / den)); }
        code = 90 + (worst >= 0.01f ? 1 : (worst >= 0.003f ? 2 : 3)); }
    const float c = sqrtf((float)code);
    for (size_t i = (size_t)C.bid * 512 + C.tid; i < (size_t)T * D; i += (size_t)C.nb * 512) out[i] = c;
}
#endif

constexpr int NPHASE = 24;
__global__ void __launch_bounds__(512, 2) mk_fwd(Args args) {
    extern __shared__ __attribute__((aligned(16))) unsigned char lds[];
    Ctx C; C.tid = threadIdx.x; C.lane = C.tid & 63; C.wave = __builtin_amdgcn_readfirstlane(C.tid >> 6); C.bid = blockIdx.x; C.nb = gridDim.x;
    C.gw = C.bid * 8 + C.wave; C.ngw = C.nb * 8; C.lds = lds;
    unsigned char* ws = args.ws;
    volatile LAS unsigned* MISC = (volatile LAS unsigned*)((LAS unsigned char*)lds + LDS_MISC);
    if (C.tid < 32) MISC[C.tid] = 0u;
    __syncthreads();
    XcdBarrier bar = xcd_barrier_post((unsigned*)(ws + WS_CTL) + 4096 + args.li * XCD_BAR_WORDS, MISC + 8);
    const int lo = args.ph_lo, hi = args.ph_hi;
#ifdef PH_ONLY
#define IN(k) ((k) == PH_ONLY && lo <= (k) && (k) < hi)
#else
#define IN(k) (lo <= (k) && (k) < hi)
#endif
#define SEAM(k) do { if (IN((k) + 1)) xcd_barrier(bar); } while (0)
#ifdef DBG
    float* dacc = (float*)(ws + WS_DBG); unsigned* ddw = (unsigned*)(ws + WS_DBG + 1024);
#define DBGCHK(page, call) do { if (DBG == (page)) { call; xcd_barrier(bar); } } while (0)
#else
#define DBGCHK(page, call) do { } while (0)
#endif
    PG8_LAS unsigned char* glds = (PG8_LAS unsigned char*)lds;
    const float* x = (const float*)args.in[0];
    float* HA = args.out; float* HB = (float*)(ws + WS_HB);
    bf16_t* XN = (bf16_t*)(ws + WS_XN);
    float* AFF = (float*)(ws + WS_AFF); int* SEL = (int*)(ws + WS_SEL); int* IDX = (int*)(ws + WS_IDX);
    bf16_t* WGU = (bf16_t*)(ws + WS_WGU); bf16_t* WD = (bf16_t*)(ws + WS_WD);
    bf16_t* XS = (bf16_t*)(ws + AR_XS); bf16_t* HH = (bf16_t*)(ws + AR_H); bf16_t* YY = (bf16_t*)(ws + AR_Y);

    if (IN(0)) { ph_convert_small(C, args, ws); ph_convert_moe(C, args, ws, 0); ph_norm(C, x, (const float*)args.in[2], XN); SEAM(0); }
    if (IN(1)) {
        { pg8::Gemm g{XN, (const bf16_t*)(ws + WS_WGIN), T, 3072, 1024}; pg8::StaticOrder S; S.init(T, 3072, C.nb, C.bid);
          pg8::EpiGlaIn E{(bf16_t*)(ws + AR_Q0), (bf16_t*)(ws + AR_K0), (bf16_t*)(ws + AR_SR), (float*)(ws + AR_GF), (float*)(ws + AR_GB), (const float*)args.in[7], (const float*)args.in[9]};
          pg8::gemm_phase<pg8::EpiGlaIn, pg8::StaticOrder, PG8_ALIGN, PG8_SP2>(glds, g, S, E); }
        { pg8::Gemm g{(const bf16_t*)(ws + WS_WV), XN, 1024, T, 1024}; pg8::StaticOrder S; S.init(1024, T, C.nb, C.bid);
          pg8::EpiBf E{(bf16_t*)(ws + AR_VT), T};
          pg8::gemm_phase<pg8::EpiBf, pg8::StaticOrder, PG8_ALIGN, PG8_SP2>(glds, g, S, E); }
        SEAM(1); } DBGCHK(0, chk_p1(C, args, ws, dacc));
    if (IN(2)) { ph_gla_prep(C, (const bf16_t*)(ws + AR_Q0), (const bf16_t*)(ws + AR_K0), (const float*)(ws + AR_GF), (const float*)(ws + AR_GB), (bf16_t*)(ws + AR_QDF), (bf16_t*)(ws + AR_QDB),
                             (bf16_t*)(ws + AR_KDF), (bf16_t*)(ws + AR_KDB), (bf16_t*)(ws + AR_KTF), (bf16_t*)(ws + AR_KTB), (float*)(ws + WS_EGL)); SEAM(2); }
    if (IN(3)) { ph_gla_u(C, (const bf16_t*)(ws + AR_VT), (const bf16_t*)(ws + AR_KTF), (const bf16_t*)(ws + AR_KTB), (const float*)(ws + WS_EGL), (bf16_t*)(ws + AR_U)); SEAM(3); }
    if (IN(4)) { ph_gla_scan(C, (const bf16_t*)(ws + AR_U), (const float*)(ws + WS_EGL), (bf16_t*)(ws + AR_ST)); SEAM(4); }
    if (IN(5)) { ph_gla_out(C, (const bf16_t*)(ws + AR_QDF), (const bf16_t*)(ws + AR_QDB), (const bf16_t*)(ws + AR_KDF), (const bf16_t*)(ws + AR_KDB), (const bf16_t*)(ws + AR_VT), (const bf16_t*)(ws + AR_ST),
                            (const bf16_t*)(ws + AR_SR), (const float*)args.in[10], XN); SEAM(5); } DBGCHK(0, chk_gla(C, args, ws, dacc));
    if (IN(6)) { pg8::Gemm g{XN, (const bf16_t*)(ws + WS_WGOUT), T, 1024, 1024}; pg8::StaticOrder S; S.init(T, 1024, C.nb, C.bid);
        pg8::EpiF32 E{HA, x, 1024}; pg8::gemm_phase<pg8::EpiF32, pg8::StaticOrder, false, PG8_SP2>(glds, g, S, E); SEAM(6); } DBGCHK(0, chk_resid(C, x, XN, 1024, (const float*)args.in[11], HA, dacc, 3));
#define MOE_LAYER(P, L, HIN, TAILMODE, HOUT, GAIN2, OUTP)                                                                                         \
    if (IN(P)) { ph_router(C, HIN, (const float*)args.in[3] + (L) * 1024, (const float*)args.in[18] + (L) * 1024 * 16, XN, AFF); SEAM(P); if ((P) == 7) DBGCHK(0, chk_router(C, HIN, (const float*)args.in[3] + (L) * 1024, (const float*)args.in[18] + (L) * 1024 * 16, XN, AFF, dacc, 4)); }       \
    if (IN(P + 1)) { ph_select(C, AFF, SEL, IDX); SEAM(P + 1); if ((P) == 7) DBGCHK(0, chk_select(C, AFF, SEL, IDX, ddw)); }                                                                                 \
    if (IN(P + 2)) { ph_gather(C, IDX, XN, XS); SEAM(P + 2); }                                                                                   \
    if (IN(P + 3)) { pg8::Gemm g{XS, WGU, NE * CAP, 4096, 1024}; pg8::GroupedOrder S; S.init(NE * CAP, 4096, C.nb, C.bid); pg8::EpiMoe1 E{HH};     \
        pg8::gemm_phase<pg8::EpiMoe1, pg8::GroupedOrder, PG8_ALIGN, PG8_SP2>(glds, g, S, E); SEAM(P + 3); if ((P) == 7) DBGCHK(0, chk_moe_h(C, args, ws, L, dacc, 6)); }                                       \
    if (IN(P + 4)) { pg8::Gemm g{HH, WD, NE * CAP, 1024, 2048}; pg8::GroupedOrder S; S.init(NE * CAP, 1024, C.nb, C.bid); pg8::EpiMoe2 E{YY};      \
        pg8::gemm_phase<pg8::EpiMoe2, pg8::GroupedOrder, PG8_ALIGN, PG8_SP2>(glds, g, S, E); SEAM(P + 4); if ((P) == 7) DBGCHK(0, chk_moe_y(C, args, ws, L, dacc, 7)); }                                       \
    if (IN(P + 5)) { ph_combine<TAILMODE>(C, HIN, AFF, SEL, YY, HOUT, GAIN2, XN, OUTP); SEAM(P + 5); if ((P) == 7) DBGCHK(0, chk_combine(C, ws, HIN, HOUT, dacc, 8)); }

    MOE_LAYER(7, 0, HA, 1, HB, (const float*)args.in[2] + 1024, nullptr)
    if (IN(13)) { pg8::Gemm g{XN, (const bf16_t*)(ws + WS_WMIN), T, 512, 1024}; pg8::StaticOrder S; S.init(T, 512, C.nb, C.bid);
        pg8::EpiF32 E{(float*)(ws + AR_CIN), nullptr, 512}; pg8::gemm_phase<pg8::EpiF32, pg8::StaticOrder, false, PG8_SP2>(glds, g, S, E); SEAM(13); } DBGCHK(1, chk_cin(C, args, ws, dacc));
    if (IN(14)) { ph_mla_tok(C, (const float*)(ws + AR_CIN), (const int*)args.in[1], (const float*)args.in[13], (const float*)args.in[15], args.invf, (bf16_t*)(ws + AR_CQN), (bf16_t*)(ws + AR_CKVN),
                             (float*)(ws + WS_CS), (bf16_t*)(ws + AR_K));
        ph_convert_moe(C, args, ws, 1); SEAM(14); } DBGCHK(1, chk_tok(C, args, ws, dacc));
    if (IN(15)) {
        { pg8::Gemm g{(const bf16_t*)(ws + AR_CQN), (const bf16_t*)(ws + WS_WUQ), T, 4096, 256}; pg8::StaticOrder S; S.init(T, 4096, C.nb, C.bid);
          pg8::EpiQup E{(bf16_t*)(ws + AR_Q), (const float*)(ws + WS_CS)}; pg8::gemm_phase<pg8::EpiQup, pg8::StaticOrder, PG8_ALIGN, PG8_SP2>(glds, g, S, E); }
        { pg8::Gemm g{(const bf16_t*)(ws + AR_CKVN), (const bf16_t*)(ws + WS_WUKV), T, 4096, 256}; pg8::StaticOrder S; S.init(T, 4096, C.nb, C.bid);
          pg8::EpiKVup E{(bf16_t*)(ws + AR_K), (bf16_t*)(ws + AR_V)}; pg8::gemm_phase<pg8::EpiKVup, pg8::StaticOrder, PG8_ALIGN, PG8_SP2>(glds, g, S, E); }
        SEAM(15); } DBGCHK(1, chk_qkv(C, args, ws, dacc));
    if (IN(16)) {
        const int nun = MH * (T / 256);
        for (int i = 0; i * C.nb + C.bid < nun; ++i) {
            int h, qb; if (C.nb == 256) { h = (C.bid & 7) + 8 * (i >> 1); qb = (i & 1) * 32 + (C.bid >> 3); } else { const int u = i * C.nb + C.bid; h = u >> 6; qb = u & 63; }
            const bf16_t* Qb = (const bf16_t*)(ws + AR_Q) + ((size_t)h * T + (size_t)qb * 256) * MDK;
            att::attn_body(Qb, (const bf16_t*)(ws + AR_K) + (size_t)h * T * MDK, (const bf16_t*)(ws + AR_V) + (size_t)h * T * MDV, (bf16_t*)(ws + AR_O) + (size_t)qb * 256 * 2048 + 128 * h, 2048, T, (char*)lds);
            __syncthreads();
        }
        SEAM(16); } DBGCHK(1, chk_attn(C, ws, dacc));
    if (IN(17)) { pg8::Gemm g{(const bf16_t*)(ws + AR_O), (const bf16_t*)(ws + WS_WMOUT), T, 1024, 2048}; pg8::StaticOrder S; S.init(T, 1024, C.nb, C.bid);
        pg8::EpiF32 E{HA, HB, 1024}; pg8::gemm_phase<pg8::EpiF32, pg8::StaticOrder, false, PG8_SP2>(glds, g, S, E); SEAM(17); } DBGCHK(1, chk_resid(C, HB, (const bf16_t*)(ws + AR_O), 2048, (const float*)args.in[17], HA, dacc, 14));
    MOE_LAYER(18, 1, HA, 2, nullptr, (const float*)args.in[4], args.out)
#ifdef DBG
    xcd_barrier(bar); dbg_report(C, ws, args.out, DBG == 0 ? 0 : 10, DBG == 0 ? 10 : 20);
#endif
#undef IN
#undef SEAM
}

#ifndef MK_N_LAUNCHES
#define MK_N_LAUNCHES 1
#endif
extern "C" void kernel_launch(void* const* d_in, const int* in_sizes, int n_in, void* d_out, int out_size, void* d_ws, size_t ws_size, hipStream_t stream) {
    static int grid = 0;
    if (grid == 0) {
        if (n_in != 22 || out_size != T * D || ws_size < WS_END) { fprintf(stderr, "kernel_launch: unexpected shapes (n_in %d out %d ws %zu, need ws >= %zu)\n", n_in, out_size, ws_size, (size_t)WS_END); grid = -1; return; }
        int dev = 0, cus = 0, per_cu = 0;
        if (hipGetDevice(&dev) != hipSuccess || hipDeviceGetAttribute(&cus, hipDeviceAttributeMultiprocessorCount, dev) != hipSuccess) { grid = -1; return; }
        if (hipFuncSetAttribute((const void*)mk_fwd, hipFuncAttributeMaxDynamicSharedMemorySize, LDS_BYTES) != hipSuccess) { fprintf(stderr, "kernel_launch: hipFuncSetAttribute failed\n"); grid = -1; return; }
        if (hipOccupancyMaxActiveBlocksPerMultiprocessor(&per_cu, (const void*)mk_fwd, 512, LDS_BYTES) != hipSuccess || per_cu < 1) fprintf(stderr, "kernel_launch: occupancy query says %d\n", per_cu);
        (void)hipGetLastError();
        grid = cus;
    }
    if (grid < 0) return;
    (void)hipMemsetAsync((char*)d_ws + WS_CTL, 0, CTL_ZERO_BYTES, stream);
    Args a{};
    for (int i = 0; i < 22; ++i) a.in[i] = d_in[i];
    a.out = (float*)d_out; a.ws = (unsigned char*)d_ws;
    for (int i = 0; i < 32; ++i) a.invf[i] = powf(10000.0f, -(float)i / 32.0f);
    if (MK_N_LAUNCHES == 1) { a.ph_lo = 0; a.ph_hi = NPHASE; a.li = 0; hipLaunchKernelGGL(mk_fwd, dim3(grid), dim3(512), LDS_BYTES, stream, a); }
    else { for (int p = 0; p < NPHASE; ++p) { a.ph_lo = p; a.ph_hi = p + 1; a.li = p; hipLaunchKernelGGL(mk_fwd, dim3(grid), dim3(512), LDS_BYTES, stream, a); } }
}
```

```cpp
#include <hip/hip_runtime.h>
#include <cstdio>
#include <cstdint>
#include <cmath>

constexpr int T = 16384, D = 1024, NE = 16, CAP = 2048, FF = 2048;
constexpr int GH = 4, GDK = 128, GDV = 256, GC = 64, GNC = T / GC;
constexpr int MH = 16, MDK = 192, MDV = 128;
constexpr float RMS_EPS = 1e-6f;

typedef unsigned short bf16_t;
typedef short bf16x8 __attribute__((ext_vector_type(8)));
typedef short s16x4 __attribute__((ext_vector_type(4)));
typedef float f32x4 __attribute__((ext_vector_type(4)));
typedef float f32x2 __attribute__((ext_vector_type(2)));
typedef float f32x16 __attribute__((ext_vector_type(16)));
typedef unsigned u32x4 __attribute__((ext_vector_type(4)));
typedef unsigned u32x2 __attribute__((ext_vector_type(2)));
typedef int i32x8 __attribute__((ext_vector_type(8)));
#ifndef ATT_FP8
#define ATT_FP8 1
#endif

constexpr size_t MiB = 1u << 20;
constexpr size_t WS_CTL = 0, CTL_ZERO_BYTES = 512 * 1024;
constexpr size_t WS_WGIN = 1 * MiB;
constexpr size_t WS_WV = 7 * MiB;
constexpr size_t WS_WGOUT = 9 * MiB;
constexpr size_t WS_WMIN = 11 * MiB;
constexpr size_t WS_WUQ = 12 * MiB;
constexpr size_t WS_WUKV = 14 * MiB;
constexpr size_t WS_WMOUT = 16 * MiB;
constexpr size_t WS_WGU = 20 * MiB;
constexpr size_t WS_WD = 148 * MiB;
constexpr size_t WS_AFF = 212 * MiB;
constexpr size_t WS_SEL = 213 * MiB;
constexpr size_t WS_IDX = 214 * MiB;
constexpr size_t WS_EGL = 215 * MiB;
constexpr size_t WS_CS = 216 * MiB;
constexpr size_t WS_XN = 220 * MiB;
constexpr size_t WS_HB = 252 * MiB;
constexpr size_t WS_AR = 316 * MiB;
constexpr size_t WS_AFFT = 828 * MiB;
constexpr size_t WS_END = 829 * MiB;
constexpr size_t AR_Q0 = WS_AR, AR_K0 = WS_AR + 16 * MiB, AR_GF = WS_AR + 32 * MiB, AR_GB = WS_AR + 64 * MiB, AR_SR = WS_AR + 96 * MiB, AR_VT = WS_AR + 128 * MiB;
constexpr size_t AR_QDF = WS_AR + 160 * MiB, AR_QDB = WS_AR + 176 * MiB, AR_KDF = WS_AR + 192 * MiB, AR_KDB = WS_AR + 208 * MiB, AR_KTF = WS_AR + 224 * MiB, AR_KTB = WS_AR + 240 * MiB;
constexpr size_t AR_U = WS_AR + 256 * MiB, AR_ST = WS_AR + 384 * MiB;
constexpr size_t AR_XS = WS_AR, AR_H = WS_AR + 64 * MiB, AR_Y = WS_AR + 192 * MiB;
constexpr size_t AR_CIN = WS_AR, AR_CQN = WS_AR + 32 * MiB, AR_CKVN = WS_AR + 40 * MiB, AR_Q = WS_AR + 48 * MiB, AR_K = WS_AR + 144 * MiB, AR_V = WS_AR + 240 * MiB, AR_O = WS_AR + 304 * MiB;

constexpr size_t AR_Q8 = AR_Q, AR_K8 = AR_K, AR_V8T = AR_V;
constexpr int LDS_BYTES = 147456;
constexpr int LDS_MISC = 135168;

__device__ __forceinline__ unsigned cvt_pk_bf16(float lo, float hi) { unsigned r; asm volatile("v_cvt_pk_bf16_f32 %0, %1, %2" : "=v"(r) : "v"(lo), "v"(hi)); return r; }
__device__ __forceinline__ float bf_lo(unsigned w) { return __uint_as_float(w << 16); }
__device__ __forceinline__ float bf_hi(unsigned w) { return __uint_as_float(w & 0xffff0000u); }
__device__ __forceinline__ float bf2f(bf16_t b) { return __uint_as_float(((unsigned)b) << 16); }
__device__ __forceinline__ bf16_t f2bf(float f) { return (bf16_t)(cvt_pk_bf16(f, 0.f) & 0xffffu); }
__device__ __forceinline__ float siluf(float x) { return x / (1.f + __expf(-x)); }
__device__ __forceinline__ float logsigf(float x) { return fminf(x, 0.f) - log1pf(__expf(-fabsf(x))); }
__device__ __forceinline__ void store8bf(bf16_t* p, f32x4 v0, f32x4 v1) {
    u32x4 w; w.x = cvt_pk_bf16(v0[0], v0[1]); w.y = cvt_pk_bf16(v0[2], v0[3]); w.z = cvt_pk_bf16(v1[0], v1[1]); w.w = cvt_pk_bf16(v1[2], v1[3]); *(u32x4*)p = w; }
__device__ __forceinline__ unsigned pk4fp8(float a, float b, float c, float d) { int w = __builtin_amdgcn_cvt_pk_fp8_f32(a, b, 0, false); w = __builtin_amdgcn_cvt_pk_fp8_f32(c, d, w, true); return (unsigned)w; }
__device__ __forceinline__ void store8fp8(unsigned char* p, f32x4 v0, f32x4 v1) { u32x2 w; w.x = pk4fp8(v0[0], v0[1], v0[2], v0[3]); w.y = pk4fp8(v1[0], v1[1], v1[2], v1[3]); *(u32x2*)p = w; }
__device__ __forceinline__ float fp8f(const unsigned char* p) { const unsigned w = *(const unsigned*)((size_t)p & ~(size_t)3); const int b = (int)((size_t)p & 3);
    return b == 0 ? __builtin_amdgcn_cvt_f32_fp8((int)w, 0) : b == 1 ? __builtin_amdgcn_cvt_f32_fp8((int)w, 1) : b == 2 ? __builtin_amdgcn_cvt_f32_fp8((int)w, 2) : __builtin_amdgcn_cvt_f32_fp8((int)w, 3); }
__device__ __forceinline__ float wave_sum(float v) {
#pragma unroll
    for (int o = 1; o < 64; o <<= 1) v += __shfl_xor(v, o);
    return v; }
__device__ __forceinline__ float wave_max(float v) {
#pragma unroll
    for (int o = 1; o < 64; o <<= 1) v = fmaxf(v, __shfl_xor(v, o));
    return v; }
#define LAS __attribute__((address_space(3)))
#define LDS_WAIT() asm volatile("s_waitcnt lgkmcnt(0)" ::: "memory")
#define VM_WAIT() asm volatile("s_waitcnt vmcnt(0)" ::: "memory")

namespace pg8 {
#define PG8_LAS __attribute__((address_space(3)))
typedef unsigned short bf16_t;
typedef short bf16x8 __attribute__((ext_vector_type(8)));
typedef float f32x4 __attribute__((ext_vector_type(4)));
typedef unsigned u32x4 __attribute__((ext_vector_type(4)));
constexpr int BM = 256, BK = 64, HALF = 128, HTB = HALF * BK * 2  , STAGE_BYTES = 8 * HTB, NXCD = 8, WGM = 8;

__host__ __device__ __forceinline__ int lds_byte(int r, int c) { const int st = (r >> 4) * 2 + (c >> 5), rr = r & 15, cc = c & 31, ob = rr * 64 + cc * 2; return st * 1024 + (ob ^ (((ob >> 9) & 1) << 5)); }
__host__ __device__ __forceinline__ void stage_rc(int b, int& R, int& C) { const int st = b / 1024, sb = b % 1024, swz = sb ^ (((sb >> 9) & 1) << 5); R = (st >> 1) * 16 + swz / 64; C = (st & 1) * 32 + (swz % 64) / 2; }
__host__ __device__ __forceinline__ int perm32(int rho) { const int n = rho >> 4, i = rho & 15; return 8 * (i >> 2) + 4 * n + (i & 3); }

struct Unit { int pm, pn; };
struct Gemm { const bf16_t* A; const bf16_t* Bt; int M, N, K; };

struct StaticOrder {
    int nM, nN, nwg, G, c, rep;
    __host__ __device__ void init(int M, int N, int G_, int c_) { nM = M / BM; nN = N / BM; nwg = nM * nN; G = G_; c = c_; rep = 1; }
    __host__ __device__ bool next(int i, Unit& u) const {
        if (rep > 1) { const int cnt = (nwg - c + G - 1) / G; if (cnt <= 0 || i >= cnt * rep) return false; i = i % cnt; }
        const long L = (long)i * G + c; if (L >= nwg) return false;
        int wgid = (int)L; { const int q = nwg / NXCD, r = nwg % NXCD, xcd = wgid % NXCD, off = wgid / NXCD; wgid = (xcd < r ? xcd * (q + 1) : r * (q + 1) + (xcd - r) * q) + off; }
        const int nig = WGM * nN, gid = wgid / nig, fm = gid * WGM, gsz = (nM - fm) < WGM ? (nM - fm) : WGM;
        u.pm = fm + ((wgid % nig) % gsz); u.pn = (wgid % nig) / gsz; return true;
    }
    __device__ __forceinline__ void a_ready(const Unit&) const {}
    __device__ __forceinline__ void done(const Unit&) const {}
};

struct GroupedOrder : StaticOrder {
    int nNl;
    __host__ __device__ void init(int Mtot, int Nper, int G_, int c_) { StaticOrder::init(Mtot, Nper, G_, c_); nNl = Nper / BM; }
    __host__ __device__ bool next(int i, Unit& u) const { if (!StaticOrder::next(i, u)) return false; u.pn += (u.pm >> 3) * nNl; return true; }
};

#define EPI_LOOP_ROWS for (int ai = 0; ai < 2; ++ai) _Pragma("unroll") for (int m = 0; m < 4; ++m)

struct EpiGlaIn {
    static constexpr bool PERM = true, AFTER_DRAIN = false;
    bf16_t *Q0, *K0, *SR; float *GF, *GB; const float *bF, *bB;
    __device__ __forceinline__ void operator()(const f32x4 (&acc)[2][2][4][2], const Unit& u, int wr, int wc, int fr, int fq) const {
        const int row0 = u.pm * BM + wr * 64 + fr, pn = u.pn;
#pragma unroll
        EPI_LOOP_ROWS { const size_t row = (size_t)(row0 + ai * HALF + m * 16);
#pragma unroll
            for (int bj = 0; bj < 2; ++bj) { const int cl = bj * HALF + wc * 32 + 8 * fq; f32x4 v0 = acc[ai][bj][m][0], v1 = acc[ai][bj][m][1];
                if (pn < 2) { const float s = 0.08838834764831845f; store8bf(Q0 + row * 512 + pn * 256 + cl, v0 * s, v1 * s); }
                else if (pn < 4) { store8bf(K0 + row * 512 + (pn - 2) * 256 + cl, v0, v1); }
                else if (pn < 8) {
#pragma unroll
                    for (int j = 0; j < 4; ++j) { v0[j] = siluf(v0[j]); v1[j] = siluf(v1[j]); }
                    store8bf(SR + row * 1024 + (pn - 4) * 256 + cl, v0, v1); }
                else { float* G = pn < 10 ? GF : GB; const float* b = pn < 10 ? bF : bB; const int c = ((pn - 8) & 1) * 256 + cl;
                    const f32x4 b0 = *(const f32x4*)(b + c), b1 = *(const f32x4*)(b + c + 4); f32x4 o0, o1;
#pragma unroll
                    for (int j = 0; j < 4; ++j) { o0[j] = logsigf(v0[j] + b0[j]) * 0.0625f; o1[j] = logsigf(v1[j] + b1[j]) * 0.0625f; }
                    *(f32x4*)(G + row * 512 + c) = o0; *(f32x4*)(G + row * 512 + c + 4) = o1; } } }
    }
};
struct EpiBf {
    static constexpr bool PERM = true, AFTER_DRAIN = false;
    bf16_t* O; int ldc;
    __device__ __forceinline__ void operator()(const f32x4 (&acc)[2][2][4][2], const Unit& u, int wr, int wc, int fr, int fq) const {
        const int row0 = u.pm * BM + wr * 64 + fr;
#pragma unroll
        EPI_LOOP_ROWS { bf16_t* rowp = O + (size_t)(row0 + ai * HALF + m * 16) * ldc + u.pn * BM + wc * 32 + 8 * fq;
#pragma unroll
            for (int bj = 0; bj < 2; ++bj) store8bf(rowp + bj * HALF, acc[ai][bj][m][0], acc[ai][bj][m][1]); }
    }
};
struct EpiF32 {
    static constexpr bool PERM = false, AFTER_DRAIN = false;
    float* C; const float* base; int ldc;
    __device__ __forceinline__ void operator()(const f32x4 (&acc)[2][2][4][2], const Unit& u, int wr, int wc, int fr, int fq) const {
        const int row0 = u.pm * BM + wr * 64 + fr, col0 = u.pn * BM + wc * 32 + 4 * fq;
#pragma unroll
        EPI_LOOP_ROWS { const size_t off = (size_t)(row0 + ai * HALF + m * 16) * ldc + col0;
#pragma unroll
            for (int bj = 0; bj < 2; ++bj)
#pragma unroll
                for (int n = 0; n < 2; ++n) { f32x4 v = acc[ai][bj][m][n]; if (base) v = v + *(const f32x4*)(base + off + bj * HALF + n * 16); *(f32x4*)(C + off + bj * HALF + n * 16) = v; } }
    }
};
struct EpiQup {
    static constexpr bool PERM = true, AFTER_DRAIN = false;
    bf16_t* Q; const float* CS;
    __device__ __forceinline__ void operator()(const f32x4 (&acc)[2][2][4][2], const Unit& u, int wr, int wc, int fr, int fq) const {
        const int row0 = u.pm * BM + wr * 64 + fr, h = u.pn; const float QS = 0.07216878364870322f * 1.4426950408889634f;
#pragma unroll
        EPI_LOOP_ROWS { const size_t row = (size_t)(row0 + ai * HALF + m * 16); bf16_t* qrow = Q + ((size_t)h * T + row) * MDK;
            store8bf(qrow + wc * 32 + 8 * fq, acc[ai][0][m][0] * QS, acc[ai][0][m][1] * QS);
            if (wc < 2) { const int i0 = wc * 16 + 4 * fq; const f32x4 c = *(const f32x4*)(CS + row * 64 + i0), s = *(const f32x4*)(CS + row * 64 + 32 + i0);
                const f32x4 x1 = acc[ai][1][m][0], x2 = acc[ai][1][m][1];
                store8bf(qrow + 128 + wc * 32 + 8 * fq, (x1 * c - x2 * s) * QS, (x1 * s + x2 * c) * QS); } }
    }
};
struct EpiKVup {
    static constexpr bool PERM = true, AFTER_DRAIN = false;
    bf16_t *K, *V;
    __device__ __forceinline__ void operator()(const f32x4 (&acc)[2][2][4][2], const Unit& u, int wr, int wc, int fr, int fq) const {
        const int row0 = u.pm * BM + wr * 64 + fr, h = u.pn;
#pragma unroll
        EPI_LOOP_ROWS { const size_t row = (size_t)h * T + (size_t)(row0 + ai * HALF + m * 16);
            store8bf(K + row * MDK + wc * 32 + 8 * fq, acc[ai][0][m][0], acc[ai][0][m][1]);
            store8bf(V + row * MDV + wc * 32 + 8 * fq, acc[ai][1][m][0], acc[ai][1][m][1]); }
    }
};
struct EpiMoe1 {
    static constexpr bool PERM = true, AFTER_DRAIN = false;
    bf16_t* H;
    __device__ __forceinline__ void operator()(const f32x4 (&acc)[2][2][4][2], const Unit& u, int wr, int wc, int fr, int fq) const {
        const int row0 = u.pm * BM + wr * 64 + fr, j = u.pn & 15;
#pragma unroll
        EPI_LOOP_ROWS { bf16_t* rowp = H + (size_t)(row0 + ai * HALF + m * 16) * FF + 128 * j + 16 * wc + 4 * fq;
#pragma unroll
            for (int bj = 0; bj < 2; ++bj) { const f32x4 g = acc[ai][bj][m][0], uu = acc[ai][bj][m][1];
                u32x2 w; w.x = cvt_pk_bf16(siluf(g[0]) * uu[0], siluf(g[1]) * uu[1]); w.y = cvt_pk_bf16(siluf(g[2]) * uu[2], siluf(g[3]) * uu[3]);
                *(u32x2*)(rowp + 64 * bj) = w; } }
    }
};
struct EpiMoe2 {
    static constexpr bool PERM = true, AFTER_DRAIN = false;
    bf16_t* Y;
    __device__ __forceinline__ void operator()(const f32x4 (&acc)[2][2][4][2], const Unit& u, int wr, int wc, int fr, int fq) const {
        const int row0 = u.pm * BM + wr * 64 + fr, j = u.pn & 3;
#pragma unroll
        EPI_LOOP_ROWS { bf16_t* rowp = Y + (size_t)(row0 + ai * HALF + m * 16) * D + 256 * j + wc * 32 + 8 * fq;
#pragma unroll
            for (int bj = 0; bj < 2; ++bj) store8bf(rowp + bj * HALF, acc[ai][bj][m][0], acc[ai][bj][m][1]); }
    }
};

struct EpiQ8 {
    static constexpr bool PERM = true, AFTER_DRAIN = false;
    unsigned char* Q; const float* CS;
    __device__ __forceinline__ void operator()(const f32x4 (&acc)[2][2][4][2], const Unit& u, int wr, int wc, int fr, int fq) const {
        const int row0 = u.pm * BM + wr * 64 + fr, h = u.pn; const float QS = 8.0f * 0.07216878364870322f * 1.4426950408889634f;
#pragma unroll
        EPI_LOOP_ROWS { const size_t row = (size_t)(row0 + ai * HALF + m * 16); unsigned char* qrow = Q + ((size_t)h * T + row) * MDK;
            store8fp8(qrow + wc * 32 + 8 * fq, acc[ai][0][m][0] * QS, acc[ai][0][m][1] * QS);
            if (wc < 2) { const int i0 = wc * 16 + 4 * fq; const f32x4 c = *(const f32x4*)(CS + row * 64 + i0), s = *(const f32x4*)(CS + row * 64 + 32 + i0);
                const f32x4 x1 = acc[ai][1][m][0], x2 = acc[ai][1][m][1];
                store8fp8(qrow + 128 + wc * 32 + 8 * fq, (x1 * c - x2 * s) * QS, (x1 * s + x2 * c) * QS); } }
    }
};
struct EpiK8 {
    static constexpr bool PERM = true, AFTER_DRAIN = false;
    unsigned char* K;
    __device__ __forceinline__ void operator()(const f32x4 (&acc)[2][2][4][2], const Unit& u, int wr, int wc, int fr, int fq) const {
        const int row0 = u.pm * BM + wr * 64 + fr;
#pragma unroll
        EPI_LOOP_ROWS { const size_t row = (size_t)(row0 + ai * HALF + m * 16);
#pragma unroll
            for (int bj = 0; bj < 2; ++bj) store8fp8(K + ((size_t)(2 * u.pn + bj) * T + row) * MDK + wc * 32 + 8 * fq, acc[ai][bj][m][0], acc[ai][bj][m][1]); }
    }
};
struct EpiV8T {
    static constexpr bool PERM = true, AFTER_DRAIN = false;
    unsigned char* V;
    __device__ __forceinline__ void operator()(const f32x4 (&acc)[2][2][4][2], const Unit& u, int wr, int wc, int fr, int fq) const {
        const int row0 = u.pm * BM + wr * 64 + fr;
#pragma unroll
        EPI_LOOP_ROWS { unsigned char* rowp = V + (size_t)(row0 + ai * HALF + m * 16) * T + u.pn * BM + 64 * (wc >> 1) + 16 * (wc & 1) + 4 * fq;
#pragma unroll
            for (int bj = 0; bj < 2; ++bj) { const f32x4 a = acc[ai][bj][m][0], b = acc[ai][bj][m][1];
                *(unsigned*)(rowp + bj * HALF) = pk4fp8(a[0], a[1], a[2], a[3]); *(unsigned*)(rowp + bj * HALF + 32) = pk4fp8(b[0], b[1], b[2], b[3]); } }
    }
};

template <class Epi, class Sched, bool ALIGN_EPI = false, bool SP2 = false>
__device__ __forceinline__ void gemm_phase(PG8_LAS unsigned char* lds, const Gemm g, const Sched& S, const Epi& E) {
    const int tid = threadIdx.x, wid = __builtin_amdgcn_readfirstlane(tid >> 6), lane = tid & 63, wr = wid >> 2, wc = wid & 3, fr = lane & 15, fq = lane >> 4;
    int K = g.K; asm volatile("" : "+s"(K));
    const int nt = K / BK;
    unsigned voffA[2], voffB[2];
#pragma unroll
    for (int i = 0; i < 2; ++i) { int R, C; stage_rc(tid * 16 + i * 8192, R, C); const int Rb = Epi::PERM ? ((R & ~31) + perm32(R & 31)) : R;
        voffA[i] = (unsigned)(R * K + C) * 2u; voffB[i] = (unsigned)(Rb * K + C) * 2u; }
    const size_t kstep = (size_t)(BK * 2);
    const size_t hstep = (size_t)HALF * K * 2;
    const size_t tstep = 2 * hstep;
    const unsigned ldsw = (unsigned)wid * 1024u;
    const int aoff = lds_byte(wr * 64 + fr, fq * 8), boff = lds_byte(wc * 32 + fr, fq * 8);
#define PG8_SA(b, h) (((b) * 2 + (h)) * HTB)
#define PG8_SB(b, h) ((4 + (b) * 2 + (h)) * HTB)
#define PG8_STAGE(bufoff, gbase, voff) do { _Pragma("unroll") for (int _i = 0; _i < 2; ++_i) \
        __builtin_amdgcn_global_load_lds((const unsigned*)((const char*)(gbase) + (voff)[_i]), (PG8_LAS unsigned*)(lds + (bufoff) + ldsw + _i * 8192), 16, 0, 0); } while (0)
#define PG8_LDA(dst, b, h) do { _Pragma("unroll") for (int m = 0; m < 4; ++m) _Pragma("unroll") for (int k = 0; k < 2; ++k) dst[m][k] = *(const PG8_LAS bf16x8*)(lds + PG8_SA(b, h) + aoff + m * 2048 + k * 1024); } while (0)
#define PG8_LDB(dst, b, h) do { _Pragma("unroll") for (int n = 0; n < 2; ++n) _Pragma("unroll") for (int k = 0; k < 2; ++k) dst[n][k] = *(const PG8_LAS bf16x8*)(lds + PG8_SB(b, h) + boff + n * 2048 + k * 1024); } while (0)
#define PG8_MMA(ai, bj, At, Bt) do { __builtin_amdgcn_s_setprio(1); _Pragma("unroll") for (int m = 0; m < 4; ++m) _Pragma("unroll") for (int n = 0; n < 2; ++n) _Pragma("unroll") for (int k = 0; k < 2; ++k) \
        acc[ai][bj][m][n] = __builtin_amdgcn_mfma_f32_16x16x32_bf16(Bt[n][k], At[m][k], acc[ai][bj][m][n], 0, 0, 0); __builtin_amdgcn_s_setprio(0); } while (0)
#define PG8_WAIT_V(n) asm volatile("s_waitcnt vmcnt(" #n ")" ::: "memory")
#define PG8_WAIT_L(n) asm volatile("s_waitcnt lgkmcnt(" #n ")" ::: "memory")
#define PG8_BAR __builtin_amdgcn_s_barrier()
#define PG8_SCHED __builtin_amdgcn_sched_barrier(0)
    Unit cur, nxt; int ui = 0;
    if (!S.next(0, cur)) return;
    f32x4 acc[2][2][4][2];
#pragma unroll
    for (int a = 0; a < 2; ++a)
#pragma unroll
        for (int b = 0; b < 2; ++b)
#pragma unroll
            for (int m = 0; m < 4; ++m)
#pragma unroll
                for (int n = 0; n < 2; ++n) acc[a][b][m][n] = (f32x4){0.f, 0.f, 0.f, 0.f};
    bf16x8 At[4][2], B0[2][2], B1[2][2];
    const char* cA = (const char*)g.A + (size_t)cur.pm * tstep; const char* cB = (const char*)g.Bt + (size_t)cur.pn * tstep;
    S.a_ready(cur);
    if constexpr (SP2) {
        PG8_STAGE(PG8_SB(0, 0), cB, voffB); PG8_STAGE(PG8_SB(0, 1), cB + hstep, voffB); PG8_STAGE(PG8_SA(0, 0), cA, voffA); PG8_STAGE(PG8_SA(0, 1), cA + hstep, voffA);
        if (wr == 1) PG8_BAR;
        PG8_WAIT_V(2); PG8_BAR;
        PG8_STAGE(PG8_SB(1, 0), cB + kstep, voffB); PG8_STAGE(PG8_SA(1, 0), cA + kstep, voffA); PG8_STAGE(PG8_SB(1, 1), cB + hstep + kstep, voffB);
        PG8_WAIT_V(6); PG8_BAR;
    } else {
        PG8_STAGE(PG8_SB(0, 0), cB, voffB); PG8_STAGE(PG8_SA(0, 0), cA, voffA); PG8_STAGE(PG8_SB(0, 1), cB + hstep, voffB); PG8_STAGE(PG8_SA(0, 1), cA + hstep, voffA);
        if (wr == 1) PG8_BAR;
        PG8_WAIT_V(4); PG8_BAR;
        PG8_STAGE(PG8_SB(1, 0), cB + kstep, voffB); PG8_STAGE(PG8_SA(1, 0), cA + kstep, voffA); PG8_STAGE(PG8_SB(1, 1), cB + hstep + kstep, voffB);
        PG8_WAIT_V(6); PG8_BAR;
    }
    for (;;) {
        const bool has_next = S.next(ui + 1, nxt);
        const char* nA = has_next ? (const char*)g.A + (size_t)nxt.pm * tstep : cA; const char* nB = has_next ? (const char*)g.Bt + (size_t)nxt.pn * tstep : cB;
        for (int t = 0; t < nt; t += 2) {
            const bool last = (t == nt - 2);
            const char* a1 = cA + (size_t)(t + 1) * kstep;
            const char* a2 = last ? nA : cA + (size_t)(t + 2) * kstep; const char* b2 = last ? nB : cB + (size_t)(t + 2) * kstep;
            const char* a3 = a2 + kstep; const char* b3 = b2 + kstep;
            if (last && has_next) S.a_ready(nxt);
            if constexpr (SP2) {
            PG8_LDB(B0, 0, 0); PG8_LDB(B1, 0, 1); PG8_SCHED; PG8_LDA(At, 0, 0); PG8_STAGE(PG8_SA(1, 1), a1 + hstep, voffA);
            PG8_WAIT_V(8); PG8_WAIT_L(0); PG8_BAR; PG8_MMA(0, 0, At, B0); PG8_MMA(0, 1, At, B1); PG8_BAR; PG8_SCHED;
            PG8_LDA(At, 0, 1); PG8_STAGE(PG8_SB(0, 0), b2, voffB); PG8_STAGE(PG8_SB(0, 1), b2 + hstep, voffB); PG8_STAGE(PG8_SA(0, 0), a2, voffA);
            PG8_WAIT_V(8); PG8_WAIT_L(0); PG8_BAR; PG8_MMA(1, 0, At, B0); PG8_MMA(1, 1, At, B1); PG8_BAR; PG8_SCHED;
            PG8_LDB(B0, 1, 0); PG8_LDB(B1, 1, 1); PG8_SCHED; PG8_LDA(At, 1, 0); PG8_STAGE(PG8_SA(0, 1), a2 + hstep, voffA);
            PG8_WAIT_V(8); PG8_WAIT_L(0); PG8_BAR; PG8_MMA(0, 0, At, B0); PG8_MMA(0, 1, At, B1); PG8_BAR; PG8_SCHED;
            PG8_LDA(At, 1, 1); PG8_STAGE(PG8_SB(1, 0), b3, voffB); PG8_STAGE(PG8_SB(1, 1), b3 + hstep, voffB); PG8_STAGE(PG8_SA(1, 0), a3, voffA);
            PG8_WAIT_V(8); PG8_WAIT_L(0); PG8_BAR; PG8_MMA(1, 0, At, B0); PG8_MMA(1, 1, At, B1); PG8_BAR; PG8_SCHED;
            } else {
            PG8_LDB(B0, 0, 0); PG8_SCHED; PG8_LDA(At, 0, 0); PG8_STAGE(PG8_SA(1, 1), a1 + hstep, voffA);
            PG8_WAIT_L(8); PG8_BAR; PG8_WAIT_L(0); PG8_MMA(0, 0, At, B0); PG8_BAR; PG8_SCHED;
            PG8_LDB(B1, 0, 1); PG8_STAGE(PG8_SB(0, 0), b2, voffB);
            PG8_BAR; PG8_WAIT_L(0); PG8_MMA(0, 1, At, B1); PG8_BAR;
            PG8_LDA(At, 0, 1); PG8_STAGE(PG8_SA(0, 0), a2, voffA);
            PG8_BAR; PG8_WAIT_L(0); PG8_MMA(1, 0, At, B0); PG8_BAR; PG8_SCHED;
            PG8_STAGE(PG8_SB(0, 1), b2 + hstep, voffB);
            PG8_WAIT_V(6); PG8_BAR; PG8_MMA(1, 1, At, B1); PG8_BAR;
            PG8_LDB(B0, 1, 0); PG8_SCHED; PG8_LDA(At, 1, 0); PG8_STAGE(PG8_SA(0, 1), a2 + hstep, voffA);
            PG8_WAIT_L(8); PG8_BAR; PG8_WAIT_L(0); PG8_MMA(0, 0, At, B0); PG8_BAR; PG8_SCHED;
            PG8_LDB(B1, 1, 1); PG8_STAGE(PG8_SB(1, 0), b3, voffB);
            PG8_BAR; PG8_WAIT_L(0); PG8_MMA(0, 1, At, B1); PG8_BAR;
            PG8_LDA(At, 1, 1); PG8_STAGE(PG8_SA(1, 0), a3, voffA);
            PG8_BAR; PG8_WAIT_L(0); PG8_MMA(1, 0, At, B0); PG8_BAR; PG8_SCHED;
            PG8_STAGE(PG8_SB(1, 1), b3 + hstep, voffB);
            PG8_WAIT_V(6); PG8_BAR; PG8_MMA(1, 1, At, B1); PG8_BAR;
            }
        }
        if constexpr (ALIGN_EPI) { if (wr == 0) PG8_BAR; }
        if constexpr (!Epi::AFTER_DRAIN) { E(acc, cur, wr, wc, fr, fq); S.done(cur); }
        if (!has_next) break;
#pragma unroll
        for (int a = 0; a < 2; ++a)
#pragma unroll
            for (int b = 0; b < 2; ++b)
#pragma unroll
                for (int m = 0; m < 4; ++m)
#pragma unroll
                    for (int n = 0; n < 2; ++n) acc[a][b][m][n] = (f32x4){0.f, 0.f, 0.f, 0.f};
        cur = nxt; cA = nA; cB = nB; ++ui;
        if constexpr (ALIGN_EPI) { if (wr == 1) PG8_BAR; }
    }
    PG8_WAIT_V(0);
    if constexpr (!ALIGN_EPI) { if (wr == 0) PG8_BAR; }
    PG8_BAR;
    if constexpr (Epi::AFTER_DRAIN) { E.fused(acc, cur, wr, wc, fr, fq, lds, wid, lane); S.done(cur); }
#undef PG8_SA
#undef PG8_SB
#undef PG8_STAGE
#undef PG8_LDA
#undef PG8_LDB
#undef PG8_MMA
#undef PG8_WAIT_V
#undef PG8_WAIT_L
#undef PG8_BAR
#undef PG8_SCHED
}
}
#define XB_TMO      128
#define XB_XCNT(j)  (256  + 64 * (j))
#define XB_XSUB(j)  (1280 + 64 * (j))
#define XB_XGEN(j)  (2304 + 64 * (j))
#define XB_TOP      3328
#define XB_TOPGEN   3392
#define XCD_BAR_WORDS 3456
#define XB_SPIN_CAP (1u << 18)

__device__ __forceinline__ unsigned xb_ld(unsigned* p)              { return __hip_atomic_load(p, __ATOMIC_RELAXED, __HIP_MEMORY_SCOPE_AGENT); }
__device__ __forceinline__ unsigned xb_add(unsigned* p, unsigned v) { return __hip_atomic_fetch_add(p, v, __ATOMIC_RELAXED, __HIP_MEMORY_SCOPE_AGENT); }
__device__ __forceinline__ unsigned xb_xcc_id() { return (unsigned)__builtin_amdgcn_s_getreg((3 << 11) | 20) & 0xFu; }
#define XB_SPIN(cond, bar) do { unsigned _sp = 0; while (cond) { __builtin_amdgcn_s_sleep(1); \
    if ((++_sp & 255u) == 0u) { if (xb_ld(&(bar)[XB_TMO])) break; if (_sp > XB_SPIN_CAP) { atomicAdd(&(bar)[XB_TMO], 1u); break; } } } } while (0)

struct XcdBarrier {
    unsigned* bar; unsigned x;
    volatile LAS unsigned* st;
};

__device__ __forceinline__ XcdBarrier xcd_barrier_post(unsigned* bar, volatile LAS unsigned* st) {
    XcdBarrier b; b.bar = bar; b.x = xb_xcc_id(); b.st = st;
    if (threadIdx.x == 0) (void)xb_add(&bar[XB_XCNT(b.x)], 1u);
    return b;
}
__device__ __forceinline__ void xcd_barrier_complete(unsigned* bar, unsigned x, unsigned& nloc, unsigned& nx) {
    const unsigned G = gridDim.x * gridDim.y * gridDim.z;
    unsigned sum, cnt, mine, sp = 0u;
    for (;;) {
        sum = 0u; cnt = 0u; mine = 0u;
#pragma unroll
        for (unsigned j = 0; j < 16; ++j) { const unsigned c = xb_ld(&bar[XB_XCNT(j)]); sum += c; cnt += (c > 0u) ? 1u : 0u; mine = (j == x) ? c : mine; }
        if (sum == G) break;
        __builtin_amdgcn_s_sleep(1);
        if ((++sp & 255u) == 0u) { if (xb_ld(&bar[XB_TMO])) break; if (sp > XB_SPIN_CAP) { atomicAdd(&bar[XB_TMO], 1u); break; } }
    }
    nloc = mine > 0u ? mine : 1u; nx = cnt > 0u ? cnt : 1u;
}

__device__ __forceinline__ void xcd_barrier(const XcdBarrier& b) {
    asm volatile("s_waitcnt vmcnt(0)" ::: "memory");
    __syncthreads();
    if (threadIdx.x == 0) {
        unsigned* bar = b.bar;
        __builtin_amdgcn_s_waitcnt(0);
        unsigned nloc = b.st[0], nx = b.st[1];
        if (nloc == 0u) { xcd_barrier_complete(bar, b.x, nloc, nx); b.st[0] = nloc; b.st[1] = nx; }
        const unsigned old = xb_add(&bar[XB_XSUB(b.x)], 1u);
        const unsigned gen = old / nloc;
        if (old + 1u == (gen + 1u) * nloc) {
            __builtin_amdgcn_fence(__ATOMIC_RELEASE, "agent");
            asm volatile("s_waitcnt vmcnt(0)" ::: "memory");
            const unsigned og = xb_add(&bar[XB_TOP], 1u);
            const unsigned tg = og / nx;
            if (og + 1u == (tg + 1u) * nx) xb_add(&bar[XB_TOPGEN], 1u);
            else XB_SPIN(xb_ld(&bar[XB_TOPGEN]) == tg, bar);
            __builtin_amdgcn_fence(__ATOMIC_ACQUIRE, "agent");
            xb_add(&bar[XB_XGEN(b.x)], 1u);
            asm volatile("s_waitcnt vmcnt(0)" ::: "memory");
        } else {
            XB_SPIN(xb_ld(&bar[XB_XGEN(b.x)]) == gen, bar);
            __builtin_amdgcn_fence(__ATOMIC_ACQUIRE, "agent");
            asm volatile("s_waitcnt vmcnt(0)" ::: "memory");
        }
    }
    __syncthreads();
}

#ifndef PG8_SP2
#define PG8_SP2 true
#endif
#ifndef PG8_ALIGN
#define PG8_ALIGN true
#endif

struct Args { const void* in[22]; float* out; unsigned char* ws; float invf[32]; int ph_lo, ph_hi, li, pad; };
struct Ctx { int tid, lane, wave, gw, ngw, bid, nb; unsigned char* lds; };

struct MapId { int off; __device__ __forceinline__ int operator()(int n) const { return off + n; } };
struct MapGU { int which; __device__ __forceinline__ int operator()(int f) const { return 8 * (f >> 2) + 4 * which + (f & 3); } };
struct MapUkv { __device__ __forceinline__ int operator()(int n) const { const int h = n >> 8, j = n & 255; return ATT_FP8 ? (j < 128 ? 128 * h + j : 2048 + 128 * h + (j - 128)) : n; } };
struct MapUq { __device__ __forceinline__ int operator()(int n) const { const int h = n / 192, j = n - h * 192;
    if (j < 128) return 256 * h + j; if (j < 160) { const int i = j - 128; return 256 * h + 128 + 8 * (i >> 2) + (i & 3); } const int i = j - 160; return 256 * h + 128 + 8 * (i >> 2) + 4 + (i & 3); } };
constexpr int TR_SCR = 16896;
__device__ __forceinline__ void tr_load(const float* W, int ldw, int k0, int n0, f32x4 (&v)[16], int lane) {
#pragma unroll
    for (int i = 0; i < 16; ++i) v[i] = *(const f32x4*)(W + (size_t)(k0 + (lane >> 4) + 4 * i) * ldw + n0 + 4 * (lane & 15));
}
template <class RM>
__device__ __forceinline__ void tr_flush(const f32x4 (&v)[16], bf16_t* WT, int ldt, int k0, int nloc0, const RM& rm, float* scr, int lane) {
    const int nb = 4 * (lane & 15), kq = lane >> 4;
#pragma unroll
    for (int i = 0; i < 16; ++i) { float* d = scr + nb * 65 + kq + 4 * i; d[0] = v[i][0]; d[65] = v[i][1]; d[130] = v[i][2]; d[195] = v[i][3]; }
    LDS_WAIT();
    const int c = lane & 7;
#pragma unroll
    for (int j = 0; j < 8; ++j) { const int n = (lane >> 3) + 8 * j; const float* q = scr + n * 65 + 8 * c;
        u32x4 o; o.x = cvt_pk_bf16(q[0], q[1]); o.y = cvt_pk_bf16(q[2], q[3]); o.z = cvt_pk_bf16(q[4], q[5]); o.w = cvt_pk_bf16(q[6], q[7]);
        *(u32x4*)(WT + (size_t)rm(nloc0 + n) * ldt + k0 + 8 * c) = o; }
    LDS_WAIT();
}
template <class RM>
__device__ __forceinline__ void tr_job(const Ctx& C, int& base, const float* W, int ldw, int K, int ncol0, int ncols, bf16_t* WT, int ldt, const RM& rm) {
    const int nblk = ncols / 64, items = (K / 64) * nblk; float* scr = (float*)(C.lds + C.wave * TR_SCR);
    int first = (C.gw - base % C.ngw + C.ngw) % C.ngw;
    for (int it = first; it < items; it += C.ngw) { const int kb = it / nblk, nb = it - kb * nblk; f32x4 v[16]; tr_load(W, ldw, 64 * kb, ncol0 + 64 * nb, v, C.lane); tr_flush(v, WT, ldt, 64 * kb, 64 * nb, rm, scr, C.lane); }
    base += items;
}
__device__ __forceinline__ void ph_convert_small(const Ctx& C, const Args& a, unsigned char* ws) {
    const float* w_in = (const float*)a.in[5]; int base = 0;
    bf16_t* WGIN = (bf16_t*)(ws + WS_WGIN);
    tr_job(C, base, w_in, 3104, 1024, 0, 1024, WGIN, 1024, MapId{0});
    tr_job(C, base, w_in, 3104, 1024, 1024, 1024, (bf16_t*)(ws + WS_WV), 1024, MapId{0});
    tr_job(C, base, w_in, 3104, 1024, 2048, 1024, WGIN, 1024, MapId{1024});
    tr_job(C, base, (const float*)a.in[11], 1024, 1024, 0, 1024, (bf16_t*)(ws + WS_WGOUT), 1024, MapId{0});
    tr_job(C, base, (const float*)a.in[12], 448, 1024, 0, 448, (bf16_t*)(ws + WS_WMIN), 1024, MapId{0});
    tr_job(C, base, (const float*)a.in[14], 3072, 256, 0, 3072, (bf16_t*)(ws + WS_WUQ), 256, MapUq{});
    tr_job(C, base, (const float*)a.in[16], 4096, 128, 0, 4096, (bf16_t*)(ws + WS_WUKV), 256, MapUkv{});
    tr_job(C, base, (const float*)a.in[17], 1024, 2048, 0, 1024, (bf16_t*)(ws + WS_WMOUT), 2048, MapId{0});
    const int gt = C.bid * 512 + C.tid, ngt = C.nb * 512;
    for (int it = gt; it < 1024 * 128; it += ngt) { const int cp = it >> 7, k8 = it & 127, dir = cp >> 9, c = cp & 511;
        const float* wg = (const float*)a.in[dir ? 8 : 6]; float wj[16];
#pragma unroll
        for (int j = 0; j < 16; ++j) wj[j] = wg[j * 512 + c];
        float o[8];
#pragma unroll
        for (int kk = 0; kk < 8; ++kk) { const float* wr = w_in + (size_t)(8 * k8 + kk) * 3104 + 3072 + 16 * dir; float s = 0.f;
#pragma unroll
            for (int j4 = 0; j4 < 4; ++j4) { const f32x4 x = *(const f32x4*)(wr + 4 * j4); s += x[0] * wj[4 * j4] + x[1] * wj[4 * j4 + 1] + x[2] * wj[4 * j4 + 2] + x[3] * wj[4 * j4 + 3]; }
            o[kk] = s; }
        u32x4 w; w.x = cvt_pk_bf16(o[0], o[1]); w.y = cvt_pk_bf16(o[2], o[3]); w.z = cvt_pk_bf16(o[4], o[5]); w.w = cvt_pk_bf16(o[6], o[7]);
        *(u32x4*)(WGIN + (size_t)(2048 + cp) * 1024 + 8 * k8) = w; }
    const u32x4 z = {0u, 0u, 0u, 0u};
    for (int it = gt; it < 64 * 128; it += ngt) *(u32x4*)((bf16_t*)(ws + WS_WMIN) + (size_t)448 * 1024 + (size_t)it * 8) = z;
    for (int it = gt; it < 16 * 64 * 32; it += ngt) { const int h = it >> 11, r = (it >> 5) & 63, c8 = it & 31; *(u32x4*)((bf16_t*)(ws + WS_WUQ) + (size_t)(256 * h + 192 + r) * 256 + c8 * 8) = z; }
    for (int it = gt; it < 4096 * 16; it += ngt) { const int r = it >> 4, c8 = it & 15; *(u32x4*)((bf16_t*)(ws + WS_WUKV) + (size_t)r * 256 + 128 + c8 * 8) = z; }
}
struct MapMoe { int kind; __device__ __forceinline__ int operator()(int f) const { return kind < 2 ? 8 * (f >> 2) + 4 * kind + (f & 3) : f; } };
struct MoeItem { const float* src; bf16_t* dst; int ldw, ldt, k0, n0, kind; };
__device__ __forceinline__ MoeItem moe_item(const Args& a, unsigned char* ws, int layer, int it) {
    const int e = it / 1536, r = it - e * 1536, which = r >> 9, j = r & 511; const size_t le = (size_t)(layer * NE + e); MoeItem m; m.kind = which;
    if (which < 2) { m.src = (const float*)a.in[19 + which] + le * 1024 * 2048; m.ldw = 2048; m.dst = (bf16_t*)(ws + WS_WGU) + (size_t)e * 4096 * 1024; m.ldt = 1024; m.k0 = 64 * (j >> 5); m.n0 = 64 * (j & 31); }
    else { m.src = (const float*)a.in[21] + le * 2048 * 1024; m.ldw = 1024; m.dst = (bf16_t*)(ws + WS_WD) + (size_t)e * 1024 * 2048; m.ldt = 2048; m.k0 = 64 * (j >> 4); m.n0 = 64 * (j & 15); }
    return m;
}
__device__ __forceinline__ void ph_convert_moe(const Ctx& C, const Args& a, unsigned char* ws, int layer, int rep) {
    constexpr int NIT1 = NE * 1536; const int NIT = NIT1 * rep; float* scr = (float*)(C.lds + C.wave * TR_SCR);
    int it = C.gw; if (it >= NIT) return;
    f32x4 va[16], vb[16]; MoeItem ma = moe_item(a, ws, layer, it % NIT1), mb = ma; tr_load(ma.src, ma.ldw, ma.k0, ma.n0, va, C.lane);
    for (;;) {
        int nx = it + C.ngw; if (nx < NIT) { mb = moe_item(a, ws, layer, nx % NIT1); tr_load(mb.src, mb.ldw, mb.k0, mb.n0, vb, C.lane); }
        tr_flush(va, ma.dst, ma.ldt, ma.k0, ma.n0, MapMoe{ma.kind}, scr, C.lane);
        it = nx; if (it >= NIT) break;
        nx = it + C.ngw; if (nx < NIT) { ma = moe_item(a, ws, layer, nx % NIT1); tr_load(ma.src, ma.ldw, ma.k0, ma.n0, va, C.lane); }
        tr_flush(vb, mb.dst, mb.ldt, mb.k0, mb.n0, MapMoe{mb.kind}, scr, C.lane);
        it = nx; if (it >= NIT) break;
    }
}

__device__ __forceinline__ void row_load(const float* row, int lane, f32x4 (&v)[4]) {
#pragma unroll
    for (int j = 0; j < 4; ++j) v[j] = *(const f32x4*)(row + 256 * j + 4 * lane); }
__device__ __forceinline__ float row_rstd(const f32x4 (&v)[4]) { float s = 0.f;
#pragma unroll
    for (int j = 0; j < 4; ++j) s += (v[j][0] * v[j][0] + v[j][1] * v[j][1]) + (v[j][2] * v[j][2] + v[j][3] * v[j][3]);
    return 1.0f / sqrtf(wave_sum(s) * (1.0f / 1024.0f) + RMS_EPS); }
__device__ __forceinline__ void row_store_bf(bf16_t* row, int lane, const f32x4 (&v)[4]) {
#pragma unroll
    for (int j = 0; j < 4; ++j) { u32x2 w; w.x = cvt_pk_bf16(v[j][0], v[j][1]); w.y = cvt_pk_bf16(v[j][2], v[j][3]); *(u32x2*)(row + 256 * j + 4 * lane) = w; } }

__device__ __forceinline__ void ph_norm(const Ctx& C, const float* src, const float* gain, bf16_t* XN) {
    f32x4 g[4]; row_load(gain, C.lane, g);
    for (int t = C.gw; t < T; t += C.ngw) { f32x4 v[4]; row_load(src + (size_t)t * D, C.lane, v); const float r = row_rstd(v);
#pragma unroll
        for (int j = 0; j < 4; ++j) v[j] = v[j] * r * g[j];
        row_store_bf(XN + (size_t)t * D, C.lane, v); }
}
__device__ __forceinline__ void ph_router(const Ctx& C, const float* Hin, const float* gain, const float* Wr, bf16_t* XN, float* AFF, float* AFFT) {
    f32x4* Wl = (f32x4*)C.lds;
    for (int idx = C.tid; idx < 4096; idx += 512) { const int l = idx & 63, e4 = (idx >> 6) & 3, i = (idx >> 8) & 3, j = idx >> 10; Wl[idx] = *(const f32x4*)(Wr + (size_t)(256 * j + 4 * l + i) * 16 + 4 * e4); }
    __syncthreads();
    f32x4 g[4]; row_load(gain, C.lane, g);
    for (int t = C.gw; t < T; t += C.ngw) {
        f32x4 v[4]; row_load(Hin + (size_t)t * D, C.lane, v); const float r = row_rstd(v);
#pragma unroll
        for (int j = 0; j < 4; ++j) v[j] = v[j] * r * g[j];
        row_store_bf(XN + (size_t)t * D, C.lane, v);
        float p[16];
#pragma unroll
        for (int e = 0; e < 16; ++e) p[e] = 0.f;
#pragma unroll
        for (int j = 0; j < 4; ++j)
#pragma unroll
            for (int i = 0; i < 4; ++i) { const float x = v[j][i];
#pragma unroll
                for (int e4 = 0; e4 < 4; ++e4) { const f32x4 w = Wl[((j * 4 + i) * 4 + e4) * 64 + C.lane]; p[4 * e4] += x * w[0]; p[4 * e4 + 1] += x * w[1]; p[4 * e4 + 2] += x * w[2]; p[4 * e4 + 3] += x * w[3]; } }
        float mx = -1e30f;
#pragma unroll
        for (int e = 0; e < 16; ++e) { p[e] = wave_sum(p[e]); mx = fmaxf(mx, p[e]); }
        float s = 0.f;
#pragma unroll
        for (int e = 0; e < 16; ++e) { p[e] = expf(p[e] - mx); s += p[e]; }
        const float inv = 1.0f / s; float mine = 0.f;
#pragma unroll
        for (int e = 0; e < 16; ++e) mine = (C.lane == e) ? p[e] * inv : mine;
        if (C.lane < 16) { AFF[(size_t)t * 16 + C.lane] = mine; AFFT[(size_t)C.lane * T + t] = mine; }
    }
    __syncthreads();
}
__device__ __forceinline__ void ph_select(const Ctx& C, const float* AFFT, int* SEL, int* IDX) {
    if (C.bid >= NE) return;
    const int e = C.bid; unsigned* vals = (unsigned*)C.lds; unsigned* hist = vals + T; unsigned* sh = hist + 256;
    for (int i = C.tid; i < T; i += 512) vals[i] = __float_as_uint(AFFT[(size_t)e * T + i]);
    __syncthreads();
    unsigned prefix = 0u, mask = 0u, remaining = CAP;
    for (int pass = 0; pass < 4; ++pass) { const int shift = 24 - 8 * pass;
        if (C.tid < 256) hist[C.tid] = 0u;
        __syncthreads();
        for (int i = C.tid; i < T; i += 512) { const unsigned v = vals[i]; if ((v & mask) == prefix) atomicAdd(&hist[(v >> shift) & 255u], 1u); }
        __syncthreads();
        if (C.wave == 0) {
            unsigned cb[4]; unsigned tl = 0u;
#pragma unroll
            for (int j = 0; j < 4; ++j) { cb[j] = hist[255 - (4 * C.lane + j)]; tl += cb[j]; }
            unsigned incl = tl;
#pragma unroll
            for (int o = 1; o < 64; o <<= 1) { const unsigned tt = __shfl_up(incl, o); if (C.lane >= o) incl += tt; }
            unsigned cum = incl - tl;
            if (cum < remaining && remaining <= incl) {
#pragma unroll
                for (int j = 0; j < 4; ++j) { if (cum < remaining && cum + cb[j] >= remaining) { sh[0] = (unsigned)(255 - (4 * C.lane + j)); sh[1] = remaining - cum; } cum += cb[j]; } } }
        __syncthreads();
        prefix |= sh[0] << shift; mask |= 255u << shift; remaining = sh[1];
        __syncthreads();
    }
    const unsigned thr = prefix, ntie = remaining;
    unsigned cg = 0u, ce = 0u;
    for (int i = 0; i < 32; ++i) { const unsigned v = vals[C.tid + 512 * i]; cg += v > thr; ce += v == thr; }
    unsigned sg = cg, se = ce;
#pragma unroll
    for (int o = 1; o < 64; o <<= 1) { const unsigned tg = __shfl_up(sg, o), te = __shfl_up(se, o); if (C.lane >= o) { sg += tg; se += te; } }
    if (C.lane == 63) { sh[16 + C.wave] = sg; sh[32 + C.wave] = se; }
    __syncthreads();
    unsigned og = 0u, oe = 0u, totg = 0u;
    for (int w = 0; w < 8; ++w) { const unsigned a = sh[16 + w], b = sh[32 + w]; if (w < C.wave) { og += a; oe += b; } totg += a; }
    unsigned pg = og + sg - cg, pe = oe + se - ce;
    for (int i = 0; i < 32; ++i) { const int t = C.tid + 512 * i; const unsigned v = vals[t]; int slot = -1;
        if (v > thr) slot = (int)pg++; else if (v == thr) { if (pe < ntie) slot = (int)(totg + pe); ++pe; }
        SEL[(size_t)t * 16 + e] = slot + 1; if (slot >= 0) IDX[e * CAP + slot] = t; }
}
__device__ __forceinline__ void ph_gather(const Ctx& C, const int* IDX, const bf16_t* XN, bf16_t* XS) {
    for (int r = C.gw; r < NE * CAP; r += C.ngw) { const int t = IDX[r]; const u32x4* s = (const u32x4*)(XN + (size_t)t * D); u32x4* d = (u32x4*)(XS + (size_t)r * D);
        const u32x4 a = s[C.lane], b = s[C.lane + 64]; d[C.lane] = a; d[C.lane + 64] = b; }
}
template <int MODE>
__device__ __forceinline__ void ph_combine(const Ctx& C, const float* Hin, const float* AFF, const int* SEL, const bf16_t* Y, float* Hout, const float* gain, bf16_t* XN, float* OUT) {
    f32x4 g[4]; row_load(gain, C.lane, g);
    for (int t = C.gw; t < T; t += C.ngw) {
        f32x4 v[4]; row_load(Hin + (size_t)t * D, C.lane, v);
        const int sel = SEL[(size_t)t * 16 + (C.lane & 15)]; const float af = AFF[(size_t)t * 16 + (C.lane & 15)];
#pragma unroll
        for (int e = 0; e < 16; ++e) { const int s = __builtin_amdgcn_readlane(sel, e);
            if (s) { const float a = __uint_as_float(__builtin_amdgcn_readlane(__float_as_uint(af), e)); const bf16_t* y = Y + ((size_t)e * CAP + (s - 1)) * D + 4 * C.lane;
#pragma unroll
                for (int j = 0; j < 4; ++j) { const u32x2 w = *(const u32x2*)(y + 256 * j); v[j][0] += a * bf_lo(w.x); v[j][1] += a * bf_hi(w.x); v[j][2] += a * bf_lo(w.y); v[j][3] += a * bf_hi(w.y); } } }
        if (MODE == 1) {
#pragma unroll
            for (int j = 0; j < 4; ++j) *(f32x4*)(Hout + (size_t)t * D + 256 * j + 4 * C.lane) = v[j]; }
        const float r = row_rstd(v);
#pragma unroll
        for (int j = 0; j < 4; ++j) v[j] = v[j] * r * g[j];
        if (MODE == 1) row_store_bf(XN + (size_t)t * D, C.lane, v);
        else {
#pragma unroll
            for (int j = 0; j < 4; ++j) *(f32x4*)(OUT + (size_t)t * D + 256 * j + 4 * C.lane) = v[j]; }
    }
}

#define MFMA32(a, b, c) __builtin_amdgcn_mfma_f32_32x32x16_bf16((a), (b), (c), 0, 0, 0)
__device__ __forceinline__ int crow(int r, int hi) { return (r & 3) + 8 * (r >> 2) + 4 * hi; }
__device__ __forceinline__ bf16x8 ldfrag(const bf16_t* p) { return *(const bf16x8*)p; }

__device__ __forceinline__ void ph_gla_prep(const Ctx& C, const bf16_t* Q0, const bf16_t* K0, const float* GF, const float* GB,
                                            bf16_t* QDF, bf16_t* QDB, bf16_t* KDF, bf16_t* KDB, bf16_t* KTF, bf16_t* KTB, float* EGL) {
    float* tot = (float*)C.lds;
    const int o = C.wave, l = C.lane; int par = 0;
    for (int c = C.bid; c < GNC; c += C.nb) { const int t0 = c * GC + 8 * o;
        for (int cb = 0; cb < 8; ++cb, par ^= 1) { const int ch = cb * 64 + l; const size_t off0 = (size_t)t0 * 512 + ch;
            float gf[8], gb[8], q[8], k[8];
#pragma unroll
            for (int i = 0; i < 8; ++i) { const size_t of = off0 + (size_t)i * 512; gf[i] = GF[of]; gb[i] = GB[of]; q[i] = bf2f(Q0[of]); k[i] = bf2f(K0[of]); }
            float sf = 0.f, sb = 0.f;
#pragma unroll
            for (int i = 0; i < 8; ++i) { sf += gf[i]; gf[i] = sf; }
#pragma unroll
            for (int i = 7; i >= 0; --i) { sb += gb[i]; gb[i] = sb; }
            float* tp = tot + par * 1024; tp[o * 64 + l] = sf; tp[512 + o * 64 + l] = sb;
            __syncthreads();
            float offf = 0.f, offb = 0.f, allf = 0.f, allb = 0.f;
#pragma unroll
            for (int oo = 0; oo < 8; ++oo) { const float a = tp[oo * 64 + l], b = tp[512 + oo * 64 + l]; offf += (oo < o) ? a : 0.f; offb += (oo > o) ? b : 0.f; allf += a; allb += b; }
            unsigned pf[4], pb[4];
#pragma unroll
            for (int i = 0; i < 8; i += 2) { float kdf[2], kdb[2];
#pragma unroll
                for (int u = 0; u < 2; ++u) { const size_t of = off0 + (size_t)(i + u) * 512; const float ef = __expf(offf + gf[i + u]), eb = __expf(offb + gb[i + u]);
                    kdf[u] = k[i + u] * __builtin_amdgcn_rcpf(ef); kdb[u] = k[i + u] * __builtin_amdgcn_rcpf(eb);
                    QDF[of] = f2bf(q[i + u] * ef); QDB[of] = f2bf(q[i + u] * eb); KDF[of] = f2bf(kdf[u]); KDB[of] = f2bf(kdb[u]); }
                pf[i >> 1] = cvt_pk_bf16(kdf[0], kdf[1]); pb[i >> 1] = cvt_pk_bf16(kdb[0], kdb[1]); }
            *(u32x4*)(KTF + (size_t)ch * T + t0) = (u32x4){pf[0], pf[1], pf[2], pf[3]};
            *(u32x4*)(KTB + (size_t)ch * T + t0) = (u32x4){pb[0], pb[1], pb[2], pb[3]};
            if (o == 0) { EGL[(size_t)c * 512 + ch] = __expf(allf); EGL[(size_t)(GNC + c) * 512 + ch] = __expf(allb); }
        }
    }
    __syncthreads();
}
__device__ __forceinline__ void ph_gla_u(const Ctx& C, const bf16_t* VT, const bf16_t* KTF, const bf16_t* KTB, const float* EGL, bf16_t* U) {
    const int r = C.lane & 31, hh = C.lane >> 5;
    for (int it = C.gw; it < 2 * GH * GNC * 8; it += C.ngw) { const int w = it & 7, unit = it >> 3, c = unit % GNC, h = (unit / GNC) % GH, dir = unit / (GNC * GH); const int t0 = c * GC;
        const bf16_t* KT = dir ? KTB : KTF; const bf16_t* ap = VT + (size_t)(256 * h + 32 * w + r) * T + t0 + 8 * hh;
        bf16x8 a[4];
#pragma unroll
        for (int s = 0; s < 4; ++s) a[s] = ldfrag(ap + 16 * s);
        bf16_t* Ub = U + ((size_t)(dir * GH + h) * GNC + c) * (GDV * GDK);
#pragma unroll
        for (int j = 0; j < 4; ++j) { f32x16 acc = {}; const bf16_t* bp = KT + (size_t)(128 * h + 32 * j + r) * T + t0 + 8 * hh;
#pragma unroll
            for (int s = 0; s < 4; ++s) acc = MFMA32(a[s], ldfrag(bp + 16 * s), acc);
            const float eg = EGL[(size_t)(dir * GNC + c) * 512 + 128 * h + 32 * j + r];
#pragma unroll
            for (int q = 0; q < 16; ++q) Ub[(size_t)(32 * w + crow(q, hh)) * GDK + 32 * j + r] = f2bf(acc[q] * eg); }
    }
}
__device__ __forceinline__ void ph_gla_scan(const Ctx& C, const bf16_t* U, const float* EGL, bf16_t* ST) {
    if (C.tid >= 256) return;
    for (int el = C.bid * 256 + C.tid; el < 2 * GH * GDV * (GDK / 4); el += C.nb * 256) { const int dk4 = el & 31, dv = (el >> 5) & 255, h = (el >> 13) & 3, dir = el >> 15;
        const size_t eb = (size_t)(dir * GH + h) * GNC * (GDV * GDK) + (size_t)dv * GDK + 4 * dk4; const float* eg = EGL + (size_t)dir * GNC * 512 + 128 * h + 4 * dk4;
        float s0 = 0.f, s1 = 0.f, s2 = 0.f, s3 = 0.f;
#pragma unroll 16
        for (int i = 0; i < GNC; ++i) { const int c = dir ? GNC - 1 - i : i; const size_t o = eb + (size_t)c * (GDV * GDK);
            const u32x2 u = *(const u32x2*)(U + o); const f32x4 d = *(const f32x4*)(eg + (size_t)c * 512);
            u32x2 w; w.x = cvt_pk_bf16(s0, s1); w.y = cvt_pk_bf16(s2, s3); *(u32x2*)(ST + o) = w;
            s0 = d[0] * s0 + bf_lo(u.x); s1 = d[1] * s1 + bf_hi(u.x); s2 = d[2] * s2 + bf_lo(u.y); s3 = d[3] * s3 + bf_hi(u.y); }
    }
}
__device__ __forceinline__ void ph_gla_out(const Ctx& C, const bf16_t* QDF, const bf16_t* QDB, const bf16_t* KDF, const bf16_t* KDB, const bf16_t* VT, const bf16_t* ST,
                                           const bf16_t* SR, const float* hnorm, bf16_t* OG) {
    constexpr int ACS = 72;
    bf16_t* AC = (bf16_t*)C.lds; float* SSQ = (float*)(C.lds + 64 * ACS * 2);
    const int w = C.wave, r = C.lane & 31, hh = C.lane >> 5;
    for (int unit = C.bid; unit < GH * GNC; unit += C.nb) { const int h = unit / GNC, c = unit % GNC, t0 = c * GC;
        {
            const int dir = w >> 2, ti = (w >> 1) & 1, si = w & 1;
            if (!((dir == 0 && ti == 0 && si == 1) || (dir == 1 && ti == 1 && si == 0))) {
                const bf16_t* qp = (dir ? QDB : QDF) + (size_t)(t0 + 32 * ti + r) * 512 + 128 * h + 8 * hh; const bf16_t* kp = (dir ? KDB : KDF) + (size_t)(t0 + 32 * si + r) * 512 + 128 * h + 8 * hh;
                f32x16 acc = {};
#pragma unroll
                for (int s = 0; s < 8; ++s) acc = MFMA32(ldfrag(qp + 16 * s), ldfrag(kp + 16 * s), acc);
#pragma unroll
                for (int q = 0; q < 16; ++q) { const int tl = 32 * ti + crow(q, hh), sl = 32 * si + r; const bool keep = dir ? (sl > tl) : (sl <= tl); if (keep) AC[tl * ACS + sl] = f2bf(acc[q]); }
            }
        }
        __syncthreads();
        f32x16 o0 = {}, o1 = {};
#pragma unroll
        for (int dir = 0; dir < 2; ++dir) { const bf16_t* qp = (dir ? QDB : QDF) + (size_t)(t0 + r) * 512 + 128 * h + 8 * hh;
            const bf16_t* sp = ST + ((size_t)(dir * GH + h) * GNC + c) * (GDV * GDK) + (size_t)(32 * w + r) * GDK + 8 * hh;
#pragma unroll
            for (int s = 0; s < 8; ++s) { const bf16x8 b = ldfrag(sp + 16 * s); o0 = MFMA32(ldfrag(qp + 16 * s), b, o0); o1 = MFMA32(ldfrag(qp + 32 * 512 + 16 * s), b, o1); } }
        { const bf16_t* vp = VT + (size_t)(256 * h + 32 * w + r) * T + t0 + 8 * hh;
#pragma unroll
            for (int s = 0; s < 4; ++s) { const bf16x8 b = ldfrag(vp + 16 * s); o0 = MFMA32(ldfrag(AC + r * ACS + 16 * s + 8 * hh), b, o0); o1 = MFMA32(ldfrag(AC + (32 + r) * ACS + 16 * s + 8 * hh), b, o1); } }
#pragma unroll
        for (int q = 0; q < 16; ++q) { float a = o0[q] * o0[q], b = o1[q] * o1[q];
#pragma unroll
            for (int of = 1; of < 32; of <<= 1) { a += __shfl_xor(a, of); b += __shfl_xor(b, of); }
            if (r == 0) { SSQ[w * 64 + crow(q, hh)] = a; SSQ[w * 64 + 32 + crow(q, hh)] = b; } }
        __syncthreads();
        const float gn = hnorm[32 * w + r];
#pragma unroll
        for (int q = 0; q < 16; ++q) { const int tl = crow(q, hh); float sa = 0.f, sb = 0.f;
#pragma unroll
            for (int ww = 0; ww < 8; ++ww) { sa += SSQ[ww * 64 + tl]; sb += SSQ[ww * 64 + 32 + tl]; }
            const float ra = 1.0f / sqrtf(sa * (1.0f / 256.0f) + RMS_EPS), rb = 1.0f / sqrtf(sb * (1.0f / 256.0f) + RMS_EPS);
            const size_t oa = (size_t)(t0 + tl) * 1024 + 256 * h + 32 * w + r, ob = oa + 32 * 1024;
            OG[oa] = f2bf(o0[q] * ra * gn * bf2f(SR[oa])); OG[ob] = f2bf(o1[q] * rb * gn * bf2f(SR[ob])); }
        __syncthreads();
    }
}

__device__ __forceinline__ void ph_mla_tok(const Ctx& C, const float* CIN, const int* pos, const float* qn, const float* kvn, const float* invf, bf16_t* CQN, bf16_t* CKVN, float* CS, bf16_t* K) {
    const int l = C.lane;
    f32x4 g0, g1;
    if (l < 32) { g0 = *(const f32x4*)(qn + 8 * l); g1 = *(const f32x4*)(qn + 8 * l + 4); }
    else if (l < 48) { g0 = *(const f32x4*)(kvn + 8 * (l - 32)); g1 = *(const f32x4*)(kvn + 8 * (l - 32) + 4); }
    else { g0 = (f32x4){1.f, 1.f, 1.f, 1.f}; g1 = g0; }
    const float fr = invf[l & 31];
    for (int t = C.gw; t < T; t += C.ngw) {
        const float* row = CIN + (size_t)t * 512; const f32x4 a = *(const f32x4*)(row + 8 * l), b = *(const f32x4*)(row + 8 * l + 4);
        const float ss = (a[0] * a[0] + a[1] * a[1]) + (a[2] * a[2] + a[3] * a[3]) + (b[0] * b[0] + b[1] * b[1]) + (b[2] * b[2] + b[3] * b[3]);
        const float sq = wave_sum(l < 32 ? ss : 0.f), sk = wave_sum((l >= 32 && l < 48) ? ss : 0.f);
        const float rq = 1.0f / sqrtf(sq * (1.0f / 256.0f) + RMS_EPS), rk = 1.0f / sqrtf(sk * (1.0f / 128.0f) + RMS_EPS);
        const float ang = (float)pos[t] * fr; const double rev = (double)ang * 0.15915494309189533577; const float fr01 = (float)(rev - rint(rev));
        const float cv = __builtin_amdgcn_cosf(fr01), sv = __builtin_amdgcn_sinf(fr01);
        if (l < 32) { CS[(size_t)t * 64 + l] = cv; CS[(size_t)t * 64 + 32 + l] = sv; }
        if (l < 32) store8bf(CQN + (size_t)t * 256 + 8 * l, a * rq * g0, b * rq * g1);
        else if (l < 48) store8bf(CKVN + (size_t)t * 256 + 8 * (l - 32), a * rk * g0, b * rk * g1);
        else { const u32x4 z = {0u, 0u, 0u, 0u}; *(u32x4*)(CKVN + (size_t)t * 256 + 128 + 8 * (l - 48)) = z; }
        f32x4 xa = a, xb = b;
        f32x4 pa, pb;
#pragma unroll
        for (int j = 0; j < 4; ++j) { pa[j] = __shfl(xa[j], (l + 4) & 63); pb[j] = __shfl(xb[j], (l + 4) & 63); }
        f32x4 c0, c1, s0, s1;
#pragma unroll
        for (int j = 0; j < 4; ++j) { const int i = 8 * (l & 3) + j; c0[j] = __shfl(cv, i); c1[j] = __shfl(cv, i + 4); s0[j] = __shfl(sv, i); s1[j] = __shfl(sv, i + 4); }
        if (l >= 48 && l < 52) {
            const f32x4 o1a = xa * c0 - pa * s0, o2a = xa * s0 + pa * c0, o1b = xb * c1 - pb * s1, o2b = xb * s1 + pb * c1;
            u32x4 w0, w1; w0.x = cvt_pk_bf16(o1a[0], o1a[1]); w0.y = cvt_pk_bf16(o1a[2], o1a[3]); w0.z = cvt_pk_bf16(o2a[0], o2a[1]); w0.w = cvt_pk_bf16(o2a[2], o2a[3]);
            w1.x = cvt_pk_bf16(o1b[0], o1b[1]); w1.y = cvt_pk_bf16(o1b[2], o1b[3]); w1.z = cvt_pk_bf16(o2b[0], o2b[1]); w1.w = cvt_pk_bf16(o2b[2], o2b[3]);
            if (ATT_FP8) { u32x4 w8; w8.x = pk4fp8(o1a[0], o1a[1], o1a[2], o1a[3]); w8.y = pk4fp8(o2a[0], o2a[1], o2a[2], o2a[3]); w8.z = pk4fp8(o1b[0], o1b[1], o1b[2], o1b[3]); w8.w = pk4fp8(o2b[0], o2b[1], o2b[2], o2b[3]);
#pragma unroll
                for (int h = 0; h < MH; ++h) *(u32x4*)((unsigned char*)K + ((size_t)h * T + t) * MDK + 128 + 16 * (l & 3)) = w8; }
            else {
#pragma unroll
            for (int h = 0; h < MH; ++h) { bf16_t* kp = K + ((size_t)h * T + t) * MDK + 128 + 16 * (l & 3); *(u32x4*)kp = w0; *(u32x4*)(kp + 8) = w1; } }
        }
    }
}

namespace att {
constexpr int NW = 8, QBLK = 32, KVBLK = 64;
#ifndef ATT_PVSPLIT
#define ATT_PVSPLIT 0
#endif
#ifndef ATT_SDEPTH
#define ATT_SDEPTH 1
#endif
constexpr int SDEPTH = ATT_SDEPTH;
constexpr float THR2 = 11.5f;
constexpr int SHM_V = KVBLK * MDV * 2, SHM_K = KVBLK * 400, SHM_ATTN = 2 * SHM_V + 2 * SHM_K + NW * 64 * 4;
#define KSWZ(row, colB) ((row) * 400 + (colB))
#define SBAR() __builtin_amdgcn_sched_barrier(0)
__device__ __forceinline__ unsigned cvtpk(float lo, float hi) { unsigned r; asm volatile("v_cvt_pk_bf16_f32 %0, %1, %2" : "=v"(r) : "v"(lo), "v"(hi)); return r; }
__device__ __forceinline__ void partialSM(f32x16& p0, f32x16& p1, float& m_reg, float& mn, float& alpha) {
  float pmax = p0[0];
#pragma unroll
  for (int r = 1; r < 16; ++r) pmax = fmaxf(pmax, p0[r]);
#pragma unroll
  for (int r = 0; r < 16; ++r) pmax = fmaxf(pmax, p1[r]);
  { auto rr = __builtin_amdgcn_permlane32_swap(__float_as_uint(pmax), __float_as_uint(pmax), false, false);
    pmax = fmaxf(__uint_as_float(rr[0]), __uint_as_float(rr[1])); }
  if (__builtin_expect(__all(pmax - m_reg <= THR2), 1)) { mn = m_reg; alpha = 1.f; }
  else { mn = fmaxf(m_reg, pmax); alpha = __builtin_amdgcn_exp2f(m_reg - mn); m_reg = mn; }
#pragma unroll
  for (int r = 0; r < 16; ++r) p0[r] = p0[r] - mn;
#pragma unroll
  for (int r = 0; r < 16; ++r) p1[r] = p1[r] - mn;
#pragma unroll
  for (int r = 0; r < 16; ++r) p0[r] = __builtin_amdgcn_exp2f(p0[r]);
}
__device__ __forceinline__ void finishSM(f32x16& p0, f32x16& p1, float alpha, float& l_reg, bf16x8& pa0, bf16x8& pa1, bf16x8& pa2, bf16x8& pa3) {
#pragma unroll
  for (int r = 0; r < 16; ++r) p1[r] = __builtin_amdgcn_exp2f(p1[r]);
  float ps = 0;
#pragma unroll
  for (int r = 0; r < 16; ++r) ps += p0[r];
#pragma unroll
  for (int r = 0; r < 16; ++r) ps += p1[r];
  { auto rr = __builtin_amdgcn_permlane32_swap(__float_as_uint(ps), __float_as_uint(ps), false, false);
    ps = __uint_as_float(rr[0]) + __uint_as_float(rr[1]); }
  l_reg = l_reg * alpha + ps;
#define PK4(P, BASE, OUT) do { unsigned a0 = cvtpk(P[BASE + 0], P[BASE + 1]), a1 = cvtpk(P[BASE + 2], P[BASE + 3]);   \
    unsigned b0 = cvtpk(P[BASE + 4], P[BASE + 5]), b1 = cvtpk(P[BASE + 6], P[BASE + 7]);                              \
    auto r0 = __builtin_amdgcn_permlane32_swap(a0, b0, false, false); auto r1 = __builtin_amdgcn_permlane32_swap(a1, b1, false, false); \
    u32x4 w = {r0[0], r1[0], r0[1], r1[1]}; OUT = *reinterpret_cast<bf16x8*>(&w); } while (0)
  PK4(p0, 0, pa0); PK4(p0, 8, pa1); PK4(p1, 0, pa2); PK4(p1, 8, pa3);
#undef PK4
}
__device__ __forceinline__ void qkt(f32x16& p0, f32x16& p1, const char* Ks, const bf16x8* qr, int r32, int hi) {
  p0 = f32x16{}; p1 = f32x16{};
#pragma unroll
  for (int d0 = 0; d0 < 12; ++d0) { const int cb = (d0 * 16 + hi * 8) * 2;
    const bf16x8 b0 = *reinterpret_cast<const bf16x8*>(Ks + KSWZ(r32, cb));
    const bf16x8 b1 = *reinterpret_cast<const bf16x8*>(Ks + KSWZ(32 + r32, cb));
    p0 = __builtin_amdgcn_mfma_f32_32x32x16_bf16(b0, qr[d0], p0, 0, 0, 0);
    p1 = __builtin_amdgcn_mfma_f32_32x32x16_bf16(b1, qr[d0], p1, 0, 0, 0); }
}
__device__ __forceinline__ int v_st(int k, int c) { const int kk = (k & ~0xC) | ((k & 4) << 1) | ((k & 8) >> 1); return ((kk >> 3) * 4 + (c >> 5)) * 512 + ((kk & 7) * 32 + (c & 31)) * 2; }
__device__ __forceinline__ int v_rd_base(int lane) { return ((lane & 3) << 3) | (((lane >> 2) & 3) << 6) | (((lane >> 4) & 1) << 5) | (((lane >> 5) & 1) << 8); }
constexpr int v_rd_off(int d0, int ks, int half) { return d0 * 512 + ks * 4096 + half * 2048; }
template <int OFF> __device__ __forceinline__ s16x4 tr_read(int vb) {
  s16x4 r; asm volatile("ds_read_b64_tr_b16 %0, %1 offset:%2" : "=&v"(r) : "v"(vb), "i"(OFF) : "memory"); return r;
}
template <int D0> __device__ __forceinline__ void pv_one(f32x16& od, int vb, bf16x8 pa0, bf16x8 pa1, bf16x8 pa2, bf16x8 pa3) {
#if ATT_PVSPLIT
#define PK(L, H) (bf16x8){L[0], L[1], L[2], L[3], H[0], H[1], H[2], H[3]}
  { const s16x4 l0 = tr_read<v_rd_off(D0, 0, 0)>(vb), h0 = tr_read<v_rd_off(D0, 0, 1)>(vb), l1 = tr_read<v_rd_off(D0, 1, 0)>(vb), h1 = tr_read<v_rd_off(D0, 1, 1)>(vb);
    asm volatile("s_waitcnt lgkmcnt(0)" ::: "memory"); SBAR();
    od = __builtin_amdgcn_mfma_f32_32x32x16_bf16(pa0, PK(l0, h0), od, 0, 0, 0);
    od = __builtin_amdgcn_mfma_f32_32x32x16_bf16(pa1, PK(l1, h1), od, 0, 0, 0); }
  { const s16x4 l2 = tr_read<v_rd_off(D0, 2, 0)>(vb), h2 = tr_read<v_rd_off(D0, 2, 1)>(vb), l3 = tr_read<v_rd_off(D0, 3, 0)>(vb), h3 = tr_read<v_rd_off(D0, 3, 1)>(vb);
    asm volatile("s_waitcnt lgkmcnt(0)" ::: "memory"); SBAR();
    od = __builtin_amdgcn_mfma_f32_32x32x16_bf16(pa2, PK(l2, h2), od, 0, 0, 0);
    od = __builtin_amdgcn_mfma_f32_32x32x16_bf16(pa3, PK(l3, h3), od, 0, 0, 0); }
#undef PK
#else
  const s16x4 l0 = tr_read<v_rd_off(D0, 0, 0)>(vb), h0 = tr_read<v_rd_off(D0, 0, 1)>(vb), l1 = tr_read<v_rd_off(D0, 1, 0)>(vb), h1 = tr_read<v_rd_off(D0, 1, 1)>(vb);
  const s16x4 l2 = tr_read<v_rd_off(D0, 2, 0)>(vb), h2 = tr_read<v_rd_off(D0, 2, 1)>(vb), l3 = tr_read<v_rd_off(D0, 3, 0)>(vb), h3 = tr_read<v_rd_off(D0, 3, 1)>(vb);
  asm volatile("s_waitcnt lgkmcnt(0)" ::: "memory"); SBAR();
#define PK(L, H) (bf16x8){L[0], L[1], L[2], L[3], H[0], H[1], H[2], H[3]}
  od = __builtin_amdgcn_mfma_f32_32x32x16_bf16(pa0, PK(l0, h0), od, 0, 0, 0);
  od = __builtin_amdgcn_mfma_f32_32x32x16_bf16(pa1, PK(l1, h1), od, 0, 0, 0);
  od = __builtin_amdgcn_mfma_f32_32x32x16_bf16(pa2, PK(l2, h2), od, 0, 0, 0);
  od = __builtin_amdgcn_mfma_f32_32x32x16_bf16(pa3, PK(l3, h3), od, 0, 0, 0);
#undef PK
#endif
}
__device__ __forceinline__ void pv_d0(f32x16* o, int vb, bf16x8 pa0, bf16x8 pa1, bf16x8 pa2, bf16x8 pa3) {
  pv_one<0>(o[0], vb, pa0, pa1, pa2, pa3); pv_one<1>(o[1], vb, pa0, pa1, pa2, pa3); pv_one<2>(o[2], vb, pa0, pa1, pa2, pa3); pv_one<3>(o[3], vb, pa0, pa1, pa2, pa3);
}
__device__ __forceinline__ void attn_body(const bf16_t* __restrict__ Qb, const bf16_t* __restrict__ Kh, const bf16_t* __restrict__ Vh, bf16_t* __restrict__ Ob, int ldo, int seq, char* lds) {
  const int tid = threadIdx.x, wid = tid >> 6, lane = tid & 63, r32 = lane & 31, hi = lane >> 5;
  char* V_lds = lds; char* K_lds = lds + 2 * SHM_V;
  float* ws = (float*)(lds + 2 * SHM_V + 2 * SHM_K) + wid * 64; float* li_l = ws; float* al_l = ws + 32;
  float m_reg = -1e30f, l_reg = 0; f32x16 o[4] = {}; bf16x8 qr[12];
  const bf16_t* Qw = Qb + (size_t)(wid * QBLK + r32) * MDK + hi * 8;
#pragma unroll
  for (int d0 = 0; d0 < 12; ++d0) qr[d0] = *reinterpret_cast<const bf16x8*>(Qw + d0 * 16);
  const int sr = tid >> 4, sc = (tid & 15) * 8, vst0 = v_st(sr, sc), vst1 = v_st(32 + sr, sc);
  int kst[3];
#pragma unroll
  for (int i = 0; i < 3; ++i) { const int ck = tid + 512 * i, row = ck / 24, cc = ck - row * 24; kst[i] = KSWZ(row, cc * 16); }
  const int vb0 = (int)(uintptr_t)V_lds + v_rd_base(lane);
  const unsigned vo0 = (unsigned)(sr * MDV + sc), ko0 = (unsigned)(tid * 8);
  struct { bf16x8 vs0, vs1, ks0, ks1, ks2; } sr_[SDEPTH];
#define SLOAD(i, k0) do { const bf16_t* vt_ = Vh + (size_t)(k0) * MDV; const bf16_t* kt_ = Kh + (size_t)(k0) * MDK;                                         \
    sr_[i].vs0 = *reinterpret_cast<const bf16x8*>(vt_ + vo0); sr_[i].vs1 = *reinterpret_cast<const bf16x8*>(vt_ + 32 * MDV + vo0);                               \
    sr_[i].ks0 = *reinterpret_cast<const bf16x8*>(kt_ + ko0); sr_[i].ks1 = *reinterpret_cast<const bf16x8*>(kt_ + 4096 + ko0); sr_[i].ks2 = *reinterpret_cast<const bf16x8*>(kt_ + 8192 + ko0); } while (0)
#define SWRITE(b, i) do { *(bf16x8*)(V_lds + (b) * SHM_V + vst0) = sr_[i].vs0; *(bf16x8*)(V_lds + (b) * SHM_V + vst1) = sr_[i].vs1;               \
    *(bf16x8*)(K_lds + (b) * SHM_K + kst[0]) = sr_[i].ks0; *(bf16x8*)(K_lds + (b) * SHM_K + kst[1]) = sr_[i].ks1; *(bf16x8*)(K_lds + (b) * SHM_K + kst[2]) = sr_[i].ks2; } while (0)
#define SWAIT() do { if constexpr (SDEPTH == 2) asm volatile("s_waitcnt vmcnt(5)" ::: "memory"); else asm volatile("s_waitcnt vmcnt(0)" ::: "memory"); } while (0)
#define RESC(a) do { if (__any((a) < 1.f)) { if (hi == 0) al_l[r32] = (a); asm volatile("s_waitcnt lgkmcnt(0)" ::: "memory"); \
    _Pragma("unroll") for (int d = 0; d < 4; ++d) _Pragma("unroll") for (int r = 0; r < 16; ++r) o[d][r] *= al_l[crow(r, hi)]; } } while (0)
  f32x16 pA0, pA1, pB0, pB1; float mnA, mnB, alA, alB; bf16x8 pa0, pa1, pa2, pa3; const int NT = seq / KVBLK;
  constexpr int SE = 0, SO = SDEPTH - 1;
  SLOAD(SE, 0); asm volatile("s_waitcnt vmcnt(0)" ::: "memory"); SWRITE(0, SE); __syncthreads();
  qkt(pA0, pA1, K_lds, qr, r32, hi); partialSM(pA0, pA1, m_reg, mnA, alA);
  SLOAD(SO, KVBLK); if constexpr (SDEPTH == 2) { if (2 < NT) SLOAD(SE, 2 * KVBLK); }
  SWAIT(); SWRITE(1, SO); __syncthreads();
  for (int j = 1; j + 1 < NT; j += 2) {
    SBAR(); qkt(pB0, pB1, K_lds + SHM_K, qr, r32, hi);
    finishSM(pA0, pA1, alA, l_reg, pa0, pa1, pa2, pa3); SBAR();
    SLOAD(SO, (j + SDEPTH) * KVBLK); SBAR();
    pv_d0(o, vb0, pa0, pa1, pa2, pa3); partialSM(pB0, pB1, m_reg, mnB, alB);
    __syncthreads(); SWAIT(); SWRITE(0, SE);
    RESC(alB); __syncthreads();
    SBAR(); qkt(pA0, pA1, K_lds, qr, r32, hi);
    finishSM(pB0, pB1, alB, l_reg, pa0, pa1, pa2, pa3); SBAR();
    if (SDEPTH == 1 || j + 3 < NT) SLOAD(SE, (j + 1 + SDEPTH) * KVBLK); SBAR();
    pv_d0(o, vb0 + SHM_V, pa0, pa1, pa2, pa3); partialSM(pA0, pA1, m_reg, mnA, alA);
    __syncthreads(); SWAIT(); SWRITE(1, SO);
    RESC(alA); __syncthreads();
  }
  SBAR(); qkt(pB0, pB1, K_lds + SHM_K, qr, r32, hi);
  finishSM(pA0, pA1, alA, l_reg, pa0, pa1, pa2, pa3); SBAR();
  pv_d0(o, vb0, pa0, pa1, pa2, pa3); partialSM(pB0, pB1, m_reg, mnB, alB);
  __syncthreads(); RESC(alB);
  finishSM(pB0, pB1, alB, l_reg, pa0, pa1, pa2, pa3); SBAR();
  pv_d0(o, vb0 + SHM_V, pa0, pa1, pa2, pa3);
  if (hi == 0) li_l[r32] = l_reg; asm volatile("s_waitcnt lgkmcnt(0)" ::: "memory");
  float rli[16];
#pragma unroll
  for (int r = 0; r < 16; ++r) rli[r] = __builtin_amdgcn_rcpf(li_l[crow(r, hi)]);
  bf16_t* Ow = Ob + (size_t)(wid * QBLK) * ldo;
#pragma unroll
  for (int r = 0; r < 16; ++r) { const int orow = crow(r, hi);
#pragma unroll
    for (int d0 = 0; d0 < 4; ++d0) Ow[(size_t)orow * ldo + d0 * 32 + r32] = f2bf(o[d0][r] * rli[r]); }
#undef SLOAD
#undef SWRITE
#undef SWAIT
#undef RESC
}
}


namespace att8 {
constexpr int NW = 8, QBLK = 32, KVBLK = 64, KST = 208, VST = 80;
#ifndef ATT8_SDEPTH
#define ATT8_SDEPTH 1
#endif
constexpr int SDEPTH = ATT8_SDEPTH;
constexpr float THR8 = 64.f;
constexpr int SHM_K = KVBLK * KST, SHM_V = MDV * VST, SHM_ATTN = 2 * SHM_K + 2 * SHM_V + NW * 64 * 4;
#define SBAR() __builtin_amdgcn_sched_barrier(0)
#define MFMA8(a, b, c) __builtin_amdgcn_mfma_scale_f32_32x32x64_f8f6f4((a), (b), (c), 0, 0, 0, 0x7f7f7f7f, 0, 0x7f7f7f7f)
__device__ __forceinline__ i32x8 ld32(const char* p) { const u32x4 a = *(const u32x4*)p, b = *(const u32x4*)(p + 16); return (i32x8){(int)a.x, (int)a.y, (int)a.z, (int)a.w, (int)b.x, (int)b.y, (int)b.z, (int)b.w}; }
__device__ __forceinline__ void partialSM(f32x16& p0, f32x16& p1, float& m_reg, float& mn, float& alpha) {
  float pmax = p0[0];
#pragma unroll
  for (int r = 1; r < 16; ++r) pmax = fmaxf(pmax, p0[r]);
#pragma unroll
  for (int r = 0; r < 16; ++r) pmax = fmaxf(pmax, p1[r]);
  { auto rr = __builtin_amdgcn_permlane32_swap(__float_as_uint(pmax), __float_as_uint(pmax), false, false);
    pmax = fmaxf(__uint_as_float(rr[0]), __uint_as_float(rr[1])); }
  if (__builtin_expect(__all(pmax - m_reg <= THR8), 1)) { mn = m_reg; alpha = 1.f; }
  else { mn = fmaxf(m_reg, pmax); alpha = __builtin_amdgcn_exp2f((m_reg - mn) * 0.125f); m_reg = mn; }
  const float mnC = -0.125f * mn;
#pragma unroll
  for (int r = 0; r < 16; ++r) p0[r] = fmaf(p0[r], 0.125f, mnC);
#pragma unroll
  for (int r = 0; r < 16; ++r) p1[r] = fmaf(p1[r], 0.125f, mnC);
#pragma unroll
  for (int r = 0; r < 16; ++r) p0[r] = __builtin_amdgcn_exp2f(p0[r]);
}
__device__ __forceinline__ void finishSM(f32x16& p0, f32x16& p1, float alpha, float& l_reg, i32x8& pa) {
#pragma unroll
  for (int r = 0; r < 16; ++r) p1[r] = __builtin_amdgcn_exp2f(p1[r]);
  float ps = 0;
#pragma unroll
  for (int r = 0; r < 16; ++r) ps += p0[r];
#pragma unroll
  for (int r = 0; r < 16; ++r) ps += p1[r];
  { auto rr = __builtin_amdgcn_permlane32_swap(__float_as_uint(ps), __float_as_uint(ps), false, false);
    ps = __uint_as_float(rr[0]) + __uint_as_float(rr[1]); }
  l_reg = l_reg * alpha + ps;
#pragma unroll
  for (int j = 0; j < 4; ++j) { pa[j] = (int)pk4fp8(p0[4 * j], p0[4 * j + 1], p0[4 * j + 2], p0[4 * j + 3]); pa[4 + j] = (int)pk4fp8(p1[4 * j], p1[4 * j + 1], p1[4 * j + 2], p1[4 * j + 3]); }
}
__device__ __forceinline__ void qkt(f32x16& p0, f32x16& p1, const char* Ks, const i32x8* qr, int r32, int hi) {
  p0 = f32x16{}; p1 = f32x16{};
  const char* k0 = Ks + r32 * KST + hi * 32;
#pragma unroll
  for (int s = 0; s < 3; ++s) { const i32x8 a0 = ld32(k0 + 64 * s), a1 = ld32(k0 + 32 * KST + 64 * s);
    p0 = MFMA8(a0, qr[s], p0); p1 = MFMA8(a1, qr[s], p1); }
}
__device__ __forceinline__ void pv(f32x16* o, const char* Vs, const i32x8 pa, int r32, int hi) {
  const char* v0 = Vs + r32 * VST + hi * 32;
#pragma unroll
  for (int d0 = 0; d0 < 4; ++d0) { const i32x8 b = ld32(v0 + d0 * 32 * VST); o[d0] = MFMA8(pa, b, o[d0]); }
}
__device__ __forceinline__ void attn_body(const unsigned char* __restrict__ Qb, const unsigned char* __restrict__ Kh, const unsigned char* __restrict__ Vt, bf16_t* __restrict__ Ob, int ldo, int seq, char* lds) {
  const int tid = threadIdx.x, wid = __builtin_amdgcn_readfirstlane(tid >> 6), lane = tid & 63, r32 = lane & 31, hi = lane >> 5;
  char* K_lds = lds; char* V_lds = lds + 2 * SHM_K;
  float* ws = (float*)(lds + 2 * SHM_K + 2 * SHM_V) + wid * 64; float* li_l = ws; float* al_l = ws + 32;
  float m_reg = -1e30f, l_reg = 0; f32x16 o[4] = {}; i32x8 qr[3];
  { const char* Qw = (const char*)Qb + (size_t)(wid * QBLK + r32) * MDK + hi * 32;
#pragma unroll
    for (int s = 0; s < 3; ++s) qr[s] = ld32(Qw + 64 * s); }
  const int kd0 = (tid / 12) * KST + (tid % 12) * 16, kd1 = ((512 + tid) / 12) * KST + ((512 + tid) % 12) * 16, vd = (tid >> 2) * VST + (tid & 3) * 16;
  struct { u32x4 k0, k1, v; } sr_[SDEPTH];
#define SLOAD(i, t0) do { const unsigned ko = (unsigned)tid * 16u, vo = ((unsigned)(tid >> 2) << 14) | ((unsigned)(tid & 3) << 4); const unsigned char* kt_ = Kh + (size_t)(t0) * MDK; sr_[i].k0 = *(const u32x4*)(kt_ + ko); if (wid < 4) sr_[i].k1 = *(const u32x4*)(kt_ + 8192 + ko); sr_[i].v = *(const u32x4*)(Vt + (t0) + vo); } while (0)
#define SWRITE(b, i) do { *(u32x4*)(K_lds + (b) * SHM_K + kd0) = sr_[i].k0; if (wid < 4) *(u32x4*)(K_lds + (b) * SHM_K + kd1) = sr_[i].k1; *(u32x4*)(V_lds + (b) * SHM_V + vd) = sr_[i].v; } while (0)
#define SWAIT() do { if constexpr (SDEPTH == 2) asm volatile("s_waitcnt vmcnt(3)" ::: "memory"); else asm volatile("s_waitcnt vmcnt(0)" ::: "memory"); } while (0)
#define RESC(a) do { if (__any((a) < 1.f)) { if (hi == 0) al_l[r32] = (a); asm volatile("s_waitcnt lgkmcnt(0)" ::: "memory"); \
    _Pragma("unroll") for (int d = 0; d < 4; ++d) _Pragma("unroll") for (int r = 0; r < 16; ++r) o[d][r] *= al_l[crow(r, hi)]; } } while (0)
  f32x16 pA0, pA1, pB0, pB1; float mnA, mnB, alA, alB; i32x8 pa; const int NT = seq / KVBLK;
  constexpr int SE = 0, SO = SDEPTH - 1;
  SLOAD(SE, 0); asm volatile("s_waitcnt vmcnt(0)" ::: "memory"); SWRITE(0, SE); __syncthreads();
  qkt(pA0, pA1, K_lds, qr, r32, hi); partialSM(pA0, pA1, m_reg, mnA, alA);
  SLOAD(SO, KVBLK); if constexpr (SDEPTH == 2) { if (2 < NT) SLOAD(SE, 2 * KVBLK); }
  SWAIT(); SWRITE(1, SO); __syncthreads();
  for (int j = 1; j + 1 < NT; j += 2) {
    SBAR(); qkt(pB0, pB1, K_lds + SHM_K, qr, r32, hi);
    finishSM(pA0, pA1, alA, l_reg, pa); SBAR();
    SLOAD(SO, (j + SDEPTH) * KVBLK); SBAR();
    pv(o, V_lds, pa, r32, hi); partialSM(pB0, pB1, m_reg, mnB, alB);
    __syncthreads(); SWAIT(); SWRITE(0, SE);
    RESC(alB); __syncthreads();
    SBAR(); qkt(pA0, pA1, K_lds, qr, r32, hi);
    finishSM(pB0, pB1, alB, l_reg, pa); SBAR();
    if (SDEPTH == 1 || j + 3 < NT) SLOAD(SE, (j + 1 + SDEPTH) * KVBLK); SBAR();
    pv(o, V_lds + SHM_V, pa, r32, hi); partialSM(pA0, pA1, m_reg, mnA, alA);
    __syncthreads(); SWAIT(); SWRITE(1, SO);
    RESC(alA); __syncthreads();
  }
  SBAR(); qkt(pB0, pB1, K_lds + SHM_K, qr, r32, hi);
  finishSM(pA0, pA1, alA, l_reg, pa); SBAR();
  pv(o, V_lds, pa, r32, hi); partialSM(pB0, pB1, m_reg, mnB, alB);
  __syncthreads(); RESC(alB);
  finishSM(pB0, pB1, alB, l_reg, pa); SBAR();
  pv(o, V_lds + SHM_V, pa, r32, hi);
  if (hi == 0) li_l[r32] = l_reg; asm volatile("s_waitcnt lgkmcnt(0)" ::: "memory");
  float rli[16];
#pragma unroll
  for (int r = 0; r < 16; ++r) rli[r] = __builtin_amdgcn_rcpf(li_l[crow(r, hi)]);
  bf16_t* Ow = Ob + (size_t)(wid * QBLK) * ldo;
#pragma unroll
  for (int r = 0; r < 16; ++r) { const int orow = crow(r, hi);
#pragma unroll
    for (int d0 = 0; d0 < 4; ++d0) Ow[(size_t)orow * ldo + d0 * 32 + r32] = f2bf(o[d0][r] * rli[r]); }
#undef SLOAD
#undef SWRITE
#undef SWAIT
#undef RESC
}
#undef SBAR
#undef MFMA8
}

#ifdef DBG
constexpr size_t WS_DBG = 256 * 1024;
__device__ __forceinline__ unsigned hash32(unsigned x) { x ^= x >> 16; x *= 0x7feb352dU; x ^= x >> 15; x *= 0x846ca68bU; x ^= x >> 16; return x; }
__device__ __forceinline__ void dbg_acc(float* acc, int slot, float got, float ref) { const float d = got - ref; atomicAdd(acc + 2 * slot, d * d); atomicAdd(acc + 2 * slot + 1, ref * ref); }
__device__ __forceinline__ float dotA(const bf16_t* a, const float* W, int K, int ldw, int n) { float s = 0.f; for (int k = 0; k < K; ++k) s += bf2f(a[k]) * W[(size_t)k * ldw + n]; return s; }
__device__ __forceinline__ void chk_p1(const Ctx& C, const Args& a, unsigned char* ws, float* acc) {
    const int gt = C.bid * 512 + C.tid; if (gt >= 6144) return;
    const unsigned hs = hash32(gt * 7919u + 13u); const int t = hs % T, kind = gt % 6; const unsigned c0 = hs >> 14;
    const bf16_t* xn = (const bf16_t*)(ws + WS_XN) + (size_t)t * 1024; const float* w_in = (const float*)a.in[5];
    if (kind == 0) { const int c = c0 % 512; dbg_acc(acc, 0, bf2f(((const bf16_t*)(ws + AR_Q0))[(size_t)t * 512 + c]), dotA(xn, w_in, 1024, 3104, c) * 0.08838834764831845f); }
    else if (kind == 1) { const int c = c0 % 512; dbg_acc(acc, 0, bf2f(((const bf16_t*)(ws + AR_K0))[(size_t)t * 512 + c]), dotA(xn, w_in, 1024, 3104, 512 + c)); }
    else if (kind == 2) { const int c = c0 % 1024; dbg_acc(acc, 0, bf2f(((const bf16_t*)(ws + AR_VT))[(size_t)c * T + t]), dotA(xn, w_in, 1024, 3104, 1024 + c)); }
    else if (kind == 3) { const int c = c0 % 1024; dbg_acc(acc, 0, bf2f(((const bf16_t*)(ws + AR_SR))[(size_t)t * 1024 + c]), siluf(dotA(xn, w_in, 1024, 3104, 2048 + c))); }
    else { const int dir = kind - 4, c = c0 % 512; const float* wg = (const float*)a.in[dir ? 8 : 6]; const float* bg = (const float*)a.in[dir ? 9 : 7]; float lg = bg[c];
        for (int j = 0; j < 16; ++j) lg += dotA(xn, w_in, 1024, 3104, 3072 + 16 * dir + j) * wg[j * 512 + c];
        dbg_acc(acc, 1, ((const float*)(ws + (dir ? AR_GB : AR_GF)))[(size_t)t * 512 + c], logsigf(lg) * 0.0625f); }
}
__device__ __forceinline__ void chk_gla(const Ctx& C, const Args& a, unsigned char* ws, float* acc) {
    if (C.bid >= 64) return;
    float* A = (float*)C.lds; float* O = A + 4096; float* red = O + 512;
    const unsigned hs = hash32(C.bid * 977u + 5u); const int t = hs % T, h = (hs >> 14) & 3;
    const bf16_t* Q0 = (const bf16_t*)(ws + AR_Q0); const bf16_t* K0 = (const bf16_t*)(ws + AR_K0); const float* GF = (const float*)(ws + AR_GF); const float* GB = (const float*)(ws + AR_GB);
    const bf16_t* VT = (const bf16_t*)(ws + AR_VT); const bf16_t* SR = (const bf16_t*)(ws + AR_SR); const bf16_t* OG = (const bf16_t*)(ws + WS_XN);
    for (int i = C.tid; i < 4096; i += 512) A[i] = 0.f;
    __syncthreads();
    const int dir = C.tid >> 8, sub = C.tid & 255;
    if (sub < 128) { const int k = sub, ch = 128 * h + k; const float q = bf2f(Q0[(size_t)t * 512 + ch]); float Dk = dir ? __expf(GB[(size_t)t * 512 + ch]) : 1.f;
        for (int i = 0; i < 2048; ++i) { const int s = dir ? t + 1 + i : t - i; const bool valid = s >= 0 && s < T; float w = 0.f;
            if (valid) { w = q * Dk * bf2f(K0[(size_t)s * 512 + ch]); Dk *= __expf((dir ? GB : GF)[(size_t)s * 512 + ch]); }
            w = wave_sum(w); if (C.lane == 0) atomicAdd(&A[dir * 2048 + i], w); } }
    __syncthreads();
    { float o = 0.f; for (int i = 0; i < 2048; ++i) { const int s = dir ? t + 1 + i : t - i; if (s >= 0 && s < T) o += A[dir * 2048 + i] * bf2f(VT[(size_t)(256 * h + sub) * T + s]); } O[dir * 256 + sub] = o; }
    __syncthreads();
    if (C.tid < 256) { const float o = O[C.tid] + O[256 + C.tid]; float ss = wave_sum(o * o); if (C.lane == 0) red[C.wave] = ss; }
    __syncthreads();
    if (C.tid < 256) { const float o = O[C.tid] + O[256 + C.tid]; const float ss = red[0] + red[1] + red[2] + red[3]; const float r = 1.0f / sqrtf(ss * (1.0f / 256.0f) + RMS_EPS);
        const size_t oi = (size_t)t * 1024 + 256 * h + C.tid; dbg_acc(acc, 2, bf2f(OG[oi]), o * r * ((const float*)a.in[10])[C.tid] * bf2f(SR[oi])); }
    __syncthreads();
}
__device__ __forceinline__ void chk_resid(const Ctx& C, const float* base, const bf16_t* A, int K, const float* W, const float* HAp, float* acc, int slot) {
    const int gt = C.bid * 512 + C.tid; if (gt >= 4096) return;
    const unsigned hs = hash32(gt * 31u + slot); const int t = hs % T, n = (hs >> 14) % 1024;
    dbg_acc(acc, slot, HAp[(size_t)t * 1024 + n], base[(size_t)t * 1024 + n] + dotA(A + (size_t)t * K, W, K, 1024, n));
}
__device__ __forceinline__ void chk_router(const Ctx& C, const float* Hin, const float* gain, const float* Wr, const bf16_t* XN, const float* AFF, float* acc, int slot) {
    const int gt = C.bid * 512 + C.tid; if (gt >= 512) return;
    const int t = hash32(gt * 101u + 7u) % T; const float* hr = Hin + (size_t)t * 1024; float ss = 0.f; for (int k = 0; k < 1024; ++k) ss += hr[k] * hr[k];
    const float r = 1.0f / sqrtf(ss / 1024.0f + RMS_EPS); float lg[16]; for (int e = 0; e < 16; ++e) lg[e] = 0.f;
    for (int k = 0; k < 1024; ++k) { const float xv = hr[k] * r * gain[k]; for (int e = 0; e < 16; ++e) lg[e] += xv * Wr[k * 16 + e]; if ((k & 63) == (gt & 63)) dbg_acc(acc, slot, bf2f(XN[(size_t)t * 1024 + k]), xv); }
    float mx = lg[0]; for (int e = 1; e < 16; ++e) mx = fmaxf(mx, lg[e]); float s = 0.f; for (int e = 0; e < 16; ++e) { lg[e] = expf(lg[e] - mx); s += lg[e]; }
    for (int e = 0; e < 16; ++e) dbg_acc(acc, slot, AFF[(size_t)t * 16 + e], lg[e] / s);
}
__device__ __forceinline__ void chk_select(const Ctx& C, const float* AFF, const int* SEL, const int* IDX, unsigned* dw) {
    const int gt = C.bid * 512 + C.tid;
    for (int p = gt; p < T * 16; p += C.nb * 512) { const int t = p >> 4, e = p & 15; const int s = SEL[p]; const unsigned b = __float_as_uint(AFF[p]);
        if (s > 0) { atomicAdd(&dw[e], 1u); atomicMax(&dw[16 + e], ~b); if (s > CAP || IDX[e * CAP + s - 1] != t) atomicAdd(&dw[48], 1u); } else { atomicMax(&dw[32 + e], b); if (s < 0) atomicAdd(&dw[48], 1u); } }
}
__device__ __forceinline__ void chk_moe_h(const Ctx& C, const Args& a, unsigned char* ws, int layer, float* acc, int slot) {
    const int gt = C.bid * 512 + C.tid; if (gt >= 2048) return;
    const unsigned hs = hash32(gt * 53u + 3u); const int e = hs & 15, sl = (hs >> 4) % CAP, f = (hs >> 15) % FF; const int t = ((const int*)(ws + WS_IDX))[e * CAP + sl];
    if (t < 0 || t >= T) { dbg_acc(acc, slot, 1e3f, 0.f); return; }
    const bf16_t* xn = (const bf16_t*)(ws + WS_XN) + (size_t)t * 1024; const size_t wo = (size_t)(layer * NE + e) * 1024 * 2048;
    const float g = dotA(xn, (const float*)a.in[19] + wo, 1024, 2048, f), u = dotA(xn, (const float*)a.in[20] + wo, 1024, 2048, f);
    dbg_acc(acc, slot, bf2f(((const bf16_t*)(ws + AR_H))[((size_t)e * CAP + sl) * FF + f]), siluf(g) * u);
    dbg_acc(acc, slot, bf2f(((const bf16_t*)(ws + AR_XS))[((size_t)e * CAP + sl) * 1024 + (f & 1023)]), bf2f(xn[f & 1023]));
}
__device__ __forceinline__ void chk_moe_y(const Ctx& C, const Args& a, unsigned char* ws, int layer, float* acc, int slot) {
    const int gt = C.bid * 512 + C.tid; if (gt >= 2048) return;
    const unsigned hs = hash32(gt * 59u + 11u); const int e = hs & 15, sl = (hs >> 4) % CAP, n = (hs >> 15) % 1024;
    const float ref = dotA((const bf16_t*)(ws + AR_H) + ((size_t)e * CAP + sl) * FF, (const float*)a.in[21] + (size_t)(layer * NE + e) * 2048 * 1024, 2048, 1024, n);
    dbg_acc(acc, slot, bf2f(((const bf16_t*)(ws + AR_Y))[((size_t)e * CAP + sl) * 1024 + n]), ref);
}
__device__ __forceinline__ void chk_combine(const Ctx& C, unsigned char* ws, const float* Hin, const float* Hout, float* acc, int slot) {
    const int gt = C.bid * 512 + C.tid; if (gt >= 4096) return;
    const unsigned hs = hash32(gt * 67u + 1u); const int t = hs % T, n = (hs >> 14) % 1024; float ref = Hin[(size_t)t * 1024 + n];
    for (int e = 0; e < 16; ++e) { const int s = ((const int*)(ws + WS_SEL))[t * 16 + e]; if (s > 0) ref += ((const float*)(ws + WS_AFF))[t * 16 + e] * bf2f(((const bf16_t*)(ws + AR_Y))[((size_t)e * CAP + s - 1) * 1024 + n]); }
    dbg_acc(acc, slot, Hout[(size_t)t * 1024 + n], ref);
}
__device__ __forceinline__ void chk_cin(const Ctx& C, const Args& a, unsigned char* ws, float* acc) {
    const int gt = C.bid * 512 + C.tid; if (gt >= 4096) return;
    const unsigned hs = hash32(gt * 71u + 9u); const int t = hs % T, n = (hs >> 14) % 448;
    dbg_acc(acc, 10, ((const float*)(ws + AR_CIN))[(size_t)t * 512 + n], dotA((const bf16_t*)(ws + WS_XN) + (size_t)t * 1024, (const float*)a.in[12], 1024, 448, n));
}
__device__ __forceinline__ void chk_tok(const Ctx& C, const Args& a, unsigned char* ws, float* acc) {
    const int gt = C.bid * 512 + C.tid; if (gt >= 1024) return;
    const unsigned hs = hash32(gt * 73u + 19u); const int t = hs % T, h = (hs >> 14) & 15; const float* row = (const float*)(ws + AR_CIN) + (size_t)t * 512;
    float sq = 0.f, sk = 0.f; for (int i = 0; i < 256; ++i) sq += row[i] * row[i]; for (int i = 0; i < 128; ++i) sk += row[256 + i] * row[256 + i];
    const float rq = 1.0f / sqrtf(sq / 256.0f + RMS_EPS), rk = 1.0f / sqrtf(sk / 128.0f + RMS_EPS);
    const int i = (hs >> 18) % 256; dbg_acc(acc, 11, bf2f(((const bf16_t*)(ws + AR_CQN))[(size_t)t * 256 + i]), row[i] * rq * ((const float*)a.in[13])[i]);
    const int j = i & 127; dbg_acc(acc, 11, bf2f(((const bf16_t*)(ws + AR_CKVN))[(size_t)t * 256 + j]), row[256 + j] * rk * ((const float*)a.in[15])[j]);
    dbg_acc(acc, 11, 1.f + bf2f(((const bf16_t*)(ws + AR_CKVN))[(size_t)t * 256 + 128 + j]), 1.f);
    const int f = i & 31; const float ang = (float)((const int*)a.in[1])[t] * a.invf[f]; double xr = (double)ang * 0.15915494309189533577; xr = (xr - rint(xr)) * 6.283185307179586477; double cd = 1.0, sd = xr, tc = 1.0, ts = xr; for (int n = 1; n < 16; ++n) { tc *= -xr * xr / ((2.0 * n - 1.0) * (2.0 * n)); ts *= -xr * xr / ((2.0 * n) * (2.0 * n + 1.0)); cd += tc; sd += ts; } const float cr = (float)cd, sr = (float)sd;
    dbg_acc(acc, 11, ((const float*)(ws + WS_CS))[(size_t)t * 64 + f], cr); dbg_acc(acc, 11, ((const float*)(ws + WS_CS))[(size_t)t * 64 + 32 + f], sr);
    const float x1 = row[384 + f], x2 = row[416 + f]; const bf16_t* kp = (const bf16_t*)(ws + AR_K) + ((size_t)h * T + t) * MDK + 128 + 8 * (f >> 2) + (f & 3);
    dbg_acc(acc, 11, bf2f(kp[0]), x1 * cr - x2 * sr); dbg_acc(acc, 11, bf2f(kp[4]), x1 * sr + x2 * cr);
}
__device__ __forceinline__ void chk_qkv(const Ctx& C, const Args& a, unsigned char* ws, float* acc) {
    const int gt = C.bid * 512 + C.tid; if (gt >= 4096) return;
    const unsigned hs = hash32(gt * 79u + 29u); const int t = hs % T, h = (hs >> 14) & 15, j = (hs >> 18) & 127, kind = gt & 3; const float QS = (ATT_FP8 ? 8.0f : 1.0f) * 0.07216878364870322f * 1.4426950408889634f;
    const bf16_t* cq = (const bf16_t*)(ws + AR_CQN) + (size_t)t * 256; const bf16_t* ck = (const bf16_t*)(ws + AR_CKVN) + (size_t)t * 256;
    const size_t qo = ((size_t)h * T + t) * MDK; const int tau = t & 63, pos = 32 * ((tau >> 2) & 1) + (tau & 3) + 4 * ((tau >> 3) & 3) + 16 * (tau >> 5);
#if ATT_FP8
#define QV(i) fp8f(ws + AR_Q8 + qo + (i))
#define KV(i) fp8f(ws + AR_K8 + qo + (i))
#define VV(i) fp8f(ws + AR_V8T + ((size_t)h * MDV + (i)) * T + (t & ~63) + pos)
#else
#define QV(i) bf2f(((const bf16_t*)(ws + AR_Q))[qo + (i)])
#define KV(i) bf2f(((const bf16_t*)(ws + AR_K))[qo + (i)])
#define VV(i) bf2f(((const bf16_t*)(ws + AR_V))[((size_t)h * T + t) * MDV + (i)])
#endif
    if (kind == 0) dbg_acc(acc, 12, QV(j), dotA(cq, (const float*)a.in[14], 256, 3072, 192 * h + j) * QS);
    else if (kind == 1) { const int f = j & 31; const float x1 = dotA(cq, (const float*)a.in[14], 256, 3072, 192 * h + 128 + f), x2 = dotA(cq, (const float*)a.in[14], 256, 3072, 192 * h + 160 + f);
        const float cr = ((const float*)(ws + WS_CS))[(size_t)t * 64 + f], sr = ((const float*)(ws + WS_CS))[(size_t)t * 64 + 32 + f]; const int qp = 128 + 8 * (f >> 2) + (f & 3);
        dbg_acc(acc, 12, QV(qp), (x1 * cr - x2 * sr) * QS); dbg_acc(acc, 12, QV(qp + 4), (x1 * sr + x2 * cr) * QS);
        const float* row = (const float*)(ws + AR_CIN) + (size_t)t * 512; const float k1 = row[384 + f], k2 = row[416 + f];
        dbg_acc(acc, 12, KV(qp), k1 * cr - k2 * sr); dbg_acc(acc, 12, KV(qp + 4), k1 * sr + k2 * cr); }
    else if (kind == 2) dbg_acc(acc, 12, KV(j), dotA(ck, (const float*)a.in[16], 128, 4096, 256 * h + j));
    else dbg_acc(acc, 12, VV(j), dotA(ck, (const float*)a.in[16], 128, 4096, 256 * h + 128 + j));
#undef QV
#undef KV
#undef VV
}
__device__ __forceinline__ void chk_attn(const Ctx& C, unsigned char* ws, float* acc) {
    if (C.bid >= 64) return;
    float* P = (float*)C.lds; float* red = P + T; float* qs = red + 32;
    const unsigned hs = hash32(C.bid * 991u + 77u); const int t = hs % T, h = (hs >> 14) & 15;
#if ATT_FP8
    const unsigned char* Q = ws + AR_Q8 + ((size_t)h * T + t) * MDK; const unsigned char* K = ws + AR_K8 + (size_t)h * T * MDK; const unsigned char* V = ws + AR_V8T + (size_t)h * MDV * T; const float SC = 0.125f;
    if (C.tid < MDK) qs[C.tid] = fp8f(Q + C.tid);
#define KEL(j, d) fp8f(K + (size_t)(j) * MDK + (d))
#define VEL(j, d) fp8f(V + (size_t)(d) * T + ((j) & ~63) + 32 * ((((j) & 63) >> 2) & 1) + ((j) & 3) + 4 * ((((j) & 63) >> 3) & 3) + 16 * (((j) & 63) >> 5))
#else
    const bf16_t* Q = (const bf16_t*)(ws + AR_Q) + ((size_t)h * T + t) * MDK; const bf16_t* K = (const bf16_t*)(ws + AR_K) + (size_t)h * T * MDK; const bf16_t* V = (const bf16_t*)(ws + AR_V) + (size_t)h * T * MDV; const float SC = 1.0f;
    if (C.tid < MDK) qs[C.tid] = bf2f(Q[C.tid]);
#define KEL(j, d) bf2f(K[(size_t)(j) * MDK + (d)])
#define VEL(j, d) bf2f(V[(size_t)(j) * MDV + (d)])
#endif
    __syncthreads();
    float mx = -1e30f;
    for (int j = C.tid; j < T; j += 512) { float s = 0.f; for (int d = 0; d < MDK; ++d) s += qs[d] * KEL(j, d); s *= SC; P[j] = s; mx = fmaxf(mx, s); }
    mx = wave_max(mx); if (C.lane == 0) red[C.wave] = mx;
    __syncthreads();
    mx = red[0]; for (int w = 1; w < 8; ++w) mx = fmaxf(mx, red[w]);
    float sm = 0.f; for (int j = C.tid; j < T; j += 512) { const float p = exp2f(P[j] - mx); P[j] = p; sm += p; }
    sm = wave_sum(sm);
    __syncthreads();
    if (C.lane == 0) red[8 + C.wave] = sm;
    __syncthreads();
    sm = 0.f; for (int w = 0; w < 8; ++w) sm += red[8 + w];
    if (C.tid < MDV) { float o = 0.f; for (int j = 0; j < T; ++j) o += P[j] * VEL(j, C.tid); dbg_acc(acc, 13, bf2f(((const bf16_t*)(ws + AR_O))[(size_t)t * 2048 + 128 * h + C.tid]) * 100.f, o / sm * 100.f); }
    __syncthreads();
#undef KEL
#undef VEL
}
__device__ __forceinline__ void dbg_report(const Ctx& C, unsigned char* ws, float* out, int lo, int hi) {
    const float* acc = (const float*)(ws + WS_DBG); const unsigned* dw = (const unsigned*)(ws + WS_DBG + 1024);
    int code = 90;
    for (int s = lo; s < hi && code == 90; ++s) { float num = __hip_atomic_load(acc + 2 * s, __ATOMIC_RELAXED, __HIP_MEMORY_SCOPE_AGENT), den = __hip_atomic_load(acc + 2 * s + 1, __ATOMIC_RELAXED, __HIP_MEMORY_SCOPE_AGENT);
        if (s == 5) { unsigned viol = __hip_atomic_load(dw + 48, __ATOMIC_RELAXED, __HIP_MEMORY_SCOPE_AGENT); for (int e = 0; e < 16; ++e) { const unsigned cnt = __hip_atomic_load(dw + e, __ATOMIC_RELAXED, __HIP_MEMORY_SCOPE_AGENT), mn = ~__hip_atomic_load(dw + 16 + e, __ATOMIC_RELAXED, __HIP_MEMORY_SCOPE_AGENT), mxu = __hip_atomic_load(dw + 32 + e, __ATOMIC_RELAXED, __HIP_MEMORY_SCOPE_AGENT); if (cnt != CAP) viol += 1000; if (mn < mxu) viol += 1; }
            num = (float)viol; den = 1.f; if (viol == 0) continue; code = 10 * (s - lo) + (viol >= 1000 ? 0 : (viol >= 100 ? 1 : (viol >= 10 ? 2 : 3))); break; }
        if (den == 0.f && num == 0.f) continue;
        const float e = sqrtf(num / den);
        if (!(e < 0.03f)) { const int b = !(e < 1.f) ? 0 : (e >= 0.3f ? 1 : (e >= 0.1f ? 2 : 3)); code = 10 * (s - lo) + b; } }
    if (code == 90) { float worst = 0.f; for (int s = lo; s < hi; ++s) { if (s == 5) continue; const float num = acc[2 * s], den = acc[2 * s + 1]; if (den > 0.f) worst = fmaxf(worst, sqrtf(num / den)); }
        code = 90 + (worst >= 0.01f ? 1 : (worst >= 0.003f ? 2 : 3)); }
    if (DBG >= 2) { const int sl = DBG == 2 ? 13 : 12; const float num = acc[2 * sl], den = acc[2 * sl + 1]; const float e = sqrtf(num / den); code = !(e > 0.f) ? 99 : (e >= 1.f ? 0 : (int)fminf(89.f, -20.f * log10f(e))); }
    const float c = sqrtf((float)code);
    for (size_t i = (size_t)C.bid * 512 + C.tid; i < (size_t)T * D; i += (size_t)C.nb * 512) out[i] = c;
}
#endif

constexpr int NPHASE = 24;
__global__ void __launch_bounds__(512, 2) mk_fwd(Args args) {
    extern __shared__ __attribute__((aligned(16))) unsigned char lds[];
    Ctx C; C.tid = threadIdx.x; C.lane = C.tid & 63; C.wave = __builtin_amdgcn_readfirstlane(C.tid >> 6); C.bid = blockIdx.x; C.nb = gridDim.x;
    C.gw = C.bid * 8 + C.wave; C.ngw = C.nb * 8; C.lds = lds;
    unsigned char* ws = args.ws;
    volatile LAS unsigned* MISC = (volatile LAS unsigned*)((LAS unsigned char*)lds + LDS_MISC);
    if (C.tid < 32) MISC[C.tid] = 0u;
    __syncthreads();
    XcdBarrier bar = xcd_barrier_post((unsigned*)(ws + WS_CTL) + 4096 + args.li * XCD_BAR_WORDS, MISC + 8);
    const int lo = args.ph_lo, hi = args.ph_hi;
#if defined(PH_MASK)
#define IN(k) ((((PH_MASK) >> (k)) & 1u) && lo <= (k) && (k) < hi)
#elif defined(PH_ONLY)
#define IN(k) ((k) == PH_ONLY && lo <= (k) && (k) < hi)
#else
#define IN(k) (lo <= (k) && (k) < hi)
#endif
#define SEAM(k) do { if (IN((k) + 1)) xcd_barrier(bar); } while (0)
#ifndef REPMASK
#define REPMASK 0u
#endif
#define NREP(k) ((((REPMASK) >> (k)) & 1u) ? 2 : 1)
#ifdef DBG
    float* dacc = (float*)(ws + WS_DBG); unsigned* ddw = (unsigned*)(ws + WS_DBG + 1024);
#define DBGCHK(page, call) do { if ((DBG >= 2 ? 1 : DBG) == (page)) { call; xcd_barrier(bar); } } while (0)
#else
#define DBGCHK(page, call) do { } while (0)
#endif
    PG8_LAS unsigned char* glds = (PG8_LAS unsigned char*)lds;
    const float* x = (const float*)args.in[0];
    float* HA = args.out; float* HB = (float*)(ws + WS_HB);
    bf16_t* XN = (bf16_t*)(ws + WS_XN);
    float* AFF = (float*)(ws + WS_AFF); int* SEL = (int*)(ws + WS_SEL); int* IDX = (int*)(ws + WS_IDX);
    bf16_t* WGU = (bf16_t*)(ws + WS_WGU); bf16_t* WD = (bf16_t*)(ws + WS_WD);
    bf16_t* XS = (bf16_t*)(ws + AR_XS); bf16_t* HH = (bf16_t*)(ws + AR_H); bf16_t* YY = (bf16_t*)(ws + AR_Y);

    if (IN(0)) { ph_convert_small(C, args, ws); ph_convert_moe(C, args, ws, 0, NREP(0)); ph_norm(C, x, (const float*)args.in[2], XN); SEAM(0); }
    if (IN(1)) {
        { pg8::Gemm g{XN, (const bf16_t*)(ws + WS_WGIN), T, 3072, 1024}; pg8::StaticOrder S; S.init(T, 3072, C.nb, C.bid); S.rep = NREP(1);
          pg8::EpiGlaIn E{(bf16_t*)(ws + AR_Q0), (bf16_t*)(ws + AR_K0), (bf16_t*)(ws + AR_SR), (float*)(ws + AR_GF), (float*)(ws + AR_GB), (const float*)args.in[7], (const float*)args.in[9]};
          pg8::gemm_phase<pg8::EpiGlaIn, pg8::StaticOrder, PG8_ALIGN, PG8_SP2>(glds, g, S, E); }
        { pg8::Gemm g{(const bf16_t*)(ws + WS_WV), XN, 1024, T, 1024}; pg8::StaticOrder S; S.init(1024, T, C.nb, C.bid); S.rep = NREP(1);
          pg8::EpiBf E{(bf16_t*)(ws + AR_VT), T};
          pg8::gemm_phase<pg8::EpiBf, pg8::StaticOrder, PG8_ALIGN, PG8_SP2>(glds, g, S, E); }
        SEAM(1); } DBGCHK(0, chk_p1(C, args, ws, dacc));
    if (IN(2)) for (int rep_ = 0; rep_ < NREP(2); ++rep_) { ph_gla_prep(C, (const bf16_t*)(ws + AR_Q0), (const bf16_t*)(ws + AR_K0), (const float*)(ws + AR_GF), (const float*)(ws + AR_GB), (bf16_t*)(ws + AR_QDF), (bf16_t*)(ws + AR_QDB),
                             (bf16_t*)(ws + AR_KDF), (bf16_t*)(ws + AR_KDB), (bf16_t*)(ws + AR_KTF), (bf16_t*)(ws + AR_KTB), (float*)(ws + WS_EGL)); SEAM(2); }
    if (IN(3)) for (int rep_ = 0; rep_ < NREP(3); ++rep_) { ph_gla_u(C, (const bf16_t*)(ws + AR_VT), (const bf16_t*)(ws + AR_KTF), (const bf16_t*)(ws + AR_KTB), (const float*)(ws + WS_EGL), (bf16_t*)(ws + AR_U)); SEAM(3); }
    if (IN(4)) for (int rep_ = 0; rep_ < NREP(4); ++rep_) { ph_gla_scan(C, (const bf16_t*)(ws + AR_U), (const float*)(ws + WS_EGL), (bf16_t*)(ws + AR_ST)); SEAM(4); }
    if (IN(5)) for (int rep_ = 0; rep_ < NREP(5); ++rep_) { ph_gla_out(C, (const bf16_t*)(ws + AR_QDF), (const bf16_t*)(ws + AR_QDB), (const bf16_t*)(ws + AR_KDF), (const bf16_t*)(ws + AR_KDB), (const bf16_t*)(ws + AR_VT), (const bf16_t*)(ws + AR_ST),
                            (const bf16_t*)(ws + AR_SR), (const float*)args.in[10], XN); SEAM(5); } DBGCHK(0, chk_gla(C, args, ws, dacc));
    if (IN(6)) { pg8::Gemm g{XN, (const bf16_t*)(ws + WS_WGOUT), T, 1024, 1024}; pg8::StaticOrder S; S.init(T, 1024, C.nb, C.bid); S.rep = NREP(6);
        pg8::EpiF32 E{HA, x, 1024}; pg8::gemm_phase<pg8::EpiF32, pg8::StaticOrder, false, PG8_SP2>(glds, g, S, E); SEAM(6); } DBGCHK(0, chk_resid(C, x, XN, 1024, (const float*)args.in[11], HA, dacc, 3));
#define MOE_LAYER(P, L, HIN, TAILMODE, HOUT, GAIN2, OUTP)                                                                                         \
    if (IN(P)) for (int rep_ = 0; rep_ < NREP(P); ++rep_) { ph_router(C, HIN, (const float*)args.in[3] + (L) * 1024, (const float*)args.in[18] + (L) * 1024 * 16, XN, AFF, (float*)(ws + WS_AFFT)); SEAM(P); if ((P) == 7) DBGCHK(0, chk_router(C, HIN, (const float*)args.in[3] + (L) * 1024, (const float*)args.in[18] + (L) * 1024 * 16, XN, AFF, dacc, 4)); }       \
    if (IN(P + 1)) for (int rep_ = 0; rep_ < NREP(P + 1); ++rep_) { ph_select(C, (const float*)(ws + WS_AFFT), SEL, IDX); SEAM(P + 1); if ((P) == 7) DBGCHK(0, chk_select(C, AFF, SEL, IDX, ddw)); }                                                                                 \
    if (IN(P + 2)) for (int rep_ = 0; rep_ < NREP(P + 2); ++rep_) { ph_gather(C, IDX, XN, XS); SEAM(P + 2); }                                                                                   \
    if (IN(P + 3)) { pg8::Gemm g{XS, WGU, NE * CAP, 4096, 1024}; pg8::GroupedOrder S; S.init(NE * CAP, 4096, C.nb, C.bid); S.rep = NREP(P + 3); pg8::EpiMoe1 E{HH};     \
        pg8::gemm_phase<pg8::EpiMoe1, pg8::GroupedOrder, PG8_ALIGN, PG8_SP2>(glds, g, S, E); SEAM(P + 3); if ((P) == 7) DBGCHK(0, chk_moe_h(C, args, ws, L, dacc, 6)); }                                       \
    if (IN(P + 4)) { pg8::Gemm g{HH, WD, NE * CAP, 1024, 2048}; pg8::GroupedOrder S; S.init(NE * CAP, 1024, C.nb, C.bid); S.rep = NREP(P + 4); pg8::EpiMoe2 E{YY};      \
        pg8::gemm_phase<pg8::EpiMoe2, pg8::GroupedOrder, PG8_ALIGN, PG8_SP2>(glds, g, S, E); SEAM(P + 4); if ((P) == 7) DBGCHK(0, chk_moe_y(C, args, ws, L, dacc, 7)); }                                       \
    if (IN(P + 5)) for (int rep_ = 0; rep_ < NREP(P + 5); ++rep_) { ph_combine<TAILMODE>(C, HIN, AFF, SEL, YY, HOUT, GAIN2, XN, OUTP); SEAM(P + 5); if ((P) == 7) DBGCHK(0, chk_combine(C, ws, HIN, HOUT, dacc, 8)); }

    MOE_LAYER(7, 0, HA, 1, HB, (const float*)args.in[2] + 1024, nullptr)
    if (IN(13)) { pg8::Gemm g{XN, (const bf16_t*)(ws + WS_WMIN), T, 512, 1024}; pg8::StaticOrder S; S.init(T, 512, C.nb, C.bid); S.rep = NREP(13);
        pg8::EpiF32 E{(float*)(ws + AR_CIN), nullptr, 512}; pg8::gemm_phase<pg8::EpiF32, pg8::StaticOrder, false, PG8_SP2>(glds, g, S, E); SEAM(13); } DBGCHK(1, chk_cin(C, args, ws, dacc));
    if (IN(14)) { ph_mla_tok(C, (const float*)(ws + AR_CIN), (const int*)args.in[1], (const float*)args.in[13], (const float*)args.in[15], args.invf, (bf16_t*)(ws + AR_CQN), (bf16_t*)(ws + AR_CKVN),
                             (float*)(ws + WS_CS), (bf16_t*)(ws + AR_K));
        ph_convert_moe(C, args, ws, 1, NREP(14)); SEAM(14); } DBGCHK(1, chk_tok(C, args, ws, dacc));
    if (IN(15)) {
#if ATT_FP8
        { pg8::Gemm g{(const bf16_t*)(ws + AR_CQN), (const bf16_t*)(ws + WS_WUQ), T, 4096, 256}; pg8::StaticOrder S; S.init(T, 4096, C.nb, C.bid); S.rep = NREP(15);
          pg8::EpiQ8 E{ws + AR_Q8, (const float*)(ws + WS_CS)}; pg8::gemm_phase<pg8::EpiQ8, pg8::StaticOrder, PG8_ALIGN, PG8_SP2>(glds, g, S, E); }
        { pg8::Gemm g{(const bf16_t*)(ws + AR_CKVN), (const bf16_t*)(ws + WS_WUKV), T, 2048, 256}; pg8::StaticOrder S; S.init(T, 2048, C.nb, C.bid); S.rep = NREP(15);
          pg8::EpiK8 E{ws + AR_K8}; pg8::gemm_phase<pg8::EpiK8, pg8::StaticOrder, PG8_ALIGN, PG8_SP2>(glds, g, S, E); }
        { pg8::Gemm g{(const bf16_t*)(ws + WS_WUKV) + (size_t)2048 * 256, (const bf16_t*)(ws + AR_CKVN), 2048, T, 256}; pg8::StaticOrder S; S.init(2048, T, C.nb, C.bid); S.rep = NREP(15);
          pg8::EpiV8T E{ws + AR_V8T}; pg8::gemm_phase<pg8::EpiV8T, pg8::StaticOrder, PG8_ALIGN, PG8_SP2>(glds, g, S, E); }
#else
        { pg8::Gemm g{(const bf16_t*)(ws + AR_CQN), (const bf16_t*)(ws + WS_WUQ), T, 4096, 256}; pg8::StaticOrder S; S.init(T, 4096, C.nb, C.bid); S.rep = NREP(15);
          pg8::EpiQup E{(bf16_t*)(ws + AR_Q), (const float*)(ws + WS_CS)}; pg8::gemm_phase<pg8::EpiQup, pg8::StaticOrder, PG8_ALIGN, PG8_SP2>(glds, g, S, E); }
        { pg8::Gemm g{(const bf16_t*)(ws + AR_CKVN), (const bf16_t*)(ws + WS_WUKV), T, 4096, 256}; pg8::StaticOrder S; S.init(T, 4096, C.nb, C.bid); S.rep = NREP(15);
          pg8::EpiKVup E{(bf16_t*)(ws + AR_K), (bf16_t*)(ws + AR_V)}; pg8::gemm_phase<pg8::EpiKVup, pg8::StaticOrder, PG8_ALIGN, PG8_SP2>(glds, g, S, E); }
#endif
        SEAM(15); } DBGCHK(1, chk_qkv(C, args, ws, dacc));
    if (IN(16)) {
        const int nun = MH * (T / 256);
        for (int ii = 0; ii * C.nb + C.bid < nun * NREP(16); ++ii) { const int i = ii % (nun / C.nb);
            int h, qb; if (C.nb == 256) { h = (C.bid & 7) + 8 * (i >> 1); qb = (i & 1) * 32 + (C.bid >> 3); } else { const int u = i * C.nb + C.bid; h = u >> 6; qb = u & 63; }
#if ATT_FP8
            att8::attn_body(ws + AR_Q8 + ((size_t)h * T + (size_t)qb * 256) * MDK, ws + AR_K8 + (size_t)h * T * MDK, ws + AR_V8T + (size_t)h * MDV * T, (bf16_t*)(ws + AR_O) + (size_t)qb * 256 * 2048 + 128 * h, 2048, T, (char*)lds);
#else
            const bf16_t* Qb = (const bf16_t*)(ws + AR_Q) + ((size_t)h * T + (size_t)qb * 256) * MDK;
            att::attn_body(Qb, (const bf16_t*)(ws + AR_K) + (size_t)h * T * MDK, (const bf16_t*)(ws + AR_V) + (size_t)h * T * MDV, (bf16_t*)(ws + AR_O) + (size_t)qb * 256 * 2048 + 128 * h, 2048, T, (char*)lds);
#endif
            __syncthreads();
        }
        SEAM(16); } DBGCHK(1, chk_attn(C, ws, dacc));
    if (IN(17)) { pg8::Gemm g{(const bf16_t*)(ws + AR_O), (const bf16_t*)(ws + WS_WMOUT), T, 1024, 2048}; pg8::StaticOrder S; S.init(T, 1024, C.nb, C.bid); S.rep = NREP(17);
        pg8::EpiF32 E{HA, HB, 1024}; pg8::gemm_phase<pg8::EpiF32, pg8::StaticOrder, false, PG8_SP2>(glds, g, S, E); SEAM(17); } DBGCHK(1, chk_resid(C, HB, (const bf16_t*)(ws + AR_O), 2048, (const float*)args.in[17], HA, dacc, 14));
    MOE_LAYER(18, 1, HA, 2, nullptr, (const float*)args.in[4], args.out)
#ifdef DBG
    xcd_barrier(bar); dbg_report(C, ws, args.out, DBG == 0 ? 0 : 10, DBG == 0 ? 10 : 20);
#endif
#undef IN
#undef SEAM
}

#ifndef MK_N_LAUNCHES
#define MK_N_LAUNCHES 1
#endif
extern "C" void kernel_launch(void* const* d_in, const int* in_sizes, int n_in, void* d_out, int out_size, void* d_ws, size_t ws_size, hipStream_t stream) {
    static int grid = 0;
    if (grid == 0) {
        if (n_in != 22 || out_size != T * D || ws_size < WS_END) { fprintf(stderr, "kernel_launch: unexpected shapes (n_in %d out %d ws %zu, need ws >= %zu)\n", n_in, out_size, ws_size, (size_t)WS_END); grid = -1; return; }
        int dev = 0, cus = 0, per_cu = 0;
        if (hipGetDevice(&dev) != hipSuccess || hipDeviceGetAttribute(&cus, hipDeviceAttributeMultiprocessorCount, dev) != hipSuccess) { grid = -1; return; }
        if (hipFuncSetAttribute((const void*)mk_fwd, hipFuncAttributeMaxDynamicSharedMemorySize, LDS_BYTES) != hipSuccess) { fprintf(stderr, "kernel_launch: hipFuncSetAttribute failed\n"); grid = -1; return; }
        if (hipOccupancyMaxActiveBlocksPerMultiprocessor(&per_cu, (const void*)mk_fwd, 512, LDS_BYTES) != hipSuccess || per_cu < 1) fprintf(stderr, "kernel_launch: occupancy query says %d\n", per_cu);
        (void)hipGetLastError();
        grid = cus;
    }
    if (grid < 0) return;
    (void)hipMemsetAsync((char*)d_ws + WS_CTL, 0, CTL_ZERO_BYTES, stream);
    Args a{};
    for (int i = 0; i < 22; ++i) a.in[i] = d_in[i];
    a.out = (float*)d_out; a.ws = (unsigned char*)d_ws;
    for (int i = 0; i < 32; ++i) a.invf[i] = powf(10000.0f, -(float)i / 32.0f);
    if (MK_N_LAUNCHES == 1) { a.ph_lo = 0; a.ph_hi = NPHASE; a.li = 0; hipLaunchKernelGGL(mk_fwd, dim3(grid), dim3(512), LDS_BYTES, stream, a); }
    else { for (int p = 0; p < NPHASE; ++p) { a.ph_lo = p; a.ph_hi = p + 1; a.li = p; hipLaunchKernelGGL(mk_fwd, dim3(grid), dim3(512), LDS_BYTES, stream, a); } }
}
```

```cpp
#include <hip/hip_runtime.h>
#include <cstdio>
#include <cstdint>
#include <cmath>

constexpr int T = 16384, D = 1024, NE = 16, CAP = 2048, FF = 2048;
constexpr int GH = 4, GDK = 128, GDV = 256, GC = 64, GNC = T / GC;
constexpr int MH = 16, MDK = 192, MDV = 128;
constexpr float RMS_EPS = 1e-6f;

typedef unsigned short bf16_t;
typedef short bf16x8 __attribute__((ext_vector_type(8)));
typedef short s16x4 __attribute__((ext_vector_type(4)));
typedef float f32x4 __attribute__((ext_vector_type(4)));
typedef float f32x2 __attribute__((ext_vector_type(2)));
typedef float f32x16 __attribute__((ext_vector_type(16)));
typedef unsigned u32x4 __attribute__((ext_vector_type(4)));
typedef unsigned u32x2 __attribute__((ext_vector_type(2)));
typedef int i32x8 __attribute__((ext_vector_type(8)));
#ifndef MOE_FP8
#define MOE_FP8 1
#endif
#ifndef ATT_FP8
#define ATT_FP8 1
#endif

constexpr size_t MiB = 1u << 20;
constexpr size_t WS_CTL = 0, CTL_ZERO_BYTES = 512 * 1024;
constexpr size_t WS_WGIN = 1 * MiB;
constexpr size_t WS_WV = 7 * MiB;
constexpr size_t WS_WGOUT = 9 * MiB;
constexpr size_t WS_WMIN = 11 * MiB;
constexpr size_t WS_WUQ = 12 * MiB;
constexpr size_t WS_WUKV = 14 * MiB;
constexpr size_t WS_WMOUT = 16 * MiB;
constexpr size_t WS_WGU = 20 * MiB;
constexpr size_t WS_WD = 148 * MiB;
constexpr size_t WS_AFF = 212 * MiB;
constexpr size_t WS_SEL = 213 * MiB;
constexpr size_t WS_IDX = 214 * MiB;
constexpr size_t WS_EGL = 215 * MiB;
constexpr size_t WS_CS = 216 * MiB;
constexpr size_t WS_XN = 220 * MiB;
constexpr size_t WS_HB = 252 * MiB;
constexpr size_t WS_AR = 316 * MiB;
constexpr size_t WS_AFFT = 828 * MiB;
constexpr size_t WS_END = 829 * MiB;
constexpr size_t AR_Q0 = WS_AR, AR_K0 = WS_AR + 16 * MiB, AR_GF = WS_AR + 32 * MiB, AR_GB = WS_AR + 64 * MiB, AR_SR = WS_AR + 96 * MiB, AR_VT = WS_AR + 128 * MiB;
constexpr size_t AR_QDF = WS_AR + 160 * MiB, AR_QDB = WS_AR + 176 * MiB, AR_KDF = WS_AR + 192 * MiB, AR_KDB = WS_AR + 208 * MiB, AR_KTF = WS_AR + 224 * MiB, AR_KTB = WS_AR + 240 * MiB;
constexpr size_t AR_U = WS_AR + 256 * MiB, AR_ST = WS_AR + 384 * MiB;
constexpr size_t AR_XS = WS_AR, AR_H = WS_AR + 64 * MiB, AR_Y = WS_AR + 192 * MiB, AR_XN8 = WS_AR + 256 * MiB;
constexpr size_t AR_CIN = WS_AR, AR_CQN = WS_AR + 32 * MiB, AR_CKVN = WS_AR + 40 * MiB, AR_Q = WS_AR + 48 * MiB, AR_K = WS_AR + 144 * MiB, AR_V = WS_AR + 240 * MiB, AR_O = WS_AR + 304 * MiB;

constexpr size_t AR_Q8 = AR_Q, AR_K8 = AR_K, AR_V8T = AR_V;
constexpr int LDS_BYTES = 147456;
constexpr int LDS_MISC = 135168;

__device__ __forceinline__ unsigned cvt_pk_bf16(float lo, float hi) { unsigned r; asm volatile("v_cvt_pk_bf16_f32 %0, %1, %2" : "=v"(r) : "v"(lo), "v"(hi)); return r; }
__device__ __forceinline__ float bf_lo(unsigned w) { return __uint_as_float(w << 16); }
__device__ __forceinline__ float bf_hi(unsigned w) { return __uint_as_float(w & 0xffff0000u); }
__device__ __forceinline__ float bf2f(bf16_t b) { return __uint_as_float(((unsigned)b) << 16); }
__device__ __forceinline__ bf16_t f2bf(float f) { return (bf16_t)(cvt_pk_bf16(f, 0.f) & 0xffffu); }
__device__ __forceinline__ float siluf(float x) { return x / (1.f + __expf(-x)); }
__device__ __forceinline__ float logsigf(float x) { return fminf(x, 0.f) - log1pf(__expf(-fabsf(x))); }
__device__ __forceinline__ void store8bf(bf16_t* p, f32x4 v0, f32x4 v1) {
    u32x4 w; w.x = cvt_pk_bf16(v0[0], v0[1]); w.y = cvt_pk_bf16(v0[2], v0[3]); w.z = cvt_pk_bf16(v1[0], v1[1]); w.w = cvt_pk_bf16(v1[2], v1[3]); *(u32x4*)p = w; }
__device__ __forceinline__ unsigned pk4fp8(float a, float b, float c, float d) { int w = __builtin_amdgcn_cvt_pk_fp8_f32(a, b, 0, false); w = __builtin_amdgcn_cvt_pk_fp8_f32(c, d, w, true); return (unsigned)w; }
__device__ __forceinline__ void store8fp8(unsigned char* p, f32x4 v0, f32x4 v1) { u32x2 w; w.x = pk4fp8(v0[0], v0[1], v0[2], v0[3]); w.y = pk4fp8(v1[0], v1[1], v1[2], v1[3]); *(u32x2*)p = w; }
__device__ __forceinline__ float fp8f(const unsigned char* p) { const unsigned w = *(const unsigned*)((size_t)p & ~(size_t)3); const int b = (int)((size_t)p & 3);
    return b == 0 ? __builtin_amdgcn_cvt_f32_fp8((int)w, 0) : b == 1 ? __builtin_amdgcn_cvt_f32_fp8((int)w, 1) : b == 2 ? __builtin_amdgcn_cvt_f32_fp8((int)w, 2) : __builtin_amdgcn_cvt_f32_fp8((int)w, 3); }
__device__ __forceinline__ float wave_sum(float v) {
#pragma unroll
    for (int o = 1; o < 64; o <<= 1) v += __shfl_xor(v, o);
    return v; }
__device__ __forceinline__ float wave_max(float v) {
#pragma unroll
    for (int o = 1; o < 64; o <<= 1) v = fmaxf(v, __shfl_xor(v, o));
    return v; }
#define LAS __attribute__((address_space(3)))
#define LDS_WAIT() asm volatile("s_waitcnt lgkmcnt(0)" ::: "memory")
#define VM_WAIT() asm volatile("s_waitcnt vmcnt(0)" ::: "memory")

namespace pg8 {
#define PG8_LAS __attribute__((address_space(3)))
typedef unsigned short bf16_t;
typedef short bf16x8 __attribute__((ext_vector_type(8)));
typedef float f32x4 __attribute__((ext_vector_type(4)));
typedef unsigned u32x4 __attribute__((ext_vector_type(4)));
constexpr int BM = 256, BK = 64, HALF = 128, HTB = HALF * BK * 2  , STAGE_BYTES = 8 * HTB, NXCD = 8, WGM = 8;

__host__ __device__ __forceinline__ int lds_byte(int r, int c) { const int st = (r >> 4) * 2 + (c >> 5), rr = r & 15, cc = c & 31, ob = rr * 64 + cc * 2; return st * 1024 + (ob ^ (((ob >> 9) & 1) << 5)); }
__host__ __device__ __forceinline__ void stage_rc(int b, int& R, int& C) { const int st = b / 1024, sb = b % 1024, swz = sb ^ (((sb >> 9) & 1) << 5); R = (st >> 1) * 16 + swz / 64; C = (st & 1) * 32 + (swz % 64) / 2; }
__host__ __device__ __forceinline__ int perm32(int rho) { const int n = rho >> 4, i = rho & 15; return 8 * (i >> 2) + 4 * n + (i & 3); }

struct Unit { int pm, pn; };
struct Gemm { const bf16_t* A; const bf16_t* Bt; int M, N, K; };

struct StaticOrder {
    int nM, nN, nwg, G, c, rep;
    __host__ __device__ void init(int M, int N, int G_, int c_) { nM = M / BM; nN = N / BM; nwg = nM * nN; G = G_; c = c_; rep = 1; }
    __host__ __device__ bool next(int i, Unit& u) const {
        if (rep > 1) { const int cnt = (nwg - c + G - 1) / G; if (cnt <= 0 || i >= cnt * rep) return false; i = i % cnt; }
        const long L = (long)i * G + c; if (L >= nwg) return false;
        int wgid = (int)L; { const int q = nwg / NXCD, r = nwg % NXCD, xcd = wgid % NXCD, off = wgid / NXCD; wgid = (xcd < r ? xcd * (q + 1) : r * (q + 1) + (xcd - r) * q) + off; }
        const int nig = WGM * nN, gid = wgid / nig, fm = gid * WGM, gsz = (nM - fm) < WGM ? (nM - fm) : WGM;
        u.pm = fm + ((wgid % nig) % gsz); u.pn = (wgid % nig) / gsz; return true;
    }
    __device__ __forceinline__ void a_ready(const Unit&) const {}
    __device__ __forceinline__ void done(const Unit&) const {}
};

struct GroupedOrder : StaticOrder {
    int nNl;
    __host__ __device__ void init(int Mtot, int Nper, int G_, int c_) { StaticOrder::init(Mtot, Nper, G_, c_); nNl = Nper / BM; }
    __host__ __device__ bool next(int i, Unit& u) const { if (!StaticOrder::next(i, u)) return false; u.pn += (u.pm >> 3) * nNl; return true; }
};

#define EPI_LOOP_ROWS for (int ai = 0; ai < 2; ++ai) _Pragma("unroll") for (int m = 0; m < 4; ++m)

struct EpiGlaIn {
    static constexpr bool PERM = true, AFTER_DRAIN = false;
    bf16_t *Q0, *K0, *SR; float *GF, *GB; const float *bF, *bB;
    __device__ __forceinline__ void operator()(const f32x4 (&acc)[2][2][4][2], const Unit& u, int wr, int wc, int fr, int fq) const {
        const int row0 = u.pm * BM + wr * 64 + fr, pn = u.pn;
#pragma unroll
        EPI_LOOP_ROWS { const size_t row = (size_t)(row0 + ai * HALF + m * 16);
#pragma unroll
            for (int bj = 0; bj < 2; ++bj) { const int cl = bj * HALF + wc * 32 + 8 * fq; f32x4 v0 = acc[ai][bj][m][0], v1 = acc[ai][bj][m][1];
                if (pn < 2) { const float s = 0.08838834764831845f; store8bf(Q0 + row * 512 + pn * 256 + cl, v0 * s, v1 * s); }
                else if (pn < 4) { store8bf(K0 + row * 512 + (pn - 2) * 256 + cl, v0, v1); }
                else if (pn < 8) {
#pragma unroll
                    for (int j = 0; j < 4; ++j) { v0[j] = siluf(v0[j]); v1[j] = siluf(v1[j]); }
                    store8bf(SR + row * 1024 + (pn - 4) * 256 + cl, v0, v1); }
                else { float* G = pn < 10 ? GF : GB; const float* b = pn < 10 ? bF : bB; const int c = ((pn - 8) & 1) * 256 + cl;
                    const f32x4 b0 = *(const f32x4*)(b + c), b1 = *(const f32x4*)(b + c + 4); f32x4 o0, o1;
#pragma unroll
                    for (int j = 0; j < 4; ++j) { o0[j] = logsigf(v0[j] + b0[j]) * 0.0625f; o1[j] = logsigf(v1[j] + b1[j]) * 0.0625f; }
                    *(f32x4*)(G + row * 512 + c) = o0; *(f32x4*)(G + row * 512 + c + 4) = o1; } } }
    }
};
struct EpiBf {
    static constexpr bool PERM = true, AFTER_DRAIN = false;
    bf16_t* O; int ldc;
    __device__ __forceinline__ void operator()(const f32x4 (&acc)[2][2][4][2], const Unit& u, int wr, int wc, int fr, int fq) const {
        const int row0 = u.pm * BM + wr * 64 + fr;
#pragma unroll
        EPI_LOOP_ROWS { bf16_t* rowp = O + (size_t)(row0 + ai * HALF + m * 16) * ldc + u.pn * BM + wc * 32 + 8 * fq;
#pragma unroll
            for (int bj = 0; bj < 2; ++bj) store8bf(rowp + bj * HALF, acc[ai][bj][m][0], acc[ai][bj][m][1]); }
    }
};
struct EpiF32 {
    static constexpr bool PERM = false, AFTER_DRAIN = false;
    float* C; const float* base; int ldc;
    __device__ __forceinline__ void operator()(const f32x4 (&acc)[2][2][4][2], const Unit& u, int wr, int wc, int fr, int fq) const {
        const int row0 = u.pm * BM + wr * 64 + fr, col0 = u.pn * BM + wc * 32 + 4 * fq;
#pragma unroll
        EPI_LOOP_ROWS { const size_t off = (size_t)(row0 + ai * HALF + m * 16) * ldc + col0;
#pragma unroll
            for (int bj = 0; bj < 2; ++bj)
#pragma unroll
                for (int n = 0; n < 2; ++n) { f32x4 v = acc[ai][bj][m][n]; if (base) v = v + *(const f32x4*)(base + off + bj * HALF + n * 16); *(f32x4*)(C + off + bj * HALF + n * 16) = v; } }
    }
};
struct EpiQup {
    static constexpr bool PERM = true, AFTER_DRAIN = false;
    bf16_t* Q; const float* CS;
    __device__ __forceinline__ void operator()(const f32x4 (&acc)[2][2][4][2], const Unit& u, int wr, int wc, int fr, int fq) const {
        const int row0 = u.pm * BM + wr * 64 + fr, h = u.pn; const float QS = 0.07216878364870322f * 1.4426950408889634f;
#pragma unroll
        EPI_LOOP_ROWS { const size_t row = (size_t)(row0 + ai * HALF + m * 16); bf16_t* qrow = Q + ((size_t)h * T + row) * MDK;
            store8bf(qrow + wc * 32 + 8 * fq, acc[ai][0][m][0] * QS, acc[ai][0][m][1] * QS);
            if (wc < 2) { const int i0 = wc * 16 + 4 * fq; const f32x4 c = *(const f32x4*)(CS + row * 64 + i0), s = *(const f32x4*)(CS + row * 64 + 32 + i0);
                const f32x4 x1 = acc[ai][1][m][0], x2 = acc[ai][1][m][1];
                store8bf(qrow + 128 + wc * 32 + 8 * fq, (x1 * c - x2 * s) * QS, (x1 * s + x2 * c) * QS); } }
    }
};
struct EpiKVup {
    static constexpr bool PERM = true, AFTER_DRAIN = false;
    bf16_t *K, *V;
    __device__ __forceinline__ void operator()(const f32x4 (&acc)[2][2][4][2], const Unit& u, int wr, int wc, int fr, int fq) const {
        const int row0 = u.pm * BM + wr * 64 + fr, h = u.pn;
#pragma unroll
        EPI_LOOP_ROWS { const size_t row = (size_t)h * T + (size_t)(row0 + ai * HALF + m * 16);
            store8bf(K + row * MDK + wc * 32 + 8 * fq, acc[ai][0][m][0], acc[ai][0][m][1]);
            store8bf(V + row * MDV + wc * 32 + 8 * fq, acc[ai][1][m][0], acc[ai][1][m][1]); }
    }
};
struct EpiMoe1 {
    static constexpr bool PERM = true, AFTER_DRAIN = false;
    bf16_t* H;
    __device__ __forceinline__ void operator()(const f32x4 (&acc)[2][2][4][2], const Unit& u, int wr, int wc, int fr, int fq) const {
        const int row0 = u.pm * BM + wr * 64 + fr, j = u.pn & 15;
#pragma unroll
        EPI_LOOP_ROWS { const size_t eo = (size_t)(row0 + ai * HALF + m * 16) * FF + 128 * j + 16 * wc + 4 * fq; bf16_t* rowp = H + eo;
#pragma unroll
            for (int bj = 0; bj < 2; ++bj) { f32x4 g = acc[ai][bj][m][0], uu = acc[ai][bj][m][1];
                if (MOE_FP8) { g = g * 0.03125f; uu = uu * 0.03125f; *(unsigned*)((unsigned char*)H + eo + 64 * bj) = pk4fp8(siluf(g[0]) * uu[0], siluf(g[1]) * uu[1], siluf(g[2]) * uu[2], siluf(g[3]) * uu[3]); continue; }
                u32x2 w; w.x = cvt_pk_bf16(siluf(g[0]) * uu[0], siluf(g[1]) * uu[1]); w.y = cvt_pk_bf16(siluf(g[2]) * uu[2], siluf(g[3]) * uu[3]);
                *(u32x2*)(rowp + 64 * bj) = w; } }
    }
};
struct EpiMoe2 {
    static constexpr bool PERM = true, AFTER_DRAIN = false;
    bf16_t* Y;
    __device__ __forceinline__ void operator()(const f32x4 (&acc)[2][2][4][2], const Unit& u, int wr, int wc, int fr, int fq) const {
        const int row0 = u.pm * BM + wr * 64 + fr, j = u.pn & 3;
#pragma unroll
        EPI_LOOP_ROWS { bf16_t* rowp = Y + (size_t)(row0 + ai * HALF + m * 16) * D + 256 * j + wc * 32 + 8 * fq;
#pragma unroll
            for (int bj = 0; bj < 2; ++bj) { const float sc = MOE_FP8 ? 0.03125f : 1.0f; store8bf(rowp + bj * HALF, acc[ai][bj][m][0] * sc, acc[ai][bj][m][1] * sc); } }
    }
};

struct EpiQ8 {
    static constexpr bool PERM = true, AFTER_DRAIN = false;
    unsigned char* Q; const float* CS;
    __device__ __forceinline__ void operator()(const f32x4 (&acc)[2][2][4][2], const Unit& u, int wr, int wc, int fr, int fq) const {
        const int row0 = u.pm * BM + wr * 64 + fr, h = u.pn; const float QS = 8.0f * 0.07216878364870322f * 1.4426950408889634f;
#pragma unroll
        EPI_LOOP_ROWS { const size_t row = (size_t)(row0 + ai * HALF + m * 16); unsigned char* qrow = Q + ((size_t)h * T + row) * MDK;
            store8fp8(qrow + wc * 32 + 8 * fq, acc[ai][0][m][0] * QS, acc[ai][0][m][1] * QS);
            if (wc < 2) { const int i0 = wc * 16 + 4 * fq; const f32x4 c = *(const f32x4*)(CS + row * 64 + i0), s = *(const f32x4*)(CS + row * 64 + 32 + i0);
                const f32x4 x1 = acc[ai][1][m][0], x2 = acc[ai][1][m][1];
                store8fp8(qrow + 128 + wc * 32 + 8 * fq, (x1 * c - x2 * s) * QS, (x1 * s + x2 * c) * QS); } }
    }
};
struct EpiK8 {
    static constexpr bool PERM = true, AFTER_DRAIN = false;
    unsigned char* K;
    __device__ __forceinline__ void operator()(const f32x4 (&acc)[2][2][4][2], const Unit& u, int wr, int wc, int fr, int fq) const {
        const int row0 = u.pm * BM + wr * 64 + fr;
#pragma unroll
        EPI_LOOP_ROWS { const size_t row = (size_t)(row0 + ai * HALF + m * 16);
#pragma unroll
            for (int bj = 0; bj < 2; ++bj) store8fp8(K + ((size_t)(2 * u.pn + bj) * T + row) * MDK + wc * 32 + 8 * fq, acc[ai][bj][m][0], acc[ai][bj][m][1]); }
    }
};
struct EpiV8T {
    static constexpr bool PERM = true, AFTER_DRAIN = false;
    unsigned char* V;
    __device__ __forceinline__ void operator()(const f32x4 (&acc)[2][2][4][2], const Unit& u, int wr, int wc, int fr, int fq) const {
        const int row0 = u.pm * BM + wr * 64 + fr;
#pragma unroll
        EPI_LOOP_ROWS { unsigned char* rowp = V + (size_t)(row0 + ai * HALF + m * 16) * T + u.pn * BM + 64 * (wc >> 1) + 16 * (wc & 1) + 4 * fq;
#pragma unroll
            for (int bj = 0; bj < 2; ++bj) { const f32x4 a = acc[ai][bj][m][0], b = acc[ai][bj][m][1];
                *(unsigned*)(rowp + bj * HALF) = pk4fp8(a[0], a[1], a[2], a[3]); *(unsigned*)(rowp + bj * HALF + 32) = pk4fp8(b[0], b[1], b[2], b[3]); } }
    }
};

typedef int i32x4g __attribute__((ext_vector_type(4)));
template <class Epi, class Sched, bool ALIGN_EPI = false, bool SP2 = false, bool F8 = false>
__device__ __forceinline__ void gemm_phase(PG8_LAS unsigned char* lds, const Gemm g, const Sched& S, const Epi& E) {
    const int tid = threadIdx.x, wid = __builtin_amdgcn_readfirstlane(tid >> 6), lane = tid & 63, wr = wid >> 2, wc = wid & 3, fr = lane & 15, fq = lane >> 4;
    int K = g.K; asm volatile("" : "+s"(K));
    const int nt = K / BK;
    unsigned voffA[2], voffB[2];
#pragma unroll
    for (int i = 0; i < 2; ++i) { int R, C; stage_rc(tid * 16 + i * 8192, R, C); const int Rb = Epi::PERM ? ((R & ~31) + perm32(R & 31)) : R;
        voffA[i] = (unsigned)(R * K + C) * 2u; voffB[i] = (unsigned)(Rb * K + C) * 2u; }
    const size_t kstep = (size_t)(BK * 2);
    const size_t hstep = (size_t)HALF * K * 2;
    const size_t tstep = 2 * hstep;
    const unsigned ldsw = (unsigned)wid * 1024u;
    const int aoff = lds_byte(wr * 64 + fr, fq * 8), boff = lds_byte(wc * 32 + fr, fq * 8);
    PG8_LAS unsigned char* const ldsA = lds + aoff; PG8_LAS unsigned char* const ldsB = lds + 4 * HTB + boff;
#define PG8_SA(b, h) (((b) * 2 + (h)) * HTB)
#define PG8_SB(b, h) ((4 + (b) * 2 + (h)) * HTB)
#define PG8_STAGE(bufoff, gbase, voff) do { _Pragma("unroll") for (int _i = 0; _i < 2; ++_i) \
        __builtin_amdgcn_global_load_lds((const unsigned*)((const char*)(gbase) + (voff)[_i]), (PG8_LAS unsigned*)(lds + (bufoff) + ldsw + _i * 8192), 16, 0, 0); } while (0)
#define PG8_LD8(base, off) __builtin_shufflevector(*(const PG8_LAS i32x4g*)((base) + (off)), *(const PG8_LAS i32x4g*)((base) + (off) + 1024), 0, 1, 2, 3, 4, 5, 6, 7)
#define PG8_LDA(dst, b, h) do { _Pragma("unroll") for (int m = 0; m < 4; ++m) { if constexpr (F8) dst##8[m] = PG8_LD8(ldsA, PG8_SA(b, h) + m * 2048); else { _Pragma("unroll") for (int k = 0; k < 2; ++k) dst[m][k] = *(const PG8_LAS bf16x8*)(lds + PG8_SA(b, h) + aoff + m * 2048 + k * 1024); } } } while (0)
#define PG8_LDB(dst, b, h) do { _Pragma("unroll") for (int n = 0; n < 2; ++n) { if constexpr (F8) dst##8[n] = PG8_LD8(ldsB, PG8_SA(b, h) + n * 2048); else { _Pragma("unroll") for (int k = 0; k < 2; ++k) dst[n][k] = *(const PG8_LAS bf16x8*)(lds + PG8_SB(b, h) + boff + n * 2048 + k * 1024); } } } while (0)
#define PG8_CAT(x, y) __builtin_shufflevector((i32x4g)(x), (i32x4g)(y), 0, 1, 2, 3, 4, 5, 6, 7)
#define PG8_MMA(ai, bj, At, Bt) do { __builtin_amdgcn_s_setprio(1); _Pragma("unroll") for (int m = 0; m < 4; ++m) _Pragma("unroll") for (int n = 0; n < 2; ++n) { \
        if constexpr (F8) asm volatile("v_mfma_scale_f32_16x16x128_f8f6f4 %0, %1, %2, %0, %3, %3 op_sel_hi:[0,0,0]" : "+v"(acc[ai][bj][m][n]) : "v"(Bt##8[n]), "v"(At##8[m]), "v"(scl8));     \
        else { _Pragma("unroll") for (int k = 0; k < 2; ++k) acc[ai][bj][m][n] = __builtin_amdgcn_mfma_f32_16x16x32_bf16(Bt[n][k], At[m][k], acc[ai][bj][m][n], 0, 0, 0); } } \
        __builtin_amdgcn_s_setprio(0); } while (0)
#define PG8_WAIT_V(n) asm volatile("s_waitcnt vmcnt(" #n ")" ::: "memory")
#define PG8_WAIT_L(n) asm volatile("s_waitcnt lgkmcnt(" #n ")" ::: "memory")
#define PG8_BAR __builtin_amdgcn_s_barrier()
#define PG8_SCHED __builtin_amdgcn_sched_barrier(0)
    Unit cur, nxt; int ui = 0;
    if (!S.next(0, cur)) return;
    f32x4 acc[2][2][4][2];
#pragma unroll
    for (int a = 0; a < 2; ++a)
#pragma unroll
        for (int b = 0; b < 2; ++b)
#pragma unroll
            for (int m = 0; m < 4; ++m)
#pragma unroll
                for (int n = 0; n < 2; ++n) acc[a][b][m][n] = (f32x4){0.f, 0.f, 0.f, 0.f};
    unsigned scl8 = 0x7f7f7f7fu; asm volatile("" : "+v"(scl8));
    bf16x8 At[4][2], B0[2][2], B1[2][2]; i32x8 At8[4], B08[2], B18[2];
    const char* cA = (const char*)g.A + (size_t)cur.pm * tstep; const char* cB = (const char*)g.Bt + (size_t)cur.pn * tstep;
    S.a_ready(cur);
    if constexpr (SP2) {
        PG8_STAGE(PG8_SB(0, 0), cB, voffB); PG8_STAGE(PG8_SB(0, 1), cB + hstep, voffB); PG8_STAGE(PG8_SA(0, 0), cA, voffA); PG8_STAGE(PG8_SA(0, 1), cA + hstep, voffA);
        if (wr == 1) PG8_BAR;
        PG8_WAIT_V(2); PG8_BAR;
        PG8_STAGE(PG8_SB(1, 0), cB + kstep, voffB); PG8_STAGE(PG8_SA(1, 0), cA + kstep, voffA); PG8_STAGE(PG8_SB(1, 1), cB + hstep + kstep, voffB);
        PG8_WAIT_V(6); PG8_BAR;
    } else {
        PG8_STAGE(PG8_SB(0, 0), cB, voffB); PG8_STAGE(PG8_SA(0, 0), cA, voffA); PG8_STAGE(PG8_SB(0, 1), cB + hstep, voffB); PG8_STAGE(PG8_SA(0, 1), cA + hstep, voffA);
        if (wr == 1) PG8_BAR;
        PG8_WAIT_V(4); PG8_BAR;
        PG8_STAGE(PG8_SB(1, 0), cB + kstep, voffB); PG8_STAGE(PG8_SA(1, 0), cA + kstep, voffA); PG8_STAGE(PG8_SB(1, 1), cB + hstep + kstep, voffB);
        PG8_WAIT_V(6); PG8_BAR;
    }
    for (;;) {
        const bool has_next = S.next(ui + 1, nxt);
        const char* nA = has_next ? (const char*)g.A + (size_t)nxt.pm * tstep : cA; const char* nB = has_next ? (const char*)g.Bt + (size_t)nxt.pn * tstep : cB;
        for (int t = 0; t < nt; t += 2) {
            const bool last = (t == nt - 2);
            const char* a1 = cA + (size_t)(t + 1) * kstep;
            const char* a2 = last ? nA : cA + (size_t)(t + 2) * kstep; const char* b2 = last ? nB : cB + (size_t)(t + 2) * kstep;
            const char* a3 = a2 + kstep; const char* b3 = b2 + kstep;
            if (last && has_next) S.a_ready(nxt);
            if constexpr (SP2) {
            PG8_LDB(B0, 0, 0); PG8_LDB(B1, 0, 1); PG8_SCHED; PG8_LDA(At, 0, 0); PG8_STAGE(PG8_SA(1, 1), a1 + hstep, voffA);
            PG8_WAIT_V(8); PG8_WAIT_L(0); PG8_BAR; PG8_MMA(0, 0, At, B0); PG8_MMA(0, 1, At, B1); PG8_BAR; PG8_SCHED;
            PG8_LDA(At, 0, 1); PG8_STAGE(PG8_SB(0, 0), b2, voffB); PG8_STAGE(PG8_SB(0, 1), b2 + hstep, voffB); PG8_STAGE(PG8_SA(0, 0), a2, voffA);
            PG8_WAIT_V(8); PG8_WAIT_L(0); PG8_BAR; PG8_MMA(1, 0, At, B0); PG8_MMA(1, 1, At, B1); PG8_BAR; PG8_SCHED;
            PG8_LDB(B0, 1, 0); PG8_LDB(B1, 1, 1); PG8_SCHED; PG8_LDA(At, 1, 0); PG8_STAGE(PG8_SA(0, 1), a2 + hstep, voffA);
            PG8_WAIT_V(8); PG8_WAIT_L(0); PG8_BAR; PG8_MMA(0, 0, At, B0); PG8_MMA(0, 1, At, B1); PG8_BAR; PG8_SCHED;
            PG8_LDA(At, 1, 1); PG8_STAGE(PG8_SB(1, 0), b3, voffB); PG8_STAGE(PG8_SB(1, 1), b3 + hstep, voffB); PG8_STAGE(PG8_SA(1, 0), a3, voffA);
            PG8_WAIT_V(8); PG8_WAIT_L(0); PG8_BAR; PG8_MMA(1, 0, At, B0); PG8_MMA(1, 1, At, B1); PG8_BAR; PG8_SCHED;
            } else {
            PG8_LDB(B0, 0, 0); PG8_SCHED; PG8_LDA(At, 0, 0); PG8_STAGE(PG8_SA(1, 1), a1 + hstep, voffA);
            PG8_WAIT_L(8); PG8_BAR; PG8_WAIT_L(0); PG8_MMA(0, 0, At, B0); PG8_BAR; PG8_SCHED;
            PG8_LDB(B1, 0, 1); PG8_STAGE(PG8_SB(0, 0), b2, voffB);
            PG8_BAR; PG8_WAIT_L(0); PG8_MMA(0, 1, At, B1); PG8_BAR;
            PG8_LDA(At, 0, 1); PG8_STAGE(PG8_SA(0, 0), a2, voffA);
            PG8_BAR; PG8_WAIT_L(0); PG8_MMA(1, 0, At, B0); PG8_BAR; PG8_SCHED;
            PG8_STAGE(PG8_SB(0, 1), b2 + hstep, voffB);
            PG8_WAIT_V(6); PG8_BAR; PG8_MMA(1, 1, At, B1); PG8_BAR;
            PG8_LDB(B0, 1, 0); PG8_SCHED; PG8_LDA(At, 1, 0); PG8_STAGE(PG8_SA(0, 1), a2 + hstep, voffA);
            PG8_WAIT_L(8); PG8_BAR; PG8_WAIT_L(0); PG8_MMA(0, 0, At, B0); PG8_BAR; PG8_SCHED;
            PG8_LDB(B1, 1, 1); PG8_STAGE(PG8_SB(1, 0), b3, voffB);
            PG8_BAR; PG8_WAIT_L(0); PG8_MMA(0, 1, At, B1); PG8_BAR;
            PG8_LDA(At, 1, 1); PG8_STAGE(PG8_SA(1, 0), a3, voffA);
            PG8_BAR; PG8_WAIT_L(0); PG8_MMA(1, 0, At, B0); PG8_BAR; PG8_SCHED;
            PG8_STAGE(PG8_SB(1, 1), b3 + hstep, voffB);
            PG8_WAIT_V(6); PG8_BAR; PG8_MMA(1, 1, At, B1); PG8_BAR;
            }
        }
        if constexpr (F8) asm volatile("s_nop 15\n\ts_nop 15" ::: "memory");
        if constexpr (ALIGN_EPI) { if (wr == 0) PG8_BAR; }
        if constexpr (!Epi::AFTER_DRAIN) { E(acc, cur, wr, wc, fr, fq); S.done(cur); }
        if (!has_next) break;
#pragma unroll
        for (int a = 0; a < 2; ++a)
#pragma unroll
            for (int b = 0; b < 2; ++b)
#pragma unroll
                for (int m = 0; m < 4; ++m)
#pragma unroll
                    for (int n = 0; n < 2; ++n) acc[a][b][m][n] = (f32x4){0.f, 0.f, 0.f, 0.f};
        cur = nxt; cA = nA; cB = nB; ++ui;
        if constexpr (ALIGN_EPI) { if (wr == 1) PG8_BAR; }
    }
    PG8_WAIT_V(0);
    if constexpr (!ALIGN_EPI) { if (wr == 0) PG8_BAR; }
    PG8_BAR;
    if constexpr (Epi::AFTER_DRAIN) { E.fused(acc, cur, wr, wc, fr, fq, lds, wid, lane); S.done(cur); }
#undef PG8_SA
#undef PG8_SB
#undef PG8_STAGE
#undef PG8_LDA
#undef PG8_LD8
#undef PG8_LDB
#undef PG8_MMA
#undef PG8_CAT
#undef PG8_WAIT_V
#undef PG8_WAIT_L
#undef PG8_BAR
#undef PG8_SCHED
}
}
#define XB_TMO      128
#define XB_XCNT(j)  (256  + 64 * (j))
#define XB_XSUB(j)  (1280 + 64 * (j))
#define XB_XGEN(j)  (2304 + 64 * (j))
#define XB_TOP      3328
#define XB_TOPGEN   3392
#define XCD_BAR_WORDS 3456
#define XB_SPIN_CAP (1u << 18)

__device__ __forceinline__ unsigned xb_ld(unsigned* p)              { return __hip_atomic_load(p, __ATOMIC_RELAXED, __HIP_MEMORY_SCOPE_AGENT); }
__device__ __forceinline__ unsigned xb_add(unsigned* p, unsigned v) { return __hip_atomic_fetch_add(p, v, __ATOMIC_RELAXED, __HIP_MEMORY_SCOPE_AGENT); }
__device__ __forceinline__ unsigned xb_xcc_id() { return (unsigned)__builtin_amdgcn_s_getreg((3 << 11) | 20) & 0xFu; }
#define XB_SPIN(cond, bar) do { unsigned _sp = 0; while (cond) { __builtin_amdgcn_s_sleep(1); \
    if ((++_sp & 255u) == 0u) { if (xb_ld(&(bar)[XB_TMO])) break; if (_sp > XB_SPIN_CAP) { atomicAdd(&(bar)[XB_TMO], 1u); break; } } } } while (0)

struct XcdBarrier {
    unsigned* bar; unsigned x;
    volatile LAS unsigned* st;
};

__device__ __forceinline__ XcdBarrier xcd_barrier_post(unsigned* bar, volatile LAS unsigned* st) {
    XcdBarrier b; b.bar = bar; b.x = xb_xcc_id(); b.st = st;
    if (threadIdx.x == 0) (void)xb_add(&bar[XB_XCNT(b.x)], 1u);
    return b;
}
__device__ __forceinline__ void xcd_barrier_complete(unsigned* bar, unsigned x, unsigned& nloc, unsigned& nx) {
    const unsigned G = gridDim.x * gridDim.y * gridDim.z;
    unsigned sum, cnt, mine, sp = 0u;
    for (;;) {
        sum = 0u; cnt = 0u; mine = 0u;
#pragma unroll
        for (unsigned j = 0; j < 16; ++j) { const unsigned c = xb_ld(&bar[XB_XCNT(j)]); sum += c; cnt += (c > 0u) ? 1u : 0u; mine = (j == x) ? c : mine; }
        if (sum == G) break;
        __builtin_amdgcn_s_sleep(1);
        if ((++sp & 255u) == 0u) { if (xb_ld(&bar[XB_TMO])) break; if (sp > XB_SPIN_CAP) { atomicAdd(&bar[XB_TMO], 1u); break; } }
    }
    nloc = mine > 0u ? mine : 1u; nx = cnt > 0u ? cnt : 1u;
}

__device__ __forceinline__ void xcd_barrier(const XcdBarrier& b) {
    asm volatile("s_waitcnt vmcnt(0)" ::: "memory");
    __syncthreads();
    if (threadIdx.x == 0) {
        unsigned* bar = b.bar;
        __builtin_amdgcn_s_waitcnt(0);
        unsigned nloc = b.st[0], nx = b.st[1];
        if (nloc == 0u) { xcd_barrier_complete(bar, b.x, nloc, nx); b.st[0] = nloc; b.st[1] = nx; }
        const unsigned old = xb_add(&bar[XB_XSUB(b.x)], 1u);
        const unsigned gen = old / nloc;
        if (old + 1u == (gen + 1u) * nloc) {
            __builtin_amdgcn_fence(__ATOMIC_RELEASE, "agent");
            asm volatile("s_waitcnt vmcnt(0)" ::: "memory");
            const unsigned og = xb_add(&bar[XB_TOP], 1u);
            const unsigned tg = og / nx;
            if (og + 1u == (tg + 1u) * nx) xb_add(&bar[XB_TOPGEN], 1u);
            else XB_SPIN(xb_ld(&bar[XB_TOPGEN]) == tg, bar);
            __builtin_amdgcn_fence(__ATOMIC_ACQUIRE, "agent");
            xb_add(&bar[XB_XGEN(b.x)], 1u);
            asm volatile("s_waitcnt vmcnt(0)" ::: "memory");
        } else {
            XB_SPIN(xb_ld(&bar[XB_XGEN(b.x)]) == gen, bar);
            __builtin_amdgcn_fence(__ATOMIC_ACQUIRE, "agent");
            asm volatile("s_waitcnt vmcnt(0)" ::: "memory");
        }
    }
    __syncthreads();
}

#ifndef PG8_SP2
#define PG8_SP2 true
#endif
#ifndef PG8_ALIGN
#define PG8_ALIGN true
#endif

struct Args { const void* in[22]; float* out; unsigned char* ws; float invf[32]; int ph_lo, ph_hi, li, pad; };
struct Ctx { int tid, lane, wave, gw, ngw, bid, nb; unsigned char* lds; };

struct MapId { int off; __device__ __forceinline__ int operator()(int n) const { return off + n; } };
struct MapGU { int which; __device__ __forceinline__ int operator()(int f) const { return 8 * (f >> 2) + 4 * which + (f & 3); } };
struct MapUkv { __device__ __forceinline__ int operator()(int n) const { const int h = n >> 8, j = n & 255; return ATT_FP8 ? (j < 128 ? 128 * h + j : 2048 + 128 * h + (j - 128)) : n; } };
struct MapUq { __device__ __forceinline__ int operator()(int n) const { const int h = n / 192, j = n - h * 192;
    if (j < 128) return 256 * h + j; if (j < 160) { const int i = j - 128; return 256 * h + 128 + 8 * (i >> 2) + (i & 3); } const int i = j - 160; return 256 * h + 128 + 8 * (i >> 2) + 4 + (i & 3); } };
constexpr int TR_SCR = 16896;
__device__ __forceinline__ void tr_load(const float* W, int ldw, int k0, int n0, f32x4 (&v)[16], int lane) {
#pragma unroll
    for (int i = 0; i < 16; ++i) v[i] = *(const f32x4*)(W + (size_t)(k0 + (lane >> 4) + 4 * i) * ldw + n0 + 4 * (lane & 15));
}
template <class RM, bool F8 = false>
__device__ __forceinline__ void tr_flush(const f32x4 (&v)[16], bf16_t* WT, int ldt, int k0, int nloc0, const RM& rm, float* scr, int lane) {
    const int nb = 4 * (lane & 15), kq = lane >> 4;
#pragma unroll
    for (int i = 0; i < 16; ++i) { float* d = scr + nb * 65 + kq + 4 * i; d[0] = v[i][0]; d[65] = v[i][1]; d[130] = v[i][2]; d[195] = v[i][3]; }
    LDS_WAIT();
    const int c = lane & 7;
#pragma unroll
    for (int j = 0; j < 8; ++j) { const int n = (lane >> 3) + 8 * j; const float* q = scr + n * 65 + 8 * c;
        if constexpr (F8) { u32x2 o; o.x = pk4fp8(q[0] * 32.f, q[1] * 32.f, q[2] * 32.f, q[3] * 32.f); o.y = pk4fp8(q[4] * 32.f, q[5] * 32.f, q[6] * 32.f, q[7] * 32.f);
            *(u32x2*)((unsigned char*)WT + (size_t)rm(nloc0 + n) * ldt + k0 + 8 * c) = o; }
        else { u32x4 o; o.x = cvt_pk_bf16(q[0], q[1]); o.y = cvt_pk_bf16(q[2], q[3]); o.z = cvt_pk_bf16(q[4], q[5]); o.w = cvt_pk_bf16(q[6], q[7]);
        *(u32x4*)(WT + (size_t)rm(nloc0 + n) * ldt + k0 + 8 * c) = o; } }
    LDS_WAIT();
}
template <class RM>
__device__ __forceinline__ void tr_job(const Ctx& C, int& base, const float* W, int ldw, int K, int ncol0, int ncols, bf16_t* WT, int ldt, const RM& rm) {
    const int nblk = ncols / 64, items = (K / 64) * nblk; float* scr = (float*)(C.lds + C.wave * TR_SCR);
    int first = (C.gw - base % C.ngw + C.ngw) % C.ngw;
    for (int it = first; it < items; it += C.ngw) { const int kb = it / nblk, nb = it - kb * nblk; f32x4 v[16]; tr_load(W, ldw, 64 * kb, ncol0 + 64 * nb, v, C.lane); tr_flush(v, WT, ldt, 64 * kb, 64 * nb, rm, scr, C.lane); }
    base += items;
}
__device__ __forceinline__ void ph_convert_small(const Ctx& C, const Args& a, unsigned char* ws) {
    const float* w_in = (const float*)a.in[5]; int base = 0;
    bf16_t* WGIN = (bf16_t*)(ws + WS_WGIN);
    tr_job(C, base, w_in, 3104, 1024, 0, 1024, WGIN, 1024, MapId{0});
    tr_job(C, base, w_in, 3104, 1024, 1024, 1024, (bf16_t*)(ws + WS_WV), 1024, MapId{0});
    tr_job(C, base, w_in, 3104, 1024, 2048, 1024, WGIN, 1024, MapId{1024});
    tr_job(C, base, (const float*)a.in[11], 1024, 1024, 0, 1024, (bf16_t*)(ws + WS_WGOUT), 1024, MapId{0});
    tr_job(C, base, (const float*)a.in[12], 448, 1024, 0, 448, (bf16_t*)(ws + WS_WMIN), 1024, MapId{0});
    tr_job(C, base, (const float*)a.in[14], 3072, 256, 0, 3072, (bf16_t*)(ws + WS_WUQ), 256, MapUq{});
    tr_job(C, base, (const float*)a.in[16], 4096, 128, 0, 4096, (bf16_t*)(ws + WS_WUKV), 256, MapUkv{});
    tr_job(C, base, (const float*)a.in[17], 1024, 2048, 0, 1024, (bf16_t*)(ws + WS_WMOUT), 2048, MapId{0});
    const int gt = C.bid * 512 + C.tid, ngt = C.nb * 512;
    for (int it = gt; it < 1024 * 128; it += ngt) { const int cp = it >> 7, k8 = it & 127, dir = cp >> 9, c = cp & 511;
        const float* wg = (const float*)a.in[dir ? 8 : 6]; float wj[16];
#pragma unroll
        for (int j = 0; j < 16; ++j) wj[j] = wg[j * 512 + c];
        float o[8];
#pragma unroll
        for (int kk = 0; kk < 8; ++kk) { const float* wr = w_in + (size_t)(8 * k8 + kk) * 3104 + 3072 + 16 * dir; float s = 0.f;
#pragma unroll
            for (int j4 = 0; j4 < 4; ++j4) { const f32x4 x = *(const f32x4*)(wr + 4 * j4); s += x[0] * wj[4 * j4] + x[1] * wj[4 * j4 + 1] + x[2] * wj[4 * j4 + 2] + x[3] * wj[4 * j4 + 3]; }
            o[kk] = s; }
        u32x4 w; w.x = cvt_pk_bf16(o[0], o[1]); w.y = cvt_pk_bf16(o[2], o[3]); w.z = cvt_pk_bf16(o[4], o[5]); w.w = cvt_pk_bf16(o[6], o[7]);
        *(u32x4*)(WGIN + (size_t)(2048 + cp) * 1024 + 8 * k8) = w; }
    const u32x4 z = {0u, 0u, 0u, 0u};
    for (int it = gt; it < 64 * 128; it += ngt) *(u32x4*)((bf16_t*)(ws + WS_WMIN) + (size_t)448 * 1024 + (size_t)it * 8) = z;
    for (int it = gt; it < 16 * 64 * 32; it += ngt) { const int h = it >> 11, r = (it >> 5) & 63, c8 = it & 31; *(u32x4*)((bf16_t*)(ws + WS_WUQ) + (size_t)(256 * h + 192 + r) * 256 + c8 * 8) = z; }
    for (int it = gt; it < 4096 * 16; it += ngt) { const int r = it >> 4, c8 = it & 15; *(u32x4*)((bf16_t*)(ws + WS_WUKV) + (size_t)r * 256 + 128 + c8 * 8) = z; }
}
struct MapMoe { int kind; __device__ __forceinline__ int operator()(int f) const { return kind < 2 ? 8 * (f >> 2) + 4 * kind + (f & 3) : f; } };
struct MoeItem { const float* src; bf16_t* dst; int ldw, ldt, k0, n0, kind; };
__device__ __forceinline__ MoeItem moe_item(const Args& a, unsigned char* ws, int layer, int it) {
    const int e = it / 1536, r = it - e * 1536, which = r >> 9, j = r & 511; const size_t le = (size_t)(layer * NE + e); MoeItem m; m.kind = which;
    if (which < 2) { m.src = (const float*)a.in[19 + which] + le * 1024 * 2048; m.ldw = 2048; m.dst = (bf16_t*)(ws + WS_WGU + (size_t)e * 4096 * 1024 * (MOE_FP8 ? 1 : 2)); m.ldt = 1024; m.k0 = 64 * (j >> 5); m.n0 = 64 * (j & 31); }
    else { m.src = (const float*)a.in[21] + le * 2048 * 1024; m.ldw = 1024; m.dst = (bf16_t*)(ws + WS_WD + (size_t)e * 1024 * 2048 * (MOE_FP8 ? 1 : 2)); m.ldt = 2048; m.k0 = 64 * (j >> 4); m.n0 = 64 * (j & 15); }
    return m;
}
__device__ __forceinline__ void ph_convert_moe(const Ctx& C, const Args& a, unsigned char* ws, int layer, int rep) {
    constexpr int NIT1 = NE * 1536; const int NIT = NIT1 * rep; float* scr = (float*)(C.lds + C.wave * TR_SCR);
    int it = C.gw; if (it >= NIT) return;
    f32x4 va[16], vb[16]; MoeItem ma = moe_item(a, ws, layer, it % NIT1), mb = ma; tr_load(ma.src, ma.ldw, ma.k0, ma.n0, va, C.lane);
    for (;;) {
        int nx = it + C.ngw; if (nx < NIT) { mb = moe_item(a, ws, layer, nx % NIT1); tr_load(mb.src, mb.ldw, mb.k0, mb.n0, vb, C.lane); }
        tr_flush<MapMoe, MOE_FP8 != 0>(va, ma.dst, ma.ldt, ma.k0, ma.n0, MapMoe{ma.kind}, scr, C.lane);
        it = nx; if (it >= NIT) break;
        nx = it + C.ngw; if (nx < NIT) { ma = moe_item(a, ws, layer, nx % NIT1); tr_load(ma.src, ma.ldw, ma.k0, ma.n0, va, C.lane); }
        tr_flush<MapMoe, MOE_FP8 != 0>(vb, mb.dst, mb.ldt, mb.k0, mb.n0, MapMoe{mb.kind}, scr, C.lane);
        it = nx; if (it >= NIT) break;
    }
}

__device__ __forceinline__ void row_load(const float* row, int lane, f32x4 (&v)[4]) {
#pragma unroll
    for (int j = 0; j < 4; ++j) v[j] = *(const f32x4*)(row + 256 * j + 4 * lane); }
__device__ __forceinline__ float row_rstd(const f32x4 (&v)[4]) { float s = 0.f;
#pragma unroll
    for (int j = 0; j < 4; ++j) s += (v[j][0] * v[j][0] + v[j][1] * v[j][1]) + (v[j][2] * v[j][2] + v[j][3] * v[j][3]);
    return 1.0f / sqrtf(wave_sum(s) * (1.0f / 1024.0f) + RMS_EPS); }
__device__ __forceinline__ void row_store_bf(bf16_t* row, int lane, const f32x4 (&v)[4]) {
#pragma unroll
    for (int j = 0; j < 4; ++j) { u32x2 w; w.x = cvt_pk_bf16(v[j][0], v[j][1]); w.y = cvt_pk_bf16(v[j][2], v[j][3]); *(u32x2*)(row + 256 * j + 4 * lane) = w; } }

__device__ __forceinline__ void ph_norm(const Ctx& C, const float* src, const float* gain, bf16_t* XN) {
    f32x4 g[4]; row_load(gain, C.lane, g);
    for (int t = C.gw; t < T; t += C.ngw) { f32x4 v[4]; row_load(src + (size_t)t * D, C.lane, v); const float r = row_rstd(v);
#pragma unroll
        for (int j = 0; j < 4; ++j) v[j] = v[j] * r * g[j];
        row_store_bf(XN + (size_t)t * D, C.lane, v); }
}
__device__ __forceinline__ void ph_router(const Ctx& C, const float* Hin, const float* gain, const float* Wr, bf16_t* XN, float* AFF, float* AFFT, unsigned char* XN8) {
    f32x4* Wl = (f32x4*)C.lds;
    for (int idx = C.tid; idx < 4096; idx += 512) { const int l = idx & 63, e4 = (idx >> 6) & 3, i = (idx >> 8) & 3, j = idx >> 10; Wl[idx] = *(const f32x4*)(Wr + (size_t)(256 * j + 4 * l + i) * 16 + 4 * e4); }
    __syncthreads();
    f32x4 g[4]; row_load(gain, C.lane, g);
    for (int t = C.gw; t < T; t += C.ngw) {
        f32x4 v[4]; row_load(Hin + (size_t)t * D, C.lane, v); const float r = row_rstd(v);
#pragma unroll
        for (int j = 0; j < 4; ++j) v[j] = v[j] * r * g[j];
#if MOE_FP8
#pragma unroll
        for (int j = 0; j < 4; ++j) *(unsigned*)(XN8 + (size_t)t * D + 256 * j + 4 * C.lane) = pk4fp8(v[j][0], v[j][1], v[j][2], v[j][3]);
#ifdef DBG
        row_store_bf(XN + (size_t)t * D, C.lane, v);
#endif
#else
        row_store_bf(XN + (size_t)t * D, C.lane, v);
#endif
        float p[16];
#pragma unroll
        for (int e = 0; e < 16; ++e) p[e] = 0.f;
#pragma unroll
        for (int j = 0; j < 4; ++j)
#pragma unroll
            for (int i = 0; i < 4; ++i) { const float x = v[j][i];
#pragma unroll
                for (int e4 = 0; e4 < 4; ++e4) { const f32x4 w = Wl[((j * 4 + i) * 4 + e4) * 64 + C.lane]; p[4 * e4] += x * w[0]; p[4 * e4 + 1] += x * w[1]; p[4 * e4 + 2] += x * w[2]; p[4 * e4 + 3] += x * w[3]; }  asm volatile("" ::: "memory"); }
        float mx = -1e30f;
#pragma unroll
        for (int e = 0; e < 16; ++e) { p[e] = wave_sum(p[e]); mx = fmaxf(mx, p[e]); }
        float s = 0.f;
#pragma unroll
        for (int e = 0; e < 16; ++e) { p[e] = expf(p[e] - mx); s += p[e]; }
        const float inv = 1.0f / s; float mine = 0.f;
#pragma unroll
        for (int e = 0; e < 16; ++e) mine = (C.lane == e) ? p[e] * inv : mine;
        if (C.lane < 16) { AFF[(size_t)t * 16 + C.lane] = mine; AFFT[(size_t)C.lane * T + t] = mine; }
    }
    __syncthreads();
}
__device__ __forceinline__ void ph_select(const Ctx& C, const float* AFFT, int* SEL, int* IDX) {
    if (C.bid >= NE) return;
    const int e = C.bid; unsigned* vals = (unsigned*)C.lds; unsigned* hist = vals + T; unsigned* sh = hist + 256;
    for (int i = C.tid; i < T; i += 512) vals[i] = __float_as_uint(AFFT[(size_t)e * T + i]);
    __syncthreads();
    unsigned prefix = 0u, mask = 0u, remaining = CAP;
    for (int pass = 0; pass < 4; ++pass) { const int shift = 24 - 8 * pass;
        if (C.tid < 256) hist[C.tid] = 0u;
        __syncthreads();
        for (int i = C.tid; i < T; i += 512) { const unsigned v = vals[i]; if ((v & mask) == prefix) atomicAdd(&hist[(v >> shift) & 255u], 1u); }
        __syncthreads();
        if (C.wave == 0) {
            unsigned cb[4]; unsigned tl = 0u;
#pragma unroll
            for (int j = 0; j < 4; ++j) { cb[j] = hist[255 - (4 * C.lane + j)]; tl += cb[j]; }
            unsigned incl = tl;
#pragma unroll
            for (int o = 1; o < 64; o <<= 1) { const unsigned tt = __shfl_up(incl, o); if (C.lane >= o) incl += tt; }
            unsigned cum = incl - tl;
            if (cum < remaining && remaining <= incl) {
#pragma unroll
                for (int j = 0; j < 4; ++j) { if (cum < remaining && cum + cb[j] >= remaining) { sh[0] = (unsigned)(255 - (4 * C.lane + j)); sh[1] = remaining - cum; } cum += cb[j]; } } }
        __syncthreads();
        prefix |= sh[0] << shift; mask |= 255u << shift; remaining = sh[1];
        __syncthreads();
    }
    const unsigned thr = prefix, ntie = remaining;
    unsigned cg = 0u, ce = 0u;
    for (int i = 0; i < 32; ++i) { const unsigned v = vals[C.tid + 512 * i]; cg += v > thr; ce += v == thr; }
    unsigned sg = cg, se = ce;
#pragma unroll
    for (int o = 1; o < 64; o <<= 1) { const unsigned tg = __shfl_up(sg, o), te = __shfl_up(se, o); if (C.lane >= o) { sg += tg; se += te; } }
    if (C.lane == 63) { sh[16 + C.wave] = sg; sh[32 + C.wave] = se; }
    __syncthreads();
    unsigned og = 0u, oe = 0u, totg = 0u;
    for (int w = 0; w < 8; ++w) { const unsigned a = sh[16 + w], b = sh[32 + w]; if (w < C.wave) { og += a; oe += b; } totg += a; }
    unsigned pg = og + sg - cg, pe = oe + se - ce;
    for (int i = 0; i < 32; ++i) { const int t = C.tid + 512 * i; const unsigned v = vals[t]; int slot = -1;
        if (v > thr) slot = (int)pg++; else if (v == thr) { if (pe < ntie) slot = (int)(totg + pe); ++pe; }
        SEL[(size_t)t * 16 + e] = slot + 1; if (slot >= 0) IDX[e * CAP + slot] = t; }
}
__device__ __forceinline__ void ph_gather(const Ctx& C, const int* IDX, const bf16_t* XN, bf16_t* XS, const unsigned char* XN8) {
    for (int r = C.gw; r < NE * CAP; r += C.ngw) { const int t = IDX[r];
        if (MOE_FP8) { ((u32x4*)((unsigned char*)XS + (size_t)r * D))[C.lane] = ((const u32x4*)(XN8 + (size_t)t * D))[C.lane]; }
        else { const u32x4* s = (const u32x4*)(XN + (size_t)t * D); u32x4* d = (u32x4*)(XS + (size_t)r * D); const u32x4 a = s[C.lane], b = s[C.lane + 64]; d[C.lane] = a; d[C.lane + 64] = b; } }
}
template <int MODE>
__device__ __forceinline__ void ph_combine(const Ctx& C, const float* Hin, const float* AFF, const int* SEL, const bf16_t* Y, float* Hout, const float* gain, bf16_t* XN, float* OUT) {
    f32x4 g[4]; row_load(gain, C.lane, g);
    for (int t = C.gw; t < T; t += C.ngw) {
        f32x4 v[4]; row_load(Hin + (size_t)t * D, C.lane, v);
        const int sel = SEL[(size_t)t * 16 + (C.lane & 15)]; const float af = AFF[(size_t)t * 16 + (C.lane & 15)];
#pragma unroll
        for (int e = 0; e < 16; ++e) { const int s = __builtin_amdgcn_readlane(sel, e);
            if (s) { const float a = __uint_as_float(__builtin_amdgcn_readlane(__float_as_uint(af), e)); const bf16_t* y = Y + ((size_t)e * CAP + (s - 1)) * D + 4 * C.lane;
#pragma unroll
                for (int j = 0; j < 4; ++j) { const u32x2 w = *(const u32x2*)(y + 256 * j); v[j][0] += a * bf_lo(w.x); v[j][1] += a * bf_hi(w.x); v[j][2] += a * bf_lo(w.y); v[j][3] += a * bf_hi(w.y); } } }
        if (MODE == 1) {
#pragma unroll
            for (int j = 0; j < 4; ++j) *(f32x4*)(Hout + (size_t)t * D + 256 * j + 4 * C.lane) = v[j]; }
        const float r = row_rstd(v);
#pragma unroll
        for (int j = 0; j < 4; ++j) v[j] = v[j] * r * g[j];
        if (MODE == 1) row_store_bf(XN + (size_t)t * D, C.lane, v);
        else {
#pragma unroll
            for (int j = 0; j < 4; ++j) *(f32x4*)(OUT + (size_t)t * D + 256 * j + 4 * C.lane) = v[j]; }
    }
}

#define MFMA32(a, b, c) __builtin_amdgcn_mfma_f32_32x32x16_bf16((a), (b), (c), 0, 0, 0)
__device__ __forceinline__ int crow(int r, int hi) { return (r & 3) + 8 * (r >> 2) + 4 * hi; }
__device__ __forceinline__ bf16x8 ldfrag(const bf16_t* p) { return *(const bf16x8*)p; }

__device__ __forceinline__ void ph_gla_prep(const Ctx& C, const bf16_t* Q0, const bf16_t* K0, const float* GF, const float* GB,
                                            bf16_t* QDF, bf16_t* QDB, bf16_t* KDF, bf16_t* KDB, bf16_t* KTF, bf16_t* KTB, float* EGL) {
    float* tot = (float*)C.lds;
    const int o = C.wave, l = C.lane; int par = 0;
    for (int c = C.bid; c < GNC; c += C.nb) { const int t0 = c * GC + 8 * o;
        for (int cb = 0; cb < 8; ++cb, par ^= 1) { const int ch = cb * 64 + l; const size_t off0 = (size_t)t0 * 512 + ch;
            float gf[8], gb[8], q[8], k[8];
#pragma unroll
            for (int i = 0; i < 8; ++i) { const size_t of = off0 + (size_t)i * 512; gf[i] = GF[of]; gb[i] = GB[of]; q[i] = bf2f(Q0[of]); k[i] = bf2f(K0[of]); }
            float sf = 0.f, sb = 0.f;
#pragma unroll
            for (int i = 0; i < 8; ++i) { sf += gf[i]; gf[i] = sf; }
#pragma unroll
            for (int i = 7; i >= 0; --i) { sb += gb[i]; gb[i] = sb; }
            float* tp = tot + par * 1024; tp[o * 64 + l] = sf; tp[512 + o * 64 + l] = sb;
            __syncthreads();
            float offf = 0.f, offb = 0.f, allf = 0.f, allb = 0.f;
#pragma unroll
            for (int oo = 0; oo < 8; ++oo) { const float a = tp[oo * 64 + l], b = tp[512 + oo * 64 + l]; offf += (oo < o) ? a : 0.f; offb += (oo > o) ? b : 0.f; allf += a; allb += b; }
            unsigned pf[4], pb[4];
#pragma unroll
            for (int i = 0; i < 8; i += 2) { float kdf[2], kdb[2];
#pragma unroll
                for (int u = 0; u < 2; ++u) { const size_t of = off0 + (size_t)(i + u) * 512; const float ef = __expf(offf + gf[i + u]), eb = __expf(offb + gb[i + u]);
                    kdf[u] = k[i + u] * __builtin_amdgcn_rcpf(ef); kdb[u] = k[i + u] * __builtin_amdgcn_rcpf(eb);
                    QDF[of] = f2bf(q[i + u] * ef); QDB[of] = f2bf(q[i + u] * eb); KDF[of] = f2bf(kdf[u]); KDB[of] = f2bf(kdb[u]); }
                pf[i >> 1] = cvt_pk_bf16(kdf[0], kdf[1]); pb[i >> 1] = cvt_pk_bf16(kdb[0], kdb[1]); }
            *(u32x4*)(KTF + (size_t)ch * T + t0) = (u32x4){pf[0], pf[1], pf[2], pf[3]};
            *(u32x4*)(KTB + (size_t)ch * T + t0) = (u32x4){pb[0], pb[1], pb[2], pb[3]};
            if (o == 0) { EGL[(size_t)c * 512 + ch] = __expf(allf); EGL[(size_t)(GNC + c) * 512 + ch] = __expf(allb); }
        }
    }
    __syncthreads();
}
__device__ __forceinline__ void ph_gla_u(const Ctx& C, const bf16_t* VT, const bf16_t* KTF, const bf16_t* KTB, const float* EGL, bf16_t* U) {
    const int r = C.lane & 31, hh = C.lane >> 5;
    for (int it = C.gw; it < 2 * GH * GNC * 8; it += C.ngw) { const int w = it & 7, unit = it >> 3, c = unit % GNC, h = (unit / GNC) % GH, dir = unit / (GNC * GH); const int t0 = c * GC;
        const bf16_t* KT = dir ? KTB : KTF; const bf16_t* ap = VT + (size_t)(256 * h + 32 * w + r) * T + t0 + 8 * hh;
        bf16x8 a[4];
#pragma unroll
        for (int s = 0; s < 4; ++s) a[s] = ldfrag(ap + 16 * s);
        bf16_t* Ub = U + ((size_t)(dir * GH + h) * GNC + c) * (GDV * GDK);
#pragma unroll
        for (int j = 0; j < 4; ++j) { f32x16 acc = {}; const bf16_t* bp = KT + (size_t)(128 * h + 32 * j + r) * T + t0 + 8 * hh;
#pragma unroll
            for (int s = 0; s < 4; ++s) acc = MFMA32(a[s], ldfrag(bp + 16 * s), acc);
            const float eg = EGL[(size_t)(dir * GNC + c) * 512 + 128 * h + 32 * j + r];
#pragma unroll
            for (int q = 0; q < 16; ++q) Ub[(size_t)(32 * w + crow(q, hh)) * GDK + 32 * j + r] = f2bf(acc[q] * eg); }
    }
}
__device__ __forceinline__ void ph_gla_scan(const Ctx& C, const bf16_t* U, const float* EGL, bf16_t* ST) {
    if (C.tid >= 256) return;
    for (int el = C.bid * 256 + C.tid; el < 2 * GH * GDV * (GDK / 4); el += C.nb * 256) { const int dk4 = el & 31, dv = (el >> 5) & 255, h = (el >> 13) & 3, dir = el >> 15;
        const size_t eb = (size_t)(dir * GH + h) * GNC * (GDV * GDK) + (size_t)dv * GDK + 4 * dk4; const float* eg = EGL + (size_t)dir * GNC * 512 + 128 * h + 4 * dk4;
        float s0 = 0.f, s1 = 0.f, s2 = 0.f, s3 = 0.f;
#pragma unroll 16
        for (int i = 0; i < GNC; ++i) { const int c = dir ? GNC - 1 - i : i; const size_t o = eb + (size_t)c * (GDV * GDK);
            const u32x2 u = *(const u32x2*)(U + o); const f32x4 d = *(const f32x4*)(eg + (size_t)c * 512);
            u32x2 w; w.x = cvt_pk_bf16(s0, s1); w.y = cvt_pk_bf16(s2, s3); *(u32x2*)(ST + o) = w;
            s0 = d[0] * s0 + bf_lo(u.x); s1 = d[1] * s1 + bf_hi(u.x); s2 = d[2] * s2 + bf_lo(u.y); s3 = d[3] * s3 + bf_hi(u.y); }
    }
}
__device__ __forceinline__ void ph_gla_out(const Ctx& C, const bf16_t* QDF, const bf16_t* QDB, const bf16_t* KDF, const bf16_t* KDB, const bf16_t* VT, const bf16_t* ST,
                                           const bf16_t* SR, const float* hnorm, bf16_t* OG) {
    constexpr int ACS = 72;
    bf16_t* AC = (bf16_t*)C.lds; float* SSQ = (float*)(C.lds + 64 * ACS * 2);
    const int w = C.wave, r = C.lane & 31, hh = C.lane >> 5;
    for (int unit = C.bid; unit < GH * GNC; unit += C.nb) { const int h = unit / GNC, c = unit % GNC, t0 = c * GC;
        {
            const int dir = w >> 2, ti = (w >> 1) & 1, si = w & 1;
            if (!((dir == 0 && ti == 0 && si == 1) || (dir == 1 && ti == 1 && si == 0))) {
                const bf16_t* qp = (dir ? QDB : QDF) + (size_t)(t0 + 32 * ti + r) * 512 + 128 * h + 8 * hh; const bf16_t* kp = (dir ? KDB : KDF) + (size_t)(t0 + 32 * si + r) * 512 + 128 * h + 8 * hh;
                f32x16 acc = {};
#pragma unroll
                for (int s = 0; s < 8; ++s) acc = MFMA32(ldfrag(qp + 16 * s), ldfrag(kp + 16 * s), acc);
#pragma unroll
                for (int q = 0; q < 16; ++q) { const int tl = 32 * ti + crow(q, hh), sl = 32 * si + r; const bool keep = dir ? (sl > tl) : (sl <= tl); if (keep) AC[tl * ACS + sl] = f2bf(acc[q]); }
            }
        }
        __syncthreads();
        f32x16 o0 = {}, o1 = {};
#pragma unroll
        for (int dir = 0; dir < 2; ++dir) { const bf16_t* qp = (dir ? QDB : QDF) + (size_t)(t0 + r) * 512 + 128 * h + 8 * hh;
            const bf16_t* sp = ST + ((size_t)(dir * GH + h) * GNC + c) * (GDV * GDK) + (size_t)(32 * w + r) * GDK + 8 * hh;
#pragma unroll
            for (int s = 0; s < 8; ++s) { const bf16x8 b = ldfrag(sp + 16 * s); o0 = MFMA32(ldfrag(qp + 16 * s), b, o0); o1 = MFMA32(ldfrag(qp + 32 * 512 + 16 * s), b, o1); } }
        { const bf16_t* vp = VT + (size_t)(256 * h + 32 * w + r) * T + t0 + 8 * hh;
#pragma unroll
            for (int s = 0; s < 4; ++s) { const bf16x8 b = ldfrag(vp + 16 * s); o0 = MFMA32(ldfrag(AC + r * ACS + 16 * s + 8 * hh), b, o0); o1 = MFMA32(ldfrag(AC + (32 + r) * ACS + 16 * s + 8 * hh), b, o1); } }
#pragma unroll
        for (int q = 0; q < 16; ++q) { float a = o0[q] * o0[q], b = o1[q] * o1[q];
#pragma unroll
            for (int of = 1; of < 32; of <<= 1) { a += __shfl_xor(a, of); b += __shfl_xor(b, of); }
            if (r == 0) { SSQ[w * 64 + crow(q, hh)] = a; SSQ[w * 64 + 32 + crow(q, hh)] = b; } }
        __syncthreads();
        const float gn = hnorm[32 * w + r];
#pragma unroll
        for (int q = 0; q < 16; ++q) { const int tl = crow(q, hh); float sa = 0.f, sb = 0.f;
#pragma unroll
            for (int ww = 0; ww < 8; ++ww) { sa += SSQ[ww * 64 + tl]; sb += SSQ[ww * 64 + 32 + tl]; }
            const float ra = 1.0f / sqrtf(sa * (1.0f / 256.0f) + RMS_EPS), rb = 1.0f / sqrtf(sb * (1.0f / 256.0f) + RMS_EPS);
            const size_t oa = (size_t)(t0 + tl) * 1024 + 256 * h + 32 * w + r, ob = oa + 32 * 1024;
            OG[oa] = f2bf(o0[q] * ra * gn * bf2f(SR[oa])); OG[ob] = f2bf(o1[q] * rb * gn * bf2f(SR[ob])); }
        __syncthreads();
    }
}

__device__ __forceinline__ void ph_mla_tok(const Ctx& C, const float* CIN, const int* pos, const float* qn, const float* kvn, const float* invf, bf16_t* CQN, bf16_t* CKVN, float* CS, bf16_t* K) {
    const int l = C.lane;
    f32x4 g0, g1;
    if (l < 32) { g0 = *(const f32x4*)(qn + 8 * l); g1 = *(const f32x4*)(qn + 8 * l + 4); }
    else if (l < 48) { g0 = *(const f32x4*)(kvn + 8 * (l - 32)); g1 = *(const f32x4*)(kvn + 8 * (l - 32) + 4); }
    else { g0 = (f32x4){1.f, 1.f, 1.f, 1.f}; g1 = g0; }
    const float fr = invf[l & 31];
    for (int t = C.gw; t < T; t += C.ngw) {
        const float* row = CIN + (size_t)t * 512; const f32x4 a = *(const f32x4*)(row + 8 * l), b = *(const f32x4*)(row + 8 * l + 4);
        const float ss = (a[0] * a[0] + a[1] * a[1]) + (a[2] * a[2] + a[3] * a[3]) + (b[0] * b[0] + b[1] * b[1]) + (b[2] * b[2] + b[3] * b[3]);
        const float sq = wave_sum(l < 32 ? ss : 0.f), sk = wave_sum((l >= 32 && l < 48) ? ss : 0.f);
        const float rq = 1.0f / sqrtf(sq * (1.0f / 256.0f) + RMS_EPS), rk = 1.0f / sqrtf(sk * (1.0f / 128.0f) + RMS_EPS);
        const float ang = (float)pos[t] * fr; const double rev = (double)ang * 0.15915494309189533577; const float fr01 = (float)(rev - rint(rev));
        const float cv = __builtin_amdgcn_cosf(fr01), sv = __builtin_amdgcn_sinf(fr01);
        if (l < 32) { CS[(size_t)t * 64 + l] = cv; CS[(size_t)t * 64 + 32 + l] = sv; }
        if (l < 32) store8bf(CQN + (size_t)t * 256 + 8 * l, a * rq * g0, b * rq * g1);
        else if (l < 48) store8bf(CKVN + (size_t)t * 256 + 8 * (l - 32), a * rk * g0, b * rk * g1);
        else { const u32x4 z = {0u, 0u, 0u, 0u}; *(u32x4*)(CKVN + (size_t)t * 256 + 128 + 8 * (l - 48)) = z; }
        f32x4 xa = a, xb = b;
        f32x4 pa, pb;
#pragma unroll
        for (int j = 0; j < 4; ++j) { pa[j] = __shfl(xa[j], (l + 4) & 63); pb[j] = __shfl(xb[j], (l + 4) & 63); }
        f32x4 c0, c1, s0, s1;
#pragma unroll
        for (int j = 0; j < 4; ++j) { const int i = 8 * (l & 3) + j; c0[j] = __shfl(cv, i); c1[j] = __shfl(cv, i + 4); s0[j] = __shfl(sv, i); s1[j] = __shfl(sv, i + 4); }
        if (l >= 48 && l < 52) {
            const f32x4 o1a = xa * c0 - pa * s0, o2a = xa * s0 + pa * c0, o1b = xb * c1 - pb * s1, o2b = xb * s1 + pb * c1;
            u32x4 w0, w1; w0.x = cvt_pk_bf16(o1a[0], o1a[1]); w0.y = cvt_pk_bf16(o1a[2], o1a[3]); w0.z = cvt_pk_bf16(o2a[0], o2a[1]); w0.w = cvt_pk_bf16(o2a[2], o2a[3]);
            w1.x = cvt_pk_bf16(o1b[0], o1b[1]); w1.y = cvt_pk_bf16(o1b[2], o1b[3]); w1.z = cvt_pk_bf16(o2b[0], o2b[1]); w1.w = cvt_pk_bf16(o2b[2], o2b[3]);
            if (ATT_FP8) { u32x4 w8; w8.x = pk4fp8(o1a[0], o1a[1], o1a[2], o1a[3]); w8.y = pk4fp8(o2a[0], o2a[1], o2a[2], o2a[3]); w8.z = pk4fp8(o1b[0], o1b[1], o1b[2], o1b[3]); w8.w = pk4fp8(o2b[0], o2b[1], o2b[2], o2b[3]);
#pragma unroll
                for (int h = 0; h < MH; ++h) *(u32x4*)((unsigned char*)K + ((size_t)h * T + t) * MDK + 128 + 16 * (l & 3)) = w8; }
            else {
#pragma unroll
            for (int h = 0; h < MH; ++h) { bf16_t* kp = K + ((size_t)h * T + t) * MDK + 128 + 16 * (l & 3); *(u32x4*)kp = w0; *(u32x4*)(kp + 8) = w1; } }
        }
    }
}

namespace att {
constexpr int NW = 8, QBLK = 32, KVBLK = 64;
#ifndef ATT_PVSPLIT
#define ATT_PVSPLIT 0
#endif
#ifndef ATT_SDEPTH
#define ATT_SDEPTH 1
#endif
constexpr int SDEPTH = ATT_SDEPTH;
constexpr float THR2 = 11.5f;
constexpr int SHM_V = KVBLK * MDV * 2, SHM_K = KVBLK * 400, SHM_ATTN = 2 * SHM_V + 2 * SHM_K + NW * 64 * 4;
#define KSWZ(row, colB) ((row) * 400 + (colB))
#define SBAR() __builtin_amdgcn_sched_barrier(0)
__device__ __forceinline__ unsigned cvtpk(float lo, float hi) { unsigned r; asm volatile("v_cvt_pk_bf16_f32 %0, %1, %2" : "=v"(r) : "v"(lo), "v"(hi)); return r; }
__device__ __forceinline__ void partialSM(f32x16& p0, f32x16& p1, float& m_reg, float& mn, float& alpha) {
  float pmax = p0[0];
#pragma unroll
  for (int r = 1; r < 16; ++r) pmax = fmaxf(pmax, p0[r]);
#pragma unroll
  for (int r = 0; r < 16; ++r) pmax = fmaxf(pmax, p1[r]);
  { auto rr = __builtin_amdgcn_permlane32_swap(__float_as_uint(pmax), __float_as_uint(pmax), false, false);
    pmax = fmaxf(__uint_as_float(rr[0]), __uint_as_float(rr[1])); }
  if (__builtin_expect(__all(pmax - m_reg <= THR2), 1)) { mn = m_reg; alpha = 1.f; }
  else { mn = fmaxf(m_reg, pmax); alpha = __builtin_amdgcn_exp2f(m_reg - mn); m_reg = mn; }
#pragma unroll
  for (int r = 0; r < 16; ++r) p0[r] = p0[r] - mn;
#pragma unroll
  for (int r = 0; r < 16; ++r) p1[r] = p1[r] - mn;
#pragma unroll
  for (int r = 0; r < 16; ++r) p0[r] = __builtin_amdgcn_exp2f(p0[r]);
}
__device__ __forceinline__ void finishSM(f32x16& p0, f32x16& p1, float alpha, float& l_reg, bf16x8& pa0, bf16x8& pa1, bf16x8& pa2, bf16x8& pa3) {
#pragma unroll
  for (int r = 0; r < 16; ++r) p1[r] = __builtin_amdgcn_exp2f(p1[r]);
  float ps = 0;
#pragma unroll
  for (int r = 0; r < 16; ++r) ps += p0[r];
#pragma unroll
  for (int r = 0; r < 16; ++r) ps += p1[r];
  { auto rr = __builtin_amdgcn_permlane32_swap(__float_as_uint(ps), __float_as_uint(ps), false, false);
    ps = __uint_as_float(rr[0]) + __uint_as_float(rr[1]); }
  l_reg = l_reg * alpha + ps;
#define PK4(P, BASE, OUT) do { unsigned a0 = cvtpk(P[BASE + 0], P[BASE + 1]), a1 = cvtpk(P[BASE + 2], P[BASE + 3]);   \
    unsigned b0 = cvtpk(P[BASE + 4], P[BASE + 5]), b1 = cvtpk(P[BASE + 6], P[BASE + 7]);                              \
    auto r0 = __builtin_amdgcn_permlane32_swap(a0, b0, false, false); auto r1 = __builtin_amdgcn_permlane32_swap(a1, b1, false, false); \
    u32x4 w = {r0[0], r1[0], r0[1], r1[1]}; OUT = *reinterpret_cast<bf16x8*>(&w); } while (0)
  PK4(p0, 0, pa0); PK4(p0, 8, pa1); PK4(p1, 0, pa2); PK4(p1, 8, pa3);
#undef PK4
}
__device__ __forceinline__ void qkt(f32x16& p0, f32x16& p1, const char* Ks, const bf16x8* qr, int r32, int hi) {
  p0 = f32x16{}; p1 = f32x16{};
#pragma unroll
  for (int d0 = 0; d0 < 12; ++d0) { const int cb = (d0 * 16 + hi * 8) * 2;
    const bf16x8 b0 = *reinterpret_cast<const bf16x8*>(Ks + KSWZ(r32, cb));
    const bf16x8 b1 = *reinterpret_cast<const bf16x8*>(Ks + KSWZ(32 + r32, cb));
    p0 = __builtin_amdgcn_mfma_f32_32x32x16_bf16(b0, qr[d0], p0, 0, 0, 0);
    p1 = __builtin_amdgcn_mfma_f32_32x32x16_bf16(b1, qr[d0], p1, 0, 0, 0); }
}
__device__ __forceinline__ int v_st(int k, int c) { const int kk = (k & ~0xC) | ((k & 4) << 1) | ((k & 8) >> 1); return ((kk >> 3) * 4 + (c >> 5)) * 512 + ((kk & 7) * 32 + (c & 31)) * 2; }
__device__ __forceinline__ int v_rd_base(int lane) { return ((lane & 3) << 3) | (((lane >> 2) & 3) << 6) | (((lane >> 4) & 1) << 5) | (((lane >> 5) & 1) << 8); }
constexpr int v_rd_off(int d0, int ks, int half) { return d0 * 512 + ks * 4096 + half * 2048; }
template <int OFF> __device__ __forceinline__ s16x4 tr_read(int vb) {
  s16x4 r; asm volatile("ds_read_b64_tr_b16 %0, %1 offset:%2" : "=&v"(r) : "v"(vb), "i"(OFF) : "memory"); return r;
}
template <int D0> __device__ __forceinline__ void pv_one(f32x16& od, int vb, bf16x8 pa0, bf16x8 pa1, bf16x8 pa2, bf16x8 pa3) {
#if ATT_PVSPLIT
#define PK(L, H) (bf16x8){L[0], L[1], L[2], L[3], H[0], H[1], H[2], H[3]}
  { const s16x4 l0 = tr_read<v_rd_off(D0, 0, 0)>(vb), h0 = tr_read<v_rd_off(D0, 0, 1)>(vb), l1 = tr_read<v_rd_off(D0, 1, 0)>(vb), h1 = tr_read<v_rd_off(D0, 1, 1)>(vb);
    asm volatile("s_waitcnt lgkmcnt(0)" ::: "memory"); SBAR();
    od = __builtin_amdgcn_mfma_f32_32x32x16_bf16(pa0, PK(l0, h0), od, 0, 0, 0);
    od = __builtin_amdgcn_mfma_f32_32x32x16_bf16(pa1, PK(l1, h1), od, 0, 0, 0); }
  { const s16x4 l2 = tr_read<v_rd_off(D0, 2, 0)>(vb), h2 = tr_read<v_rd_off(D0, 2, 1)>(vb), l3 = tr_read<v_rd_off(D0, 3, 0)>(vb), h3 = tr_read<v_rd_off(D0, 3, 1)>(vb);
    asm volatile("s_waitcnt lgkmcnt(0)" ::: "memory"); SBAR();
    od = __builtin_amdgcn_mfma_f32_32x32x16_bf16(pa2, PK(l2, h2), od, 0, 0, 0);
    od = __builtin_amdgcn_mfma_f32_32x32x16_bf16(pa3, PK(l3, h3), od, 0, 0, 0); }
#undef PK
#else
  const s16x4 l0 = tr_read<v_rd_off(D0, 0, 0)>(vb), h0 = tr_read<v_rd_off(D0, 0, 1)>(vb), l1 = tr_read<v_rd_off(D0, 1, 0)>(vb), h1 = tr_read<v_rd_off(D0, 1, 1)>(vb);
  const s16x4 l2 = tr_read<v_rd_off(D0, 2, 0)>(vb), h2 = tr_read<v_rd_off(D0, 2, 1)>(vb), l3 = tr_read<v_rd_off(D0, 3, 0)>(vb), h3 = tr_read<v_rd_off(D0, 3, 1)>(vb);
  asm volatile("s_waitcnt lgkmcnt(0)" ::: "memory"); SBAR();
#define PK(L, H) (bf16x8){L[0], L[1], L[2], L[3], H[0], H[1], H[2], H[3]}
  od = __builtin_amdgcn_mfma_f32_32x32x16_bf16(pa0, PK(l0, h0), od, 0, 0, 0);
  od = __builtin_amdgcn_mfma_f32_32x32x16_bf16(pa1, PK(l1, h1), od, 0, 0, 0);
  od = __builtin_amdgcn_mfma_f32_32x32x16_bf16(pa2, PK(l2, h2), od, 0, 0, 0);
  od = __builtin_amdgcn_mfma_f32_32x32x16_bf16(pa3, PK(l3, h3), od, 0, 0, 0);
#undef PK
#endif
}
__device__ __forceinline__ void pv_d0(f32x16* o, int vb, bf16x8 pa0, bf16x8 pa1, bf16x8 pa2, bf16x8 pa3) {
  pv_one<0>(o[0], vb, pa0, pa1, pa2, pa3); pv_one<1>(o[1], vb, pa0, pa1, pa2, pa3); pv_one<2>(o[2], vb, pa0, pa1, pa2, pa3); pv_one<3>(o[3], vb, pa0, pa1, pa2, pa3);
}
__device__ __forceinline__ void attn_body(const bf16_t* __restrict__ Qb, const bf16_t* __restrict__ Kh, const bf16_t* __restrict__ Vh, bf16_t* __restrict__ Ob, int ldo, int seq, char* lds) {
  const int tid = threadIdx.x, wid = tid >> 6, lane = tid & 63, r32 = lane & 31, hi = lane >> 5;
  char* V_lds = lds; char* K_lds = lds + 2 * SHM_V;
  float* ws = (float*)(lds + 2 * SHM_V + 2 * SHM_K) + wid * 64; float* li_l = ws; float* al_l = ws + 32;
  float m_reg = -1e30f, l_reg = 0; f32x16 o[4] = {}; bf16x8 qr[12];
  const bf16_t* Qw = Qb + (size_t)(wid * QBLK + r32) * MDK + hi * 8;
#pragma unroll
  for (int d0 = 0; d0 < 12; ++d0) qr[d0] = *reinterpret_cast<const bf16x8*>(Qw + d0 * 16);
  const int sr = tid >> 4, sc = (tid & 15) * 8, vst0 = v_st(sr, sc), vst1 = v_st(32 + sr, sc);
  int kst[3];
#pragma unroll
  for (int i = 0; i < 3; ++i) { const int ck = tid + 512 * i, row = ck / 24, cc = ck - row * 24; kst[i] = KSWZ(row, cc * 16); }
  const int vb0 = (int)(uintptr_t)V_lds + v_rd_base(lane);
  const unsigned vo0 = (unsigned)(sr * MDV + sc), ko0 = (unsigned)(tid * 8);
  struct { bf16x8 vs0, vs1, ks0, ks1, ks2; } sr_[SDEPTH];
#define SLOAD(i, k0) do { const bf16_t* vt_ = Vh + (size_t)(k0) * MDV; const bf16_t* kt_ = Kh + (size_t)(k0) * MDK;                                         \
    sr_[i].vs0 = *reinterpret_cast<const bf16x8*>(vt_ + vo0); sr_[i].vs1 = *reinterpret_cast<const bf16x8*>(vt_ + 32 * MDV + vo0);                               \
    sr_[i].ks0 = *reinterpret_cast<const bf16x8*>(kt_ + ko0); sr_[i].ks1 = *reinterpret_cast<const bf16x8*>(kt_ + 4096 + ko0); sr_[i].ks2 = *reinterpret_cast<const bf16x8*>(kt_ + 8192 + ko0); } while (0)
#define SWRITE(b, i) do { *(bf16x8*)(V_lds + (b) * SHM_V + vst0) = sr_[i].vs0; *(bf16x8*)(V_lds + (b) * SHM_V + vst1) = sr_[i].vs1;               \
    *(bf16x8*)(K_lds + (b) * SHM_K + kst[0]) = sr_[i].ks0; *(bf16x8*)(K_lds + (b) * SHM_K + kst[1]) = sr_[i].ks1; *(bf16x8*)(K_lds + (b) * SHM_K + kst[2]) = sr_[i].ks2; } while (0)
#define SWAIT() do { if constexpr (SDEPTH == 2) asm volatile("s_waitcnt vmcnt(5)" ::: "memory"); else asm volatile("s_waitcnt vmcnt(0)" ::: "memory"); } while (0)
#define RESC(a) do { if (__any((a) < 1.f)) { if (hi == 0) al_l[r32] = (a); asm volatile("s_waitcnt lgkmcnt(0)" ::: "memory"); \
    _Pragma("unroll") for (int d = 0; d < 4; ++d) _Pragma("unroll") for (int r = 0; r < 16; ++r) o[d][r] *= al_l[crow(r, hi)]; } } while (0)
  f32x16 pA0, pA1, pB0, pB1; float mnA, mnB, alA, alB; bf16x8 pa0, pa1, pa2, pa3; const int NT = seq / KVBLK;
  constexpr int SE = 0, SO = SDEPTH - 1;
  SLOAD(SE, 0); asm volatile("s_waitcnt vmcnt(0)" ::: "memory"); SWRITE(0, SE); __syncthreads();
  qkt(pA0, pA1, K_lds, qr, r32, hi); partialSM(pA0, pA1, m_reg, mnA, alA);
  SLOAD(SO, KVBLK); if constexpr (SDEPTH == 2) { if (2 < NT) SLOAD(SE, 2 * KVBLK); }
  SWAIT(); SWRITE(1, SO); __syncthreads();
  for (int j = 1; j + 1 < NT; j += 2) {
    SBAR(); qkt(pB0, pB1, K_lds + SHM_K, qr, r32, hi);
    finishSM(pA0, pA1, alA, l_reg, pa0, pa1, pa2, pa3); SBAR();
    SLOAD(SO, (j + SDEPTH) * KVBLK); SBAR();
    pv_d0(o, vb0, pa0, pa1, pa2, pa3); partialSM(pB0, pB1, m_reg, mnB, alB);
    __syncthreads(); SWAIT(); SWRITE(0, SE);
    RESC(alB); __syncthreads();
    SBAR(); qkt(pA0, pA1, K_lds, qr, r32, hi);
    finishSM(pB0, pB1, alB, l_reg, pa0, pa1, pa2, pa3); SBAR();
    if (SDEPTH == 1 || j + 3 < NT) SLOAD(SE, (j + 1 + SDEPTH) * KVBLK); SBAR();
    pv_d0(o, vb0 + SHM_V, pa0, pa1, pa2, pa3); partialSM(pA0, pA1, m_reg, mnA, alA);
    __syncthreads(); SWAIT(); SWRITE(1, SO);
    RESC(alA); __syncthreads();
  }
  SBAR(); qkt(pB0, pB1, K_lds + SHM_K, qr, r32, hi);
  finishSM(pA0, pA1, alA, l_reg, pa0, pa1, pa2, pa3); SBAR();
  pv_d0(o, vb0, pa0, pa1, pa2, pa3); partialSM(pB0, pB1, m_reg, mnB, alB);
  __syncthreads(); RESC(alB);
  finishSM(pB0, pB1, alB, l_reg, pa0, pa1, pa2, pa3); SBAR();
  pv_d0(o, vb0 + SHM_V, pa0, pa1, pa2, pa3);
  if (hi == 0) li_l[r32] = l_reg; asm volatile("s_waitcnt lgkmcnt(0)" ::: "memory");
  float rli[16];
#pragma unroll
  for (int r = 0; r < 16; ++r) rli[r] = __builtin_amdgcn_rcpf(li_l[crow(r, hi)]);
  bf16_t* Ow = Ob + (size_t)(wid * QBLK) * ldo;
#pragma unroll
  for (int r = 0; r < 16; ++r) { const int orow = crow(r, hi);
#pragma unroll
    for (int d0 = 0; d0 < 4; ++d0) Ow[(size_t)orow * ldo + d0 * 32 + r32] = f2bf(o[d0][r] * rli[r]); }
#undef SLOAD
#undef SWRITE
#undef SWAIT
#undef RESC
}
}


namespace att8 {
constexpr int NW = 8, QBLK = 32, KVBLK = 64, KST = 208, VST = 80;
#ifndef ATT8_SDEPTH
#define ATT8_SDEPTH 1
#endif
constexpr int SDEPTH = ATT8_SDEPTH;
constexpr float THR8 = 64.f;
constexpr int SHM_K = KVBLK * KST, SHM_V = MDV * VST, SHM_ATTN = 2 * SHM_K + 2 * SHM_V + NW * 64 * 4;
#define SBAR() __builtin_amdgcn_sched_barrier(0)
#define MFMA8(a, b, c) __builtin_amdgcn_mfma_scale_f32_32x32x64_f8f6f4((a), (b), (c), 0, 0, 0, 0x7f7f7f7f, 0, 0x7f7f7f7f)
__device__ __forceinline__ i32x8 ld32(const char* p) { const u32x4 a = *(const u32x4*)p, b = *(const u32x4*)(p + 16); return (i32x8){(int)a.x, (int)a.y, (int)a.z, (int)a.w, (int)b.x, (int)b.y, (int)b.z, (int)b.w}; }
__device__ __forceinline__ void partialSM(f32x16& p0, f32x16& p1, float& m_reg, float& mn, float& alpha) {
  float pmax = p0[0];
#pragma unroll
  for (int r = 1; r < 16; ++r) pmax = fmaxf(pmax, p0[r]);
#pragma unroll
  for (int r = 0; r < 16; ++r) pmax = fmaxf(pmax, p1[r]);
  { auto rr = __builtin_amdgcn_permlane32_swap(__float_as_uint(pmax), __float_as_uint(pmax), false, false);
    pmax = fmaxf(__uint_as_float(rr[0]), __uint_as_float(rr[1])); }
  if (__builtin_expect(__all(pmax - m_reg <= THR8), 1)) { mn = m_reg; alpha = 1.f; }
  else { mn = fmaxf(m_reg, pmax); alpha = __builtin_amdgcn_exp2f((m_reg - mn) * 0.125f); m_reg = mn; }
  const float mnC = -0.125f * mn;
#pragma unroll
  for (int r = 0; r < 16; ++r) p0[r] = fmaf(p0[r], 0.125f, mnC);
#pragma unroll
  for (int r = 0; r < 16; ++r) p1[r] = fmaf(p1[r], 0.125f, mnC);
#pragma unroll
  for (int r = 0; r < 16; ++r) p0[r] = __builtin_amdgcn_exp2f(p0[r]);
}
__device__ __forceinline__ void finishSM(f32x16& p0, f32x16& p1, float alpha, float& l_reg, i32x8& pa) {
#pragma unroll
  for (int r = 0; r < 16; ++r) p1[r] = __builtin_amdgcn_exp2f(p1[r]);
  float ps = 0;
#pragma unroll
  for (int r = 0; r < 16; ++r) ps += p0[r];
#pragma unroll
  for (int r = 0; r < 16; ++r) ps += p1[r];
  { auto rr = __builtin_amdgcn_permlane32_swap(__float_as_uint(ps), __float_as_uint(ps), false, false);
    ps = __uint_as_float(rr[0]) + __uint_as_float(rr[1]); }
  l_reg = l_reg * alpha + ps;
#pragma unroll
  for (int j = 0; j < 4; ++j) { pa[j] = (int)pk4fp8(p0[4 * j], p0[4 * j + 1], p0[4 * j + 2], p0[4 * j + 3]); pa[4 + j] = (int)pk4fp8(p1[4 * j], p1[4 * j + 1], p1[4 * j + 2], p1[4 * j + 3]); }
}
__device__ __forceinline__ void qkt(f32x16& p0, f32x16& p1, const char* Ks, const i32x8* qr, int r32, int hi) {
  p0 = f32x16{}; p1 = f32x16{};
  const char* k0 = Ks + r32 * KST + hi * 32;
#pragma unroll
  for (int s = 0; s < 3; ++s) { const i32x8 a0 = ld32(k0 + 64 * s), a1 = ld32(k0 + 32 * KST + 64 * s);
    p0 = MFMA8(a0, qr[s], p0); p1 = MFMA8(a1, qr[s], p1); }
}
__device__ __forceinline__ void pv(f32x16* o, const char* Vs, const i32x8 pa, int r32, int hi) {
  const char* v0 = Vs + r32 * VST + hi * 32;
#pragma unroll
  for (int d0 = 0; d0 < 4; ++d0) { const i32x8 b = ld32(v0 + d0 * 32 * VST); o[d0] = MFMA8(pa, b, o[d0]); }
}
__device__ __forceinline__ void attn_body(const unsigned char* __restrict__ Qb, const unsigned char* __restrict__ Kh, const unsigned char* __restrict__ Vt, bf16_t* __restrict__ Ob, int ldo, int seq, char* lds) {
  const int tid = threadIdx.x, wid = __builtin_amdgcn_readfirstlane(tid >> 6), lane = tid & 63, r32 = lane & 31, hi = lane >> 5;
  char* K_lds = lds; char* V_lds = lds + 2 * SHM_K;
  float* ws = (float*)(lds + 2 * SHM_K + 2 * SHM_V) + wid * 64; float* li_l = ws; float* al_l = ws + 32;
  float m_reg = -1e30f, l_reg = 0; f32x16 o[4] = {}; i32x8 qr[3];
  { const char* Qw = (const char*)Qb + (size_t)(wid * QBLK + r32) * MDK + hi * 32;
#pragma unroll
    for (int s = 0; s < 3; ++s) qr[s] = ld32(Qw + 64 * s); }
  const int kd0 = (tid / 12) * KST + (tid % 12) * 16, kd1 = ((512 + tid) / 12) * KST + ((512 + tid) % 12) * 16, vd = (tid >> 2) * VST + (tid & 3) * 16;
  struct { u32x4 k0, k1, v; } sr_[SDEPTH];
#define SLOAD(i, t0) do { const unsigned ko = (unsigned)tid * 16u, vo = ((unsigned)(tid >> 2) << 14) | ((unsigned)(tid & 3) << 4); const unsigned char* kt_ = Kh + (size_t)(t0) * MDK; sr_[i].k0 = *(const u32x4*)(kt_ + ko); if (wid < 4) sr_[i].k1 = *(const u32x4*)(kt_ + 8192 + ko); sr_[i].v = *(const u32x4*)(Vt + (t0) + vo); } while (0)
#define SWRITE(b, i) do { *(u32x4*)(K_lds + (b) * SHM_K + kd0) = sr_[i].k0; if (wid < 4) *(u32x4*)(K_lds + (b) * SHM_K + kd1) = sr_[i].k1; *(u32x4*)(V_lds + (b) * SHM_V + vd) = sr_[i].v; } while (0)
#define SWAIT() do { if constexpr (SDEPTH == 2) asm volatile("s_waitcnt vmcnt(3)" ::: "memory"); else asm volatile("s_waitcnt vmcnt(0)" ::: "memory"); } while (0)
#define RESC(a) do { if (__any((a) < 1.f)) { if (hi == 0) al_l[r32] = (a); asm volatile("s_waitcnt lgkmcnt(0)" ::: "memory"); \
    _Pragma("unroll") for (int d = 0; d < 4; ++d) _Pragma("unroll") for (int r = 0; r < 16; ++r) o[d][r] *= al_l[crow(r, hi)]; } } while (0)
  f32x16 pA0, pA1, pB0, pB1; float mnA, mnB, alA, alB; i32x8 pa; const int NT = seq / KVBLK;
  constexpr int SE = 0, SO = SDEPTH - 1;
  SLOAD(SE, 0); asm volatile("s_waitcnt vmcnt(0)" ::: "memory"); SWRITE(0, SE); __syncthreads();
  qkt(pA0, pA1, K_lds, qr, r32, hi); partialSM(pA0, pA1, m_reg, mnA, alA);
  SLOAD(SO, KVBLK); if constexpr (SDEPTH == 2) { if (2 < NT) SLOAD(SE, 2 * KVBLK); }
  SWAIT(); SWRITE(1, SO); __syncthreads();
  for (int j = 1; j + 1 < NT; j += 2) {
    SBAR(); qkt(pB0, pB1, K_lds + SHM_K, qr, r32, hi);
    finishSM(pA0, pA1, alA, l_reg, pa); SBAR();
    SLOAD(SO, (j + SDEPTH) * KVBLK); SBAR();
    pv(o, V_lds, pa, r32, hi); partialSM(pB0, pB1, m_reg, mnB, alB);
    __syncthreads(); SWAIT(); SWRITE(0, SE);
    RESC(alB); __syncthreads();
    SBAR(); qkt(pA0, pA1, K_lds, qr, r32, hi);
    finishSM(pB0, pB1, alB, l_reg, pa); SBAR();
    if (SDEPTH == 1 || j + 3 < NT) SLOAD(SE, (j + 1 + SDEPTH) * KVBLK); SBAR();
    pv(o, V_lds + SHM_V, pa, r32, hi); partialSM(pA0, pA1, m_reg, mnA, alA);
    __syncthreads(); SWAIT(); SWRITE(1, SO);
    RESC(alA); __syncthreads();
  }
  SBAR(); qkt(pB0, pB1, K_lds + SHM_K, qr, r32, hi);
  finishSM(pA0, pA1, alA, l_reg, pa); SBAR();
  pv(o, V_lds, pa, r32, hi); partialSM(pB0, pB1, m_reg, mnB, alB);
  __syncthreads(); RESC(alB);
  finishSM(pB0, pB1, alB, l_reg, pa); SBAR();
  pv(o, V_lds + SHM_V, pa, r32, hi);
  if (hi == 0) li_l[r32] = l_reg; asm volatile("s_waitcnt lgkmcnt(0)" ::: "memory");
  float rli[16];
#pragma unroll
  for (int r = 0; r < 16; ++r) rli[r] = __builtin_amdgcn_rcpf(li_l[crow(r, hi)]);
  bf16_t* Ow = Ob + (size_t)(wid * QBLK) * ldo;
#pragma unroll
  for (int r = 0; r < 16; ++r) { const int orow = crow(r, hi);
#pragma unroll
    for (int d0 = 0; d0 < 4; ++d0) Ow[(size_t)orow * ldo + d0 * 32 + r32] = f2bf(o[d0][r] * rli[r]); }
#undef SLOAD
#undef SWRITE
#undef SWAIT
#undef RESC
}
#undef SBAR
#undef MFMA8
}

#ifdef DBG
constexpr size_t WS_DBG = 256 * 1024;
__device__ __forceinline__ unsigned hash32(unsigned x) { x ^= x >> 16; x *= 0x7feb352dU; x ^= x >> 15; x *= 0x846ca68bU; x ^= x >> 16; return x; }
__device__ __forceinline__ void dbg_acc(float* acc, int slot, float got, float ref) { const float d = got - ref; atomicAdd(acc + 2 * slot, d * d); atomicAdd(acc + 2 * slot + 1, ref * ref); }
__device__ __forceinline__ float dotA(const bf16_t* a, const float* W, int K, int ldw, int n) { float s = 0.f; for (int k = 0; k < K; ++k) s += bf2f(a[k]) * W[(size_t)k * ldw + n]; return s; }
__device__ __forceinline__ void chk_p1(const Ctx& C, const Args& a, unsigned char* ws, float* acc) {
    const int gt = C.bid * 512 + C.tid; if (gt >= 6144) return;
    const unsigned hs = hash32(gt * 7919u + 13u); const int t = hs % T, kind = gt % 6; const unsigned c0 = hs >> 14;
    const bf16_t* xn = (const bf16_t*)(ws + WS_XN) + (size_t)t * 1024; const float* w_in = (const float*)a.in[5];
    if (kind == 0) { const int c = c0 % 512; dbg_acc(acc, 0, bf2f(((const bf16_t*)(ws + AR_Q0))[(size_t)t * 512 + c]), dotA(xn, w_in, 1024, 3104, c) * 0.08838834764831845f); }
    else if (kind == 1) { const int c = c0 % 512; dbg_acc(acc, 0, bf2f(((const bf16_t*)(ws + AR_K0))[(size_t)t * 512 + c]), dotA(xn, w_in, 1024, 3104, 512 + c)); }
    else if (kind == 2) { const int c = c0 % 1024; dbg_acc(acc, 0, bf2f(((const bf16_t*)(ws + AR_VT))[(size_t)c * T + t]), dotA(xn, w_in, 1024, 3104, 1024 + c)); }
    else if (kind == 3) { const int c = c0 % 1024; dbg_acc(acc, 0, bf2f(((const bf16_t*)(ws + AR_SR))[(size_t)t * 1024 + c]), siluf(dotA(xn, w_in, 1024, 3104, 2048 + c))); }
    else { const int dir = kind - 4, c = c0 % 512; const float* wg = (const float*)a.in[dir ? 8 : 6]; const float* bg = (const float*)a.in[dir ? 9 : 7]; float lg = bg[c];
        for (int j = 0; j < 16; ++j) lg += dotA(xn, w_in, 1024, 3104, 3072 + 16 * dir + j) * wg[j * 512 + c];
        dbg_acc(acc, 1, ((const float*)(ws + (dir ? AR_GB : AR_GF)))[(size_t)t * 512 + c], logsigf(lg) * 0.0625f); }
}
__device__ __forceinline__ void chk_gla(const Ctx& C, const Args& a, unsigned char* ws, float* acc) {
    if (C.bid >= 64) return;
    float* A = (float*)C.lds; float* O = A + 4096; float* red = O + 512;
    const unsigned hs = hash32(C.bid * 977u + 5u); const int t = hs % T, h = (hs >> 14) & 3;
    const bf16_t* Q0 = (const bf16_t*)(ws + AR_Q0); const bf16_t* K0 = (const bf16_t*)(ws + AR_K0); const float* GF = (const float*)(ws + AR_GF); const float* GB = (const float*)(ws + AR_GB);
    const bf16_t* VT = (const bf16_t*)(ws + AR_VT); const bf16_t* SR = (const bf16_t*)(ws + AR_SR); const bf16_t* OG = (const bf16_t*)(ws + WS_XN);
    for (int i = C.tid; i < 4096; i += 512) A[i] = 0.f;
    __syncthreads();
    const int dir = C.tid >> 8, sub = C.tid & 255;
    if (sub < 128) { const int k = sub, ch = 128 * h + k; const float q = bf2f(Q0[(size_t)t * 512 + ch]); float Dk = dir ? __expf(GB[(size_t)t * 512 + ch]) : 1.f;
        for (int i = 0; i < 2048; ++i) { const int s = dir ? t + 1 + i : t - i; const bool valid = s >= 0 && s < T; float w = 0.f;
            if (valid) { w = q * Dk * bf2f(K0[(size_t)s * 512 + ch]); Dk *= __expf((dir ? GB : GF)[(size_t)s * 512 + ch]); }
            w = wave_sum(w); if (C.lane == 0) atomicAdd(&A[dir * 2048 + i], w); } }
    __syncthreads();
    { float o = 0.f; for (int i = 0; i < 2048; ++i) { const int s = dir ? t + 1 + i : t - i; if (s >= 0 && s < T) o += A[dir * 2048 + i] * bf2f(VT[(size_t)(256 * h + sub) * T + s]); } O[dir * 256 + sub] = o; }
    __syncthreads();
    if (C.tid < 256) { const float o = O[C.tid] + O[256 + C.tid]; float ss = wave_sum(o * o); if (C.lane == 0) red[C.wave] = ss; }
    __syncthreads();
    if (C.tid < 256) { const float o = O[C.tid] + O[256 + C.tid]; const float ss = red[0] + red[1] + red[2] + red[3]; const float r = 1.0f / sqrtf(ss * (1.0f / 256.0f) + RMS_EPS);
        const size_t oi = (size_t)t * 1024 + 256 * h + C.tid; dbg_acc(acc, 2, bf2f(OG[oi]), o * r * ((const float*)a.in[10])[C.tid] * bf2f(SR[oi])); }
    __syncthreads();
}
__device__ __forceinline__ void chk_resid(const Ctx& C, const float* base, const bf16_t* A, int K, const float* W, const float* HAp, float* acc, int slot) {
    const int gt = C.bid * 512 + C.tid; if (gt >= 4096) return;
    const unsigned hs = hash32(gt * 31u + slot); const int t = hs % T, n = (hs >> 14) % 1024;
    dbg_acc(acc, slot, HAp[(size_t)t * 1024 + n], base[(size_t)t * 1024 + n] + dotA(A + (size_t)t * K, W, K, 1024, n));
}
__device__ __forceinline__ void chk_router(const Ctx& C, const float* Hin, const float* gain, const float* Wr, const bf16_t* XN, const float* AFF, float* acc, int slot) {
    const int gt = C.bid * 512 + C.tid; if (gt >= 512) return;
    const int t = hash32(gt * 101u + 7u) % T; const float* hr = Hin + (size_t)t * 1024; float ss = 0.f; for (int k = 0; k < 1024; ++k) ss += hr[k] * hr[k];
    const float r = 1.0f / sqrtf(ss / 1024.0f + RMS_EPS); float lg[16]; for (int e = 0; e < 16; ++e) lg[e] = 0.f;
    for (int k = 0; k < 1024; ++k) { const float xv = hr[k] * r * gain[k]; for (int e = 0; e < 16; ++e) lg[e] += xv * Wr[k * 16 + e]; if ((k & 63) == (gt & 63)) dbg_acc(acc, slot, bf2f(XN[(size_t)t * 1024 + k]), xv); }
    float mx = lg[0]; for (int e = 1; e < 16; ++e) mx = fmaxf(mx, lg[e]); float s = 0.f; for (int e = 0; e < 16; ++e) { lg[e] = expf(lg[e] - mx); s += lg[e]; }
    for (int e = 0; e < 16; ++e) dbg_acc(acc, slot, AFF[(size_t)t * 16 + e], lg[e] / s);
}
__device__ __forceinline__ void chk_select(const Ctx& C, const float* AFF, const int* SEL, const int* IDX, unsigned* dw) {
    const int gt = C.bid * 512 + C.tid;
    for (int p = gt; p < T * 16; p += C.nb * 512) { const int t = p >> 4, e = p & 15; const int s = SEL[p]; const unsigned b = __float_as_uint(AFF[p]);
        if (s > 0) { atomicAdd(&dw[e], 1u); atomicMax(&dw[16 + e], ~b); if (s > CAP || IDX[e * CAP + s - 1] != t) atomicAdd(&dw[48], 1u); } else { atomicMax(&dw[32 + e], b); if (s < 0) atomicAdd(&dw[48], 1u); } }
}
__device__ __forceinline__ void chk_moe_h(const Ctx& C, const Args& a, unsigned char* ws, int layer, float* acc, int slot) {
    const int gt = C.bid * 512 + C.tid; if (gt >= 2048) return;
    const unsigned hs = hash32(gt * 53u + 3u); const int e = hs & 15, sl = (hs >> 4) % CAP, f = (hs >> 15) % FF; const int t = ((const int*)(ws + WS_IDX))[e * CAP + sl];
    if (t < 0 || t >= T) { dbg_acc(acc, slot, 1e3f, 0.f); return; }
    const bf16_t* xn = (const bf16_t*)(ws + WS_XN) + (size_t)t * 1024; const size_t wo = (size_t)(layer * NE + e) * 1024 * 2048;
    const float g = dotA(xn, (const float*)a.in[19] + wo, 1024, 2048, f), u = dotA(xn, (const float*)a.in[20] + wo, 1024, 2048, f);
    dbg_acc(acc, slot, bf2f(((const bf16_t*)(ws + AR_H))[((size_t)e * CAP + sl) * FF + f]), siluf(g) * u);
    dbg_acc(acc, slot, bf2f(((const bf16_t*)(ws + AR_XS))[((size_t)e * CAP + sl) * 1024 + (f & 1023)]), bf2f(xn[f & 1023]));
}
__device__ __forceinline__ void chk_moe_y(const Ctx& C, const Args& a, unsigned char* ws, int layer, float* acc, int slot) {
    const int gt = C.bid * 512 + C.tid; if (gt >= 2048) return;
    const unsigned hs = hash32(gt * 59u + 11u); const int e = hs & 15, sl = (hs >> 4) % CAP, n = (hs >> 15) % 1024;
    const float ref = dotA((const bf16_t*)(ws + AR_H) + ((size_t)e * CAP + sl) * FF, (const float*)a.in[21] + (size_t)(layer * NE + e) * 2048 * 1024, 2048, 1024, n);
    dbg_acc(acc, slot, bf2f(((const bf16_t*)(ws + AR_Y))[((size_t)e * CAP + sl) * 1024 + n]), ref);
}
__device__ __forceinline__ void chk_combine(const Ctx& C, unsigned char* ws, const float* Hin, const float* Hout, float* acc, int slot) {
    const int gt = C.bid * 512 + C.tid; if (gt >= 4096) return;
    const unsigned hs = hash32(gt * 67u + 1u); const int t = hs % T, n = (hs >> 14) % 1024; float ref = Hin[(size_t)t * 1024 + n];
    for (int e = 0; e < 16; ++e) { const int s = ((const int*)(ws + WS_SEL))[t * 16 + e]; if (s > 0) ref += ((const float*)(ws + WS_AFF))[t * 16 + e] * bf2f(((const bf16_t*)(ws + AR_Y))[((size_t)e * CAP + s - 1) * 1024 + n]); }
    dbg_acc(acc, slot, Hout[(size_t)t * 1024 + n], ref);
}
__device__ __forceinline__ void chk_cin(const Ctx& C, const Args& a, unsigned char* ws, float* acc) {
    const int gt = C.bid * 512 + C.tid; if (gt >= 4096) return;
    const unsigned hs = hash32(gt * 71u + 9u); const int t = hs % T, n = (hs >> 14) % 448;
    dbg_acc(acc, 10, ((const float*)(ws + AR_CIN))[(size_t)t * 512 + n], dotA((const bf16_t*)(ws + WS_XN) + (size_t)t * 1024, (const float*)a.in[12], 1024, 448, n));
}
__device__ __forceinline__ void chk_tok(const Ctx& C, const Args& a, unsigned char* ws, float* acc) {
    const int gt = C.bid * 512 + C.tid; if (gt >= 1024) return;
    const unsigned hs = hash32(gt * 73u + 19u); const int t = hs % T, h = (hs >> 14) & 15; const float* row = (const float*)(ws + AR_CIN) + (size_t)t * 512;
    float sq = 0.f, sk = 0.f; for (int i = 0; i < 256; ++i) sq += row[i] * row[i]; for (int i = 0; i < 128; ++i) sk += row[256 + i] * row[256 + i];
    const float rq = 1.0f / sqrtf(sq / 256.0f + RMS_EPS), rk = 1.0f / sqrtf(sk / 128.0f + RMS_EPS);
    const int i = (hs >> 18) % 256; dbg_acc(acc, 11, bf2f(((const bf16_t*)(ws + AR_CQN))[(size_t)t * 256 + i]), row[i] * rq * ((const float*)a.in[13])[i]);
    const int j = i & 127; dbg_acc(acc, 11, bf2f(((const bf16_t*)(ws + AR_CKVN))[(size_t)t * 256 + j]), row[256 + j] * rk * ((const float*)a.in[15])[j]);
    dbg_acc(acc, 11, 1.f + bf2f(((const bf16_t*)(ws + AR_CKVN))[(size_t)t * 256 + 128 + j]), 1.f);
    const int f = i & 31; const float ang = (float)((const int*)a.in[1])[t] * a.invf[f]; double xr = (double)ang * 0.15915494309189533577; xr = (xr - rint(xr)) * 6.283185307179586477; double cd = 1.0, sd = xr, tc = 1.0, ts = xr; for (int n = 1; n < 16; ++n) { tc *= -xr * xr / ((2.0 * n - 1.0) * (2.0 * n)); ts *= -xr * xr / ((2.0 * n) * (2.0 * n + 1.0)); cd += tc; sd += ts; } const float cr = (float)cd, sr = (float)sd;
    dbg_acc(acc, 11, ((const float*)(ws + WS_CS))[(size_t)t * 64 + f], cr); dbg_acc(acc, 11, ((const float*)(ws + WS_CS))[(size_t)t * 64 + 32 + f], sr);
    const float x1 = row[384 + f], x2 = row[416 + f]; const bf16_t* kp = (const bf16_t*)(ws + AR_K) + ((size_t)h * T + t) * MDK + 128 + 8 * (f >> 2) + (f & 3);
    dbg_acc(acc, 11, bf2f(kp[0]), x1 * cr - x2 * sr); dbg_acc(acc, 11, bf2f(kp[4]), x1 * sr + x2 * cr);
}
__device__ __forceinline__ void chk_qkv(const Ctx& C, const Args& a, unsigned char* ws, float* acc) {
    const int gt = C.bid * 512 + C.tid; if (gt >= 4096) return;
    const unsigned hs = hash32(gt * 79u + 29u); const int t = hs % T, h = (hs >> 14) & 15, j = (hs >> 18) & 127, kind = gt & 3; const float QS = (ATT_FP8 ? 8.0f : 1.0f) * 0.07216878364870322f * 1.4426950408889634f;
    const bf16_t* cq = (const bf16_t*)(ws + AR_CQN) + (size_t)t * 256; const bf16_t* ck = (const bf16_t*)(ws + AR_CKVN) + (size_t)t * 256;
    const size_t qo = ((size_t)h * T + t) * MDK; const int tau = t & 63, pos = 32 * ((tau >> 2) & 1) + (tau & 3) + 4 * ((tau >> 3) & 3) + 16 * (tau >> 5);
#if ATT_FP8
#define QV(i) fp8f(ws + AR_Q8 + qo + (i))
#define KV(i) fp8f(ws + AR_K8 + qo + (i))
#define VV(i) fp8f(ws + AR_V8T + ((size_t)h * MDV + (i)) * T + (t & ~63) + pos)
#else
#define QV(i) bf2f(((const bf16_t*)(ws + AR_Q))[qo + (i)])
#define KV(i) bf2f(((const bf16_t*)(ws + AR_K))[qo + (i)])
#define VV(i) bf2f(((const bf16_t*)(ws + AR_V))[((size_t)h * T + t) * MDV + (i)])
#endif
    if (kind == 0) dbg_acc(acc, 12, QV(j), dotA(cq, (const float*)a.in[14], 256, 3072, 192 * h + j) * QS);
    else if (kind == 1) { const int f = j & 31; const float x1 = dotA(cq, (const float*)a.in[14], 256, 3072, 192 * h + 128 + f), x2 = dotA(cq, (const float*)a.in[14], 256, 3072, 192 * h + 160 + f);
        const float cr = ((const float*)(ws + WS_CS))[(size_t)t * 64 + f], sr = ((const float*)(ws + WS_CS))[(size_t)t * 64 + 32 + f]; const int qp = 128 + 8 * (f >> 2) + (f & 3);
        dbg_acc(acc, 12, QV(qp), (x1 * cr - x2 * sr) * QS); dbg_acc(acc, 12, QV(qp + 4), (x1 * sr + x2 * cr) * QS);
        const float* row = (const float*)(ws + AR_CIN) + (size_t)t * 512; const float k1 = row[384 + f], k2 = row[416 + f];
        dbg_acc(acc, 12, KV(qp), k1 * cr - k2 * sr); dbg_acc(acc, 12, KV(qp + 4), k1 * sr + k2 * cr); }
    else if (kind == 2) dbg_acc(acc, 12, KV(j), dotA(ck, (const float*)a.in[16], 128, 4096, 256 * h + j));
    else dbg_acc(acc, 12, VV(j), dotA(ck, (const float*)a.in[16], 128, 4096, 256 * h + 128 + j));
#undef QV
#undef KV
#undef VV
}
__device__ __forceinline__ void chk_attn(const Ctx& C, unsigned char* ws, float* acc) {
    if (C.bid >= 64) return;
    float* P = (float*)C.lds; float* red = P + T; float* qs = red + 32;
    const unsigned hs = hash32(C.bid * 991u + 77u); const int t = hs % T, h = (hs >> 14) & 15;
#if ATT_FP8
    const unsigned char* Q = ws + AR_Q8 + ((size_t)h * T + t) * MDK; const unsigned char* K = ws + AR_K8 + (size_t)h * T * MDK; const unsigned char* V = ws + AR_V8T + (size_t)h * MDV * T; const float SC = 0.125f;
    if (C.tid < MDK) qs[C.tid] = fp8f(Q + C.tid);
#define KEL(j, d) fp8f(K + (size_t)(j) * MDK + (d))
#define VEL(j, d) fp8f(V + (size_t)(d) * T + ((j) & ~63) + 32 * ((((j) & 63) >> 2) & 1) + ((j) & 3) + 4 * ((((j) & 63) >> 3) & 3) + 16 * (((j) & 63) >> 5))
#else
    const bf16_t* Q = (const bf16_t*)(ws + AR_Q) + ((size_t)h * T + t) * MDK; const bf16_t* K = (const bf16_t*)(ws + AR_K) + (size_t)h * T * MDK; const bf16_t* V = (const bf16_t*)(ws + AR_V) + (size_t)h * T * MDV; const float SC = 1.0f;
    if (C.tid < MDK) qs[C.tid] = bf2f(Q[C.tid]);
#define KEL(j, d) bf2f(K[(size_t)(j) * MDK + (d)])
#define VEL(j, d) bf2f(V[(size_t)(j) * MDV + (d)])
#endif
    __syncthreads();
    float mx = -1e30f;
    for (int j = C.tid; j < T; j += 512) { float s = 0.f; for (int d = 0; d < MDK; ++d) s += qs[d] * KEL(j, d); s *= SC; P[j] = s; mx = fmaxf(mx, s); }
    mx = wave_max(mx); if (C.lane == 0) red[C.wave] = mx;
    __syncthreads();
    mx = red[0]; for (int w = 1; w < 8; ++w) mx = fmaxf(mx, red[w]);
    float sm = 0.f; for (int j = C.tid; j < T; j += 512) { const float p = exp2f(P[j] - mx); P[j] = p; sm += p; }
    sm = wave_sum(sm);
    __syncthreads();
    if (C.lane == 0) red[8 + C.wave] = sm;
    __syncthreads();
    sm = 0.f; for (int w = 0; w < 8; ++w) sm += red[8 + w];
    if (C.tid < MDV) { float o = 0.f; for (int j = 0; j < T; ++j) o += P[j] * VEL(j, C.tid); dbg_acc(acc, 13, bf2f(((const bf16_t*)(ws + AR_O))[(size_t)t * 2048 + 128 * h + C.tid]) * 100.f, o / sm * 100.f); }
    __syncthreads();
#undef KEL
#undef VEL
}
__device__ __forceinline__ void dbg_report(const Ctx& C, unsigned char* ws, float* out, int lo, int hi) {
    const float* acc = (const float*)(ws + WS_DBG); const unsigned* dw = (const unsigned*)(ws + WS_DBG + 1024);
    int code = 90;
    for (int s = lo; s < hi && code == 90; ++s) { float num = __hip_atomic_load(acc + 2 * s, __ATOMIC_RELAXED, __HIP_MEMORY_SCOPE_AGENT), den = __hip_atomic_load(acc + 2 * s + 1, __ATOMIC_RELAXED, __HIP_MEMORY_SCOPE_AGENT);
        if (s == 5) { unsigned viol = __hip_atomic_load(dw + 48, __ATOMIC_RELAXED, __HIP_MEMORY_SCOPE_AGENT); for (int e = 0; e < 16; ++e) { const unsigned cnt = __hip_atomic_load(dw + e, __ATOMIC_RELAXED, __HIP_MEMORY_SCOPE_AGENT), mn = ~__hip_atomic_load(dw + 16 + e, __ATOMIC_RELAXED, __HIP_MEMORY_SCOPE_AGENT), mxu = __hip_atomic_load(dw + 32 + e, __ATOMIC_RELAXED, __HIP_MEMORY_SCOPE_AGENT); if (cnt != CAP) viol += 1000; if (mn < mxu) viol += 1; }
            num = (float)viol; den = 1.f; if (viol == 0) continue; code = 10 * (s - lo) + (viol >= 1000 ? 0 : (viol >= 100 ? 1 : (viol >= 10 ? 2 : 3))); break; }
        if (den == 0.f && num == 0.f) continue;
        const float e = sqrtf(num / den);
        if (!(e < 0.03f)) { const int b = !(e < 1.f) ? 0 : (e >= 0.3f ? 1 : (e >= 0.1f ? 2 : 3)); code = 10 * (s - lo) + b; } }
    if (code == 90) { float worst = 0.f; for (int s = lo; s < hi; ++s) { if (s == 5) continue; const float num = acc[2 * s], den = acc[2 * s + 1]; if (den > 0.f) worst = fmaxf(worst, sqrtf(num / den)); }
        code = 90 + (worst >= 0.01f ? 1 : (worst >= 0.003f ? 2 : 3)); }
    if (DBG >= 2) { const int sl = DBG == 2 ? 13 : 12; const float num = acc[2 * sl], den = acc[2 * sl + 1]; const float e = sqrtf(num / den); code = !(e > 0.f) ? 99 : (e >= 1.f ? 0 : (int)fminf(89.f, -20.f * log10f(e))); }
    const float c = sqrtf((float)code);
    for (size_t i = (size_t)C.bid * 512 + C.tid; i < (size_t)T * D; i += (size_t)C.nb * 512) out[i] = c;
}
#endif

constexpr int NPHASE = 24;
__global__ void __launch_bounds__(512, 2) mk_fwd(Args args) {
    extern __shared__ __attribute__((aligned(16))) unsigned char lds[];
    Ctx C; C.tid = threadIdx.x; C.lane = C.tid & 63; C.wave = __builtin_amdgcn_readfirstlane(C.tid >> 6); C.bid = blockIdx.x; C.nb = gridDim.x;
    C.gw = C.bid * 8 + C.wave; C.ngw = C.nb * 8; C.lds = lds;
    unsigned char* ws = args.ws;
    volatile LAS unsigned* MISC = (volatile LAS unsigned*)((LAS unsigned char*)lds + LDS_MISC);
    if (C.tid < 32) MISC[C.tid] = 0u;
    __syncthreads();
    XcdBarrier bar = xcd_barrier_post((unsigned*)(ws + WS_CTL) + 4096 + args.li * XCD_BAR_WORDS, MISC + 8);
    const int lo = args.ph_lo, hi = args.ph_hi;
#if defined(PH_MASK)
#define IN(k) ((((PH_MASK) >> (k)) & 1u) && lo <= (k) && (k) < hi)
#elif defined(PH_ONLY)
#define IN(k) ((k) == PH_ONLY && lo <= (k) && (k) < hi)
#else
#define IN(k) (lo <= (k) && (k) < hi)
#endif
#define SEAM(k) do { if (IN((k) + 1)) xcd_barrier(bar); } while (0)
#ifndef REPMASK
#define REPMASK 0u
#endif
#define NREP(k) ((((REPMASK) >> (k)) & 1u) ? 2 : 1)
#ifdef DBG
    float* dacc = (float*)(ws + WS_DBG); unsigned* ddw = (unsigned*)(ws + WS_DBG + 1024);
#define DBGCHK(page, call) do { if ((DBG >= 2 ? 1 : DBG) == (page)) { call; xcd_barrier(bar); } } while (0)
#else
#define DBGCHK(page, call) do { } while (0)
#endif
    PG8_LAS unsigned char* glds = (PG8_LAS unsigned char*)lds;
    const float* x = (const float*)args.in[0];
    float* HA = args.out; float* HB = (float*)(ws + WS_HB);
    bf16_t* XN = (bf16_t*)(ws + WS_XN);
    float* AFF = (float*)(ws + WS_AFF); int* SEL = (int*)(ws + WS_SEL); int* IDX = (int*)(ws + WS_IDX);
    bf16_t* WGU = (bf16_t*)(ws + WS_WGU); bf16_t* WD = (bf16_t*)(ws + WS_WD);
    bf16_t* XS = (bf16_t*)(ws + AR_XS); bf16_t* HH = (bf16_t*)(ws + AR_H); bf16_t* YY = (bf16_t*)(ws + AR_Y);

    if (IN(0)) { ph_convert_small(C, args, ws); ph_convert_moe(C, args, ws, 0, NREP(0)); ph_norm(C, x, (const float*)args.in[2], XN); SEAM(0); }
    if (IN(1)) {
        { pg8::Gemm g{XN, (const bf16_t*)(ws + WS_WGIN), T, 3072, 1024}; pg8::StaticOrder S; S.init(T, 3072, C.nb, C.bid); S.rep = NREP(1);
          pg8::EpiGlaIn E{(bf16_t*)(ws + AR_Q0), (bf16_t*)(ws + AR_K0), (bf16_t*)(ws + AR_SR), (float*)(ws + AR_GF), (float*)(ws + AR_GB), (const float*)args.in[7], (const float*)args.in[9]};
          pg8::gemm_phase<pg8::EpiGlaIn, pg8::StaticOrder, PG8_ALIGN, PG8_SP2>(glds, g, S, E); }
        { pg8::Gemm g{(const bf16_t*)(ws + WS_WV), XN, 1024, T, 1024}; pg8::StaticOrder S; S.init(1024, T, C.nb, C.bid); S.rep = NREP(1);
          pg8::EpiBf E{(bf16_t*)(ws + AR_VT), T};
          pg8::gemm_phase<pg8::EpiBf, pg8::StaticOrder, PG8_ALIGN, PG8_SP2>(glds, g, S, E); }
        SEAM(1); } DBGCHK(0, chk_p1(C, args, ws, dacc));
    if (IN(2)) for (int rep_ = 0; rep_ < NREP(2); ++rep_) { ph_gla_prep(C, (const bf16_t*)(ws + AR_Q0), (const bf16_t*)(ws + AR_K0), (const float*)(ws + AR_GF), (const float*)(ws + AR_GB), (bf16_t*)(ws + AR_QDF), (bf16_t*)(ws + AR_QDB),
                             (bf16_t*)(ws + AR_KDF), (bf16_t*)(ws + AR_KDB), (bf16_t*)(ws + AR_KTF), (bf16_t*)(ws + AR_KTB), (float*)(ws + WS_EGL)); SEAM(2); }
    if (IN(3)) for (int rep_ = 0; rep_ < NREP(3); ++rep_) { ph_gla_u(C, (const bf16_t*)(ws + AR_VT), (const bf16_t*)(ws + AR_KTF), (const bf16_t*)(ws + AR_KTB), (const float*)(ws + WS_EGL), (bf16_t*)(ws + AR_U)); SEAM(3); }
    if (IN(4)) for (int rep_ = 0; rep_ < NREP(4); ++rep_) { ph_gla_scan(C, (const bf16_t*)(ws + AR_U), (const float*)(ws + WS_EGL), (bf16_t*)(ws + AR_ST)); SEAM(4); }
    if (IN(5)) for (int rep_ = 0; rep_ < NREP(5); ++rep_) { ph_gla_out(C, (const bf16_t*)(ws + AR_QDF), (const bf16_t*)(ws + AR_QDB), (const bf16_t*)(ws + AR_KDF), (const bf16_t*)(ws + AR_KDB), (const bf16_t*)(ws + AR_VT), (const bf16_t*)(ws + AR_ST),
                            (const bf16_t*)(ws + AR_SR), (const float*)args.in[10], XN); SEAM(5); } DBGCHK(0, chk_gla(C, args, ws, dacc));
    if (IN(6)) { pg8::Gemm g{XN, (const bf16_t*)(ws + WS_WGOUT), T, 1024, 1024}; pg8::StaticOrder S; S.init(T, 1024, C.nb, C.bid); S.rep = NREP(6);
        pg8::EpiF32 E{HA, x, 1024}; pg8::gemm_phase<pg8::EpiF32, pg8::StaticOrder, false, PG8_SP2>(glds, g, S, E); SEAM(6); } DBGCHK(0, chk_resid(C, x, XN, 1024, (const float*)args.in[11], HA, dacc, 3));
#define MOE_LAYER(P, L, HIN, TAILMODE, HOUT, GAIN2, OUTP)                                                                                         \
    if (IN(P)) for (int rep_ = 0; rep_ < NREP(P); ++rep_) { ph_router(C, HIN, (const float*)args.in[3] + (L) * 1024, (const float*)args.in[18] + (L) * 1024 * 16, XN, AFF, (float*)(ws + WS_AFFT), ws + AR_XN8); SEAM(P); if ((P) == 7) DBGCHK(0, chk_router(C, HIN, (const float*)args.in[3] + (L) * 1024, (const float*)args.in[18] + (L) * 1024 * 16, XN, AFF, dacc, 4)); }       \
    if (IN(P + 1)) for (int rep_ = 0; rep_ < NREP(P + 1); ++rep_) { ph_select(C, (const float*)(ws + WS_AFFT), SEL, IDX); SEAM(P + 1); if ((P) == 7) DBGCHK(0, chk_select(C, AFF, SEL, IDX, ddw)); }                                                                                 \
    if (IN(P + 2)) for (int rep_ = 0; rep_ < NREP(P + 2); ++rep_) { ph_gather(C, IDX, XN, XS, ws + AR_XN8); SEAM(P + 2); }                                                                                   \
    if (IN(P + 3)) { pg8::Gemm g{XS, WGU, NE * CAP, 4096, MOE_FP8 ? 512 : 1024}; pg8::GroupedOrder S; S.init(NE * CAP, 4096, C.nb, C.bid); S.rep = NREP(P + 3); pg8::EpiMoe1 E{HH};     \
        pg8::gemm_phase<pg8::EpiMoe1, pg8::GroupedOrder, PG8_ALIGN, PG8_SP2, MOE_FP8 != 0>(glds, g, S, E); SEAM(P + 3); if ((P) == 7) DBGCHK(0, chk_moe_h(C, args, ws, L, dacc, 6)); }                                       \
    if (IN(P + 4)) { pg8::Gemm g{HH, WD, NE * CAP, 1024, MOE_FP8 ? 1024 : 2048}; pg8::GroupedOrder S; S.init(NE * CAP, 1024, C.nb, C.bid); S.rep = NREP(P + 4); pg8::EpiMoe2 E{YY};      \
        pg8::gemm_phase<pg8::EpiMoe2, pg8::GroupedOrder, PG8_ALIGN, PG8_SP2, MOE_FP8 != 0>(glds, g, S, E); SEAM(P + 4); if ((P) == 7) DBGCHK(0, chk_moe_y(C, args, ws, L, dacc, 7)); }                                       \
    if (IN(P + 5)) for (int rep_ = 0; rep_ < NREP(P + 5); ++rep_) { ph_combine<TAILMODE>(C, HIN, AFF, SEL, YY, HOUT, GAIN2, XN, OUTP); SEAM(P + 5); if ((P) == 7) DBGCHK(0, chk_combine(C, ws, HIN, HOUT, dacc, 8)); }

    MOE_LAYER(7, 0, HA, 1, HB, (const float*)args.in[2] + 1024, nullptr)
    if (IN(13)) { pg8::Gemm g{XN, (const bf16_t*)(ws + WS_WMIN), T, 512, 1024}; pg8::StaticOrder S; S.init(T, 512, C.nb, C.bid); S.rep = NREP(13);
        pg8::EpiF32 E{(float*)(ws + AR_CIN), nullptr, 512}; pg8::gemm_phase<pg8::EpiF32, pg8::StaticOrder, false, PG8_SP2>(glds, g, S, E); SEAM(13); } DBGCHK(1, chk_cin(C, args, ws, dacc));
    if (IN(14)) { ph_mla_tok(C, (const float*)(ws + AR_CIN), (const int*)args.in[1], (const float*)args.in[13], (const float*)args.in[15], args.invf, (bf16_t*)(ws + AR_CQN), (bf16_t*)(ws + AR_CKVN),
                             (float*)(ws + WS_CS), (bf16_t*)(ws + AR_K));
        ph_convert_moe(C, args, ws, 1, NREP(14)); SEAM(14); } DBGCHK(1, chk_tok(C, args, ws, dacc));
    if (IN(15)) {
#if ATT_FP8
        { pg8::Gemm g{(const bf16_t*)(ws + AR_CQN), (const bf16_t*)(ws + WS_WUQ), T, 4096, 256}; pg8::StaticOrder S; S.init(T, 4096, C.nb, C.bid); S.rep = NREP(15);
          pg8::EpiQ8 E{ws + AR_Q8, (const float*)(ws + WS_CS)}; pg8::gemm_phase<pg8::EpiQ8, pg8::StaticOrder, PG8_ALIGN, PG8_SP2>(glds, g, S, E); }
        { pg8::Gemm g{(const bf16_t*)(ws + AR_CKVN), (const bf16_t*)(ws + WS_WUKV), T, 2048, 256}; pg8::StaticOrder S; S.init(T, 2048, C.nb, C.bid); S.rep = NREP(15);
          pg8::EpiK8 E{ws + AR_K8}; pg8::gemm_phase<pg8::EpiK8, pg8::StaticOrder, PG8_ALIGN, PG8_SP2>(glds, g, S, E); }
        { pg8::Gemm g{(const bf16_t*)(ws + WS_WUKV) + (size_t)2048 * 256, (const bf16_t*)(ws + AR_CKVN), 2048, T, 256}; pg8::StaticOrder S; S.init(2048, T, C.nb, C.bid); S.rep = NREP(15);
          pg8::EpiV8T E{ws + AR_V8T}; pg8::gemm_phase<pg8::EpiV8T, pg8::StaticOrder, PG8_ALIGN, PG8_SP2>(glds, g, S, E); }
#else
        { pg8::Gemm g{(const bf16_t*)(ws + AR_CQN), (const bf16_t*)(ws + WS_WUQ), T, 4096, 256}; pg8::StaticOrder S; S.init(T, 4096, C.nb, C.bid); S.rep = NREP(15);
          pg8::EpiQup E{(bf16_t*)(ws + AR_Q), (const float*)(ws + WS_CS)}; pg8::gemm_phase<pg8::EpiQup, pg8::StaticOrder, PG8_ALIGN, PG8_SP2>(glds, g, S, E); }
        { pg8::Gemm g{(const bf16_t*)(ws + AR_CKVN), (const bf16_t*)(ws + WS_WUKV), T, 4096, 256}; pg8::StaticOrder S; S.init(T, 4096, C.nb, C.bid); S.rep = NREP(15);
          pg8::EpiKVup E{(bf16_t*)(ws + AR_K), (bf16_t*)(ws + AR_V)}; pg8::gemm_phase<pg8::EpiKVup, pg8::StaticOrder, PG8_ALIGN, PG8_SP2>(glds, g, S, E); }
#endif
        SEAM(15); } DBGCHK(1, chk_qkv(C, args, ws, dacc));
    if (IN(16)) {
        const int nun = MH * (T / 256);
        for (int ii = 0; ii * C.nb + C.bid < nun * NREP(16); ++ii) { const int i = ii % (nun / C.nb);
            int h, qb; if (C.nb == 256) { h = (C.bid & 7) + 8 * (i >> 1); qb = (i & 1) * 32 + (C.bid >> 3); } else { const int u = i * C.nb + C.bid; h = u >> 6; qb = u & 63; }
#if ATT_FP8
            att8::attn_body(ws + AR_Q8 + ((size_t)h * T + (size_t)qb * 256) * MDK, ws + AR_K8 + (size_t)h * T * MDK, ws + AR_V8T + (size_t)h * MDV * T, (bf16_t*)(ws + AR_O) + (size_t)qb * 256 * 2048 + 128 * h, 2048, T, (char*)lds);
#else
            const bf16_t* Qb = (const bf16_t*)(ws + AR_Q) + ((size_t)h * T + (size_t)qb * 256) * MDK;
            att::attn_body(Qb, (const bf16_t*)(ws + AR_K) + (size_t)h * T * MDK, (const bf16_t*)(ws + AR_V) + (size_t)h * T * MDV, (bf16_t*)(ws + AR_O) + (size_t)qb * 256 * 2048 + 128 * h, 2048, T, (char*)lds);
#endif
            __syncthreads();
        }
        SEAM(16); } DBGCHK(1, chk_attn(C, ws, dacc));
    if (IN(17)) { pg8::Gemm g{(const bf16_t*)(ws + AR_O), (const bf16_t*)(ws + WS_WMOUT), T, 1024, 2048}; pg8::StaticOrder S; S.init(T, 1024, C.nb, C.bid); S.rep = NREP(17);
        pg8::EpiF32 E{HA, HB, 1024}; pg8::gemm_phase<pg8::EpiF32, pg8::StaticOrder, false, PG8_SP2>(glds, g, S, E); SEAM(17); } DBGCHK(1, chk_resid(C, HB, (const bf16_t*)(ws + AR_O), 2048, (const float*)args.in[17], HA, dacc, 14));
    MOE_LAYER(18, 1, HA, 2, nullptr, (const float*)args.in[4], args.out)
#ifdef DBG
    xcd_barrier(bar); dbg_report(C, ws, args.out, DBG == 0 ? 0 : 10, DBG == 0 ? 10 : 20);
#endif
#undef IN
#undef SEAM
}

#ifndef MK_N_LAUNCHES
#define MK_N_LAUNCHES 1
#endif
extern "C" void kernel_launch(void* const* d_in, const int* in_sizes, int n_in, void* d_out, int out_size, void* d_ws, size_t ws_size, hipStream_t stream) {
    static int grid = 0;
    if (grid == 0) {
        if (n_in != 22 || out_size != T * D || ws_size < WS_END) { fprintf(stderr, "kernel_launch: unexpected shapes (n_in %d out %d ws %zu, need ws >= %zu)\n", n_in, out_size, ws_size, (size_t)WS_END); grid = -1; return; }
        int dev = 0, cus = 0, per_cu = 0;
        if (hipGetDevice(&dev) != hipSuccess || hipDeviceGetAttribute(&cus, hipDeviceAttributeMultiprocessorCount, dev) != hipSuccess) { grid = -1; return; }
        if (hipFuncSetAttribute((const void*)mk_fwd, hipFuncAttributeMaxDynamicSharedMemorySize, LDS_BYTES) != hipSuccess) { fprintf(stderr, "kernel_launch: hipFuncSetAttribute failed\n"); grid = -1; return; }
        if (hipOccupancyMaxActiveBlocksPerMultiprocessor(&per_cu, (const void*)mk_fwd, 512, LDS_BYTES) != hipSuccess || per_cu < 1) fprintf(stderr, "kernel_launch: occupancy query says %d\n", per_cu);
        (void)hipGetLastError();
        grid = cus;
    }
    if (grid < 0) return;
    (void)hipMemsetAsync((char*)d_ws + WS_CTL, 0, CTL_ZERO_BYTES, stream);
    Args a{};
    for (int i = 0; i < 22; ++i) a.in[i] = d_in[i];
    a.out = (float*)d_out; a.ws = (unsigned char*)d_ws;
    for (int i = 0; i < 32; ++i) a.invf[i] = powf(10000.0f, -(float)i / 32.0f);
    if (MK_N_LAUNCHES == 1) { a.ph_lo = 0; a.ph_hi = NPHASE; a.li = 0; hipLaunchKernelGGL(mk_fwd, dim3(grid), dim3(512), LDS_BYTES, stream, a); }
    else { for (int p = 0; p < NPHASE; ++p) { a.ph_lo = p; a.ph_hi = p + 1; a.li = p; hipLaunchKernelGGL(mk_fwd, dim3(grid), dim3(512), LDS_BYTES, stream, a); } }
}
```

```cpp
#include <hip/hip_runtime.h>
#include <cstdio>
#include <cstdint>
#include <cmath>

constexpr int T = 16384, D = 1024, NE = 16, CAP = 2048, FF = 2048;
constexpr int GH = 4, GDK = 128, GDV = 256, GC = 64, GNC = T / GC;
constexpr int MH = 16, MDK = 192, MDV = 128;
constexpr float RMS_EPS = 1e-6f;

typedef unsigned short bf16_t;
typedef short bf16x8 __attribute__((ext_vector_type(8)));
typedef short s16x4 __attribute__((ext_vector_type(4)));
typedef float f32x4 __attribute__((ext_vector_type(4)));
typedef float f32x2 __attribute__((ext_vector_type(2)));
typedef float f32x16 __attribute__((ext_vector_type(16)));
typedef unsigned u32x4 __attribute__((ext_vector_type(4)));
typedef unsigned u32x2 __attribute__((ext_vector_type(2)));
typedef int i32x8 __attribute__((ext_vector_type(8)));
#ifndef MOE_FP8
#define MOE_FP8 1
#endif
#ifndef ATT_FP8
#define ATT_FP8 1
#endif

constexpr size_t MiB = 1u << 20;
constexpr size_t WS_CTL = 0, CTL_ZERO_BYTES = 512 * 1024;
constexpr size_t WS_WGIN = 1 * MiB;
constexpr size_t WS_WV = 7 * MiB;
constexpr size_t WS_WGOUT = 9 * MiB;
constexpr size_t WS_WMIN = 11 * MiB;
constexpr size_t WS_WUQ = 12 * MiB;
constexpr size_t WS_WUKV = 14 * MiB;
constexpr size_t WS_WMOUT = 16 * MiB;
constexpr size_t WS_WGU = 20 * MiB;
constexpr size_t WS_WD = 148 * MiB;
constexpr size_t WS_AFF = 212 * MiB;
constexpr size_t WS_SEL = 213 * MiB;
constexpr size_t WS_IDX = 214 * MiB;
constexpr size_t WS_EGL = 215 * MiB;
constexpr size_t WS_CS = 216 * MiB;
constexpr size_t WS_XN = 220 * MiB;
constexpr size_t WS_HB = 252 * MiB;
constexpr size_t WS_AR = 316 * MiB;
constexpr size_t WS_AFFT = 828 * MiB;
constexpr size_t WS_END = 829 * MiB;
constexpr size_t AR_Q0 = WS_AR, AR_K0 = WS_AR + 16 * MiB, AR_GF = WS_AR + 32 * MiB, AR_GB = WS_AR + 64 * MiB, AR_SR = WS_AR + 96 * MiB, AR_VT = WS_AR + 128 * MiB;
constexpr size_t AR_QDF = WS_AR + 160 * MiB, AR_QDB = WS_AR + 176 * MiB, AR_KDF = WS_AR + 192 * MiB, AR_KDB = WS_AR + 208 * MiB, AR_KTF = WS_AR + 224 * MiB, AR_KTB = WS_AR + 240 * MiB;
constexpr size_t AR_U = WS_AR + 256 * MiB, AR_ST = WS_AR + 384 * MiB;
constexpr size_t AR_XS = WS_AR, AR_H = WS_AR + 64 * MiB, AR_Y = WS_AR + 192 * MiB, AR_XN8 = WS_AR + 256 * MiB;
constexpr size_t AR_CIN = WS_AR, AR_CQN = WS_AR + 32 * MiB, AR_CKVN = WS_AR + 40 * MiB, AR_Q = WS_AR + 48 * MiB, AR_K = WS_AR + 144 * MiB, AR_V = WS_AR + 240 * MiB, AR_O = WS_AR + 304 * MiB;

constexpr size_t AR_Q8 = AR_Q, AR_K8 = AR_K, AR_V8T = AR_V;
constexpr int LDS_BYTES = 147456;
constexpr int LDS_MISC = 135168;

__device__ __forceinline__ unsigned cvt_pk_bf16(float lo, float hi) { unsigned r; asm volatile("v_cvt_pk_bf16_f32 %0, %1, %2" : "=v"(r) : "v"(lo), "v"(hi)); return r; }
__device__ __forceinline__ float bf_lo(unsigned w) { return __uint_as_float(w << 16); }
__device__ __forceinline__ float bf_hi(unsigned w) { return __uint_as_float(w & 0xffff0000u); }
__device__ __forceinline__ float bf2f(bf16_t b) { return __uint_as_float(((unsigned)b) << 16); }
__device__ __forceinline__ bf16_t f2bf(float f) { return (bf16_t)(cvt_pk_bf16(f, 0.f) & 0xffffu); }
__device__ __forceinline__ float siluf(float x) { return x / (1.f + __expf(-x)); }
__device__ __forceinline__ float logsigf(float x) { return fminf(x, 0.f) - log1pf(__expf(-fabsf(x))); }
__device__ __forceinline__ void store8bf(bf16_t* p, f32x4 v0, f32x4 v1) {
    u32x4 w; w.x = cvt_pk_bf16(v0[0], v0[1]); w.y = cvt_pk_bf16(v0[2], v0[3]); w.z = cvt_pk_bf16(v1[0], v1[1]); w.w = cvt_pk_bf16(v1[2], v1[3]); *(u32x4*)p = w; }
__device__ __forceinline__ unsigned pk4fp8(float a, float b, float c, float d) { int w = __builtin_amdgcn_cvt_pk_fp8_f32(a, b, 0, false); w = __builtin_amdgcn_cvt_pk_fp8_f32(c, d, w, true); return (unsigned)w; }
__device__ __forceinline__ void store8fp8(unsigned char* p, f32x4 v0, f32x4 v1) { u32x2 w; w.x = pk4fp8(v0[0], v0[1], v0[2], v0[3]); w.y = pk4fp8(v1[0], v1[1], v1[2], v1[3]); *(u32x2*)p = w; }
__device__ __forceinline__ float fp8f(const unsigned char* p) { const unsigned w = *(const unsigned*)((size_t)p & ~(size_t)3); const int b = (int)((size_t)p & 3);
    return b == 0 ? __builtin_amdgcn_cvt_f32_fp8((int)w, 0) : b == 1 ? __builtin_amdgcn_cvt_f32_fp8((int)w, 1) : b == 2 ? __builtin_amdgcn_cvt_f32_fp8((int)w, 2) : __builtin_amdgcn_cvt_f32_fp8((int)w, 3); }
__device__ __forceinline__ float wave_sum(float v) {
#pragma unroll
    for (int o = 1; o < 64; o <<= 1) v += __shfl_xor(v, o);
    return v; }
__device__ __forceinline__ float wave_max(float v) {
#pragma unroll
    for (int o = 1; o < 64; o <<= 1) v = fmaxf(v, __shfl_xor(v, o));
    return v; }
#define LAS __attribute__((address_space(3)))
#define LDS_WAIT() asm volatile("s_waitcnt lgkmcnt(0)" ::: "memory")
#define VM_WAIT() asm volatile("s_waitcnt vmcnt(0)" ::: "memory")

namespace pg8 {
#define PG8_LAS __attribute__((address_space(3)))
typedef unsigned short bf16_t;
typedef short bf16x8 __attribute__((ext_vector_type(8)));
typedef float f32x4 __attribute__((ext_vector_type(4)));
typedef unsigned u32x4 __attribute__((ext_vector_type(4)));
constexpr int BM = 256, BK = 64, HALF = 128, HTB = HALF * BK * 2  , STAGE_BYTES = 8 * HTB, NXCD = 8, WGM = 8;

__host__ __device__ __forceinline__ int lds_byte(int r, int c) { const int st = (r >> 4) * 2 + (c >> 5), rr = r & 15, cc = c & 31, ob = rr * 64 + cc * 2; return st * 1024 + (ob ^ (((ob >> 9) & 1) << 5)); }
__host__ __device__ __forceinline__ void stage_rc(int b, int& R, int& C) { const int st = b / 1024, sb = b % 1024, swz = sb ^ (((sb >> 9) & 1) << 5); R = (st >> 1) * 16 + swz / 64; C = (st & 1) * 32 + (swz % 64) / 2; }
__host__ __device__ __forceinline__ int perm32(int rho) { const int n = rho >> 4, i = rho & 15; return 8 * (i >> 2) + 4 * n + (i & 3); }

struct Unit { int pm, pn; };
struct Gemm { const bf16_t* A; const bf16_t* Bt; int M, N, K; };

struct StaticOrder {
    int nM, nN, nwg, G, c, rep;
    __host__ __device__ void init(int M, int N, int G_, int c_) { nM = M / BM; nN = N / BM; nwg = nM * nN; G = G_; c = c_; rep = 1; }
    __host__ __device__ bool next(int i, Unit& u) const {
        if (rep > 1) { const int cnt = (nwg - c + G - 1) / G; if (cnt <= 0 || i >= cnt * rep) return false; i = i % cnt; }
        const long L = (long)i * G + c; if (L >= nwg) return false;
        int wgid = (int)L; { const int q = nwg / NXCD, r = nwg % NXCD, xcd = wgid % NXCD, off = wgid / NXCD; wgid = (xcd < r ? xcd * (q + 1) : r * (q + 1) + (xcd - r) * q) + off; }
        const int nig = WGM * nN, gid = wgid / nig, fm = gid * WGM, gsz = (nM - fm) < WGM ? (nM - fm) : WGM;
        u.pm = fm + ((wgid % nig) % gsz); u.pn = (wgid % nig) / gsz; return true;
    }
    __device__ __forceinline__ void a_ready(const Unit&) const {}
    __device__ __forceinline__ void done(const Unit&) const {}
};

struct GroupedOrder : StaticOrder {
    int nNl;
    __host__ __device__ void init(int Mtot, int Nper, int G_, int c_) { StaticOrder::init(Mtot, Nper, G_, c_); nNl = Nper / BM; }
    __host__ __device__ bool next(int i, Unit& u) const { if (!StaticOrder::next(i, u)) return false; u.pn += (u.pm >> 3) * nNl; return true; }
};

#define EPI_LOOP_ROWS for (int ai = 0; ai < 2; ++ai) _Pragma("unroll") for (int m = 0; m < 4; ++m)

struct EpiGlaIn {
    static constexpr bool PERM = true, AFTER_DRAIN = false;
    bf16_t *Q0, *K0, *SR; float *GF, *GB; const float *bF, *bB;
    __device__ __forceinline__ void operator()(const f32x4 (&acc)[2][2][4][2], const Unit& u, int wr, int wc, int fr, int fq) const {
        const int row0 = u.pm * BM + wr * 64 + fr, pn = u.pn;
#pragma unroll
        EPI_LOOP_ROWS { const size_t row = (size_t)(row0 + ai * HALF + m * 16);
#pragma unroll
            for (int bj = 0; bj < 2; ++bj) { const int cl = bj * HALF + wc * 32 + 8 * fq; f32x4 v0 = acc[ai][bj][m][0], v1 = acc[ai][bj][m][1];
                if (pn < 2) { const float s = 0.08838834764831845f; store8bf(Q0 + row * 512 + pn * 256 + cl, v0 * s, v1 * s); }
                else if (pn < 4) { store8bf(K0 + row * 512 + (pn - 2) * 256 + cl, v0, v1); }
                else if (pn < 8) {
#pragma unroll
                    for (int j = 0; j < 4; ++j) { v0[j] = siluf(v0[j]); v1[j] = siluf(v1[j]); }
                    store8bf(SR + row * 1024 + (pn - 4) * 256 + cl, v0, v1); }
                else { float* G = pn < 10 ? GF : GB; const float* b = pn < 10 ? bF : bB; const int c = ((pn - 8) & 1) * 256 + cl;
                    const f32x4 b0 = *(const f32x4*)(b + c), b1 = *(const f32x4*)(b + c + 4); f32x4 o0, o1;
#pragma unroll
                    for (int j = 0; j < 4; ++j) { o0[j] = logsigf(v0[j] + b0[j]) * 0.0625f; o1[j] = logsigf(v1[j] + b1[j]) * 0.0625f; }
                    *(f32x4*)(G + row * 512 + c) = o0; *(f32x4*)(G + row * 512 + c + 4) = o1; } } }
    }
};
struct EpiBf {
    static constexpr bool PERM = true, AFTER_DRAIN = false;
    bf16_t* O; int ldc;
    __device__ __forceinline__ void operator()(const f32x4 (&acc)[2][2][4][2], const Unit& u, int wr, int wc, int fr, int fq) const {
        const int row0 = u.pm * BM + wr * 64 + fr;
#pragma unroll
        EPI_LOOP_ROWS { bf16_t* rowp = O + (size_t)(row0 + ai * HALF + m * 16) * ldc + u.pn * BM + wc * 32 + 8 * fq;
#pragma unroll
            for (int bj = 0; bj < 2; ++bj) store8bf(rowp + bj * HALF, acc[ai][bj][m][0], acc[ai][bj][m][1]); }
    }
};
struct EpiF32 {
    static constexpr bool PERM = false, AFTER_DRAIN = false;
    float* C; const float* base; int ldc;
    __device__ __forceinline__ void operator()(const f32x4 (&acc)[2][2][4][2], const Unit& u, int wr, int wc, int fr, int fq) const {
        const int row0 = u.pm * BM + wr * 64 + fr, col0 = u.pn * BM + wc * 32 + 4 * fq;
#pragma unroll
        EPI_LOOP_ROWS { const size_t off = (size_t)(row0 + ai * HALF + m * 16) * ldc + col0;
#pragma unroll
            for (int bj = 0; bj < 2; ++bj)
#pragma unroll
                for (int n = 0; n < 2; ++n) { f32x4 v = acc[ai][bj][m][n]; if (base) v = v + *(const f32x4*)(base + off + bj * HALF + n * 16); *(f32x4*)(C + off + bj * HALF + n * 16) = v; } }
    }
};
struct EpiQup {
    static constexpr bool PERM = true, AFTER_DRAIN = false;
    bf16_t* Q; const float* CS;
    __device__ __forceinline__ void operator()(const f32x4 (&acc)[2][2][4][2], const Unit& u, int wr, int wc, int fr, int fq) const {
        const int row0 = u.pm * BM + wr * 64 + fr, h = u.pn; const float QS = 0.07216878364870322f * 1.4426950408889634f;
#pragma unroll
        EPI_LOOP_ROWS { const size_t row = (size_t)(row0 + ai * HALF + m * 16); bf16_t* qrow = Q + ((size_t)h * T + row) * MDK;
            store8bf(qrow + wc * 32 + 8 * fq, acc[ai][0][m][0] * QS, acc[ai][0][m][1] * QS);
            if (wc < 2) { const int i0 = wc * 16 + 4 * fq; const f32x4 c = *(const f32x4*)(CS + row * 64 + i0), s = *(const f32x4*)(CS + row * 64 + 32 + i0);
                const f32x4 x1 = acc[ai][1][m][0], x2 = acc[ai][1][m][1];
                store8bf(qrow + 128 + wc * 32 + 8 * fq, (x1 * c - x2 * s) * QS, (x1 * s + x2 * c) * QS); } }
    }
};
struct EpiKVup {
    static constexpr bool PERM = true, AFTER_DRAIN = false;
    bf16_t *K, *V;
    __device__ __forceinline__ void operator()(const f32x4 (&acc)[2][2][4][2], const Unit& u, int wr, int wc, int fr, int fq) const {
        const int row0 = u.pm * BM + wr * 64 + fr, h = u.pn;
#pragma unroll
        EPI_LOOP_ROWS { const size_t row = (size_t)h * T + (size_t)(row0 + ai * HALF + m * 16);
            store8bf(K + row * MDK + wc * 32 + 8 * fq, acc[ai][0][m][0], acc[ai][0][m][1]);
            store8bf(V + row * MDV + wc * 32 + 8 * fq, acc[ai][1][m][0], acc[ai][1][m][1]); }
    }
};
struct EpiMoe1 {
    static constexpr bool PERM = true, AFTER_DRAIN = false;
    bf16_t* H;
    __device__ __forceinline__ void operator()(const f32x4 (&acc)[2][2][4][2], const Unit& u, int wr, int wc, int fr, int fq) const {
        const int row0 = u.pm * BM + wr * 64 + fr, j = u.pn & 15;
#pragma unroll
        EPI_LOOP_ROWS { const size_t eo = (size_t)(row0 + ai * HALF + m * 16) * FF + 128 * j + 16 * wc + 4 * fq; bf16_t* rowp = H + eo;
#pragma unroll
            for (int bj = 0; bj < 2; ++bj) { f32x4 g = acc[ai][bj][m][0], uu = acc[ai][bj][m][1];
                if (MOE_FP8) { g = g * 0.03125f; uu = uu * 0.03125f; *(unsigned*)((unsigned char*)H + eo + 64 * bj) = pk4fp8(siluf(g[0]) * uu[0], siluf(g[1]) * uu[1], siluf(g[2]) * uu[2], siluf(g[3]) * uu[3]); continue; }
                u32x2 w; w.x = cvt_pk_bf16(siluf(g[0]) * uu[0], siluf(g[1]) * uu[1]); w.y = cvt_pk_bf16(siluf(g[2]) * uu[2], siluf(g[3]) * uu[3]);
                *(u32x2*)(rowp + 64 * bj) = w; } }
    }
};
struct EpiMoe2 {
    static constexpr bool PERM = true, AFTER_DRAIN = false;
    bf16_t* Y;
    __device__ __forceinline__ void operator()(const f32x4 (&acc)[2][2][4][2], const Unit& u, int wr, int wc, int fr, int fq) const {
        const int row0 = u.pm * BM + wr * 64 + fr, j = u.pn & 3;
#pragma unroll
        EPI_LOOP_ROWS { bf16_t* rowp = Y + (size_t)(row0 + ai * HALF + m * 16) * D + 256 * j + wc * 32 + 8 * fq;
#pragma unroll
            for (int bj = 0; bj < 2; ++bj) { const float sc = MOE_FP8 ? 0.03125f : 1.0f; store8bf(rowp + bj * HALF, acc[ai][bj][m][0] * sc, acc[ai][bj][m][1] * sc); } }
    }
};

struct EpiQ8 {
    static constexpr bool PERM = true, AFTER_DRAIN = false;
    unsigned char* Q; const float* CS;
    __device__ __forceinline__ void operator()(const f32x4 (&acc)[2][2][4][2], const Unit& u, int wr, int wc, int fr, int fq) const {
        const int row0 = u.pm * BM + wr * 64 + fr, h = u.pn; const float QS = 8.0f * 0.07216878364870322f * 1.4426950408889634f;
#pragma unroll
        EPI_LOOP_ROWS { const size_t row = (size_t)(row0 + ai * HALF + m * 16); unsigned char* qrow = Q + ((size_t)h * T + row) * MDK;
            store8fp8(qrow + wc * 32 + 8 * fq, acc[ai][0][m][0] * QS, acc[ai][0][m][1] * QS);
            if (wc < 2) { const int i0 = wc * 16 + 4 * fq; const f32x4 c = *(const f32x4*)(CS + row * 64 + i0), s = *(const f32x4*)(CS + row * 64 + 32 + i0);
                const f32x4 x1 = acc[ai][1][m][0], x2 = acc[ai][1][m][1];
                store8fp8(qrow + 128 + wc * 32 + 8 * fq, (x1 * c - x2 * s) * QS, (x1 * s + x2 * c) * QS); } }
    }
};
struct EpiK8 {
    static constexpr bool PERM = true, AFTER_DRAIN = false;
    unsigned char* K;
    __device__ __forceinline__ void operator()(const f32x4 (&acc)[2][2][4][2], const Unit& u, int wr, int wc, int fr, int fq) const {
        const int row0 = u.pm * BM + wr * 64 + fr;
#pragma unroll
        EPI_LOOP_ROWS { const size_t row = (size_t)(row0 + ai * HALF + m * 16);
#pragma unroll
            for (int bj = 0; bj < 2; ++bj) store8fp8(K + ((size_t)(2 * u.pn + bj) * T + row) * MDK + wc * 32 + 8 * fq, acc[ai][bj][m][0], acc[ai][bj][m][1]); }
    }
};
struct EpiV8T {
    static constexpr bool PERM = true, AFTER_DRAIN = false;
    unsigned char* V;
    __device__ __forceinline__ void operator()(const f32x4 (&acc)[2][2][4][2], const Unit& u, int wr, int wc, int fr, int fq) const {
        const int row0 = u.pm * BM + wr * 64 + fr;
#pragma unroll
        EPI_LOOP_ROWS { unsigned char* rowp = V + (size_t)(row0 + ai * HALF + m * 16) * T + u.pn * BM + 64 * (wc >> 1) + 16 * (wc & 1) + 4 * fq;
#pragma unroll
            for (int bj = 0; bj < 2; ++bj) { const f32x4 a = acc[ai][bj][m][0], b = acc[ai][bj][m][1];
                *(unsigned*)(rowp + bj * HALF) = pk4fp8(a[0], a[1], a[2], a[3]); *(unsigned*)(rowp + bj * HALF + 32) = pk4fp8(b[0], b[1], b[2], b[3]); } }
    }
};

typedef int i32x4g __attribute__((ext_vector_type(4)));
template <class Epi, class Sched, bool ALIGN_EPI = false, bool SP2 = false, bool F8 = false>
__device__ __forceinline__ void gemm_phase(PG8_LAS unsigned char* lds, const Gemm g, const Sched& S, const Epi& E) {
    const int tid = threadIdx.x, wid = __builtin_amdgcn_readfirstlane(tid >> 6), lane = tid & 63, wr = wid >> 2, wc = wid & 3, fr = lane & 15, fq = lane >> 4;
    int K = g.K; asm volatile("" : "+s"(K));
    const int nt = K / BK;
    unsigned voffA[2], voffB[2];
#pragma unroll
    for (int i = 0; i < 2; ++i) { int R, C; stage_rc(tid * 16 + i * 8192, R, C); const int Rb = Epi::PERM ? ((R & ~31) + perm32(R & 31)) : R;
        voffA[i] = (unsigned)(R * K + C) * 2u; voffB[i] = (unsigned)(Rb * K + C) * 2u; }
    const size_t kstep = (size_t)(BK * 2);
    const size_t hstep = (size_t)HALF * K * 2;
    const size_t tstep = 2 * hstep;
    const unsigned ldsw = (unsigned)wid * 1024u;
    const int aoff = lds_byte(wr * 64 + fr, fq * 8), boff = lds_byte(wc * 32 + fr, fq * 8);
    PG8_LAS unsigned char* const ldsA = lds + aoff; PG8_LAS unsigned char* const ldsB = lds + 4 * HTB + boff;
#define PG8_SA(b, h) (((b) * 2 + (h)) * HTB)
#define PG8_SB(b, h) ((4 + (b) * 2 + (h)) * HTB)
#define PG8_STAGE(bufoff, gbase, voff) do { _Pragma("unroll") for (int _i = 0; _i < 2; ++_i) \
        __builtin_amdgcn_global_load_lds((const unsigned*)((const char*)(gbase) + (voff)[_i]), (PG8_LAS unsigned*)(lds + (bufoff) + ldsw + _i * 8192), 16, 0, 0); } while (0)
#define PG8_LD8(base, off) __builtin_shufflevector(*(const PG8_LAS i32x4g*)((base) + (off)), *(const PG8_LAS i32x4g*)((base) + (off) + 1024), 0, 1, 2, 3, 4, 5, 6, 7)
#define PG8_LDA(dst, b, h) do { _Pragma("unroll") for (int m = 0; m < 4; ++m) { if constexpr (F8) dst##8[m] = PG8_LD8(ldsA, PG8_SA(b, h) + m * 2048); else { _Pragma("unroll") for (int k = 0; k < 2; ++k) dst[m][k] = *(const PG8_LAS bf16x8*)(lds + PG8_SA(b, h) + aoff + m * 2048 + k * 1024); } } } while (0)
#define PG8_LDB(dst, b, h) do { _Pragma("unroll") for (int n = 0; n < 2; ++n) { if constexpr (F8) dst##8[n] = PG8_LD8(ldsB, PG8_SA(b, h) + n * 2048); else { _Pragma("unroll") for (int k = 0; k < 2; ++k) dst[n][k] = *(const PG8_LAS bf16x8*)(lds + PG8_SB(b, h) + boff + n * 2048 + k * 1024); } } } while (0)
#define PG8_CAT(x, y) __builtin_shufflevector((i32x4g)(x), (i32x4g)(y), 0, 1, 2, 3, 4, 5, 6, 7)
#define PG8_MMA(ai, bj, At, Bt) do { __builtin_amdgcn_s_setprio(1); _Pragma("unroll") for (int m = 0; m < 4; ++m) _Pragma("unroll") for (int n = 0; n < 2; ++n) { \
        if constexpr (F8) asm volatile("v_mfma_scale_f32_16x16x128_f8f6f4 %0, %1, %2, %0, %3, %3 op_sel_hi:[0,0,0]" : "+v"(acc[ai][bj][m][n]) : "v"(Bt##8[n]), "v"(At##8[m]), "v"(scl8));     \
        else { _Pragma("unroll") for (int k = 0; k < 2; ++k) acc[ai][bj][m][n] = __builtin_amdgcn_mfma_f32_16x16x32_bf16(Bt[n][k], At[m][k], acc[ai][bj][m][n], 0, 0, 0); } } \
        __builtin_amdgcn_s_setprio(0); } while (0)
#define PG8_WAIT_V(n) asm volatile("s_waitcnt vmcnt(" #n ")" ::: "memory")
#define PG8_WAIT_L(n) asm volatile("s_waitcnt lgkmcnt(" #n ")" ::: "memory")
#define PG8_BAR __builtin_amdgcn_s_barrier()
#define PG8_SCHED __builtin_amdgcn_sched_barrier(0)
    Unit cur, nxt; int ui = 0;
    if (!S.next(0, cur)) return;
    f32x4 acc[2][2][4][2];
#pragma unroll
    for (int a = 0; a < 2; ++a)
#pragma unroll
        for (int b = 0; b < 2; ++b)
#pragma unroll
            for (int m = 0; m < 4; ++m)
#pragma unroll
                for (int n = 0; n < 2; ++n) acc[a][b][m][n] = (f32x4){0.f, 0.f, 0.f, 0.f};
    unsigned scl8 = 0x7f7f7f7fu; asm volatile("" : "+v"(scl8));
    bf16x8 At[4][2], B0[2][2], B1[2][2]; i32x8 At8[4], B08[2], B18[2];
    const char* cA = (const char*)g.A + (size_t)cur.pm * tstep; const char* cB = (const char*)g.Bt + (size_t)cur.pn * tstep;
    S.a_ready(cur);
    if constexpr (SP2) {
        PG8_STAGE(PG8_SB(0, 0), cB, voffB); PG8_STAGE(PG8_SB(0, 1), cB + hstep, voffB); PG8_STAGE(PG8_SA(0, 0), cA, voffA); PG8_STAGE(PG8_SA(0, 1), cA + hstep, voffA);
        if (wr == 1) PG8_BAR;
        PG8_WAIT_V(2); PG8_BAR;
        PG8_STAGE(PG8_SB(1, 0), cB + kstep, voffB); PG8_STAGE(PG8_SA(1, 0), cA + kstep, voffA); PG8_STAGE(PG8_SB(1, 1), cB + hstep + kstep, voffB);
        PG8_WAIT_V(6); PG8_BAR;
    } else {
        PG8_STAGE(PG8_SB(0, 0), cB, voffB); PG8_STAGE(PG8_SA(0, 0), cA, voffA); PG8_STAGE(PG8_SB(0, 1), cB + hstep, voffB); PG8_STAGE(PG8_SA(0, 1), cA + hstep, voffA);
        if (wr == 1) PG8_BAR;
        PG8_WAIT_V(4); PG8_BAR;
        PG8_STAGE(PG8_SB(1, 0), cB + kstep, voffB); PG8_STAGE(PG8_SA(1, 0), cA + kstep, voffA); PG8_STAGE(PG8_SB(1, 1), cB + hstep + kstep, voffB);
        PG8_WAIT_V(6); PG8_BAR;
    }
    for (;;) {
        const bool has_next = S.next(ui + 1, nxt);
        const char* nA = has_next ? (const char*)g.A + (size_t)nxt.pm * tstep : cA; const char* nB = has_next ? (const char*)g.Bt + (size_t)nxt.pn * tstep : cB;
        for (int t = 0; t < nt; t += 2) {
            const bool last = (t == nt - 2);
            const char* a1 = cA + (size_t)(t + 1) * kstep;
            const char* a2 = last ? nA : cA + (size_t)(t + 2) * kstep; const char* b2 = last ? nB : cB + (size_t)(t + 2) * kstep;
            const char* a3 = a2 + kstep; const char* b3 = b2 + kstep;
            if (last && has_next) S.a_ready(nxt);
            if constexpr (SP2) {
            PG8_LDB(B0, 0, 0); PG8_LDB(B1, 0, 1); PG8_SCHED; PG8_LDA(At, 0, 0); PG8_STAGE(PG8_SA(1, 1), a1 + hstep, voffA);
            PG8_WAIT_V(8); PG8_WAIT_L(0); PG8_BAR; PG8_MMA(0, 0, At, B0); PG8_MMA(0, 1, At, B1); PG8_BAR; PG8_SCHED;
            PG8_LDA(At, 0, 1); PG8_STAGE(PG8_SB(0, 0), b2, voffB); PG8_STAGE(PG8_SB(0, 1), b2 + hstep, voffB); PG8_STAGE(PG8_SA(0, 0), a2, voffA);
            PG8_WAIT_V(8); PG8_WAIT_L(0); PG8_BAR; PG8_MMA(1, 0, At, B0); PG8_MMA(1, 1, At, B1); PG8_BAR; PG8_SCHED;
            PG8_LDB(B0, 1, 0); PG8_LDB(B1, 1, 1); PG8_SCHED; PG8_LDA(At, 1, 0); PG8_STAGE(PG8_SA(0, 1), a2 + hstep, voffA);
            PG8_WAIT_V(8); PG8_WAIT_L(0); PG8_BAR; PG8_MMA(0, 0, At, B0); PG8_MMA(0, 1, At, B1); PG8_BAR; PG8_SCHED;
            PG8_LDA(At, 1, 1); PG8_STAGE(PG8_SB(1, 0), b3, voffB); PG8_STAGE(PG8_SB(1, 1), b3 + hstep, voffB); PG8_STAGE(PG8_SA(1, 0), a3, voffA);
            PG8_WAIT_V(8); PG8_WAIT_L(0); PG8_BAR; PG8_MMA(1, 0, At, B0); PG8_MMA(1, 1, At, B1); PG8_BAR; PG8_SCHED;
            } else {
            PG8_LDB(B0, 0, 0); PG8_SCHED; PG8_LDA(At, 0, 0); PG8_STAGE(PG8_SA(1, 1), a1 + hstep, voffA);
            PG8_WAIT_L(8); PG8_BAR; PG8_WAIT_L(0); PG8_MMA(0, 0, At, B0); PG8_BAR; PG8_SCHED;
            PG8_LDB(B1, 0, 1); PG8_STAGE(PG8_SB(0, 0), b2, voffB);
            PG8_BAR; PG8_WAIT_L(0); PG8_MMA(0, 1, At, B1); PG8_BAR;
            PG8_LDA(At, 0, 1); PG8_STAGE(PG8_SA(0, 0), a2, voffA);
            PG8_BAR; PG8_WAIT_L(0); PG8_MMA(1, 0, At, B0); PG8_BAR; PG8_SCHED;
            PG8_STAGE(PG8_SB(0, 1), b2 + hstep, voffB);
            PG8_WAIT_V(6); PG8_BAR; PG8_MMA(1, 1, At, B1); PG8_BAR;
            PG8_LDB(B0, 1, 0); PG8_SCHED; PG8_LDA(At, 1, 0); PG8_STAGE(PG8_SA(0, 1), a2 + hstep, voffA);
            PG8_WAIT_L(8); PG8_BAR; PG8_WAIT_L(0); PG8_MMA(0, 0, At, B0); PG8_BAR; PG8_SCHED;
            PG8_LDB(B1, 1, 1); PG8_STAGE(PG8_SB(1, 0), b3, voffB);
            PG8_BAR; PG8_WAIT_L(0); PG8_MMA(0, 1, At, B1); PG8_BAR;
            PG8_LDA(At, 1, 1); PG8_STAGE(PG8_SA(1, 0), a3, voffA);
            PG8_BAR; PG8_WAIT_L(0); PG8_MMA(1, 0, At, B0); PG8_BAR; PG8_SCHED;
            PG8_STAGE(PG8_SB(1, 1), b3 + hstep, voffB);
            PG8_WAIT_V(6); PG8_BAR; PG8_MMA(1, 1, At, B1); PG8_BAR;
            }
        }
        if constexpr (F8) asm volatile("s_nop 15\n\ts_nop 15" ::: "memory");
        if constexpr (ALIGN_EPI) { if (wr == 0) PG8_BAR; }
        if constexpr (!Epi::AFTER_DRAIN) { E(acc, cur, wr, wc, fr, fq); S.done(cur); }
        if (!has_next) break;
#pragma unroll
        for (int a = 0; a < 2; ++a)
#pragma unroll
            for (int b = 0; b < 2; ++b)
#pragma unroll
                for (int m = 0; m < 4; ++m)
#pragma unroll
                    for (int n = 0; n < 2; ++n) acc[a][b][m][n] = (f32x4){0.f, 0.f, 0.f, 0.f};
        cur = nxt; cA = nA; cB = nB; ++ui;
        if constexpr (ALIGN_EPI) { if (wr == 1) PG8_BAR; }
    }
    PG8_WAIT_V(0);
    if constexpr (!ALIGN_EPI) { if (wr == 0) PG8_BAR; }
    PG8_BAR;
    if constexpr (Epi::AFTER_DRAIN) { E.fused(acc, cur, wr, wc, fr, fq, lds, wid, lane); S.done(cur); }
#undef PG8_SA
#undef PG8_SB
#undef PG8_STAGE
#undef PG8_LDA
#undef PG8_LD8
#undef PG8_LDB
#undef PG8_MMA
#undef PG8_CAT
#undef PG8_WAIT_V
#undef PG8_WAIT_L
#undef PG8_BAR
#undef PG8_SCHED
}
}
#define XB_TMO      128
#define XB_XCNT(j)  (256  + 64 * (j))
#define XB_XSUB(j)  (1280 + 64 * (j))
#define XB_XGEN(j)  (2304 + 64 * (j))
#define XB_TOP      3328
#define XB_TOPGEN   3392
#define XCD_BAR_WORDS 3456
#define XB_SPIN_CAP (1u << 18)

__device__ __forceinline__ unsigned xb_ld(unsigned* p)              { return __hip_atomic_load(p, __ATOMIC_RELAXED, __HIP_MEMORY_SCOPE_AGENT); }
__device__ __forceinline__ unsigned xb_add(unsigned* p, unsigned v) { return __hip_atomic_fetch_add(p, v, __ATOMIC_RELAXED, __HIP_MEMORY_SCOPE_AGENT); }
__device__ __forceinline__ unsigned xb_xcc_id() { return (unsigned)__builtin_amdgcn_s_getreg((3 << 11) | 20) & 0xFu; }
#define XB_SPIN(cond, bar) do { unsigned _sp = 0; while (cond) { __builtin_amdgcn_s_sleep(1); \
    if ((++_sp & 255u) == 0u) { if (xb_ld(&(bar)[XB_TMO])) break; if (_sp > XB_SPIN_CAP) { atomicAdd(&(bar)[XB_TMO], 1u); break; } } } } while (0)

struct XcdBarrier {
    unsigned* bar; unsigned x;
    volatile LAS unsigned* st;
};

__device__ __forceinline__ XcdBarrier xcd_barrier_post(unsigned* bar, volatile LAS unsigned* st) {
    XcdBarrier b; b.bar = bar; b.x = xb_xcc_id(); b.st = st;
    if (threadIdx.x == 0) (void)xb_add(&bar[XB_XCNT(b.x)], 1u);
    return b;
}
__device__ __forceinline__ void xcd_barrier_complete(unsigned* bar, unsigned x, unsigned& nloc, unsigned& nx) {
    const unsigned G = gridDim.x * gridDim.y * gridDim.z;
    unsigned sum, cnt, mine, sp = 0u;
    for (;;) {
        sum = 0u; cnt = 0u; mine = 0u;
#pragma unroll
        for (unsigned j = 0; j < 16; ++j) { const unsigned c = xb_ld(&bar[XB_XCNT(j)]); sum += c; cnt += (c > 0u) ? 1u : 0u; mine = (j == x) ? c : mine; }
        if (sum == G) break;
        __builtin_amdgcn_s_sleep(1);
        if ((++sp & 255u) == 0u) { if (xb_ld(&bar[XB_TMO])) break; if (sp > XB_SPIN_CAP) { atomicAdd(&bar[XB_TMO], 1u); break; } }
    }
    nloc = mine > 0u ? mine : 1u; nx = cnt > 0u ? cnt : 1u;
}

__device__ __forceinline__ void xcd_barrier(const XcdBarrier& b) {
    asm volatile("s_waitcnt vmcnt(0)" ::: "memory");
    __syncthreads();
    if (threadIdx.x == 0) {
        unsigned* bar = b.bar;
        __builtin_amdgcn_s_waitcnt(0);
        unsigned nloc = b.st[0], nx = b.st[1];
        if (nloc == 0u) { xcd_barrier_complete(bar, b.x, nloc, nx); b.st[0] = nloc; b.st[1] = nx; }
        const unsigned old = xb_add(&bar[XB_XSUB(b.x)], 1u);
        const unsigned gen = old / nloc;
        if (old + 1u == (gen + 1u) * nloc) {
            __builtin_amdgcn_fence(__ATOMIC_RELEASE, "agent");
            asm volatile("s_waitcnt vmcnt(0)" ::: "memory");
            const unsigned og = xb_add(&bar[XB_TOP], 1u);
            const unsigned tg = og / nx;
            if (og + 1u == (tg + 1u) * nx) xb_add(&bar[XB_TOPGEN], 1u);
            else XB_SPIN(xb_ld(&bar[XB_TOPGEN]) == tg, bar);
            __builtin_amdgcn_fence(__ATOMIC_ACQUIRE, "agent");
            xb_add(&bar[XB_XGEN(b.x)], 1u);
            asm volatile("s_waitcnt vmcnt(0)" ::: "memory");
        } else {
            XB_SPIN(xb_ld(&bar[XB_XGEN(b.x)]) == gen, bar);
            __builtin_amdgcn_fence(__ATOMIC_ACQUIRE, "agent");
            asm volatile("s_waitcnt vmcnt(0)" ::: "memory");
        }
    }
    __syncthreads();
}

#ifndef PG8_SP2
#define PG8_SP2 true
#endif
#ifndef PG8_ALIGN
#define PG8_ALIGN true
#endif

struct Args { const void* in[22]; float* out; unsigned char* ws; float invf[32]; int ph_lo, ph_hi, li, pad; };
struct Ctx { int tid, lane, wave, gw, ngw, bid, nb; unsigned char* lds; };

struct MapId { int off; __device__ __forceinline__ int operator()(int n) const { return off + n; } };
struct MapGU { int which; __device__ __forceinline__ int operator()(int f) const { return 8 * (f >> 2) + 4 * which + (f & 3); } };
struct MapUkv { __device__ __forceinline__ int operator()(int n) const { const int h = n >> 8, j = n & 255; return ATT_FP8 ? (j < 128 ? 128 * h + j : 2048 + 128 * h + (j - 128)) : n; } };
struct MapUq { __device__ __forceinline__ int operator()(int n) const { const int h = n / 192, j = n - h * 192;
    if (j < 128) return 256 * h + j; if (j < 160) { const int i = j - 128; return 256 * h + 128 + 8 * (i >> 2) + (i & 3); } const int i = j - 160; return 256 * h + 128 + 8 * (i >> 2) + 4 + (i & 3); } };
constexpr int TR_SCR = 16896;
__device__ __forceinline__ void tr_load(const float* W, int ldw, int k0, int n0, f32x4 (&v)[16], int lane) {
#pragma unroll
    for (int i = 0; i < 16; ++i) v[i] = *(const f32x4*)(W + (size_t)(k0 + (lane >> 4) + 4 * i) * ldw + n0 + 4 * (lane & 15));
}
template <class RM, bool F8 = false>
__device__ __forceinline__ void tr_flush(const f32x4 (&v)[16], bf16_t* WT, int ldt, int k0, int nloc0, const RM& rm, float* scr, int lane) {
    const int nb = 4 * (lane & 15), kq = lane >> 4;
#pragma unroll
    for (int i = 0; i < 16; ++i) { float* d = scr + nb * 65 + kq + 4 * i; d[0] = v[i][0]; d[65] = v[i][1]; d[130] = v[i][2]; d[195] = v[i][3]; }
    LDS_WAIT();
    const int c = lane & 7;
#pragma unroll
    for (int j = 0; j < 8; ++j) { const int n = (lane >> 3) + 8 * j; const float* q = scr + n * 65 + 8 * c;
        if constexpr (F8) { u32x2 o; o.x = pk4fp8(q[0] * 32.f, q[1] * 32.f, q[2] * 32.f, q[3] * 32.f); o.y = pk4fp8(q[4] * 32.f, q[5] * 32.f, q[6] * 32.f, q[7] * 32.f);
            *(u32x2*)((unsigned char*)WT + (size_t)rm(nloc0 + n) * ldt + k0 + 8 * c) = o; }
        else { u32x4 o; o.x = cvt_pk_bf16(q[0], q[1]); o.y = cvt_pk_bf16(q[2], q[3]); o.z = cvt_pk_bf16(q[4], q[5]); o.w = cvt_pk_bf16(q[6], q[7]);
        *(u32x4*)(WT + (size_t)rm(nloc0 + n) * ldt + k0 + 8 * c) = o; } }
    LDS_WAIT();
}
template <class RM>
__device__ __forceinline__ void tr_job(const Ctx& C, int& base, const float* W, int ldw, int K, int ncol0, int ncols, bf16_t* WT, int ldt, const RM& rm) {
    const int nblk = ncols / 64, items = (K / 64) * nblk; float* scr = (float*)(C.lds + C.wave * TR_SCR);
    int first = (C.gw - base % C.ngw + C.ngw) % C.ngw;
    for (int it = first; it < items; it += C.ngw) { const int kb = it / nblk, nb = it - kb * nblk; f32x4 v[16]; tr_load(W, ldw, 64 * kb, ncol0 + 64 * nb, v, C.lane); tr_flush(v, WT, ldt, 64 * kb, 64 * nb, rm, scr, C.lane); }
    base += items;
}
__device__ __forceinline__ void ph_convert_small(const Ctx& C, const Args& a, unsigned char* ws) {
    const float* w_in = (const float*)a.in[5]; int base = 0;
    bf16_t* WGIN = (bf16_t*)(ws + WS_WGIN);
    tr_job(C, base, w_in, 3104, 1024, 0, 1024, WGIN, 1024, MapId{0});
    tr_job(C, base, w_in, 3104, 1024, 1024, 1024, (bf16_t*)(ws + WS_WV), 1024, MapId{0});
    tr_job(C, base, w_in, 3104, 1024, 2048, 1024, WGIN, 1024, MapId{1024});
    tr_job(C, base, (const float*)a.in[11], 1024, 1024, 0, 1024, (bf16_t*)(ws + WS_WGOUT), 1024, MapId{0});
    tr_job(C, base, (const float*)a.in[12], 448, 1024, 0, 448, (bf16_t*)(ws + WS_WMIN), 1024, MapId{0});
    tr_job(C, base, (const float*)a.in[14], 3072, 256, 0, 3072, (bf16_t*)(ws + WS_WUQ), 256, MapUq{});
    tr_job(C, base, (const float*)a.in[16], 4096, 128, 0, 4096, (bf16_t*)(ws + WS_WUKV), 256, MapUkv{});
    tr_job(C, base, (const float*)a.in[17], 1024, 2048, 0, 1024, (bf16_t*)(ws + WS_WMOUT), 2048, MapId{0});
    const int gt = C.bid * 512 + C.tid, ngt = C.nb * 512;
    for (int it = gt; it < 1024 * 128; it += ngt) { const int cp = it >> 7, k8 = it & 127, dir = cp >> 9, c = cp & 511;
        const float* wg = (const float*)a.in[dir ? 8 : 6]; float wj[16];
#pragma unroll
        for (int j = 0; j < 16; ++j) wj[j] = wg[j * 512 + c];
        float o[8];
#pragma unroll
        for (int kk = 0; kk < 8; ++kk) { const float* wr = w_in + (size_t)(8 * k8 + kk) * 3104 + 3072 + 16 * dir; float s = 0.f;
#pragma unroll
            for (int j4 = 0; j4 < 4; ++j4) { const f32x4 x = *(const f32x4*)(wr + 4 * j4); s += x[0] * wj[4 * j4] + x[1] * wj[4 * j4 + 1] + x[2] * wj[4 * j4 + 2] + x[3] * wj[4 * j4 + 3]; }
            o[kk] = s; }
        u32x4 w; w.x = cvt_pk_bf16(o[0], o[1]); w.y = cvt_pk_bf16(o[2], o[3]); w.z = cvt_pk_bf16(o[4], o[5]); w.w = cvt_pk_bf16(o[6], o[7]);
        *(u32x4*)(WGIN + (size_t)(2048 + cp) * 1024 + 8 * k8) = w; }
    const u32x4 z = {0u, 0u, 0u, 0u};
    for (int it = gt; it < 64 * 128; it += ngt) *(u32x4*)((bf16_t*)(ws + WS_WMIN) + (size_t)448 * 1024 + (size_t)it * 8) = z;
    for (int it = gt; it < 16 * 64 * 32; it += ngt) { const int h = it >> 11, r = (it >> 5) & 63, c8 = it & 31; *(u32x4*)((bf16_t*)(ws + WS_WUQ) + (size_t)(256 * h + 192 + r) * 256 + c8 * 8) = z; }
    for (int it = gt; it < 4096 * 16; it += ngt) { const int r = it >> 4, c8 = it & 15; *(u32x4*)((bf16_t*)(ws + WS_WUKV) + (size_t)r * 256 + 128 + c8 * 8) = z; }
}
struct MapMoe { int kind; __device__ __forceinline__ int operator()(int f) const { return kind < 2 ? 8 * (f >> 2) + 4 * kind + (f & 3) : f; } };
struct MoeItem { const float* src; bf16_t* dst; int ldw, ldt, k0, n0, kind; };
__device__ __forceinline__ MoeItem moe_item(const Args& a, unsigned char* ws, int layer, int it) {
    const int e = it / 1536, r = it - e * 1536, which = r >> 9, j = r & 511; const size_t le = (size_t)(layer * NE + e); MoeItem m; m.kind = which;
    if (which < 2) { m.src = (const float*)a.in[19 + which] + le * 1024 * 2048; m.ldw = 2048; m.dst = (bf16_t*)(ws + WS_WGU + (size_t)e * 4096 * 1024 * (MOE_FP8 ? 1 : 2)); m.ldt = 1024; m.k0 = 64 * (j >> 5); m.n0 = 64 * (j & 31); }
    else { m.src = (const float*)a.in[21] + le * 2048 * 1024; m.ldw = 1024; m.dst = (bf16_t*)(ws + WS_WD + (size_t)e * 1024 * 2048 * (MOE_FP8 ? 1 : 2)); m.ldt = 2048; m.k0 = 64 * (j >> 4); m.n0 = 64 * (j & 15); }
    return m;
}
__device__ __forceinline__ void ph_convert_moe(const Ctx& C, const Args& a, unsigned char* ws, int layer, int rep) {
    constexpr int NIT1 = NE * 1536; const int NIT = NIT1 * rep; float* scr = (float*)(C.lds + C.wave * TR_SCR);
    int it = C.gw; if (it >= NIT) return;
    f32x4 va[16], vb[16]; MoeItem ma = moe_item(a, ws, layer, it % NIT1), mb = ma; tr_load(ma.src, ma.ldw, ma.k0, ma.n0, va, C.lane);
    for (;;) {
        int nx = it + C.ngw; if (nx < NIT) { mb = moe_item(a, ws, layer, nx % NIT1); tr_load(mb.src, mb.ldw, mb.k0, mb.n0, vb, C.lane); }
        tr_flush<MapMoe, MOE_FP8 != 0>(va, ma.dst, ma.ldt, ma.k0, ma.n0, MapMoe{ma.kind}, scr, C.lane);
        it = nx; if (it >= NIT) break;
        nx = it + C.ngw; if (nx < NIT) { ma = moe_item(a, ws, layer, nx % NIT1); tr_load(ma.src, ma.ldw, ma.k0, ma.n0, va, C.lane); }
        tr_flush<MapMoe, MOE_FP8 != 0>(vb, mb.dst, mb.ldt, mb.k0, mb.n0, MapMoe{mb.kind}, scr, C.lane);
        it = nx; if (it >= NIT) break;
    }
}

__device__ __forceinline__ void row_load(const float* row, int lane, f32x4 (&v)[4]) {
#pragma unroll
    for (int j = 0; j < 4; ++j) v[j] = *(const f32x4*)(row + 256 * j + 4 * lane); }
__device__ __forceinline__ float row_rstd(const f32x4 (&v)[4]) { float s = 0.f;
#pragma unroll
    for (int j = 0; j < 4; ++j) s += (v[j][0] * v[j][0] + v[j][1] * v[j][1]) + (v[j][2] * v[j][2] + v[j][3] * v[j][3]);
    return 1.0f / sqrtf(wave_sum(s) * (1.0f / 1024.0f) + RMS_EPS); }
__device__ __forceinline__ void row_store_bf(bf16_t* row, int lane, const f32x4 (&v)[4]) {
#pragma unroll
    for (int j = 0; j < 4; ++j) { u32x2 w; w.x = cvt_pk_bf16(v[j][0], v[j][1]); w.y = cvt_pk_bf16(v[j][2], v[j][3]); *(u32x2*)(row + 256 * j + 4 * lane) = w; } }

__device__ __forceinline__ void ph_norm(const Ctx& C, const float* src, const float* gain, bf16_t* XN) {
    f32x4 g[4]; row_load(gain, C.lane, g);
    for (int t = C.gw; t < T; t += C.ngw) { f32x4 v[4]; row_load(src + (size_t)t * D, C.lane, v); const float r = row_rstd(v);
#pragma unroll
        for (int j = 0; j < 4; ++j) v[j] = v[j] * r * g[j];
        row_store_bf(XN + (size_t)t * D, C.lane, v); }
}
__device__ __forceinline__ void ph_router(const Ctx& C, const float* Hin, const float* gain, const float* Wr, bf16_t* XN, float* AFF, float* AFFT, unsigned char* XN8) {
    f32x4* Wl = (f32x4*)C.lds;
    for (int idx = C.tid; idx < 4096; idx += 512) { const int l = idx & 63, e4 = (idx >> 6) & 3, i = (idx >> 8) & 3, j = idx >> 10; Wl[idx] = *(const f32x4*)(Wr + (size_t)(256 * j + 4 * l + i) * 16 + 4 * e4); }
    __syncthreads();
    f32x4 g[4]; row_load(gain, C.lane, g);
    for (int t = C.gw; t < T; t += C.ngw) {
        f32x4 v[4]; row_load(Hin + (size_t)t * D, C.lane, v); const float r = row_rstd(v);
#pragma unroll
        for (int j = 0; j < 4; ++j) v[j] = v[j] * r * g[j];
#if MOE_FP8
#pragma unroll
        for (int j = 0; j < 4; ++j) *(unsigned*)(XN8 + (size_t)t * D + 256 * j + 4 * C.lane) = pk4fp8(v[j][0], v[j][1], v[j][2], v[j][3]);
#ifdef DBG
        row_store_bf(XN + (size_t)t * D, C.lane, v);
#endif
#else
        row_store_bf(XN + (size_t)t * D, C.lane, v);
#endif
        float p[16];
#pragma unroll
        for (int e = 0; e < 16; ++e) p[e] = 0.f;
#pragma unroll
        for (int j = 0; j < 4; ++j)
#pragma unroll
            for (int i = 0; i < 4; ++i) { const float x = v[j][i];
#pragma unroll
                for (int e4 = 0; e4 < 4; ++e4) { const f32x4 w = Wl[((j * 4 + i) * 4 + e4) * 64 + C.lane]; p[4 * e4] += x * w[0]; p[4 * e4 + 1] += x * w[1]; p[4 * e4 + 2] += x * w[2]; p[4 * e4 + 3] += x * w[3]; }  asm volatile("" ::: "memory"); }
        float mx = -1e30f;
#pragma unroll
        for (int e = 0; e < 16; ++e) { p[e] = wave_sum(p[e]); mx = fmaxf(mx, p[e]); }
        float s = 0.f;
#pragma unroll
        for (int e = 0; e < 16; ++e) { p[e] = expf(p[e] - mx); s += p[e]; }
        const float inv = 1.0f / s; float mine = 0.f;
#pragma unroll
        for (int e = 0; e < 16; ++e) mine = (C.lane == e) ? p[e] * inv : mine;
        if (C.lane < 16) { AFF[(size_t)t * 16 + C.lane] = mine; AFFT[(size_t)C.lane * T + t] = mine; }
    }
    __syncthreads();
}
__device__ __forceinline__ void ph_select(const Ctx& C, const float* AFFT, int* SEL, int* IDX) {
    if (C.bid >= NE) return;
    const int e = C.bid; unsigned* vals = (unsigned*)C.lds; unsigned* hist = vals + T; unsigned* sh = hist + 256;
    for (int i = C.tid; i < T; i += 512) vals[i] = __float_as_uint(AFFT[(size_t)e * T + i]);
    __syncthreads();
    unsigned prefix = 0u, mask = 0u, remaining = CAP;
    for (int pass = 0; pass < 4; ++pass) { const int shift = 24 - 8 * pass;
        if (C.tid < 256) hist[C.tid] = 0u;
        __syncthreads();
        for (int i = C.tid; i < T; i += 512) { const unsigned v = vals[i]; if ((v & mask) == prefix) atomicAdd(&hist[(v >> shift) & 255u], 1u); }
        __syncthreads();
        if (C.wave == 0) {
            unsigned cb[4]; unsigned tl = 0u;
#pragma unroll
            for (int j = 0; j < 4; ++j) { cb[j] = hist[255 - (4 * C.lane + j)]; tl += cb[j]; }
            unsigned incl = tl;
#pragma unroll
            for (int o = 1; o < 64; o <<= 1) { const unsigned tt = __shfl_up(incl, o); if (C.lane >= o) incl += tt; }
            unsigned cum = incl - tl;
            if (cum < remaining && remaining <= incl) {
#pragma unroll
                for (int j = 0; j < 4; ++j) { if (cum < remaining && cum + cb[j] >= remaining) { sh[0] = (unsigned)(255 - (4 * C.lane + j)); sh[1] = remaining - cum; } cum += cb[j]; } } }
        __syncthreads();
        prefix |= sh[0] << shift; mask |= 255u << shift; remaining = sh[1];
        __syncthreads();
    }
    const unsigned thr = prefix, ntie = remaining;
    unsigned cg = 0u, ce = 0u;
    for (int i = 0; i < 32; ++i) { const unsigned v = vals[C.tid + 512 * i]; cg += v > thr; ce += v == thr; }
    unsigned sg = cg, se = ce;
#pragma unroll
    for (int o = 1; o < 64; o <<= 1) { const unsigned tg = __shfl_up(sg, o), te = __shfl_up(se, o); if (C.lane >= o) { sg += tg; se += te; } }
    if (C.lane == 63) { sh[16 + C.wave] = sg; sh[32 + C.wave] = se; }
    __syncthreads();
    unsigned og = 0u, oe = 0u, totg = 0u;
    for (int w = 0; w < 8; ++w) { const unsigned a = sh[16 + w], b = sh[32 + w]; if (w < C.wave) { og += a; oe += b; } totg += a; }
    unsigned pg = og + sg - cg, pe = oe + se - ce;
    for (int i = 0; i < 32; ++i) { const int t = C.tid + 512 * i; const unsigned v = vals[t]; int slot = -1;
        if (v > thr) slot = (int)pg++; else if (v == thr) { if (pe < ntie) slot = (int)(totg + pe); ++pe; }
        SEL[(size_t)t * 16 + e] = slot + 1; if (slot >= 0) IDX[e * CAP + slot] = t; }
}
__device__ __forceinline__ void ph_gather(const Ctx& C, const int* IDX, const bf16_t* XN, bf16_t* XS, const unsigned char* XN8) {
    for (int r = C.gw; r < NE * CAP; r += C.ngw) { const int t = IDX[r];
        if (MOE_FP8) { ((u32x4*)((unsigned char*)XS + (size_t)r * D))[C.lane] = ((const u32x4*)(XN8 + (size_t)t * D))[C.lane]; }
        else { const u32x4* s = (const u32x4*)(XN + (size_t)t * D); u32x4* d = (u32x4*)(XS + (size_t)r * D); const u32x4 a = s[C.lane], b = s[C.lane + 64]; d[C.lane] = a; d[C.lane + 64] = b; } }
}
template <int MODE>
__device__ __forceinline__ void ph_combine(const Ctx& C, const float* Hin, const float* AFF, const int* SEL, const bf16_t* Y, float* Hout, const float* gain, bf16_t* XN, float* OUT) {
    f32x4 g[4]; row_load(gain, C.lane, g);
    for (int t = C.gw; t < T; t += C.ngw) {
        f32x4 v[4]; row_load(Hin + (size_t)t * D, C.lane, v);
        const int sel = SEL[(size_t)t * 16 + (C.lane & 15)]; const float af = AFF[(size_t)t * 16 + (C.lane & 15)];
#pragma unroll
        for (int e = 0; e < 16; ++e) { const int s = __builtin_amdgcn_readlane(sel, e);
            if (s) { const float a = __uint_as_float(__builtin_amdgcn_readlane(__float_as_uint(af), e)); const bf16_t* y = Y + ((size_t)e * CAP + (s - 1)) * D + 4 * C.lane;
#pragma unroll
                for (int j = 0; j < 4; ++j) { const u32x2 w = *(const u32x2*)(y + 256 * j); v[j][0] += a * bf_lo(w.x); v[j][1] += a * bf_hi(w.x); v[j][2] += a * bf_lo(w.y); v[j][3] += a * bf_hi(w.y); } } }
        if (MODE == 1) {
#pragma unroll
            for (int j = 0; j < 4; ++j) *(f32x4*)(Hout + (size_t)t * D + 256 * j + 4 * C.lane) = v[j]; }
        const float r = row_rstd(v);
#pragma unroll
        for (int j = 0; j < 4; ++j) v[j] = v[j] * r * g[j];
        if (MODE == 1) row_store_bf(XN + (size_t)t * D, C.lane, v);
        else {
#pragma unroll
            for (int j = 0; j < 4; ++j) *(f32x4*)(OUT + (size_t)t * D + 256 * j + 4 * C.lane) = v[j]; }
    }
}

#define MFMA32(a, b, c) __builtin_amdgcn_mfma_f32_32x32x16_bf16((a), (b), (c), 0, 0, 0)
__device__ __forceinline__ int crow(int r, int hi) { return (r & 3) + 8 * (r >> 2) + 4 * hi; }
__device__ __forceinline__ bf16x8 ldfrag(const bf16_t* p) { return *(const bf16x8*)p; }

__device__ __forceinline__ void ph_gla_prep(const Ctx& C, const bf16_t* Q0, const bf16_t* K0, const float* GF, const float* GB,
                                            bf16_t* QDF, bf16_t* QDB, bf16_t* KDF, bf16_t* KDB, bf16_t* KTF, bf16_t* KTB, float* EGL) {
    float* tot = (float*)C.lds;
    const int o = C.wave, l = C.lane; int par = 0;
    for (int c = C.bid; c < GNC; c += C.nb) { const int t0 = c * GC + 8 * o;
        for (int cb = 0; cb < 8; ++cb, par ^= 1) { const int ch = cb * 64 + l; const size_t off0 = (size_t)t0 * 512 + ch;
            float gf[8], gb[8], q[8], k[8];
#pragma unroll
            for (int i = 0; i < 8; ++i) { const size_t of = off0 + (size_t)i * 512; gf[i] = GF[of]; gb[i] = GB[of]; q[i] = bf2f(Q0[of]); k[i] = bf2f(K0[of]); }
            float sf = 0.f, sb = 0.f;
#pragma unroll
            for (int i = 0; i < 8; ++i) { sf += gf[i]; gf[i] = sf; }
#pragma unroll
            for (int i = 7; i >= 0; --i) { sb += gb[i]; gb[i] = sb; }
            float* tp = tot + par * 1024; tp[o * 64 + l] = sf; tp[512 + o * 64 + l] = sb;
            __syncthreads();
            float offf = 0.f, offb = 0.f, allf = 0.f, allb = 0.f;
#pragma unroll
            for (int oo = 0; oo < 8; ++oo) { const float a = tp[oo * 64 + l], b = tp[512 + oo * 64 + l]; offf += (oo < o) ? a : 0.f; offb += (oo > o) ? b : 0.f; allf += a; allb += b; }
            unsigned pf[4], pb[4];
#pragma unroll
            for (int i = 0; i < 8; i += 2) { float kdf[2], kdb[2];
#pragma unroll
                for (int u = 0; u < 2; ++u) { const size_t of = off0 + (size_t)(i + u) * 512; const float ef = __expf(offf + gf[i + u]), eb = __expf(offb + gb[i + u]);
                    kdf[u] = k[i + u] * __builtin_amdgcn_rcpf(ef); kdb[u] = k[i + u] * __builtin_amdgcn_rcpf(eb);
                    QDF[of] = f2bf(q[i + u] * ef); QDB[of] = f2bf(q[i + u] * eb); KDF[of] = f2bf(kdf[u]); KDB[of] = f2bf(kdb[u]); }
                pf[i >> 1] = cvt_pk_bf16(kdf[0], kdf[1]); pb[i >> 1] = cvt_pk_bf16(kdb[0], kdb[1]); }
            *(u32x4*)(KTF + (size_t)ch * T + t0) = (u32x4){pf[0], pf[1], pf[2], pf[3]};
            *(u32x4*)(KTB + (size_t)ch * T + t0) = (u32x4){pb[0], pb[1], pb[2], pb[3]};
            if (o == 0) { EGL[(size_t)c * 512 + ch] = __expf(allf); EGL[(size_t)(GNC + c) * 512 + ch] = __expf(allb); }
        }
    }
    __syncthreads();
}
__device__ __forceinline__ void ph_gla_u(const Ctx& C, const bf16_t* VT, const bf16_t* KTF, const bf16_t* KTB, const float* EGL, bf16_t* U) {
    const int r = C.lane & 31, hh = C.lane >> 5;
    for (int it = C.gw; it < 2 * GH * GNC * 8; it += C.ngw) { const int w = it & 7, unit = it >> 3, c = unit % GNC, h = (unit / GNC) % GH, dir = unit / (GNC * GH); const int t0 = c * GC;
        const bf16_t* KT = dir ? KTB : KTF; const bf16_t* ap = VT + (size_t)(256 * h + 32 * w + r) * T + t0 + 8 * hh;
        bf16x8 a[4];
#pragma unroll
        for (int s = 0; s < 4; ++s) a[s] = ldfrag(ap + 16 * s);
        bf16_t* Ub = U + ((size_t)(dir * GH + h) * GNC + c) * (GDV * GDK);
#pragma unroll
        for (int j = 0; j < 4; ++j) { f32x16 acc = {}; const bf16_t* bp = KT + (size_t)(128 * h + 32 * j + r) * T + t0 + 8 * hh;
#pragma unroll
            for (int s = 0; s < 4; ++s) acc = MFMA32(a[s], ldfrag(bp + 16 * s), acc);
            const float eg = EGL[(size_t)(dir * GNC + c) * 512 + 128 * h + 32 * j + r];
#pragma unroll
            for (int q = 0; q < 16; ++q) Ub[(size_t)(32 * w + crow(q, hh)) * GDK + 32 * j + r] = f2bf(acc[q] * eg); }
    }
}
__device__ __forceinline__ void ph_gla_scan(const Ctx& C, const bf16_t* U, const float* EGL, bf16_t* ST) {
    if (C.tid >= 256) return;
    for (int el = C.bid * 256 + C.tid; el < 2 * GH * GDV * (GDK / 4); el += C.nb * 256) { const int dk4 = el & 31, dv = (el >> 5) & 255, h = (el >> 13) & 3, dir = el >> 15;
        const size_t eb = (size_t)(dir * GH + h) * GNC * (GDV * GDK) + (size_t)dv * GDK + 4 * dk4; const float* eg = EGL + (size_t)dir * GNC * 512 + 128 * h + 4 * dk4;
        float s0 = 0.f, s1 = 0.f, s2 = 0.f, s3 = 0.f;
#pragma unroll 16
        for (int i = 0; i < GNC; ++i) { const int c = dir ? GNC - 1 - i : i; const size_t o = eb + (size_t)c * (GDV * GDK);
            const u32x2 u = *(const u32x2*)(U + o); const f32x4 d = *(const f32x4*)(eg + (size_t)c * 512);
            u32x2 w; w.x = cvt_pk_bf16(s0, s1); w.y = cvt_pk_bf16(s2, s3); *(u32x2*)(ST + o) = w;
            s0 = d[0] * s0 + bf_lo(u.x); s1 = d[1] * s1 + bf_hi(u.x); s2 = d[2] * s2 + bf_lo(u.y); s3 = d[3] * s3 + bf_hi(u.y); }
    }
}
__device__ __forceinline__ void ph_gla_out(const Ctx& C, const bf16_t* QDF, const bf16_t* QDB, const bf16_t* KDF, const bf16_t* KDB, const bf16_t* VT, const bf16_t* ST,
                                           const bf16_t* SR, const float* hnorm, bf16_t* OG) {
    constexpr int ACS = 72, TS = 272, TB = 64 * TS;
    unsigned char* TL = C.lds;
    bf16_t* AC = (bf16_t*)(C.lds + 4 * TB); float* SSQ = (float*)(C.lds + 4 * TB + 64 * ACS * 2);
    const int w = C.wave, r = C.lane & 31, hh = C.lane >> 5;
    for (int unit = C.bid; unit < GH * GNC; unit += C.nb) { const int h = unit / GNC, c = unit % GNC, t0 = c * GC;
        bf16x8 bs[2][8], bv[4];
#pragma unroll
        for (int dir = 0; dir < 2; ++dir) { const bf16_t* sp = ST + ((size_t)(dir * GH + h) * GNC + c) * (GDV * GDK) + (size_t)(32 * w + r) * GDK + 8 * hh;
#pragma unroll
            for (int s = 0; s < 8; ++s) bs[dir][s] = ldfrag(sp + 16 * s); }
        { const bf16_t* vp = VT + (size_t)(256 * h + 32 * w + r) * T + t0 + 8 * hh;
#pragma unroll
            for (int s = 0; s < 4; ++s) bv[s] = ldfrag(vp + 16 * s); }
        {
            u32x4 v[8];
#pragma unroll
            for (int q = 0; q < 8; ++q) { const int tile = q >> 1, ck = C.tid + 512 * (q & 1), row = ck >> 4, cc = ck & 15; const bf16_t* src = tile == 0 ? QDF : tile == 1 ? QDB : tile == 2 ? KDF : KDB;
                v[q] = *(const u32x4*)(src + (size_t)(t0 + row) * 512 + 128 * h + 8 * cc); }
#pragma unroll
            for (int q = 0; q < 8; ++q) { const int tile = q >> 1, ck = C.tid + 512 * (q & 1), row = ck >> 4, cc = ck & 15; *(u32x4*)(TL + tile * TB + row * TS + 16 * cc) = v[q]; }
        }
        __syncthreads();
        {
            const int dir = w >> 2, ti = (w >> 1) & 1, si = w & 1;
            if (!((dir == 0 && ti == 0 && si == 1) || (dir == 1 && ti == 1 && si == 0))) {
                const unsigned char* qp = TL + dir * TB + (32 * ti + r) * TS + 16 * hh; const unsigned char* kp = TL + (2 + dir) * TB + (32 * si + r) * TS + 16 * hh;
                f32x16 acc = {};
#pragma unroll
                for (int s = 0; s < 8; ++s) acc = MFMA32(*(const bf16x8*)(qp + 32 * s), *(const bf16x8*)(kp + 32 * s), acc);
#pragma unroll
                for (int q = 0; q < 16; ++q) { const int tl = 32 * ti + crow(q, hh), sl = 32 * si + r; const bool keep = dir ? (sl > tl) : (sl <= tl); if (keep) AC[tl * ACS + sl] = f2bf(acc[q]); }
            }
        }
        __syncthreads();
        f32x16 o0 = {}, o1 = {};
#pragma unroll
        for (int dir = 0; dir < 2; ++dir) { const unsigned char* qp = TL + dir * TB + r * TS + 16 * hh;
#pragma unroll
            for (int s = 0; s < 8; ++s) { o0 = MFMA32(*(const bf16x8*)(qp + 32 * s), bs[dir][s], o0); o1 = MFMA32(*(const bf16x8*)(qp + 32 * TS + 32 * s), bs[dir][s], o1); } }
#pragma unroll
        for (int s = 0; s < 4; ++s) { o0 = MFMA32(ldfrag(AC + r * ACS + 16 * s + 8 * hh), bv[s], o0); o1 = MFMA32(ldfrag(AC + (32 + r) * ACS + 16 * s + 8 * hh), bv[s], o1); }
#pragma unroll
        for (int q = 0; q < 16; ++q) { float a = o0[q] * o0[q], b = o1[q] * o1[q];
#pragma unroll
            for (int of = 1; of < 32; of <<= 1) { a += __shfl_xor(a, of); b += __shfl_xor(b, of); }
            if (r == 0) { SSQ[w * 64 + crow(q, hh)] = a; SSQ[w * 64 + 32 + crow(q, hh)] = b; } }
        __syncthreads();
        const float gn = hnorm[32 * w + r];
#pragma unroll
        for (int q = 0; q < 16; ++q) { const int tl = crow(q, hh); float sa = 0.f, sb = 0.f;
#pragma unroll
            for (int ww = 0; ww < 8; ++ww) { sa += SSQ[ww * 64 + tl]; sb += SSQ[ww * 64 + 32 + tl]; }
            const float ra = 1.0f / sqrtf(sa * (1.0f / 256.0f) + RMS_EPS), rb = 1.0f / sqrtf(sb * (1.0f / 256.0f) + RMS_EPS);
            const size_t oa = (size_t)(t0 + tl) * 1024 + 256 * h + 32 * w + r, ob = oa + 32 * 1024;
            OG[oa] = f2bf(o0[q] * ra * gn * bf2f(SR[oa])); OG[ob] = f2bf(o1[q] * rb * gn * bf2f(SR[ob])); }
        __syncthreads();
    }
}

__device__ __forceinline__ void ph_mla_tok(const Ctx& C, const float* CIN, const int* pos, const float* qn, const float* kvn, const float* invf, bf16_t* CQN, bf16_t* CKVN, float* CS, bf16_t* K) {
    const int l = C.lane;
    f32x4 g0, g1;
    if (l < 32) { g0 = *(const f32x4*)(qn + 8 * l); g1 = *(const f32x4*)(qn + 8 * l + 4); }
    else if (l < 48) { g0 = *(const f32x4*)(kvn + 8 * (l - 32)); g1 = *(const f32x4*)(kvn + 8 * (l - 32) + 4); }
    else { g0 = (f32x4){1.f, 1.f, 1.f, 1.f}; g1 = g0; }
    const float fr = invf[l & 31];
    for (int t = C.gw; t < T; t += C.ngw) {
        const float* row = CIN + (size_t)t * 512; const f32x4 a = *(const f32x4*)(row + 8 * l), b = *(const f32x4*)(row + 8 * l + 4);
        const float ss = (a[0] * a[0] + a[1] * a[1]) + (a[2] * a[2] + a[3] * a[3]) + (b[0] * b[0] + b[1] * b[1]) + (b[2] * b[2] + b[3] * b[3]);
        const float sq = wave_sum(l < 32 ? ss : 0.f), sk = wave_sum((l >= 32 && l < 48) ? ss : 0.f);
        const float rq = 1.0f / sqrtf(sq * (1.0f / 256.0f) + RMS_EPS), rk = 1.0f / sqrtf(sk * (1.0f / 128.0f) + RMS_EPS);
        const float ang = (float)pos[t] * fr; const double rev = (double)ang * 0.15915494309189533577; const float fr01 = (float)(rev - rint(rev));
        const float cv = __builtin_amdgcn_cosf(fr01), sv = __builtin_amdgcn_sinf(fr01);
        if (l < 32) { CS[(size_t)t * 64 + l] = cv; CS[(size_t)t * 64 + 32 + l] = sv; }
        if (l < 32) store8bf(CQN + (size_t)t * 256 + 8 * l, a * rq * g0, b * rq * g1);
        else if (l < 48) store8bf(CKVN + (size_t)t * 256 + 8 * (l - 32), a * rk * g0, b * rk * g1);
        else { const u32x4 z = {0u, 0u, 0u, 0u}; *(u32x4*)(CKVN + (size_t)t * 256 + 128 + 8 * (l - 48)) = z; }
        f32x4 xa = a, xb = b;
        f32x4 pa, pb;
#pragma unroll
        for (int j = 0; j < 4; ++j) { pa[j] = __shfl(xa[j], (l + 4) & 63); pb[j] = __shfl(xb[j], (l + 4) & 63); }
        f32x4 c0, c1, s0, s1;
#pragma unroll
        for (int j = 0; j < 4; ++j) { const int i = 8 * (l & 3) + j; c0[j] = __shfl(cv, i); c1[j] = __shfl(cv, i + 4); s0[j] = __shfl(sv, i); s1[j] = __shfl(sv, i + 4); }
        if (l >= 48 && l < 52) {
            const f32x4 o1a = xa * c0 - pa * s0, o2a = xa * s0 + pa * c0, o1b = xb * c1 - pb * s1, o2b = xb * s1 + pb * c1;
            u32x4 w0, w1; w0.x = cvt_pk_bf16(o1a[0], o1a[1]); w0.y = cvt_pk_bf16(o1a[2], o1a[3]); w0.z = cvt_pk_bf16(o2a[0], o2a[1]); w0.w = cvt_pk_bf16(o2a[2], o2a[3]);
            w1.x = cvt_pk_bf16(o1b[0], o1b[1]); w1.y = cvt_pk_bf16(o1b[2], o1b[3]); w1.z = cvt_pk_bf16(o2b[0], o2b[1]); w1.w = cvt_pk_bf16(o2b[2], o2b[3]);
            if (ATT_FP8) { u32x4 w8; w8.x = pk4fp8(o1a[0], o1a[1], o1a[2], o1a[3]); w8.y = pk4fp8(o2a[0], o2a[1], o2a[2], o2a[3]); w8.z = pk4fp8(o1b[0], o1b[1], o1b[2], o1b[3]); w8.w = pk4fp8(o2b[0], o2b[1], o2b[2], o2b[3]);
#pragma unroll
                for (int h = 0; h < MH; ++h) *(u32x4*)((unsigned char*)K + ((size_t)h * T + t) * MDK + 128 + 16 * (l & 3)) = w8; }
            else {
#pragma unroll
            for (int h = 0; h < MH; ++h) { bf16_t* kp = K + ((size_t)h * T + t) * MDK + 128 + 16 * (l & 3); *(u32x4*)kp = w0; *(u32x4*)(kp + 8) = w1; } }
        }
    }
}

namespace att {
constexpr int NW = 8, QBLK = 32, KVBLK = 64;
#ifndef ATT_PVSPLIT
#define ATT_PVSPLIT 0
#endif
#ifndef ATT_SDEPTH
#define ATT_SDEPTH 1
#endif
constexpr int SDEPTH = ATT_SDEPTH;
constexpr float THR2 = 11.5f;
constexpr int SHM_V = KVBLK * MDV * 2, SHM_K = KVBLK * 400, SHM_ATTN = 2 * SHM_V + 2 * SHM_K + NW * 64 * 4;
#define KSWZ(row, colB) ((row) * 400 + (colB))
#define SBAR() __builtin_amdgcn_sched_barrier(0)
__device__ __forceinline__ unsigned cvtpk(float lo, float hi) { unsigned r; asm volatile("v_cvt_pk_bf16_f32 %0, %1, %2" : "=v"(r) : "v"(lo), "v"(hi)); return r; }
__device__ __forceinline__ void partialSM(f32x16& p0, f32x16& p1, float& m_reg, float& mn, float& alpha) {
  float pmax = p0[0];
#pragma unroll
  for (int r = 1; r < 16; ++r) pmax = fmaxf(pmax, p0[r]);
#pragma unroll
  for (int r = 0; r < 16; ++r) pmax = fmaxf(pmax, p1[r]);
  { auto rr = __builtin_amdgcn_permlane32_swap(__float_as_uint(pmax), __float_as_uint(pmax), false, false);
    pmax = fmaxf(__uint_as_float(rr[0]), __uint_as_float(rr[1])); }
  if (__builtin_expect(__all(pmax - m_reg <= THR2), 1)) { mn = m_reg; alpha = 1.f; }
  else { mn = fmaxf(m_reg, pmax); alpha = __builtin_amdgcn_exp2f(m_reg - mn); m_reg = mn; }
#pragma unroll
  for (int r = 0; r < 16; ++r) p0[r] = p0[r] - mn;
#pragma unroll
  for (int r = 0; r < 16; ++r) p1[r] = p1[r] - mn;
#pragma unroll
  for (int r = 0; r < 16; ++r) p0[r] = __builtin_amdgcn_exp2f(p0[r]);
}
__device__ __forceinline__ void finishSM(f32x16& p0, f32x16& p1, float alpha, float& l_reg, bf16x8& pa0, bf16x8& pa1, bf16x8& pa2, bf16x8& pa3) {
#pragma unroll
  for (int r = 0; r < 16; ++r) p1[r] = __builtin_amdgcn_exp2f(p1[r]);
  float ps = 0;
#pragma unroll
  for (int r = 0; r < 16; ++r) ps += p0[r];
#pragma unroll
  for (int r = 0; r < 16; ++r) ps += p1[r];
  { auto rr = __builtin_amdgcn_permlane32_swap(__float_as_uint(ps), __float_as_uint(ps), false, false);
    ps = __uint_as_float(rr[0]) + __uint_as_float(rr[1]); }
  l_reg = l_reg * alpha + ps;
#define PK4(P, BASE, OUT) do { unsigned a0 = cvtpk(P[BASE + 0], P[BASE + 1]), a1 = cvtpk(P[BASE + 2], P[BASE + 3]);   \
    unsigned b0 = cvtpk(P[BASE + 4], P[BASE + 5]), b1 = cvtpk(P[BASE + 6], P[BASE + 7]);                              \
    auto r0 = __builtin_amdgcn_permlane32_swap(a0, b0, false, false); auto r1 = __builtin_amdgcn_permlane32_swap(a1, b1, false, false); \
    u32x4 w = {r0[0], r1[0], r0[1], r1[1]}; OUT = *reinterpret_cast<bf16x8*>(&w); } while (0)
  PK4(p0, 0, pa0); PK4(p0, 8, pa1); PK4(p1, 0, pa2); PK4(p1, 8, pa3);
#undef PK4
}
__device__ __forceinline__ void qkt(f32x16& p0, f32x16& p1, const char* Ks, const bf16x8* qr, int r32, int hi) {
  p0 = f32x16{}; p1 = f32x16{};
#pragma unroll
  for (int d0 = 0; d0 < 12; ++d0) { const int cb = (d0 * 16 + hi * 8) * 2;
    const bf16x8 b0 = *reinterpret_cast<const bf16x8*>(Ks + KSWZ(r32, cb));
    const bf16x8 b1 = *reinterpret_cast<const bf16x8*>(Ks + KSWZ(32 + r32, cb));
    p0 = __builtin_amdgcn_mfma_f32_32x32x16_bf16(b0, qr[d0], p0, 0, 0, 0);
    p1 = __builtin_amdgcn_mfma_f32_32x32x16_bf16(b1, qr[d0], p1, 0, 0, 0); }
}
__device__ __forceinline__ int v_st(int k, int c) { const int kk = (k & ~0xC) | ((k & 4) << 1) | ((k & 8) >> 1); return ((kk >> 3) * 4 + (c >> 5)) * 512 + ((kk & 7) * 32 + (c & 31)) * 2; }
__device__ __forceinline__ int v_rd_base(int lane) { return ((lane & 3) << 3) | (((lane >> 2) & 3) << 6) | (((lane >> 4) & 1) << 5) | (((lane >> 5) & 1) << 8); }
constexpr int v_rd_off(int d0, int ks, int half) { return d0 * 512 + ks * 4096 + half * 2048; }
template <int OFF> __device__ __forceinline__ s16x4 tr_read(int vb) {
  s16x4 r; asm volatile("ds_read_b64_tr_b16 %0, %1 offset:%2" : "=&v"(r) : "v"(vb), "i"(OFF) : "memory"); return r;
}
template <int D0> __device__ __forceinline__ void pv_one(f32x16& od, int vb, bf16x8 pa0, bf16x8 pa1, bf16x8 pa2, bf16x8 pa3) {
#if ATT_PVSPLIT
#define PK(L, H) (bf16x8){L[0], L[1], L[2], L[3], H[0], H[1], H[2], H[3]}
  { const s16x4 l0 = tr_read<v_rd_off(D0, 0, 0)>(vb), h0 = tr_read<v_rd_off(D0, 0, 1)>(vb), l1 = tr_read<v_rd_off(D0, 1, 0)>(vb), h1 = tr_read<v_rd_off(D0, 1, 1)>(vb);
    asm volatile("s_waitcnt lgkmcnt(0)" ::: "memory"); SBAR();
    od = __builtin_amdgcn_mfma_f32_32x32x16_bf16(pa0, PK(l0, h0), od, 0, 0, 0);
    od = __builtin_amdgcn_mfma_f32_32x32x16_bf16(pa1, PK(l1, h1), od, 0, 0, 0); }
  { const s16x4 l2 = tr_read<v_rd_off(D0, 2, 0)>(vb), h2 = tr_read<v_rd_off(D0, 2, 1)>(vb), l3 = tr_read<v_rd_off(D0, 3, 0)>(vb), h3 = tr_read<v_rd_off(D0, 3, 1)>(vb);
    asm volatile("s_waitcnt lgkmcnt(0)" ::: "memory"); SBAR();
    od = __builtin_amdgcn_mfma_f32_32x32x16_bf16(pa2, PK(l2, h2), od, 0, 0, 0);
    od = __builtin_amdgcn_mfma_f32_32x32x16_bf16(pa3, PK(l3, h3), od, 0, 0, 0); }
#undef PK
#else
  const s16x4 l0 = tr_read<v_rd_off(D0, 0, 0)>(vb), h0 = tr_read<v_rd_off(D0, 0, 1)>(vb), l1 = tr_read<v_rd_off(D0, 1, 0)>(vb), h1 = tr_read<v_rd_off(D0, 1, 1)>(vb);
  const s16x4 l2 = tr_read<v_rd_off(D0, 2, 0)>(vb), h2 = tr_read<v_rd_off(D0, 2, 1)>(vb), l3 = tr_read<v_rd_off(D0, 3, 0)>(vb), h3 = tr_read<v_rd_off(D0, 3, 1)>(vb);
  asm volatile("s_waitcnt lgkmcnt(0)" ::: "memory"); SBAR();
#define PK(L, H) (bf16x8){L[0], L[1], L[2], L[3], H[0], H[1], H[2], H[3]}
  od = __builtin_amdgcn_mfma_f32_32x32x16_bf16(pa0, PK(l0, h0), od, 0, 0, 0);
  od = __builtin_amdgcn_mfma_f32_32x32x16_bf16(pa1, PK(l1, h1), od, 0, 0, 0);
  od = __builtin_amdgcn_mfma_f32_32x32x16_bf16(pa2, PK(l2, h2), od, 0, 0, 0);
  od = __builtin_amdgcn_mfma_f32_32x32x16_bf16(pa3, PK(l3, h3), od, 0, 0, 0);
#undef PK
#endif
}
__device__ __forceinline__ void pv_d0(f32x16* o, int vb, bf16x8 pa0, bf16x8 pa1, bf16x8 pa2, bf16x8 pa3) {
  pv_one<0>(o[0], vb, pa0, pa1, pa2, pa3); pv_one<1>(o[1], vb, pa0, pa1, pa2, pa3); pv_one<2>(o[2], vb, pa0, pa1, pa2, pa3); pv_one<3>(o[3], vb, pa0, pa1, pa2, pa3);
}
__device__ __forceinline__ void attn_body(const bf16_t* __restrict__ Qb, const bf16_t* __restrict__ Kh, const bf16_t* __restrict__ Vh, bf16_t* __restrict__ Ob, int ldo, int seq, char* lds) {
  const int tid = threadIdx.x, wid = tid >> 6, lane = tid & 63, r32 = lane & 31, hi = lane >> 5;
  char* V_lds = lds; char* K_lds = lds + 2 * SHM_V;
  float* ws = (float*)(lds + 2 * SHM_V + 2 * SHM_K) + wid * 64; float* li_l = ws; float* al_l = ws + 32;
  float m_reg = -1e30f, l_reg = 0; f32x16 o[4] = {}; bf16x8 qr[12];
  const bf16_t* Qw = Qb + (size_t)(wid * QBLK + r32) * MDK + hi * 8;
#pragma unroll
  for (int d0 = 0; d0 < 12; ++d0) qr[d0] = *reinterpret_cast<const bf16x8*>(Qw + d0 * 16);
  const int sr = tid >> 4, sc = (tid & 15) * 8, vst0 = v_st(sr, sc), vst1 = v_st(32 + sr, sc);
  int kst[3];
#pragma unroll
  for (int i = 0; i < 3; ++i) { const int ck = tid + 512 * i, row = ck / 24, cc = ck - row * 24; kst[i] = KSWZ(row, cc * 16); }
  const int vb0 = (int)(uintptr_t)V_lds + v_rd_base(lane);
  const unsigned vo0 = (unsigned)(sr * MDV + sc), ko0 = (unsigned)(tid * 8);
  struct { bf16x8 vs0, vs1, ks0, ks1, ks2; } sr_[SDEPTH];
#define SLOAD(i, k0) do { const bf16_t* vt_ = Vh + (size_t)(k0) * MDV; const bf16_t* kt_ = Kh + (size_t)(k0) * MDK;                                         \
    sr_[i].vs0 = *reinterpret_cast<const bf16x8*>(vt_ + vo0); sr_[i].vs1 = *reinterpret_cast<const bf16x8*>(vt_ + 32 * MDV + vo0);                               \
    sr_[i].ks0 = *reinterpret_cast<const bf16x8*>(kt_ + ko0); sr_[i].ks1 = *reinterpret_cast<const bf16x8*>(kt_ + 4096 + ko0); sr_[i].ks2 = *reinterpret_cast<const bf16x8*>(kt_ + 8192 + ko0); } while (0)
#define SWRITE(b, i) do { *(bf16x8*)(V_lds + (b) * SHM_V + vst0) = sr_[i].vs0; *(bf16x8*)(V_lds + (b) * SHM_V + vst1) = sr_[i].vs1;               \
    *(bf16x8*)(K_lds + (b) * SHM_K + kst[0]) = sr_[i].ks0; *(bf16x8*)(K_lds + (b) * SHM_K + kst[1]) = sr_[i].ks1; *(bf16x8*)(K_lds + (b) * SHM_K + kst[2]) = sr_[i].ks2; } while (0)
#define SWAIT() do { if constexpr (SDEPTH == 2) asm volatile("s_waitcnt vmcnt(5)" ::: "memory"); else asm volatile("s_waitcnt vmcnt(0)" ::: "memory"); } while (0)
#define RESC(a) do { if (__any((a) < 1.f)) { if (hi == 0) al_l[r32] = (a); asm volatile("s_waitcnt lgkmcnt(0)" ::: "memory"); \
    _Pragma("unroll") for (int d = 0; d < 4; ++d) _Pragma("unroll") for (int r = 0; r < 16; ++r) o[d][r] *= al_l[crow(r, hi)]; } } while (0)
  f32x16 pA0, pA1, pB0, pB1; float mnA, mnB, alA, alB; bf16x8 pa0, pa1, pa2, pa3; const int NT = seq / KVBLK;
  constexpr int SE = 0, SO = SDEPTH - 1;
  SLOAD(SE, 0); asm volatile("s_waitcnt vmcnt(0)" ::: "memory"); SWRITE(0, SE); __syncthreads();
  qkt(pA0, pA1, K_lds, qr, r32, hi); partialSM(pA0, pA1, m_reg, mnA, alA);
  SLOAD(SO, KVBLK); if constexpr (SDEPTH == 2) { if (2 < NT) SLOAD(SE, 2 * KVBLK); }
  SWAIT(); SWRITE(1, SO); __syncthreads();
  for (int j = 1; j + 1 < NT; j += 2) {
    SBAR(); qkt(pB0, pB1, K_lds + SHM_K, qr, r32, hi);
    finishSM(pA0, pA1, alA, l_reg, pa0, pa1, pa2, pa3); SBAR();
    SLOAD(SO, (j + SDEPTH) * KVBLK); SBAR();
    pv_d0(o, vb0, pa0, pa1, pa2, pa3); partialSM(pB0, pB1, m_reg, mnB, alB);
    __syncthreads(); SWAIT(); SWRITE(0, SE);
    RESC(alB); __syncthreads();
    SBAR(); qkt(pA0, pA1, K_lds, qr, r32, hi);
    finishSM(pB0, pB1, alB, l_reg, pa0, pa1, pa2, pa3); SBAR();
    if (SDEPTH == 1 || j + 3 < NT) SLOAD(SE, (j + 1 + SDEPTH) * KVBLK); SBAR();
    pv_d0(o, vb0 + SHM_V, pa0, pa1, pa2, pa3); partialSM(pA0, pA1, m_reg, mnA, alA);
    __syncthreads(); SWAIT(); SWRITE(1, SO);
    RESC(alA); __syncthreads();
  }
  SBAR(); qkt(pB0, pB1, K_lds + SHM_K, qr, r32, hi);
  finishSM(pA0, pA1, alA, l_reg, pa0, pa1, pa2, pa3); SBAR();
  pv_d0(o, vb0, pa0, pa1, pa2, pa3); partialSM(pB0, pB1, m_reg, mnB, alB);
  __syncthreads(); RESC(alB);
  finishSM(pB0, pB1, alB, l_reg, pa0, pa1, pa2, pa3); SBAR();
  pv_d0(o, vb0 + SHM_V, pa0, pa1, pa2, pa3);
  if (hi == 0) li_l[r32] = l_reg; asm volatile("s_waitcnt lgkmcnt(0)" ::: "memory");
  float rli[16];
#pragma unroll
  for (int r = 0; r < 16; ++r) rli[r] = __builtin_amdgcn_rcpf(li_l[crow(r, hi)]);
  bf16_t* Ow = Ob + (size_t)(wid * QBLK) * ldo;
#pragma unroll
  for (int r = 0; r < 16; ++r) { const int orow = crow(r, hi);
#pragma unroll
    for (int d0 = 0; d0 < 4; ++d0) Ow[(size_t)orow * ldo + d0 * 32 + r32] = f2bf(o[d0][r] * rli[r]); }
#undef SLOAD
#undef SWRITE
#undef SWAIT
#undef RESC
}
}


namespace att8 {
constexpr int NW = 8, QBLK = 32, KVBLK = 64, KST = 208, VST = 80;
#ifndef ATT8_SDEPTH
#define ATT8_SDEPTH 1
#endif
constexpr int SDEPTH = ATT8_SDEPTH;
constexpr float THR8 = 8.f;
#ifndef ATT8_RING3
#define ATT8_RING3 0
#endif
constexpr int NBUF = ATT8_RING3 ? 3 : 2;
constexpr int SHM_K = KVBLK * KST, SHM_V = MDV * VST, SHM_ATTN = NBUF * SHM_K + NBUF * SHM_V + NW * 64 * 4;
#define SBAR() __builtin_amdgcn_sched_barrier(0)
#define SGB(mask, n) __builtin_amdgcn_sched_group_barrier((mask), (n), 0)
#ifndef ATT8_ILV
#define ATT8_ILV 1
#endif
#define PIN2(a, b) asm volatile("" : "+v"(a), "+v"(b))
#define PIN4(o) asm volatile("" : "+v"(o[0]), "+v"(o[1]), "+v"(o[2]), "+v"(o[3]))
#define ILV_QK() do { if (ATT8_ILV) { SGB(0x100, 4); _Pragma("unroll") for (int i_ = 0; i_ < 6; ++i_) { SGB(0x008, 1); SGB(0x002, 14); if (i_ < 4) SGB(0x100, 2); } } } while (0)
#define ILV_PV() do { if (ATT8_ILV) { SGB(0x100, 4); _Pragma("unroll") for (int i_ = 0; i_ < 4; ++i_) { SGB(0x008, 1); SGB(0x002, 22); if (i_ < 2) SGB(0x100, 2); } } } while (0)
#define MFMA8(a, b, c) __builtin_amdgcn_mfma_scale_f32_32x32x64_f8f6f4((a), (b), (c), 0, 0, 0, 0x7f7f7f7f, 0, 0x7f7f7f7f)
#define MFMA8Q(a, b, c) __builtin_amdgcn_mfma_scale_f32_32x32x64_f8f6f4((a), (b), (c), 0, 0, 0, 0x7f7f7f7f, 0, 0x7c7c7c7c)
__device__ __forceinline__ i32x8 ld32(const char* p) { const u32x4 a = *(const u32x4*)p, b = *(const u32x4*)(p + 16); return (i32x8){(int)a.x, (int)a.y, (int)a.z, (int)a.w, (int)b.x, (int)b.y, (int)b.z, (int)b.w}; }
typedef short v2i16 __attribute__((ext_vector_type(2)));
__device__ __forceinline__ float rowmax32(const f32x16& p0, const f32x16& p1) {
  float pmax = fmaxf(fmaxf(p0[0], p0[1]), p0[2]);
#pragma unroll
  for (int r = 3; r < 15; r += 2) pmax = fmaxf(fmaxf(pmax, p0[r]), p0[r + 1]);
  pmax = fmaxf(fmaxf(pmax, p0[15]), p1[0]);
#pragma unroll
  for (int r = 1; r < 15; r += 2) pmax = fmaxf(fmaxf(pmax, p1[r]), p1[r + 1]);
  pmax = fmaxf(pmax, p1[15]);
  auto rr = __builtin_amdgcn_permlane32_swap(__float_as_uint(pmax), __float_as_uint(pmax), false, false);
  return fmaxf(__uint_as_float(rr[0]), __uint_as_float(rr[1]));
}
template <bool FIRST>
__device__ __forceinline__ void partialSM(f32x16& p0, f32x16& p1, float& m_reg, f32x16& mt, float& alpha, float& sc) {
  const float pmax = rowmax32(p0, p1);
  if constexpr (FIRST) { m_reg += pmax; p0 = p0 - pmax; p1 = p1 - pmax; mt = mt - pmax; alpha = 1.f; sc = 1.f; }
  else { const bool keep = __all(pmax <= THR8); const float d = keep ? 0.f : ceilf(fmaxf(pmax, 0.f));     alpha = __builtin_amdgcn_exp2f(-d); sc = __builtin_amdgcn_exp2f(d); m_reg += d;
    mt = mt - d; }
#pragma unroll
  for (int r = 0; r < 16; ++r) p0[r] = __builtin_amdgcn_exp2f(p0[r]);
}
__device__ __forceinline__ void finishSM(f32x16& p0, f32x16& p1, float alpha, float sc, float& l_reg, i32x8& pa) {
#pragma unroll
  for (int r = 0; r < 16; ++r) p1[r] = __builtin_amdgcn_exp2f(p1[r]);
  float ps = 0;
#pragma unroll
  for (int r = 0; r < 16; ++r) ps += p0[r];
#pragma unroll
  for (int r = 0; r < 16; ++r) ps += p1[r];
  { auto rr = __builtin_amdgcn_permlane32_swap(__float_as_uint(ps), __float_as_uint(ps), false, false);
    ps = __uint_as_float(rr[0]) + __uint_as_float(rr[1]); }
  l_reg = (l_reg + ps) * alpha;
#pragma unroll
  for (int j = 0; j < 4; ++j) { v2i16 w = {0, 0};
    w = __builtin_amdgcn_cvt_scalef32_pk_fp8_f32(w, p0[4 * j], p0[4 * j + 1], sc, false); w = __builtin_amdgcn_cvt_scalef32_pk_fp8_f32(w, p0[4 * j + 2], p0[4 * j + 3], sc, true); pa[j] = __builtin_bit_cast(int, w);
    v2i16 u = {0, 0};
    u = __builtin_amdgcn_cvt_scalef32_pk_fp8_f32(u, p1[4 * j], p1[4 * j + 1], sc, false); u = __builtin_amdgcn_cvt_scalef32_pk_fp8_f32(u, p1[4 * j + 2], p1[4 * j + 3], sc, true); pa[4 + j] = __builtin_bit_cast(int, u); }
}
__device__ __forceinline__ void qkt(f32x16& p0, f32x16& p1, const char* Ks, const i32x8* qr, const f32x16& mt, int r32, int hi) {
  const char* k0 = Ks + r32 * KST + hi * 32;
  { const i32x8 a0 = ld32(k0), a1 = ld32(k0 + 32 * KST); p0 = MFMA8Q(a0, qr[0], mt); p1 = MFMA8Q(a1, qr[0], mt); }
#pragma unroll
  for (int s = 1; s < 3; ++s) { const i32x8 a0 = ld32(k0 + 64 * s), a1 = ld32(k0 + 32 * KST + 64 * s);
    p0 = MFMA8Q(a0, qr[s], p0); p1 = MFMA8Q(a1, qr[s], p1); }
}
__device__ __forceinline__ void pv(f32x16* o, const char* Vs, const i32x8 pa, int r32, int hi) {
  const char* v0 = Vs + r32 * VST + hi * 32;
#pragma unroll
  for (int d0 = 0; d0 < 4; ++d0) { const i32x8 b = ld32(v0 + d0 * 32 * VST); o[d0] = MFMA8(pa, b, o[d0]); }
}
__device__ __forceinline__ void attn_body(const unsigned char* __restrict__ Qb, const unsigned char* __restrict__ Kh, const unsigned char* __restrict__ Vt, bf16_t* __restrict__ Ob, int ldo, int seq, char* lds) {
  const int tid = threadIdx.x, wid = __builtin_amdgcn_readfirstlane(tid >> 6), lane = tid & 63, r32 = lane & 31, hi = lane >> 5;
  char* K_lds = lds; char* V_lds = lds + NBUF * SHM_K;
  float* ws = (float*)(lds + NBUF * SHM_K + NBUF * SHM_V) + wid * 64; float* li_l = ws; float* al_l = ws + 32;
  float m_reg = 0.f, l_reg = 0; f32x16 o[4] = {}; f32x16 mt = {}; i32x8 qr[3];
  { const char* Qw = (const char*)Qb + (size_t)(wid * QBLK + r32) * MDK + hi * 32;
#pragma unroll
    for (int s = 0; s < 3; ++s) qr[s] = ld32(Qw + 64 * s); }
  const int kd0 = (tid / 12) * KST + (tid % 12) * 16, kd1 = ((512 + tid) / 12) * KST + ((512 + tid) % 12) * 16, vd = (tid >> 2) * VST + (tid & 3) * 16;
  struct { u32x4 k0, k1, v; } sr_[SDEPTH];
#define SLOAD(i, t0) do { const unsigned ko = (unsigned)tid * 16u, vo = ((unsigned)(tid >> 2) << 14) | ((unsigned)(tid & 3) << 4); const unsigned char* kt_ = Kh + (size_t)(t0) * MDK; sr_[i].k0 = *(const u32x4*)(kt_ + ko); if (wid < 4) sr_[i].k1 = *(const u32x4*)(kt_ + 8192 + ko); sr_[i].v = *(const u32x4*)(Vt + (t0) + vo); } while (0)
#define SWRITE(b, i) do { *(u32x4*)(K_lds + (b) * SHM_K + kd0) = sr_[i].k0; if (wid < 4) *(u32x4*)(K_lds + (b) * SHM_K + kd1) = sr_[i].k1; *(u32x4*)(V_lds + (b) * SHM_V + vd) = sr_[i].v; } while (0)
#define SWAIT() do { if constexpr (SDEPTH == 2) asm volatile("s_waitcnt vmcnt(3)" ::: "memory"); else asm volatile("s_waitcnt vmcnt(0)" ::: "memory"); } while (0)
#define RESC(a) do { if (__any((a) < 1.f)) { if (hi == 0) al_l[r32] = (a); asm volatile("s_waitcnt lgkmcnt(0)" ::: "memory"); \
    _Pragma("unroll") for (int d = 0; d < 4; ++d) _Pragma("unroll") for (int r = 0; r < 16; ++r) o[d][r] *= al_l[crow(r, hi)]; } } while (0)
  f32x16 pA0, pA1, pB0, pB1; float alA, alB, scA, scB; i32x8 pa; const int NT = seq / KVBLK;
#if ATT8_RING3
  SLOAD(0, 0); asm volatile("s_waitcnt vmcnt(0)" ::: "memory"); SWRITE(0, 0);
  SLOAD(0, KVBLK); asm volatile("s_waitcnt vmcnt(0)" ::: "memory"); SWRITE(1, 0); __syncthreads();
  qkt(pA0, pA1, K_lds, qr, mt, r32, hi); partialSM<true>(pA0, pA1, m_reg, mt, alA, scA);
  int b0 = 0, b1 = 1, b2 = 2;
#define STEP(c0, c1, alc, n0, n1, mnn, aln, jj) do {                                                                          \
    SBAR(); if ((jj) + 1 < NT) qkt(n0, n1, K_lds + b1 * SHM_K, qr, r32, hi);                                                    \
    finishSM(c0, c1, alc, l_reg, pa); SBAR();                                                                                 \
    if ((jj) + 2 < NT) SLOAD(0, ((jj) + 2) * KVBLK); SBAR();                                                                   \
    pv(o, V_lds + b0 * SHM_V, pa, r32, hi); if ((jj) + 1 < NT) partialSM(n0, n1, m_reg, mnn, aln);                              \
    if ((jj) + 2 < NT) { SWRITE(b2, 0); }                                                                                      \
    if ((jj) + 1 < NT) RESC(aln);                                                                                              \
    __syncthreads(); { const int t_ = b0; b0 = b1; b1 = b2; b2 = t_; } } while (0)
  for (int j = 0; j < NT; j += 2) { STEP(pA0, pA1, alA, pB0, pB1, mnB, alB, j); STEP(pB0, pB1, alB, pA0, pA1, mnA, alA, j + 1); }
#undef STEP
#else
  constexpr int SE = 0, SO = SDEPTH - 1;
  SLOAD(SE, 0); asm volatile("s_waitcnt vmcnt(0)" ::: "memory"); SWRITE(0, SE); __syncthreads();
  qkt(pA0, pA1, K_lds, qr, mt, r32, hi); partialSM<true>(pA0, pA1, m_reg, mt, alA, scA);
  SLOAD(SO, KVBLK); if constexpr (SDEPTH == 2) { if (2 < NT) SLOAD(SE, 2 * KVBLK); }
  SWAIT(); SWRITE(1, SO); __syncthreads();
  for (int j = 1; j + 1 < NT; j += 2) {
    SBAR(); qkt(pB0, pB1, K_lds + SHM_K, qr, mt, r32, hi);
    finishSM(pA0, pA1, alA, scA, l_reg, pa); ILV_QK(); PIN2(pB0, pB1); SBAR();
    SLOAD(SO, (j + SDEPTH) * KVBLK); SBAR();
    pv(o, V_lds, pa, r32, hi); partialSM<false>(pB0, pB1, m_reg, mt, alB, scB); ILV_PV(); PIN4(o); PIN2(pB0, pB1); SBAR();
    __syncthreads(); SWAIT(); SWRITE(0, SE);
    RESC(alB); __syncthreads();
    SBAR(); qkt(pA0, pA1, K_lds, qr, mt, r32, hi);
    finishSM(pB0, pB1, alB, scB, l_reg, pa); ILV_QK(); PIN2(pA0, pA1); SBAR();
    if (SDEPTH == 1 || j + 3 < NT) SLOAD(SE, (j + 1 + SDEPTH) * KVBLK); SBAR();
    pv(o, V_lds + SHM_V, pa, r32, hi); partialSM<false>(pA0, pA1, m_reg, mt, alA, scA); ILV_PV(); PIN4(o); PIN2(pA0, pA1); SBAR();
    __syncthreads(); SWAIT(); SWRITE(1, SO);
    RESC(alA); __syncthreads();
  }
  SBAR(); qkt(pB0, pB1, K_lds + SHM_K, qr, mt, r32, hi);
  finishSM(pA0, pA1, alA, scA, l_reg, pa); SBAR();
  pv(o, V_lds, pa, r32, hi); partialSM<false>(pB0, pB1, m_reg, mt, alB, scB);
  __syncthreads(); RESC(alB);
  finishSM(pB0, pB1, alB, scB, l_reg, pa); SBAR();
  pv(o, V_lds + SHM_V, pa, r32, hi);
#endif
  if (hi == 0) li_l[r32] = l_reg; asm volatile("s_waitcnt lgkmcnt(0)" ::: "memory");
  float rli[16];
#pragma unroll
  for (int r = 0; r < 16; ++r) rli[r] = __builtin_amdgcn_rcpf(li_l[crow(r, hi)]);
  bf16_t* Ow = Ob + (size_t)(wid * QBLK) * ldo;
#pragma unroll
  for (int r = 0; r < 16; ++r) { const int orow = crow(r, hi);
#pragma unroll
    for (int d0 = 0; d0 < 4; ++d0) Ow[(size_t)orow * ldo + d0 * 32 + r32] = f2bf(o[d0][r] * rli[r]); }
#undef SLOAD
#undef SWRITE
#undef SWAIT
#undef RESC
}
#undef SBAR
#undef SGB
#undef MFMA8
}

#ifdef DBG
constexpr size_t WS_DBG = 256 * 1024;
__device__ __forceinline__ unsigned hash32(unsigned x) { x ^= x >> 16; x *= 0x7feb352dU; x ^= x >> 15; x *= 0x846ca68bU; x ^= x >> 16; return x; }
__device__ __forceinline__ void dbg_acc(float* acc, int slot, float got, float ref) { const float d = got - ref; atomicAdd(acc + 2 * slot, d * d); atomicAdd(acc + 2 * slot + 1, ref * ref); }
__device__ __forceinline__ float dotA(const bf16_t* a, const float* W, int K, int ldw, int n) { float s = 0.f; for (int k = 0; k < K; ++k) s += bf2f(a[k]) * W[(size_t)k * ldw + n]; return s; }
__device__ __forceinline__ void chk_p1(const Ctx& C, const Args& a, unsigned char* ws, float* acc) {
    const int gt = C.bid * 512 + C.tid; if (gt >= 6144) return;
    const unsigned hs = hash32(gt * 7919u + 13u); const int t = hs % T, kind = gt % 6; const unsigned c0 = hs >> 14;
    const bf16_t* xn = (const bf16_t*)(ws + WS_XN) + (size_t)t * 1024; const float* w_in = (const float*)a.in[5];
    if (kind == 0) { const int c = c0 % 512; dbg_acc(acc, 0, bf2f(((const bf16_t*)(ws + AR_Q0))[(size_t)t * 512 + c]), dotA(xn, w_in, 1024, 3104, c) * 0.08838834764831845f); }
    else if (kind == 1) { const int c = c0 % 512; dbg_acc(acc, 0, bf2f(((const bf16_t*)(ws + AR_K0))[(size_t)t * 512 + c]), dotA(xn, w_in, 1024, 3104, 512 + c)); }
    else if (kind == 2) { const int c = c0 % 1024; dbg_acc(acc, 0, bf2f(((const bf16_t*)(ws + AR_VT))[(size_t)c * T + t]), dotA(xn, w_in, 1024, 3104, 1024 + c)); }
    else if (kind == 3) { const int c = c0 % 1024; dbg_acc(acc, 0, bf2f(((const bf16_t*)(ws + AR_SR))[(size_t)t * 1024 + c]), siluf(dotA(xn, w_in, 1024, 3104, 2048 + c))); }
    else { const int dir = kind - 4, c = c0 % 512; const float* wg = (const float*)a.in[dir ? 8 : 6]; const float* bg = (const float*)a.in[dir ? 9 : 7]; float lg = bg[c];
        for (int j = 0; j < 16; ++j) lg += dotA(xn, w_in, 1024, 3104, 3072 + 16 * dir + j) * wg[j * 512 + c];
        dbg_acc(acc, 1, ((const float*)(ws + (dir ? AR_GB : AR_GF)))[(size_t)t * 512 + c], logsigf(lg) * 0.0625f); }
}
__device__ __forceinline__ void chk_gla(const Ctx& C, const Args& a, unsigned char* ws, float* acc) {
    if (C.bid >= 64) return;
    float* A = (float*)C.lds; float* O = A + 4096; float* red = O + 512;
    const unsigned hs = hash32(C.bid * 977u + 5u); const int t = hs % T, h = (hs >> 14) & 3;
    const bf16_t* Q0 = (const bf16_t*)(ws + AR_Q0); const bf16_t* K0 = (const bf16_t*)(ws + AR_K0); const float* GF = (const float*)(ws + AR_GF); const float* GB = (const float*)(ws + AR_GB);
    const bf16_t* VT = (const bf16_t*)(ws + AR_VT); const bf16_t* SR = (const bf16_t*)(ws + AR_SR); const bf16_t* OG = (const bf16_t*)(ws + WS_XN);
    for (int i = C.tid; i < 4096; i += 512) A[i] = 0.f;
    __syncthreads();
    const int dir = C.tid >> 8, sub = C.tid & 255;
    if (sub < 128) { const int k = sub, ch = 128 * h + k; const float q = bf2f(Q0[(size_t)t * 512 + ch]); float Dk = dir ? __expf(GB[(size_t)t * 512 + ch]) : 1.f;
        for (int i = 0; i < 2048; ++i) { const int s = dir ? t + 1 + i : t - i; const bool valid = s >= 0 && s < T; float w = 0.f;
            if (valid) { w = q * Dk * bf2f(K0[(size_t)s * 512 + ch]); Dk *= __expf((dir ? GB : GF)[(size_t)s * 512 + ch]); }
            w = wave_sum(w); if (C.lane == 0) atomicAdd(&A[dir * 2048 + i], w); } }
    __syncthreads();
    { float o = 0.f; for (int i = 0; i < 2048; ++i) { const int s = dir ? t + 1 + i : t - i; if (s >= 0 && s < T) o += A[dir * 2048 + i] * bf2f(VT[(size_t)(256 * h + sub) * T + s]); } O[dir * 256 + sub] = o; }
    __syncthreads();
    if (C.tid < 256) { const float o = O[C.tid] + O[256 + C.tid]; float ss = wave_sum(o * o); if (C.lane == 0) red[C.wave] = ss; }
    __syncthreads();
    if (C.tid < 256) { const float o = O[C.tid] + O[256 + C.tid]; const float ss = red[0] + red[1] + red[2] + red[3]; const float r = 1.0f / sqrtf(ss * (1.0f / 256.0f) + RMS_EPS);
        const size_t oi = (size_t)t * 1024 + 256 * h + C.tid; dbg_acc(acc, 2, bf2f(OG[oi]), o * r * ((const float*)a.in[10])[C.tid] * bf2f(SR[oi])); }
    __syncthreads();
}
__device__ __forceinline__ void chk_resid(const Ctx& C, const float* base, const bf16_t* A, int K, const float* W, const float* HAp, float* acc, int slot) {
    const int gt = C.bid * 512 + C.tid; if (gt >= 4096) return;
    const unsigned hs = hash32(gt * 31u + slot); const int t = hs % T, n = (hs >> 14) % 1024;
    dbg_acc(acc, slot, HAp[(size_t)t * 1024 + n], base[(size_t)t * 1024 + n] + dotA(A + (size_t)t * K, W, K, 1024, n));
}
__device__ __forceinline__ void chk_router(const Ctx& C, const float* Hin, const float* gain, const float* Wr, const bf16_t* XN, const float* AFF, float* acc, int slot) {
    const int gt = C.bid * 512 + C.tid; if (gt >= 512) return;
    const int t = hash32(gt * 101u + 7u) % T; const float* hr = Hin + (size_t)t * 1024; float ss = 0.f; for (int k = 0; k < 1024; ++k) ss += hr[k] * hr[k];
    const float r = 1.0f / sqrtf(ss / 1024.0f + RMS_EPS); float lg[16]; for (int e = 0; e < 16; ++e) lg[e] = 0.f;
    for (int k = 0; k < 1024; ++k) { const float xv = hr[k] * r * gain[k]; for (int e = 0; e < 16; ++e) lg[e] += xv * Wr[k * 16 + e]; if ((k & 63) == (gt & 63)) dbg_acc(acc, slot, bf2f(XN[(size_t)t * 1024 + k]), xv); }
    float mx = lg[0]; for (int e = 1; e < 16; ++e) mx = fmaxf(mx, lg[e]); float s = 0.f; for (int e = 0; e < 16; ++e) { lg[e] = expf(lg[e] - mx); s += lg[e]; }
    for (int e = 0; e < 16; ++e) dbg_acc(acc, slot, AFF[(size_t)t * 16 + e], lg[e] / s);
}
__device__ __forceinline__ void chk_select(const Ctx& C, const float* AFF, const int* SEL, const int* IDX, unsigned* dw) {
    const int gt = C.bid * 512 + C.tid;
    for (int p = gt; p < T * 16; p += C.nb * 512) { const int t = p >> 4, e = p & 15; const int s = SEL[p]; const unsigned b = __float_as_uint(AFF[p]);
        if (s > 0) { atomicAdd(&dw[e], 1u); atomicMax(&dw[16 + e], ~b); if (s > CAP || IDX[e * CAP + s - 1] != t) atomicAdd(&dw[48], 1u); } else { atomicMax(&dw[32 + e], b); if (s < 0) atomicAdd(&dw[48], 1u); } }
}
__device__ __forceinline__ void chk_moe_h(const Ctx& C, const Args& a, unsigned char* ws, int layer, float* acc, int slot) {
    const int gt = C.bid * 512 + C.tid; if (gt >= 2048) return;
    const unsigned hs = hash32(gt * 53u + 3u); const int e = hs & 15, sl = (hs >> 4) % CAP, f = (hs >> 15) % FF; const int t = ((const int*)(ws + WS_IDX))[e * CAP + sl];
    if (t < 0 || t >= T) { dbg_acc(acc, slot, 1e3f, 0.f); return; }
    const bf16_t* xn = (const bf16_t*)(ws + WS_XN) + (size_t)t * 1024; const size_t wo = (size_t)(layer * NE + e) * 1024 * 2048;
    const float g = dotA(xn, (const float*)a.in[19] + wo, 1024, 2048, f), u = dotA(xn, (const float*)a.in[20] + wo, 1024, 2048, f);
    dbg_acc(acc, slot, bf2f(((const bf16_t*)(ws + AR_H))[((size_t)e * CAP + sl) * FF + f]), siluf(g) * u);
    dbg_acc(acc, slot, bf2f(((const bf16_t*)(ws + AR_XS))[((size_t)e * CAP + sl) * 1024 + (f & 1023)]), bf2f(xn[f & 1023]));
}
__device__ __forceinline__ void chk_moe_y(const Ctx& C, const Args& a, unsigned char* ws, int layer, float* acc, int slot) {
    const int gt = C.bid * 512 + C.tid; if (gt >= 2048) return;
    const unsigned hs = hash32(gt * 59u + 11u); const int e = hs & 15, sl = (hs >> 4) % CAP, n = (hs >> 15) % 1024;
    const float ref = dotA((const bf16_t*)(ws + AR_H) + ((size_t)e * CAP + sl) * FF, (const float*)a.in[21] + (size_t)(layer * NE + e) * 2048 * 1024, 2048, 1024, n);
    dbg_acc(acc, slot, bf2f(((const bf16_t*)(ws + AR_Y))[((size_t)e * CAP + sl) * 1024 + n]), ref);
}
__device__ __forceinline__ void chk_combine(const Ctx& C, unsigned char* ws, const float* Hin, const float* Hout, float* acc, int slot) {
    const int gt = C.bid * 512 + C.tid; if (gt >= 4096) return;
    const unsigned hs = hash32(gt * 67u + 1u); const int t = hs % T, n = (hs >> 14) % 1024; float ref = Hin[(size_t)t * 1024 + n];
    for (int e = 0; e < 16; ++e) { const int s = ((const int*)(ws + WS_SEL))[t * 16 + e]; if (s > 0) ref += ((const float*)(ws + WS_AFF))[t * 16 + e] * bf2f(((const bf16_t*)(ws + AR_Y))[((size_t)e * CAP + s - 1) * 1024 + n]); }
    dbg_acc(acc, slot, Hout[(size_t)t * 1024 + n], ref);
}
__device__ __forceinline__ void chk_cin(const Ctx& C, const Args& a, unsigned char* ws, float* acc) {
    const int gt = C.bid * 512 + C.tid; if (gt >= 4096) return;
    const unsigned hs = hash32(gt * 71u + 9u); const int t = hs % T, n = (hs >> 14) % 448;
    dbg_acc(acc, 10, ((const float*)(ws + AR_CIN))[(size_t)t * 512 + n], dotA((const bf16_t*)(ws + WS_XN) + (size_t)t * 1024, (const float*)a.in[12], 1024, 448, n));
}
__device__ __forceinline__ void chk_tok(const Ctx& C, const Args& a, unsigned char* ws, float* acc) {
    const int gt = C.bid * 512 + C.tid; if (gt >= 1024) return;
    const unsigned hs = hash32(gt * 73u + 19u); const int t = hs % T, h = (hs >> 14) & 15; const float* row = (const float*)(ws + AR_CIN) + (size_t)t * 512;
    float sq = 0.f, sk = 0.f; for (int i = 0; i < 256; ++i) sq += row[i] * row[i]; for (int i = 0; i < 128; ++i) sk += row[256 + i] * row[256 + i];
    const float rq = 1.0f / sqrtf(sq / 256.0f + RMS_EPS), rk = 1.0f / sqrtf(sk / 128.0f + RMS_EPS);
    const int i = (hs >> 18) % 256; dbg_acc(acc, 11, bf2f(((const bf16_t*)(ws + AR_CQN))[(size_t)t * 256 + i]), row[i] * rq * ((const float*)a.in[13])[i]);
    const int j = i & 127; dbg_acc(acc, 11, bf2f(((const bf16_t*)(ws + AR_CKVN))[(size_t)t * 256 + j]), row[256 + j] * rk * ((const float*)a.in[15])[j]);
    dbg_acc(acc, 11, 1.f + bf2f(((const bf16_t*)(ws + AR_CKVN))[(size_t)t * 256 + 128 + j]), 1.f);
    const int f = i & 31; const float ang = (float)((const int*)a.in[1])[t] * a.invf[f]; double xr = (double)ang * 0.15915494309189533577; xr = (xr - rint(xr)) * 6.283185307179586477; double cd = 1.0, sd = xr, tc = 1.0, ts = xr; for (int n = 1; n < 16; ++n) { tc *= -xr * xr / ((2.0 * n - 1.0) * (2.0 * n)); ts *= -xr * xr / ((2.0 * n) * (2.0 * n + 1.0)); cd += tc; sd += ts; } const float cr = (float)cd, sr = (float)sd;
    dbg_acc(acc, 11, ((const float*)(ws + WS_CS))[(size_t)t * 64 + f], cr); dbg_acc(acc, 11, ((const float*)(ws + WS_CS))[(size_t)t * 64 + 32 + f], sr);
    const float x1 = row[384 + f], x2 = row[416 + f]; const bf16_t* kp = (const bf16_t*)(ws + AR_K) + ((size_t)h * T + t) * MDK + 128 + 8 * (f >> 2) + (f & 3);
    dbg_acc(acc, 11, bf2f(kp[0]), x1 * cr - x2 * sr); dbg_acc(acc, 11, bf2f(kp[4]), x1 * sr + x2 * cr);
}
__device__ __forceinline__ void chk_qkv(const Ctx& C, const Args& a, unsigned char* ws, float* acc) {
    const int gt = C.bid * 512 + C.tid; if (gt >= 4096) return;
    const unsigned hs = hash32(gt * 79u + 29u); const int t = hs % T, h = (hs >> 14) & 15, j = (hs >> 18) & 127, kind = gt & 3; const float QS = (ATT_FP8 ? 8.0f : 1.0f) * 0.07216878364870322f * 1.4426950408889634f;
    const bf16_t* cq = (const bf16_t*)(ws + AR_CQN) + (size_t)t * 256; const bf16_t* ck = (const bf16_t*)(ws + AR_CKVN) + (size_t)t * 256;
    const size_t qo = ((size_t)h * T + t) * MDK; const int tau = t & 63, pos = 32 * ((tau >> 2) & 1) + (tau & 3) + 4 * ((tau >> 3) & 3) + 16 * (tau >> 5);
#if ATT_FP8
#define QV(i) fp8f(ws + AR_Q8 + qo + (i))
#define KV(i) fp8f(ws + AR_K8 + qo + (i))
#define VV(i) fp8f(ws + AR_V8T + ((size_t)h * MDV + (i)) * T + (t & ~63) + pos)
#else
#define QV(i) bf2f(((const bf16_t*)(ws + AR_Q))[qo + (i)])
#define KV(i) bf2f(((const bf16_t*)(ws + AR_K))[qo + (i)])
#define VV(i) bf2f(((const bf16_t*)(ws + AR_V))[((size_t)h * T + t) * MDV + (i)])
#endif
    if (kind == 0) dbg_acc(acc, 12, QV(j), dotA(cq, (const float*)a.in[14], 256, 3072, 192 * h + j) * QS);
    else if (kind == 1) { const int f = j & 31; const float x1 = dotA(cq, (const float*)a.in[14], 256, 3072, 192 * h + 128 + f), x2 = dotA(cq, (const float*)a.in[14], 256, 3072, 192 * h + 160 + f);
        const float cr = ((const float*)(ws + WS_CS))[(size_t)t * 64 + f], sr = ((const float*)(ws + WS_CS))[(size_t)t * 64 + 32 + f]; const int qp = 128 + 8 * (f >> 2) + (f & 3);
        dbg_acc(acc, 12, QV(qp), (x1 * cr - x2 * sr) * QS); dbg_acc(acc, 12, QV(qp + 4), (x1 * sr + x2 * cr) * QS);
        const float* row = (const float*)(ws + AR_CIN) + (size_t)t * 512; const float k1 = row[384 + f], k2 = row[416 + f];
        dbg_acc(acc, 12, KV(qp), k1 * cr - k2 * sr); dbg_acc(acc, 12, KV(qp + 4), k1 * sr + k2 * cr); }
    else if (kind == 2) dbg_acc(acc, 12, KV(j), dotA(ck, (const float*)a.in[16], 128, 4096, 256 * h + j));
    else dbg_acc(acc, 12, VV(j), dotA(ck, (const float*)a.in[16], 128, 4096, 256 * h + 128 + j));
#undef QV
#undef KV
#undef VV
}
__device__ __forceinline__ void chk_attn(const Ctx& C, unsigned char* ws, float* acc) {
    if (C.bid >= 64) return;
    float* P = (float*)C.lds; float* red = P + T; float* qs = red + 32;
    const unsigned hs = hash32(C.bid * 991u + 77u); const int t = hs % T, h = (hs >> 14) & 15;
#if ATT_FP8
    const unsigned char* Q = ws + AR_Q8 + ((size_t)h * T + t) * MDK; const unsigned char* K = ws + AR_K8 + (size_t)h * T * MDK; const unsigned char* V = ws + AR_V8T + (size_t)h * MDV * T; const float SC = 0.125f;
    if (C.tid < MDK) qs[C.tid] = fp8f(Q + C.tid);
#define KEL(j, d) fp8f(K + (size_t)(j) * MDK + (d))
#define VEL(j, d) fp8f(V + (size_t)(d) * T + ((j) & ~63) + 32 * ((((j) & 63) >> 2) & 1) + ((j) & 3) + 4 * ((((j) & 63) >> 3) & 3) + 16 * (((j) & 63) >> 5))
#else
    const bf16_t* Q = (const bf16_t*)(ws + AR_Q) + ((size_t)h * T + t) * MDK; const bf16_t* K = (const bf16_t*)(ws + AR_K) + (size_t)h * T * MDK; const bf16_t* V = (const bf16_t*)(ws + AR_V) + (size_t)h * T * MDV; const float SC = 1.0f;
    if (C.tid < MDK) qs[C.tid] = bf2f(Q[C.tid]);
#define KEL(j, d) bf2f(K[(size_t)(j) * MDK + (d)])
#define VEL(j, d) bf2f(V[(size_t)(j) * MDV + (d)])
#endif
    __syncthreads();
    float mx = -1e30f;
    for (int j = C.tid; j < T; j += 512) { float s = 0.f; for (int d = 0; d < MDK; ++d) s += qs[d] * KEL(j, d); s *= SC; P[j] = s; mx = fmaxf(mx, s); }
    mx = wave_max(mx); if (C.lane == 0) red[C.wave] = mx;
    __syncthreads();
    mx = red[0]; for (int w = 1; w < 8; ++w) mx = fmaxf(mx, red[w]);
    float sm = 0.f; for (int j = C.tid; j < T; j += 512) { const float p = exp2f(P[j] - mx); P[j] = p; sm += p; }
    sm = wave_sum(sm);
    __syncthreads();
    if (C.lane == 0) red[8 + C.wave] = sm;
    __syncthreads();
    sm = 0.f; for (int w = 0; w < 8; ++w) sm += red[8 + w];
    if (C.tid < MDV) { float o = 0.f; for (int j = 0; j < T; ++j) o += P[j] * VEL(j, C.tid); dbg_acc(acc, 13, bf2f(((const bf16_t*)(ws + AR_O))[(size_t)t * 2048 + 128 * h + C.tid]) * 100.f, o / sm * 100.f); }
    __syncthreads();
#undef KEL
#undef VEL
}
__device__ __forceinline__ void dbg_report(const Ctx& C, unsigned char* ws, float* out, int lo, int hi) {
    const float* acc = (const float*)(ws + WS_DBG); const unsigned* dw = (const unsigned*)(ws + WS_DBG + 1024);
    int code = 90;
    for (int s = lo; s < hi && code == 90; ++s) { float num = __hip_atomic_load(acc + 2 * s, __ATOMIC_RELAXED, __HIP_MEMORY_SCOPE_AGENT), den = __hip_atomic_load(acc + 2 * s + 1, __ATOMIC_RELAXED, __HIP_MEMORY_SCOPE_AGENT);
        if (s == 5) { unsigned viol = __hip_atomic_load(dw + 48, __ATOMIC_RELAXED, __HIP_MEMORY_SCOPE_AGENT); for (int e = 0; e < 16; ++e) { const unsigned cnt = __hip_atomic_load(dw + e, __ATOMIC_RELAXED, __HIP_MEMORY_SCOPE_AGENT), mn = ~__hip_atomic_load(dw + 16 + e, __ATOMIC_RELAXED, __HIP_MEMORY_SCOPE_AGENT), mxu = __hip_atomic_load(dw + 32 + e, __ATOMIC_RELAXED, __HIP_MEMORY_SCOPE_AGENT); if (cnt != CAP) viol += 1000; if (mn < mxu) viol += 1; }
            num = (float)viol; den = 1.f; if (viol == 0) continue; code = 10 * (s - lo) + (viol >= 1000 ? 0 : (viol >= 100 ? 1 : (viol >= 10 ? 2 : 3))); break; }
        if (den == 0.f && num == 0.f) continue;
        const float e = sqrtf(num / den);
        if (!(e < 0.03f)) { const int b = !(e < 1.f) ? 0 : (e >= 0.3f ? 1 : (e >= 0.1f ? 2 : 3)); code = 10 * (s - lo) + b; } }
    if (code == 90) { float worst = 0.f; for (int s = lo; s < hi; ++s) { if (s == 5) continue; const float num = acc[2 * s], den = acc[2 * s + 1]; if (den > 0.f) worst = fmaxf(worst, sqrtf(num / den)); }
        code = 90 + (worst >= 0.01f ? 1 : (worst >= 0.003f ? 2 : 3)); }
    if (DBG >= 2) { const int sl = DBG == 2 ? 13 : 12; const float num = acc[2 * sl], den = acc[2 * sl + 1]; const float e = sqrtf(num / den); code = !(e > 0.f) ? 99 : (e >= 1.f ? 0 : (int)fminf(89.f, -20.f * log10f(e))); }
    const float c = sqrtf((float)code);
    for (size_t i = (size_t)C.bid * 512 + C.tid; i < (size_t)T * D; i += (size_t)C.nb * 512) out[i] = c;
}
#endif

constexpr int NPHASE = 24;
__global__ void __launch_bounds__(512, 2) mk_fwd(Args args) {
    extern __shared__ __attribute__((aligned(16))) unsigned char lds[];
    Ctx C; C.tid = threadIdx.x; C.lane = C.tid & 63; C.wave = __builtin_amdgcn_readfirstlane(C.tid >> 6); C.bid = blockIdx.x; C.nb = gridDim.x;
    C.gw = C.bid * 8 + C.wave; C.ngw = C.nb * 8; C.lds = lds;
    unsigned char* ws = args.ws;
    volatile LAS unsigned* MISC = (volatile LAS unsigned*)((LAS unsigned char*)lds + LDS_MISC);
    if (C.tid < 32) MISC[C.tid] = 0u;
    __syncthreads();
    XcdBarrier bar = xcd_barrier_post((unsigned*)(ws + WS_CTL) + 4096 + args.li * XCD_BAR_WORDS, MISC + 8);
    const int lo = args.ph_lo, hi = args.ph_hi;
#if defined(PH_MASK)
#define IN(k) ((((PH_MASK) >> (k)) & 1u) && lo <= (k) && (k) < hi)
#elif defined(PH_ONLY)
#define IN(k) ((k) == PH_ONLY && lo <= (k) && (k) < hi)
#else
#define IN(k) (lo <= (k) && (k) < hi)
#endif
#define SEAM(k) do { if (IN((k) + 1)) xcd_barrier(bar); } while (0)
#ifndef REPMASK
#define REPMASK 0u
#endif
#define NREP(k) ((((REPMASK) >> (k)) & 1u) ? 2 : 1)
#ifdef DBG
    float* dacc = (float*)(ws + WS_DBG); unsigned* ddw = (unsigned*)(ws + WS_DBG + 1024);
#define DBGCHK(page, call) do { if ((DBG >= 2 ? 1 : DBG) == (page)) { call; xcd_barrier(bar); } } while (0)
#else
#define DBGCHK(page, call) do { } while (0)
#endif
    PG8_LAS unsigned char* glds = (PG8_LAS unsigned char*)lds;
    const float* x = (const float*)args.in[0];
    float* HA = args.out; float* HB = (float*)(ws + WS_HB);
    bf16_t* XN = (bf16_t*)(ws + WS_XN);
    float* AFF = (float*)(ws + WS_AFF); int* SEL = (int*)(ws + WS_SEL); int* IDX = (int*)(ws + WS_IDX);
    bf16_t* WGU = (bf16_t*)(ws + WS_WGU); bf16_t* WD = (bf16_t*)(ws + WS_WD);
    bf16_t* XS = (bf16_t*)(ws + AR_XS); bf16_t* HH = (bf16_t*)(ws + AR_H); bf16_t* YY = (bf16_t*)(ws + AR_Y);

    if (IN(0)) { ph_convert_small(C, args, ws); ph_convert_moe(C, args, ws, 0, NREP(0)); ph_norm(C, x, (const float*)args.in[2], XN); SEAM(0); }
    if (IN(1)) {
        { pg8::Gemm g{XN, (const bf16_t*)(ws + WS_WGIN), T, 3072, 1024}; pg8::StaticOrder S; S.init(T, 3072, C.nb, C.bid); S.rep = NREP(1);
          pg8::EpiGlaIn E{(bf16_t*)(ws + AR_Q0), (bf16_t*)(ws + AR_K0), (bf16_t*)(ws + AR_SR), (float*)(ws + AR_GF), (float*)(ws + AR_GB), (const float*)args.in[7], (const float*)args.in[9]};
          pg8::gemm_phase<pg8::EpiGlaIn, pg8::StaticOrder, PG8_ALIGN, PG8_SP2>(glds, g, S, E); }
        { pg8::Gemm g{(const bf16_t*)(ws + WS_WV), XN, 1024, T, 1024}; pg8::StaticOrder S; S.init(1024, T, C.nb, C.bid); S.rep = NREP(1);
          pg8::EpiBf E{(bf16_t*)(ws + AR_VT), T};
          pg8::gemm_phase<pg8::EpiBf, pg8::StaticOrder, PG8_ALIGN, PG8_SP2>(glds, g, S, E); }
        SEAM(1); } DBGCHK(0, chk_p1(C, args, ws, dacc));
    if (IN(2)) for (int rep_ = 0; rep_ < NREP(2); ++rep_) { ph_gla_prep(C, (const bf16_t*)(ws + AR_Q0), (const bf16_t*)(ws + AR_K0), (const float*)(ws + AR_GF), (const float*)(ws + AR_GB), (bf16_t*)(ws + AR_QDF), (bf16_t*)(ws + AR_QDB),
                             (bf16_t*)(ws + AR_KDF), (bf16_t*)(ws + AR_KDB), (bf16_t*)(ws + AR_KTF), (bf16_t*)(ws + AR_KTB), (float*)(ws + WS_EGL)); SEAM(2); }
    if (IN(3)) for (int rep_ = 0; rep_ < NREP(3); ++rep_) { ph_gla_u(C, (const bf16_t*)(ws + AR_VT), (const bf16_t*)(ws + AR_KTF), (const bf16_t*)(ws + AR_KTB), (const float*)(ws + WS_EGL), (bf16_t*)(ws + AR_U)); SEAM(3); }
    if (IN(4)) for (int rep_ = 0; rep_ < NREP(4); ++rep_) { ph_gla_scan(C, (const bf16_t*)(ws + AR_U), (const float*)(ws + WS_EGL), (bf16_t*)(ws + AR_ST)); SEAM(4); }
    if (IN(5)) for (int rep_ = 0; rep_ < NREP(5); ++rep_) { ph_gla_out(C, (const bf16_t*)(ws + AR_QDF), (const bf16_t*)(ws + AR_QDB), (const bf16_t*)(ws + AR_KDF), (const bf16_t*)(ws + AR_KDB), (const bf16_t*)(ws + AR_VT), (const bf16_t*)(ws + AR_ST),
                            (const bf16_t*)(ws + AR_SR), (const float*)args.in[10], XN); SEAM(5); } DBGCHK(0, chk_gla(C, args, ws, dacc));
    if (IN(6)) { pg8::Gemm g{XN, (const bf16_t*)(ws + WS_WGOUT), T, 1024, 1024}; pg8::StaticOrder S; S.init(T, 1024, C.nb, C.bid); S.rep = NREP(6);
        pg8::EpiF32 E{HA, x, 1024}; pg8::gemm_phase<pg8::EpiF32, pg8::StaticOrder, false, PG8_SP2>(glds, g, S, E); SEAM(6); } DBGCHK(0, chk_resid(C, x, XN, 1024, (const float*)args.in[11], HA, dacc, 3));
#define MOE_LAYER(P, L, HIN, TAILMODE, HOUT, GAIN2, OUTP)                                                                                         \
    if (IN(P)) for (int rep_ = 0; rep_ < NREP(P); ++rep_) { ph_router(C, HIN, (const float*)args.in[3] + (L) * 1024, (const float*)args.in[18] + (L) * 1024 * 16, XN, AFF, (float*)(ws + WS_AFFT), ws + AR_XN8); SEAM(P); if ((P) == 7) DBGCHK(0, chk_router(C, HIN, (const float*)args.in[3] + (L) * 1024, (const float*)args.in[18] + (L) * 1024 * 16, XN, AFF, dacc, 4)); }       \
    if (IN(P + 1)) for (int rep_ = 0; rep_ < NREP(P + 1); ++rep_) { ph_select(C, (const float*)(ws + WS_AFFT), SEL, IDX); SEAM(P + 1); if ((P) == 7) DBGCHK(0, chk_select(C, AFF, SEL, IDX, ddw)); }                                                                                 \
    if (IN(P + 2)) for (int rep_ = 0; rep_ < NREP(P + 2); ++rep_) { ph_gather(C, IDX, XN, XS, ws + AR_XN8); SEAM(P + 2); }                                                                                   \
    if (IN(P + 3)) { pg8::Gemm g{XS, WGU, NE * CAP, 4096, MOE_FP8 ? 512 : 1024}; pg8::GroupedOrder S; S.init(NE * CAP, 4096, C.nb, C.bid); S.rep = NREP(P + 3); pg8::EpiMoe1 E{HH};     \
        pg8::gemm_phase<pg8::EpiMoe1, pg8::GroupedOrder, PG8_ALIGN, PG8_SP2, MOE_FP8 != 0>(glds, g, S, E); SEAM(P + 3); if ((P) == 7) DBGCHK(0, chk_moe_h(C, args, ws, L, dacc, 6)); }                                       \
    if (IN(P + 4)) { pg8::Gemm g{HH, WD, NE * CAP, 1024, MOE_FP8 ? 1024 : 2048}; pg8::GroupedOrder S; S.init(NE * CAP, 1024, C.nb, C.bid); S.rep = NREP(P + 4); pg8::EpiMoe2 E{YY};      \
        pg8::gemm_phase<pg8::EpiMoe2, pg8::GroupedOrder, PG8_ALIGN, PG8_SP2, MOE_FP8 != 0>(glds, g, S, E); SEAM(P + 4); if ((P) == 7) DBGCHK(0, chk_moe_y(C, args, ws, L, dacc, 7)); }                                       \
    if (IN(P + 5)) for (int rep_ = 0; rep_ < NREP(P + 5); ++rep_) { ph_combine<TAILMODE>(C, HIN, AFF, SEL, YY, HOUT, GAIN2, XN, OUTP); SEAM(P + 5); if ((P) == 7) DBGCHK(0, chk_combine(C, ws, HIN, HOUT, dacc, 8)); }

    MOE_LAYER(7, 0, HA, 1, HB, (const float*)args.in[2] + 1024, nullptr)
    if (IN(13)) { pg8::Gemm g{XN, (const bf16_t*)(ws + WS_WMIN), T, 512, 1024}; pg8::StaticOrder S; S.init(T, 512, C.nb, C.bid); S.rep = NREP(13);
        pg8::EpiF32 E{(float*)(ws + AR_CIN), nullptr, 512}; pg8::gemm_phase<pg8::EpiF32, pg8::StaticOrder, false, PG8_SP2>(glds, g, S, E); SEAM(13); } DBGCHK(1, chk_cin(C, args, ws, dacc));
    if (IN(14)) { ph_mla_tok(C, (const float*)(ws + AR_CIN), (const int*)args.in[1], (const float*)args.in[13], (const float*)args.in[15], args.invf, (bf16_t*)(ws + AR_CQN), (bf16_t*)(ws + AR_CKVN),
                             (float*)(ws + WS_CS), (bf16_t*)(ws + AR_K));
        ph_convert_moe(C, args, ws, 1, NREP(14)); SEAM(14); } DBGCHK(1, chk_tok(C, args, ws, dacc));
    if (IN(15)) {
#if ATT_FP8
        { pg8::Gemm g{(const bf16_t*)(ws + AR_CQN), (const bf16_t*)(ws + WS_WUQ), T, 4096, 256}; pg8::StaticOrder S; S.init(T, 4096, C.nb, C.bid); S.rep = NREP(15);
          pg8::EpiQ8 E{ws + AR_Q8, (const float*)(ws + WS_CS)}; pg8::gemm_phase<pg8::EpiQ8, pg8::StaticOrder, PG8_ALIGN, PG8_SP2>(glds, g, S, E); }
        { pg8::Gemm g{(const bf16_t*)(ws + AR_CKVN), (const bf16_t*)(ws + WS_WUKV), T, 2048, 256}; pg8::StaticOrder S; S.init(T, 2048, C.nb, C.bid); S.rep = NREP(15);
          pg8::EpiK8 E{ws + AR_K8}; pg8::gemm_phase<pg8::EpiK8, pg8::StaticOrder, PG8_ALIGN, PG8_SP2>(glds, g, S, E); }
        { pg8::Gemm g{(const bf16_t*)(ws + WS_WUKV) + (size_t)2048 * 256, (const bf16_t*)(ws + AR_CKVN), 2048, T, 256}; pg8::StaticOrder S; S.init(2048, T, C.nb, C.bid); S.rep = NREP(15);
          pg8::EpiV8T E{ws + AR_V8T}; pg8::gemm_phase<pg8::EpiV8T, pg8::StaticOrder, PG8_ALIGN, PG8_SP2>(glds, g, S, E); }
#else
        { pg8::Gemm g{(const bf16_t*)(ws + AR_CQN), (const bf16_t*)(ws + WS_WUQ), T, 4096, 256}; pg8::StaticOrder S; S.init(T, 4096, C.nb, C.bid); S.rep = NREP(15);
          pg8::EpiQup E{(bf16_t*)(ws + AR_Q), (const float*)(ws + WS_CS)}; pg8::gemm_phase<pg8::EpiQup, pg8::StaticOrder, PG8_ALIGN, PG8_SP2>(glds, g, S, E); }
        { pg8::Gemm g{(const bf16_t*)(ws + AR_CKVN), (const bf16_t*)(ws + WS_WUKV), T, 4096, 256}; pg8::StaticOrder S; S.init(T, 4096, C.nb, C.bid); S.rep = NREP(15);
          pg8::EpiKVup E{(bf16_t*)(ws + AR_K), (bf16_t*)(ws + AR_V)}; pg8::gemm_phase<pg8::EpiKVup, pg8::StaticOrder, PG8_ALIGN, PG8_SP2>(glds, g, S, E); }
#endif
        SEAM(15); } DBGCHK(1, chk_qkv(C, args, ws, dacc));
    if (IN(16)) {
        const int nun = MH * (T / 256);
        for (int ii = 0; ii * C.nb + C.bid < nun * NREP(16); ++ii) { const int i = ii % (nun / C.nb);
            int h, qb; if (C.nb == 256) { h = (C.bid & 7) + 8 * (i >> 1); qb = (i & 1) * 32 + (C.bid >> 3); } else { const int u = i * C.nb + C.bid; h = u >> 6; qb = u & 63; }
#if ATT_FP8
            att8::attn_body(ws + AR_Q8 + ((size_t)h * T + (size_t)qb * 256) * MDK, ws + AR_K8 + (size_t)h * T * MDK, ws + AR_V8T + (size_t)h * MDV * T, (bf16_t*)(ws + AR_O) + (size_t)qb * 256 * 2048 + 128 * h, 2048, T, (char*)lds);
#else
            const bf16_t* Qb = (const bf16_t*)(ws + AR_Q) + ((size_t)h * T + (size_t)qb * 256) * MDK;
            att::attn_body(Qb, (const bf16_t*)(ws + AR_K) + (size_t)h * T * MDK, (const bf16_t*)(ws + AR_V) + (size_t)h * T * MDV, (bf16_t*)(ws + AR_O) + (size_t)qb * 256 * 2048 + 128 * h, 2048, T, (char*)lds);
#endif
            __syncthreads();
        }
        SEAM(16); } DBGCHK(1, chk_attn(C, ws, dacc));
    if (IN(17)) { pg8::Gemm g{(const bf16_t*)(ws + AR_O), (const bf16_t*)(ws + WS_WMOUT), T, 1024, 2048}; pg8::StaticOrder S; S.init(T, 1024, C.nb, C.bid); S.rep = NREP(17);
        pg8::EpiF32 E{HA, HB, 1024}; pg8::gemm_phase<pg8::EpiF32, pg8::StaticOrder, false, PG8_SP2>(glds, g, S, E); SEAM(17); } DBGCHK(1, chk_resid(C, HB, (const bf16_t*)(ws + AR_O), 2048, (const float*)args.in[17], HA, dacc, 14));
    MOE_LAYER(18, 1, HA, 2, nullptr, (const float*)args.in[4], args.out)
#ifdef DBG
    xcd_barrier(bar); dbg_report(C, ws, args.out, DBG == 0 ? 0 : 10, DBG == 0 ? 10 : 20);
#endif
#undef IN
#undef SEAM
}

#ifndef MK_N_LAUNCHES
#define MK_N_LAUNCHES 1
#endif
extern "C" void kernel_launch(void* const* d_in, const int* in_sizes, int n_in, void* d_out, int out_size, void* d_ws, size_t ws_size, hipStream_t stream) {
    static int grid = 0;
    if (grid == 0) {
        if (n_in != 22 || out_size != T * D || ws_size < WS_END) { fprintf(stderr, "kernel_launch: unexpected shapes (n_in %d out %d ws %zu, need ws >= %zu)\n", n_in, out_size, ws_size, (size_t)WS_END); grid = -1; return; }
        int dev = 0, cus = 0, per_cu = 0;
        if (hipGetDevice(&dev) != hipSuccess || hipDeviceGetAttribute(&cus, hipDeviceAttributeMultiprocessorCount, dev) != hipSuccess) { grid = -1; return; }
        if (hipFuncSetAttribute((const void*)mk_fwd, hipFuncAttributeMaxDynamicSharedMemorySize, LDS_BYTES) != hipSuccess) { fprintf(stderr, "kernel_launch: hipFuncSetAttribute failed\n"); grid = -1; return; }
        if (hipOccupancyMaxActiveBlocksPerMultiprocessor(&per_cu, (const void*)mk_fwd, 512, LDS_BYTES) != hipSuccess || per_cu < 1) fprintf(stderr, "kernel_launch: occupancy query says %d\n", per_cu);
        (void)hipGetLastError();
        grid = cus;
    }
    if (grid < 0) return;
    (void)hipMemsetAsync((char*)d_ws + WS_CTL, 0, CTL_ZERO_BYTES, stream);
    Args a{};
    for (int i = 0; i < 22; ++i) a.in[i] = d_in[i];
    a.out = (float*)d_out; a.ws = (unsigned char*)d_ws;
    for (int i = 0; i < 32; ++i) a.invf[i] = powf(10000.0f, -(float)i / 32.0f);
    if (MK_N_LAUNCHES == 1) { a.ph_lo = 0; a.ph_hi = NPHASE; a.li = 0; hipLaunchKernelGGL(mk_fwd, dim3(grid), dim3(512), LDS_BYTES, stream, a); }
    else { for (int p = 0; p < NPHASE; ++p) { a.ph_lo = p; a.ph_hi = p + 1; a.li = p; hipLaunchKernelGGL(mk_fwd, dim3(grid), dim3(512), LDS_BYTES, stream, a); } }
}
```

```cpp
#include <hip/hip_runtime.h>
#include <cstdio>
#include <cstdint>
#include <cmath>

constexpr int T = 16384, D = 1024, NE = 16, CAP = 2048, FF = 2048;
constexpr int GH = 4, GDK = 128, GDV = 256, GC = 64, GNC = T / GC;
constexpr int MH = 16, MDK = 192, MDV = 128;
constexpr float RMS_EPS = 1e-6f;

typedef unsigned short bf16_t;
typedef short bf16x8 __attribute__((ext_vector_type(8)));
typedef short s16x4 __attribute__((ext_vector_type(4)));
typedef float f32x4 __attribute__((ext_vector_type(4)));
typedef float f32x2 __attribute__((ext_vector_type(2)));
typedef float f32x16 __attribute__((ext_vector_type(16)));
typedef unsigned u32x4 __attribute__((ext_vector_type(4)));
typedef unsigned u32x2 __attribute__((ext_vector_type(2)));
typedef int i32x8 __attribute__((ext_vector_type(8)));
#ifndef MOE_FP8
#define MOE_FP8 1
#endif
#ifndef ATT_FP8
#define ATT_FP8 1
#endif

constexpr size_t MiB = 1u << 20;
constexpr size_t WS_CTL = 0, CTL_ZERO_BYTES = 512 * 1024;
constexpr size_t WS_WGIN = 1 * MiB;
constexpr size_t WS_WV = 7 * MiB;
constexpr size_t WS_WGOUT = 9 * MiB;
constexpr size_t WS_WMIN = 11 * MiB;
constexpr size_t WS_WUQ = 12 * MiB;
constexpr size_t WS_WUKV = 14 * MiB;
constexpr size_t WS_WMOUT = 16 * MiB;
constexpr size_t WS_WGU = 20 * MiB;
constexpr size_t WS_WD = 148 * MiB;
constexpr size_t WS_AFF = 212 * MiB;
constexpr size_t WS_SEL = 213 * MiB;
constexpr size_t WS_IDX = 214 * MiB;
constexpr size_t WS_EGL = 215 * MiB;
constexpr size_t WS_CS = 216 * MiB;
constexpr size_t WS_XN = 220 * MiB;
constexpr size_t WS_HB = 252 * MiB;
constexpr size_t WS_AR = 316 * MiB;
constexpr size_t WS_AFFT = 828 * MiB;
constexpr size_t WS_END = 829 * MiB;
constexpr size_t AR_Q0 = WS_AR, AR_K0 = WS_AR + 16 * MiB, AR_GF = WS_AR + 32 * MiB, AR_GB = WS_AR + 64 * MiB, AR_SR = WS_AR + 96 * MiB, AR_VT = WS_AR + 128 * MiB;
constexpr size_t AR_QDF = WS_AR + 160 * MiB, AR_QDB = WS_AR + 176 * MiB, AR_KDF = WS_AR + 192 * MiB, AR_KDB = WS_AR + 208 * MiB, AR_KTF = WS_AR + 224 * MiB, AR_KTB = WS_AR + 240 * MiB;
constexpr size_t AR_U = WS_AR + 256 * MiB, AR_ST = WS_AR + 384 * MiB;
constexpr size_t AR_XS = WS_AR, AR_H = WS_AR + 64 * MiB, AR_Y = WS_AR + 192 * MiB, AR_XN8 = WS_AR + 256 * MiB;
constexpr size_t AR_CIN = WS_AR, AR_CQN = WS_AR + 32 * MiB, AR_CKVN = WS_AR + 40 * MiB, AR_Q = WS_AR + 48 * MiB, AR_K = WS_AR + 144 * MiB, AR_V = WS_AR + 240 * MiB, AR_O = WS_AR + 304 * MiB;

constexpr size_t AR_Q8 = AR_Q, AR_K8 = AR_K, AR_V8T = AR_V;
constexpr int LDS_BYTES = 147456;
constexpr int LDS_MISC = 135168;

__device__ __forceinline__ unsigned cvt_pk_bf16(float lo, float hi) { unsigned r; asm volatile("v_cvt_pk_bf16_f32 %0, %1, %2" : "=v"(r) : "v"(lo), "v"(hi)); return r; }
__device__ __forceinline__ float bf_lo(unsigned w) { return __uint_as_float(w << 16); }
__device__ __forceinline__ float bf_hi(unsigned w) { return __uint_as_float(w & 0xffff0000u); }
__device__ __forceinline__ float bf2f(bf16_t b) { return __uint_as_float(((unsigned)b) << 16); }
__device__ __forceinline__ bf16_t f2bf(float f) { return (bf16_t)(cvt_pk_bf16(f, 0.f) & 0xffffu); }
__device__ __forceinline__ float siluf(float x) { return x / (1.f + __expf(-x)); }
__device__ __forceinline__ float logsigf(float x) { return fminf(x, 0.f) - log1pf(__expf(-fabsf(x))); }
__device__ __forceinline__ void store8bf(bf16_t* p, f32x4 v0, f32x4 v1) {
    u32x4 w; w.x = cvt_pk_bf16(v0[0], v0[1]); w.y = cvt_pk_bf16(v0[2], v0[3]); w.z = cvt_pk_bf16(v1[0], v1[1]); w.w = cvt_pk_bf16(v1[2], v1[3]); *(u32x4*)p = w; }
__device__ __forceinline__ unsigned pk4fp8(float a, float b, float c, float d) { int w = __builtin_amdgcn_cvt_pk_fp8_f32(a, b, 0, false); w = __builtin_amdgcn_cvt_pk_fp8_f32(c, d, w, true); return (unsigned)w; }
__device__ __forceinline__ void store8fp8(unsigned char* p, f32x4 v0, f32x4 v1) { u32x2 w; w.x = pk4fp8(v0[0], v0[1], v0[2], v0[3]); w.y = pk4fp8(v1[0], v1[1], v1[2], v1[3]); *(u32x2*)p = w; }
__device__ __forceinline__ float fp8f(const unsigned char* p) { const unsigned w = *(const unsigned*)((size_t)p & ~(size_t)3); const int b = (int)((size_t)p & 3);
    return b == 0 ? __builtin_amdgcn_cvt_f32_fp8((int)w, 0) : b == 1 ? __builtin_amdgcn_cvt_f32_fp8((int)w, 1) : b == 2 ? __builtin_amdgcn_cvt_f32_fp8((int)w, 2) : __builtin_amdgcn_cvt_f32_fp8((int)w, 3); }
__device__ __forceinline__ float wave_sum(float v) {
#pragma unroll
    for (int o = 1; o < 64; o <<= 1) v += __shfl_xor(v, o);
    return v; }
__device__ __forceinline__ float wave_max(float v) {
#pragma unroll
    for (int o = 1; o < 64; o <<= 1) v = fmaxf(v, __shfl_xor(v, o));
    return v; }
#define LAS __attribute__((address_space(3)))
#define LDS_WAIT() asm volatile("s_waitcnt lgkmcnt(0)" ::: "memory")
#define VM_WAIT() asm volatile("s_waitcnt vmcnt(0)" ::: "memory")

namespace pg8 {
#define PG8_LAS __attribute__((address_space(3)))
typedef unsigned short bf16_t;
typedef short bf16x8 __attribute__((ext_vector_type(8)));
typedef float f32x4 __attribute__((ext_vector_type(4)));
typedef unsigned u32x4 __attribute__((ext_vector_type(4)));
constexpr int BM = 256, BK = 64, HALF = 128, HTB = HALF * BK * 2  , STAGE_BYTES = 8 * HTB, NXCD = 8, WGM = 8;

__host__ __device__ __forceinline__ int lds_byte(int r, int c) { const int st = (r >> 4) * 2 + (c >> 5), rr = r & 15, cc = c & 31, ob = rr * 64 + cc * 2; return st * 1024 + (ob ^ (((ob >> 9) & 1) << 5)); }
__host__ __device__ __forceinline__ void stage_rc(int b, int& R, int& C) { const int st = b / 1024, sb = b % 1024, swz = sb ^ (((sb >> 9) & 1) << 5); R = (st >> 1) * 16 + swz / 64; C = (st & 1) * 32 + (swz % 64) / 2; }
__host__ __device__ __forceinline__ int perm32(int rho) { const int n = rho >> 4, i = rho & 15; return 8 * (i >> 2) + 4 * n + (i & 3); }

struct Unit { int pm, pn; };
struct Gemm { const bf16_t* A; const bf16_t* Bt; int M, N, K; };

struct StaticOrder {
    int nM, nN, nwg, G, c, rep;
    __host__ __device__ void init(int M, int N, int G_, int c_) { nM = M / BM; nN = N / BM; nwg = nM * nN; G = G_; c = c_; rep = 1; }
    __host__ __device__ bool next(int i, Unit& u) const {
        if (rep > 1) { const int cnt = (nwg - c + G - 1) / G; if (cnt <= 0 || i >= cnt * rep) return false; i = i % cnt; }
        const long L = (long)i * G + c; if (L >= nwg) return false;
        int wgid = (int)L; { const int q = nwg / NXCD, r = nwg % NXCD, xcd = wgid % NXCD, off = wgid / NXCD; wgid = (xcd < r ? xcd * (q + 1) : r * (q + 1) + (xcd - r) * q) + off; }
        const int nig = WGM * nN, gid = wgid / nig, fm = gid * WGM, gsz = (nM - fm) < WGM ? (nM - fm) : WGM;
        u.pm = fm + ((wgid % nig) % gsz); u.pn = (wgid % nig) / gsz; return true;
    }
    __device__ __forceinline__ void a_ready(const Unit&) const {}
    __device__ __forceinline__ void done(const Unit&) const {}
};

struct GroupedOrder : StaticOrder {
    int nNl;
    __host__ __device__ void init(int Mtot, int Nper, int G_, int c_) { StaticOrder::init(Mtot, Nper, G_, c_); nNl = Nper / BM; }
    __host__ __device__ bool next(int i, Unit& u) const { if (!StaticOrder::next(i, u)) return false; u.pn += (u.pm >> 3) * nNl; return true; }
};

#define EPI_LOOP_ROWS for (int ai = 0; ai < 2; ++ai) _Pragma("unroll") for (int m = 0; m < 4; ++m)

struct EpiGlaIn {
    static constexpr bool PERM = true, AFTER_DRAIN = false;
    bf16_t *Q0, *K0, *SR; float *GF, *GB; const float *bF, *bB;
    __device__ __forceinline__ void operator()(const f32x4 (&acc)[2][2][4][2], const Unit& u, int wr, int wc, int fr, int fq) const {
        const int row0 = u.pm * BM + wr * 64 + fr, pn = u.pn;
#pragma unroll
        EPI_LOOP_ROWS { const size_t row = (size_t)(row0 + ai * HALF + m * 16);
#pragma unroll
            for (int bj = 0; bj < 2; ++bj) { const int cl = bj * HALF + wc * 32 + 8 * fq; f32x4 v0 = acc[ai][bj][m][0], v1 = acc[ai][bj][m][1];
                if (pn < 2) { const float s = 0.08838834764831845f; store8bf(Q0 + row * 512 + pn * 256 + cl, v0 * s, v1 * s); }
                else if (pn < 4) { store8bf(K0 + row * 512 + (pn - 2) * 256 + cl, v0, v1); }
                else if (pn < 8) {
#pragma unroll
                    for (int j = 0; j < 4; ++j) { v0[j] = siluf(v0[j]); v1[j] = siluf(v1[j]); }
                    store8bf(SR + row * 1024 + (pn - 4) * 256 + cl, v0, v1); }
                else { float* G = pn < 10 ? GF : GB; const float* b = pn < 10 ? bF : bB; const int c = ((pn - 8) & 1) * 256 + cl;
                    const f32x4 b0 = *(const f32x4*)(b + c), b1 = *(const f32x4*)(b + c + 4); f32x4 o0, o1;
#pragma unroll
                    for (int j = 0; j < 4; ++j) { o0[j] = logsigf(v0[j] + b0[j]) * 0.0625f; o1[j] = logsigf(v1[j] + b1[j]) * 0.0625f; }
                    *(f32x4*)(G + row * 512 + c) = o0; *(f32x4*)(G + row * 512 + c + 4) = o1; } } }
    }
};
struct EpiBf {
    static constexpr bool PERM = true, AFTER_DRAIN = false;
    bf16_t* O; int ldc;
    __device__ __forceinline__ void operator()(const f32x4 (&acc)[2][2][4][2], const Unit& u, int wr, int wc, int fr, int fq) const {
        const int row0 = u.pm * BM + wr * 64 + fr;
#pragma unroll
        EPI_LOOP_ROWS { bf16_t* rowp = O + (size_t)(row0 + ai * HALF + m * 16) * ldc + u.pn * BM + wc * 32 + 8 * fq;
#pragma unroll
            for (int bj = 0; bj < 2; ++bj) store8bf(rowp + bj * HALF, acc[ai][bj][m][0], acc[ai][bj][m][1]); }
    }
};
struct EpiF32 {
    static constexpr bool PERM = false, AFTER_DRAIN = false;
    float* C; const float* base; int ldc;
    __device__ __forceinline__ void operator()(const f32x4 (&acc)[2][2][4][2], const Unit& u, int wr, int wc, int fr, int fq) const {
        const int row0 = u.pm * BM + wr * 64 + fr, col0 = u.pn * BM + wc * 32 + 4 * fq;
#pragma unroll
        EPI_LOOP_ROWS { const size_t off = (size_t)(row0 + ai * HALF + m * 16) * ldc + col0;
#pragma unroll
            for (int bj = 0; bj < 2; ++bj)
#pragma unroll
                for (int n = 0; n < 2; ++n) { f32x4 v = acc[ai][bj][m][n]; if (base) v = v + *(const f32x4*)(base + off + bj * HALF + n * 16); *(f32x4*)(C + off + bj * HALF + n * 16) = v; } }
    }
};
struct EpiQup {
    static constexpr bool PERM = true, AFTER_DRAIN = false;
    bf16_t* Q; const float* CS;
    __device__ __forceinline__ void operator()(const f32x4 (&acc)[2][2][4][2], const Unit& u, int wr, int wc, int fr, int fq) const {
        const int row0 = u.pm * BM + wr * 64 + fr, h = u.pn; const float QS = 0.07216878364870322f * 1.4426950408889634f;
#pragma unroll
        EPI_LOOP_ROWS { const size_t row = (size_t)(row0 + ai * HALF + m * 16); bf16_t* qrow = Q + ((size_t)h * T + row) * MDK;
            store8bf(qrow + wc * 32 + 8 * fq, acc[ai][0][m][0] * QS, acc[ai][0][m][1] * QS);
            if (wc < 2) { const int i0 = wc * 16 + 4 * fq; const f32x4 c = *(const f32x4*)(CS + row * 64 + i0), s = *(const f32x4*)(CS + row * 64 + 32 + i0);
                const f32x4 x1 = acc[ai][1][m][0], x2 = acc[ai][1][m][1];
                store8bf(qrow + 128 + wc * 32 + 8 * fq, (x1 * c - x2 * s) * QS, (x1 * s + x2 * c) * QS); } }
    }
};
struct EpiKVup {
    static constexpr bool PERM = true, AFTER_DRAIN = false;
    bf16_t *K, *V;
    __device__ __forceinline__ void operator()(const f32x4 (&acc)[2][2][4][2], const Unit& u, int wr, int wc, int fr, int fq) const {
        const int row0 = u.pm * BM + wr * 64 + fr, h = u.pn;
#pragma unroll
        EPI_LOOP_ROWS { const size_t row = (size_t)h * T + (size_t)(row0 + ai * HALF + m * 16);
            store8bf(K + row * MDK + wc * 32 + 8 * fq, acc[ai][0][m][0], acc[ai][0][m][1]);
            store8bf(V + row * MDV + wc * 32 + 8 * fq, acc[ai][1][m][0], acc[ai][1][m][1]); }
    }
};
struct EpiMoe1 {
    static constexpr bool PERM = true, AFTER_DRAIN = false;
    bf16_t* H;
    __device__ __forceinline__ void operator()(const f32x4 (&acc)[2][2][4][2], const Unit& u, int wr, int wc, int fr, int fq) const {
        const int row0 = u.pm * BM + wr * 64 + fr, j = u.pn & 15;
#pragma unroll
        EPI_LOOP_ROWS { const size_t eo = (size_t)(row0 + ai * HALF + m * 16) * FF + 128 * j + 16 * wc + 4 * fq; bf16_t* rowp = H + eo;
#pragma unroll
            for (int bj = 0; bj < 2; ++bj) { f32x4 g = acc[ai][bj][m][0], uu = acc[ai][bj][m][1];
                if (MOE_FP8) { g = g * 0.03125f; uu = uu * 0.03125f; *(unsigned*)((unsigned char*)H + eo + 64 * bj) = pk4fp8(siluf(g[0]) * uu[0], siluf(g[1]) * uu[1], siluf(g[2]) * uu[2], siluf(g[3]) * uu[3]); continue; }
                u32x2 w; w.x = cvt_pk_bf16(siluf(g[0]) * uu[0], siluf(g[1]) * uu[1]); w.y = cvt_pk_bf16(siluf(g[2]) * uu[2], siluf(g[3]) * uu[3]);
                *(u32x2*)(rowp + 64 * bj) = w; } }
    }
};
struct EpiMoe2 {
    static constexpr bool PERM = true, AFTER_DRAIN = false;
    bf16_t* Y;
    __device__ __forceinline__ void operator()(const f32x4 (&acc)[2][2][4][2], const Unit& u, int wr, int wc, int fr, int fq) const {
        const int row0 = u.pm * BM + wr * 64 + fr, j = u.pn & 3;
#pragma unroll
        EPI_LOOP_ROWS { bf16_t* rowp = Y + (size_t)(row0 + ai * HALF + m * 16) * D + 256 * j + wc * 32 + 8 * fq;
#pragma unroll
            for (int bj = 0; bj < 2; ++bj) { const float sc = MOE_FP8 ? 0.03125f : 1.0f; store8bf(rowp + bj * HALF, acc[ai][bj][m][0] * sc, acc[ai][bj][m][1] * sc); } }
    }
};

struct EpiQ8 {
    static constexpr bool PERM = true, AFTER_DRAIN = false;
    unsigned char* Q; const float* CS;
    __device__ __forceinline__ void operator()(const f32x4 (&acc)[2][2][4][2], const Unit& u, int wr, int wc, int fr, int fq) const {
        const int row0 = u.pm * BM + wr * 64 + fr, h = u.pn; const float QS = 8.0f * 0.07216878364870322f * 1.4426950408889634f;
#pragma unroll
        EPI_LOOP_ROWS { const size_t row = (size_t)(row0 + ai * HALF + m * 16); unsigned char* qrow = Q + ((size_t)h * T + row) * MDK;
            store8fp8(qrow + wc * 32 + 8 * fq, acc[ai][0][m][0] * QS, acc[ai][0][m][1] * QS);
            if (wc < 2) { const int i0 = wc * 16 + 4 * fq; const f32x4 c = *(const f32x4*)(CS + row * 64 + i0), s = *(const f32x4*)(CS + row * 64 + 32 + i0);
                const f32x4 x1 = acc[ai][1][m][0], x2 = acc[ai][1][m][1];
                store8fp8(qrow + 128 + wc * 32 + 8 * fq, (x1 * c - x2 * s) * QS, (x1 * s + x2 * c) * QS); } }
    }
};
struct EpiK8 {
    static constexpr bool PERM = true, AFTER_DRAIN = false;
    unsigned char* K;
    __device__ __forceinline__ void operator()(const f32x4 (&acc)[2][2][4][2], const Unit& u, int wr, int wc, int fr, int fq) const {
        const int row0 = u.pm * BM + wr * 64 + fr;
#pragma unroll
        EPI_LOOP_ROWS { const size_t row = (size_t)(row0 + ai * HALF + m * 16);
#pragma unroll
            for (int bj = 0; bj < 2; ++bj) store8fp8(K + ((size_t)(2 * u.pn + bj) * T + row) * MDK + wc * 32 + 8 * fq, acc[ai][bj][m][0], acc[ai][bj][m][1]); }
    }
};
struct EpiV8T {
    static constexpr bool PERM = true, AFTER_DRAIN = false;
    unsigned char* V;
    __device__ __forceinline__ void operator()(const f32x4 (&acc)[2][2][4][2], const Unit& u, int wr, int wc, int fr, int fq) const {
        const int row0 = u.pm * BM + wr * 64 + fr;
#pragma unroll
        EPI_LOOP_ROWS { unsigned char* rowp = V + (size_t)(row0 + ai * HALF + m * 16) * T + u.pn * BM + 64 * (wc >> 1) + 16 * (wc & 1) + 4 * fq;
#pragma unroll
            for (int bj = 0; bj < 2; ++bj) { const f32x4 a = acc[ai][bj][m][0], b = acc[ai][bj][m][1];
                *(unsigned*)(rowp + bj * HALF) = pk4fp8(a[0], a[1], a[2], a[3]); *(unsigned*)(rowp + bj * HALF + 32) = pk4fp8(b[0], b[1], b[2], b[3]); } }
    }
};

typedef int i32x4g __attribute__((ext_vector_type(4)));
template <class Epi, class Sched, bool ALIGN_EPI = false, bool SP2 = false, bool F8 = false>
__device__ __forceinline__ void gemm_phase(PG8_LAS unsigned char* lds, const Gemm g, const Sched& S, const Epi& E) {
    const int tid = threadIdx.x, wid = __builtin_amdgcn_readfirstlane(tid >> 6), lane = tid & 63, wr = wid >> 2, wc = wid & 3, fr = lane & 15, fq = lane >> 4;
    int K = g.K; asm volatile("" : "+s"(K));
    const int nt = K / BK;
    unsigned voffA[2], voffB[2];
#pragma unroll
    for (int i = 0; i < 2; ++i) { int R, C; stage_rc(tid * 16 + i * 8192, R, C); const int Rb = Epi::PERM ? ((R & ~31) + perm32(R & 31)) : R;
        voffA[i] = (unsigned)(R * K + C) * 2u; voffB[i] = (unsigned)(Rb * K + C) * 2u; }
    const size_t kstep = (size_t)(BK * 2);
    const size_t hstep = (size_t)HALF * K * 2;
    const size_t tstep = 2 * hstep;
    const unsigned ldsw = (unsigned)wid * 1024u;
    const int aoff = lds_byte(wr * 64 + fr, fq * 8), boff = lds_byte(wc * 32 + fr, fq * 8);
    PG8_LAS unsigned char* const ldsA = lds + aoff; PG8_LAS unsigned char* const ldsB = lds + 4 * HTB + boff;
#define PG8_SA(b, h) (((b) * 2 + (h)) * HTB)
#define PG8_SB(b, h) ((4 + (b) * 2 + (h)) * HTB)
#define PG8_STAGE(bufoff, gbase, voff) do { _Pragma("unroll") for (int _i = 0; _i < 2; ++_i) \
        __builtin_amdgcn_global_load_lds((const unsigned*)((const char*)(gbase) + (voff)[_i]), (PG8_LAS unsigned*)(lds + (bufoff) + ldsw + _i * 8192), 16, 0, 0); } while (0)
#define PG8_LD8(base, off) __builtin_shufflevector(*(const PG8_LAS i32x4g*)((base) + (off)), *(const PG8_LAS i32x4g*)((base) + (off) + 1024), 0, 1, 2, 3, 4, 5, 6, 7)
#define PG8_LDA(dst, b, h) do { _Pragma("unroll") for (int m = 0; m < 4; ++m) { if constexpr (F8) dst##8[m] = PG8_LD8(ldsA, PG8_SA(b, h) + m * 2048); else { _Pragma("unroll") for (int k = 0; k < 2; ++k) dst[m][k] = *(const PG8_LAS bf16x8*)(lds + PG8_SA(b, h) + aoff + m * 2048 + k * 1024); } } } while (0)
#define PG8_LDB(dst, b, h) do { _Pragma("unroll") for (int n = 0; n < 2; ++n) { if constexpr (F8) dst##8[n] = PG8_LD8(ldsB, PG8_SA(b, h) + n * 2048); else { _Pragma("unroll") for (int k = 0; k < 2; ++k) dst[n][k] = *(const PG8_LAS bf16x8*)(lds + PG8_SB(b, h) + boff + n * 2048 + k * 1024); } } } while (0)
#define PG8_CAT(x, y) __builtin_shufflevector((i32x4g)(x), (i32x4g)(y), 0, 1, 2, 3, 4, 5, 6, 7)
#define PG8_MMA(ai, bj, At, Bt) do { __builtin_amdgcn_s_setprio(1); _Pragma("unroll") for (int m = 0; m < 4; ++m) _Pragma("unroll") for (int n = 0; n < 2; ++n) { \
        if constexpr (F8) asm volatile("v_mfma_scale_f32_16x16x128_f8f6f4 %0, %1, %2, %0, %3, %3 op_sel_hi:[0,0,0]" : "+v"(acc[ai][bj][m][n]) : "v"(Bt##8[n]), "v"(At##8[m]), "v"(scl8));     \
        else { _Pragma("unroll") for (int k = 0; k < 2; ++k) acc[ai][bj][m][n] = __builtin_amdgcn_mfma_f32_16x16x32_bf16(Bt[n][k], At[m][k], acc[ai][bj][m][n], 0, 0, 0); } } \
        __builtin_amdgcn_s_setprio(0); } while (0)
#define PG8_WAIT_V(n) asm volatile("s_waitcnt vmcnt(" #n ")" ::: "memory")
#define PG8_WAIT_L(n) asm volatile("s_waitcnt lgkmcnt(" #n ")" ::: "memory")
#define PG8_BAR __builtin_amdgcn_s_barrier()
#define PG8_SCHED __builtin_amdgcn_sched_barrier(0)
    Unit cur, nxt; int ui = 0;
    if (!S.next(0, cur)) return;
    f32x4 acc[2][2][4][2];
#pragma unroll
    for (int a = 0; a < 2; ++a)
#pragma unroll
        for (int b = 0; b < 2; ++b)
#pragma unroll
            for (int m = 0; m < 4; ++m)
#pragma unroll
                for (int n = 0; n < 2; ++n) acc[a][b][m][n] = (f32x4){0.f, 0.f, 0.f, 0.f};
    unsigned scl8 = 0x7f7f7f7fu; asm volatile("" : "+v"(scl8));
    bf16x8 At[4][2], B0[2][2], B1[2][2]; i32x8 At8[4], B08[2], B18[2];
    const char* cA = (const char*)g.A + (size_t)cur.pm * tstep; const char* cB = (const char*)g.Bt + (size_t)cur.pn * tstep;
    S.a_ready(cur);
    if constexpr (SP2) {
        PG8_STAGE(PG8_SB(0, 0), cB, voffB); PG8_STAGE(PG8_SB(0, 1), cB + hstep, voffB); PG8_STAGE(PG8_SA(0, 0), cA, voffA); PG8_STAGE(PG8_SA(0, 1), cA + hstep, voffA);
        if (wr == 1) PG8_BAR;
        PG8_WAIT_V(2); PG8_BAR;
        PG8_STAGE(PG8_SB(1, 0), cB + kstep, voffB); PG8_STAGE(PG8_SA(1, 0), cA + kstep, voffA); PG8_STAGE(PG8_SB(1, 1), cB + hstep + kstep, voffB);
        PG8_WAIT_V(6); PG8_BAR;
    } else {
        PG8_STAGE(PG8_SB(0, 0), cB, voffB); PG8_STAGE(PG8_SA(0, 0), cA, voffA); PG8_STAGE(PG8_SB(0, 1), cB + hstep, voffB); PG8_STAGE(PG8_SA(0, 1), cA + hstep, voffA);
        if (wr == 1) PG8_BAR;
        PG8_WAIT_V(4); PG8_BAR;
        PG8_STAGE(PG8_SB(1, 0), cB + kstep, voffB); PG8_STAGE(PG8_SA(1, 0), cA + kstep, voffA); PG8_STAGE(PG8_SB(1, 1), cB + hstep + kstep, voffB);
        PG8_WAIT_V(6); PG8_BAR;
    }
    for (;;) {
        const bool has_next = S.next(ui + 1, nxt);
        const char* nA = has_next ? (const char*)g.A + (size_t)nxt.pm * tstep : cA; const char* nB = has_next ? (const char*)g.Bt + (size_t)nxt.pn * tstep : cB;
        for (int t = 0; t < nt; t += 2) {
            const bool last = (t == nt - 2);
            const char* a1 = cA + (size_t)(t + 1) * kstep;
            const char* a2 = last ? nA : cA + (size_t)(t + 2) * kstep; const char* b2 = last ? nB : cB + (size_t)(t + 2) * kstep;
            const char* a3 = a2 + kstep; const char* b3 = b2 + kstep;
            if (last && has_next) S.a_ready(nxt);
            if constexpr (SP2) {
            PG8_LDB(B0, 0, 0); PG8_LDB(B1, 0, 1); PG8_SCHED; PG8_LDA(At, 0, 0); PG8_STAGE(PG8_SA(1, 1), a1 + hstep, voffA);
            PG8_WAIT_V(8); PG8_WAIT_L(0); PG8_BAR; PG8_MMA(0, 0, At, B0); PG8_MMA(0, 1, At, B1); PG8_BAR; PG8_SCHED;
            PG8_LDA(At, 0, 1); PG8_STAGE(PG8_SB(0, 0), b2, voffB); PG8_STAGE(PG8_SB(0, 1), b2 + hstep, voffB); PG8_STAGE(PG8_SA(0, 0), a2, voffA);
            PG8_WAIT_V(8); PG8_WAIT_L(0); PG8_BAR; PG8_MMA(1, 0, At, B0); PG8_MMA(1, 1, At, B1); PG8_BAR; PG8_SCHED;
            PG8_LDB(B0, 1, 0); PG8_LDB(B1, 1, 1); PG8_SCHED; PG8_LDA(At, 1, 0); PG8_STAGE(PG8_SA(0, 1), a2 + hstep, voffA);
            PG8_WAIT_V(8); PG8_WAIT_L(0); PG8_BAR; PG8_MMA(0, 0, At, B0); PG8_MMA(0, 1, At, B1); PG8_BAR; PG8_SCHED;
            PG8_LDA(At, 1, 1); PG8_STAGE(PG8_SB(1, 0), b3, voffB); PG8_STAGE(PG8_SB(1, 1), b3 + hstep, voffB); PG8_STAGE(PG8_SA(1, 0), a3, voffA);
            PG8_WAIT_V(8); PG8_WAIT_L(0); PG8_BAR; PG8_MMA(1, 0, At, B0); PG8_MMA(1, 1, At, B1); PG8_BAR; PG8_SCHED;
            } else {
            PG8_LDB(B0, 0, 0); PG8_SCHED; PG8_LDA(At, 0, 0); PG8_STAGE(PG8_SA(1, 1), a1 + hstep, voffA);
            PG8_WAIT_L(8); PG8_BAR; PG8_WAIT_L(0); PG8_MMA(0, 0, At, B0); PG8_BAR; PG8_SCHED;
            PG8_LDB(B1, 0, 1); PG8_STAGE(PG8_SB(0, 0), b2, voffB);
            PG8_BAR; PG8_WAIT_L(0); PG8_MMA(0, 1, At, B1); PG8_BAR;
            PG8_LDA(At, 0, 1); PG8_STAGE(PG8_SA(0, 0), a2, voffA);
            PG8_BAR; PG8_WAIT_L(0); PG8_MMA(1, 0, At, B0); PG8_BAR; PG8_SCHED;
            PG8_STAGE(PG8_SB(0, 1), b2 + hstep, voffB);
            PG8_WAIT_V(6); PG8_BAR; PG8_MMA(1, 1, At, B1); PG8_BAR;
            PG8_LDB(B0, 1, 0); PG8_SCHED; PG8_LDA(At, 1, 0); PG8_STAGE(PG8_SA(0, 1), a2 + hstep, voffA);
            PG8_WAIT_L(8); PG8_BAR; PG8_WAIT_L(0); PG8_MMA(0, 0, At, B0); PG8_BAR; PG8_SCHED;
            PG8_LDB(B1, 1, 1); PG8_STAGE(PG8_SB(1, 0), b3, voffB);
            PG8_BAR; PG8_WAIT_L(0); PG8_MMA(0, 1, At, B1); PG8_BAR;
            PG8_LDA(At, 1, 1); PG8_STAGE(PG8_SA(1, 0), a3, voffA);
            PG8_BAR; PG8_WAIT_L(0); PG8_MMA(1, 0, At, B0); PG8_BAR; PG8_SCHED;
            PG8_STAGE(PG8_SB(1, 1), b3 + hstep, voffB);
            PG8_WAIT_V(6); PG8_BAR; PG8_MMA(1, 1, At, B1); PG8_BAR;
            }
        }
        if constexpr (F8) asm volatile("s_nop 15\n\ts_nop 15" ::: "memory");
        if constexpr (ALIGN_EPI) { if (wr == 0) PG8_BAR; }
        if constexpr (!Epi::AFTER_DRAIN) { E(acc, cur, wr, wc, fr, fq); S.done(cur); }
        if (!has_next) break;
#pragma unroll
        for (int a = 0; a < 2; ++a)
#pragma unroll
            for (int b = 0; b < 2; ++b)
#pragma unroll
                for (int m = 0; m < 4; ++m)
#pragma unroll
                    for (int n = 0; n < 2; ++n) acc[a][b][m][n] = (f32x4){0.f, 0.f, 0.f, 0.f};
        cur = nxt; cA = nA; cB = nB; ++ui;
        if constexpr (ALIGN_EPI) { if (wr == 1) PG8_BAR; }
    }
    PG8_WAIT_V(0);
    if constexpr (!ALIGN_EPI) { if (wr == 0) PG8_BAR; }
    PG8_BAR;
    if constexpr (Epi::AFTER_DRAIN) { E.fused(acc, cur, wr, wc, fr, fq, lds, wid, lane); S.done(cur); }
#undef PG8_SA
#undef PG8_SB
#undef PG8_STAGE
#undef PG8_LDA
#undef PG8_LD8
#undef PG8_LDB
#undef PG8_MMA
#undef PG8_CAT
#undef PG8_WAIT_V
#undef PG8_WAIT_L
#undef PG8_BAR
#undef PG8_SCHED
}
}
#define XB_TMO      128
#define XB_XCNT(j)  (256  + 64 * (j))
#define XB_XSUB(j)  (1280 + 64 * (j))
#define XB_XGEN(j)  (2304 + 64 * (j))
#define XB_TOP      3328
#define XB_TOPGEN   3392
#define XCD_BAR_WORDS 3456
#define XB_SPIN_CAP (1u << 18)

__device__ __forceinline__ unsigned xb_ld(unsigned* p)              { return __hip_atomic_load(p, __ATOMIC_RELAXED, __HIP_MEMORY_SCOPE_AGENT); }
__device__ __forceinline__ unsigned xb_add(unsigned* p, unsigned v) { return __hip_atomic_fetch_add(p, v, __ATOMIC_RELAXED, __HIP_MEMORY_SCOPE_AGENT); }
__device__ __forceinline__ unsigned xb_xcc_id() { return (unsigned)__builtin_amdgcn_s_getreg((3 << 11) | 20) & 0xFu; }
#define XB_SPIN(cond, bar) do { unsigned _sp = 0; while (cond) { __builtin_amdgcn_s_sleep(1); \
    if ((++_sp & 255u) == 0u) { if (xb_ld(&(bar)[XB_TMO])) break; if (_sp > XB_SPIN_CAP) { atomicAdd(&(bar)[XB_TMO], 1u); break; } } } } while (0)

struct XcdBarrier {
    unsigned* bar; unsigned x;
    volatile LAS unsigned* st;
};

__device__ __forceinline__ XcdBarrier xcd_barrier_post(unsigned* bar, volatile LAS unsigned* st) {
    XcdBarrier b; b.bar = bar; b.x = xb_xcc_id(); b.st = st;
    if (threadIdx.x == 0) (void)xb_add(&bar[XB_XCNT(b.x)], 1u);
    return b;
}
__device__ __forceinline__ void xcd_barrier_complete(unsigned* bar, unsigned x, unsigned& nloc, unsigned& nx) {
    const unsigned G = gridDim.x * gridDim.y * gridDim.z;
    unsigned sum, cnt, mine, sp = 0u;
    for (;;) {
        sum = 0u; cnt = 0u; mine = 0u;
#pragma unroll
        for (unsigned j = 0; j < 16; ++j) { const unsigned c = xb_ld(&bar[XB_XCNT(j)]); sum += c; cnt += (c > 0u) ? 1u : 0u; mine = (j == x) ? c : mine; }
        if (sum == G) break;
        __builtin_amdgcn_s_sleep(1);
        if ((++sp & 255u) == 0u) { if (xb_ld(&bar[XB_TMO])) break; if (sp > XB_SPIN_CAP) { atomicAdd(&bar[XB_TMO], 1u); break; } }
    }
    nloc = mine > 0u ? mine : 1u; nx = cnt > 0u ? cnt : 1u;
}

__device__ __forceinline__ void xcd_barrier(const XcdBarrier& b) {
    asm volatile("s_waitcnt vmcnt(0)" ::: "memory");
    __syncthreads();
    if (threadIdx.x == 0) {
        unsigned* bar = b.bar;
        __builtin_amdgcn_s_waitcnt(0);
        unsigned nloc = b.st[0], nx = b.st[1];
        if (nloc == 0u) { xcd_barrier_complete(bar, b.x, nloc, nx); b.st[0] = nloc; b.st[1] = nx; }
        const unsigned old = xb_add(&bar[XB_XSUB(b.x)], 1u);
        const unsigned gen = old / nloc;
        if (old + 1u == (gen + 1u) * nloc) {
            __builtin_amdgcn_fence(__ATOMIC_RELEASE, "agent");
            asm volatile("s_waitcnt vmcnt(0)" ::: "memory");
            const unsigned og = xb_add(&bar[XB_TOP], 1u);
            const unsigned tg = og / nx;
            if (og + 1u == (tg + 1u) * nx) xb_add(&bar[XB_TOPGEN], 1u);
            else XB_SPIN(xb_ld(&bar[XB_TOPGEN]) == tg, bar);
            __builtin_amdgcn_fence(__ATOMIC_ACQUIRE, "agent");
            xb_add(&bar[XB_XGEN(b.x)], 1u);
            asm volatile("s_waitcnt vmcnt(0)" ::: "memory");
        } else {
            XB_SPIN(xb_ld(&bar[XB_XGEN(b.x)]) == gen, bar);
            __builtin_amdgcn_fence(__ATOMIC_ACQUIRE, "agent");
            asm volatile("s_waitcnt vmcnt(0)" ::: "memory");
        }
    }
    __syncthreads();
}

#ifndef PG8_SP2
#define PG8_SP2 true
#endif
#ifndef PG8_ALIGN
#define PG8_ALIGN true
#endif

struct Args { const void* in[22]; float* out; unsigned char* ws; float invf[32]; int ph_lo, ph_hi, li, pad; };
struct Ctx { int tid, lane, wave, gw, ngw, bid, nb; unsigned char* lds; };

struct MapId { int off; __device__ __forceinline__ int operator()(int n) const { return off + n; } };
struct MapGU { int which; __device__ __forceinline__ int operator()(int f) const { return 8 * (f >> 2) + 4 * which + (f & 3); } };
struct MapUkv { __device__ __forceinline__ int operator()(int n) const { const int h = n >> 8, j = n & 255; return ATT_FP8 ? (j < 128 ? 128 * h + j : 2048 + 128 * h + (j - 128)) : n; } };
struct MapUq { __device__ __forceinline__ int operator()(int n) const { const int h = n / 192, j = n - h * 192;
    if (j < 128) return 256 * h + j; if (j < 160) { const int i = j - 128; return 256 * h + 128 + 8 * (i >> 2) + (i & 3); } const int i = j - 160; return 256 * h + 128 + 8 * (i >> 2) + 4 + (i & 3); } };
constexpr int TR_SCR = 16896;
__device__ __forceinline__ void tr_load(const float* W, int ldw, int k0, int n0, f32x4 (&v)[16], int lane) {
#pragma unroll
    for (int i = 0; i < 16; ++i) v[i] = *(const f32x4*)(W + (size_t)(k0 + (lane >> 4) + 4 * i) * ldw + n0 + 4 * (lane & 15));
}
template <class RM, bool F8 = false>
__device__ __forceinline__ void tr_flush(const f32x4 (&v)[16], bf16_t* WT, int ldt, int k0, int nloc0, const RM& rm, float* scr, int lane) {
    const int nb = 4 * (lane & 15), kq = lane >> 4;
#pragma unroll
    for (int i = 0; i < 16; ++i) { float* d = scr + nb * 65 + kq + 4 * i; d[0] = v[i][0]; d[65] = v[i][1]; d[130] = v[i][2]; d[195] = v[i][3]; }
    LDS_WAIT();
    const int c = lane & 7;
#pragma unroll
    for (int j = 0; j < 8; ++j) { const int n = (lane >> 3) + 8 * j; const float* q = scr + n * 65 + 8 * c;
        if constexpr (F8) { u32x2 o; o.x = pk4fp8(q[0] * 32.f, q[1] * 32.f, q[2] * 32.f, q[3] * 32.f); o.y = pk4fp8(q[4] * 32.f, q[5] * 32.f, q[6] * 32.f, q[7] * 32.f);
            *(u32x2*)((unsigned char*)WT + (size_t)rm(nloc0 + n) * ldt + k0 + 8 * c) = o; }
        else { u32x4 o; o.x = cvt_pk_bf16(q[0], q[1]); o.y = cvt_pk_bf16(q[2], q[3]); o.z = cvt_pk_bf16(q[4], q[5]); o.w = cvt_pk_bf16(q[6], q[7]);
        *(u32x4*)(WT + (size_t)rm(nloc0 + n) * ldt + k0 + 8 * c) = o; } }
    LDS_WAIT();
}
template <class RM>
__device__ __forceinline__ void tr_job(const Ctx& C, int& base, const float* W, int ldw, int K, int ncol0, int ncols, bf16_t* WT, int ldt, const RM& rm) {
    const int nblk = ncols / 64, items = (K / 64) * nblk; float* scr = (float*)(C.lds + C.wave * TR_SCR);
    int first = (C.gw - base % C.ngw + C.ngw) % C.ngw;
    for (int it = first; it < items; it += C.ngw) { const int kb = it / nblk, nb = it - kb * nblk; f32x4 v[16]; tr_load(W, ldw, 64 * kb, ncol0 + 64 * nb, v, C.lane); tr_flush(v, WT, ldt, 64 * kb, 64 * nb, rm, scr, C.lane); }
    base += items;
}
__device__ __forceinline__ void ph_convert_small(const Ctx& C, const Args& a, unsigned char* ws) {
    const float* w_in = (const float*)a.in[5]; int base = 0;
    bf16_t* WGIN = (bf16_t*)(ws + WS_WGIN);
    tr_job(C, base, w_in, 3104, 1024, 0, 1024, WGIN, 1024, MapId{0});
    tr_job(C, base, w_in, 3104, 1024, 1024, 1024, (bf16_t*)(ws + WS_WV), 1024, MapId{0});
    tr_job(C, base, w_in, 3104, 1024, 2048, 1024, WGIN, 1024, MapId{1024});
    tr_job(C, base, (const float*)a.in[11], 1024, 1024, 0, 1024, (bf16_t*)(ws + WS_WGOUT), 1024, MapId{0});
    tr_job(C, base, (const float*)a.in[12], 448, 1024, 0, 448, (bf16_t*)(ws + WS_WMIN), 1024, MapId{0});
    tr_job(C, base, (const float*)a.in[14], 3072, 256, 0, 3072, (bf16_t*)(ws + WS_WUQ), 256, MapUq{});
    tr_job(C, base, (const float*)a.in[16], 4096, 128, 0, 4096, (bf16_t*)(ws + WS_WUKV), 256, MapUkv{});
    tr_job(C, base, (const float*)a.in[17], 1024, 2048, 0, 1024, (bf16_t*)(ws + WS_WMOUT), 2048, MapId{0});
    const int gt = C.bid * 512 + C.tid, ngt = C.nb * 512;
    for (int it = gt; it < 1024 * 128; it += ngt) { const int cp = it >> 7, k8 = it & 127, dir = cp >> 9, c = cp & 511;
        const float* wg = (const float*)a.in[dir ? 8 : 6]; float wj[16];
#pragma unroll
        for (int j = 0; j < 16; ++j) wj[j] = wg[j * 512 + c];
        float o[8];
#pragma unroll
        for (int kk = 0; kk < 8; ++kk) { const float* wr = w_in + (size_t)(8 * k8 + kk) * 3104 + 3072 + 16 * dir; float s = 0.f;
#pragma unroll
            for (int j4 = 0; j4 < 4; ++j4) { const f32x4 x = *(const f32x4*)(wr + 4 * j4); s += x[0] * wj[4 * j4] + x[1] * wj[4 * j4 + 1] + x[2] * wj[4 * j4 + 2] + x[3] * wj[4 * j4 + 3]; }
            o[kk] = s; }
        u32x4 w; w.x = cvt_pk_bf16(o[0], o[1]); w.y = cvt_pk_bf16(o[2], o[3]); w.z = cvt_pk_bf16(o[4], o[5]); w.w = cvt_pk_bf16(o[6], o[7]);
        *(u32x4*)(WGIN + (size_t)(2048 + cp) * 1024 + 8 * k8) = w; }
    const u32x4 z = {0u, 0u, 0u, 0u};
    for (int it = gt; it < 64 * 128; it += ngt) *(u32x4*)((bf16_t*)(ws + WS_WMIN) + (size_t)448 * 1024 + (size_t)it * 8) = z;
    for (int it = gt; it < 16 * 64 * 32; it += ngt) { const int h = it >> 11, r = (it >> 5) & 63, c8 = it & 31; *(u32x4*)((bf16_t*)(ws + WS_WUQ) + (size_t)(256 * h + 192 + r) * 256 + c8 * 8) = z; }
    for (int it = gt; it < 4096 * 16; it += ngt) { const int r = it >> 4, c8 = it & 15; *(u32x4*)((bf16_t*)(ws + WS_WUKV) + (size_t)r * 256 + 128 + c8 * 8) = z; }
}
struct MapMoe { int kind; __device__ __forceinline__ int operator()(int f) const { return kind < 2 ? 8 * (f >> 2) + 4 * kind + (f & 3) : f; } };
struct MoeItem { const float* src; bf16_t* dst; int ldw, ldt, k0, n0, kind; };
__device__ __forceinline__ MoeItem moe_item(const Args& a, unsigned char* ws, int layer, int it) {
    const int e = it / 1536, r = it - e * 1536, which = r >> 9, j = r & 511; const size_t le = (size_t)(layer * NE + e); MoeItem m; m.kind = which;
    if (which < 2) { m.src = (const float*)a.in[19 + which] + le * 1024 * 2048; m.ldw = 2048; m.dst = (bf16_t*)(ws + WS_WGU + (size_t)e * 4096 * 1024 * (MOE_FP8 ? 1 : 2)); m.ldt = 1024; m.k0 = 64 * (j >> 5); m.n0 = 64 * (j & 31); }
    else { m.src = (const float*)a.in[21] + le * 2048 * 1024; m.ldw = 1024; m.dst = (bf16_t*)(ws + WS_WD + (size_t)e * 1024 * 2048 * (MOE_FP8 ? 1 : 2)); m.ldt = 2048; m.k0 = 64 * (j >> 4); m.n0 = 64 * (j & 15); }
    return m;
}
__device__ __forceinline__ void ph_convert_moe(const Ctx& C, const Args& a, unsigned char* ws, int layer, int rep) {
    constexpr int NIT1 = NE * 1536; const int NIT = NIT1 * rep; float* scr = (float*)(C.lds + C.wave * TR_SCR);
    int it = C.gw; if (it >= NIT) return;
    f32x4 va[16], vb[16]; MoeItem ma = moe_item(a, ws, layer, it % NIT1), mb = ma; tr_load(ma.src, ma.ldw, ma.k0, ma.n0, va, C.lane);
    for (;;) {
        int nx = it + C.ngw; if (nx < NIT) { mb = moe_item(a, ws, layer, nx % NIT1); tr_load(mb.src, mb.ldw, mb.k0, mb.n0, vb, C.lane); }
        tr_flush<MapMoe, MOE_FP8 != 0>(va, ma.dst, ma.ldt, ma.k0, ma.n0, MapMoe{ma.kind}, scr, C.lane);
        it = nx; if (it >= NIT) break;
        nx = it + C.ngw; if (nx < NIT) { ma = moe_item(a, ws, layer, nx % NIT1); tr_load(ma.src, ma.ldw, ma.k0, ma.n0, va, C.lane); }
        tr_flush<MapMoe, MOE_FP8 != 0>(vb, mb.dst, mb.ldt, mb.k0, mb.n0, MapMoe{mb.kind}, scr, C.lane);
        it = nx; if (it >= NIT) break;
    }
}

__device__ __forceinline__ void row_load(const float* row, int lane, f32x4 (&v)[4]) {
#pragma unroll
    for (int j = 0; j < 4; ++j) v[j] = *(const f32x4*)(row + 256 * j + 4 * lane); }
__device__ __forceinline__ float row_rstd(const f32x4 (&v)[4]) { float s = 0.f;
#pragma unroll
    for (int j = 0; j < 4; ++j) s += (v[j][0] * v[j][0] + v[j][1] * v[j][1]) + (v[j][2] * v[j][2] + v[j][3] * v[j][3]);
    return 1.0f / sqrtf(wave_sum(s) * (1.0f / 1024.0f) + RMS_EPS); }
__device__ __forceinline__ void row_store_bf(bf16_t* row, int lane, const f32x4 (&v)[4]) {
#pragma unroll
    for (int j = 0; j < 4; ++j) { u32x2 w; w.x = cvt_pk_bf16(v[j][0], v[j][1]); w.y = cvt_pk_bf16(v[j][2], v[j][3]); *(u32x2*)(row + 256 * j + 4 * lane) = w; } }

__device__ __forceinline__ void ph_norm(const Ctx& C, const float* src, const float* gain, bf16_t* XN) {
    f32x4 g[4]; row_load(gain, C.lane, g);
    for (int t = C.gw; t < T; t += C.ngw) { f32x4 v[4]; row_load(src + (size_t)t * D, C.lane, v); const float r = row_rstd(v);
#pragma unroll
        for (int j = 0; j < 4; ++j) v[j] = v[j] * r * g[j];
        row_store_bf(XN + (size_t)t * D, C.lane, v); }
}
__device__ __forceinline__ void ph_router(const Ctx& C, const float* Hin, const float* gain, const float* Wr, bf16_t* XN, float* AFF, float* AFFT, unsigned char* XN8) {
    f32x4* Wl = (f32x4*)C.lds;
    for (int idx = C.tid; idx < 4096; idx += 512) { const int l = idx & 63, e4 = (idx >> 6) & 3, i = (idx >> 8) & 3, j = idx >> 10; Wl[idx] = *(const f32x4*)(Wr + (size_t)(256 * j + 4 * l + i) * 16 + 4 * e4); }
    __syncthreads();
    f32x4 g[4]; row_load(gain, C.lane, g);
    for (int t = C.gw; t < T; t += C.ngw) {
        f32x4 v[4]; row_load(Hin + (size_t)t * D, C.lane, v); const float r = row_rstd(v);
#pragma unroll
        for (int j = 0; j < 4; ++j) v[j] = v[j] * r * g[j];
#if MOE_FP8
#pragma unroll
        for (int j = 0; j < 4; ++j) *(unsigned*)(XN8 + (size_t)t * D + 256 * j + 4 * C.lane) = pk4fp8(v[j][0], v[j][1], v[j][2], v[j][3]);
#ifdef DBG
        row_store_bf(XN + (size_t)t * D, C.lane, v);
#endif
#else
        row_store_bf(XN + (size_t)t * D, C.lane, v);
#endif
        float p[16];
#pragma unroll
        for (int e = 0; e < 16; ++e) p[e] = 0.f;
#pragma unroll
        for (int j = 0; j < 4; ++j)
#pragma unroll
            for (int i = 0; i < 4; ++i) { const float x = v[j][i];
#pragma unroll
                for (int e4 = 0; e4 < 4; ++e4) { const f32x4 w = Wl[((j * 4 + i) * 4 + e4) * 64 + C.lane]; p[4 * e4] += x * w[0]; p[4 * e4 + 1] += x * w[1]; p[4 * e4 + 2] += x * w[2]; p[4 * e4 + 3] += x * w[3]; }  asm volatile("" ::: "memory"); }
        float mx = -1e30f;
#pragma unroll
        for (int e = 0; e < 16; ++e) { p[e] = wave_sum(p[e]); mx = fmaxf(mx, p[e]); }
        float s = 0.f;
#pragma unroll
        for (int e = 0; e < 16; ++e) { p[e] = expf(p[e] - mx); s += p[e]; }
        const float inv = 1.0f / s; float mine = 0.f;
#pragma unroll
        for (int e = 0; e < 16; ++e) mine = (C.lane == e) ? p[e] * inv : mine;
        if (C.lane < 16) { AFF[(size_t)t * 16 + C.lane] = mine; AFFT[(size_t)C.lane * T + t] = mine; }
    }
    __syncthreads();
}
__device__ __forceinline__ void ph_select(const Ctx& C, const float* AFFT, int* SEL, int* IDX) {
    if (C.bid >= NE) return;
    const int e = C.bid; unsigned* vals = (unsigned*)C.lds; unsigned* hist = vals + T; unsigned* sh = hist + 256;
    for (int i = C.tid; i < T; i += 512) vals[i] = __float_as_uint(AFFT[(size_t)e * T + i]);
    __syncthreads();
    unsigned prefix = 0u, mask = 0u, remaining = CAP;
    for (int pass = 0; pass < 4; ++pass) { const int shift = 24 - 8 * pass;
        if (C.tid < 256) hist[C.tid] = 0u;
        __syncthreads();
        for (int i = C.tid; i < T; i += 512) { const unsigned v = vals[i]; if ((v & mask) == prefix) atomicAdd(&hist[(v >> shift) & 255u], 1u); }
        __syncthreads();
        if (C.wave == 0) {
            unsigned cb[4]; unsigned tl = 0u;
#pragma unroll
            for (int j = 0; j < 4; ++j) { cb[j] = hist[255 - (4 * C.lane + j)]; tl += cb[j]; }
            unsigned incl = tl;
#pragma unroll
            for (int o = 1; o < 64; o <<= 1) { const unsigned tt = __shfl_up(incl, o); if (C.lane >= o) incl += tt; }
            unsigned cum = incl - tl;
            if (cum < remaining && remaining <= incl) {
#pragma unroll
                for (int j = 0; j < 4; ++j) { if (cum < remaining && cum + cb[j] >= remaining) { sh[0] = (unsigned)(255 - (4 * C.lane + j)); sh[1] = remaining - cum; } cum += cb[j]; } } }
        __syncthreads();
        prefix |= sh[0] << shift; mask |= 255u << shift; remaining = sh[1];
        __syncthreads();
    }
    const unsigned thr = prefix, ntie = remaining;
    unsigned cg = 0u, ce = 0u;
    for (int i = 0; i < 32; ++i) { const unsigned v = vals[C.tid + 512 * i]; cg += v > thr; ce += v == thr; }
    unsigned sg = cg, se = ce;
#pragma unroll
    for (int o = 1; o < 64; o <<= 1) { const unsigned tg = __shfl_up(sg, o), te = __shfl_up(se, o); if (C.lane >= o) { sg += tg; se += te; } }
    if (C.lane == 63) { sh[16 + C.wave] = sg; sh[32 + C.wave] = se; }
    __syncthreads();
    unsigned og = 0u, oe = 0u, totg = 0u;
    for (int w = 0; w < 8; ++w) { const unsigned a = sh[16 + w], b = sh[32 + w]; if (w < C.wave) { og += a; oe += b; } totg += a; }
    unsigned pg = og + sg - cg, pe = oe + se - ce;
    for (int i = 0; i < 32; ++i) { const int t = C.tid + 512 * i; const unsigned v = vals[t]; int slot = -1;
        if (v > thr) slot = (int)pg++; else if (v == thr) { if (pe < ntie) slot = (int)(totg + pe); ++pe; }
        SEL[(size_t)t * 16 + e] = slot + 1; if (slot >= 0) IDX[e * CAP + slot] = t; }
}
__device__ __forceinline__ void ph_gather(const Ctx& C, const int* IDX, const bf16_t* XN, bf16_t* XS, const unsigned char* XN8) {
    for (int r = C.gw; r < NE * CAP; r += C.ngw) { const int t = IDX[r];
        if (MOE_FP8) { ((u32x4*)((unsigned char*)XS + (size_t)r * D))[C.lane] = ((const u32x4*)(XN8 + (size_t)t * D))[C.lane]; }
        else { const u32x4* s = (const u32x4*)(XN + (size_t)t * D); u32x4* d = (u32x4*)(XS + (size_t)r * D); const u32x4 a = s[C.lane], b = s[C.lane + 64]; d[C.lane] = a; d[C.lane + 64] = b; } }
}
template <int MODE>
__device__ __forceinline__ void ph_combine(const Ctx& C, const float* Hin, const float* AFF, const int* SEL, const bf16_t* Y, float* Hout, const float* gain, bf16_t* XN, float* OUT) {
    f32x4 g[4]; row_load(gain, C.lane, g);
    for (int t = C.gw; t < T; t += C.ngw) {
        f32x4 v[4]; row_load(Hin + (size_t)t * D, C.lane, v);
        const int sel = SEL[(size_t)t * 16 + (C.lane & 15)]; const float af = AFF[(size_t)t * 16 + (C.lane & 15)];
#pragma unroll
        for (int e = 0; e < 16; ++e) { const int s = __builtin_amdgcn_readlane(sel, e);
            if (s) { const float a = __uint_as_float(__builtin_amdgcn_readlane(__float_as_uint(af), e)); const bf16_t* y = Y + ((size_t)e * CAP + (s - 1)) * D + 4 * C.lane;
#pragma unroll
                for (int j = 0; j < 4; ++j) { const u32x2 w = *(const u32x2*)(y + 256 * j); v[j][0] += a * bf_lo(w.x); v[j][1] += a * bf_hi(w.x); v[j][2] += a * bf_lo(w.y); v[j][3] += a * bf_hi(w.y); } } }
        if (MODE == 1) {
#pragma unroll
            for (int j = 0; j < 4; ++j) *(f32x4*)(Hout + (size_t)t * D + 256 * j + 4 * C.lane) = v[j]; }
        const float r = row_rstd(v);
#pragma unroll
        for (int j = 0; j < 4; ++j) v[j] = v[j] * r * g[j];
        if (MODE == 1) row_store_bf(XN + (size_t)t * D, C.lane, v);
        else {
#pragma unroll
            for (int j = 0; j < 4; ++j) *(f32x4*)(OUT + (size_t)t * D + 256 * j + 4 * C.lane) = v[j]; }
    }
}

#define MFMA32(a, b, c) __builtin_amdgcn_mfma_f32_32x32x16_bf16((a), (b), (c), 0, 0, 0)
__device__ __forceinline__ int crow(int r, int hi) { return (r & 3) + 8 * (r >> 2) + 4 * hi; }
__device__ __forceinline__ bf16x8 ldfrag(const bf16_t* p) { return *(const bf16x8*)p; }

__device__ __forceinline__ void ph_gla_prep(const Ctx& C, const bf16_t* Q0, const bf16_t* K0, const float* GF, const float* GB,
                                            bf16_t* QDF, bf16_t* QDB, bf16_t* KDF, bf16_t* KDB, bf16_t* KTF, bf16_t* KTB, float* EGL) {
    float* tot = (float*)C.lds;
    const int o = C.wave, l = C.lane; int par = 0;
    for (int c = C.bid; c < GNC; c += C.nb) { const int t0 = c * GC + 8 * o;
        for (int cb = 0; cb < 8; ++cb, par ^= 1) { const int ch = cb * 64 + l; const size_t off0 = (size_t)t0 * 512 + ch;
            float gf[8], gb[8], q[8], k[8];
#pragma unroll
            for (int i = 0; i < 8; ++i) { const size_t of = off0 + (size_t)i * 512; gf[i] = GF[of]; gb[i] = GB[of]; q[i] = bf2f(Q0[of]); k[i] = bf2f(K0[of]); }
            float sf = 0.f, sb = 0.f;
#pragma unroll
            for (int i = 0; i < 8; ++i) { sf += gf[i]; gf[i] = sf; }
#pragma unroll
            for (int i = 7; i >= 0; --i) { sb += gb[i]; gb[i] = sb; }
            float* tp = tot + par * 1024; tp[o * 64 + l] = sf; tp[512 + o * 64 + l] = sb;
            __syncthreads();
            float offf = 0.f, offb = 0.f, allf = 0.f, allb = 0.f;
#pragma unroll
            for (int oo = 0; oo < 8; ++oo) { const float a = tp[oo * 64 + l], b = tp[512 + oo * 64 + l]; offf += (oo < o) ? a : 0.f; offb += (oo > o) ? b : 0.f; allf += a; allb += b; }
            unsigned pf[4], pb[4];
#pragma unroll
            for (int i = 0; i < 8; i += 2) { float kdf[2], kdb[2];
#pragma unroll
                for (int u = 0; u < 2; ++u) { const size_t of = off0 + (size_t)(i + u) * 512; const float ef = __expf(offf + gf[i + u]), eb = __expf(offb + gb[i + u]);
                    kdf[u] = k[i + u] * __builtin_amdgcn_rcpf(ef); kdb[u] = k[i + u] * __builtin_amdgcn_rcpf(eb);
                    QDF[of] = f2bf(q[i + u] * ef); QDB[of] = f2bf(q[i + u] * eb); KDF[of] = f2bf(kdf[u]); KDB[of] = f2bf(kdb[u]); }
                pf[i >> 1] = cvt_pk_bf16(kdf[0], kdf[1]); pb[i >> 1] = cvt_pk_bf16(kdb[0], kdb[1]); }
            *(u32x4*)(KTF + (size_t)ch * T + t0) = (u32x4){pf[0], pf[1], pf[2], pf[3]};
            *(u32x4*)(KTB + (size_t)ch * T + t0) = (u32x4){pb[0], pb[1], pb[2], pb[3]};
            if (o == 0) { EGL[(size_t)c * 512 + ch] = __expf(allf); EGL[(size_t)(GNC + c) * 512 + ch] = __expf(allb); }
        }
    }
    __syncthreads();
}
__device__ __forceinline__ void ph_gla_u(const Ctx& C, const bf16_t* VT, const bf16_t* KTF, const bf16_t* KTB, const float* EGL, bf16_t* U) {
    const int r = C.lane & 31, hh = C.lane >> 5;
    for (int it = C.gw; it < 2 * GH * GNC * 8; it += C.ngw) { const int w = it & 7, unit = it >> 3, c = unit % GNC, h = (unit / GNC) % GH, dir = unit / (GNC * GH); const int t0 = c * GC;
        const bf16_t* KT = dir ? KTB : KTF; const bf16_t* ap = VT + (size_t)(256 * h + 32 * w + r) * T + t0 + 8 * hh;
        bf16x8 a[4];
#pragma unroll
        for (int s = 0; s < 4; ++s) a[s] = ldfrag(ap + 16 * s);
        bf16_t* Ub = U + ((size_t)(dir * GH + h) * GNC + c) * (GDV * GDK);
#pragma unroll
        for (int j = 0; j < 4; ++j) { f32x16 acc = {}; const bf16_t* bp = KT + (size_t)(128 * h + 32 * j + r) * T + t0 + 8 * hh;
#pragma unroll
            for (int s = 0; s < 4; ++s) acc = MFMA32(a[s], ldfrag(bp + 16 * s), acc);
            const float eg = EGL[(size_t)(dir * GNC + c) * 512 + 128 * h + 32 * j + r];
#pragma unroll
            for (int q = 0; q < 16; ++q) Ub[(size_t)(32 * w + crow(q, hh)) * GDK + 32 * j + r] = f2bf(acc[q] * eg); }
    }
}
__device__ __forceinline__ void ph_gla_scan(const Ctx& C, const bf16_t* U, const float* EGL, bf16_t* ST) {
    if (C.tid >= 256) return;
    for (int el = C.bid * 256 + C.tid; el < 2 * GH * GDV * (GDK / 4); el += C.nb * 256) { const int dk4 = el & 31, dv = (el >> 5) & 255, h = (el >> 13) & 3, dir = el >> 15;
        const size_t eb = (size_t)(dir * GH + h) * GNC * (GDV * GDK) + (size_t)dv * GDK + 4 * dk4; const float* eg = EGL + (size_t)dir * GNC * 512 + 128 * h + 4 * dk4;
        float s0 = 0.f, s1 = 0.f, s2 = 0.f, s3 = 0.f;
#pragma unroll 16
        for (int i = 0; i < GNC; ++i) { const int c = dir ? GNC - 1 - i : i; const size_t o = eb + (size_t)c * (GDV * GDK);
            const u32x2 u = *(const u32x2*)(U + o); const f32x4 d = *(const f32x4*)(eg + (size_t)c * 512);
            u32x2 w; w.x = cvt_pk_bf16(s0, s1); w.y = cvt_pk_bf16(s2, s3); *(u32x2*)(ST + o) = w;
            s0 = d[0] * s0 + bf_lo(u.x); s1 = d[1] * s1 + bf_hi(u.x); s2 = d[2] * s2 + bf_lo(u.y); s3 = d[3] * s3 + bf_hi(u.y); }
    }
}
__device__ __forceinline__ void ph_gla_out(const Ctx& C, const bf16_t* QDF, const bf16_t* QDB, const bf16_t* KDF, const bf16_t* KDB, const bf16_t* VT, const bf16_t* ST,
                                           const bf16_t* SR, const float* hnorm, bf16_t* OG) {
    constexpr int ACS = 72, TS = 272, TB = 64 * TS;
    unsigned char* TL = C.lds;
    bf16_t* AC = (bf16_t*)(C.lds + 4 * TB); float* SSQ = (float*)(C.lds + 4 * TB + 64 * ACS * 2);
    const int w = C.wave, r = C.lane & 31, hh = C.lane >> 5;
    for (int unit = C.bid; unit < GH * GNC; unit += C.nb) { const int h = unit / GNC, c = unit % GNC, t0 = c * GC;
        bf16x8 bs[2][8], bv[4];
#pragma unroll
        for (int dir = 0; dir < 2; ++dir) { const bf16_t* sp = ST + ((size_t)(dir * GH + h) * GNC + c) * (GDV * GDK) + (size_t)(32 * w + r) * GDK + 8 * hh;
#pragma unroll
            for (int s = 0; s < 8; ++s) bs[dir][s] = ldfrag(sp + 16 * s); }
        { const bf16_t* vp = VT + (size_t)(256 * h + 32 * w + r) * T + t0 + 8 * hh;
#pragma unroll
            for (int s = 0; s < 4; ++s) bv[s] = ldfrag(vp + 16 * s); }
        {
            u32x4 v[8];
#pragma unroll
            for (int q = 0; q < 8; ++q) { const int tile = q >> 1, ck = C.tid + 512 * (q & 1), row = ck >> 4, cc = ck & 15; const bf16_t* src = tile == 0 ? QDF : tile == 1 ? QDB : tile == 2 ? KDF : KDB;
                v[q] = *(const u32x4*)(src + (size_t)(t0 + row) * 512 + 128 * h + 8 * cc); }
#pragma unroll
            for (int q = 0; q < 8; ++q) { const int tile = q >> 1, ck = C.tid + 512 * (q & 1), row = ck >> 4, cc = ck & 15; *(u32x4*)(TL + tile * TB + row * TS + 16 * cc) = v[q]; }
        }
        __syncthreads();
        {
            const int dir = w >> 2, ti = (w >> 1) & 1, si = w & 1;
            if (!((dir == 0 && ti == 0 && si == 1) || (dir == 1 && ti == 1 && si == 0))) {
                const unsigned char* qp = TL + dir * TB + (32 * ti + r) * TS + 16 * hh; const unsigned char* kp = TL + (2 + dir) * TB + (32 * si + r) * TS + 16 * hh;
                f32x16 acc = {};
#pragma unroll
                for (int s = 0; s < 8; ++s) acc = MFMA32(*(const bf16x8*)(qp + 32 * s), *(const bf16x8*)(kp + 32 * s), acc);
#pragma unroll
                for (int q = 0; q < 16; ++q) { const int tl = 32 * ti + crow(q, hh), sl = 32 * si + r; const bool keep = dir ? (sl > tl) : (sl <= tl); if (keep) AC[tl * ACS + sl] = f2bf(acc[q]); }
            }
        }
        __syncthreads();
        f32x16 o0 = {}, o1 = {};
#pragma unroll
        for (int dir = 0; dir < 2; ++dir) { const unsigned char* qp = TL + dir * TB + r * TS + 16 * hh;
#pragma unroll
            for (int s = 0; s < 8; ++s) { o0 = MFMA32(*(const bf16x8*)(qp + 32 * s), bs[dir][s], o0); o1 = MFMA32(*(const bf16x8*)(qp + 32 * TS + 32 * s), bs[dir][s], o1); } }
#pragma unroll
        for (int s = 0; s < 4; ++s) { o0 = MFMA32(ldfrag(AC + r * ACS + 16 * s + 8 * hh), bv[s], o0); o1 = MFMA32(ldfrag(AC + (32 + r) * ACS + 16 * s + 8 * hh), bv[s], o1); }
#pragma unroll
        for (int q = 0; q < 16; ++q) { float a = o0[q] * o0[q], b = o1[q] * o1[q];
#pragma unroll
            for (int of = 1; of < 32; of <<= 1) { a += __shfl_xor(a, of); b += __shfl_xor(b, of); }
            if (r == 0) { SSQ[w * 64 + crow(q, hh)] = a; SSQ[w * 64 + 32 + crow(q, hh)] = b; } }
        __syncthreads();
        const float gn = hnorm[32 * w + r];
#pragma unroll
        for (int q = 0; q < 16; ++q) { const int tl = crow(q, hh); float sa = 0.f, sb = 0.f;
#pragma unroll
            for (int ww = 0; ww < 8; ++ww) { sa += SSQ[ww * 64 + tl]; sb += SSQ[ww * 64 + 32 + tl]; }
            const float ra = 1.0f / sqrtf(sa * (1.0f / 256.0f) + RMS_EPS), rb = 1.0f / sqrtf(sb * (1.0f / 256.0f) + RMS_EPS);
            const size_t oa = (size_t)(t0 + tl) * 1024 + 256 * h + 32 * w + r, ob = oa + 32 * 1024;
            OG[oa] = f2bf(o0[q] * ra * gn * bf2f(SR[oa])); OG[ob] = f2bf(o1[q] * rb * gn * bf2f(SR[ob])); }
        __syncthreads();
    }
}

__device__ __forceinline__ void ph_mla_tok(const Ctx& C, const float* CIN, const int* pos, const float* qn, const float* kvn, const float* invf, bf16_t* CQN, bf16_t* CKVN, float* CS, bf16_t* K) {
    const int l = C.lane;
    f32x4 g0, g1;
    if (l < 32) { g0 = *(const f32x4*)(qn + 8 * l); g1 = *(const f32x4*)(qn + 8 * l + 4); }
    else if (l < 48) { g0 = *(const f32x4*)(kvn + 8 * (l - 32)); g1 = *(const f32x4*)(kvn + 8 * (l - 32) + 4); }
    else { g0 = (f32x4){1.f, 1.f, 1.f, 1.f}; g1 = g0; }
    const float fr = invf[l & 31];
    for (int t = C.gw; t < T; t += C.ngw) {
        const float* row = CIN + (size_t)t * 512; const f32x4 a = *(const f32x4*)(row + 8 * l), b = *(const f32x4*)(row + 8 * l + 4);
        const float ss = (a[0] * a[0] + a[1] * a[1]) + (a[2] * a[2] + a[3] * a[3]) + (b[0] * b[0] + b[1] * b[1]) + (b[2] * b[2] + b[3] * b[3]);
        const float sq = wave_sum(l < 32 ? ss : 0.f), sk = wave_sum((l >= 32 && l < 48) ? ss : 0.f);
        const float rq = 1.0f / sqrtf(sq * (1.0f / 256.0f) + RMS_EPS), rk = 1.0f / sqrtf(sk * (1.0f / 128.0f) + RMS_EPS);
        const float ang = (float)pos[t] * fr; const double rev = (double)ang * 0.15915494309189533577; const float fr01 = (float)(rev - rint(rev));
        const float cv = __builtin_amdgcn_cosf(fr01), sv = __builtin_amdgcn_sinf(fr01);
        if (l < 32) { CS[(size_t)t * 64 + l] = cv; CS[(size_t)t * 64 + 32 + l] = sv; }
        if (l < 32) store8bf(CQN + (size_t)t * 256 + 8 * l, a * rq * g0, b * rq * g1);
        else if (l < 48) store8bf(CKVN + (size_t)t * 256 + 8 * (l - 32), a * rk * g0, b * rk * g1);
        else { const u32x4 z = {0u, 0u, 0u, 0u}; *(u32x4*)(CKVN + (size_t)t * 256 + 128 + 8 * (l - 48)) = z; }
        f32x4 xa = a, xb = b;
        f32x4 pa, pb;
#pragma unroll
        for (int j = 0; j < 4; ++j) { pa[j] = __shfl(xa[j], (l + 4) & 63); pb[j] = __shfl(xb[j], (l + 4) & 63); }
        f32x4 c0, c1, s0, s1;
#pragma unroll
        for (int j = 0; j < 4; ++j) { const int i = 8 * (l & 3) + j; c0[j] = __shfl(cv, i); c1[j] = __shfl(cv, i + 4); s0[j] = __shfl(sv, i); s1[j] = __shfl(sv, i + 4); }
        if (l >= 48 && l < 52) {
            const f32x4 o1a = xa * c0 - pa * s0, o2a = xa * s0 + pa * c0, o1b = xb * c1 - pb * s1, o2b = xb * s1 + pb * c1;
            u32x4 w0, w1; w0.x = cvt_pk_bf16(o1a[0], o1a[1]); w0.y = cvt_pk_bf16(o1a[2], o1a[3]); w0.z = cvt_pk_bf16(o2a[0], o2a[1]); w0.w = cvt_pk_bf16(o2a[2], o2a[3]);
            w1.x = cvt_pk_bf16(o1b[0], o1b[1]); w1.y = cvt_pk_bf16(o1b[2], o1b[3]); w1.z = cvt_pk_bf16(o2b[0], o2b[1]); w1.w = cvt_pk_bf16(o2b[2], o2b[3]);
            if (ATT_FP8) { u32x4 w8; w8.x = pk4fp8(o1a[0], o1a[1], o1a[2], o1a[3]); w8.y = pk4fp8(o2a[0], o2a[1], o2a[2], o2a[3]); w8.z = pk4fp8(o1b[0], o1b[1], o1b[2], o1b[3]); w8.w = pk4fp8(o2b[0], o2b[1], o2b[2], o2b[3]);
#pragma unroll
                for (int h = 0; h < MH; ++h) *(u32x4*)((unsigned char*)K + ((size_t)h * T + t) * MDK + 128 + 16 * (l & 3)) = w8; }
            else {
#pragma unroll
            for (int h = 0; h < MH; ++h) { bf16_t* kp = K + ((size_t)h * T + t) * MDK + 128 + 16 * (l & 3); *(u32x4*)kp = w0; *(u32x4*)(kp + 8) = w1; } }
        }
    }
}

namespace att {
constexpr int NW = 8, QBLK = 32, KVBLK = 64;
#ifndef ATT_PVSPLIT
#define ATT_PVSPLIT 0
#endif
#ifndef ATT_SDEPTH
#define ATT_SDEPTH 1
#endif
constexpr int SDEPTH = ATT_SDEPTH;
constexpr float THR2 = 11.5f;
constexpr int SHM_V = KVBLK * MDV * 2, SHM_K = KVBLK * 400, SHM_ATTN = 2 * SHM_V + 2 * SHM_K + NW * 64 * 4;
#define KSWZ(row, colB) ((row) * 400 + (colB))
#define SBAR() __builtin_amdgcn_sched_barrier(0)
__device__ __forceinline__ unsigned cvtpk(float lo, float hi) { unsigned r; asm volatile("v_cvt_pk_bf16_f32 %0, %1, %2" : "=v"(r) : "v"(lo), "v"(hi)); return r; }
__device__ __forceinline__ void partialSM(f32x16& p0, f32x16& p1, float& m_reg, float& mn, float& alpha) {
  float pmax = p0[0];
#pragma unroll
  for (int r = 1; r < 16; ++r) pmax = fmaxf(pmax, p0[r]);
#pragma unroll
  for (int r = 0; r < 16; ++r) pmax = fmaxf(pmax, p1[r]);
  { auto rr = __builtin_amdgcn_permlane32_swap(__float_as_uint(pmax), __float_as_uint(pmax), false, false);
    pmax = fmaxf(__uint_as_float(rr[0]), __uint_as_float(rr[1])); }
  if (__builtin_expect(__all(pmax - m_reg <= THR2), 1)) { mn = m_reg; alpha = 1.f; }
  else { mn = fmaxf(m_reg, pmax); alpha = __builtin_amdgcn_exp2f(m_reg - mn); m_reg = mn; }
#pragma unroll
  for (int r = 0; r < 16; ++r) p0[r] = p0[r] - mn;
#pragma unroll
  for (int r = 0; r < 16; ++r) p1[r] = p1[r] - mn;
#pragma unroll
  for (int r = 0; r < 16; ++r) p0[r] = __builtin_amdgcn_exp2f(p0[r]);
}
__device__ __forceinline__ void finishSM(f32x16& p0, f32x16& p1, float alpha, float& l_reg, bf16x8& pa0, bf16x8& pa1, bf16x8& pa2, bf16x8& pa3) {
#pragma unroll
  for (int r = 0; r < 16; ++r) p1[r] = __builtin_amdgcn_exp2f(p1[r]);
  float ps = 0;
#pragma unroll
  for (int r = 0; r < 16; ++r) ps += p0[r];
#pragma unroll
  for (int r = 0; r < 16; ++r) ps += p1[r];
  { auto rr = __builtin_amdgcn_permlane32_swap(__float_as_uint(ps), __float_as_uint(ps), false, false);
    ps = __uint_as_float(rr[0]) + __uint_as_float(rr[1]); }
  l_reg = l_reg * alpha + ps;
#define PK4(P, BASE, OUT) do { unsigned a0 = cvtpk(P[BASE + 0], P[BASE + 1]), a1 = cvtpk(P[BASE + 2], P[BASE + 3]);   \
    unsigned b0 = cvtpk(P[BASE + 4], P[BASE + 5]), b1 = cvtpk(P[BASE + 6], P[BASE + 7]);                              \
    auto r0 = __builtin_amdgcn_permlane32_swap(a0, b0, false, false); auto r1 = __builtin_amdgcn_permlane32_swap(a1, b1, false, false); \
    u32x4 w = {r0[0], r1[0], r0[1], r1[1]}; OUT = *reinterpret_cast<bf16x8*>(&w); } while (0)
  PK4(p0, 0, pa0); PK4(p0, 8, pa1); PK4(p1, 0, pa2); PK4(p1, 8, pa3);
#undef PK4
}
__device__ __forceinline__ void qkt(f32x16& p0, f32x16& p1, const char* Ks, const bf16x8* qr, int r32, int hi) {
  p0 = f32x16{}; p1 = f32x16{};
#pragma unroll
  for (int d0 = 0; d0 < 12; ++d0) { const int cb = (d0 * 16 + hi * 8) * 2;
    const bf16x8 b0 = *reinterpret_cast<const bf16x8*>(Ks + KSWZ(r32, cb));
    const bf16x8 b1 = *reinterpret_cast<const bf16x8*>(Ks + KSWZ(32 + r32, cb));
    p0 = __builtin_amdgcn_mfma_f32_32x32x16_bf16(b0, qr[d0], p0, 0, 0, 0);
    p1 = __builtin_amdgcn_mfma_f32_32x32x16_bf16(b1, qr[d0], p1, 0, 0, 0); }
}
__device__ __forceinline__ int v_st(int k, int c) { const int kk = (k & ~0xC) | ((k & 4) << 1) | ((k & 8) >> 1); return ((kk >> 3) * 4 + (c >> 5)) * 512 + ((kk & 7) * 32 + (c & 31)) * 2; }
__device__ __forceinline__ int v_rd_base(int lane) { return ((lane & 3) << 3) | (((lane >> 2) & 3) << 6) | (((lane >> 4) & 1) << 5) | (((lane >> 5) & 1) << 8); }
constexpr int v_rd_off(int d0, int ks, int half) { return d0 * 512 + ks * 4096 + half * 2048; }
template <int OFF> __device__ __forceinline__ s16x4 tr_read(int vb) {
  s16x4 r; asm volatile("ds_read_b64_tr_b16 %0, %1 offset:%2" : "=&v"(r) : "v"(vb), "i"(OFF) : "memory"); return r;
}
template <int D0> __device__ __forceinline__ void pv_one(f32x16& od, int vb, bf16x8 pa0, bf16x8 pa1, bf16x8 pa2, bf16x8 pa3) {
#if ATT_PVSPLIT
#define PK(L, H) (bf16x8){L[0], L[1], L[2], L[3], H[0], H[1], H[2], H[3]}
  { const s16x4 l0 = tr_read<v_rd_off(D0, 0, 0)>(vb), h0 = tr_read<v_rd_off(D0, 0, 1)>(vb), l1 = tr_read<v_rd_off(D0, 1, 0)>(vb), h1 = tr_read<v_rd_off(D0, 1, 1)>(vb);
    asm volatile("s_waitcnt lgkmcnt(0)" ::: "memory"); SBAR();
    od = __builtin_amdgcn_mfma_f32_32x32x16_bf16(pa0, PK(l0, h0), od, 0, 0, 0);
    od = __builtin_amdgcn_mfma_f32_32x32x16_bf16(pa1, PK(l1, h1), od, 0, 0, 0); }
  { const s16x4 l2 = tr_read<v_rd_off(D0, 2, 0)>(vb), h2 = tr_read<v_rd_off(D0, 2, 1)>(vb), l3 = tr_read<v_rd_off(D0, 3, 0)>(vb), h3 = tr_read<v_rd_off(D0, 3, 1)>(vb);
    asm volatile("s_waitcnt lgkmcnt(0)" ::: "memory"); SBAR();
    od = __builtin_amdgcn_mfma_f32_32x32x16_bf16(pa2, PK(l2, h2), od, 0, 0, 0);
    od = __builtin_amdgcn_mfma_f32_32x32x16_bf16(pa3, PK(l3, h3), od, 0, 0, 0); }
#undef PK
#else
  const s16x4 l0 = tr_read<v_rd_off(D0, 0, 0)>(vb), h0 = tr_read<v_rd_off(D0, 0, 1)>(vb), l1 = tr_read<v_rd_off(D0, 1, 0)>(vb), h1 = tr_read<v_rd_off(D0, 1, 1)>(vb);
  const s16x4 l2 = tr_read<v_rd_off(D0, 2, 0)>(vb), h2 = tr_read<v_rd_off(D0, 2, 1)>(vb), l3 = tr_read<v_rd_off(D0, 3, 0)>(vb), h3 = tr_read<v_rd_off(D0, 3, 1)>(vb);
  asm volatile("s_waitcnt lgkmcnt(0)" ::: "memory"); SBAR();
#define PK(L, H) (bf16x8){L[0], L[1], L[2], L[3], H[0], H[1], H[2], H[3]}
  od = __builtin_amdgcn_mfma_f32_32x32x16_bf16(pa0, PK(l0, h0), od, 0, 0, 0);
  od = __builtin_amdgcn_mfma_f32_32x32x16_bf16(pa1, PK(l1, h1), od, 0, 0, 0);
  od = __builtin_amdgcn_mfma_f32_32x32x16_bf16(pa2, PK(l2, h2), od, 0, 0, 0);
  od = __builtin_amdgcn_mfma_f32_32x32x16_bf16(pa3, PK(l3, h3), od, 0, 0, 0);
#undef PK
#endif
}
__device__ __forceinline__ void pv_d0(f32x16* o, int vb, bf16x8 pa0, bf16x8 pa1, bf16x8 pa2, bf16x8 pa3) {
  pv_one<0>(o[0], vb, pa0, pa1, pa2, pa3); pv_one<1>(o[1], vb, pa0, pa1, pa2, pa3); pv_one<2>(o[2], vb, pa0, pa1, pa2, pa3); pv_one<3>(o[3], vb, pa0, pa1, pa2, pa3);
}
__device__ __forceinline__ void attn_body(const bf16_t* __restrict__ Qb, const bf16_t* __restrict__ Kh, const bf16_t* __restrict__ Vh, bf16_t* __restrict__ Ob, int ldo, int seq, char* lds) {
  const int tid = threadIdx.x, wid = tid >> 6, lane = tid & 63, r32 = lane & 31, hi = lane >> 5;
  char* V_lds = lds; char* K_lds = lds + 2 * SHM_V;
  float* ws = (float*)(lds + 2 * SHM_V + 2 * SHM_K) + wid * 64; float* li_l = ws; float* al_l = ws + 32;
  float m_reg = -1e30f, l_reg = 0; f32x16 o[4] = {}; bf16x8 qr[12];
  const bf16_t* Qw = Qb + (size_t)(wid * QBLK + r32) * MDK + hi * 8;
#pragma unroll
  for (int d0 = 0; d0 < 12; ++d0) qr[d0] = *reinterpret_cast<const bf16x8*>(Qw + d0 * 16);
  const int sr = tid >> 4, sc = (tid & 15) * 8, vst0 = v_st(sr, sc), vst1 = v_st(32 + sr, sc);
  int kst[3];
#pragma unroll
  for (int i = 0; i < 3; ++i) { const int ck = tid + 512 * i, row = ck / 24, cc = ck - row * 24; kst[i] = KSWZ(row, cc * 16); }
  const int vb0 = (int)(uintptr_t)V_lds + v_rd_base(lane);
  const unsigned vo0 = (unsigned)(sr * MDV + sc), ko0 = (unsigned)(tid * 8);
  struct { bf16x8 vs0, vs1, ks0, ks1, ks2; } sr_[SDEPTH];
#define SLOAD(i, k0) do { const bf16_t* vt_ = Vh + (size_t)(k0) * MDV; const bf16_t* kt_ = Kh + (size_t)(k0) * MDK;                                         \
    sr_[i].vs0 = *reinterpret_cast<const bf16x8*>(vt_ + vo0); sr_[i].vs1 = *reinterpret_cast<const bf16x8*>(vt_ + 32 * MDV + vo0);                               \
    sr_[i].ks0 = *reinterpret_cast<const bf16x8*>(kt_ + ko0); sr_[i].ks1 = *reinterpret_cast<const bf16x8*>(kt_ + 4096 + ko0); sr_[i].ks2 = *reinterpret_cast<const bf16x8*>(kt_ + 8192 + ko0); } while (0)
#define SWRITE(b, i) do { *(bf16x8*)(V_lds + (b) * SHM_V + vst0) = sr_[i].vs0; *(bf16x8*)(V_lds + (b) * SHM_V + vst1) = sr_[i].vs1;               \
    *(bf16x8*)(K_lds + (b) * SHM_K + kst[0]) = sr_[i].ks0; *(bf16x8*)(K_lds + (b) * SHM_K + kst[1]) = sr_[i].ks1; *(bf16x8*)(K_lds + (b) * SHM_K + kst[2]) = sr_[i].ks2; } while (0)
#define SWAIT() do { if constexpr (SDEPTH == 2) asm volatile("s_waitcnt vmcnt(5)" ::: "memory"); else asm volatile("s_waitcnt vmcnt(0)" ::: "memory"); } while (0)
#define RESC(a) do { if (__any((a) < 1.f)) { if (hi == 0) al_l[r32] = (a); asm volatile("s_waitcnt lgkmcnt(0)" ::: "memory"); \
    _Pragma("unroll") for (int d = 0; d < 4; ++d) _Pragma("unroll") for (int r = 0; r < 16; ++r) o[d][r] *= al_l[crow(r, hi)]; } } while (0)
  f32x16 pA0, pA1, pB0, pB1; float mnA, mnB, alA, alB; bf16x8 pa0, pa1, pa2, pa3; const int NT = seq / KVBLK;
  constexpr int SE = 0, SO = SDEPTH - 1;
  SLOAD(SE, 0); asm volatile("s_waitcnt vmcnt(0)" ::: "memory"); SWRITE(0, SE); __syncthreads();
  qkt(pA0, pA1, K_lds, qr, r32, hi); partialSM(pA0, pA1, m_reg, mnA, alA);
  SLOAD(SO, KVBLK); if constexpr (SDEPTH == 2) { if (2 < NT) SLOAD(SE, 2 * KVBLK); }
  SWAIT(); SWRITE(1, SO); __syncthreads();
  for (int j = 1; j + 1 < NT; j += 2) {
    SBAR(); qkt(pB0, pB1, K_lds + SHM_K, qr, r32, hi);
    finishSM(pA0, pA1, alA, l_reg, pa0, pa1, pa2, pa3); SBAR();
    SLOAD(SO, (j + SDEPTH) * KVBLK); SBAR();
    pv_d0(o, vb0, pa0, pa1, pa2, pa3); partialSM(pB0, pB1, m_reg, mnB, alB);
    __syncthreads(); SWAIT(); SWRITE(0, SE);
    RESC(alB); __syncthreads();
    SBAR(); qkt(pA0, pA1, K_lds, qr, r32, hi);
    finishSM(pB0, pB1, alB, l_reg, pa0, pa1, pa2, pa3); SBAR();
    if (SDEPTH == 1 || j + 3 < NT) SLOAD(SE, (j + 1 + SDEPTH) * KVBLK); SBAR();
    pv_d0(o, vb0 + SHM_V, pa0, pa1, pa2, pa3); partialSM(pA0, pA1, m_reg, mnA, alA);
    __syncthreads(); SWAIT(); SWRITE(1, SO);
    RESC(alA); __syncthreads();
  }
  SBAR(); qkt(pB0, pB1, K_lds + SHM_K, qr, r32, hi);
  finishSM(pA0, pA1, alA, l_reg, pa0, pa1, pa2, pa3); SBAR();
  pv_d0(o, vb0, pa0, pa1, pa2, pa3); partialSM(pB0, pB1, m_reg, mnB, alB);
  __syncthreads(); RESC(alB);
  finishSM(pB0, pB1, alB, l_reg, pa0, pa1, pa2, pa3); SBAR();
  pv_d0(o, vb0 + SHM_V, pa0, pa1, pa2, pa3);
  if (hi == 0) li_l[r32] = l_reg; asm volatile("s_waitcnt lgkmcnt(0)" ::: "memory");
  float rli[16];
#pragma unroll
  for (int r = 0; r < 16; ++r) rli[r] = __builtin_amdgcn_rcpf(li_l[crow(r, hi)]);
  bf16_t* Ow = Ob + (size_t)(wid * QBLK) * ldo;
#pragma unroll
  for (int r = 0; r < 16; ++r) { const int orow = crow(r, hi);
#pragma unroll
    for (int d0 = 0; d0 < 4; ++d0) Ow[(size_t)orow * ldo + d0 * 32 + r32] = f2bf(o[d0][r] * rli[r]); }
#undef SLOAD
#undef SWRITE
#undef SWAIT
#undef RESC
}
}


namespace att8 {
constexpr int NW = 8, QBLK = 32, KVBLK = 64, KST = 208, VST = 80;
#ifndef ATT8_SDEPTH
#define ATT8_SDEPTH 1
#endif
constexpr int SDEPTH = ATT8_SDEPTH;
constexpr float THR8 = 8.f;
#ifndef ATT8_RING3
#define ATT8_RING3 0
#endif
constexpr int NBUF = ATT8_RING3 ? 3 : 2;
constexpr int SHM_K = KVBLK * KST, SHM_V = MDV * VST, SHM_ATTN = NBUF * SHM_K + NBUF * SHM_V + NW * 64 * 4;
#define SBAR() __builtin_amdgcn_sched_barrier(0)
#define SGB(mask, n) __builtin_amdgcn_sched_group_barrier((mask), (n), 0)
#ifndef ATT8_ILV
#define ATT8_ILV 1
#endif
#ifndef ATT8_ONES
#define ATT8_ONES 1
#endif
#define PIN2(a, b) asm volatile("" : "+v"(a), "+v"(b))
#define PIN4(o) asm volatile("" : "+v"(o[0]), "+v"(o[1]), "+v"(o[2]), "+v"(o[3]), "+v"(o[4]))
#define ILV_QK() do { if (ATT8_ILV) { SGB(0x100, 4); _Pragma("unroll") for (int i_ = 0; i_ < 6; ++i_) { SGB(0x008, 1); SGB(0x002, 8); if (i_ < 4) SGB(0x100, 2); } } } while (0)
#define ILV_PV() do { if (ATT8_ILV) { SGB(0x100, 4); _Pragma("unroll") for (int i_ = 0; i_ < 4 + ATT8_ONES; ++i_) { SGB(0x008, 1); SGB(0x002, 14); if (i_ < 2) SGB(0x100, 2); } } } while (0)
#define MFMA8(a, b, c) __builtin_amdgcn_mfma_scale_f32_32x32x64_f8f6f4((a), (b), (c), 0, 0, 0, 0x7f7f7f7f, 0, 0x7f7f7f7f)
#define MFMA8Q(a, b, c) __builtin_amdgcn_mfma_scale_f32_32x32x64_f8f6f4((a), (b), (c), 0, 0, 0, 0x7f7f7f7f, 0, 0x7c7c7c7c)
__device__ __forceinline__ i32x8 ld32(const char* p) { const u32x4 a = *(const u32x4*)p, b = *(const u32x4*)(p + 16); return (i32x8){(int)a.x, (int)a.y, (int)a.z, (int)a.w, (int)b.x, (int)b.y, (int)b.z, (int)b.w}; }
typedef short v2i16 __attribute__((ext_vector_type(2)));
#ifndef ATT8_ONES
#define ATT8_ONES 1
#endif
__device__ __forceinline__ float rowmax32(const f32x16& p0, const f32x16& p1) {
  float pmax = fmaxf(fmaxf(p0[0], p0[1]), p0[2]);
#pragma unroll
  for (int r = 3; r < 15; r += 2) pmax = fmaxf(fmaxf(pmax, p0[r]), p0[r + 1]);
  pmax = fmaxf(fmaxf(pmax, p0[15]), p1[0]);
#pragma unroll
  for (int r = 1; r < 15; r += 2) pmax = fmaxf(fmaxf(pmax, p1[r]), p1[r + 1]);
  pmax = fmaxf(pmax, p1[15]);
  auto rr = __builtin_amdgcn_permlane32_swap(__float_as_uint(pmax), __float_as_uint(pmax), false, false);
  return fmaxf(__uint_as_float(rr[0]), __uint_as_float(rr[1]));
}
template <bool FIRST>
__device__ __forceinline__ void partialSM(f32x16& p0, f32x16& p1, float& m_reg, f32x16& mt, float& alpha, float& sc) {
  const float pmax = rowmax32(p0, p1);
  if constexpr (FIRST) { m_reg += pmax; p0 = p0 - pmax; p1 = p1 - pmax; mt = mt - pmax; alpha = 1.f; sc = 1.f; }
  else { const bool keep = __all(pmax <= THR8); const float d = keep ? 0.f : ceilf(fmaxf(pmax, 0.f));     alpha = __builtin_amdgcn_exp2f(-d); sc = __builtin_amdgcn_exp2f(d); m_reg += d;
    mt = mt - d; }
#pragma unroll
  for (int r = 0; r < 16; ++r) p0[r] = __builtin_amdgcn_exp2f(p0[r]);
}
__device__ __forceinline__ void finishSM(f32x16& p0, f32x16& p1, float alpha, float sc, float& l_reg, i32x8& pa) {
#pragma unroll
  for (int r = 0; r < 16; ++r) p1[r] = __builtin_amdgcn_exp2f(p1[r]);
#if !ATT8_ONES
  float ps = 0;
#pragma unroll
  for (int r = 0; r < 16; ++r) ps += p0[r];
#pragma unroll
  for (int r = 0; r < 16; ++r) ps += p1[r];
  { auto rr = __builtin_amdgcn_permlane32_swap(__float_as_uint(ps), __float_as_uint(ps), false, false);
    ps = __uint_as_float(rr[0]) + __uint_as_float(rr[1]); }
  l_reg = (l_reg + ps) * alpha;
#endif
#pragma unroll
  for (int j = 0; j < 4; ++j) { v2i16 w = {0, 0};
    w = __builtin_amdgcn_cvt_scalef32_pk_fp8_f32(w, p0[4 * j], p0[4 * j + 1], sc, false); w = __builtin_amdgcn_cvt_scalef32_pk_fp8_f32(w, p0[4 * j + 2], p0[4 * j + 3], sc, true); pa[j] = __builtin_bit_cast(int, w);
    v2i16 u = {0, 0};
    u = __builtin_amdgcn_cvt_scalef32_pk_fp8_f32(u, p1[4 * j], p1[4 * j + 1], sc, false); u = __builtin_amdgcn_cvt_scalef32_pk_fp8_f32(u, p1[4 * j + 2], p1[4 * j + 3], sc, true); pa[4 + j] = __builtin_bit_cast(int, u); }
}
__device__ __forceinline__ void qkt(f32x16& p0, f32x16& p1, const char* Ks, const i32x8* qr, const f32x16& mt, int r32, int hi) {
  const char* k0 = Ks + r32 * KST + hi * 32;
  { const i32x8 a0 = ld32(k0), a1 = ld32(k0 + 32 * KST); p0 = MFMA8Q(a0, qr[0], mt); p1 = MFMA8Q(a1, qr[0], mt); }
#pragma unroll
  for (int s = 1; s < 3; ++s) { const i32x8 a0 = ld32(k0 + 64 * s), a1 = ld32(k0 + 32 * KST + 64 * s);
    p0 = MFMA8Q(a0, qr[s], p0); p1 = MFMA8Q(a1, qr[s], p1); }
}
__device__ __forceinline__ void pv(f32x16* o, const char* Vs, const i32x8 pa, const i32x8& ones, int r32, int hi) {
  const char* v0 = Vs + r32 * VST + hi * 32;
#pragma unroll
  for (int d0 = 0; d0 < 4; ++d0) { const i32x8 b = ld32(v0 + d0 * 32 * VST); o[d0] = MFMA8(pa, b, o[d0]); }
  if (ATT8_ONES) o[4] = MFMA8(pa, ones, o[4]);
}
__device__ __forceinline__ void attn_body(const unsigned char* __restrict__ Qb, const unsigned char* __restrict__ Kh, const unsigned char* __restrict__ Vt, bf16_t* __restrict__ Ob, int ldo, int seq, char* lds) {
  const int tid = threadIdx.x, wid = __builtin_amdgcn_readfirstlane(tid >> 6), lane = tid & 63, r32 = lane & 31, hi = lane >> 5;
  char* K_lds = lds; char* V_lds = lds + NBUF * SHM_K;
  float* ws = (float*)(lds + NBUF * SHM_K + NBUF * SHM_V) + wid * 64; float* li_l = ws; float* al_l = ws + 32;
  float m_reg = 0.f, l_reg = 0; f32x16 o[5] = {}; f32x16 mt = {}; i32x8 qr[3];
  i32x8 ones; { int w1 = 0x38383838; asm volatile("" : "+v"(w1)); ones = (i32x8){w1, w1, w1, w1, w1, w1, w1, w1}; }
  { const char* Qw = (const char*)Qb + (size_t)(wid * QBLK + r32) * MDK + hi * 32;
#pragma unroll
    for (int s = 0; s < 3; ++s) qr[s] = ld32(Qw + 64 * s); }
  const int kd0 = (tid / 12) * KST + (tid % 12) * 16, kd1 = ((512 + tid) / 12) * KST + ((512 + tid) % 12) * 16, vd = (tid >> 2) * VST + (tid & 3) * 16;
  struct { u32x4 k0, k1, v; } sr_[SDEPTH];
#define SLOAD(i, t0) do { const unsigned ko = (unsigned)tid * 16u, vo = ((unsigned)(tid >> 2) << 14) | ((unsigned)(tid & 3) << 4); const unsigned char* kt_ = Kh + (size_t)(t0) * MDK; sr_[i].k0 = *(const u32x4*)(kt_ + ko); if (wid < 4) sr_[i].k1 = *(const u32x4*)(kt_ + 8192 + ko); sr_[i].v = *(const u32x4*)(Vt + (t0) + vo); } while (0)
#define SWRITE(b, i) do { *(u32x4*)(K_lds + (b) * SHM_K + kd0) = sr_[i].k0; if (wid < 4) *(u32x4*)(K_lds + (b) * SHM_K + kd1) = sr_[i].k1; *(u32x4*)(V_lds + (b) * SHM_V + vd) = sr_[i].v; } while (0)
#define SWAIT() do { if constexpr (SDEPTH == 2) asm volatile("s_waitcnt vmcnt(3)" ::: "memory"); else asm volatile("s_waitcnt vmcnt(0)" ::: "memory"); } while (0)
#define RESC(a) do { if (__any((a) < 1.f)) { if (hi == 0) al_l[r32] = (a); asm volatile("s_waitcnt lgkmcnt(0)" ::: "memory"); \
    _Pragma("unroll") for (int d = 0; d < 4 + ATT8_ONES; ++d) _Pragma("unroll") for (int r = 0; r < 16; ++r) o[d][r] *= al_l[crow(r, hi)]; } } while (0)
  f32x16 pA0, pA1, pB0, pB1; float alA, alB, scA, scB; i32x8 pa; const int NT = seq / KVBLK;
#if ATT8_RING3
  SLOAD(0, 0); asm volatile("s_waitcnt vmcnt(0)" ::: "memory"); SWRITE(0, 0);
  SLOAD(0, KVBLK); asm volatile("s_waitcnt vmcnt(0)" ::: "memory"); SWRITE(1, 0); __syncthreads();
  qkt(pA0, pA1, K_lds, qr, mt, r32, hi); partialSM<true>(pA0, pA1, m_reg, mt, alA, scA);
  int b0 = 0, b1 = 1, b2 = 2;
#define STEP(c0, c1, alc, n0, n1, mnn, aln, jj) do {                                                                          \
    SBAR(); if ((jj) + 1 < NT) qkt(n0, n1, K_lds + b1 * SHM_K, qr, r32, hi);                                                    \
    finishSM(c0, c1, alc, l_reg, pa); SBAR();                                                                                 \
    if ((jj) + 2 < NT) SLOAD(0, ((jj) + 2) * KVBLK); SBAR();                                                                   \
    pv(o, V_lds + b0 * SHM_V, pa, ones, r32, hi); if ((jj) + 1 < NT) partialSM(n0, n1, m_reg, mnn, aln);                              \
    if ((jj) + 2 < NT) { SWRITE(b2, 0); }                                                                                      \
    if ((jj) + 1 < NT) RESC(aln);                                                                                              \
    __syncthreads(); { const int t_ = b0; b0 = b1; b1 = b2; b2 = t_; } } while (0)
  for (int j = 0; j < NT; j += 2) { STEP(pA0, pA1, alA, pB0, pB1, mnB, alB, j); STEP(pB0, pB1, alB, pA0, pA1, mnA, alA, j + 1); }
#undef STEP
#else
  constexpr int SE = 0, SO = SDEPTH - 1;
  SLOAD(SE, 0); asm volatile("s_waitcnt vmcnt(0)" ::: "memory"); SWRITE(0, SE); __syncthreads();
  qkt(pA0, pA1, K_lds, qr, mt, r32, hi); partialSM<true>(pA0, pA1, m_reg, mt, alA, scA);
  SLOAD(SO, KVBLK); if constexpr (SDEPTH == 2) { if (2 < NT) SLOAD(SE, 2 * KVBLK); }
  SWAIT(); SWRITE(1, SO); __syncthreads();
  for (int j = 1; j + 1 < NT; j += 2) {
    SBAR(); qkt(pB0, pB1, K_lds + SHM_K, qr, mt, r32, hi);
    finishSM(pA0, pA1, alA, scA, l_reg, pa); ILV_QK(); PIN2(pB0, pB1); SBAR();
    SLOAD(SO, (j + SDEPTH) * KVBLK); SBAR();
    pv(o, V_lds, pa, ones, r32, hi); partialSM<false>(pB0, pB1, m_reg, mt, alB, scB); ILV_PV(); PIN4(o); PIN2(pB0, pB1); SBAR();
    __syncthreads(); SWAIT(); SWRITE(0, SE);
    RESC(alB); __syncthreads();
    SBAR(); qkt(pA0, pA1, K_lds, qr, mt, r32, hi);
    finishSM(pB0, pB1, alB, scB, l_reg, pa); ILV_QK(); PIN2(pA0, pA1); SBAR();
    if (SDEPTH == 1 || j + 3 < NT) SLOAD(SE, (j + 1 + SDEPTH) * KVBLK); SBAR();
    pv(o, V_lds + SHM_V, pa, ones, r32, hi); partialSM<false>(pA0, pA1, m_reg, mt, alA, scA); ILV_PV(); PIN4(o); PIN2(pA0, pA1); SBAR();
    __syncthreads(); SWAIT(); SWRITE(1, SO);
    RESC(alA); __syncthreads();
  }
  SBAR(); qkt(pB0, pB1, K_lds + SHM_K, qr, mt, r32, hi);
  finishSM(pA0, pA1, alA, scA, l_reg, pa); SBAR();
  pv(o, V_lds, pa, ones, r32, hi); partialSM<false>(pB0, pB1, m_reg, mt, alB, scB);
  __syncthreads(); RESC(alB);
  finishSM(pB0, pB1, alB, scB, l_reg, pa); SBAR();
  pv(o, V_lds + SHM_V, pa, ones, r32, hi);
#endif
  float rli[16];
  if (ATT8_ONES) {
#pragma unroll
    for (int r = 0; r < 16; ++r) rli[r] = __builtin_amdgcn_rcpf(o[4][r]);
  } else { if (hi == 0) li_l[r32] = l_reg; asm volatile("s_waitcnt lgkmcnt(0)" ::: "memory");
#pragma unroll
    for (int r = 0; r < 16; ++r) rli[r] = __builtin_amdgcn_rcpf(li_l[crow(r, hi)]); }
  bf16_t* Ow = Ob + (size_t)(wid * QBLK) * ldo;
#pragma unroll
  for (int r = 0; r < 16; ++r) { const int orow = crow(r, hi);
#pragma unroll
    for (int d0 = 0; d0 < 4; ++d0) Ow[(size_t)orow * ldo + d0 * 32 + r32] = f2bf(o[d0][r] * rli[r]); }
#undef SLOAD
#undef SWRITE
#undef SWAIT
#undef RESC
}
#undef SBAR
#undef SGB
#undef MFMA8
}

#ifdef DBG
constexpr size_t WS_DBG = 256 * 1024;
__device__ __forceinline__ unsigned hash32(unsigned x) { x ^= x >> 16; x *= 0x7feb352dU; x ^= x >> 15; x *= 0x846ca68bU; x ^= x >> 16; return x; }
__device__ __forceinline__ void dbg_acc(float* acc, int slot, float got, float ref) { const float d = got - ref; atomicAdd(acc + 2 * slot, d * d); atomicAdd(acc + 2 * slot + 1, ref * ref); }
__device__ __forceinline__ float dotA(const bf16_t* a, const float* W, int K, int ldw, int n) { float s = 0.f; for (int k = 0; k < K; ++k) s += bf2f(a[k]) * W[(size_t)k * ldw + n]; return s; }
__device__ __forceinline__ void chk_p1(const Ctx& C, const Args& a, unsigned char* ws, float* acc) {
    const int gt = C.bid * 512 + C.tid; if (gt >= 6144) return;
    const unsigned hs = hash32(gt * 7919u + 13u); const int t = hs % T, kind = gt % 6; const unsigned c0 = hs >> 14;
    const bf16_t* xn = (const bf16_t*)(ws + WS_XN) + (size_t)t * 1024; const float* w_in = (const float*)a.in[5];
    if (kind == 0) { const int c = c0 % 512; dbg_acc(acc, 0, bf2f(((const bf16_t*)(ws + AR_Q0))[(size_t)t * 512 + c]), dotA(xn, w_in, 1024, 3104, c) * 0.08838834764831845f); }
    else if (kind == 1) { const int c = c0 % 512; dbg_acc(acc, 0, bf2f(((const bf16_t*)(ws + AR_K0))[(size_t)t * 512 + c]), dotA(xn, w_in, 1024, 3104, 512 + c)); }
    else if (kind == 2) { const int c = c0 % 1024; dbg_acc(acc, 0, bf2f(((const bf16_t*)(ws + AR_VT))[(size_t)c * T + t]), dotA(xn, w_in, 1024, 3104, 1024 + c)); }
    else if (kind == 3) { const int c = c0 % 1024; dbg_acc(acc, 0, bf2f(((const bf16_t*)(ws + AR_SR))[(size_t)t * 1024 + c]), siluf(dotA(xn, w_in, 1024, 3104, 2048 + c))); }
    else { const int dir = kind - 4, c = c0 % 512; const float* wg = (const float*)a.in[dir ? 8 : 6]; const float* bg = (const float*)a.in[dir ? 9 : 7]; float lg = bg[c];
        for (int j = 0; j < 16; ++j) lg += dotA(xn, w_in, 1024, 3104, 3072 + 16 * dir + j) * wg[j * 512 + c];
        dbg_acc(acc, 1, ((const float*)(ws + (dir ? AR_GB : AR_GF)))[(size_t)t * 512 + c], logsigf(lg) * 0.0625f); }
}
__device__ __forceinline__ void chk_gla(const Ctx& C, const Args& a, unsigned char* ws, float* acc) {
    if (C.bid >= 64) return;
    float* A = (float*)C.lds; float* O = A + 4096; float* red = O + 512;
    const unsigned hs = hash32(C.bid * 977u + 5u); const int t = hs % T, h = (hs >> 14) & 3;
    const bf16_t* Q0 = (const bf16_t*)(ws + AR_Q0); const bf16_t* K0 = (const bf16_t*)(ws + AR_K0); const float* GF = (const float*)(ws + AR_GF); const float* GB = (const float*)(ws + AR_GB);
    const bf16_t* VT = (const bf16_t*)(ws + AR_VT); const bf16_t* SR = (const bf16_t*)(ws + AR_SR); const bf16_t* OG = (const bf16_t*)(ws + WS_XN);
    for (int i = C.tid; i < 4096; i += 512) A[i] = 0.f;
    __syncthreads();
    const int dir = C.tid >> 8, sub = C.tid & 255;
    if (sub < 128) { const int k = sub, ch = 128 * h + k; const float q = bf2f(Q0[(size_t)t * 512 + ch]); float Dk = dir ? __expf(GB[(size_t)t * 512 + ch]) : 1.f;
        for (int i = 0; i < 2048; ++i) { const int s = dir ? t + 1 + i : t - i; const bool valid = s >= 0 && s < T; float w = 0.f;
            if (valid) { w = q * Dk * bf2f(K0[(size_t)s * 512 + ch]); Dk *= __expf((dir ? GB : GF)[(size_t)s * 512 + ch]); }
            w = wave_sum(w); if (C.lane == 0) atomicAdd(&A[dir * 2048 + i], w); } }
    __syncthreads();
    { float o = 0.f; for (int i = 0; i < 2048; ++i) { const int s = dir ? t + 1 + i : t - i; if (s >= 0 && s < T) o += A[dir * 2048 + i] * bf2f(VT[(size_t)(256 * h + sub) * T + s]); } O[dir * 256 + sub] = o; }
    __syncthreads();
    if (C.tid < 256) { const float o = O[C.tid] + O[256 + C.tid]; float ss = wave_sum(o * o); if (C.lane == 0) red[C.wave] = ss; }
    __syncthreads();
    if (C.tid < 256) { const float o = O[C.tid] + O[256 + C.tid]; const float ss = red[0] + red[1] + red[2] + red[3]; const float r = 1.0f / sqrtf(ss * (1.0f / 256.0f) + RMS_EPS);
        const size_t oi = (size_t)t * 1024 + 256 * h + C.tid; dbg_acc(acc, 2, bf2f(OG[oi]), o * r * ((const float*)a.in[10])[C.tid] * bf2f(SR[oi])); }
    __syncthreads();
}
__device__ __forceinline__ void chk_resid(const Ctx& C, const float* base, const bf16_t* A, int K, const float* W, const float* HAp, float* acc, int slot) {
    const int gt = C.bid * 512 + C.tid; if (gt >= 4096) return;
    const unsigned hs = hash32(gt * 31u + slot); const int t = hs % T, n = (hs >> 14) % 1024;
    dbg_acc(acc, slot, HAp[(size_t)t * 1024 + n], base[(size_t)t * 1024 + n] + dotA(A + (size_t)t * K, W, K, 1024, n));
}
__device__ __forceinline__ void chk_router(const Ctx& C, const float* Hin, const float* gain, const float* Wr, const bf16_t* XN, const float* AFF, float* acc, int slot) {
    const int gt = C.bid * 512 + C.tid; if (gt >= 512) return;
    const int t = hash32(gt * 101u + 7u) % T; const float* hr = Hin + (size_t)t * 1024; float ss = 0.f; for (int k = 0; k < 1024; ++k) ss += hr[k] * hr[k];
    const float r = 1.0f / sqrtf(ss / 1024.0f + RMS_EPS); float lg[16]; for (int e = 0; e < 16; ++e) lg[e] = 0.f;
    for (int k = 0; k < 1024; ++k) { const float xv = hr[k] * r * gain[k]; for (int e = 0; e < 16; ++e) lg[e] += xv * Wr[k * 16 + e]; if ((k & 63) == (gt & 63)) dbg_acc(acc, slot, bf2f(XN[(size_t)t * 1024 + k]), xv); }
    float mx = lg[0]; for (int e = 1; e < 16; ++e) mx = fmaxf(mx, lg[e]); float s = 0.f; for (int e = 0; e < 16; ++e) { lg[e] = expf(lg[e] - mx); s += lg[e]; }
    for (int e = 0; e < 16; ++e) dbg_acc(acc, slot, AFF[(size_t)t * 16 + e], lg[e] / s);
}
__device__ __forceinline__ void chk_select(const Ctx& C, const float* AFF, const int* SEL, const int* IDX, unsigned* dw) {
    const int gt = C.bid * 512 + C.tid;
    for (int p = gt; p < T * 16; p += C.nb * 512) { const int t = p >> 4, e = p & 15; const int s = SEL[p]; const unsigned b = __float_as_uint(AFF[p]);
        if (s > 0) { atomicAdd(&dw[e], 1u); atomicMax(&dw[16 + e], ~b); if (s > CAP || IDX[e * CAP + s - 1] != t) atomicAdd(&dw[48], 1u); } else { atomicMax(&dw[32 + e], b); if (s < 0) atomicAdd(&dw[48], 1u); } }
}
__device__ __forceinline__ void chk_moe_h(const Ctx& C, const Args& a, unsigned char* ws, int layer, float* acc, int slot) {
    const int gt = C.bid * 512 + C.tid; if (gt >= 2048) return;
    const unsigned hs = hash32(gt * 53u + 3u); const int e = hs & 15, sl = (hs >> 4) % CAP, f = (hs >> 15) % FF; const int t = ((const int*)(ws + WS_IDX))[e * CAP + sl];
    if (t < 0 || t >= T) { dbg_acc(acc, slot, 1e3f, 0.f); return; }
    const bf16_t* xn = (const bf16_t*)(ws + WS_XN) + (size_t)t * 1024; const size_t wo = (size_t)(layer * NE + e) * 1024 * 2048;
    const float g = dotA(xn, (const float*)a.in[19] + wo, 1024, 2048, f), u = dotA(xn, (const float*)a.in[20] + wo, 1024, 2048, f);
    dbg_acc(acc, slot, bf2f(((const bf16_t*)(ws + AR_H))[((size_t)e * CAP + sl) * FF + f]), siluf(g) * u);
    dbg_acc(acc, slot, bf2f(((const bf16_t*)(ws + AR_XS))[((size_t)e * CAP + sl) * 1024 + (f & 1023)]), bf2f(xn[f & 1023]));
}
__device__ __forceinline__ void chk_moe_y(const Ctx& C, const Args& a, unsigned char* ws, int layer, float* acc, int slot) {
    const int gt = C.bid * 512 + C.tid; if (gt >= 2048) return;
    const unsigned hs = hash32(gt * 59u + 11u); const int e = hs & 15, sl = (hs >> 4) % CAP, n = (hs >> 15) % 1024;
    const float ref = dotA((const bf16_t*)(ws + AR_H) + ((size_t)e * CAP + sl) * FF, (const float*)a.in[21] + (size_t)(layer * NE + e) * 2048 * 1024, 2048, 1024, n);
    dbg_acc(acc, slot, bf2f(((const bf16_t*)(ws + AR_Y))[((size_t)e * CAP + sl) * 1024 + n]), ref);
}
__device__ __forceinline__ void chk_combine(const Ctx& C, unsigned char* ws, const float* Hin, const float* Hout, float* acc, int slot) {
    const int gt = C.bid * 512 + C.tid; if (gt >= 4096) return;
    const unsigned hs = hash32(gt * 67u + 1u); const int t = hs % T, n = (hs >> 14) % 1024; float ref = Hin[(size_t)t * 1024 + n];
    for (int e = 0; e < 16; ++e) { const int s = ((const int*)(ws + WS_SEL))[t * 16 + e]; if (s > 0) ref += ((const float*)(ws + WS_AFF))[t * 16 + e] * bf2f(((const bf16_t*)(ws + AR_Y))[((size_t)e * CAP + s - 1) * 1024 + n]); }
    dbg_acc(acc, slot, Hout[(size_t)t * 1024 + n], ref);
}
__device__ __forceinline__ void chk_cin(const Ctx& C, const Args& a, unsigned char* ws, float* acc) {
    const int gt = C.bid * 512 + C.tid; if (gt >= 4096) return;
    const unsigned hs = hash32(gt * 71u + 9u); const int t = hs % T, n = (hs >> 14) % 448;
    dbg_acc(acc, 10, ((const float*)(ws + AR_CIN))[(size_t)t * 512 + n], dotA((const bf16_t*)(ws + WS_XN) + (size_t)t * 1024, (const float*)a.in[12], 1024, 448, n));
}
__device__ __forceinline__ void chk_tok(const Ctx& C, const Args& a, unsigned char* ws, float* acc) {
    const int gt = C.bid * 512 + C.tid; if (gt >= 1024) return;
    const unsigned hs = hash32(gt * 73u + 19u); const int t = hs % T, h = (hs >> 14) & 15; const float* row = (const float*)(ws + AR_CIN) + (size_t)t * 512;
    float sq = 0.f, sk = 0.f; for (int i = 0; i < 256; ++i) sq += row[i] * row[i]; for (int i = 0; i < 128; ++i) sk += row[256 + i] * row[256 + i];
    const float rq = 1.0f / sqrtf(sq / 256.0f + RMS_EPS), rk = 1.0f / sqrtf(sk / 128.0f + RMS_EPS);
    const int i = (hs >> 18) % 256; dbg_acc(acc, 11, bf2f(((const bf16_t*)(ws + AR_CQN))[(size_t)t * 256 + i]), row[i] * rq * ((const float*)a.in[13])[i]);
    const int j = i & 127; dbg_acc(acc, 11, bf2f(((const bf16_t*)(ws + AR_CKVN))[(size_t)t * 256 + j]), row[256 + j] * rk * ((const float*)a.in[15])[j]);
    dbg_acc(acc, 11, 1.f + bf2f(((const bf16_t*)(ws + AR_CKVN))[(size_t)t * 256 + 128 + j]), 1.f);
    const int f = i & 31; const float ang = (float)((const int*)a.in[1])[t] * a.invf[f]; double xr = (double)ang * 0.15915494309189533577; xr = (xr - rint(xr)) * 6.283185307179586477; double cd = 1.0, sd = xr, tc = 1.0, ts = xr; for (int n = 1; n < 16; ++n) { tc *= -xr * xr / ((2.0 * n - 1.0) * (2.0 * n)); ts *= -xr * xr / ((2.0 * n) * (2.0 * n + 1.0)); cd += tc; sd += ts; } const float cr = (float)cd, sr = (float)sd;
    dbg_acc(acc, 11, ((const float*)(ws + WS_CS))[(size_t)t * 64 + f], cr); dbg_acc(acc, 11, ((const float*)(ws + WS_CS))[(size_t)t * 64 + 32 + f], sr);
    const float x1 = row[384 + f], x2 = row[416 + f]; const bf16_t* kp = (const bf16_t*)(ws + AR_K) + ((size_t)h * T + t) * MDK + 128 + 8 * (f >> 2) + (f & 3);
    dbg_acc(acc, 11, bf2f(kp[0]), x1 * cr - x2 * sr); dbg_acc(acc, 11, bf2f(kp[4]), x1 * sr + x2 * cr);
}
__device__ __forceinline__ void chk_qkv(const Ctx& C, const Args& a, unsigned char* ws, float* acc) {
    const int gt = C.bid * 512 + C.tid; if (gt >= 4096) return;
    const unsigned hs = hash32(gt * 79u + 29u); const int t = hs % T, h = (hs >> 14) & 15, j = (hs >> 18) & 127, kind = gt & 3; const float QS = (ATT_FP8 ? 8.0f : 1.0f) * 0.07216878364870322f * 1.4426950408889634f;
    const bf16_t* cq = (const bf16_t*)(ws + AR_CQN) + (size_t)t * 256; const bf16_t* ck = (const bf16_t*)(ws + AR_CKVN) + (size_t)t * 256;
    const size_t qo = ((size_t)h * T + t) * MDK; const int tau = t & 63, pos = 32 * ((tau >> 2) & 1) + (tau & 3) + 4 * ((tau >> 3) & 3) + 16 * (tau >> 5);
#if ATT_FP8
#define QV(i) fp8f(ws + AR_Q8 + qo + (i))
#define KV(i) fp8f(ws + AR_K8 + qo + (i))
#define VV(i) fp8f(ws + AR_V8T + ((size_t)h * MDV + (i)) * T + (t & ~63) + pos)
#else
#define QV(i) bf2f(((const bf16_t*)(ws + AR_Q))[qo + (i)])
#define KV(i) bf2f(((const bf16_t*)(ws + AR_K))[qo + (i)])
#define VV(i) bf2f(((const bf16_t*)(ws + AR_V))[((size_t)h * T + t) * MDV + (i)])
#endif
    if (kind == 0) dbg_acc(acc, 12, QV(j), dotA(cq, (const float*)a.in[14], 256, 3072, 192 * h + j) * QS);
    else if (kind == 1) { const int f = j & 31; const float x1 = dotA(cq, (const float*)a.in[14], 256, 3072, 192 * h + 128 + f), x2 = dotA(cq, (const float*)a.in[14], 256, 3072, 192 * h + 160 + f);
        const float cr = ((const float*)(ws + WS_CS))[(size_t)t * 64 + f], sr = ((const float*)(ws + WS_CS))[(size_t)t * 64 + 32 + f]; const int qp = 128 + 8 * (f >> 2) + (f & 3);
        dbg_acc(acc, 12, QV(qp), (x1 * cr - x2 * sr) * QS); dbg_acc(acc, 12, QV(qp + 4), (x1 * sr + x2 * cr) * QS);
        const float* row = (const float*)(ws + AR_CIN) + (size_t)t * 512; const float k1 = row[384 + f], k2 = row[416 + f];
        dbg_acc(acc, 12, KV(qp), k1 * cr - k2 * sr); dbg_acc(acc, 12, KV(qp + 4), k1 * sr + k2 * cr); }
    else if (kind == 2) dbg_acc(acc, 12, KV(j), dotA(ck, (const float*)a.in[16], 128, 4096, 256 * h + j));
    else dbg_acc(acc, 12, VV(j), dotA(ck, (const float*)a.in[16], 128, 4096, 256 * h + 128 + j));
#undef QV
#undef KV
#undef VV
}
__device__ __forceinline__ void chk_attn(const Ctx& C, unsigned char* ws, float* acc) {
    if (C.bid >= 64) return;
    float* P = (float*)C.lds; float* red = P + T; float* qs = red + 32;
    const unsigned hs = hash32(C.bid * 991u + 77u); const int t = hs % T, h = (hs >> 14) & 15;
#if ATT_FP8
    const unsigned char* Q = ws + AR_Q8 + ((size_t)h * T + t) * MDK; const unsigned char* K = ws + AR_K8 + (size_t)h * T * MDK; const unsigned char* V = ws + AR_V8T + (size_t)h * MDV * T; const float SC = 0.125f;
    if (C.tid < MDK) qs[C.tid] = fp8f(Q + C.tid);
#define KEL(j, d) fp8f(K + (size_t)(j) * MDK + (d))
#define VEL(j, d) fp8f(V + (size_t)(d) * T + ((j) & ~63) + 32 * ((((j) & 63) >> 2) & 1) + ((j) & 3) + 4 * ((((j) & 63) >> 3) & 3) + 16 * (((j) & 63) >> 5))
#else
    const bf16_t* Q = (const bf16_t*)(ws + AR_Q) + ((size_t)h * T + t) * MDK; const bf16_t* K = (const bf16_t*)(ws + AR_K) + (size_t)h * T * MDK; const bf16_t* V = (const bf16_t*)(ws + AR_V) + (size_t)h * T * MDV; const float SC = 1.0f;
    if (C.tid < MDK) qs[C.tid] = bf2f(Q[C.tid]);
#define KEL(j, d) bf2f(K[(size_t)(j) * MDK + (d)])
#define VEL(j, d) bf2f(V[(size_t)(j) * MDV + (d)])
#endif
    __syncthreads();
    float mx = -1e30f;
    for (int j = C.tid; j < T; j += 512) { float s = 0.f; for (int d = 0; d < MDK; ++d) s += qs[d] * KEL(j, d); s *= SC; P[j] = s; mx = fmaxf(mx, s); }
    mx = wave_max(mx); if (C.lane == 0) red[C.wave] = mx;
    __syncthreads();
    mx = red[0]; for (int w = 1; w < 8; ++w) mx = fmaxf(mx, red[w]);
    float sm = 0.f; for (int j = C.tid; j < T; j += 512) { const float p = exp2f(P[j] - mx); P[j] = p; sm += p; }
    sm = wave_sum(sm);
    __syncthreads();
    if (C.lane == 0) red[8 + C.wave] = sm;
    __syncthreads();
    sm = 0.f; for (int w = 0; w < 8; ++w) sm += red[8 + w];
    if (C.tid < MDV) { float o = 0.f; for (int j = 0; j < T; ++j) o += P[j] * VEL(j, C.tid); dbg_acc(acc, 13, bf2f(((const bf16_t*)(ws + AR_O))[(size_t)t * 2048 + 128 * h + C.tid]) * 100.f, o / sm * 100.f); }
    __syncthreads();
#undef KEL
#undef VEL
}
__device__ __forceinline__ void dbg_report(const Ctx& C, unsigned char* ws, float* out, int lo, int hi) {
    const float* acc = (const float*)(ws + WS_DBG); const unsigned* dw = (const unsigned*)(ws + WS_DBG + 1024);
    int code = 90;
    for (int s = lo; s < hi && code == 90; ++s) { float num = __hip_atomic_load(acc + 2 * s, __ATOMIC_RELAXED, __HIP_MEMORY_SCOPE_AGENT), den = __hip_atomic_load(acc + 2 * s + 1, __ATOMIC_RELAXED, __HIP_MEMORY_SCOPE_AGENT);
        if (s == 5) { unsigned viol = __hip_atomic_load(dw + 48, __ATOMIC_RELAXED, __HIP_MEMORY_SCOPE_AGENT); for (int e = 0; e < 16; ++e) { const unsigned cnt = __hip_atomic_load(dw + e, __ATOMIC_RELAXED, __HIP_MEMORY_SCOPE_AGENT), mn = ~__hip_atomic_load(dw + 16 + e, __ATOMIC_RELAXED, __HIP_MEMORY_SCOPE_AGENT), mxu = __hip_atomic_load(dw + 32 + e, __ATOMIC_RELAXED, __HIP_MEMORY_SCOPE_AGENT); if (cnt != CAP) viol += 1000; if (mn < mxu) viol += 1; }
            num = (float)viol; den = 1.f; if (viol == 0) continue; code = 10 * (s - lo) + (viol >= 1000 ? 0 : (viol >= 100 ? 1 : (viol >= 10 ? 2 : 3))); break; }
        if (den == 0.f && num == 0.f) continue;
        const float e = sqrtf(num / den);
        if (!(e < 0.03f)) { const int b = !(e < 1.f) ? 0 : (e >= 0.3f ? 1 : (e >= 0.1f ? 2 : 3)); code = 10 * (s - lo) + b; } }
    if (code == 90) { float worst = 0.f; for (int s = lo; s < hi; ++s) { if (s == 5) continue; const float num = acc[2 * s], den = acc[2 * s + 1]; if (den > 0.f) worst = fmaxf(worst, sqrtf(num / den)); }
        code = 90 + (worst >= 0.01f ? 1 : (worst >= 0.003f ? 2 : 3)); }
    if (DBG >= 2) { const int sl = DBG == 2 ? 13 : 12; const float num = acc[2 * sl], den = acc[2 * sl + 1]; const float e = sqrtf(num / den); code = !(e > 0.f) ? 99 : (e >= 1.f ? 0 : (int)fminf(89.f, -20.f * log10f(e))); }
    const float c = sqrtf((float)code);
    for (size_t i = (size_t)C.bid * 512 + C.tid; i < (size_t)T * D; i += (size_t)C.nb * 512) out[i] = c;
}
#endif

constexpr int NPHASE = 24;
__global__ void __launch_bounds__(512, 2) mk_fwd(Args args) {
    extern __shared__ __attribute__((aligned(16))) unsigned char lds[];
    Ctx C; C.tid = threadIdx.x; C.lane = C.tid & 63; C.wave = __builtin_amdgcn_readfirstlane(C.tid >> 6); C.bid = blockIdx.x; C.nb = gridDim.x;
    C.gw = C.bid * 8 + C.wave; C.ngw = C.nb * 8; C.lds = lds;
    unsigned char* ws = args.ws;
    volatile LAS unsigned* MISC = (volatile LAS unsigned*)((LAS unsigned char*)lds + LDS_MISC);
    if (C.tid < 32) MISC[C.tid] = 0u;
    __syncthreads();
    XcdBarrier bar = xcd_barrier_post((unsigned*)(ws + WS_CTL) + 4096 + args.li * XCD_BAR_WORDS, MISC + 8);
    const int lo = args.ph_lo, hi = args.ph_hi;
#if defined(PH_MASK)
#define IN(k) ((((PH_MASK) >> (k)) & 1u) && lo <= (k) && (k) < hi)
#elif defined(PH_ONLY)
#define IN(k) ((k) == PH_ONLY && lo <= (k) && (k) < hi)
#else
#define IN(k) (lo <= (k) && (k) < hi)
#endif
#define SEAM(k) do { if (IN((k) + 1)) xcd_barrier(bar); } while (0)
#ifndef REPMASK
#define REPMASK 0u
#endif
#define NREP(k) ((((REPMASK) >> (k)) & 1u) ? 2 : 1)
#ifdef DBG
    float* dacc = (float*)(ws + WS_DBG); unsigned* ddw = (unsigned*)(ws + WS_DBG + 1024);
#define DBGCHK(page, call) do { if ((DBG >= 2 ? 1 : DBG) == (page)) { call; xcd_barrier(bar); } } while (0)
#else
#define DBGCHK(page, call) do { } while (0)
#endif
    PG8_LAS unsigned char* glds = (PG8_LAS unsigned char*)lds;
    const float* x = (const float*)args.in[0];
    float* HA = args.out; float* HB = (float*)(ws + WS_HB);
    bf16_t* XN = (bf16_t*)(ws + WS_XN);
    float* AFF = (float*)(ws + WS_AFF); int* SEL = (int*)(ws + WS_SEL); int* IDX = (int*)(ws + WS_IDX);
    bf16_t* WGU = (bf16_t*)(ws + WS_WGU); bf16_t* WD = (bf16_t*)(ws + WS_WD);
    bf16_t* XS = (bf16_t*)(ws + AR_XS); bf16_t* HH = (bf16_t*)(ws + AR_H); bf16_t* YY = (bf16_t*)(ws + AR_Y);

    if (IN(0)) { ph_convert_small(C, args, ws); ph_convert_moe(C, args, ws, 0, NREP(0)); ph_norm(C, x, (const float*)args.in[2], XN); SEAM(0); }
    if (IN(1)) {
        { pg8::Gemm g{XN, (const bf16_t*)(ws + WS_WGIN), T, 3072, 1024}; pg8::StaticOrder S; S.init(T, 3072, C.nb, C.bid); S.rep = NREP(1);
          pg8::EpiGlaIn E{(bf16_t*)(ws + AR_Q0), (bf16_t*)(ws + AR_K0), (bf16_t*)(ws + AR_SR), (float*)(ws + AR_GF), (float*)(ws + AR_GB), (const float*)args.in[7], (const float*)args.in[9]};
          pg8::gemm_phase<pg8::EpiGlaIn, pg8::StaticOrder, PG8_ALIGN, PG8_SP2>(glds, g, S, E); }
        { pg8::Gemm g{(const bf16_t*)(ws + WS_WV), XN, 1024, T, 1024}; pg8::StaticOrder S; S.init(1024, T, C.nb, C.bid); S.rep = NREP(1);
          pg8::EpiBf E{(bf16_t*)(ws + AR_VT), T};
          pg8::gemm_phase<pg8::EpiBf, pg8::StaticOrder, PG8_ALIGN, PG8_SP2>(glds, g, S, E); }
        SEAM(1); } DBGCHK(0, chk_p1(C, args, ws, dacc));
    if (IN(2)) for (int rep_ = 0; rep_ < NREP(2); ++rep_) { ph_gla_prep(C, (const bf16_t*)(ws + AR_Q0), (const bf16_t*)(ws + AR_K0), (const float*)(ws + AR_GF), (const float*)(ws + AR_GB), (bf16_t*)(ws + AR_QDF), (bf16_t*)(ws + AR_QDB),
                             (bf16_t*)(ws + AR_KDF), (bf16_t*)(ws + AR_KDB), (bf16_t*)(ws + AR_KTF), (bf16_t*)(ws + AR_KTB), (float*)(ws + WS_EGL)); SEAM(2); }
    if (IN(3)) for (int rep_ = 0; rep_ < NREP(3); ++rep_) { ph_gla_u(C, (const bf16_t*)(ws + AR_VT), (const bf16_t*)(ws + AR_KTF), (const bf16_t*)(ws + AR_KTB), (const float*)(ws + WS_EGL), (bf16_t*)(ws + AR_U)); SEAM(3); }
    if (IN(4)) for (int rep_ = 0; rep_ < NREP(4); ++rep_) { ph_gla_scan(C, (const bf16_t*)(ws + AR_U), (const float*)(ws + WS_EGL), (bf16_t*)(ws + AR_ST)); SEAM(4); }
    if (IN(5)) for (int rep_ = 0; rep_ < NREP(5); ++rep_) { ph_gla_out(C, (const bf16_t*)(ws + AR_QDF), (const bf16_t*)(ws + AR_QDB), (const bf16_t*)(ws + AR_KDF), (const bf16_t*)(ws + AR_KDB), (const bf16_t*)(ws + AR_VT), (const bf16_t*)(ws + AR_ST),
                            (const bf16_t*)(ws + AR_SR), (const float*)args.in[10], XN); SEAM(5); } DBGCHK(0, chk_gla(C, args, ws, dacc));
    if (IN(6)) { pg8::Gemm g{XN, (const bf16_t*)(ws + WS_WGOUT), T, 1024, 1024}; pg8::StaticOrder S; S.init(T, 1024, C.nb, C.bid); S.rep = NREP(6);
        pg8::EpiF32 E{HA, x, 1024}; pg8::gemm_phase<pg8::EpiF32, pg8::StaticOrder, false, PG8_SP2>(glds, g, S, E); SEAM(6); } DBGCHK(0, chk_resid(C, x, XN, 1024, (const float*)args.in[11], HA, dacc, 3));
#define MOE_LAYER(P, L, HIN, TAILMODE, HOUT, GAIN2, OUTP)                                                                                         \
    if (IN(P)) for (int rep_ = 0; rep_ < NREP(P); ++rep_) { ph_router(C, HIN, (const float*)args.in[3] + (L) * 1024, (const float*)args.in[18] + (L) * 1024 * 16, XN, AFF, (float*)(ws + WS_AFFT), ws + AR_XN8); SEAM(P); if ((P) == 7) DBGCHK(0, chk_router(C, HIN, (const float*)args.in[3] + (L) * 1024, (const float*)args.in[18] + (L) * 1024 * 16, XN, AFF, dacc, 4)); }       \
    if (IN(P + 1)) for (int rep_ = 0; rep_ < NREP(P + 1); ++rep_) { ph_select(C, (const float*)(ws + WS_AFFT), SEL, IDX); SEAM(P + 1); if ((P) == 7) DBGCHK(0, chk_select(C, AFF, SEL, IDX, ddw)); }                                                                                 \
    if (IN(P + 2)) for (int rep_ = 0; rep_ < NREP(P + 2); ++rep_) { ph_gather(C, IDX, XN, XS, ws + AR_XN8); SEAM(P + 2); }                                                                                   \
    if (IN(P + 3)) { pg8::Gemm g{XS, WGU, NE * CAP, 4096, MOE_FP8 ? 512 : 1024}; pg8::GroupedOrder S; S.init(NE * CAP, 4096, C.nb, C.bid); S.rep = NREP(P + 3); pg8::EpiMoe1 E{HH};     \
        pg8::gemm_phase<pg8::EpiMoe1, pg8::GroupedOrder, PG8_ALIGN, PG8_SP2, MOE_FP8 != 0>(glds, g, S, E); SEAM(P + 3); if ((P) == 7) DBGCHK(0, chk_moe_h(C, args, ws, L, dacc, 6)); }                                       \
    if (IN(P + 4)) { pg8::Gemm g{HH, WD, NE * CAP, 1024, MOE_FP8 ? 1024 : 2048}; pg8::GroupedOrder S; S.init(NE * CAP, 1024, C.nb, C.bid); S.rep = NREP(P + 4); pg8::EpiMoe2 E{YY};      \
        pg8::gemm_phase<pg8::EpiMoe2, pg8::GroupedOrder, PG8_ALIGN, PG8_SP2, MOE_FP8 != 0>(glds, g, S, E); SEAM(P + 4); if ((P) == 7) DBGCHK(0, chk_moe_y(C, args, ws, L, dacc, 7)); }                                       \
    if (IN(P + 5)) for (int rep_ = 0; rep_ < NREP(P + 5); ++rep_) { ph_combine<TAILMODE>(C, HIN, AFF, SEL, YY, HOUT, GAIN2, XN, OUTP); SEAM(P + 5); if ((P) == 7) DBGCHK(0, chk_combine(C, ws, HIN, HOUT, dacc, 8)); }

    MOE_LAYER(7, 0, HA, 1, HB, (const float*)args.in[2] + 1024, nullptr)
    if (IN(13)) { pg8::Gemm g{XN, (const bf16_t*)(ws + WS_WMIN), T, 512, 1024}; pg8::StaticOrder S; S.init(T, 512, C.nb, C.bid); S.rep = NREP(13);
        pg8::EpiF32 E{(float*)(ws + AR_CIN), nullptr, 512}; pg8::gemm_phase<pg8::EpiF32, pg8::StaticOrder, false, PG8_SP2>(glds, g, S, E); SEAM(13); } DBGCHK(1, chk_cin(C, args, ws, dacc));
    if (IN(14)) { ph_mla_tok(C, (const float*)(ws + AR_CIN), (const int*)args.in[1], (const float*)args.in[13], (const float*)args.in[15], args.invf, (bf16_t*)(ws + AR_CQN), (bf16_t*)(ws + AR_CKVN),
                             (float*)(ws + WS_CS), (bf16_t*)(ws + AR_K));
        ph_convert_moe(C, args, ws, 1, NREP(14)); SEAM(14); } DBGCHK(1, chk_tok(C, args, ws, dacc));
    if (IN(15)) {
#if ATT_FP8
        { pg8::Gemm g{(const bf16_t*)(ws + AR_CQN), (const bf16_t*)(ws + WS_WUQ), T, 4096, 256}; pg8::StaticOrder S; S.init(T, 4096, C.nb, C.bid); S.rep = NREP(15);
          pg8::EpiQ8 E{ws + AR_Q8, (const float*)(ws + WS_CS)}; pg8::gemm_phase<pg8::EpiQ8, pg8::StaticOrder, PG8_ALIGN, PG8_SP2>(glds, g, S, E); }
        { pg8::Gemm g{(const bf16_t*)(ws + AR_CKVN), (const bf16_t*)(ws + WS_WUKV), T, 2048, 256}; pg8::StaticOrder S; S.init(T, 2048, C.nb, C.bid); S.rep = NREP(15);
          pg8::EpiK8 E{ws + AR_K8}; pg8::gemm_phase<pg8::EpiK8, pg8::StaticOrder, PG8_ALIGN, PG8_SP2>(glds, g, S, E); }
        { pg8::Gemm g{(const bf16_t*)(ws + WS_WUKV) + (size_t)2048 * 256, (const bf16_t*)(ws + AR_CKVN), 2048, T, 256}; pg8::StaticOrder S; S.init(2048, T, C.nb, C.bid); S.rep = NREP(15);
          pg8::EpiV8T E{ws + AR_V8T}; pg8::gemm_phase<pg8::EpiV8T, pg8::StaticOrder, PG8_ALIGN, PG8_SP2>(glds, g, S, E); }
#else
        { pg8::Gemm g{(const bf16_t*)(ws + AR_CQN), (const bf16_t*)(ws + WS_WUQ), T, 4096, 256}; pg8::StaticOrder S; S.init(T, 4096, C.nb, C.bid); S.rep = NREP(15);
          pg8::EpiQup E{(bf16_t*)(ws + AR_Q), (const float*)(ws + WS_CS)}; pg8::gemm_phase<pg8::EpiQup, pg8::StaticOrder, PG8_ALIGN, PG8_SP2>(glds, g, S, E); }
        { pg8::Gemm g{(const bf16_t*)(ws + AR_CKVN), (const bf16_t*)(ws + WS_WUKV), T, 4096, 256}; pg8::StaticOrder S; S.init(T, 4096, C.nb, C.bid); S.rep = NREP(15);
          pg8::EpiKVup E{(bf16_t*)(ws + AR_K), (bf16_t*)(ws + AR_V)}; pg8::gemm_phase<pg8::EpiKVup, pg8::StaticOrder, PG8_ALIGN, PG8_SP2>(glds, g, S, E); }
#endif
        SEAM(15); } DBGCHK(1, chk_qkv(C, args, ws, dacc));
    if (IN(16)) {
        const int nun = MH * (T / 256);
        for (int ii = 0; ii * C.nb + C.bid < nun * NREP(16); ++ii) { const int i = ii % (nun / C.nb);
            int h, qb; if (C.nb == 256) { h = (C.bid & 7) + 8 * (i >> 1); qb = (i & 1) * 32 + (C.bid >> 3); } else { const int u = i * C.nb + C.bid; h = u >> 6; qb = u & 63; }
#if ATT_FP8
            att8::attn_body(ws + AR_Q8 + ((size_t)h * T + (size_t)qb * 256) * MDK, ws + AR_K8 + (size_t)h * T * MDK, ws + AR_V8T + (size_t)h * MDV * T, (bf16_t*)(ws + AR_O) + (size_t)qb * 256 * 2048 + 128 * h, 2048, T, (char*)lds);
#else
            const bf16_t* Qb = (const bf16_t*)(ws + AR_Q) + ((size_t)h * T + (size_t)qb * 256) * MDK;
            att::attn_body(Qb, (const bf16_t*)(ws + AR_K) + (size_t)h * T * MDK, (const bf16_t*)(ws + AR_V) + (size_t)h * T * MDV, (bf16_t*)(ws + AR_O) + (size_t)qb * 256 * 2048 + 128 * h, 2048, T, (char*)lds);
#endif
            __syncthreads();
        }
        SEAM(16); } DBGCHK(1, chk_attn(C, ws, dacc));
    if (IN(17)) { pg8::Gemm g{(const bf16_t*)(ws + AR_O), (const bf16_t*)(ws + WS_WMOUT), T, 1024, 2048}; pg8::StaticOrder S; S.init(T, 1024, C.nb, C.bid); S.rep = NREP(17);
        pg8::EpiF32 E{HA, HB, 1024}; pg8::gemm_phase<pg8::EpiF32, pg8::StaticOrder, false, PG8_SP2>(glds, g, S, E); SEAM(17); } DBGCHK(1, chk_resid(C, HB, (const bf16_t*)(ws + AR_O), 2048, (const float*)args.in[17], HA, dacc, 14));
    MOE_LAYER(18, 1, HA, 2, nullptr, (const float*)args.in[4], args.out)
#ifdef DBG
    xcd_barrier(bar); dbg_report(C, ws, args.out, DBG == 0 ? 0 : 10, DBG == 0 ? 10 : 20);
#endif
#undef IN
#undef SEAM
}

#ifndef MK_N_LAUNCHES
#define MK_N_LAUNCHES 1
#endif
extern "C" void kernel_launch(void* const* d_in, const int* in_sizes, int n_in, void* d_out, int out_size, void* d_ws, size_t ws_size, hipStream_t stream) {
    static int grid = 0;
    if (grid == 0) {
        if (n_in != 22 || out_size != T * D || ws_size < WS_END) { fprintf(stderr, "kernel_launch: unexpected shapes (n_in %d out %d ws %zu, need ws >= %zu)\n", n_in, out_size, ws_size, (size_t)WS_END); grid = -1; return; }
        int dev = 0, cus = 0, per_cu = 0;
        if (hipGetDevice(&dev) != hipSuccess || hipDeviceGetAttribute(&cus, hipDeviceAttributeMultiprocessorCount, dev) != hipSuccess) { grid = -1; return; }
        if (hipFuncSetAttribute((const void*)mk_fwd, hipFuncAttributeMaxDynamicSharedMemorySize, LDS_BYTES) != hipSuccess) { fprintf(stderr, "kernel_launch: hipFuncSetAttribute failed\n"); grid = -1; return; }
        if (hipOccupancyMaxActiveBlocksPerMultiprocessor(&per_cu, (const void*)mk_fwd, 512, LDS_BYTES) != hipSuccess || per_cu < 1) fprintf(stderr, "kernel_launch: occupancy query says %d\n", per_cu);
        (void)hipGetLastError();
        grid = cus;
    }
    if (grid < 0) return;
    (void)hipMemsetAsync((char*)d_ws + WS_CTL, 0, CTL_ZERO_BYTES, stream);
    Args a{};
    for (int i = 0; i < 22; ++i) a.in[i] = d_in[i];
    a.out = (float*)d_out; a.ws = (unsigned char*)d_ws;
    for (int i = 0; i < 32; ++i) a.invf[i] = powf(10000.0f, -(float)i / 32.0f);
    if (MK_N_LAUNCHES == 1) { a.ph_lo = 0; a.ph_hi = NPHASE; a.li = 0; hipLaunchKernelGGL(mk_fwd, dim3(grid), dim3(512), LDS_BYTES, stream, a); }
    else { for (int p = 0; p < NPHASE; ++p) { a.ph_lo = p; a.ph_hi = p + 1; a.li = p; hipLaunchKernelGGL(mk_fwd, dim3(grid), dim3(512), LDS_BYTES, stream, a); } }
}
```

```cpp
#include <hip/hip_runtime.h>
#include <cstdio>
#include <cstdint>
#include <cmath>

constexpr int T = 16384, D = 1024, NE = 16, CAP = 2048, FF = 2048;
constexpr int GH = 4, GDK = 128, GDV = 256, GC = 64, GNC = T / GC;
constexpr int MH = 16, MDK = 192, MDV = 128;
constexpr float RMS_EPS = 1e-6f;

typedef unsigned short bf16_t;
typedef short bf16x8 __attribute__((ext_vector_type(8)));
typedef short s16x4 __attribute__((ext_vector_type(4)));
typedef float f32x4 __attribute__((ext_vector_type(4)));
typedef float f32x2 __attribute__((ext_vector_type(2)));
typedef float f32x16 __attribute__((ext_vector_type(16)));
typedef unsigned u32x4 __attribute__((ext_vector_type(4)));
typedef unsigned u32x2 __attribute__((ext_vector_type(2)));
typedef int i32x8 __attribute__((ext_vector_type(8)));
#ifndef MOE_FP8
#define MOE_FP8 1
#endif
#ifndef MLA_FP8
#define MLA_FP8 1
#endif
#ifndef ATT_FP8
#define ATT_FP8 1
#endif

constexpr size_t MiB = 1u << 20;
constexpr size_t WS_CTL = 0, CTL_ZERO_BYTES = 512 * 1024;
constexpr size_t WS_WGIN = 1 * MiB;
constexpr size_t WS_WV = 7 * MiB;
constexpr size_t WS_WGOUT = 9 * MiB;
constexpr size_t WS_WMIN = 11 * MiB;
constexpr size_t WS_WUQ = 12 * MiB;
constexpr size_t WS_WUKV = 14 * MiB;
constexpr size_t WS_WMOUT = 16 * MiB;
constexpr size_t WS_WGU = 20 * MiB;
constexpr size_t WS_WD = 148 * MiB;
constexpr size_t WS_AFF = 212 * MiB;
constexpr size_t WS_SEL = 213 * MiB;
constexpr size_t WS_IDX = 214 * MiB;
constexpr size_t WS_EGL = 215 * MiB;
constexpr size_t WS_CS = 216 * MiB;
constexpr size_t WS_XN = 220 * MiB;
constexpr size_t WS_HB = 252 * MiB;
constexpr size_t WS_AR = 316 * MiB;
constexpr size_t WS_AFFT = 828 * MiB;
constexpr size_t WS_END = 829 * MiB;
constexpr size_t AR_Q0 = WS_AR, AR_K0 = WS_AR + 16 * MiB, AR_GF = WS_AR + 32 * MiB, AR_GB = WS_AR + 64 * MiB, AR_SR = WS_AR + 96 * MiB, AR_VT = WS_AR + 128 * MiB;
constexpr size_t AR_QDF = WS_AR + 160 * MiB, AR_QDB = WS_AR + 176 * MiB, AR_KDF = WS_AR + 192 * MiB, AR_KDB = WS_AR + 208 * MiB, AR_KTF = WS_AR + 224 * MiB, AR_KTB = WS_AR + 240 * MiB;
constexpr size_t AR_U = WS_AR + 256 * MiB, AR_ST = WS_AR + 384 * MiB;
constexpr size_t AR_XS = WS_AR, AR_H = WS_AR + 64 * MiB, AR_Y = WS_AR + 192 * MiB, AR_XN8 = WS_AR + 256 * MiB;
constexpr size_t AR_CIN = WS_AR, AR_CQN = WS_AR + 32 * MiB, AR_CKVN = WS_AR + 40 * MiB, AR_Q = WS_AR + 48 * MiB, AR_K = WS_AR + 144 * MiB, AR_V = WS_AR + 240 * MiB, AR_O = WS_AR + 304 * MiB;

constexpr size_t AR_Q8 = AR_Q, AR_K8 = AR_K, AR_V8T = AR_V;
constexpr int LDS_BYTES = 147456;
constexpr int LDS_MISC = 135168;

__device__ __forceinline__ unsigned cvt_pk_bf16(float lo, float hi) { unsigned r; asm volatile("v_cvt_pk_bf16_f32 %0, %1, %2" : "=v"(r) : "v"(lo), "v"(hi)); return r; }
__device__ __forceinline__ float bf_lo(unsigned w) { return __uint_as_float(w << 16); }
__device__ __forceinline__ float bf_hi(unsigned w) { return __uint_as_float(w & 0xffff0000u); }
__device__ __forceinline__ float bf2f(bf16_t b) { return __uint_as_float(((unsigned)b) << 16); }
__device__ __forceinline__ bf16_t f2bf(float f) { return (bf16_t)(cvt_pk_bf16(f, 0.f) & 0xffffu); }
__device__ __forceinline__ float siluf(float x) { return x / (1.f + __expf(-x)); }
__device__ __forceinline__ float logsigf(float x) { return fminf(x, 0.f) - log1pf(__expf(-fabsf(x))); }
__device__ __forceinline__ void store8bf(bf16_t* p, f32x4 v0, f32x4 v1) {
    u32x4 w; w.x = cvt_pk_bf16(v0[0], v0[1]); w.y = cvt_pk_bf16(v0[2], v0[3]); w.z = cvt_pk_bf16(v1[0], v1[1]); w.w = cvt_pk_bf16(v1[2], v1[3]); *(u32x4*)p = w; }
__device__ __forceinline__ unsigned pk4fp8(float a, float b, float c, float d) { int w = __builtin_amdgcn_cvt_pk_fp8_f32(a, b, 0, false); w = __builtin_amdgcn_cvt_pk_fp8_f32(c, d, w, true); return (unsigned)w; }
__device__ __forceinline__ void store8fp8(unsigned char* p, f32x4 v0, f32x4 v1) { u32x2 w; w.x = pk4fp8(v0[0], v0[1], v0[2], v0[3]); w.y = pk4fp8(v1[0], v1[1], v1[2], v1[3]); *(u32x2*)p = w; }
__device__ __forceinline__ float fp8f(const unsigned char* p) { const unsigned w = *(const unsigned*)((size_t)p & ~(size_t)3); const int b = (int)((size_t)p & 3);
    return b == 0 ? __builtin_amdgcn_cvt_f32_fp8((int)w, 0) : b == 1 ? __builtin_amdgcn_cvt_f32_fp8((int)w, 1) : b == 2 ? __builtin_amdgcn_cvt_f32_fp8((int)w, 2) : __builtin_amdgcn_cvt_f32_fp8((int)w, 3); }
__device__ __forceinline__ float wave_sum(float v) {
#pragma unroll
    for (int o = 1; o < 64; o <<= 1) v += __shfl_xor(v, o);
    return v; }
__device__ __forceinline__ float wave_max(float v) {
#pragma unroll
    for (int o = 1; o < 64; o <<= 1) v = fmaxf(v, __shfl_xor(v, o));
    return v; }
#define LAS __attribute__((address_space(3)))
#define LDS_WAIT() asm volatile("s_waitcnt lgkmcnt(0)" ::: "memory")
#define VM_WAIT() asm volatile("s_waitcnt vmcnt(0)" ::: "memory")

namespace pg8 {
#define PG8_LAS __attribute__((address_space(3)))
typedef unsigned short bf16_t;
typedef short bf16x8 __attribute__((ext_vector_type(8)));
typedef float f32x4 __attribute__((ext_vector_type(4)));
typedef unsigned u32x4 __attribute__((ext_vector_type(4)));
constexpr int BM = 256, BK = 64, HALF = 128, HTB = HALF * BK * 2  , STAGE_BYTES = 8 * HTB, NXCD = 8, WGM = 8;

__host__ __device__ __forceinline__ int lds_byte(int r, int c) { const int st = (r >> 4) * 2 + (c >> 5), rr = r & 15, cc = c & 31, ob = rr * 64 + cc * 2; return st * 1024 + (ob ^ (((ob >> 9) & 1) << 5)); }
__host__ __device__ __forceinline__ void stage_rc(int b, int& R, int& C) { const int st = b / 1024, sb = b % 1024, swz = sb ^ (((sb >> 9) & 1) << 5); R = (st >> 1) * 16 + swz / 64; C = (st & 1) * 32 + (swz % 64) / 2; }
__host__ __device__ __forceinline__ int perm32(int rho) { const int n = rho >> 4, i = rho & 15; return 8 * (i >> 2) + 4 * n + (i & 3); }

struct Unit { int pm, pn; };
struct Gemm { const bf16_t* A; const bf16_t* Bt; int M, N, K; };

struct StaticOrder {
    int nM, nN, nwg, G, c, rep;
    __host__ __device__ void init(int M, int N, int G_, int c_) { nM = M / BM; nN = N / BM; nwg = nM * nN; G = G_; c = c_; rep = 1; }
    __host__ __device__ bool next(int i, Unit& u) const {
        if (rep > 1) { const int cnt = (nwg - c + G - 1) / G; if (cnt <= 0 || i >= cnt * rep) return false; i = i % cnt; }
        const long L = (long)i * G + c; if (L >= nwg) return false;
        int wgid = (int)L; { const int q = nwg / NXCD, r = nwg % NXCD, xcd = wgid % NXCD, off = wgid / NXCD; wgid = (xcd < r ? xcd * (q + 1) : r * (q + 1) + (xcd - r) * q) + off; }
        const int nig = WGM * nN, gid = wgid / nig, fm = gid * WGM, gsz = (nM - fm) < WGM ? (nM - fm) : WGM;
        u.pm = fm + ((wgid % nig) % gsz); u.pn = (wgid % nig) / gsz; return true;
    }
    __device__ __forceinline__ void a_ready(const Unit&) const {}
    __device__ __forceinline__ void done(const Unit&) const {}
};

struct GroupedOrder : StaticOrder {
    int nNl;
    __host__ __device__ void init(int Mtot, int Nper, int G_, int c_) { StaticOrder::init(Mtot, Nper, G_, c_); nNl = Nper / BM; }
    __host__ __device__ bool next(int i, Unit& u) const { if (!StaticOrder::next(i, u)) return false; u.pn += (u.pm >> 3) * nNl; return true; }
};

#define EPI_LOOP_ROWS for (int ai = 0; ai < 2; ++ai) _Pragma("unroll") for (int m = 0; m < 4; ++m)

struct EpiGlaIn {
    static constexpr bool PERM = true, AFTER_DRAIN = false;
    bf16_t *Q0, *K0, *SR; float *GF, *GB; const float *bF, *bB;
    __device__ __forceinline__ void operator()(const f32x4 (&acc)[2][2][4][2], const Unit& u, int wr, int wc, int fr, int fq) const {
        const int row0 = u.pm * BM + wr * 64 + fr, pn = u.pn;
#pragma unroll
        EPI_LOOP_ROWS { const size_t row = (size_t)(row0 + ai * HALF + m * 16);
#pragma unroll
            for (int bj = 0; bj < 2; ++bj) { const int cl = bj * HALF + wc * 32 + 8 * fq; f32x4 v0 = acc[ai][bj][m][0], v1 = acc[ai][bj][m][1];
                if (pn < 2) { const float s = 0.08838834764831845f; store8bf(Q0 + row * 512 + pn * 256 + cl, v0 * s, v1 * s); }
                else if (pn < 4) { store8bf(K0 + row * 512 + (pn - 2) * 256 + cl, v0, v1); }
                else if (pn < 8) {
#pragma unroll
                    for (int j = 0; j < 4; ++j) { v0[j] = siluf(v0[j]); v1[j] = siluf(v1[j]); }
                    store8bf(SR + row * 1024 + (pn - 4) * 256 + cl, v0, v1); }
                else { float* G = pn < 10 ? GF : GB; const float* b = pn < 10 ? bF : bB; const int c = ((pn - 8) & 1) * 256 + cl;
                    const f32x4 b0 = *(const f32x4*)(b + c), b1 = *(const f32x4*)(b + c + 4); f32x4 o0, o1;
#pragma unroll
                    for (int j = 0; j < 4; ++j) { o0[j] = logsigf(v0[j] + b0[j]) * 0.0625f; o1[j] = logsigf(v1[j] + b1[j]) * 0.0625f; }
                    *(f32x4*)(G + row * 512 + c) = o0; *(f32x4*)(G + row * 512 + c + 4) = o1; } } }
    }
};
struct EpiBf {
    static constexpr bool PERM = true, AFTER_DRAIN = false;
    bf16_t* O; int ldc;
    __device__ __forceinline__ void operator()(const f32x4 (&acc)[2][2][4][2], const Unit& u, int wr, int wc, int fr, int fq) const {
        const int row0 = u.pm * BM + wr * 64 + fr;
#pragma unroll
        EPI_LOOP_ROWS { bf16_t* rowp = O + (size_t)(row0 + ai * HALF + m * 16) * ldc + u.pn * BM + wc * 32 + 8 * fq;
#pragma unroll
            for (int bj = 0; bj < 2; ++bj) store8bf(rowp + bj * HALF, acc[ai][bj][m][0], acc[ai][bj][m][1]); }
    }
};
struct EpiF32 {
    static constexpr bool PERM = false, AFTER_DRAIN = false;
    float* C; const float* base; int ldc; float sc;
    __device__ __forceinline__ void operator()(const f32x4 (&acc)[2][2][4][2], const Unit& u, int wr, int wc, int fr, int fq) const {
        const int row0 = u.pm * BM + wr * 64 + fr, col0 = u.pn * BM + wc * 32 + 4 * fq;
#pragma unroll
        EPI_LOOP_ROWS { const size_t off = (size_t)(row0 + ai * HALF + m * 16) * ldc + col0;
#pragma unroll
            for (int bj = 0; bj < 2; ++bj)
#pragma unroll
                for (int n = 0; n < 2; ++n) { f32x4 v = acc[ai][bj][m][n] * sc; if (base) v = v + *(const f32x4*)(base + off + bj * HALF + n * 16); *(f32x4*)(C + off + bj * HALF + n * 16) = v; } }
    }
};
struct EpiQup {
    static constexpr bool PERM = true, AFTER_DRAIN = false;
    bf16_t* Q; const float* CS;
    __device__ __forceinline__ void operator()(const f32x4 (&acc)[2][2][4][2], const Unit& u, int wr, int wc, int fr, int fq) const {
        const int row0 = u.pm * BM + wr * 64 + fr, h = u.pn; const float QS = 0.07216878364870322f * 1.4426950408889634f;
#pragma unroll
        EPI_LOOP_ROWS { const size_t row = (size_t)(row0 + ai * HALF + m * 16); bf16_t* qrow = Q + ((size_t)h * T + row) * MDK;
            store8bf(qrow + wc * 32 + 8 * fq, acc[ai][0][m][0] * QS, acc[ai][0][m][1] * QS);
            if (wc < 2) { const int i0 = wc * 16 + 4 * fq; const f32x4 c = *(const f32x4*)(CS + row * 64 + i0), s = *(const f32x4*)(CS + row * 64 + 32 + i0);
                const f32x4 x1 = acc[ai][1][m][0], x2 = acc[ai][1][m][1];
                store8bf(qrow + 128 + wc * 32 + 8 * fq, (x1 * c - x2 * s) * QS, (x1 * s + x2 * c) * QS); } }
    }
};
struct EpiKVup {
    static constexpr bool PERM = true, AFTER_DRAIN = false;
    bf16_t *K, *V;
    __device__ __forceinline__ void operator()(const f32x4 (&acc)[2][2][4][2], const Unit& u, int wr, int wc, int fr, int fq) const {
        const int row0 = u.pm * BM + wr * 64 + fr, h = u.pn;
#pragma unroll
        EPI_LOOP_ROWS { const size_t row = (size_t)h * T + (size_t)(row0 + ai * HALF + m * 16);
            store8bf(K + row * MDK + wc * 32 + 8 * fq, acc[ai][0][m][0], acc[ai][0][m][1]);
            store8bf(V + row * MDV + wc * 32 + 8 * fq, acc[ai][1][m][0], acc[ai][1][m][1]); }
    }
};
struct EpiMoe1 {
    static constexpr bool PERM = true, AFTER_DRAIN = false;
    bf16_t* H;
    __device__ __forceinline__ void operator()(const f32x4 (&acc)[2][2][4][2], const Unit& u, int wr, int wc, int fr, int fq) const {
        const int row0 = u.pm * BM + wr * 64 + fr, j = u.pn & 15;
#pragma unroll
        EPI_LOOP_ROWS { const size_t eo = (size_t)(row0 + ai * HALF + m * 16) * FF + 128 * j + 16 * wc + 4 * fq; bf16_t* rowp = H + eo;
#pragma unroll
            for (int bj = 0; bj < 2; ++bj) { f32x4 g = acc[ai][bj][m][0], uu = acc[ai][bj][m][1];
                if (MOE_FP8) { g = g * 0.03125f; uu = uu * 0.03125f; *(unsigned*)((unsigned char*)H + eo + 64 * bj) = pk4fp8(siluf(g[0]) * uu[0], siluf(g[1]) * uu[1], siluf(g[2]) * uu[2], siluf(g[3]) * uu[3]); continue; }
                u32x2 w; w.x = cvt_pk_bf16(siluf(g[0]) * uu[0], siluf(g[1]) * uu[1]); w.y = cvt_pk_bf16(siluf(g[2]) * uu[2], siluf(g[3]) * uu[3]);
                *(u32x2*)(rowp + 64 * bj) = w; } }
    }
};
struct EpiMoe2 {
    static constexpr bool PERM = true, AFTER_DRAIN = false;
    bf16_t* Y;
    __device__ __forceinline__ void operator()(const f32x4 (&acc)[2][2][4][2], const Unit& u, int wr, int wc, int fr, int fq) const {
        const int row0 = u.pm * BM + wr * 64 + fr, j = u.pn & 3;
#pragma unroll
        EPI_LOOP_ROWS { bf16_t* rowp = Y + (size_t)(row0 + ai * HALF + m * 16) * D + 256 * j + wc * 32 + 8 * fq;
#pragma unroll
            for (int bj = 0; bj < 2; ++bj) { const float sc = MOE_FP8 ? 0.03125f : 1.0f; store8bf(rowp + bj * HALF, acc[ai][bj][m][0] * sc, acc[ai][bj][m][1] * sc); } }
    }
};

struct EpiQ8 {
    static constexpr bool PERM = true, AFTER_DRAIN = false;
    unsigned char* Q; const float* CS;
    __device__ __forceinline__ void operator()(const f32x4 (&acc)[2][2][4][2], const Unit& u, int wr, int wc, int fr, int fq) const {
        const int row0 = u.pm * BM + wr * 64 + fr, h = u.pn; const float QS = 8.0f * 0.07216878364870322f * 1.4426950408889634f;
#pragma unroll
        EPI_LOOP_ROWS { const size_t row = (size_t)(row0 + ai * HALF + m * 16); unsigned char* qrow = Q + ((size_t)h * T + row) * MDK;
            store8fp8(qrow + wc * 32 + 8 * fq, acc[ai][0][m][0] * QS, acc[ai][0][m][1] * QS);
            if (wc < 2) { const int i0 = wc * 16 + 4 * fq; const f32x4 c = *(const f32x4*)(CS + row * 64 + i0), s = *(const f32x4*)(CS + row * 64 + 32 + i0);
                const f32x4 x1 = acc[ai][1][m][0], x2 = acc[ai][1][m][1];
                store8fp8(qrow + 128 + wc * 32 + 8 * fq, (x1 * c - x2 * s) * QS, (x1 * s + x2 * c) * QS); } }
    }
};
struct EpiK8 {
    static constexpr bool PERM = true, AFTER_DRAIN = false;
    unsigned char* K;
    __device__ __forceinline__ void operator()(const f32x4 (&acc)[2][2][4][2], const Unit& u, int wr, int wc, int fr, int fq) const {
        const int row0 = u.pm * BM + wr * 64 + fr;
#pragma unroll
        EPI_LOOP_ROWS { const size_t row = (size_t)(row0 + ai * HALF + m * 16);
#pragma unroll
            for (int bj = 0; bj < 2; ++bj) store8fp8(K + ((size_t)(2 * u.pn + bj) * T + row) * MDK + wc * 32 + 8 * fq, acc[ai][bj][m][0], acc[ai][bj][m][1]); }
    }
};
struct EpiV8T {
    static constexpr bool PERM = true, AFTER_DRAIN = false;
    unsigned char* V;
    __device__ __forceinline__ void operator()(const f32x4 (&acc)[2][2][4][2], const Unit& u, int wr, int wc, int fr, int fq) const {
        const int row0 = u.pm * BM + wr * 64 + fr;
#pragma unroll
        EPI_LOOP_ROWS { unsigned char* rowp = V + (size_t)(row0 + ai * HALF + m * 16) * T + u.pn * BM + 64 * (wc >> 1) + 16 * (wc & 1) + 4 * fq;
#pragma unroll
            for (int bj = 0; bj < 2; ++bj) { const f32x4 a = acc[ai][bj][m][0], b = acc[ai][bj][m][1];
                *(unsigned*)(rowp + bj * HALF) = pk4fp8(a[0], a[1], a[2], a[3]); *(unsigned*)(rowp + bj * HALF + 32) = pk4fp8(b[0], b[1], b[2], b[3]); } }
    }
};

typedef int i32x4g __attribute__((ext_vector_type(4)));
template <class Epi, class Sched, bool ALIGN_EPI = false, bool SP2 = false, bool F8 = false>
__device__ __forceinline__ void gemm_phase(PG8_LAS unsigned char* lds, const Gemm g, const Sched& S, const Epi& E) {
    const int tid = threadIdx.x, wid = __builtin_amdgcn_readfirstlane(tid >> 6), lane = tid & 63, wr = wid >> 2, wc = wid & 3, fr = lane & 15, fq = lane >> 4;
    int K = g.K; asm volatile("" : "+s"(K));
    const int nt = K / BK;
    unsigned voffA[2], voffB[2];
#pragma unroll
    for (int i = 0; i < 2; ++i) { int R, C; stage_rc(tid * 16 + i * 8192, R, C); const int Rb = Epi::PERM ? ((R & ~31) + perm32(R & 31)) : R;
        voffA[i] = (unsigned)(R * K + C) * 2u; voffB[i] = (unsigned)(Rb * K + C) * 2u; }
    const size_t kstep = (size_t)(BK * 2);
    const size_t hstep = (size_t)HALF * K * 2;
    const size_t tstep = 2 * hstep;
    const unsigned ldsw = (unsigned)wid * 1024u;
    const int aoff = lds_byte(wr * 64 + fr, fq * 8), boff = lds_byte(wc * 32 + fr, fq * 8);
    PG8_LAS unsigned char* const ldsA = lds + aoff; PG8_LAS unsigned char* const ldsB = lds + 4 * HTB + boff;
#define PG8_SA(b, h) (((b) * 2 + (h)) * HTB)
#define PG8_SB(b, h) ((4 + (b) * 2 + (h)) * HTB)
#define PG8_STAGE(bufoff, gbase, voff) do { _Pragma("unroll") for (int _i = 0; _i < 2; ++_i) \
        __builtin_amdgcn_global_load_lds((const unsigned*)((const char*)(gbase) + (voff)[_i]), (PG8_LAS unsigned*)(lds + (bufoff) + ldsw + _i * 8192), 16, 0, 0); } while (0)
#define PG8_LD8(base, off) __builtin_shufflevector(*(const PG8_LAS i32x4g*)((base) + (off)), *(const PG8_LAS i32x4g*)((base) + (off) + 1024), 0, 1, 2, 3, 4, 5, 6, 7)
#define PG8_LDA(dst, b, h) do { _Pragma("unroll") for (int m = 0; m < 4; ++m) { if constexpr (F8) dst##8[m] = PG8_LD8(ldsA, PG8_SA(b, h) + m * 2048); else { _Pragma("unroll") for (int k = 0; k < 2; ++k) dst[m][k] = *(const PG8_LAS bf16x8*)(lds + PG8_SA(b, h) + aoff + m * 2048 + k * 1024); } } } while (0)
#define PG8_LDB(dst, b, h) do { _Pragma("unroll") for (int n = 0; n < 2; ++n) { if constexpr (F8) dst##8[n] = PG8_LD8(ldsB, PG8_SA(b, h) + n * 2048); else { _Pragma("unroll") for (int k = 0; k < 2; ++k) dst[n][k] = *(const PG8_LAS bf16x8*)(lds + PG8_SB(b, h) + boff + n * 2048 + k * 1024); } } } while (0)
#define PG8_CAT(x, y) __builtin_shufflevector((i32x4g)(x), (i32x4g)(y), 0, 1, 2, 3, 4, 5, 6, 7)
#define PG8_MMA(ai, bj, At, Bt) do { __builtin_amdgcn_s_setprio(1); _Pragma("unroll") for (int m = 0; m < 4; ++m) _Pragma("unroll") for (int n = 0; n < 2; ++n) { \
        if constexpr (F8) asm volatile("v_mfma_scale_f32_16x16x128_f8f6f4 %0, %1, %2, %0, %3, %3 op_sel_hi:[0,0,0]" : "+v"(acc[ai][bj][m][n]) : "v"(Bt##8[n]), "v"(At##8[m]), "v"(scl8));     \
        else { _Pragma("unroll") for (int k = 0; k < 2; ++k) acc[ai][bj][m][n] = __builtin_amdgcn_mfma_f32_16x16x32_bf16(Bt[n][k], At[m][k], acc[ai][bj][m][n], 0, 0, 0); } } \
        __builtin_amdgcn_s_setprio(0); } while (0)
#define PG8_WAIT_V(n) asm volatile("s_waitcnt vmcnt(" #n ")" ::: "memory")
#define PG8_WAIT_L(n) asm volatile("s_waitcnt lgkmcnt(" #n ")" ::: "memory")
#define PG8_BAR __builtin_amdgcn_s_barrier()
#define PG8_SCHED __builtin_amdgcn_sched_barrier(0)
    Unit cur, nxt; int ui = 0;
    if (!S.next(0, cur)) return;
    f32x4 acc[2][2][4][2];
#pragma unroll
    for (int a = 0; a < 2; ++a)
#pragma unroll
        for (int b = 0; b < 2; ++b)
#pragma unroll
            for (int m = 0; m < 4; ++m)
#pragma unroll
                for (int n = 0; n < 2; ++n) acc[a][b][m][n] = (f32x4){0.f, 0.f, 0.f, 0.f};
    unsigned scl8 = 0x7f7f7f7fu; asm volatile("" : "+v"(scl8));
    bf16x8 At[4][2], B0[2][2], B1[2][2]; i32x8 At8[4], B08[2], B18[2];
    const char* cA = (const char*)g.A + (size_t)cur.pm * tstep; const char* cB = (const char*)g.Bt + (size_t)cur.pn * tstep;
    S.a_ready(cur);
    if constexpr (SP2) {
        PG8_STAGE(PG8_SB(0, 0), cB, voffB); PG8_STAGE(PG8_SB(0, 1), cB + hstep, voffB); PG8_STAGE(PG8_SA(0, 0), cA, voffA); PG8_STAGE(PG8_SA(0, 1), cA + hstep, voffA);
        if (wr == 1) PG8_BAR;
        PG8_WAIT_V(2); PG8_BAR;
        PG8_STAGE(PG8_SB(1, 0), cB + kstep, voffB); PG8_STAGE(PG8_SA(1, 0), cA + kstep, voffA); PG8_STAGE(PG8_SB(1, 1), cB + hstep + kstep, voffB);
        PG8_WAIT_V(6); PG8_BAR;
    } else {
        PG8_STAGE(PG8_SB(0, 0), cB, voffB); PG8_STAGE(PG8_SA(0, 0), cA, voffA); PG8_STAGE(PG8_SB(0, 1), cB + hstep, voffB); PG8_STAGE(PG8_SA(0, 1), cA + hstep, voffA);
        if (wr == 1) PG8_BAR;
        PG8_WAIT_V(4); PG8_BAR;
        PG8_STAGE(PG8_SB(1, 0), cB + kstep, voffB); PG8_STAGE(PG8_SA(1, 0), cA + kstep, voffA); PG8_STAGE(PG8_SB(1, 1), cB + hstep + kstep, voffB);
        PG8_WAIT_V(6); PG8_BAR;
    }
    for (;;) {
        const bool has_next = S.next(ui + 1, nxt);
        const char* nA = has_next ? (const char*)g.A + (size_t)nxt.pm * tstep : cA; const char* nB = has_next ? (const char*)g.Bt + (size_t)nxt.pn * tstep : cB;
        for (int t = 0; t < nt; t += 2) {
            const bool last = (t == nt - 2);
            const char* a1 = cA + (size_t)(t + 1) * kstep;
            const char* a2 = last ? nA : cA + (size_t)(t + 2) * kstep; const char* b2 = last ? nB : cB + (size_t)(t + 2) * kstep;
            const char* a3 = a2 + kstep; const char* b3 = b2 + kstep;
            if (last && has_next) S.a_ready(nxt);
            if constexpr (SP2) {
            PG8_LDB(B0, 0, 0); PG8_LDB(B1, 0, 1); PG8_SCHED; PG8_LDA(At, 0, 0); PG8_STAGE(PG8_SA(1, 1), a1 + hstep, voffA);
            PG8_WAIT_V(8); PG8_WAIT_L(0); PG8_BAR; PG8_MMA(0, 0, At, B0); PG8_MMA(0, 1, At, B1); PG8_BAR; PG8_SCHED;
            PG8_LDA(At, 0, 1); PG8_STAGE(PG8_SB(0, 0), b2, voffB); PG8_STAGE(PG8_SB(0, 1), b2 + hstep, voffB); PG8_STAGE(PG8_SA(0, 0), a2, voffA);
            PG8_WAIT_V(8); PG8_WAIT_L(0); PG8_BAR; PG8_MMA(1, 0, At, B0); PG8_MMA(1, 1, At, B1); PG8_BAR; PG8_SCHED;
            PG8_LDB(B0, 1, 0); PG8_LDB(B1, 1, 1); PG8_SCHED; PG8_LDA(At, 1, 0); PG8_STAGE(PG8_SA(0, 1), a2 + hstep, voffA);
            PG8_WAIT_V(8); PG8_WAIT_L(0); PG8_BAR; PG8_MMA(0, 0, At, B0); PG8_MMA(0, 1, At, B1); PG8_BAR; PG8_SCHED;
            PG8_LDA(At, 1, 1); PG8_STAGE(PG8_SB(1, 0), b3, voffB); PG8_STAGE(PG8_SB(1, 1), b3 + hstep, voffB); PG8_STAGE(PG8_SA(1, 0), a3, voffA);
            PG8_WAIT_V(8); PG8_WAIT_L(0); PG8_BAR; PG8_MMA(1, 0, At, B0); PG8_MMA(1, 1, At, B1); PG8_BAR; PG8_SCHED;
            } else {
            PG8_LDB(B0, 0, 0); PG8_SCHED; PG8_LDA(At, 0, 0); PG8_STAGE(PG8_SA(1, 1), a1 + hstep, voffA);
            PG8_WAIT_L(8); PG8_BAR; PG8_WAIT_L(0); PG8_MMA(0, 0, At, B0); PG8_BAR; PG8_SCHED;
            PG8_LDB(B1, 0, 1); PG8_STAGE(PG8_SB(0, 0), b2, voffB);
            PG8_BAR; PG8_WAIT_L(0); PG8_MMA(0, 1, At, B1); PG8_BAR;
            PG8_LDA(At, 0, 1); PG8_STAGE(PG8_SA(0, 0), a2, voffA);
            PG8_BAR; PG8_WAIT_L(0); PG8_MMA(1, 0, At, B0); PG8_BAR; PG8_SCHED;
            PG8_STAGE(PG8_SB(0, 1), b2 + hstep, voffB);
            PG8_WAIT_V(6); PG8_BAR; PG8_MMA(1, 1, At, B1); PG8_BAR;
            PG8_LDB(B0, 1, 0); PG8_SCHED; PG8_LDA(At, 1, 0); PG8_STAGE(PG8_SA(0, 1), a2 + hstep, voffA);
            PG8_WAIT_L(8); PG8_BAR; PG8_WAIT_L(0); PG8_MMA(0, 0, At, B0); PG8_BAR; PG8_SCHED;
            PG8_LDB(B1, 1, 1); PG8_STAGE(PG8_SB(1, 0), b3, voffB);
            PG8_BAR; PG8_WAIT_L(0); PG8_MMA(0, 1, At, B1); PG8_BAR;
            PG8_LDA(At, 1, 1); PG8_STAGE(PG8_SA(1, 0), a3, voffA);
            PG8_BAR; PG8_WAIT_L(0); PG8_MMA(1, 0, At, B0); PG8_BAR; PG8_SCHED;
            PG8_STAGE(PG8_SB(1, 1), b3 + hstep, voffB);
            PG8_WAIT_V(6); PG8_BAR; PG8_MMA(1, 1, At, B1); PG8_BAR;
            }
        }
        if constexpr (F8) asm volatile("s_nop 15\n\ts_nop 15" ::: "memory");
        if constexpr (ALIGN_EPI) { if (wr == 0) PG8_BAR; }
        if constexpr (!Epi::AFTER_DRAIN) { E(acc, cur, wr, wc, fr, fq); S.done(cur); }
        if (!has_next) break;
#pragma unroll
        for (int a = 0; a < 2; ++a)
#pragma unroll
            for (int b = 0; b < 2; ++b)
#pragma unroll
                for (int m = 0; m < 4; ++m)
#pragma unroll
                    for (int n = 0; n < 2; ++n) acc[a][b][m][n] = (f32x4){0.f, 0.f, 0.f, 0.f};
        cur = nxt; cA = nA; cB = nB; ++ui;
        if constexpr (ALIGN_EPI) { if (wr == 1) PG8_BAR; }
    }
    PG8_WAIT_V(0);
    if constexpr (!ALIGN_EPI) { if (wr == 0) PG8_BAR; }
    PG8_BAR;
    if constexpr (Epi::AFTER_DRAIN) { E.fused(acc, cur, wr, wc, fr, fq, lds, wid, lane); S.done(cur); }
#undef PG8_SA
#undef PG8_SB
#undef PG8_STAGE
#undef PG8_LDA
#undef PG8_LD8
#undef PG8_LDB
#undef PG8_MMA
#undef PG8_CAT
#undef PG8_WAIT_V
#undef PG8_WAIT_L
#undef PG8_BAR
#undef PG8_SCHED
}
}
#define XB_TMO      128
#define XB_XCNT(j)  (256  + 64 * (j))
#define XB_XSUB(j)  (1280 + 64 * (j))
#define XB_XGEN(j)  (2304 + 64 * (j))
#define XB_TOP      3328
#define XB_TOPGEN   3392
#define XCD_BAR_WORDS 3456
#define XB_SPIN_CAP (1u << 18)

__device__ __forceinline__ unsigned xb_ld(unsigned* p)              { return __hip_atomic_load(p, __ATOMIC_RELAXED, __HIP_MEMORY_SCOPE_AGENT); }
__device__ __forceinline__ unsigned xb_add(unsigned* p, unsigned v) { return __hip_atomic_fetch_add(p, v, __ATOMIC_RELAXED, __HIP_MEMORY_SCOPE_AGENT); }
__device__ __forceinline__ unsigned xb_xcc_id() { return (unsigned)__builtin_amdgcn_s_getreg((3 << 11) | 20) & 0xFu; }
#define XB_SPIN(cond, bar) do { unsigned _sp = 0; while (cond) { __builtin_amdgcn_s_sleep(1); \
    if ((++_sp & 255u) == 0u) { if (xb_ld(&(bar)[XB_TMO])) break; if (_sp > XB_SPIN_CAP) { atomicAdd(&(bar)[XB_TMO], 1u); break; } } } } while (0)

struct XcdBarrier {
    unsigned* bar; unsigned x;
    volatile LAS unsigned* st;
};

__device__ __forceinline__ XcdBarrier xcd_barrier_post(unsigned* bar, volatile LAS unsigned* st) {
    XcdBarrier b; b.bar = bar; b.x = xb_xcc_id(); b.st = st;
    if (threadIdx.x == 0) (void)xb_add(&bar[XB_XCNT(b.x)], 1u);
    return b;
}
__device__ __forceinline__ void xcd_barrier_complete(unsigned* bar, unsigned x, unsigned& nloc, unsigned& nx) {
    const unsigned G = gridDim.x * gridDim.y * gridDim.z;
    unsigned sum, cnt, mine, sp = 0u;
    for (;;) {
        sum = 0u; cnt = 0u; mine = 0u;
#pragma unroll
        for (unsigned j = 0; j < 16; ++j) { const unsigned c = xb_ld(&bar[XB_XCNT(j)]); sum += c; cnt += (c > 0u) ? 1u : 0u; mine = (j == x) ? c : mine; }
        if (sum == G) break;
        __builtin_amdgcn_s_sleep(1);
        if ((++sp & 255u) == 0u) { if (xb_ld(&bar[XB_TMO])) break; if (sp > XB_SPIN_CAP) { atomicAdd(&bar[XB_TMO], 1u); break; } }
    }
    nloc = mine > 0u ? mine : 1u; nx = cnt > 0u ? cnt : 1u;
}

__device__ __forceinline__ void xcd_barrier(const XcdBarrier& b) {
    asm volatile("s_waitcnt vmcnt(0)" ::: "memory");
    __syncthreads();
    if (threadIdx.x == 0) {
        unsigned* bar = b.bar;
        __builtin_amdgcn_s_waitcnt(0);
        unsigned nloc = b.st[0], nx = b.st[1];
        if (nloc == 0u) { xcd_barrier_complete(bar, b.x, nloc, nx); b.st[0] = nloc; b.st[1] = nx; }
        const unsigned old = xb_add(&bar[XB_XSUB(b.x)], 1u);
        const unsigned gen = old / nloc;
        if (old + 1u == (gen + 1u) * nloc) {
            __builtin_amdgcn_fence(__ATOMIC_RELEASE, "agent");
            asm volatile("s_waitcnt vmcnt(0)" ::: "memory");
            const unsigned og = xb_add(&bar[XB_TOP], 1u);
            const unsigned tg = og / nx;
            if (og + 1u == (tg + 1u) * nx) xb_add(&bar[XB_TOPGEN], 1u);
            else XB_SPIN(xb_ld(&bar[XB_TOPGEN]) == tg, bar);
            __builtin_amdgcn_fence(__ATOMIC_ACQUIRE, "agent");
            xb_add(&bar[XB_XGEN(b.x)], 1u);
            asm volatile("s_waitcnt vmcnt(0)" ::: "memory");
        } else {
            XB_SPIN(xb_ld(&bar[XB_XGEN(b.x)]) == gen, bar);
            __builtin_amdgcn_fence(__ATOMIC_ACQUIRE, "agent");
            asm volatile("s_waitcnt vmcnt(0)" ::: "memory");
        }
    }
    __syncthreads();
}

#ifndef PG8_SP2
#define PG8_SP2 true
#endif
#ifndef PG8_ALIGN
#define PG8_ALIGN true
#endif

struct Args { const void* in[22]; float* out; unsigned char* ws; float invf[32]; int ph_lo, ph_hi, li, pad; };
struct Ctx { int tid, lane, wave, gw, ngw, bid, nb; unsigned char* lds; };

struct MapId { int off; __device__ __forceinline__ int operator()(int n) const { return off + n; } };
struct MapGU { int which; __device__ __forceinline__ int operator()(int f) const { return 8 * (f >> 2) + 4 * which + (f & 3); } };
struct MapUkv { __device__ __forceinline__ int operator()(int n) const { const int h = n >> 8, j = n & 255; return ATT_FP8 ? (j < 128 ? 128 * h + j : 2048 + 128 * h + (j - 128)) : n; } };
struct MapUq { __device__ __forceinline__ int operator()(int n) const { const int h = n / 192, j = n - h * 192;
    if (j < 128) return 256 * h + j; if (j < 160) { const int i = j - 128; return 256 * h + 128 + 8 * (i >> 2) + (i & 3); } const int i = j - 160; return 256 * h + 128 + 8 * (i >> 2) + 4 + (i & 3); } };
constexpr int TR_SCR = 16896;
__device__ __forceinline__ void tr_load(const float* W, int ldw, int k0, int n0, f32x4 (&v)[16], int lane) {
#pragma unroll
    for (int i = 0; i < 16; ++i) v[i] = *(const f32x4*)(W + (size_t)(k0 + (lane >> 4) + 4 * i) * ldw + n0 + 4 * (lane & 15));
}
template <class RM, bool F8 = false>
__device__ __forceinline__ void tr_flush(const f32x4 (&v)[16], bf16_t* WT, int ldt, int k0, int nloc0, const RM& rm, float* scr, int lane) {
    const int nb = 4 * (lane & 15), kq = lane >> 4;
#pragma unroll
    for (int i = 0; i < 16; ++i) { float* d = scr + nb * 65 + kq + 4 * i; d[0] = v[i][0]; d[65] = v[i][1]; d[130] = v[i][2]; d[195] = v[i][3]; }
    LDS_WAIT();
    const int c = lane & 7;
#pragma unroll
    for (int j = 0; j < 8; ++j) { const int n = (lane >> 3) + 8 * j; const float* q = scr + n * 65 + 8 * c;
        if constexpr (F8) { u32x2 o; o.x = pk4fp8(q[0] * 32.f, q[1] * 32.f, q[2] * 32.f, q[3] * 32.f); o.y = pk4fp8(q[4] * 32.f, q[5] * 32.f, q[6] * 32.f, q[7] * 32.f);
            *(u32x2*)((unsigned char*)WT + (size_t)rm(nloc0 + n) * ldt + k0 + 8 * c) = o; }
        else { u32x4 o; o.x = cvt_pk_bf16(q[0], q[1]); o.y = cvt_pk_bf16(q[2], q[3]); o.z = cvt_pk_bf16(q[4], q[5]); o.w = cvt_pk_bf16(q[6], q[7]);
        *(u32x4*)(WT + (size_t)rm(nloc0 + n) * ldt + k0 + 8 * c) = o; } }
    LDS_WAIT();
}
template <class RM, bool F8 = false>
__device__ __forceinline__ void tr_job(const Ctx& C, int& base, const float* W, int ldw, int K, int ncol0, int ncols, bf16_t* WT, int ldt, const RM& rm) {
    const int nblk = ncols / 64, items = (K / 64) * nblk; float* scr = (float*)(C.lds + C.wave * TR_SCR);
    int first = (C.gw - base % C.ngw + C.ngw) % C.ngw;
    for (int it = first; it < items; it += C.ngw) { const int kb = it / nblk, nb = it - kb * nblk; f32x4 v[16]; tr_load(W, ldw, 64 * kb, ncol0 + 64 * nb, v, C.lane); tr_flush<RM, F8>(v, WT, ldt, 64 * kb, 64 * nb, rm, scr, C.lane); }
    base += items;
}
__device__ __forceinline__ void ph_convert_small(const Ctx& C, const Args& a, unsigned char* ws) {
    const float* w_in = (const float*)a.in[5]; int base = 0;
    bf16_t* WGIN = (bf16_t*)(ws + WS_WGIN);
    tr_job(C, base, w_in, 3104, 1024, 0, 1024, WGIN, 1024, MapId{0});
    tr_job(C, base, w_in, 3104, 1024, 1024, 1024, (bf16_t*)(ws + WS_WV), 1024, MapId{0});
    tr_job(C, base, w_in, 3104, 1024, 2048, 1024, WGIN, 1024, MapId{1024});
    tr_job(C, base, (const float*)a.in[11], 1024, 1024, 0, 1024, (bf16_t*)(ws + WS_WGOUT), 1024, MapId{0});
    tr_job<MapId, MLA_FP8 != 0>(C, base, (const float*)a.in[12], 448, 1024, 0, 448, (bf16_t*)(ws + WS_WMIN), 1024, MapId{0});
    tr_job(C, base, (const float*)a.in[14], 3072, 256, 0, 3072, (bf16_t*)(ws + WS_WUQ), 256, MapUq{});
    tr_job(C, base, (const float*)a.in[16], 4096, 128, 0, 4096, (bf16_t*)(ws + WS_WUKV), 256, MapUkv{});
    tr_job<MapId, MLA_FP8 != 0>(C, base, (const float*)a.in[17], 1024, 2048, 0, 1024, (bf16_t*)(ws + WS_WMOUT), 2048, MapId{0});
    const int gt = C.bid * 512 + C.tid, ngt = C.nb * 512;
    for (int it = gt; it < 1024 * 128; it += ngt) { const int cp = it >> 7, k8 = it & 127, dir = cp >> 9, c = cp & 511;
        const float* wg = (const float*)a.in[dir ? 8 : 6]; float wj[16];
#pragma unroll
        for (int j = 0; j < 16; ++j) wj[j] = wg[j * 512 + c];
        float o[8];
#pragma unroll
        for (int kk = 0; kk < 8; ++kk) { const float* wr = w_in + (size_t)(8 * k8 + kk) * 3104 + 3072 + 16 * dir; float s = 0.f;
#pragma unroll
            for (int j4 = 0; j4 < 4; ++j4) { const f32x4 x = *(const f32x4*)(wr + 4 * j4); s += x[0] * wj[4 * j4] + x[1] * wj[4 * j4 + 1] + x[2] * wj[4 * j4 + 2] + x[3] * wj[4 * j4 + 3]; }
            o[kk] = s; }
        u32x4 w; w.x = cvt_pk_bf16(o[0], o[1]); w.y = cvt_pk_bf16(o[2], o[3]); w.z = cvt_pk_bf16(o[4], o[5]); w.w = cvt_pk_bf16(o[6], o[7]);
        *(u32x4*)(WGIN + (size_t)(2048 + cp) * 1024 + 8 * k8) = w; }
    const u32x4 z = {0u, 0u, 0u, 0u};
    if (MLA_FP8) { for (int it = gt; it < 64 * 64; it += ngt) *(u32x4*)(ws + WS_WMIN + (size_t)448 * 1024 + (size_t)it * 16) = z; }
    else for (int it = gt; it < 64 * 128; it += ngt) *(u32x4*)((bf16_t*)(ws + WS_WMIN) + (size_t)448 * 1024 + (size_t)it * 8) = z;
    for (int it = gt; it < 16 * 64 * 32; it += ngt) { const int h = it >> 11, r = (it >> 5) & 63, c8 = it & 31; *(u32x4*)((bf16_t*)(ws + WS_WUQ) + (size_t)(256 * h + 192 + r) * 256 + c8 * 8) = z; }
    for (int it = gt; it < 4096 * 16; it += ngt) { const int r = it >> 4, c8 = it & 15; *(u32x4*)((bf16_t*)(ws + WS_WUKV) + (size_t)r * 256 + 128 + c8 * 8) = z; }
}
struct MapMoe { int kind; __device__ __forceinline__ int operator()(int f) const { return kind < 2 ? 8 * (f >> 2) + 4 * kind + (f & 3) : f; } };
struct MoeItem { const float* src; bf16_t* dst; int ldw, ldt, k0, n0, kind; };
__device__ __forceinline__ MoeItem moe_item(const Args& a, unsigned char* ws, int layer, int it) {
    const int e = it / 1536, r = it - e * 1536, which = r >> 9, j = r & 511; const size_t le = (size_t)(layer * NE + e); MoeItem m; m.kind = which;
    if (which < 2) { m.src = (const float*)a.in[19 + which] + le * 1024 * 2048; m.ldw = 2048; m.dst = (bf16_t*)(ws + WS_WGU + (size_t)e * 4096 * 1024 * (MOE_FP8 ? 1 : 2)); m.ldt = 1024; m.k0 = 64 * (j >> 5); m.n0 = 64 * (j & 31); }
    else { m.src = (const float*)a.in[21] + le * 2048 * 1024; m.ldw = 1024; m.dst = (bf16_t*)(ws + WS_WD + (size_t)e * 1024 * 2048 * (MOE_FP8 ? 1 : 2)); m.ldt = 2048; m.k0 = 64 * (j >> 4); m.n0 = 64 * (j & 15); }
    return m;
}
__device__ __forceinline__ void ph_convert_moe(const Ctx& C, const Args& a, unsigned char* ws, int layer, int rep) {
    constexpr int NIT1 = NE * 1536; const int NIT = NIT1 * rep; float* scr = (float*)(C.lds + C.wave * TR_SCR);
    int it = C.gw; if (it >= NIT) return;
    f32x4 va[16], vb[16]; MoeItem ma = moe_item(a, ws, layer, it % NIT1), mb = ma; tr_load(ma.src, ma.ldw, ma.k0, ma.n0, va, C.lane);
    for (;;) {
        int nx = it + C.ngw; if (nx < NIT) { mb = moe_item(a, ws, layer, nx % NIT1); tr_load(mb.src, mb.ldw, mb.k0, mb.n0, vb, C.lane); }
        tr_flush<MapMoe, MOE_FP8 != 0>(va, ma.dst, ma.ldt, ma.k0, ma.n0, MapMoe{ma.kind}, scr, C.lane);
        it = nx; if (it >= NIT) break;
        nx = it + C.ngw; if (nx < NIT) { ma = moe_item(a, ws, layer, nx % NIT1); tr_load(ma.src, ma.ldw, ma.k0, ma.n0, va, C.lane); }
        tr_flush<MapMoe, MOE_FP8 != 0>(vb, mb.dst, mb.ldt, mb.k0, mb.n0, MapMoe{mb.kind}, scr, C.lane);
        it = nx; if (it >= NIT) break;
    }
}

__device__ __forceinline__ void row_load(const float* row, int lane, f32x4 (&v)[4]) {
#pragma unroll
    for (int j = 0; j < 4; ++j) v[j] = *(const f32x4*)(row + 256 * j + 4 * lane); }
__device__ __forceinline__ float row_rstd(const f32x4 (&v)[4]) { float s = 0.f;
#pragma unroll
    for (int j = 0; j < 4; ++j) s += (v[j][0] * v[j][0] + v[j][1] * v[j][1]) + (v[j][2] * v[j][2] + v[j][3] * v[j][3]);
    return 1.0f / sqrtf(wave_sum(s) * (1.0f / 1024.0f) + RMS_EPS); }
__device__ __forceinline__ void row_store_bf(bf16_t* row, int lane, const f32x4 (&v)[4]) {
#pragma unroll
    for (int j = 0; j < 4; ++j) { u32x2 w; w.x = cvt_pk_bf16(v[j][0], v[j][1]); w.y = cvt_pk_bf16(v[j][2], v[j][3]); *(u32x2*)(row + 256 * j + 4 * lane) = w; } }

__device__ __forceinline__ void ph_norm(const Ctx& C, const float* src, const float* gain, bf16_t* XN) {
    f32x4 g[4]; row_load(gain, C.lane, g);
    for (int t = C.gw; t < T; t += C.ngw) { f32x4 v[4]; row_load(src + (size_t)t * D, C.lane, v); const float r = row_rstd(v);
#pragma unroll
        for (int j = 0; j < 4; ++j) v[j] = v[j] * r * g[j];
        row_store_bf(XN + (size_t)t * D, C.lane, v); }
}
__device__ __forceinline__ void ph_router(const Ctx& C, const float* Hin, const float* gain, const float* Wr, bf16_t* XN, float* AFF, float* AFFT, unsigned char* XN8) {
    f32x4* Wl = (f32x4*)C.lds;
    for (int idx = C.tid; idx < 4096; idx += 512) { const int l = idx & 63, e4 = (idx >> 6) & 3, i = (idx >> 8) & 3, j = idx >> 10; Wl[idx] = *(const f32x4*)(Wr + (size_t)(256 * j + 4 * l + i) * 16 + 4 * e4); }
    __syncthreads();
    f32x4 g[4]; row_load(gain, C.lane, g);
    for (int t = C.gw; t < T; t += C.ngw) {
        f32x4 v[4]; row_load(Hin + (size_t)t * D, C.lane, v); const float r = row_rstd(v);
#pragma unroll
        for (int j = 0; j < 4; ++j) v[j] = v[j] * r * g[j];
#if MOE_FP8
#pragma unroll
        for (int j = 0; j < 4; ++j) *(unsigned*)(XN8 + (size_t)t * D + 256 * j + 4 * C.lane) = pk4fp8(v[j][0], v[j][1], v[j][2], v[j][3]);
#ifdef DBG
        row_store_bf(XN + (size_t)t * D, C.lane, v);
#endif
#else
        row_store_bf(XN + (size_t)t * D, C.lane, v);
#endif
        float p[16];
#pragma unroll
        for (int e = 0; e < 16; ++e) p[e] = 0.f;
#pragma unroll
        for (int j = 0; j < 4; ++j)
#pragma unroll
            for (int i = 0; i < 4; ++i) { const float x = v[j][i];
#pragma unroll
                for (int e4 = 0; e4 < 4; ++e4) { const f32x4 w = Wl[((j * 4 + i) * 4 + e4) * 64 + C.lane]; p[4 * e4] += x * w[0]; p[4 * e4 + 1] += x * w[1]; p[4 * e4 + 2] += x * w[2]; p[4 * e4 + 3] += x * w[3]; }  asm volatile("" ::: "memory"); }
        float mx = -1e30f;
#pragma unroll
        for (int e = 0; e < 16; ++e) { p[e] = wave_sum(p[e]); mx = fmaxf(mx, p[e]); }
        float s = 0.f;
#pragma unroll
        for (int e = 0; e < 16; ++e) { p[e] = expf(p[e] - mx); s += p[e]; }
        const float inv = 1.0f / s; float mine = 0.f;
#pragma unroll
        for (int e = 0; e < 16; ++e) mine = (C.lane == e) ? p[e] * inv : mine;
        if (C.lane < 16) { AFF[(size_t)t * 16 + C.lane] = mine; AFFT[(size_t)C.lane * T + t] = mine; }
    }
    __syncthreads();
}
__device__ __forceinline__ void ph_select(const Ctx& C, const float* AFFT, int* SEL, int* IDX) {
    if (C.bid >= NE) return;
    const int e = C.bid; unsigned* vals = (unsigned*)C.lds; unsigned* hist = vals + T; unsigned* sh = hist + 256;
    for (int i = C.tid; i < T; i += 512) vals[i] = __float_as_uint(AFFT[(size_t)e * T + i]);
    __syncthreads();
    unsigned prefix = 0u, mask = 0u, remaining = CAP;
    for (int pass = 0; pass < 4; ++pass) { const int shift = 24 - 8 * pass;
        if (C.tid < 256) hist[C.tid] = 0u;
        __syncthreads();
        for (int i = C.tid; i < T; i += 512) { const unsigned v = vals[i]; if ((v & mask) == prefix) atomicAdd(&hist[(v >> shift) & 255u], 1u); }
        __syncthreads();
        if (C.wave == 0) {
            unsigned cb[4]; unsigned tl = 0u;
#pragma unroll
            for (int j = 0; j < 4; ++j) { cb[j] = hist[255 - (4 * C.lane + j)]; tl += cb[j]; }
            unsigned incl = tl;
#pragma unroll
            for (int o = 1; o < 64; o <<= 1) { const unsigned tt = __shfl_up(incl, o); if (C.lane >= o) incl += tt; }
            unsigned cum = incl - tl;
            if (cum < remaining && remaining <= incl) {
#pragma unroll
                for (int j = 0; j < 4; ++j) { if (cum < remaining && cum + cb[j] >= remaining) { sh[0] = (unsigned)(255 - (4 * C.lane + j)); sh[1] = remaining - cum; } cum += cb[j]; } } }
        __syncthreads();
        prefix |= sh[0] << shift; mask |= 255u << shift; remaining = sh[1];
        __syncthreads();
    }
    const unsigned thr = prefix, ntie = remaining;
    unsigned cg = 0u, ce = 0u;
    for (int i = 0; i < 32; ++i) { const unsigned v = vals[C.tid + 512 * i]; cg += v > thr; ce += v == thr; }
    unsigned sg = cg, se = ce;
#pragma unroll
    for (int o = 1; o < 64; o <<= 1) { const unsigned tg = __shfl_up(sg, o), te = __shfl_up(se, o); if (C.lane >= o) { sg += tg; se += te; } }
    if (C.lane == 63) { sh[16 + C.wave] = sg; sh[32 + C.wave] = se; }
    __syncthreads();
    unsigned og = 0u, oe = 0u, totg = 0u;
    for (int w = 0; w < 8; ++w) { const unsigned a = sh[16 + w], b = sh[32 + w]; if (w < C.wave) { og += a; oe += b; } totg += a; }
    unsigned pg = og + sg - cg, pe = oe + se - ce;
    for (int i = 0; i < 32; ++i) { const int t = C.tid + 512 * i; const unsigned v = vals[t]; int slot = -1;
        if (v > thr) slot = (int)pg++; else if (v == thr) { if (pe < ntie) slot = (int)(totg + pe); ++pe; }
        SEL[(size_t)t * 16 + e] = slot + 1; if (slot >= 0) IDX[e * CAP + slot] = t; }
}
__device__ __forceinline__ void ph_gather(const Ctx& C, const int* IDX, const bf16_t* XN, bf16_t* XS, const unsigned char* XN8) {
    for (int r = C.gw; r < NE * CAP; r += C.ngw) { const int t = IDX[r];
        if (MOE_FP8) { ((u32x4*)((unsigned char*)XS + (size_t)r * D))[C.lane] = ((const u32x4*)(XN8 + (size_t)t * D))[C.lane]; }
        else { const u32x4* s = (const u32x4*)(XN + (size_t)t * D); u32x4* d = (u32x4*)(XS + (size_t)r * D); const u32x4 a = s[C.lane], b = s[C.lane + 64]; d[C.lane] = a; d[C.lane + 64] = b; } }
}
template <int MODE>
__device__ __forceinline__ void ph_combine(const Ctx& C, const float* Hin, const float* AFF, const int* SEL, const bf16_t* Y, float* Hout, const float* gain, bf16_t* XN, float* OUT) {
    f32x4 g[4]; row_load(gain, C.lane, g);
    for (int t = C.gw; t < T; t += C.ngw) {
        f32x4 v[4]; row_load(Hin + (size_t)t * D, C.lane, v);
        const int sel = SEL[(size_t)t * 16 + (C.lane & 15)]; const float af = AFF[(size_t)t * 16 + (C.lane & 15)];
#pragma unroll
        for (int e = 0; e < 16; ++e) { const int s = __builtin_amdgcn_readlane(sel, e);
            if (s) { const float a = __uint_as_float(__builtin_amdgcn_readlane(__float_as_uint(af), e)); const bf16_t* y = Y + ((size_t)e * CAP + (s - 1)) * D + 4 * C.lane;
#pragma unroll
                for (int j = 0; j < 4; ++j) { const u32x2 w = *(const u32x2*)(y + 256 * j); v[j][0] += a * bf_lo(w.x); v[j][1] += a * bf_hi(w.x); v[j][2] += a * bf_lo(w.y); v[j][3] += a * bf_hi(w.y); } } }
        if (MODE == 1) {
#pragma unroll
            for (int j = 0; j < 4; ++j) *(f32x4*)(Hout + (size_t)t * D + 256 * j + 4 * C.lane) = v[j]; }
        const float r = row_rstd(v);
#pragma unroll
        for (int j = 0; j < 4; ++j) v[j] = v[j] * r * g[j];
        if (MODE == 1) { if (MLA_FP8) {
#pragma unroll
                for (int j = 0; j < 4; ++j) *(unsigned*)((unsigned char*)XN + (size_t)t * D + 256 * j + 4 * C.lane) = pk4fp8(v[j][0], v[j][1], v[j][2], v[j][3]); }
            else row_store_bf(XN + (size_t)t * D, C.lane, v); }
        else {
#pragma unroll
            for (int j = 0; j < 4; ++j) *(f32x4*)(OUT + (size_t)t * D + 256 * j + 4 * C.lane) = v[j]; }
    }
}

#define MFMA32(a, b, c) __builtin_amdgcn_mfma_f32_32x32x16_bf16((a), (b), (c), 0, 0, 0)
__device__ __forceinline__ int crow(int r, int hi) { return (r & 3) + 8 * (r >> 2) + 4 * hi; }
__device__ __forceinline__ bf16x8 ldfrag(const bf16_t* p) { return *(const bf16x8*)p; }

__device__ __forceinline__ void ph_gla_prep(const Ctx& C, const bf16_t* Q0, const bf16_t* K0, const float* GF, const float* GB,
                                            bf16_t* QDF, bf16_t* QDB, bf16_t* KDF, bf16_t* KDB, bf16_t* KTF, bf16_t* KTB, float* EGL) {
    float* tot = (float*)C.lds;
    const int o = C.wave, l = C.lane; int par = 0;
    for (int c = C.bid; c < GNC; c += C.nb) { const int t0 = c * GC + 8 * o;
        for (int cb = 0; cb < 8; ++cb, par ^= 1) { const int ch = cb * 64 + l; const size_t off0 = (size_t)t0 * 512 + ch;
            float gf[8], gb[8], q[8], k[8];
#pragma unroll
            for (int i = 0; i < 8; ++i) { const size_t of = off0 + (size_t)i * 512; gf[i] = GF[of]; gb[i] = GB[of]; q[i] = bf2f(Q0[of]); k[i] = bf2f(K0[of]); }
            float sf = 0.f, sb = 0.f;
#pragma unroll
            for (int i = 0; i < 8; ++i) { sf += gf[i]; gf[i] = sf; }
#pragma unroll
            for (int i = 7; i >= 0; --i) { sb += gb[i]; gb[i] = sb; }
            float* tp = tot + par * 1024; tp[o * 64 + l] = sf; tp[512 + o * 64 + l] = sb;
            __syncthreads();
            float offf = 0.f, offb = 0.f, allf = 0.f, allb = 0.f;
#pragma unroll
            for (int oo = 0; oo < 8; ++oo) { const float a = tp[oo * 64 + l], b = tp[512 + oo * 64 + l]; offf += (oo < o) ? a : 0.f; offb += (oo > o) ? b : 0.f; allf += a; allb += b; }
            unsigned pf[4], pb[4];
#pragma unroll
            for (int i = 0; i < 8; i += 2) { float kdf[2], kdb[2];
#pragma unroll
                for (int u = 0; u < 2; ++u) { const size_t of = off0 + (size_t)(i + u) * 512; const float ef = __expf(offf + gf[i + u]), eb = __expf(offb + gb[i + u]);
                    kdf[u] = k[i + u] * __builtin_amdgcn_rcpf(ef); kdb[u] = k[i + u] * __builtin_amdgcn_rcpf(eb);
                    QDF[of] = f2bf(q[i + u] * ef); QDB[of] = f2bf(q[i + u] * eb); KDF[of] = f2bf(kdf[u]); KDB[of] = f2bf(kdb[u]); }
                pf[i >> 1] = cvt_pk_bf16(kdf[0], kdf[1]); pb[i >> 1] = cvt_pk_bf16(kdb[0], kdb[1]); }
            *(u32x4*)(KTF + (size_t)ch * T + t0) = (u32x4){pf[0], pf[1], pf[2], pf[3]};
            *(u32x4*)(KTB + (size_t)ch * T + t0) = (u32x4){pb[0], pb[1], pb[2], pb[3]};
            if (o == 0) { EGL[(size_t)c * 512 + ch] = __expf(allf); EGL[(size_t)(GNC + c) * 512 + ch] = __expf(allb); }
        }
    }
    __syncthreads();
}
__device__ __forceinline__ void ph_gla_u(const Ctx& C, const bf16_t* VT, const bf16_t* KTF, const bf16_t* KTB, const float* EGL, bf16_t* U) {
    const int r = C.lane & 31, hh = C.lane >> 5;
    for (int it = C.gw; it < 2 * GH * GNC * 8; it += C.ngw) { const int w = it & 7, unit = it >> 3, c = unit % GNC, h = (unit / GNC) % GH, dir = unit / (GNC * GH); const int t0 = c * GC;
        const bf16_t* KT = dir ? KTB : KTF; const bf16_t* ap = VT + (size_t)(256 * h + 32 * w + r) * T + t0 + 8 * hh;
        bf16x8 a[4];
#pragma unroll
        for (int s = 0; s < 4; ++s) a[s] = ldfrag(ap + 16 * s);
        bf16_t* Ub = U + ((size_t)(dir * GH + h) * GNC + c) * (GDV * GDK);
#pragma unroll
        for (int j = 0; j < 4; ++j) { f32x16 acc = {}; const bf16_t* bp = KT + (size_t)(128 * h + 32 * j + r) * T + t0 + 8 * hh;
#pragma unroll
            for (int s = 0; s < 4; ++s) acc = MFMA32(a[s], ldfrag(bp + 16 * s), acc);
            const float eg = EGL[(size_t)(dir * GNC + c) * 512 + 128 * h + 32 * j + r];
#pragma unroll
            for (int q = 0; q < 16; ++q) Ub[(size_t)(32 * w + crow(q, hh)) * GDK + 32 * j + r] = f2bf(acc[q] * eg); }
    }
}
__device__ __forceinline__ void ph_gla_scan(const Ctx& C, const bf16_t* U, const float* EGL, bf16_t* ST) {
    if (C.tid >= 256) return;
    for (int el = C.bid * 256 + C.tid; el < 2 * GH * GDV * (GDK / 4); el += C.nb * 256) { const int dk4 = el & 31, dv = (el >> 5) & 255, h = (el >> 13) & 3, dir = el >> 15;
        const size_t eb = (size_t)(dir * GH + h) * GNC * (GDV * GDK) + (size_t)dv * GDK + 4 * dk4; const float* eg = EGL + (size_t)dir * GNC * 512 + 128 * h + 4 * dk4;
        float s0 = 0.f, s1 = 0.f, s2 = 0.f, s3 = 0.f;
#pragma unroll 16
        for (int i = 0; i < GNC; ++i) { const int c = dir ? GNC - 1 - i : i; const size_t o = eb + (size_t)c * (GDV * GDK);
            const u32x2 u = *(const u32x2*)(U + o); const f32x4 d = *(const f32x4*)(eg + (size_t)c * 512);
            u32x2 w; w.x = cvt_pk_bf16(s0, s1); w.y = cvt_pk_bf16(s2, s3); *(u32x2*)(ST + o) = w;
            s0 = d[0] * s0 + bf_lo(u.x); s1 = d[1] * s1 + bf_hi(u.x); s2 = d[2] * s2 + bf_lo(u.y); s3 = d[3] * s3 + bf_hi(u.y); }
    }
}
__device__ __forceinline__ void ph_gla_out(const Ctx& C, const bf16_t* QDF, const bf16_t* QDB, const bf16_t* KDF, const bf16_t* KDB, const bf16_t* VT, const bf16_t* ST,
                                           const bf16_t* SR, const float* hnorm, bf16_t* OG) {
    constexpr int ACS = 72, TS = 272, TB = 64 * TS;
    unsigned char* TL = C.lds;
    bf16_t* AC = (bf16_t*)(C.lds + 4 * TB); float* SSQ = (float*)(C.lds + 4 * TB + 64 * ACS * 2);
    const int w = C.wave, r = C.lane & 31, hh = C.lane >> 5;
    for (int unit = C.bid; unit < GH * GNC; unit += C.nb) { const int h = unit / GNC, c = unit % GNC, t0 = c * GC;
        bf16x8 bs[2][8], bv[4];
#pragma unroll
        for (int dir = 0; dir < 2; ++dir) { const bf16_t* sp = ST + ((size_t)(dir * GH + h) * GNC + c) * (GDV * GDK) + (size_t)(32 * w + r) * GDK + 8 * hh;
#pragma unroll
            for (int s = 0; s < 8; ++s) bs[dir][s] = ldfrag(sp + 16 * s); }
        { const bf16_t* vp = VT + (size_t)(256 * h + 32 * w + r) * T + t0 + 8 * hh;
#pragma unroll
            for (int s = 0; s < 4; ++s) bv[s] = ldfrag(vp + 16 * s); }
        {
            u32x4 v[8];
#pragma unroll
            for (int q = 0; q < 8; ++q) { const int tile = q >> 1, ck = C.tid + 512 * (q & 1), row = ck >> 4, cc = ck & 15; const bf16_t* src = tile == 0 ? QDF : tile == 1 ? QDB : tile == 2 ? KDF : KDB;
                v[q] = *(const u32x4*)(src + (size_t)(t0 + row) * 512 + 128 * h + 8 * cc); }
#pragma unroll
            for (int q = 0; q < 8; ++q) { const int tile = q >> 1, ck = C.tid + 512 * (q & 1), row = ck >> 4, cc = ck & 15; *(u32x4*)(TL + tile * TB + row * TS + 16 * cc) = v[q]; }
        }
        __syncthreads();
        {
            const int dir = w >> 2, ti = (w >> 1) & 1, si = w & 1;
            if (!((dir == 0 && ti == 0 && si == 1) || (dir == 1 && ti == 1 && si == 0))) {
                const unsigned char* qp = TL + dir * TB + (32 * ti + r) * TS + 16 * hh; const unsigned char* kp = TL + (2 + dir) * TB + (32 * si + r) * TS + 16 * hh;
                f32x16 acc = {};
#pragma unroll
                for (int s = 0; s < 8; ++s) acc = MFMA32(*(const bf16x8*)(qp + 32 * s), *(const bf16x8*)(kp + 32 * s), acc);
#pragma unroll
                for (int q = 0; q < 16; ++q) { const int tl = 32 * ti + crow(q, hh), sl = 32 * si + r; const bool keep = dir ? (sl > tl) : (sl <= tl); if (keep) AC[tl * ACS + sl] = f2bf(acc[q]); }
            }
        }
        __syncthreads();
        f32x16 o0 = {}, o1 = {};
#pragma unroll
        for (int dir = 0; dir < 2; ++dir) { const unsigned char* qp = TL + dir * TB + r * TS + 16 * hh;
#pragma unroll
            for (int s = 0; s < 8; ++s) { o0 = MFMA32(*(const bf16x8*)(qp + 32 * s), bs[dir][s], o0); o1 = MFMA32(*(const bf16x8*)(qp + 32 * TS + 32 * s), bs[dir][s], o1); } }
#pragma unroll
        for (int s = 0; s < 4; ++s) { o0 = MFMA32(ldfrag(AC + r * ACS + 16 * s + 8 * hh), bv[s], o0); o1 = MFMA32(ldfrag(AC + (32 + r) * ACS + 16 * s + 8 * hh), bv[s], o1); }
#pragma unroll
        for (int q = 0; q < 16; ++q) { float a = o0[q] * o0[q], b = o1[q] * o1[q];
#pragma unroll
            for (int of = 1; of < 32; of <<= 1) { a += __shfl_xor(a, of); b += __shfl_xor(b, of); }
            if (r == 0) { SSQ[w * 64 + crow(q, hh)] = a; SSQ[w * 64 + 32 + crow(q, hh)] = b; } }
        __syncthreads();
        const float gn = hnorm[32 * w + r];
#pragma unroll
        for (int q = 0; q < 16; ++q) { const int tl = crow(q, hh); float sa = 0.f, sb = 0.f;
#pragma unroll
            for (int ww = 0; ww < 8; ++ww) { sa += SSQ[ww * 64 + tl]; sb += SSQ[ww * 64 + 32 + tl]; }
            const float ra = 1.0f / sqrtf(sa * (1.0f / 256.0f) + RMS_EPS), rb = 1.0f / sqrtf(sb * (1.0f / 256.0f) + RMS_EPS);
            const size_t oa = (size_t)(t0 + tl) * 1024 + 256 * h + 32 * w + r, ob = oa + 32 * 1024;
            OG[oa] = f2bf(o0[q] * ra * gn * bf2f(SR[oa])); OG[ob] = f2bf(o1[q] * rb * gn * bf2f(SR[ob])); }
        __syncthreads();
    }
}

__device__ __forceinline__ void ph_mla_tok(const Ctx& C, const float* CIN, const int* pos, const float* qn, const float* kvn, const float* invf, bf16_t* CQN, bf16_t* CKVN, float* CS, bf16_t* K) {
    const int l = C.lane;
    f32x4 g0, g1;
    if (l < 32) { g0 = *(const f32x4*)(qn + 8 * l); g1 = *(const f32x4*)(qn + 8 * l + 4); }
    else if (l < 48) { g0 = *(const f32x4*)(kvn + 8 * (l - 32)); g1 = *(const f32x4*)(kvn + 8 * (l - 32) + 4); }
    else { g0 = (f32x4){1.f, 1.f, 1.f, 1.f}; g1 = g0; }
    const float fr = invf[l & 31];
    for (int t = C.gw; t < T; t += C.ngw) {
        const float* row = CIN + (size_t)t * 512; const f32x4 a = *(const f32x4*)(row + 8 * l), b = *(const f32x4*)(row + 8 * l + 4);
        const float ss = (a[0] * a[0] + a[1] * a[1]) + (a[2] * a[2] + a[3] * a[3]) + (b[0] * b[0] + b[1] * b[1]) + (b[2] * b[2] + b[3] * b[3]);
        const float sq = wave_sum(l < 32 ? ss : 0.f), sk = wave_sum((l >= 32 && l < 48) ? ss : 0.f);
        const float rq = 1.0f / sqrtf(sq * (1.0f / 256.0f) + RMS_EPS), rk = 1.0f / sqrtf(sk * (1.0f / 128.0f) + RMS_EPS);
        const float ang = (float)pos[t] * fr; const double rev = (double)ang * 0.15915494309189533577; const float fr01 = (float)(rev - rint(rev));
        const float cv = __builtin_amdgcn_cosf(fr01), sv = __builtin_amdgcn_sinf(fr01);
        if (l < 32) { CS[(size_t)t * 64 + l] = cv; CS[(size_t)t * 64 + 32 + l] = sv; }
        if (l < 32) store8bf(CQN + (size_t)t * 256 + 8 * l, a * rq * g0, b * rq * g1);
        else if (l < 48) store8bf(CKVN + (size_t)t * 256 + 8 * (l - 32), a * rk * g0, b * rk * g1);
        else { const u32x4 z = {0u, 0u, 0u, 0u}; *(u32x4*)(CKVN + (size_t)t * 256 + 128 + 8 * (l - 48)) = z; }
        f32x4 xa = a, xb = b;
        f32x4 pa, pb;
#pragma unroll
        for (int j = 0; j < 4; ++j) { pa[j] = __shfl(xa[j], (l + 4) & 63); pb[j] = __shfl(xb[j], (l + 4) & 63); }
        f32x4 c0, c1, s0, s1;
#pragma unroll
        for (int j = 0; j < 4; ++j) { const int i = 8 * (l & 3) + j; c0[j] = __shfl(cv, i); c1[j] = __shfl(cv, i + 4); s0[j] = __shfl(sv, i); s1[j] = __shfl(sv, i + 4); }
        if (l >= 48 && l < 52) {
            const f32x4 o1a = xa * c0 - pa * s0, o2a = xa * s0 + pa * c0, o1b = xb * c1 - pb * s1, o2b = xb * s1 + pb * c1;
            u32x4 w0, w1; w0.x = cvt_pk_bf16(o1a[0], o1a[1]); w0.y = cvt_pk_bf16(o1a[2], o1a[3]); w0.z = cvt_pk_bf16(o2a[0], o2a[1]); w0.w = cvt_pk_bf16(o2a[2], o2a[3]);
            w1.x = cvt_pk_bf16(o1b[0], o1b[1]); w1.y = cvt_pk_bf16(o1b[2], o1b[3]); w1.z = cvt_pk_bf16(o2b[0], o2b[1]); w1.w = cvt_pk_bf16(o2b[2], o2b[3]);
            if (ATT_FP8) { u32x4 w8; w8.x = pk4fp8(o1a[0], o1a[1], o1a[2], o1a[3]); w8.y = pk4fp8(o2a[0], o2a[1], o2a[2], o2a[3]); w8.z = pk4fp8(o1b[0], o1b[1], o1b[2], o1b[3]); w8.w = pk4fp8(o2b[0], o2b[1], o2b[2], o2b[3]);
#pragma unroll
                for (int h = 0; h < MH; ++h) *(u32x4*)((unsigned char*)K + ((size_t)h * T + t) * MDK + 128 + 16 * (l & 3)) = w8; }
            else {
#pragma unroll
            for (int h = 0; h < MH; ++h) { bf16_t* kp = K + ((size_t)h * T + t) * MDK + 128 + 16 * (l & 3); *(u32x4*)kp = w0; *(u32x4*)(kp + 8) = w1; } }
        }
    }
}

namespace att {
constexpr int NW = 8, QBLK = 32, KVBLK = 64;
#ifndef ATT_PVSPLIT
#define ATT_PVSPLIT 0
#endif
#ifndef ATT_SDEPTH
#define ATT_SDEPTH 1
#endif
constexpr int SDEPTH = ATT_SDEPTH;
constexpr float THR2 = 11.5f;
constexpr int SHM_V = KVBLK * MDV * 2, SHM_K = KVBLK * 400, SHM_ATTN = 2 * SHM_V + 2 * SHM_K + NW * 64 * 4;
#define KSWZ(row, colB) ((row) * 400 + (colB))
#define SBAR() __builtin_amdgcn_sched_barrier(0)
__device__ __forceinline__ unsigned cvtpk(float lo, float hi) { unsigned r; asm volatile("v_cvt_pk_bf16_f32 %0, %1, %2" : "=v"(r) : "v"(lo), "v"(hi)); return r; }
__device__ __forceinline__ void partialSM(f32x16& p0, f32x16& p1, float& m_reg, float& mn, float& alpha) {
  float pmax = p0[0];
#pragma unroll
  for (int r = 1; r < 16; ++r) pmax = fmaxf(pmax, p0[r]);
#pragma unroll
  for (int r = 0; r < 16; ++r) pmax = fmaxf(pmax, p1[r]);
  { auto rr = __builtin_amdgcn_permlane32_swap(__float_as_uint(pmax), __float_as_uint(pmax), false, false);
    pmax = fmaxf(__uint_as_float(rr[0]), __uint_as_float(rr[1])); }
  if (__builtin_expect(__all(pmax - m_reg <= THR2), 1)) { mn = m_reg; alpha = 1.f; }
  else { mn = fmaxf(m_reg, pmax); alpha = __builtin_amdgcn_exp2f(m_reg - mn); m_reg = mn; }
#pragma unroll
  for (int r = 0; r < 16; ++r) p0[r] = p0[r] - mn;
#pragma unroll
  for (int r = 0; r < 16; ++r) p1[r] = p1[r] - mn;
#pragma unroll
  for (int r = 0; r < 16; ++r) p0[r] = __builtin_amdgcn_exp2f(p0[r]);
}
__device__ __forceinline__ void finishSM(f32x16& p0, f32x16& p1, float alpha, float& l_reg, bf16x8& pa0, bf16x8& pa1, bf16x8& pa2, bf16x8& pa3) {
#pragma unroll
  for (int r = 0; r < 16; ++r) p1[r] = __builtin_amdgcn_exp2f(p1[r]);
  float ps = 0;
#pragma unroll
  for (int r = 0; r < 16; ++r) ps += p0[r];
#pragma unroll
  for (int r = 0; r < 16; ++r) ps += p1[r];
  { auto rr = __builtin_amdgcn_permlane32_swap(__float_as_uint(ps), __float_as_uint(ps), false, false);
    ps = __uint_as_float(rr[0]) + __uint_as_float(rr[1]); }
  l_reg = l_reg * alpha + ps;
#define PK4(P, BASE, OUT) do { unsigned a0 = cvtpk(P[BASE + 0], P[BASE + 1]), a1 = cvtpk(P[BASE + 2], P[BASE + 3]);   \
    unsigned b0 = cvtpk(P[BASE + 4], P[BASE + 5]), b1 = cvtpk(P[BASE + 6], P[BASE + 7]);                              \
    auto r0 = __builtin_amdgcn_permlane32_swap(a0, b0, false, false); auto r1 = __builtin_amdgcn_permlane32_swap(a1, b1, false, false); \
    u32x4 w = {r0[0], r1[0], r0[1], r1[1]}; OUT = *reinterpret_cast<bf16x8*>(&w); } while (0)
  PK4(p0, 0, pa0); PK4(p0, 8, pa1); PK4(p1, 0, pa2); PK4(p1, 8, pa3);
#undef PK4
}
__device__ __forceinline__ void qkt(f32x16& p0, f32x16& p1, const char* Ks, const bf16x8* qr, int r32, int hi) {
  p0 = f32x16{}; p1 = f32x16{};
#pragma unroll
  for (int d0 = 0; d0 < 12; ++d0) { const int cb = (d0 * 16 + hi * 8) * 2;
    const bf16x8 b0 = *reinterpret_cast<const bf16x8*>(Ks + KSWZ(r32, cb));
    const bf16x8 b1 = *reinterpret_cast<const bf16x8*>(Ks + KSWZ(32 + r32, cb));
    p0 = __builtin_amdgcn_mfma_f32_32x32x16_bf16(b0, qr[d0], p0, 0, 0, 0);
    p1 = __builtin_amdgcn_mfma_f32_32x32x16_bf16(b1, qr[d0], p1, 0, 0, 0); }
}
__device__ __forceinline__ int v_st(int k, int c) { const int kk = (k & ~0xC) | ((k & 4) << 1) | ((k & 8) >> 1); return ((kk >> 3) * 4 + (c >> 5)) * 512 + ((kk & 7) * 32 + (c & 31)) * 2; }
__device__ __forceinline__ int v_rd_base(int lane) { return ((lane & 3) << 3) | (((lane >> 2) & 3) << 6) | (((lane >> 4) & 1) << 5) | (((lane >> 5) & 1) << 8); }
constexpr int v_rd_off(int d0, int ks, int half) { return d0 * 512 + ks * 4096 + half * 2048; }
template <int OFF> __device__ __forceinline__ s16x4 tr_read(int vb) {
  s16x4 r; asm volatile("ds_read_b64_tr_b16 %0, %1 offset:%2" : "=&v"(r) : "v"(vb), "i"(OFF) : "memory"); return r;
}
template <int D0> __device__ __forceinline__ void pv_one(f32x16& od, int vb, bf16x8 pa0, bf16x8 pa1, bf16x8 pa2, bf16x8 pa3) {
#if ATT_PVSPLIT
#define PK(L, H) (bf16x8){L[0], L[1], L[2], L[3], H[0], H[1], H[2], H[3]}
  { const s16x4 l0 = tr_read<v_rd_off(D0, 0, 0)>(vb), h0 = tr_read<v_rd_off(D0, 0, 1)>(vb), l1 = tr_read<v_rd_off(D0, 1, 0)>(vb), h1 = tr_read<v_rd_off(D0, 1, 1)>(vb);
    asm volatile("s_waitcnt lgkmcnt(0)" ::: "memory"); SBAR();
    od = __builtin_amdgcn_mfma_f32_32x32x16_bf16(pa0, PK(l0, h0), od, 0, 0, 0);
    od = __builtin_amdgcn_mfma_f32_32x32x16_bf16(pa1, PK(l1, h1), od, 0, 0, 0); }
  { const s16x4 l2 = tr_read<v_rd_off(D0, 2, 0)>(vb), h2 = tr_read<v_rd_off(D0, 2, 1)>(vb), l3 = tr_read<v_rd_off(D0, 3, 0)>(vb), h3 = tr_read<v_rd_off(D0, 3, 1)>(vb);
    asm volatile("s_waitcnt lgkmcnt(0)" ::: "memory"); SBAR();
    od = __builtin_amdgcn_mfma_f32_32x32x16_bf16(pa2, PK(l2, h2), od, 0, 0, 0);
    od = __builtin_amdgcn_mfma_f32_32x32x16_bf16(pa3, PK(l3, h3), od, 0, 0, 0); }
#undef PK
#else
  const s16x4 l0 = tr_read<v_rd_off(D0, 0, 0)>(vb), h0 = tr_read<v_rd_off(D0, 0, 1)>(vb), l1 = tr_read<v_rd_off(D0, 1, 0)>(vb), h1 = tr_read<v_rd_off(D0, 1, 1)>(vb);
  const s16x4 l2 = tr_read<v_rd_off(D0, 2, 0)>(vb), h2 = tr_read<v_rd_off(D0, 2, 1)>(vb), l3 = tr_read<v_rd_off(D0, 3, 0)>(vb), h3 = tr_read<v_rd_off(D0, 3, 1)>(vb);
  asm volatile("s_waitcnt lgkmcnt(0)" ::: "memory"); SBAR();
#define PK(L, H) (bf16x8){L[0], L[1], L[2], L[3], H[0], H[1], H[2], H[3]}
  od = __builtin_amdgcn_mfma_f32_32x32x16_bf16(pa0, PK(l0, h0), od, 0, 0, 0);
  od = __builtin_amdgcn_mfma_f32_32x32x16_bf16(pa1, PK(l1, h1), od, 0, 0, 0);
  od = __builtin_amdgcn_mfma_f32_32x32x16_bf16(pa2, PK(l2, h2), od, 0, 0, 0);
  od = __builtin_amdgcn_mfma_f32_32x32x16_bf16(pa3, PK(l3, h3), od, 0, 0, 0);
#undef PK
#endif
}
__device__ __forceinline__ void pv_d0(f32x16* o, int vb, bf16x8 pa0, bf16x8 pa1, bf16x8 pa2, bf16x8 pa3) {
  pv_one<0>(o[0], vb, pa0, pa1, pa2, pa3); pv_one<1>(o[1], vb, pa0, pa1, pa2, pa3); pv_one<2>(o[2], vb, pa0, pa1, pa2, pa3); pv_one<3>(o[3], vb, pa0, pa1, pa2, pa3);
}
__device__ __forceinline__ void attn_body(const bf16_t* __restrict__ Qb, const bf16_t* __restrict__ Kh, const bf16_t* __restrict__ Vh, bf16_t* __restrict__ Ob, int ldo, int seq, char* lds) {
  const int tid = threadIdx.x, wid = tid >> 6, lane = tid & 63, r32 = lane & 31, hi = lane >> 5;
  char* V_lds = lds; char* K_lds = lds + 2 * SHM_V;
  float* ws = (float*)(lds + 2 * SHM_V + 2 * SHM_K) + wid * 64; float* li_l = ws; float* al_l = ws + 32;
  float m_reg = -1e30f, l_reg = 0; f32x16 o[4] = {}; bf16x8 qr[12];
  const bf16_t* Qw = Qb + (size_t)(wid * QBLK + r32) * MDK + hi * 8;
#pragma unroll
  for (int d0 = 0; d0 < 12; ++d0) qr[d0] = *reinterpret_cast<const bf16x8*>(Qw + d0 * 16);
  const int sr = tid >> 4, sc = (tid & 15) * 8, vst0 = v_st(sr, sc), vst1 = v_st(32 + sr, sc);
  int kst[3];
#pragma unroll
  for (int i = 0; i < 3; ++i) { const int ck = tid + 512 * i, row = ck / 24, cc = ck - row * 24; kst[i] = KSWZ(row, cc * 16); }
  const int vb0 = (int)(uintptr_t)V_lds + v_rd_base(lane);
  const unsigned vo0 = (unsigned)(sr * MDV + sc), ko0 = (unsigned)(tid * 8);
  struct { bf16x8 vs0, vs1, ks0, ks1, ks2; } sr_[SDEPTH];
#define SLOAD(i, k0) do { const bf16_t* vt_ = Vh + (size_t)(k0) * MDV; const bf16_t* kt_ = Kh + (size_t)(k0) * MDK;                                         \
    sr_[i].vs0 = *reinterpret_cast<const bf16x8*>(vt_ + vo0); sr_[i].vs1 = *reinterpret_cast<const bf16x8*>(vt_ + 32 * MDV + vo0);                               \
    sr_[i].ks0 = *reinterpret_cast<const bf16x8*>(kt_ + ko0); sr_[i].ks1 = *reinterpret_cast<const bf16x8*>(kt_ + 4096 + ko0); sr_[i].ks2 = *reinterpret_cast<const bf16x8*>(kt_ + 8192 + ko0); } while (0)
#define SWRITE(b, i) do { *(bf16x8*)(V_lds + (b) * SHM_V + vst0) = sr_[i].vs0; *(bf16x8*)(V_lds + (b) * SHM_V + vst1) = sr_[i].vs1;               \
    *(bf16x8*)(K_lds + (b) * SHM_K + kst[0]) = sr_[i].ks0; *(bf16x8*)(K_lds + (b) * SHM_K + kst[1]) = sr_[i].ks1; *(bf16x8*)(K_lds + (b) * SHM_K + kst[2]) = sr_[i].ks2; } while (0)
#define SWAIT() do { if constexpr (SDEPTH == 2) asm volatile("s_waitcnt vmcnt(5)" ::: "memory"); else asm volatile("s_waitcnt vmcnt(0)" ::: "memory"); } while (0)
#define RESC(a) do { if (__any((a) < 1.f)) { if (hi == 0) al_l[r32] = (a); asm volatile("s_waitcnt lgkmcnt(0)" ::: "memory"); \
    _Pragma("unroll") for (int d = 0; d < 4; ++d) _Pragma("unroll") for (int r = 0; r < 16; ++r) o[d][r] *= al_l[crow(r, hi)]; } } while (0)
  f32x16 pA0, pA1, pB0, pB1; float mnA, mnB, alA, alB; bf16x8 pa0, pa1, pa2, pa3; const int NT = seq / KVBLK;
  constexpr int SE = 0, SO = SDEPTH - 1;
  SLOAD(SE, 0); asm volatile("s_waitcnt vmcnt(0)" ::: "memory"); SWRITE(0, SE); __syncthreads();
  qkt(pA0, pA1, K_lds, qr, r32, hi); partialSM(pA0, pA1, m_reg, mnA, alA);
  SLOAD(SO, KVBLK); if constexpr (SDEPTH == 2) { if (2 < NT) SLOAD(SE, 2 * KVBLK); }
  SWAIT(); SWRITE(1, SO); __syncthreads();
  for (int j = 1; j + 1 < NT; j += 2) {
    SBAR(); qkt(pB0, pB1, K_lds + SHM_K, qr, r32, hi);
    finishSM(pA0, pA1, alA, l_reg, pa0, pa1, pa2, pa3); SBAR();
    SLOAD(SO, (j + SDEPTH) * KVBLK); SBAR();
    pv_d0(o, vb0, pa0, pa1, pa2, pa3); partialSM(pB0, pB1, m_reg, mnB, alB);
    __syncthreads(); SWAIT(); SWRITE(0, SE);
    RESC(alB); __syncthreads();
    SBAR(); qkt(pA0, pA1, K_lds, qr, r32, hi);
    finishSM(pB0, pB1, alB, l_reg, pa0, pa1, pa2, pa3); SBAR();
    if (SDEPTH == 1 || j + 3 < NT) SLOAD(SE, (j + 1 + SDEPTH) * KVBLK); SBAR();
    pv_d0(o, vb0 + SHM_V, pa0, pa1, pa2, pa3); partialSM(pA0, pA1, m_reg, mnA, alA);
    __syncthreads(); SWAIT(); SWRITE(1, SO);
    RESC(alA); __syncthreads();
  }
  SBAR(); qkt(pB0, pB1, K_lds + SHM_K, qr, r32, hi);
  finishSM(pA0, pA1, alA, l_reg, pa0, pa1, pa2, pa3); SBAR();
  pv_d0(o, vb0, pa0, pa1, pa2, pa3); partialSM(pB0, pB1, m_reg, mnB, alB);
  __syncthreads(); RESC(alB);
  finishSM(pB0, pB1, alB, l_reg, pa0, pa1, pa2, pa3); SBAR();
  pv_d0(o, vb0 + SHM_V, pa0, pa1, pa2, pa3);
  if (hi == 0) li_l[r32] = l_reg; asm volatile("s_waitcnt lgkmcnt(0)" ::: "memory");
  float rli[16];
#pragma unroll
  for (int r = 0; r < 16; ++r) rli[r] = __builtin_amdgcn_rcpf(li_l[crow(r, hi)]);
  bf16_t* Ow = Ob + (size_t)(wid * QBLK) * ldo;
#pragma unroll
  for (int r = 0; r < 16; ++r) { const int orow = crow(r, hi);
#pragma unroll
    for (int d0 = 0; d0 < 4; ++d0) Ow[(size_t)orow * ldo + d0 * 32 + r32] = f2bf(o[d0][r] * rli[r]); }
#undef SLOAD
#undef SWRITE
#undef SWAIT
#undef RESC
}
}


namespace att8 {
constexpr int NW = 8, QBLK = 32, KVBLK = 64, KST = 208, VST = 80;
#ifndef ATT8_SDEPTH
#define ATT8_SDEPTH 1
#endif
constexpr int SDEPTH = ATT8_SDEPTH;
constexpr float THR8 = 8.f;
#ifndef ATT8_RING3
#define ATT8_RING3 0
#endif
constexpr int NBUF = ATT8_RING3 ? 3 : 2;
constexpr int SHM_K = KVBLK * KST, SHM_V = MDV * VST, SHM_ATTN = NBUF * SHM_K + NBUF * SHM_V + NW * 64 * 4;
#define SBAR() __builtin_amdgcn_sched_barrier(0)
#define SGB(mask, n) __builtin_amdgcn_sched_group_barrier((mask), (n), 0)
#ifndef ATT8_ONEBAR
#define ATT8_ONEBAR 1
#endif
#ifndef ATT8_ILV
#define ATT8_ILV 1
#endif
#ifndef ATT8_ONES
#define ATT8_ONES 1
#endif
#define PIN2(a, b) asm volatile("" : "+v"(a), "+v"(b))
#define PIN4(o) asm volatile("" : "+v"(o[0]), "+v"(o[1]), "+v"(o[2]), "+v"(o[3]), "+v"(o[4]))
#define ILV_QK() do { if (ATT8_ILV) { SGB(0x100, 4); _Pragma("unroll") for (int i_ = 0; i_ < 6; ++i_) { SGB(0x008, 1); SGB(0x002, 8); if (i_ < 4) SGB(0x100, 2); } } } while (0)
#define ILV_PV() do { if (ATT8_ILV) { SGB(0x100, 4); _Pragma("unroll") for (int i_ = 0; i_ < 4 + ATT8_ONES; ++i_) { SGB(0x008, 1); SGB(0x002, 14); if (i_ < 2) SGB(0x100, 2); } } } while (0)
#define MFMA8(a, b, c) __builtin_amdgcn_mfma_scale_f32_32x32x64_f8f6f4((a), (b), (c), 0, 0, 0, 0x7f7f7f7f, 0, 0x7f7f7f7f)
#define MFMA8Q(a, b, c) __builtin_amdgcn_mfma_scale_f32_32x32x64_f8f6f4((a), (b), (c), 0, 0, 0, 0x7f7f7f7f, 0, 0x7c7c7c7c)
__device__ __forceinline__ i32x8 ld32(const char* p) { const u32x4 a = *(const u32x4*)p, b = *(const u32x4*)(p + 16); return (i32x8){(int)a.x, (int)a.y, (int)a.z, (int)a.w, (int)b.x, (int)b.y, (int)b.z, (int)b.w}; }
typedef short v2i16 __attribute__((ext_vector_type(2)));
#ifndef ATT8_ONES
#define ATT8_ONES 1
#endif
__device__ __forceinline__ float rowmax32(const f32x16& p0, const f32x16& p1) {
  float pmax = fmaxf(fmaxf(p0[0], p0[1]), p0[2]);
#pragma unroll
  for (int r = 3; r < 15; r += 2) pmax = fmaxf(fmaxf(pmax, p0[r]), p0[r + 1]);
  pmax = fmaxf(fmaxf(pmax, p0[15]), p1[0]);
#pragma unroll
  for (int r = 1; r < 15; r += 2) pmax = fmaxf(fmaxf(pmax, p1[r]), p1[r + 1]);
  pmax = fmaxf(pmax, p1[15]);
  auto rr = __builtin_amdgcn_permlane32_swap(__float_as_uint(pmax), __float_as_uint(pmax), false, false);
  return fmaxf(__uint_as_float(rr[0]), __uint_as_float(rr[1]));
}
template <bool FIRST>
__device__ __forceinline__ void partialSM(f32x16& p0, f32x16& p1, float& m_reg, f32x16& mt, float& alpha, float& sc) {
  const float pmax = rowmax32(p0, p1);
  if constexpr (FIRST) { m_reg += pmax; p0 = p0 - pmax; p1 = p1 - pmax; mt = mt - pmax; alpha = 1.f; sc = 1.f; }
  else { const bool keep = __all(pmax <= THR8); const float d = keep ? 0.f : ceilf(fmaxf(pmax, 0.f));     alpha = __builtin_amdgcn_exp2f(-d); sc = __builtin_amdgcn_exp2f(d); m_reg += d;
    mt = mt - d; }
#pragma unroll
  for (int r = 0; r < 16; ++r) p0[r] = __builtin_amdgcn_exp2f(p0[r]);
}
__device__ __forceinline__ void finishSM(f32x16& p0, f32x16& p1, float alpha, float sc, float& l_reg, i32x8& pa) {
#pragma unroll
  for (int r = 0; r < 16; ++r) p1[r] = __builtin_amdgcn_exp2f(p1[r]);
#if !ATT8_ONES
  float ps = 0;
#pragma unroll
  for (int r = 0; r < 16; ++r) ps += p0[r];
#pragma unroll
  for (int r = 0; r < 16; ++r) ps += p1[r];
  { auto rr = __builtin_amdgcn_permlane32_swap(__float_as_uint(ps), __float_as_uint(ps), false, false);
    ps = __uint_as_float(rr[0]) + __uint_as_float(rr[1]); }
  l_reg = (l_reg + ps) * alpha;
#endif
#pragma unroll
  for (int j = 0; j < 4; ++j) { v2i16 w = {0, 0};
    w = __builtin_amdgcn_cvt_scalef32_pk_fp8_f32(w, p0[4 * j], p0[4 * j + 1], sc, false); w = __builtin_amdgcn_cvt_scalef32_pk_fp8_f32(w, p0[4 * j + 2], p0[4 * j + 3], sc, true); pa[j] = __builtin_bit_cast(int, w);
    v2i16 u = {0, 0};
    u = __builtin_amdgcn_cvt_scalef32_pk_fp8_f32(u, p1[4 * j], p1[4 * j + 1], sc, false); u = __builtin_amdgcn_cvt_scalef32_pk_fp8_f32(u, p1[4 * j + 2], p1[4 * j + 3], sc, true); pa[4 + j] = __builtin_bit_cast(int, u); }
}
__device__ __forceinline__ void qkt(f32x16& p0, f32x16& p1, const char* Ks, const i32x8* qr, const f32x16& mt, int r32, int hi) {
  const char* k0 = Ks + r32 * KST + hi * 32;
  { const i32x8 a0 = ld32(k0), a1 = ld32(k0 + 32 * KST); p0 = MFMA8Q(a0, qr[0], mt); p1 = MFMA8Q(a1, qr[0], mt); }
#pragma unroll
  for (int s = 1; s < 3; ++s) { const i32x8 a0 = ld32(k0 + 64 * s), a1 = ld32(k0 + 32 * KST + 64 * s);
    p0 = MFMA8Q(a0, qr[s], p0); p1 = MFMA8Q(a1, qr[s], p1); }
}
__device__ __forceinline__ void pv(f32x16* o, const char* Vs, const i32x8 pa, const i32x8& ones, int r32, int hi) {
  const char* v0 = Vs + r32 * VST + hi * 32;
#pragma unroll
  for (int d0 = 0; d0 < 4; ++d0) { const i32x8 b = ld32(v0 + d0 * 32 * VST); o[d0] = MFMA8(pa, b, o[d0]); }
  if (ATT8_ONES) o[4] = MFMA8(pa, ones, o[4]);
}
__device__ __forceinline__ void attn_body(const unsigned char* __restrict__ Qb, const unsigned char* __restrict__ Kh, const unsigned char* __restrict__ Vt, bf16_t* __restrict__ Ob, int ldo, int seq, char* lds) {
  const int tid = threadIdx.x, wid = __builtin_amdgcn_readfirstlane(tid >> 6), lane = tid & 63, r32 = lane & 31, hi = lane >> 5;
  char* K_lds = lds; char* V_lds = lds + NBUF * SHM_K;
  float* ws = (float*)(lds + NBUF * SHM_K + NBUF * SHM_V) + wid * 64; float* li_l = ws; float* al_l = ws + 32;
  float m_reg = 0.f, l_reg = 0; f32x16 o[5] = {}; f32x16 mt = {}; i32x8 qr[3];
  i32x8 ones; { int w1 = 0x38383838; asm volatile("" : "+v"(w1)); ones = (i32x8){w1, w1, w1, w1, w1, w1, w1, w1}; }
  { const char* Qw = (const char*)Qb + (size_t)(wid * QBLK + r32) * MDK + hi * 32;
#pragma unroll
    for (int s = 0; s < 3; ++s) qr[s] = ld32(Qw + 64 * s); }
  const int kd0 = (tid / 12) * KST + (tid % 12) * 16, kd1 = ((512 + tid) / 12) * KST + ((512 + tid) % 12) * 16, vd = (tid >> 2) * VST + (tid & 3) * 16;
  struct { u32x4 k0, k1, v; } sr_[SDEPTH];
#define SLOAD(i, t0) do { const unsigned ko = (unsigned)tid * 16u, vo = ((unsigned)(tid >> 2) << 14) | ((unsigned)(tid & 3) << 4); const unsigned char* kt_ = Kh + (size_t)(t0) * MDK; sr_[i].k0 = *(const u32x4*)(kt_ + ko); if (wid < 4) sr_[i].k1 = *(const u32x4*)(kt_ + 8192 + ko); sr_[i].v = *(const u32x4*)(Vt + (t0) + vo); } while (0)
#define SWRITE_K(b, i) do { *(u32x4*)(K_lds + (b) * SHM_K + kd0) = sr_[i].k0; if (wid < 4) *(u32x4*)(K_lds + (b) * SHM_K + kd1) = sr_[i].k1; } while (0)
#define SWRITE_V(b, i) do { *(u32x4*)(V_lds + (b) * SHM_V + vd) = sr_[i].v; } while (0)
#define SWRITE(b, i) do { SWRITE_K(b, i); SWRITE_V(b, i); } while (0)
#define SWAIT() do { if constexpr (SDEPTH == 2) asm volatile("s_waitcnt vmcnt(3)" ::: "memory"); else asm volatile("s_waitcnt vmcnt(0)" ::: "memory"); } while (0)
#define RESC(a) do { if (__any((a) < 1.f)) { if (hi == 0) al_l[r32] = (a); asm volatile("s_waitcnt lgkmcnt(0)" ::: "memory"); \
    _Pragma("unroll") for (int d = 0; d < 4 + ATT8_ONES; ++d) _Pragma("unroll") for (int r = 0; r < 16; ++r) o[d][r] *= al_l[crow(r, hi)]; } } while (0)
  f32x16 pA0, pA1, pB0, pB1; float alA, alB, scA, scB; i32x8 pa; const int NT = seq / KVBLK;
#if ATT8_RING3
  SLOAD(0, 0); asm volatile("s_waitcnt vmcnt(0)" ::: "memory"); SWRITE(0, 0);
  SLOAD(0, KVBLK); asm volatile("s_waitcnt vmcnt(0)" ::: "memory"); SWRITE(1, 0); __syncthreads();
  qkt(pA0, pA1, K_lds, qr, mt, r32, hi); partialSM<true>(pA0, pA1, m_reg, mt, alA, scA);
  int b0 = 0, b1 = 1, b2 = 2;
#define STEP(c0, c1, alc, scc, n0, n1, aln, scn, jj) do {                                                                     \
    SBAR(); qkt(n0, n1, K_lds + b1 * SHM_K, qr, mt, r32, hi);                                                                  \
    finishSM(c0, c1, alc, scc, l_reg, pa); ILV_QK(); PIN2(n0, n1); SBAR();                                                     \
    SLOAD(0, (((jj) + 2 < NT) ? (jj) + 2 : 0) * KVBLK); SBAR();                                                                \
    pv(o, V_lds + b0 * SHM_V, pa, ones, r32, hi); partialSM<false>(n0, n1, m_reg, mt, aln, scn); ILV_PV(); PIN4(o); PIN2(n0, n1); SBAR(); \
    SWRITE(b2, 0);                                                                                                            \
    RESC(aln);                                                                                                                \
    __syncthreads(); { const int t_ = b0; b0 = b1; b1 = b2; b2 = t_; } } while (0)
  for (int j = 0; j + 2 < NT; j += 2) { STEP(pA0, pA1, alA, scA, pB0, pB1, alB, scB, j); STEP(pB0, pB1, alB, scB, pA0, pA1, alA, scA, j + 1); }
  SBAR(); qkt(pB0, pB1, K_lds + b1 * SHM_K, qr, mt, r32, hi);
  finishSM(pA0, pA1, alA, scA, l_reg, pa); SBAR();
  pv(o, V_lds + b0 * SHM_V, pa, ones, r32, hi); partialSM<false>(pB0, pB1, m_reg, mt, alB, scB);
  RESC(alB);
  finishSM(pB0, pB1, alB, scB, l_reg, pa); SBAR();
  pv(o, V_lds + b1 * SHM_V, pa, ones, r32, hi);
#undef STEP
#else
  constexpr int SE = 0, SO = SDEPTH - 1;
  SLOAD(SE, 0); asm volatile("s_waitcnt vmcnt(0)" ::: "memory"); SWRITE(0, SE); __syncthreads();
  qkt(pA0, pA1, K_lds, qr, mt, r32, hi); partialSM<true>(pA0, pA1, m_reg, mt, alA, scA);
  SLOAD(SO, KVBLK); if constexpr (SDEPTH == 2) { if (2 < NT) SLOAD(SE, 2 * KVBLK); }
  SWAIT(); SWRITE(1, SO); __syncthreads();
  for (int j = 1; j + 1 < NT; j += 2) {
    SBAR(); qkt(pB0, pB1, K_lds + SHM_K, qr, mt, r32, hi);
    finishSM(pA0, pA1, alA, scA, l_reg, pa); ILV_QK(); PIN2(pB0, pB1); SBAR();
    SLOAD(SO, (j + SDEPTH) * KVBLK); SBAR();
    pv(o, V_lds, pa, ones, r32, hi); partialSM<false>(pB0, pB1, m_reg, mt, alB, scB); ILV_PV(); PIN4(o); PIN2(pB0, pB1); SBAR();
#if ATT8_ONEBAR
    SWAIT(); SWRITE_K(0, SE); __syncthreads(); SWRITE_V(0, SE); RESC(alB);
#else
    __syncthreads(); SWAIT(); SWRITE(0, SE);
    RESC(alB); __syncthreads();
#endif
    SBAR(); qkt(pA0, pA1, K_lds, qr, mt, r32, hi);
    finishSM(pB0, pB1, alB, scB, l_reg, pa); ILV_QK(); PIN2(pA0, pA1); SBAR();
    if (SDEPTH == 1 || j + 3 < NT) SLOAD(SE, (j + 1 + SDEPTH) * KVBLK); SBAR();
    pv(o, V_lds + SHM_V, pa, ones, r32, hi); partialSM<false>(pA0, pA1, m_reg, mt, alA, scA); ILV_PV(); PIN4(o); PIN2(pA0, pA1); SBAR();
#if ATT8_ONEBAR
    SWAIT(); SWRITE_K(1, SO); __syncthreads(); SWRITE_V(1, SO); RESC(alA);
#else
    __syncthreads(); SWAIT(); SWRITE(1, SO);
    RESC(alA); __syncthreads();
#endif
  }
  SBAR(); qkt(pB0, pB1, K_lds + SHM_K, qr, mt, r32, hi);
  finishSM(pA0, pA1, alA, scA, l_reg, pa); SBAR();
  pv(o, V_lds, pa, ones, r32, hi); partialSM<false>(pB0, pB1, m_reg, mt, alB, scB);
  __syncthreads(); RESC(alB);
  finishSM(pB0, pB1, alB, scB, l_reg, pa); SBAR();
  pv(o, V_lds + SHM_V, pa, ones, r32, hi);
#endif
  float rli[16];
  if (ATT8_ONES) {
#pragma unroll
    for (int r = 0; r < 16; ++r) rli[r] = __builtin_amdgcn_rcpf(o[4][r]);
  } else { if (hi == 0) li_l[r32] = l_reg; asm volatile("s_waitcnt lgkmcnt(0)" ::: "memory");
#pragma unroll
    for (int r = 0; r < 16; ++r) rli[r] = __builtin_amdgcn_rcpf(li_l[crow(r, hi)]); }
  bf16_t* Ow = Ob + (size_t)(wid * QBLK) * ldo;
#pragma unroll
  for (int r = 0; r < 16; ++r) { const int orow = crow(r, hi);
#pragma unroll
    for (int d0 = 0; d0 < 4; ++d0) { const float ov = o[d0][r] * rli[r];
      if (MLA_FP8) ((unsigned char*)Ob)[(size_t)(wid * QBLK + orow) * ldo + d0 * 32 + r32] = (unsigned char)(pk4fp8(ov, ov, ov, ov) & 0xffu);
      else Ow[(size_t)orow * ldo + d0 * 32 + r32] = f2bf(ov); } }
#undef SLOAD
#undef SWRITE
#undef SWRITE_K
#undef SWRITE_V
#undef SWAIT
#undef RESC
}
#undef SBAR
#undef SGB
#undef MFMA8
}

#ifdef DBG
constexpr size_t WS_DBG = 256 * 1024;
__device__ __forceinline__ unsigned hash32(unsigned x) { x ^= x >> 16; x *= 0x7feb352dU; x ^= x >> 15; x *= 0x846ca68bU; x ^= x >> 16; return x; }
__device__ __forceinline__ void dbg_acc(float* acc, int slot, float got, float ref) { const float d = got - ref; atomicAdd(acc + 2 * slot, d * d); atomicAdd(acc + 2 * slot + 1, ref * ref); }
__device__ __forceinline__ float dotA(const bf16_t* a, const float* W, int K, int ldw, int n) { float s = 0.f; for (int k = 0; k < K; ++k) s += bf2f(a[k]) * W[(size_t)k * ldw + n]; return s; }
__device__ __forceinline__ void chk_p1(const Ctx& C, const Args& a, unsigned char* ws, float* acc) {
    const int gt = C.bid * 512 + C.tid; if (gt >= 6144) return;
    const unsigned hs = hash32(gt * 7919u + 13u); const int t = hs % T, kind = gt % 6; const unsigned c0 = hs >> 14;
    const bf16_t* xn = (const bf16_t*)(ws + WS_XN) + (size_t)t * 1024; const float* w_in = (const float*)a.in[5];
    if (kind == 0) { const int c = c0 % 512; dbg_acc(acc, 0, bf2f(((const bf16_t*)(ws + AR_Q0))[(size_t)t * 512 + c]), dotA(xn, w_in, 1024, 3104, c) * 0.08838834764831845f); }
    else if (kind == 1) { const int c = c0 % 512; dbg_acc(acc, 0, bf2f(((const bf16_t*)(ws + AR_K0))[(size_t)t * 512 + c]), dotA(xn, w_in, 1024, 3104, 512 + c)); }
    else if (kind == 2) { const int c = c0 % 1024; dbg_acc(acc, 0, bf2f(((const bf16_t*)(ws + AR_VT))[(size_t)c * T + t]), dotA(xn, w_in, 1024, 3104, 1024 + c)); }
    else if (kind == 3) { const int c = c0 % 1024; dbg_acc(acc, 0, bf2f(((const bf16_t*)(ws + AR_SR))[(size_t)t * 1024 + c]), siluf(dotA(xn, w_in, 1024, 3104, 2048 + c))); }
    else { const int dir = kind - 4, c = c0 % 512; const float* wg = (const float*)a.in[dir ? 8 : 6]; const float* bg = (const float*)a.in[dir ? 9 : 7]; float lg = bg[c];
        for (int j = 0; j < 16; ++j) lg += dotA(xn, w_in, 1024, 3104, 3072 + 16 * dir + j) * wg[j * 512 + c];
        dbg_acc(acc, 1, ((const float*)(ws + (dir ? AR_GB : AR_GF)))[(size_t)t * 512 + c], logsigf(lg) * 0.0625f); }
}
__device__ __forceinline__ void chk_gla(const Ctx& C, const Args& a, unsigned char* ws, float* acc) {
    if (C.bid >= 64) return;
    float* A = (float*)C.lds; float* O = A + 4096; float* red = O + 512;
    const unsigned hs = hash32(C.bid * 977u + 5u); const int t = hs % T, h = (hs >> 14) & 3;
    const bf16_t* Q0 = (const bf16_t*)(ws + AR_Q0); const bf16_t* K0 = (const bf16_t*)(ws + AR_K0); const float* GF = (const float*)(ws + AR_GF); const float* GB = (const float*)(ws + AR_GB);
    const bf16_t* VT = (const bf16_t*)(ws + AR_VT); const bf16_t* SR = (const bf16_t*)(ws + AR_SR); const bf16_t* OG = (const bf16_t*)(ws + WS_XN);
    for (int i = C.tid; i < 4096; i += 512) A[i] = 0.f;
    __syncthreads();
    const int dir = C.tid >> 8, sub = C.tid & 255;
    if (sub < 128) { const int k = sub, ch = 128 * h + k; const float q = bf2f(Q0[(size_t)t * 512 + ch]); float Dk = dir ? __expf(GB[(size_t)t * 512 + ch]) : 1.f;
        for (int i = 0; i < 2048; ++i) { const int s = dir ? t + 1 + i : t - i; const bool valid = s >= 0 && s < T; float w = 0.f;
            if (valid) { w = q * Dk * bf2f(K0[(size_t)s * 512 + ch]); Dk *= __expf((dir ? GB : GF)[(size_t)s * 512 + ch]); }
            w = wave_sum(w); if (C.lane == 0) atomicAdd(&A[dir * 2048 + i], w); } }
    __syncthreads();
    { float o = 0.f; for (int i = 0; i < 2048; ++i) { const int s = dir ? t + 1 + i : t - i; if (s >= 0 && s < T) o += A[dir * 2048 + i] * bf2f(VT[(size_t)(256 * h + sub) * T + s]); } O[dir * 256 + sub] = o; }
    __syncthreads();
    if (C.tid < 256) { const float o = O[C.tid] + O[256 + C.tid]; float ss = wave_sum(o * o); if (C.lane == 0) red[C.wave] = ss; }
    __syncthreads();
    if (C.tid < 256) { const float o = O[C.tid] + O[256 + C.tid]; const float ss = red[0] + red[1] + red[2] + red[3]; const float r = 1.0f / sqrtf(ss * (1.0f / 256.0f) + RMS_EPS);
        const size_t oi = (size_t)t * 1024 + 256 * h + C.tid; dbg_acc(acc, 2, bf2f(OG[oi]), o * r * ((const float*)a.in[10])[C.tid] * bf2f(SR[oi])); }
    __syncthreads();
}
__device__ __forceinline__ void chk_resid(const Ctx& C, const float* base, const bf16_t* A, int K, const float* W, const float* HAp, float* acc, int slot) {
    const int gt = C.bid * 512 + C.tid; if (gt >= 4096) return;
    const unsigned hs = hash32(gt * 31u + slot); const int t = hs % T, n = (hs >> 14) % 1024;
    dbg_acc(acc, slot, HAp[(size_t)t * 1024 + n], base[(size_t)t * 1024 + n] + dotA(A + (size_t)t * K, W, K, 1024, n));
}
__device__ __forceinline__ void chk_router(const Ctx& C, const float* Hin, const float* gain, const float* Wr, const bf16_t* XN, const float* AFF, float* acc, int slot) {
    const int gt = C.bid * 512 + C.tid; if (gt >= 512) return;
    const int t = hash32(gt * 101u + 7u) % T; const float* hr = Hin + (size_t)t * 1024; float ss = 0.f; for (int k = 0; k < 1024; ++k) ss += hr[k] * hr[k];
    const float r = 1.0f / sqrtf(ss / 1024.0f + RMS_EPS); float lg[16]; for (int e = 0; e < 16; ++e) lg[e] = 0.f;
    for (int k = 0; k < 1024; ++k) { const float xv = hr[k] * r * gain[k]; for (int e = 0; e < 16; ++e) lg[e] += xv * Wr[k * 16 + e]; if ((k & 63) == (gt & 63)) dbg_acc(acc, slot, bf2f(XN[(size_t)t * 1024 + k]), xv); }
    float mx = lg[0]; for (int e = 1; e < 16; ++e) mx = fmaxf(mx, lg[e]); float s = 0.f; for (int e = 0; e < 16; ++e) { lg[e] = expf(lg[e] - mx); s += lg[e]; }
    for (int e = 0; e < 16; ++e) dbg_acc(acc, slot, AFF[(size_t)t * 16 + e], lg[e] / s);
}
__device__ __forceinline__ void chk_select(const Ctx& C, const float* AFF, const int* SEL, const int* IDX, unsigned* dw) {
    const int gt = C.bid * 512 + C.tid;
    for (int p = gt; p < T * 16; p += C.nb * 512) { const int t = p >> 4, e = p & 15; const int s = SEL[p]; const unsigned b = __float_as_uint(AFF[p]);
        if (s > 0) { atomicAdd(&dw[e], 1u); atomicMax(&dw[16 + e], ~b); if (s > CAP || IDX[e * CAP + s - 1] != t) atomicAdd(&dw[48], 1u); } else { atomicMax(&dw[32 + e], b); if (s < 0) atomicAdd(&dw[48], 1u); } }
}
__device__ __forceinline__ void chk_moe_h(const Ctx& C, const Args& a, unsigned char* ws, int layer, float* acc, int slot) {
    const int gt = C.bid * 512 + C.tid; if (gt >= 2048) return;
    const unsigned hs = hash32(gt * 53u + 3u); const int e = hs & 15, sl = (hs >> 4) % CAP, f = (hs >> 15) % FF; const int t = ((const int*)(ws + WS_IDX))[e * CAP + sl];
    if (t < 0 || t >= T) { dbg_acc(acc, slot, 1e3f, 0.f); return; }
    const bf16_t* xn = (const bf16_t*)(ws + WS_XN) + (size_t)t * 1024; const size_t wo = (size_t)(layer * NE + e) * 1024 * 2048;
    const float g = dotA(xn, (const float*)a.in[19] + wo, 1024, 2048, f), u = dotA(xn, (const float*)a.in[20] + wo, 1024, 2048, f);
    dbg_acc(acc, slot, bf2f(((const bf16_t*)(ws + AR_H))[((size_t)e * CAP + sl) * FF + f]), siluf(g) * u);
    dbg_acc(acc, slot, bf2f(((const bf16_t*)(ws + AR_XS))[((size_t)e * CAP + sl) * 1024 + (f & 1023)]), bf2f(xn[f & 1023]));
}
__device__ __forceinline__ void chk_moe_y(const Ctx& C, const Args& a, unsigned char* ws, int layer, float* acc, int slot) {
    const int gt = C.bid * 512 + C.tid; if (gt >= 2048) return;
    const unsigned hs = hash32(gt * 59u + 11u); const int e = hs & 15, sl = (hs >> 4) % CAP, n = (hs >> 15) % 1024;
    const float ref = dotA((const bf16_t*)(ws + AR_H) + ((size_t)e * CAP + sl) * FF, (const float*)a.in[21] + (size_t)(layer * NE + e) * 2048 * 1024, 2048, 1024, n);
    dbg_acc(acc, slot, bf2f(((const bf16_t*)(ws + AR_Y))[((size_t)e * CAP + sl) * 1024 + n]), ref);
}
__device__ __forceinline__ void chk_combine(const Ctx& C, unsigned char* ws, const float* Hin, const float* Hout, float* acc, int slot) {
    const int gt = C.bid * 512 + C.tid; if (gt >= 4096) return;
    const unsigned hs = hash32(gt * 67u + 1u); const int t = hs % T, n = (hs >> 14) % 1024; float ref = Hin[(size_t)t * 1024 + n];
    for (int e = 0; e < 16; ++e) { const int s = ((const int*)(ws + WS_SEL))[t * 16 + e]; if (s > 0) ref += ((const float*)(ws + WS_AFF))[t * 16 + e] * bf2f(((const bf16_t*)(ws + AR_Y))[((size_t)e * CAP + s - 1) * 1024 + n]); }
    dbg_acc(acc, slot, Hout[(size_t)t * 1024 + n], ref);
}
__device__ __forceinline__ void chk_cin(const Ctx& C, const Args& a, unsigned char* ws, float* acc) {
    const int gt = C.bid * 512 + C.tid; if (gt >= 4096) return;
    const unsigned hs = hash32(gt * 71u + 9u); const int t = hs % T, n = (hs >> 14) % 448;
    dbg_acc(acc, 10, ((const float*)(ws + AR_CIN))[(size_t)t * 512 + n], dotA((const bf16_t*)(ws + WS_XN) + (size_t)t * 1024, (const float*)a.in[12], 1024, 448, n));
}
__device__ __forceinline__ void chk_tok(const Ctx& C, const Args& a, unsigned char* ws, float* acc) {
    const int gt = C.bid * 512 + C.tid; if (gt >= 1024) return;
    const unsigned hs = hash32(gt * 73u + 19u); const int t = hs % T, h = (hs >> 14) & 15; const float* row = (const float*)(ws + AR_CIN) + (size_t)t * 512;
    float sq = 0.f, sk = 0.f; for (int i = 0; i < 256; ++i) sq += row[i] * row[i]; for (int i = 0; i < 128; ++i) sk += row[256 + i] * row[256 + i];
    const float rq = 1.0f / sqrtf(sq / 256.0f + RMS_EPS), rk = 1.0f / sqrtf(sk / 128.0f + RMS_EPS);
    const int i = (hs >> 18) % 256; dbg_acc(acc, 11, bf2f(((const bf16_t*)(ws + AR_CQN))[(size_t)t * 256 + i]), row[i] * rq * ((const float*)a.in[13])[i]);
    const int j = i & 127; dbg_acc(acc, 11, bf2f(((const bf16_t*)(ws + AR_CKVN))[(size_t)t * 256 + j]), row[256 + j] * rk * ((const float*)a.in[15])[j]);
    dbg_acc(acc, 11, 1.f + bf2f(((const bf16_t*)(ws + AR_CKVN))[(size_t)t * 256 + 128 + j]), 1.f);
    const int f = i & 31; const float ang = (float)((const int*)a.in[1])[t] * a.invf[f]; double xr = (double)ang * 0.15915494309189533577; xr = (xr - rint(xr)) * 6.283185307179586477; double cd = 1.0, sd = xr, tc = 1.0, ts = xr; for (int n = 1; n < 16; ++n) { tc *= -xr * xr / ((2.0 * n - 1.0) * (2.0 * n)); ts *= -xr * xr / ((2.0 * n) * (2.0 * n + 1.0)); cd += tc; sd += ts; } const float cr = (float)cd, sr = (float)sd;
    dbg_acc(acc, 11, ((const float*)(ws + WS_CS))[(size_t)t * 64 + f], cr); dbg_acc(acc, 11, ((const float*)(ws + WS_CS))[(size_t)t * 64 + 32 + f], sr);
    const float x1 = row[384 + f], x2 = row[416 + f]; const bf16_t* kp = (const bf16_t*)(ws + AR_K) + ((size_t)h * T + t) * MDK + 128 + 8 * (f >> 2) + (f & 3);
    dbg_acc(acc, 11, bf2f(kp[0]), x1 * cr - x2 * sr); dbg_acc(acc, 11, bf2f(kp[4]), x1 * sr + x2 * cr);
}
__device__ __forceinline__ void chk_qkv(const Ctx& C, const Args& a, unsigned char* ws, float* acc) {
    const int gt = C.bid * 512 + C.tid; if (gt >= 4096) return;
    const unsigned hs = hash32(gt * 79u + 29u); const int t = hs % T, h = (hs >> 14) & 15, j = (hs >> 18) & 127, kind = gt & 3; const float QS = (ATT_FP8 ? 8.0f : 1.0f) * 0.07216878364870322f * 1.4426950408889634f;
    const bf16_t* cq = (const bf16_t*)(ws + AR_CQN) + (size_t)t * 256; const bf16_t* ck = (const bf16_t*)(ws + AR_CKVN) + (size_t)t * 256;
    const size_t qo = ((size_t)h * T + t) * MDK; const int tau = t & 63, pos = 32 * ((tau >> 2) & 1) + (tau & 3) + 4 * ((tau >> 3) & 3) + 16 * (tau >> 5);
#if ATT_FP8
#define QV(i) fp8f(ws + AR_Q8 + qo + (i))
#define KV(i) fp8f(ws + AR_K8 + qo + (i))
#define VV(i) fp8f(ws + AR_V8T + ((size_t)h * MDV + (i)) * T + (t & ~63) + pos)
#else
#define QV(i) bf2f(((const bf16_t*)(ws + AR_Q))[qo + (i)])
#define KV(i) bf2f(((const bf16_t*)(ws + AR_K))[qo + (i)])
#define VV(i) bf2f(((const bf16_t*)(ws + AR_V))[((size_t)h * T + t) * MDV + (i)])
#endif
    if (kind == 0) dbg_acc(acc, 12, QV(j), dotA(cq, (const float*)a.in[14], 256, 3072, 192 * h + j) * QS);
    else if (kind == 1) { const int f = j & 31; const float x1 = dotA(cq, (const float*)a.in[14], 256, 3072, 192 * h + 128 + f), x2 = dotA(cq, (const float*)a.in[14], 256, 3072, 192 * h + 160 + f);
        const float cr = ((const float*)(ws + WS_CS))[(size_t)t * 64 + f], sr = ((const float*)(ws + WS_CS))[(size_t)t * 64 + 32 + f]; const int qp = 128 + 8 * (f >> 2) + (f & 3);
        dbg_acc(acc, 12, QV(qp), (x1 * cr - x2 * sr) * QS); dbg_acc(acc, 12, QV(qp + 4), (x1 * sr + x2 * cr) * QS);
        const float* row = (const float*)(ws + AR_CIN) + (size_t)t * 512; const float k1 = row[384 + f], k2 = row[416 + f];
        dbg_acc(acc, 12, KV(qp), k1 * cr - k2 * sr); dbg_acc(acc, 12, KV(qp + 4), k1 * sr + k2 * cr); }
    else if (kind == 2) dbg_acc(acc, 12, KV(j), dotA(ck, (const float*)a.in[16], 128, 4096, 256 * h + j));
    else dbg_acc(acc, 12, VV(j), dotA(ck, (const float*)a.in[16], 128, 4096, 256 * h + 128 + j));
#undef QV
#undef KV
#undef VV
}
__device__ __forceinline__ void chk_attn(const Ctx& C, unsigned char* ws, float* acc) {
    if (C.bid >= 64) return;
    float* P = (float*)C.lds; float* red = P + T; float* qs = red + 32;
    const unsigned hs = hash32(C.bid * 991u + 77u); const int t = hs % T, h = (hs >> 14) & 15;
#if ATT_FP8
    const unsigned char* Q = ws + AR_Q8 + ((size_t)h * T + t) * MDK; const unsigned char* K = ws + AR_K8 + (size_t)h * T * MDK; const unsigned char* V = ws + AR_V8T + (size_t)h * MDV * T; const float SC = 0.125f;
    if (C.tid < MDK) qs[C.tid] = fp8f(Q + C.tid);
#define KEL(j, d) fp8f(K + (size_t)(j) * MDK + (d))
#define VEL(j, d) fp8f(V + (size_t)(d) * T + ((j) & ~63) + 32 * ((((j) & 63) >> 2) & 1) + ((j) & 3) + 4 * ((((j) & 63) >> 3) & 3) + 16 * (((j) & 63) >> 5))
#else
    const bf16_t* Q = (const bf16_t*)(ws + AR_Q) + ((size_t)h * T + t) * MDK; const bf16_t* K = (const bf16_t*)(ws + AR_K) + (size_t)h * T * MDK; const bf16_t* V = (const bf16_t*)(ws + AR_V) + (size_t)h * T * MDV; const float SC = 1.0f;
    if (C.tid < MDK) qs[C.tid] = bf2f(Q[C.tid]);
#define KEL(j, d) bf2f(K[(size_t)(j) * MDK + (d)])
#define VEL(j, d) bf2f(V[(size_t)(j) * MDV + (d)])
#endif
    __syncthreads();
    float mx = -1e30f;
    for (int j = C.tid; j < T; j += 512) { float s = 0.f; for (int d = 0; d < MDK; ++d) s += qs[d] * KEL(j, d); s *= SC; P[j] = s; mx = fmaxf(mx, s); }
    mx = wave_max(mx); if (C.lane == 0) red[C.wave] = mx;
    __syncthreads();
    mx = red[0]; for (int w = 1; w < 8; ++w) mx = fmaxf(mx, red[w]);
    float sm = 0.f; for (int j = C.tid; j < T; j += 512) { const float p = exp2f(P[j] - mx); P[j] = p; sm += p; }
    sm = wave_sum(sm);
    __syncthreads();
    if (C.lane == 0) red[8 + C.wave] = sm;
    __syncthreads();
    sm = 0.f; for (int w = 0; w < 8; ++w) sm += red[8 + w];
    if (C.tid < MDV) { float o = 0.f; for (int j = 0; j < T; ++j) o += P[j] * VEL(j, C.tid); const float got = (ATT_FP8 && MLA_FP8) ? fp8f(ws + AR_O + (size_t)t * 2048 + 128 * h + C.tid) : bf2f(((const bf16_t*)(ws + AR_O))[(size_t)t * 2048 + 128 * h + C.tid]); dbg_acc(acc, 13, got * 100.f, o / sm * 100.f); }
    __syncthreads();
#undef KEL
#undef VEL
}
__device__ __forceinline__ void dbg_report(const Ctx& C, unsigned char* ws, float* out, int lo, int hi) {
    const float* acc = (const float*)(ws + WS_DBG); const unsigned* dw = (const unsigned*)(ws + WS_DBG + 1024);
    int code = 90;
    for (int s = lo; s < hi && code == 90; ++s) { float num = __hip_atomic_load(acc + 2 * s, __ATOMIC_RELAXED, __HIP_MEMORY_SCOPE_AGENT), den = __hip_atomic_load(acc + 2 * s + 1, __ATOMIC_RELAXED, __HIP_MEMORY_SCOPE_AGENT);
        if (s == 5) { unsigned viol = __hip_atomic_load(dw + 48, __ATOMIC_RELAXED, __HIP_MEMORY_SCOPE_AGENT); for (int e = 0; e < 16; ++e) { const unsigned cnt = __hip_atomic_load(dw + e, __ATOMIC_RELAXED, __HIP_MEMORY_SCOPE_AGENT), mn = ~__hip_atomic_load(dw + 16 + e, __ATOMIC_RELAXED, __HIP_MEMORY_SCOPE_AGENT), mxu = __hip_atomic_load(dw + 32 + e, __ATOMIC_RELAXED, __HIP_MEMORY_SCOPE_AGENT); if (cnt != CAP) viol += 1000; if (mn < mxu) viol += 1; }
            num = (float)viol; den = 1.f; if (viol == 0) continue; code = 10 * (s - lo) + (viol >= 1000 ? 0 : (viol >= 100 ? 1 : (viol >= 10 ? 2 : 3))); break; }
        if (den == 0.f && num == 0.f) continue;
        const float e = sqrtf(num / den);
        if (!(e < 0.03f)) { const int b = !(e < 1.f) ? 0 : (e >= 0.3f ? 1 : (e >= 0.1f ? 2 : 3)); code = 10 * (s - lo) + b; } }
    if (code == 90) { float worst = 0.f; for (int s = lo; s < hi; ++s) { if (s == 5) continue; const float num = acc[2 * s], den = acc[2 * s + 1]; if (den > 0.f) worst = fmaxf(worst, sqrtf(num / den)); }
        code = 90 + (worst >= 0.01f ? 1 : (worst >= 0.003f ? 2 : 3)); }
    if (DBG >= 2) { const int sl = DBG == 2 ? 13 : 12; const float num = acc[2 * sl], den = acc[2 * sl + 1]; const float e = sqrtf(num / den); code = !(e > 0.f) ? 99 : (e >= 1.f ? 0 : (int)fminf(89.f, -20.f * log10f(e))); }
    const float c = sqrtf((float)code);
    for (size_t i = (size_t)C.bid * 512 + C.tid; i < (size_t)T * D; i += (size_t)C.nb * 512) out[i] = c;
}
#endif

constexpr int NPHASE = 24;
__global__ void __launch_bounds__(512, 2) mk_fwd(Args args) {
    extern __shared__ __attribute__((aligned(16))) unsigned char lds[];
    Ctx C; C.tid = threadIdx.x; C.lane = C.tid & 63; C.wave = __builtin_amdgcn_readfirstlane(C.tid >> 6); C.bid = blockIdx.x; C.nb = gridDim.x;
    C.gw = C.bid * 8 + C.wave; C.ngw = C.nb * 8; C.lds = lds;
    unsigned char* ws = args.ws;
    volatile LAS unsigned* MISC = (volatile LAS unsigned*)((LAS unsigned char*)lds + LDS_MISC);
    if (C.tid < 32) MISC[C.tid] = 0u;
    __syncthreads();
    XcdBarrier bar = xcd_barrier_post((unsigned*)(ws + WS_CTL) + 4096 + args.li * XCD_BAR_WORDS, MISC + 8);
    const int lo = args.ph_lo, hi = args.ph_hi;
#if defined(PH_MASK)
#define IN(k) ((((PH_MASK) >> (k)) & 1u) && lo <= (k) && (k) < hi)
#elif defined(PH_ONLY)
#define IN(k) ((k) == PH_ONLY && lo <= (k) && (k) < hi)
#else
#define IN(k) (lo <= (k) && (k) < hi)
#endif
#define SEAM(k) do { if (IN((k) + 1)) xcd_barrier(bar); } while (0)
#ifndef REPMASK
#define REPMASK 0u
#endif
#define NREP(k) ((((REPMASK) >> (k)) & 1u) ? 2 : 1)
#ifdef DBG
    float* dacc = (float*)(ws + WS_DBG); unsigned* ddw = (unsigned*)(ws + WS_DBG + 1024);
#define DBGCHK(page, call) do { if ((DBG >= 2 ? 1 : DBG) == (page)) { call; xcd_barrier(bar); } } while (0)
#else
#define DBGCHK(page, call) do { } while (0)
#endif
    PG8_LAS unsigned char* glds = (PG8_LAS unsigned char*)lds;
    const float* x = (const float*)args.in[0];
    float* HA = args.out; float* HB = (float*)(ws + WS_HB);
    bf16_t* XN = (bf16_t*)(ws + WS_XN);
    float* AFF = (float*)(ws + WS_AFF); int* SEL = (int*)(ws + WS_SEL); int* IDX = (int*)(ws + WS_IDX);
    bf16_t* WGU = (bf16_t*)(ws + WS_WGU); bf16_t* WD = (bf16_t*)(ws + WS_WD);
    bf16_t* XS = (bf16_t*)(ws + AR_XS); bf16_t* HH = (bf16_t*)(ws + AR_H); bf16_t* YY = (bf16_t*)(ws + AR_Y);

    if (IN(0)) { ph_convert_small(C, args, ws); ph_convert_moe(C, args, ws, 0, NREP(0)); ph_norm(C, x, (const float*)args.in[2], XN); SEAM(0); }
    if (IN(1)) {
        { pg8::Gemm g{XN, (const bf16_t*)(ws + WS_WGIN), T, 3072, 1024}; pg8::StaticOrder S; S.init(T, 3072, C.nb, C.bid); S.rep = NREP(1);
          pg8::EpiGlaIn E{(bf16_t*)(ws + AR_Q0), (bf16_t*)(ws + AR_K0), (bf16_t*)(ws + AR_SR), (float*)(ws + AR_GF), (float*)(ws + AR_GB), (const float*)args.in[7], (const float*)args.in[9]};
          pg8::gemm_phase<pg8::EpiGlaIn, pg8::StaticOrder, PG8_ALIGN, PG8_SP2>(glds, g, S, E); }
        { pg8::Gemm g{(const bf16_t*)(ws + WS_WV), XN, 1024, T, 1024}; pg8::StaticOrder S; S.init(1024, T, C.nb, C.bid); S.rep = NREP(1);
          pg8::EpiBf E{(bf16_t*)(ws + AR_VT), T};
          pg8::gemm_phase<pg8::EpiBf, pg8::StaticOrder, PG8_ALIGN, PG8_SP2>(glds, g, S, E); }
        SEAM(1); } DBGCHK(0, chk_p1(C, args, ws, dacc));
    if (IN(2)) for (int rep_ = 0; rep_ < NREP(2); ++rep_) { ph_gla_prep(C, (const bf16_t*)(ws + AR_Q0), (const bf16_t*)(ws + AR_K0), (const float*)(ws + AR_GF), (const float*)(ws + AR_GB), (bf16_t*)(ws + AR_QDF), (bf16_t*)(ws + AR_QDB),
                             (bf16_t*)(ws + AR_KDF), (bf16_t*)(ws + AR_KDB), (bf16_t*)(ws + AR_KTF), (bf16_t*)(ws + AR_KTB), (float*)(ws + WS_EGL)); SEAM(2); }
    if (IN(3)) for (int rep_ = 0; rep_ < NREP(3); ++rep_) { ph_gla_u(C, (const bf16_t*)(ws + AR_VT), (const bf16_t*)(ws + AR_KTF), (const bf16_t*)(ws + AR_KTB), (const float*)(ws + WS_EGL), (bf16_t*)(ws + AR_U)); SEAM(3); }
    if (IN(4)) for (int rep_ = 0; rep_ < NREP(4); ++rep_) { ph_gla_scan(C, (const bf16_t*)(ws + AR_U), (const float*)(ws + WS_EGL), (bf16_t*)(ws + AR_ST)); SEAM(4); }
    if (IN(5)) for (int rep_ = 0; rep_ < NREP(5); ++rep_) { ph_gla_out(C, (const bf16_t*)(ws + AR_QDF), (const bf16_t*)(ws + AR_QDB), (const bf16_t*)(ws + AR_KDF), (const bf16_t*)(ws + AR_KDB), (const bf16_t*)(ws + AR_VT), (const bf16_t*)(ws + AR_ST),
                            (const bf16_t*)(ws + AR_SR), (const float*)args.in[10], XN); SEAM(5); } DBGCHK(0, chk_gla(C, args, ws, dacc));
    if (IN(6)) { pg8::Gemm g{XN, (const bf16_t*)(ws + WS_WGOUT), T, 1024, 1024}; pg8::StaticOrder S; S.init(T, 1024, C.nb, C.bid); S.rep = NREP(6);
        pg8::EpiF32 E{HA, x, 1024, 1.0f}; pg8::gemm_phase<pg8::EpiF32, pg8::StaticOrder, false, PG8_SP2>(glds, g, S, E); SEAM(6); } DBGCHK(0, chk_resid(C, x, XN, 1024, (const float*)args.in[11], HA, dacc, 3));
#define MOE_LAYER(P, L, HIN, TAILMODE, HOUT, GAIN2, OUTP)                                                                                         \
    if (IN(P)) for (int rep_ = 0; rep_ < NREP(P); ++rep_) { ph_router(C, HIN, (const float*)args.in[3] + (L) * 1024, (const float*)args.in[18] + (L) * 1024 * 16, XN, AFF, (float*)(ws + WS_AFFT), ws + AR_XN8); SEAM(P); if ((P) == 7) DBGCHK(0, chk_router(C, HIN, (const float*)args.in[3] + (L) * 1024, (const float*)args.in[18] + (L) * 1024 * 16, XN, AFF, dacc, 4)); }       \
    if (IN(P + 1)) for (int rep_ = 0; rep_ < NREP(P + 1); ++rep_) { ph_select(C, (const float*)(ws + WS_AFFT), SEL, IDX); SEAM(P + 1); if ((P) == 7) DBGCHK(0, chk_select(C, AFF, SEL, IDX, ddw)); }                                                                                 \
    if (IN(P + 2)) for (int rep_ = 0; rep_ < NREP(P + 2); ++rep_) { ph_gather(C, IDX, XN, XS, ws + AR_XN8); SEAM(P + 2); }                                                                                   \
    if (IN(P + 3)) { pg8::Gemm g{XS, WGU, NE * CAP, 4096, MOE_FP8 ? 512 : 1024}; pg8::GroupedOrder S; S.init(NE * CAP, 4096, C.nb, C.bid); S.rep = NREP(P + 3); pg8::EpiMoe1 E{HH};     \
        pg8::gemm_phase<pg8::EpiMoe1, pg8::GroupedOrder, PG8_ALIGN, false, MOE_FP8 != 0>(glds, g, S, E); SEAM(P + 3); if ((P) == 7) DBGCHK(0, chk_moe_h(C, args, ws, L, dacc, 6)); }                                       \
    if (IN(P + 4)) { pg8::Gemm g{HH, WD, NE * CAP, 1024, MOE_FP8 ? 1024 : 2048}; pg8::GroupedOrder S; S.init(NE * CAP, 1024, C.nb, C.bid); S.rep = NREP(P + 4); pg8::EpiMoe2 E{YY};      \
        pg8::gemm_phase<pg8::EpiMoe2, pg8::GroupedOrder, PG8_ALIGN, false, MOE_FP8 != 0>(glds, g, S, E); SEAM(P + 4); if ((P) == 7) DBGCHK(0, chk_moe_y(C, args, ws, L, dacc, 7)); }                                       \
    if (IN(P + 5)) for (int rep_ = 0; rep_ < NREP(P + 5); ++rep_) { ph_combine<TAILMODE>(C, HIN, AFF, SEL, YY, HOUT, GAIN2, XN, OUTP); SEAM(P + 5); if ((P) == 7) DBGCHK(0, chk_combine(C, ws, HIN, HOUT, dacc, 8)); }

    MOE_LAYER(7, 0, HA, 1, HB, (const float*)args.in[2] + 1024, nullptr)
    if (IN(13)) { pg8::Gemm g{XN, (const bf16_t*)(ws + WS_WMIN), T, 512, MLA_FP8 ? 512 : 1024}; pg8::StaticOrder S; S.init(T, 512, C.nb, C.bid); S.rep = NREP(13);
        pg8::EpiF32 E{(float*)(ws + AR_CIN), nullptr, 512, MLA_FP8 ? 0.03125f : 1.0f}; pg8::gemm_phase<pg8::EpiF32, pg8::StaticOrder, false, false, MLA_FP8 != 0>(glds, g, S, E); SEAM(13); } DBGCHK(1, chk_cin(C, args, ws, dacc));
    if (IN(14)) { ph_mla_tok(C, (const float*)(ws + AR_CIN), (const int*)args.in[1], (const float*)args.in[13], (const float*)args.in[15], args.invf, (bf16_t*)(ws + AR_CQN), (bf16_t*)(ws + AR_CKVN),
                             (float*)(ws + WS_CS), (bf16_t*)(ws + AR_K));
        ph_convert_moe(C, args, ws, 1, NREP(14)); SEAM(14); } DBGCHK(1, chk_tok(C, args, ws, dacc));
    if (IN(15)) {
#if ATT_FP8
        { pg8::Gemm g{(const bf16_t*)(ws + AR_CQN), (const bf16_t*)(ws + WS_WUQ), T, 4096, 256}; pg8::StaticOrder S; S.init(T, 4096, C.nb, C.bid); S.rep = NREP(15);
          pg8::EpiQ8 E{ws + AR_Q8, (const float*)(ws + WS_CS)}; pg8::gemm_phase<pg8::EpiQ8, pg8::StaticOrder, PG8_ALIGN, PG8_SP2>(glds, g, S, E); }
        { pg8::Gemm g{(const bf16_t*)(ws + AR_CKVN), (const bf16_t*)(ws + WS_WUKV), T, 2048, 256}; pg8::StaticOrder S; S.init(T, 2048, C.nb, C.bid); S.rep = NREP(15);
          pg8::EpiK8 E{ws + AR_K8}; pg8::gemm_phase<pg8::EpiK8, pg8::StaticOrder, PG8_ALIGN, PG8_SP2>(glds, g, S, E); }
        { pg8::Gemm g{(const bf16_t*)(ws + WS_WUKV) + (size_t)2048 * 256, (const bf16_t*)(ws + AR_CKVN), 2048, T, 256}; pg8::StaticOrder S; S.init(2048, T, C.nb, C.bid); S.rep = NREP(15);
          pg8::EpiV8T E{ws + AR_V8T}; pg8::gemm_phase<pg8::EpiV8T, pg8::StaticOrder, PG8_ALIGN, PG8_SP2>(glds, g, S, E); }
#else
        { pg8::Gemm g{(const bf16_t*)(ws + AR_CQN), (const bf16_t*)(ws + WS_WUQ), T, 4096, 256}; pg8::StaticOrder S; S.init(T, 4096, C.nb, C.bid); S.rep = NREP(15);
          pg8::EpiQup E{(bf16_t*)(ws + AR_Q), (const float*)(ws + WS_CS)}; pg8::gemm_phase<pg8::EpiQup, pg8::StaticOrder, PG8_ALIGN, PG8_SP2>(glds, g, S, E); }
        { pg8::Gemm g{(const bf16_t*)(ws + AR_CKVN), (const bf16_t*)(ws + WS_WUKV), T, 4096, 256}; pg8::StaticOrder S; S.init(T, 4096, C.nb, C.bid); S.rep = NREP(15);
          pg8::EpiKVup E{(bf16_t*)(ws + AR_K), (bf16_t*)(ws + AR_V)}; pg8::gemm_phase<pg8::EpiKVup, pg8::StaticOrder, PG8_ALIGN, PG8_SP2>(glds, g, S, E); }
#endif
        SEAM(15); } DBGCHK(1, chk_qkv(C, args, ws, dacc));
    if (IN(16)) {
        const int nun = MH * (T / 256);
        for (int ii = 0; ii * C.nb + C.bid < nun * NREP(16); ++ii) { const int i = ii % (nun / C.nb);
            int h, qb; if (C.nb == 256) { h = (C.bid & 7) + 8 * (i >> 1); qb = (i & 1) * 32 + (C.bid >> 3); } else { const int u = i * C.nb + C.bid; h = u >> 6; qb = u & 63; }
#if ATT_FP8
            att8::attn_body(ws + AR_Q8 + ((size_t)h * T + (size_t)qb * 256) * MDK, ws + AR_K8 + (size_t)h * T * MDK, ws + AR_V8T + (size_t)h * MDV * T,
                            MLA_FP8 ? (bf16_t*)(ws + AR_O + (size_t)qb * 256 * 2048 + 128 * h) : (bf16_t*)(ws + AR_O) + (size_t)qb * 256 * 2048 + 128 * h, 2048, T, (char*)lds);
#else
            const bf16_t* Qb = (const bf16_t*)(ws + AR_Q) + ((size_t)h * T + (size_t)qb * 256) * MDK;
            att::attn_body(Qb, (const bf16_t*)(ws + AR_K) + (size_t)h * T * MDK, (const bf16_t*)(ws + AR_V) + (size_t)h * T * MDV, (bf16_t*)(ws + AR_O) + (size_t)qb * 256 * 2048 + 128 * h, 2048, T, (char*)lds);
#endif
            __syncthreads();
        }
        SEAM(16); } DBGCHK(1, chk_attn(C, ws, dacc));
    if (IN(17)) { pg8::Gemm g{(const bf16_t*)(ws + AR_O), (const bf16_t*)(ws + WS_WMOUT), T, 1024, MLA_FP8 ? 1024 : 2048}; pg8::StaticOrder S; S.init(T, 1024, C.nb, C.bid); S.rep = NREP(17);
        pg8::EpiF32 E{HA, HB, 1024, MLA_FP8 ? 0.03125f : 1.0f}; pg8::gemm_phase<pg8::EpiF32, pg8::StaticOrder, false, false, MLA_FP8 != 0>(glds, g, S, E); SEAM(17); } DBGCHK(1, chk_resid(C, HB, (const bf16_t*)(ws + AR_O), 2048, (const float*)args.in[17], HA, dacc, 14));
    MOE_LAYER(18, 1, HA, 2, nullptr, (const float*)args.in[4], args.out)
#ifdef DBG
    xcd_barrier(bar); dbg_report(C, ws, args.out, DBG == 0 ? 0 : 10, DBG == 0 ? 10 : 20);
#endif
#undef IN
#undef SEAM
}

#ifndef MK_N_LAUNCHES
#define MK_N_LAUNCHES 1
#endif
extern "C" void kernel_launch(void* const* d_in, const int* in_sizes, int n_in, void* d_out, int out_size, void* d_ws, size_t ws_size, hipStream_t stream) {
    static int grid = 0;
    if (grid == 0) {
        if (n_in != 22 || out_size != T * D || ws_size < WS_END) { fprintf(stderr, "kernel_launch: unexpected shapes (n_in %d out %d ws %zu, need ws >= %zu)\n", n_in, out_size, ws_size, (size_t)WS_END); grid = -1; return; }
        int dev = 0, cus = 0, per_cu = 0;
        if (hipGetDevice(&dev) != hipSuccess || hipDeviceGetAttribute(&cus, hipDeviceAttributeMultiprocessorCount, dev) != hipSuccess) { grid = -1; return; }
        if (hipFuncSetAttribute((const void*)mk_fwd, hipFuncAttributeMaxDynamicSharedMemorySize, LDS_BYTES) != hipSuccess) { fprintf(stderr, "kernel_launch: hipFuncSetAttribute failed\n"); grid = -1; return; }
        if (hipOccupancyMaxActiveBlocksPerMultiprocessor(&per_cu, (const void*)mk_fwd, 512, LDS_BYTES) != hipSuccess || per_cu < 1) fprintf(stderr, "kernel_launch: occupancy query says %d\n", per_cu);
        (void)hipGetLastError();
        grid = cus;
    }
    if (grid < 0) return;
    (void)hipMemsetAsync((char*)d_ws + WS_CTL, 0, CTL_ZERO_BYTES, stream);
    Args a{};
    for (int i = 0; i < 22; ++i) a.in[i] = d_in[i];
    a.out = (float*)d_out; a.ws = (unsigned char*)d_ws;
    for (int i = 0; i < 32; ++i) a.invf[i] = powf(10000.0f, -(float)i / 32.0f);
    if (MK_N_LAUNCHES == 1) { a.ph_lo = 0; a.ph_hi = NPHASE; a.li = 0; hipLaunchKernelGGL(mk_fwd, dim3(grid), dim3(512), LDS_BYTES, stream, a); }
    else { for (int p = 0; p < NPHASE; ++p) { a.ph_lo = p; a.ph_hi = p + 1; a.li = p; hipLaunchKernelGGL(mk_fwd, dim3(grid), dim3(512), LDS_BYTES, stream, a); } }
}
```

```cpp
#include <hip/hip_runtime.h>
#include <cstdio>
#include <cstdint>
#include <cmath>

constexpr int T = 16384, D = 1024, NE = 16, CAP = 2048, FF = 2048;
constexpr int GH = 4, GDK = 128, GDV = 256, GC = 64, GNC = T / GC;
constexpr int MH = 16, MDK = 192, MDV = 128;
constexpr float RMS_EPS = 1e-6f;

typedef unsigned short bf16_t;
typedef short bf16x8 __attribute__((ext_vector_type(8)));
typedef short s16x4 __attribute__((ext_vector_type(4)));
typedef float f32x4 __attribute__((ext_vector_type(4)));
typedef float f32x2 __attribute__((ext_vector_type(2)));
typedef float f32x16 __attribute__((ext_vector_type(16)));
typedef unsigned u32x4 __attribute__((ext_vector_type(4)));
typedef unsigned u32x2 __attribute__((ext_vector_type(2)));
typedef int i32x8 __attribute__((ext_vector_type(8)));
#ifndef MOE_FP8
#define MOE_FP8 1
#endif
#ifndef CONV_OVERLAP
#define CONV_OVERLAP 0
#endif
#ifndef GLA256
#define GLA256 1
#endif
#ifndef MLA_FP8
#define MLA_FP8 1
#endif
#ifndef MLA_ABSORB
#define MLA_ABSORB 1
#endif
#ifndef ATT8_DMA
#define ATT8_DMA 1
#endif
#ifndef ATT_FP8
#define ATT_FP8 1
#endif

constexpr size_t MiB = 1u << 20;
constexpr size_t WS_CTL = 0, CTL_ZERO_BYTES = 512 * 1024;
constexpr size_t WS_WGIN = 1 * MiB;
constexpr size_t WS_WV = 7 * MiB;
constexpr size_t WS_WGOUT = 9 * MiB;
constexpr size_t WS_WMIN = 11 * MiB;
constexpr size_t WS_WUQ = 12 * MiB;
constexpr size_t WS_WUKV = 14 * MiB;
constexpr size_t WS_WMOUT = 16 * MiB;
constexpr size_t WS_WGU = 20 * MiB;
constexpr size_t WS_WD = 148 * MiB;
constexpr size_t WS_AFF = 212 * MiB;
constexpr size_t WS_SEL = 213 * MiB;
constexpr size_t WS_IDX = 214 * MiB;
constexpr size_t WS_EGL = 215 * MiB;
constexpr size_t WS_CS = 216 * MiB;
constexpr size_t WS_XN = 220 * MiB;
constexpr size_t WS_HB = 252 * MiB;
constexpr size_t WS_AR = 316 * MiB;
constexpr size_t WS_AFFT = 828 * MiB;
constexpr size_t WS_END = 829 * MiB;
constexpr size_t AR_Q0 = WS_AR, AR_K0 = WS_AR + 16 * MiB, AR_GF = WS_AR + 32 * MiB, AR_GB = WS_AR + 64 * MiB, AR_SR = WS_AR + 96 * MiB, AR_VT = WS_AR + 128 * MiB;
constexpr size_t AR_QDF = WS_AR + 160 * MiB, AR_QDB = WS_AR + 176 * MiB, AR_KDF = WS_AR + 192 * MiB, AR_KDB = WS_AR + 208 * MiB, AR_KTF = WS_AR + 224 * MiB, AR_KTB = WS_AR + 240 * MiB;
constexpr size_t AR_U = WS_AR + 256 * MiB, AR_ST = WS_AR + 384 * MiB;
constexpr size_t AR_XS = WS_AR, AR_H = WS_AR + 64 * MiB, AR_Y = WS_AR + 192 * MiB, AR_XN8 = WS_AR + 256 * MiB;
constexpr size_t AR_CIN = WS_AR, AR_CQN = WS_AR + 32 * MiB, AR_CKVN = WS_AR + 40 * MiB, AR_Q = WS_AR + 48 * MiB, AR_K = WS_AR + 144 * MiB, AR_V = WS_AR + 240 * MiB, AR_O = WS_AR + 304 * MiB;

constexpr size_t AR_Q8 = AR_Q, AR_K8 = AR_K, AR_V8T = AR_V;
constexpr int LDS_BYTES = 147456;
constexpr int LDS_MISC = 135168;

__device__ __forceinline__ unsigned cvt_pk_bf16(float lo, float hi) { unsigned r; asm volatile("v_cvt_pk_bf16_f32 %0, %1, %2" : "=v"(r) : "v"(lo), "v"(hi)); return r; }
__device__ __forceinline__ float bf_lo(unsigned w) { return __uint_as_float(w << 16); }
__device__ __forceinline__ float bf_hi(unsigned w) { return __uint_as_float(w & 0xffff0000u); }
__device__ __forceinline__ float bf2f(bf16_t b) { return __uint_as_float(((unsigned)b) << 16); }
__device__ __forceinline__ bf16_t f2bf(float f) { return (bf16_t)(cvt_pk_bf16(f, 0.f) & 0xffffu); }
__device__ __forceinline__ float siluf(float x) { return x * __builtin_amdgcn_rcpf(1.f + __expf(-x)); }
__device__ __forceinline__ float logsigf(float x) { return fminf(x, 0.f) - __logf(1.f + __expf(-fabsf(x))); }
__device__ __forceinline__ void store8bf(bf16_t* p, f32x4 v0, f32x4 v1) {
    u32x4 w; w.x = cvt_pk_bf16(v0[0], v0[1]); w.y = cvt_pk_bf16(v0[2], v0[3]); w.z = cvt_pk_bf16(v1[0], v1[1]); w.w = cvt_pk_bf16(v1[2], v1[3]); *(u32x4*)p = w; }
__device__ __forceinline__ unsigned pk4fp8(float a, float b, float c, float d) { int w = __builtin_amdgcn_cvt_pk_fp8_f32(a, b, 0, false); w = __builtin_amdgcn_cvt_pk_fp8_f32(c, d, w, true); return (unsigned)w; }
__device__ __forceinline__ void store8fp8(unsigned char* p, f32x4 v0, f32x4 v1) { u32x2 w; w.x = pk4fp8(v0[0], v0[1], v0[2], v0[3]); w.y = pk4fp8(v1[0], v1[1], v1[2], v1[3]); *(u32x2*)p = w; }
__device__ __forceinline__ float fp8f(const unsigned char* p) { const unsigned w = *(const unsigned*)((size_t)p & ~(size_t)3); const int b = (int)((size_t)p & 3);
    return b == 0 ? __builtin_amdgcn_cvt_f32_fp8((int)w, 0) : b == 1 ? __builtin_amdgcn_cvt_f32_fp8((int)w, 1) : b == 2 ? __builtin_amdgcn_cvt_f32_fp8((int)w, 2) : __builtin_amdgcn_cvt_f32_fp8((int)w, 3); }
__device__ __forceinline__ float wave_sum(float v) {
#pragma unroll
    for (int o = 1; o < 64; o <<= 1) v += __shfl_xor(v, o);
    return v; }
__device__ __forceinline__ float wave_max(float v) {
#pragma unroll
    for (int o = 1; o < 64; o <<= 1) v = fmaxf(v, __shfl_xor(v, o));
    return v; }
#define LAS __attribute__((address_space(3)))
#define LDS_WAIT() asm volatile("s_waitcnt lgkmcnt(0)" ::: "memory")
#define VM_WAIT() asm volatile("s_waitcnt vmcnt(0)" ::: "memory")

namespace pg8 {
#define PG8_LAS __attribute__((address_space(3)))
typedef unsigned short bf16_t;
typedef short bf16x8 __attribute__((ext_vector_type(8)));
typedef float f32x4 __attribute__((ext_vector_type(4)));
typedef unsigned u32x4 __attribute__((ext_vector_type(4)));
constexpr int BM = 256, BK = 64, HALF = 128, HTB = HALF * BK * 2  , STAGE_BYTES = 8 * HTB, NXCD = 8, WGM = 8;

__host__ __device__ __forceinline__ int lds_byte(int r, int c) { const int st = (r >> 4) * 2 + (c >> 5), rr = r & 15, cc = c & 31, ob = rr * 64 + cc * 2; return st * 1024 + (ob ^ (((ob >> 9) & 1) << 5)); }
__host__ __device__ __forceinline__ void stage_rc(int b, int& R, int& C) { const int st = b / 1024, sb = b % 1024, swz = sb ^ (((sb >> 9) & 1) << 5); R = (st >> 1) * 16 + swz / 64; C = (st & 1) * 32 + (swz % 64) / 2; }
__host__ __device__ __forceinline__ int perm32(int rho) { const int n = rho >> 4, i = rho & 15; return 8 * (i >> 2) + 4 * n + (i & 3); }

struct Unit { int pm, pn; };
struct Gemm { const bf16_t* A; const bf16_t* Bt; int M, N, K; };

struct StaticOrder {
    int nM, nN, nwg, G, c, rep;
    __host__ __device__ void init(int M, int N, int G_, int c_) { nM = M / BM; nN = N / BM; nwg = nM * nN; G = G_; c = c_; rep = 1; }
    __host__ __device__ bool next(int i, Unit& u) const {
        if (rep > 1) { const int cnt = (nwg - c + G - 1) / G; if (cnt <= 0 || i >= cnt * rep) return false; i = i % cnt; }
        const long L = (long)i * G + c; if (L >= nwg) return false;
        int wgid = (int)L; { const int q = nwg / NXCD, r = nwg % NXCD, xcd = wgid % NXCD, off = wgid / NXCD; wgid = (xcd < r ? xcd * (q + 1) : r * (q + 1) + (xcd - r) * q) + off; }
        const int nig = WGM * nN, gid = wgid / nig, fm = gid * WGM, gsz = (nM - fm) < WGM ? (nM - fm) : WGM;
        u.pm = fm + ((wgid % nig) % gsz); u.pn = (wgid % nig) / gsz; return true;
    }
    __device__ __forceinline__ void a_ready(const Unit&) const {}
    __device__ __forceinline__ void done(const Unit&) const {}
};

struct GroupedOrder : StaticOrder {
    int nNl;
    __host__ __device__ void init(int Mtot, int Nper, int G_, int c_) { StaticOrder::init(Mtot, Nper, G_, c_); nNl = Nper / BM; }
    __host__ __device__ bool next(int i, Unit& u) const { if (!StaticOrder::next(i, u)) return false; u.pn += (u.pm >> 3) * nNl; return true; }
};

#define EPI_LOOP_ROWS for (int ai = 0; ai < 2; ++ai) _Pragma("unroll") for (int m = 0; m < 4; ++m)

struct EpiGlaIn {
    static constexpr bool PERM = true, AFTER_DRAIN = false;
    bf16_t *Q0, *K0, *SR; float *GF, *GB; const float *bF, *bB;
    __device__ __forceinline__ void operator()(const f32x4 (&acc)[2][2][4][2], const Unit& u, int wr, int wc, int fr, int fq) const {
        const int row0 = u.pm * BM + wr * 64 + fr, pn = u.pn;
#pragma unroll
        EPI_LOOP_ROWS { const size_t row = (size_t)(row0 + ai * HALF + m * 16);
#pragma unroll
            for (int bj = 0; bj < 2; ++bj) { const int cl = bj * HALF + wc * 32 + 8 * fq; f32x4 v0 = acc[ai][bj][m][0], v1 = acc[ai][bj][m][1];
                if (pn < 2) { const float s = 0.08838834764831845f; store8bf(Q0 + row * 512 + pn * 256 + cl, v0 * s, v1 * s); }
                else if (pn < 4) { store8bf(K0 + row * 512 + (pn - 2) * 256 + cl, v0, v1); }
                else if (pn < 8) {
#pragma unroll
                    for (int j = 0; j < 4; ++j) { v0[j] = siluf(v0[j]); v1[j] = siluf(v1[j]); }
                    store8bf(SR + row * 1024 + (pn - 4) * 256 + cl, v0, v1); }
                else { float* G = pn < 10 ? GF : GB; const float* b = pn < 10 ? bF : bB; const int c = ((pn - 8) & 1) * 256 + cl;
                    const f32x4 b0 = *(const f32x4*)(b + c), b1 = *(const f32x4*)(b + c + 4); f32x4 o0, o1;
#pragma unroll
                    for (int j = 0; j < 4; ++j) { o0[j] = logsigf(v0[j] + b0[j]) * 0.0625f; o1[j] = logsigf(v1[j] + b1[j]) * 0.0625f; }
                    *(f32x4*)(G + row * 512 + c) = o0; *(f32x4*)(G + row * 512 + c + 4) = o1; } } }
    }
};
struct EpiBf {
    static constexpr bool PERM = true, AFTER_DRAIN = false;
    bf16_t* O; int ldc;
    __device__ __forceinline__ void operator()(const f32x4 (&acc)[2][2][4][2], const Unit& u, int wr, int wc, int fr, int fq) const {
        const int row0 = u.pm * BM + wr * 64 + fr;
#pragma unroll
        EPI_LOOP_ROWS { bf16_t* rowp = O + (size_t)(row0 + ai * HALF + m * 16) * ldc + u.pn * BM + wc * 32 + 8 * fq;
#pragma unroll
            for (int bj = 0; bj < 2; ++bj) store8bf(rowp + bj * HALF, acc[ai][bj][m][0], acc[ai][bj][m][1]); }
    }
};
struct EpiF32 {
    static constexpr bool PERM = false, AFTER_DRAIN = false;
    float* C; const float* base; int ldc; float sc;
    __device__ __forceinline__ void operator()(const f32x4 (&acc)[2][2][4][2], const Unit& u, int wr, int wc, int fr, int fq) const {
        const int row0 = u.pm * BM + wr * 64 + fr, col0 = u.pn * BM + wc * 32 + 4 * fq;
#pragma unroll
        EPI_LOOP_ROWS { const size_t off = (size_t)(row0 + ai * HALF + m * 16) * ldc + col0;
#pragma unroll
            for (int bj = 0; bj < 2; ++bj)
#pragma unroll
                for (int n = 0; n < 2; ++n) { f32x4 v = acc[ai][bj][m][n] * sc; if (base) v = v + *(const f32x4*)(base + off + bj * HALF + n * 16); *(f32x4*)(C + off + bj * HALF + n * 16) = v; } }
    }
};
struct EpiQup {
    static constexpr bool PERM = true, AFTER_DRAIN = false;
    bf16_t* Q; const float* CS;
    __device__ __forceinline__ void operator()(const f32x4 (&acc)[2][2][4][2], const Unit& u, int wr, int wc, int fr, int fq) const {
        const int row0 = u.pm * BM + wr * 64 + fr, h = u.pn; const float QS = 0.07216878364870322f * 1.4426950408889634f;
#pragma unroll
        EPI_LOOP_ROWS { const size_t row = (size_t)(row0 + ai * HALF + m * 16); bf16_t* qrow = Q + ((size_t)h * T + row) * MDK;
            store8bf(qrow + wc * 32 + 8 * fq, acc[ai][0][m][0] * QS, acc[ai][0][m][1] * QS);
            if (wc < 2) { const int i0 = wc * 16 + 4 * fq; const f32x4 c = *(const f32x4*)(CS + row * 64 + i0), s = *(const f32x4*)(CS + row * 64 + 32 + i0);
                const f32x4 x1 = acc[ai][1][m][0], x2 = acc[ai][1][m][1];
                store8bf(qrow + 128 + wc * 32 + 8 * fq, (x1 * c - x2 * s) * QS, (x1 * s + x2 * c) * QS); } }
    }
};
struct EpiKVup {
    static constexpr bool PERM = true, AFTER_DRAIN = false;
    bf16_t *K, *V;
    __device__ __forceinline__ void operator()(const f32x4 (&acc)[2][2][4][2], const Unit& u, int wr, int wc, int fr, int fq) const {
        const int row0 = u.pm * BM + wr * 64 + fr, h = u.pn;
#pragma unroll
        EPI_LOOP_ROWS { const size_t row = (size_t)h * T + (size_t)(row0 + ai * HALF + m * 16);
            store8bf(K + row * MDK + wc * 32 + 8 * fq, acc[ai][0][m][0], acc[ai][0][m][1]);
            store8bf(V + row * MDV + wc * 32 + 8 * fq, acc[ai][1][m][0], acc[ai][1][m][1]); }
    }
};
struct EpiMoe1 {
    static constexpr bool PERM = true, AFTER_DRAIN = false;
    bf16_t* H;
    __device__ __forceinline__ void operator()(const f32x4 (&acc)[2][2][4][2], const Unit& u, int wr, int wc, int fr, int fq) const {
        const int row0 = u.pm * BM + wr * 64 + fr, j = u.pn & 15;
#pragma unroll
        EPI_LOOP_ROWS { const size_t eo = (size_t)(row0 + ai * HALF + m * 16) * FF + 128 * j + 16 * wc + 4 * fq; bf16_t* rowp = H + eo;
#pragma unroll
            for (int bj = 0; bj < 2; ++bj) { f32x4 g = acc[ai][bj][m][0], uu = acc[ai][bj][m][1];
                if (MOE_FP8) { g = g * 0.03125f; uu = uu * 0.03125f; *(unsigned*)((unsigned char*)H + eo + 64 * bj) = pk4fp8(siluf(g[0]) * uu[0], siluf(g[1]) * uu[1], siluf(g[2]) * uu[2], siluf(g[3]) * uu[3]); continue; }
                u32x2 w; w.x = cvt_pk_bf16(siluf(g[0]) * uu[0], siluf(g[1]) * uu[1]); w.y = cvt_pk_bf16(siluf(g[2]) * uu[2], siluf(g[3]) * uu[3]);
                *(u32x2*)(rowp + 64 * bj) = w; } }
    }
};
struct EpiMoe2 {
    static constexpr bool PERM = true, AFTER_DRAIN = false;
    bf16_t* Y;
    __device__ __forceinline__ void operator()(const f32x4 (&acc)[2][2][4][2], const Unit& u, int wr, int wc, int fr, int fq) const {
        const int row0 = u.pm * BM + wr * 64 + fr, j = u.pn & 3;
#pragma unroll
        EPI_LOOP_ROWS { bf16_t* rowp = Y + (size_t)(row0 + ai * HALF + m * 16) * D + 256 * j + wc * 32 + 8 * fq;
#pragma unroll
            for (int bj = 0; bj < 2; ++bj) { const float sc = MOE_FP8 ? 0.03125f : 1.0f; store8bf(rowp + bj * HALF, acc[ai][bj][m][0] * sc, acc[ai][bj][m][1] * sc); } }
    }
};

struct EpiQ8 {
    static constexpr bool PERM = true, AFTER_DRAIN = false;
    unsigned char* Q; const float* CS;
    __device__ __forceinline__ void operator()(const f32x4 (&acc)[2][2][4][2], const Unit& u, int wr, int wc, int fr, int fq) const {
        const int row0 = u.pm * BM + wr * 64 + fr, h = u.pn; const float QS = 8.0f * 0.07216878364870322f * 1.4426950408889634f;
#pragma unroll
        EPI_LOOP_ROWS { const size_t row = (size_t)(row0 + ai * HALF + m * 16); unsigned char* qrow = Q + ((size_t)h * T + row) * MDK;
            if (MLA_ABSORB) {
#pragma unroll
                for (int bj = 0; bj < 2; ++bj) { const int n = u.pn * 256 + bj * 128 + wc * 32 + 8 * fq, hh = n / 192, j0 = n - 192 * hh; unsigned char* qr_ = Q + ((size_t)hh * T + row) * MDK + j0;
                    if (j0 < 128) store8fp8(qr_, acc[ai][bj][m][0] * QS, acc[ai][bj][m][1] * QS);
                    else { const int i0 = (j0 - 128) >> 1; const f32x4 c = *(const f32x4*)(CS + row * 64 + i0), s = *(const f32x4*)(CS + row * 64 + 32 + i0); const f32x4 x1 = acc[ai][bj][m][0], x2 = acc[ai][bj][m][1];
                        store8fp8(qr_, (x1 * c - x2 * s) * QS, (x1 * s + x2 * c) * QS); } }
                continue; }
            store8fp8(qrow + wc * 32 + 8 * fq, acc[ai][0][m][0] * QS, acc[ai][0][m][1] * QS);
            if (wc < 2) { const int i0 = wc * 16 + 4 * fq; const f32x4 c = *(const f32x4*)(CS + row * 64 + i0), s = *(const f32x4*)(CS + row * 64 + 32 + i0);
                const f32x4 x1 = acc[ai][1][m][0], x2 = acc[ai][1][m][1];
                store8fp8(qrow + 128 + wc * 32 + 8 * fq, (x1 * c - x2 * s) * QS, (x1 * s + x2 * c) * QS); } }
    }
};
struct EpiK8 {
    static constexpr bool PERM = true, AFTER_DRAIN = false;
    unsigned char* K;
    __device__ __forceinline__ void operator()(const f32x4 (&acc)[2][2][4][2], const Unit& u, int wr, int wc, int fr, int fq) const {
        const int row0 = u.pm * BM + wr * 64 + fr;
#pragma unroll
        EPI_LOOP_ROWS { const size_t row = (size_t)(row0 + ai * HALF + m * 16);
#pragma unroll
            for (int bj = 0; bj < 2; ++bj) store8fp8(K + ((size_t)(2 * u.pn + bj) * T + row) * MDK + wc * 32 + 8 * fq, acc[ai][bj][m][0], acc[ai][bj][m][1]); }
    }
};
struct EpiV8T {
    static constexpr bool PERM = true, AFTER_DRAIN = false;
    unsigned char* V;
    __device__ __forceinline__ void operator()(const f32x4 (&acc)[2][2][4][2], const Unit& u, int wr, int wc, int fr, int fq) const {
        const int row0 = u.pm * BM + wr * 64 + fr;
#pragma unroll
        EPI_LOOP_ROWS { unsigned char* rowp = V + (size_t)(row0 + ai * HALF + m * 16) * T + u.pn * BM + 64 * (wc >> 1) + 16 * (wc & 1) + 4 * fq;
#pragma unroll
            for (int bj = 0; bj < 2; ++bj) { const f32x4 a = acc[ai][bj][m][0], b = acc[ai][bj][m][1];
                *(unsigned*)(rowp + bj * HALF) = pk4fp8(a[0], a[1], a[2], a[3]); *(unsigned*)(rowp + bj * HALF + 32) = pk4fp8(b[0], b[1], b[2], b[3]); } }
    }
};

typedef int i32x4g __attribute__((ext_vector_type(4)));
template <class Epi, class Sched, bool ALIGN_EPI = false, bool SP2 = false, bool F8 = false>
__device__ __forceinline__ void gemm_phase(PG8_LAS unsigned char* lds, const Gemm g, const Sched& S, const Epi& E) {
    const int tid = threadIdx.x, wid = __builtin_amdgcn_readfirstlane(tid >> 6), lane = tid & 63, wr = wid >> 2, wc = wid & 3, fr = lane & 15, fq = lane >> 4;
    int K = g.K; asm volatile("" : "+s"(K));
    const int nt = K / BK;
    unsigned voffA[2], voffB[2];
#pragma unroll
    for (int i = 0; i < 2; ++i) { int R, C; stage_rc(tid * 16 + i * 8192, R, C); const int Rb = Epi::PERM ? ((R & ~31) + perm32(R & 31)) : R;
        voffA[i] = (unsigned)(R * K + C) * 2u; voffB[i] = (unsigned)(Rb * K + C) * 2u; }
    const size_t kstep = (size_t)(BK * 2);
    const size_t hstep = (size_t)HALF * K * 2;
    const size_t tstep = 2 * hstep;
    const unsigned ldsw = (unsigned)wid * 1024u;
    const int aoff = lds_byte(wr * 64 + fr, fq * 8), boff = lds_byte(wc * 32 + fr, fq * 8);
    PG8_LAS unsigned char* const ldsA = lds + aoff; PG8_LAS unsigned char* const ldsB = lds + 4 * HTB + boff;
#define PG8_SA(b, h) (((b) * 2 + (h)) * HTB)
#define PG8_SB(b, h) ((4 + (b) * 2 + (h)) * HTB)
#define PG8_STAGE(bufoff, gbase, voff) do { _Pragma("unroll") for (int _i = 0; _i < 2; ++_i) \
        __builtin_amdgcn_global_load_lds((const unsigned*)((const char*)(gbase) + (voff)[_i]), (PG8_LAS unsigned*)(lds + (bufoff) + ldsw + _i * 8192), 16, 0, 0); } while (0)
#define PG8_LD8(base, off) __builtin_shufflevector(*(const PG8_LAS i32x4g*)((base) + (off)), *(const PG8_LAS i32x4g*)((base) + (off) + 1024), 0, 1, 2, 3, 4, 5, 6, 7)
#define PG8_LDA(dst, b, h) do { _Pragma("unroll") for (int m = 0; m < 4; ++m) { if constexpr (F8) dst##8[m] = PG8_LD8(ldsA, PG8_SA(b, h) + m * 2048); else { _Pragma("unroll") for (int k = 0; k < 2; ++k) dst[m][k] = *(const PG8_LAS bf16x8*)(lds + PG8_SA(b, h) + aoff + m * 2048 + k * 1024); } } } while (0)
#define PG8_LDB(dst, b, h) do { _Pragma("unroll") for (int n = 0; n < 2; ++n) { if constexpr (F8) dst##8[n] = PG8_LD8(ldsB, PG8_SA(b, h) + n * 2048); else { _Pragma("unroll") for (int k = 0; k < 2; ++k) dst[n][k] = *(const PG8_LAS bf16x8*)(lds + PG8_SB(b, h) + boff + n * 2048 + k * 1024); } } } while (0)
#define PG8_CAT(x, y) __builtin_shufflevector((i32x4g)(x), (i32x4g)(y), 0, 1, 2, 3, 4, 5, 6, 7)
#define PG8_MMA(ai, bj, At, Bt) do { __builtin_amdgcn_s_setprio(1); _Pragma("unroll") for (int m = 0; m < 4; ++m) _Pragma("unroll") for (int n = 0; n < 2; ++n) { \
        if constexpr (F8) asm volatile("v_mfma_scale_f32_16x16x128_f8f6f4 %0, %1, %2, %0, %3, %3 op_sel_hi:[0,0,0]" : "+v"(acc[ai][bj][m][n]) : "v"(Bt##8[n]), "v"(At##8[m]), "v"(scl8));     \
        else { _Pragma("unroll") for (int k = 0; k < 2; ++k) acc[ai][bj][m][n] = __builtin_amdgcn_mfma_f32_16x16x32_bf16(Bt[n][k], At[m][k], acc[ai][bj][m][n], 0, 0, 0); } } \
        __builtin_amdgcn_s_setprio(0); } while (0)
#define PG8_WAIT_V(n) asm volatile("s_waitcnt vmcnt(" #n ")" ::: "memory")
#define PG8_WAIT_L(n) asm volatile("s_waitcnt lgkmcnt(" #n ")" ::: "memory")
#define PG8_BAR __builtin_amdgcn_s_barrier()
#define PG8_SCHED __builtin_amdgcn_sched_barrier(0)
    Unit cur, nxt; int ui = 0;
    if (!S.next(0, cur)) return;
    f32x4 acc[2][2][4][2];
#pragma unroll
    for (int a = 0; a < 2; ++a)
#pragma unroll
        for (int b = 0; b < 2; ++b)
#pragma unroll
            for (int m = 0; m < 4; ++m)
#pragma unroll
                for (int n = 0; n < 2; ++n) acc[a][b][m][n] = (f32x4){0.f, 0.f, 0.f, 0.f};
    unsigned scl8 = 0x7f7f7f7fu; asm volatile("" : "+v"(scl8));
    bf16x8 At[4][2], B0[2][2], B1[2][2]; i32x8 At8[4], B08[2], B18[2];
    const char* cA = (const char*)g.A + (size_t)cur.pm * tstep; const char* cB = (const char*)g.Bt + (size_t)cur.pn * tstep;
    S.a_ready(cur);
    if constexpr (SP2) {
        PG8_STAGE(PG8_SB(0, 0), cB, voffB); PG8_STAGE(PG8_SB(0, 1), cB + hstep, voffB); PG8_STAGE(PG8_SA(0, 0), cA, voffA); PG8_STAGE(PG8_SA(0, 1), cA + hstep, voffA);
        if (wr == 1) PG8_BAR;
        PG8_WAIT_V(2); PG8_BAR;
        PG8_STAGE(PG8_SB(1, 0), cB + kstep, voffB); PG8_STAGE(PG8_SA(1, 0), cA + kstep, voffA); PG8_STAGE(PG8_SB(1, 1), cB + hstep + kstep, voffB);
        PG8_WAIT_V(6); PG8_BAR;
    } else {
        PG8_STAGE(PG8_SB(0, 0), cB, voffB); PG8_STAGE(PG8_SA(0, 0), cA, voffA); PG8_STAGE(PG8_SB(0, 1), cB + hstep, voffB); PG8_STAGE(PG8_SA(0, 1), cA + hstep, voffA);
        if (wr == 1) PG8_BAR;
        PG8_WAIT_V(4); PG8_BAR;
        PG8_STAGE(PG8_SB(1, 0), cB + kstep, voffB); PG8_STAGE(PG8_SA(1, 0), cA + kstep, voffA); PG8_STAGE(PG8_SB(1, 1), cB + hstep + kstep, voffB);
        PG8_WAIT_V(6); PG8_BAR;
    }
    for (;;) {
        const bool has_next = S.next(ui + 1, nxt);
        const char* nA = has_next ? (const char*)g.A + (size_t)nxt.pm * tstep : cA; const char* nB = has_next ? (const char*)g.Bt + (size_t)nxt.pn * tstep : cB;
        for (int t = 0; t < nt; t += 2) {
            const bool last = (t == nt - 2);
            const char* a1 = cA + (size_t)(t + 1) * kstep;
            const char* a2 = last ? nA : cA + (size_t)(t + 2) * kstep; const char* b2 = last ? nB : cB + (size_t)(t + 2) * kstep;
            const char* a3 = a2 + kstep; const char* b3 = b2 + kstep;
            if (last && has_next) S.a_ready(nxt);
            if constexpr (SP2) {
            PG8_LDB(B0, 0, 0); PG8_LDB(B1, 0, 1); PG8_SCHED; PG8_LDA(At, 0, 0); PG8_STAGE(PG8_SA(1, 1), a1 + hstep, voffA);
            PG8_WAIT_V(8); PG8_WAIT_L(0); PG8_BAR; PG8_MMA(0, 0, At, B0); PG8_MMA(0, 1, At, B1); PG8_BAR; PG8_SCHED;
            PG8_LDA(At, 0, 1); PG8_STAGE(PG8_SB(0, 0), b2, voffB); PG8_STAGE(PG8_SB(0, 1), b2 + hstep, voffB); PG8_STAGE(PG8_SA(0, 0), a2, voffA);
            PG8_WAIT_V(8); PG8_WAIT_L(0); PG8_BAR; PG8_MMA(1, 0, At, B0); PG8_MMA(1, 1, At, B1); PG8_BAR; PG8_SCHED;
            PG8_LDB(B0, 1, 0); PG8_LDB(B1, 1, 1); PG8_SCHED; PG8_LDA(At, 1, 0); PG8_STAGE(PG8_SA(0, 1), a2 + hstep, voffA);
            PG8_WAIT_V(8); PG8_WAIT_L(0); PG8_BAR; PG8_MMA(0, 0, At, B0); PG8_MMA(0, 1, At, B1); PG8_BAR; PG8_SCHED;
            PG8_LDA(At, 1, 1); PG8_STAGE(PG8_SB(1, 0), b3, voffB); PG8_STAGE(PG8_SB(1, 1), b3 + hstep, voffB); PG8_STAGE(PG8_SA(1, 0), a3, voffA);
            PG8_WAIT_V(8); PG8_WAIT_L(0); PG8_BAR; PG8_MMA(1, 0, At, B0); PG8_MMA(1, 1, At, B1); PG8_BAR; PG8_SCHED;
            } else {
            PG8_LDB(B0, 0, 0); PG8_SCHED; PG8_LDA(At, 0, 0); PG8_STAGE(PG8_SA(1, 1), a1 + hstep, voffA);
            PG8_WAIT_L(8); PG8_BAR; PG8_WAIT_L(0); PG8_MMA(0, 0, At, B0); PG8_BAR; PG8_SCHED;
            PG8_LDB(B1, 0, 1); PG8_STAGE(PG8_SB(0, 0), b2, voffB);
            PG8_BAR; PG8_WAIT_L(0); PG8_MMA(0, 1, At, B1); PG8_BAR;
            PG8_LDA(At, 0, 1); PG8_STAGE(PG8_SA(0, 0), a2, voffA);
            PG8_BAR; PG8_WAIT_L(0); PG8_MMA(1, 0, At, B0); PG8_BAR; PG8_SCHED;
            PG8_STAGE(PG8_SB(0, 1), b2 + hstep, voffB);
            PG8_WAIT_V(6); PG8_BAR; PG8_MMA(1, 1, At, B1); PG8_BAR;
            PG8_LDB(B0, 1, 0); PG8_SCHED; PG8_LDA(At, 1, 0); PG8_STAGE(PG8_SA(0, 1), a2 + hstep, voffA);
            PG8_WAIT_L(8); PG8_BAR; PG8_WAIT_L(0); PG8_MMA(0, 0, At, B0); PG8_BAR; PG8_SCHED;
            PG8_LDB(B1, 1, 1); PG8_STAGE(PG8_SB(1, 0), b3, voffB);
            PG8_BAR; PG8_WAIT_L(0); PG8_MMA(0, 1, At, B1); PG8_BAR;
            PG8_LDA(At, 1, 1); PG8_STAGE(PG8_SA(1, 0), a3, voffA);
            PG8_BAR; PG8_WAIT_L(0); PG8_MMA(1, 0, At, B0); PG8_BAR; PG8_SCHED;
            PG8_STAGE(PG8_SB(1, 1), b3 + hstep, voffB);
            PG8_WAIT_V(6); PG8_BAR; PG8_MMA(1, 1, At, B1); PG8_BAR;
            }
        }
        if constexpr (F8) asm volatile("s_nop 15\n\ts_nop 15" ::: "memory");
        if constexpr (ALIGN_EPI) { if (wr == 0) PG8_BAR; }
        if constexpr (!Epi::AFTER_DRAIN) { E(acc, cur, wr, wc, fr, fq); S.done(cur); }
        if (!has_next) break;
#pragma unroll
        for (int a = 0; a < 2; ++a)
#pragma unroll
            for (int b = 0; b < 2; ++b)
#pragma unroll
                for (int m = 0; m < 4; ++m)
#pragma unroll
                    for (int n = 0; n < 2; ++n) acc[a][b][m][n] = (f32x4){0.f, 0.f, 0.f, 0.f};
        cur = nxt; cA = nA; cB = nB; ++ui;
        if constexpr (ALIGN_EPI) { if (wr == 1) PG8_BAR; }
    }
    PG8_WAIT_V(0);
    if constexpr (!ALIGN_EPI) { if (wr == 0) PG8_BAR; }
    PG8_BAR;
    if constexpr (Epi::AFTER_DRAIN) { E.fused(acc, cur, wr, wc, fr, fq, lds, wid, lane); S.done(cur); }
#undef PG8_SA
#undef PG8_SB
#undef PG8_STAGE
#undef PG8_LDA
#undef PG8_LD8
#undef PG8_LDB
#undef PG8_MMA
#undef PG8_CAT
#undef PG8_WAIT_V
#undef PG8_WAIT_L
#undef PG8_BAR
#undef PG8_SCHED
}
}
#define XB_TMO      128
#define XB_XCNT(j)  (256  + 64 * (j))
#define XB_XSUB(j)  (1280 + 64 * (j))
#define XB_XGEN(j)  (2304 + 64 * (j))
#define XB_TOP      3328
#define XB_TOPGEN   3392
#define XCD_BAR_WORDS 3456
#define XB_SPIN_CAP (1u << 18)

__device__ __forceinline__ unsigned xb_ld(unsigned* p)              { return __hip_atomic_load(p, __ATOMIC_RELAXED, __HIP_MEMORY_SCOPE_AGENT); }
__device__ __forceinline__ unsigned xb_add(unsigned* p, unsigned v) { return __hip_atomic_fetch_add(p, v, __ATOMIC_RELAXED, __HIP_MEMORY_SCOPE_AGENT); }
__device__ __forceinline__ unsigned xb_xcc_id() { return (unsigned)__builtin_amdgcn_s_getreg((3 << 11) | 20) & 0xFu; }
#define XB_SPIN(cond, bar) do { unsigned _sp = 0; while (cond) { __builtin_amdgcn_s_sleep(1); \
    if ((++_sp & 255u) == 0u) { if (xb_ld(&(bar)[XB_TMO])) break; if (_sp > XB_SPIN_CAP) { atomicAdd(&(bar)[XB_TMO], 1u); break; } } } } while (0)

struct XcdBarrier {
    unsigned* bar; unsigned x;
    volatile LAS unsigned* st;
};

__device__ __forceinline__ XcdBarrier xcd_barrier_post(unsigned* bar, volatile LAS unsigned* st) {
    XcdBarrier b; b.bar = bar; b.x = xb_xcc_id(); b.st = st;
    if (threadIdx.x == 0) (void)xb_add(&bar[XB_XCNT(b.x)], 1u);
    return b;
}
__device__ __forceinline__ void xcd_barrier_complete(unsigned* bar, unsigned x, unsigned& nloc, unsigned& nx) {
    const unsigned G = gridDim.x * gridDim.y * gridDim.z;
    unsigned sum, cnt, mine, sp = 0u;
    for (;;) {
        sum = 0u; cnt = 0u; mine = 0u;
#pragma unroll
        for (unsigned j = 0; j < 16; ++j) { const unsigned c = xb_ld(&bar[XB_XCNT(j)]); sum += c; cnt += (c > 0u) ? 1u : 0u; mine = (j == x) ? c : mine; }
        if (sum == G) break;
        __builtin_amdgcn_s_sleep(1);
        if ((++sp & 255u) == 0u) { if (xb_ld(&bar[XB_TMO])) break; if (sp > XB_SPIN_CAP) { atomicAdd(&bar[XB_TMO], 1u); break; } }
    }
    nloc = mine > 0u ? mine : 1u; nx = cnt > 0u ? cnt : 1u;
}

__device__ __forceinline__ void xcd_barrier(const XcdBarrier& b) {
    asm volatile("s_waitcnt vmcnt(0)" ::: "memory");
    __syncthreads();
    if (threadIdx.x == 0) {
        unsigned* bar = b.bar;
        __builtin_amdgcn_s_waitcnt(0);
        unsigned nloc = b.st[0], nx = b.st[1];
        if (nloc == 0u) { xcd_barrier_complete(bar, b.x, nloc, nx); b.st[0] = nloc; b.st[1] = nx; }
        const unsigned old = xb_add(&bar[XB_XSUB(b.x)], 1u);
        const unsigned gen = old / nloc;
        if (old + 1u == (gen + 1u) * nloc) {
            __builtin_amdgcn_fence(__ATOMIC_RELEASE, "agent");
            asm volatile("s_waitcnt vmcnt(0)" ::: "memory");
            const unsigned og = xb_add(&bar[XB_TOP], 1u);
            const unsigned tg = og / nx;
            if (og + 1u == (tg + 1u) * nx) xb_add(&bar[XB_TOPGEN], 1u);
            else XB_SPIN(xb_ld(&bar[XB_TOPGEN]) == tg, bar);
            __builtin_amdgcn_fence(__ATOMIC_ACQUIRE, "agent");
            xb_add(&bar[XB_XGEN(b.x)], 1u);
            asm volatile("s_waitcnt vmcnt(0)" ::: "memory");
        } else {
            XB_SPIN(xb_ld(&bar[XB_XGEN(b.x)]) == gen, bar);
            __builtin_amdgcn_fence(__ATOMIC_ACQUIRE, "agent");
            asm volatile("s_waitcnt vmcnt(0)" ::: "memory");
        }
    }
    __syncthreads();
}

#ifndef PG8_SP2
#define PG8_SP2 true
#endif
#ifndef PG8_ALIGN
#define PG8_ALIGN true
#endif

struct Args { const void* in[22]; float* out; unsigned char* ws; float invf[32]; int ph_lo, ph_hi, li, pad; };
struct Ctx { int tid, lane, wave, gw, ngw, bid, nb; unsigned char* lds; };

struct MapId { int off; __device__ __forceinline__ int operator()(int n) const { return off + n; } };
struct MapGU { int which; __device__ __forceinline__ int operator()(int f) const { return 8 * (f >> 2) + 4 * which + (f & 3); } };
struct MapUkv { __device__ __forceinline__ int operator()(int n) const { const int h = n >> 8, j = n & 255; return ATT_FP8 ? (j < 128 ? 128 * h + j : 2048 + 128 * h + (j - 128)) : n; } };
struct MapUq { __device__ __forceinline__ int operator()(int n) const { const int h = n / 192, j = n - h * 192;
    if (j < 128) return 256 * h + j; if (j < 160) { const int i = j - 128; return 256 * h + 128 + 8 * (i >> 2) + (i & 3); } const int i = j - 160; return 256 * h + 128 + 8 * (i >> 2) + 4 + (i & 3); } };
constexpr int TR_SCR = 16896;
__device__ __forceinline__ void tr_load(const float* W, int ldw, int k0, int n0, f32x4 (&v)[16], int lane) {
#pragma unroll
    for (int i = 0; i < 16; ++i) v[i] = __builtin_nontemporal_load((const f32x4*)(W + (size_t)(k0 + (lane >> 4) + 4 * i) * ldw + n0 + 4 * (lane & 15)));
}
template <class RM, bool F8 = false>
__device__ __forceinline__ void tr_flush(const f32x4 (&v)[16], bf16_t* WT, int ldt, int k0, int nloc0, const RM& rm, float* scr, int lane) {
    const int nb = 4 * (lane & 15), kq = lane >> 4;
#pragma unroll
    for (int i = 0; i < 16; ++i) { float* d = scr + nb * 65 + kq + 4 * i; d[0] = v[i][0]; d[65] = v[i][1]; d[130] = v[i][2]; d[195] = v[i][3]; }
    LDS_WAIT();
    const int c = lane & 7;
#pragma unroll
    for (int j = 0; j < 8; ++j) { const int n = (lane >> 3) + 8 * j; const float* q = scr + n * 65 + 8 * c;
        if constexpr (F8) { u32x2 o; o.x = pk4fp8(q[0] * 32.f, q[1] * 32.f, q[2] * 32.f, q[3] * 32.f); o.y = pk4fp8(q[4] * 32.f, q[5] * 32.f, q[6] * 32.f, q[7] * 32.f);
            *(u32x2*)((unsigned char*)WT + (size_t)rm(nloc0 + n) * ldt + k0 + 8 * c) = o; }
        else { u32x4 o; o.x = cvt_pk_bf16(q[0], q[1]); o.y = cvt_pk_bf16(q[2], q[3]); o.z = cvt_pk_bf16(q[4], q[5]); o.w = cvt_pk_bf16(q[6], q[7]);
        *(u32x4*)(WT + (size_t)rm(nloc0 + n) * ldt + k0 + 8 * c) = o; } }
    LDS_WAIT();
}
template <class RM, bool F8 = false>
__device__ __forceinline__ void tr_job(const Ctx& C, int& base, const float* W, int ldw, int K, int ncol0, int ncols, bf16_t* WT, int ldt, const RM& rm) {
    const int nblk = ncols / 64, items = (K / 64) * nblk; float* scr = (float*)(C.lds + C.wave * TR_SCR);
    int first = (C.gw - base % C.ngw + C.ngw) % C.ngw;
    for (int it = first; it < items; it += C.ngw) { const int kb = it / nblk, nb = it - kb * nblk; f32x4 v[16]; tr_load(W, ldw, 64 * kb, ncol0 + 64 * nb, v, C.lane); tr_flush<RM, F8>(v, WT, ldt, 64 * kb, 64 * nb, rm, scr, C.lane); }
    base += items;
}
struct MapUqRope { int h; __device__ __forceinline__ int operator()(int n) const { const int i = n & 31; return 192 * h + 128 + 8 * (i >> 2) + ((n >> 5) ? 4 : 0) + (i & 3); } };
#if MLA_ABSORB
__device__ __forceinline__ void ph_mla_absorb(const Ctx& C, const Args& a, unsigned char* ws) {
    const float* w_uq = (const float*)a.in[14]; const float* w_ukv = (const float*)a.in[16]; const float* w_out = (const float*)a.in[17];
    const int tid = C.tid;
    for (int it = C.bid; it < 256; it += C.nb) { const int h = it >> 4, nb = it & 15;
        float* LA = (float*)C.lds; float* LB = (float*)(C.lds + 65536);
#pragma unroll
        for (int i = 0; i < 8; ++i) { const int idx = tid + 512 * i, c = idx >> 5, d4 = idx & 31; *(f32x4*)(LA + c * 128 + 4 * d4) = *(const f32x4*)(w_ukv + (size_t)c * 4096 + 256 * h + 128 + 4 * d4); }
#pragma unroll
        for (int i = 0; i < 4; ++i) { const int idx = tid + 512 * i, d = idx >> 4, n4 = idx & 15; *(f32x4*)(LB + d * 64 + 4 * n4) = *(const f32x4*)(w_out + (size_t)(128 * h + d) * 1024 + 64 * nb + 4 * n4); }
        __syncthreads();
        const int n = tid & 63, cq = C.wave; float acc[16];
#pragma unroll
        for (int i = 0; i < 16; ++i) acc[i] = 0.f;
        for (int d = 0; d < 128; d += 4) { const float b0 = LB[d * 64 + n], b1 = LB[(d + 1) * 64 + n], b2 = LB[(d + 2) * 64 + n], b3 = LB[(d + 3) * 64 + n];
#pragma unroll
            for (int i = 0; i < 16; ++i) { const f32x4 av = *(const f32x4*)(LA + (cq * 16 + i) * 128 + d); acc[i] += (av[0] * b0 + av[1] * b1) + (av[2] * b2 + av[3] * b3); } }
        u32x4 o; o.x = pk4fp8(acc[0] * 32.f, acc[1] * 32.f, acc[2] * 32.f, acc[3] * 32.f); o.y = pk4fp8(acc[4] * 32.f, acc[5] * 32.f, acc[6] * 32.f, acc[7] * 32.f);
        o.z = pk4fp8(acc[8] * 32.f, acc[9] * 32.f, acc[10] * 32.f, acc[11] * 32.f); o.w = pk4fp8(acc[12] * 32.f, acc[13] * 32.f, acc[14] * 32.f, acc[15] * 32.f);
        *(u32x4*)(ws + WS_WMOUT + (size_t)(64 * nb + n) * 2048 + 128 * h + 16 * cq) = o;
        __syncthreads(); }
    for (int it = C.bid; it < 256; it += C.nb) { const int h = it >> 4, rb = it & 15;
        float* LA = (float*)C.lds; float* LB = (float*)(C.lds + 8192);
        { const int r = tid >> 5, j4 = tid & 31; *(f32x4*)(LA + r * 128 + 4 * j4) = *(const f32x4*)(w_uq + (size_t)(16 * rb + r) * 3072 + 192 * h + 4 * j4); }
#pragma unroll
        for (int i = 0; i < 8; ++i) { const int idx = tid + 512 * i, c = idx >> 5, j4 = idx & 31; const f32x4 v = *(const f32x4*)(w_ukv + (size_t)c * 4096 + 256 * h + 4 * j4);
            float* d = LB + c * 129 + 4 * j4; d[0] = v[0]; d[1] = v[1]; d[2] = v[2]; d[3] = v[3]; }
        __syncthreads();
        const int c = tid & 127, rq = C.wave >> 1; float acc[4];
#pragma unroll
        for (int i = 0; i < 4; ++i) acc[i] = 0.f;
        for (int j = 0; j < 128; j += 4) { const float* bp = LB + c * 129 + j; const float b0 = bp[0], b1 = bp[1], b2 = bp[2], b3 = bp[3];
#pragma unroll
            for (int i = 0; i < 4; ++i) { const f32x4 av = *(const f32x4*)(LA + (rq * 4 + i) * 128 + j); acc[i] += (av[0] * b0 + av[1] * b1) + (av[2] * b2 + av[3] * b3); } }
        bf16_t* dst = (bf16_t*)(ws + WS_WUQ) + (size_t)(192 * h + c) * 256 + 16 * rb + 4 * rq;
        u32x2 o; o.x = cvt_pk_bf16(acc[0], acc[1]); o.y = cvt_pk_bf16(acc[2], acc[3]);
        *(u32x2*)dst = o;
        __syncthreads(); }
}
#endif
__device__ __forceinline__ void ph_convert_small(const Ctx& C, const Args& a, unsigned char* ws) {
    const float* w_in = (const float*)a.in[5]; int base = 0;
    bf16_t* WGIN = (bf16_t*)(ws + WS_WGIN);
    tr_job(C, base, w_in, 3104, 1024, 0, 1024, WGIN, 1024, MapId{0});
    tr_job(C, base, w_in, 3104, 1024, 1024, 1024, (bf16_t*)(ws + WS_WV), 1024, MapId{0});
    tr_job(C, base, w_in, 3104, 1024, 2048, 1024, WGIN, 1024, MapId{1024});
    tr_job(C, base, (const float*)a.in[11], 1024, 1024, 0, 1024, (bf16_t*)(ws + WS_WGOUT), 1024, MapId{0});
    tr_job<MapId, MLA_FP8 != 0>(C, base, (const float*)a.in[12], 448, 1024, 0, 448, (bf16_t*)(ws + WS_WMIN), 1024, MapId{0});
#if MLA_ABSORB
    for (int h = 0; h < MH; ++h) tr_job(C, base, (const float*)a.in[14], 3072, 256, 192 * h + 128, 64, (bf16_t*)(ws + WS_WUQ), 256, MapUqRope{h});
#else
    tr_job(C, base, (const float*)a.in[14], 3072, 256, 0, 3072, (bf16_t*)(ws + WS_WUQ), 256, MapUq{});
    tr_job(C, base, (const float*)a.in[16], 4096, 128, 0, 4096, (bf16_t*)(ws + WS_WUKV), 256, MapUkv{});
    tr_job<MapId, MLA_FP8 != 0>(C, base, (const float*)a.in[17], 1024, 2048, 0, 1024, (bf16_t*)(ws + WS_WMOUT), 2048, MapId{0});
#endif
    const int gt = C.bid * 512 + C.tid, ngt = C.nb * 512;
    for (int it = gt; it < 1024 * 128; it += ngt) { const int cp = it >> 7, k8 = it & 127, dir = cp >> 9, c = cp & 511;
        const float* wg = (const float*)a.in[dir ? 8 : 6]; float wj[16];
#pragma unroll
        for (int j = 0; j < 16; ++j) wj[j] = wg[j * 512 + c];
        float o[8];
#pragma unroll
        for (int kk = 0; kk < 8; ++kk) { const float* wr = w_in + (size_t)(8 * k8 + kk) * 3104 + 3072 + 16 * dir; float s = 0.f;
#pragma unroll
            for (int j4 = 0; j4 < 4; ++j4) { const f32x4 x = *(const f32x4*)(wr + 4 * j4); s += x[0] * wj[4 * j4] + x[1] * wj[4 * j4 + 1] + x[2] * wj[4 * j4 + 2] + x[3] * wj[4 * j4 + 3]; }
            o[kk] = s; }
        u32x4 w; w.x = cvt_pk_bf16(o[0], o[1]); w.y = cvt_pk_bf16(o[2], o[3]); w.z = cvt_pk_bf16(o[4], o[5]); w.w = cvt_pk_bf16(o[6], o[7]);
        *(u32x4*)(WGIN + (size_t)(2048 + cp) * 1024 + 8 * k8) = w; }
    const u32x4 z = {0u, 0u, 0u, 0u};
    if (MLA_FP8) { for (int it = gt; it < 64 * 64; it += ngt) *(u32x4*)(ws + WS_WMIN + (size_t)448 * 1024 + (size_t)it * 16) = z; }
    else for (int it = gt; it < 64 * 128; it += ngt) *(u32x4*)((bf16_t*)(ws + WS_WMIN) + (size_t)448 * 1024 + (size_t)it * 8) = z;
    if (!MLA_ABSORB) for (int it = gt; it < 16 * 64 * 32; it += ngt) { const int h = it >> 11, r = (it >> 5) & 63, c8 = it & 31; *(u32x4*)((bf16_t*)(ws + WS_WUQ) + (size_t)(256 * h + 192 + r) * 256 + c8 * 8) = z; }
    if (!MLA_ABSORB) for (int it = gt; it < 4096 * 16; it += ngt) { const int r = it >> 4, c8 = it & 15; *(u32x4*)((bf16_t*)(ws + WS_WUKV) + (size_t)r * 256 + 128 + c8 * 8) = z; }
}
struct MapMoe { int kind; __device__ __forceinline__ int operator()(int f) const { return kind < 2 ? 8 * (f >> 2) + 4 * kind + (f & 3) : f; } };
struct MoeItem { const float* src; bf16_t* dst; int ldw, ldt, k0, n0, kind; };
__device__ __forceinline__ MoeItem moe_item(const Args& a, unsigned char* ws, int layer, int it) {
    const int e = it / 1536, r = it - e * 1536, which = r >> 9, j = r & 511; const size_t le = (size_t)(layer * NE + e); MoeItem m; m.kind = which;
    if (which < 2) { m.src = (const float*)a.in[19 + which] + le * 1024 * 2048; m.ldw = 2048; m.dst = (bf16_t*)(ws + WS_WGU + (size_t)((MOE_FP8 && CONV_OVERLAP) ? layer : 0) * (64 * MiB) + (size_t)e * 4096 * 1024 * (MOE_FP8 ? 1 : 2)); m.ldt = 1024; m.k0 = 64 * (j >> 5); m.n0 = 64 * (j & 31); }
    else { m.src = (const float*)a.in[21] + le * 2048 * 1024; m.ldw = 1024; m.dst = (bf16_t*)(ws + WS_WD + (size_t)((MOE_FP8 && CONV_OVERLAP) ? layer : 0) * (32 * MiB) + (size_t)e * 1024 * 2048 * (MOE_FP8 ? 1 : 2)); m.ldt = 2048; m.k0 = 64 * (j >> 4); m.n0 = 64 * (j & 15); }
    return m;
}
__device__ __forceinline__ void ph_convert_moe(const Ctx& C, const Args& a, unsigned char* ws, int layer, int rep, int it0, int it1, int wk, int nwk) {
    constexpr int NIT1 = NE * 1536; const int NIT = it0 + (it1 - it0) * rep; float* scr = (float*)(C.lds + C.wave * TR_SCR);
    int it = it0 + wk; if (it >= NIT) return;
#define MI_(x) moe_item(a, ws, layer, rep > 1 ? (x) % NIT1 : (x))
    f32x4 va[16], vb[16]; MoeItem ma = MI_(it), mb = ma; tr_load(ma.src, ma.ldw, ma.k0, ma.n0, va, C.lane);
    for (;;) {
        int nx = it + nwk; if (nx < NIT) { mb = MI_(nx); tr_load(mb.src, mb.ldw, mb.k0, mb.n0, vb, C.lane); }
        tr_flush<MapMoe, MOE_FP8 != 0>(va, ma.dst, ma.ldt, ma.k0, ma.n0, MapMoe{ma.kind}, scr, C.lane);
        it = nx; if (it >= NIT) break;
        nx = it + nwk; if (nx < NIT) { ma = MI_(nx); tr_load(ma.src, ma.ldw, ma.k0, ma.n0, va, C.lane); }
        tr_flush<MapMoe, MOE_FP8 != 0>(vb, mb.dst, mb.ldt, mb.k0, mb.n0, MapMoe{mb.kind}, scr, C.lane);
        it = nx; if (it >= NIT) break;
    }
#undef MI_
}
constexpr int CV_NIT = NE * 1536, CV_X1 = (MOE_FP8 && CONV_OVERLAP) ? 5760 : 0, CV_X2 = (MOE_FP8 && CONV_OVERLAP) ? 5760 + 1024 : 0;

__device__ __forceinline__ void row_load(const float* row, int lane, f32x4 (&v)[4]) {
#pragma unroll
    for (int j = 0; j < 4; ++j) v[j] = *(const f32x4*)(row + 256 * j + 4 * lane); }
__device__ __forceinline__ float row_rstd(const f32x4 (&v)[4]) { float s = 0.f;
#pragma unroll
    for (int j = 0; j < 4; ++j) s += (v[j][0] * v[j][0] + v[j][1] * v[j][1]) + (v[j][2] * v[j][2] + v[j][3] * v[j][3]);
    return 1.0f / sqrtf(wave_sum(s) * (1.0f / 1024.0f) + RMS_EPS); }
__device__ __forceinline__ void row_store_bf(bf16_t* row, int lane, const f32x4 (&v)[4]) {
#pragma unroll
    for (int j = 0; j < 4; ++j) { u32x2 w; w.x = cvt_pk_bf16(v[j][0], v[j][1]); w.y = cvt_pk_bf16(v[j][2], v[j][3]); *(u32x2*)(row + 256 * j + 4 * lane) = w; } }

__device__ __forceinline__ void ph_norm(const Ctx& C, const float* src, const float* gain, bf16_t* XN) {
    f32x4 g[4]; row_load(gain, C.lane, g);
    for (int t = C.gw; t < T; t += C.ngw) { f32x4 v[4]; row_load(src + (size_t)t * D, C.lane, v); const float r = row_rstd(v);
#pragma unroll
        for (int j = 0; j < 4; ++j) v[j] = v[j] * r * g[j];
        row_store_bf(XN + (size_t)t * D, C.lane, v); }
}
__device__ __forceinline__ void ph_router(const Ctx& C, const float* Hin, const float* gain, const float* Wr, bf16_t* XN, float* AFF, float* AFFT, unsigned char* XN8) {
    f32x4* Wl = (f32x4*)C.lds;
    for (int idx = C.tid; idx < 4096; idx += 512) { const int l = idx & 63, e4 = (idx >> 6) & 3, i = (idx >> 8) & 3, j = idx >> 10; Wl[idx] = *(const f32x4*)(Wr + (size_t)(256 * j + 4 * l + i) * 16 + 4 * e4); }
    __syncthreads();
    f32x4 g[4]; row_load(gain, C.lane, g);
    f32x4 nv[4]; if (C.gw < T) row_load(Hin + (size_t)C.gw * D, C.lane, nv);
    for (int t = C.gw; t < T; t += C.ngw) {
        f32x4 v[4];
#pragma unroll
        for (int j = 0; j < 4; ++j) v[j] = nv[j];
        if (t + C.ngw < T) row_load(Hin + (size_t)(t + C.ngw) * D, C.lane, nv);
        const float r = row_rstd(v);
#pragma unroll
        for (int j = 0; j < 4; ++j) v[j] = v[j] * r * g[j];
#if MOE_FP8
#pragma unroll
        for (int j = 0; j < 4; ++j) *(unsigned*)(XN8 + (size_t)t * D + 256 * j + 4 * C.lane) = pk4fp8(v[j][0], v[j][1], v[j][2], v[j][3]);
#ifdef DBG
        row_store_bf(XN + (size_t)t * D, C.lane, v);
#endif
#else
        row_store_bf(XN + (size_t)t * D, C.lane, v);
#endif
        float p[16];
#pragma unroll
        for (int e = 0; e < 16; ++e) p[e] = 0.f;
#pragma unroll
        for (int j = 0; j < 4; ++j)
#pragma unroll
            for (int i = 0; i < 4; ++i) { const float x = v[j][i];
#pragma unroll
                for (int e4 = 0; e4 < 4; ++e4) { const f32x4 w = Wl[((j * 4 + i) * 4 + e4) * 64 + C.lane]; p[4 * e4] += x * w[0]; p[4 * e4 + 1] += x * w[1]; p[4 * e4 + 2] += x * w[2]; p[4 * e4 + 3] += x * w[3]; }  asm volatile("" ::: "memory"); }
        float mx = -1e30f;
#pragma unroll
        for (int e = 0; e < 16; ++e) { p[e] = wave_sum(p[e]); mx = fmaxf(mx, p[e]); }
        float s = 0.f;
#pragma unroll
        for (int e = 0; e < 16; ++e) { p[e] = expf(p[e] - mx); s += p[e]; }
        const float inv = 1.0f / s; float mine = 0.f;
#pragma unroll
        for (int e = 0; e < 16; ++e) mine = (C.lane == e) ? p[e] * inv : mine;
        if (C.lane < 16) { AFF[(size_t)t * 16 + C.lane] = mine; AFFT[(size_t)C.lane * T + t] = mine; }
    }
    __syncthreads();
}
__device__ __forceinline__ void ph_select(const Ctx& C, const float* AFFT, int* SEL, int* IDX) {
    if (C.bid >= NE) return;
    const int e = C.bid; unsigned* vals = (unsigned*)C.lds; unsigned* hist = vals + T; unsigned* sh = hist + 256;
    for (int i = C.tid; i < T; i += 512) vals[i] = __float_as_uint(AFFT[(size_t)e * T + i]);
    __syncthreads();
    unsigned prefix = 0u, mask = 0u, remaining = CAP;
    for (int pass = 0; pass < 4; ++pass) { const int shift = 24 - 8 * pass;
        if (C.tid < 256) hist[C.tid] = 0u;
        __syncthreads();
        if (pass == 0) {
            for (int i = C.tid; i < T; i += 512) { const unsigned bin = (vals[i] >> 24) & 255u; unsigned long long m_ = __ballot(1);
                while (m_) { const int ld_ = __builtin_amdgcn_readfirstlane(__ffsll((long long)m_) - 1); const unsigned b0_ = __builtin_amdgcn_readlane(bin, ld_);
                    const unsigned long long same_ = __ballot(bin == b0_) & m_; if (C.lane == ld_) atomicAdd(&hist[b0_], (unsigned)__popcll(same_)); m_ &= ~same_; } } }
        else for (int i = C.tid; i < T; i += 512) { const unsigned v = vals[i]; if ((v & mask) == prefix) atomicAdd(&hist[(v >> shift) & 255u], 1u); }
        __syncthreads();
        if (C.wave == 0) {
            unsigned cb[4]; unsigned tl = 0u;
#pragma unroll
            for (int j = 0; j < 4; ++j) { cb[j] = hist[255 - (4 * C.lane + j)]; tl += cb[j]; }
            unsigned incl = tl;
#pragma unroll
            for (int o = 1; o < 64; o <<= 1) { const unsigned tt = __shfl_up(incl, o); if (C.lane >= o) incl += tt; }
            unsigned cum = incl - tl;
            if (cum < remaining && remaining <= incl) {
#pragma unroll
                for (int j = 0; j < 4; ++j) { if (cum < remaining && cum + cb[j] >= remaining) { sh[0] = (unsigned)(255 - (4 * C.lane + j)); sh[1] = remaining - cum; } cum += cb[j]; } } }
        __syncthreads();
        prefix |= sh[0] << shift; mask |= 255u << shift; remaining = sh[1];
        __syncthreads();
    }
    const unsigned thr = prefix, ntie = remaining;
    unsigned cg = 0u, ce = 0u;
    for (int i = 0; i < 32; ++i) { const unsigned v = vals[C.tid + 512 * i]; cg += v > thr; ce += v == thr; }
    unsigned sg = cg, se = ce;
#pragma unroll
    for (int o = 1; o < 64; o <<= 1) { const unsigned tg = __shfl_up(sg, o), te = __shfl_up(se, o); if (C.lane >= o) { sg += tg; se += te; } }
    if (C.lane == 63) { sh[16 + C.wave] = sg; sh[32 + C.wave] = se; }
    __syncthreads();
    unsigned og = 0u, oe = 0u, totg = 0u;
    for (int w = 0; w < 8; ++w) { const unsigned a = sh[16 + w], b = sh[32 + w]; if (w < C.wave) { og += a; oe += b; } totg += a; }
    unsigned pg = og + sg - cg, pe = oe + se - ce;
    for (int i = 0; i < 32; ++i) { const int t = C.tid + 512 * i; const unsigned v = vals[t]; int slot = -1;
        if (v > thr) slot = (int)pg++; else if (v == thr) { if (pe < ntie) slot = (int)(totg + pe); ++pe; }
        SEL[(size_t)t * 16 + e] = slot + 1; if (slot >= 0) IDX[e * CAP + slot] = t; }
}
__device__ __forceinline__ void ph_gather(const Ctx& C, const int* IDX, const bf16_t* XN, bf16_t* XS, const unsigned char* XN8) {
    for (int r = C.gw; r < NE * CAP; r += C.ngw) { const int t = IDX[r];
        if (MOE_FP8) { ((u32x4*)((unsigned char*)XS + (size_t)r * D))[C.lane] = ((const u32x4*)(XN8 + (size_t)t * D))[C.lane]; }
        else { const u32x4* s = (const u32x4*)(XN + (size_t)t * D); u32x4* d = (u32x4*)(XS + (size_t)r * D); const u32x4 a = s[C.lane], b = s[C.lane + 64]; d[C.lane] = a; d[C.lane + 64] = b; } }
}
template <int MODE>
__device__ __forceinline__ void ph_combine(const Ctx& C, const float* Hin, const float* AFF, const int* SEL, const bf16_t* Y, float* Hout, const float* gain, bf16_t* XN, float* OUT) {
    f32x4 g[4]; row_load(gain, C.lane, g);
    f32x4 nv[4]; int nsel = 0; float naf = 0.f;
    if (C.gw < T) { row_load(Hin + (size_t)C.gw * D, C.lane, nv); nsel = SEL[(size_t)C.gw * 16 + (C.lane & 15)]; naf = AFF[(size_t)C.gw * 16 + (C.lane & 15)]; }
    for (int t = C.gw; t < T; t += C.ngw) {
        f32x4 v[4];
#pragma unroll
        for (int j = 0; j < 4; ++j) v[j] = nv[j];
        const int sel = nsel; const float af = naf;
        if (t + C.ngw < T) { const size_t tn = (size_t)(t + C.ngw); row_load(Hin + tn * D, C.lane, nv); nsel = SEL[tn * 16 + (C.lane & 15)]; naf = AFF[tn * 16 + (C.lane & 15)]; }
#pragma unroll
        for (int e = 0; e < 16; ++e) { const int s = __builtin_amdgcn_readlane(sel, e);
            if (s) { const float a = __uint_as_float(__builtin_amdgcn_readlane(__float_as_uint(af), e)); const bf16_t* y = Y + ((size_t)e * CAP + (s - 1)) * D + 4 * C.lane;
#pragma unroll
                for (int j = 0; j < 4; ++j) { const u32x2 w = *(const u32x2*)(y + 256 * j); v[j][0] += a * bf_lo(w.x); v[j][1] += a * bf_hi(w.x); v[j][2] += a * bf_lo(w.y); v[j][3] += a * bf_hi(w.y); } } }
        if (MODE == 1) {
#pragma unroll
            for (int j = 0; j < 4; ++j) *(f32x4*)(Hout + (size_t)t * D + 256 * j + 4 * C.lane) = v[j]; }
        const float r = row_rstd(v);
#pragma unroll
        for (int j = 0; j < 4; ++j) v[j] = v[j] * r * g[j];
        if (MODE == 1) { if (MLA_FP8) {
#pragma unroll
                for (int j = 0; j < 4; ++j) *(unsigned*)((unsigned char*)XN + (size_t)t * D + 256 * j + 4 * C.lane) = pk4fp8(v[j][0], v[j][1], v[j][2], v[j][3]); }
            else row_store_bf(XN + (size_t)t * D, C.lane, v); }
        else {
#pragma unroll
            for (int j = 0; j < 4; ++j) *(f32x4*)(OUT + (size_t)t * D + 256 * j + 4 * C.lane) = v[j]; }
    }
}

#define MFMA32(a, b, c) __builtin_amdgcn_mfma_f32_32x32x16_bf16((a), (b), (c), 0, 0, 0)
__device__ __forceinline__ int crow(int r, int hi) { return (r & 3) + 8 * (r >> 2) + 4 * hi; }
__device__ __forceinline__ bf16x8 ldfrag(const bf16_t* p) { return *(const bf16x8*)p; }

struct PrepRegs { float gf[8], gb[8]; unsigned short q[8], k[8]; };
__device__ __forceinline__ void prep_load(PrepRegs& R, const bf16_t* Q0, const bf16_t* K0, const float* GF, const float* GB, size_t off0) {
#pragma unroll
    for (int i = 0; i < 8; ++i) { const size_t of = off0 + (size_t)i * 512; R.gf[i] = GF[of]; R.gb[i] = GB[of]; R.q[i] = Q0[of]; R.k[i] = K0[of]; }
}
__device__ __forceinline__ void ph_gla_prep(const Ctx& C, const bf16_t* Q0, const bf16_t* K0, const float* GF, const float* GB,
                                            bf16_t* QDF, bf16_t* QDB, bf16_t* KDF, bf16_t* KDB, bf16_t* KTF, bf16_t* KTB, float* EGL) {
    float* tot = (float*)C.lds;
    const int o = C.wave, l = C.lane;
    for (int c = C.bid; c < GNC; c += C.nb) { const int t0 = c * GC + 8 * o; const size_t base0 = (size_t)t0 * 512 + l;
        PrepRegs RA, RB; prep_load(RA, Q0, K0, GF, GB, base0);
#define PREP_STEP(R, cb, par) do { const int ch = (cb) * 64 + l; const size_t off0 = base0 + (cb) * 64;                                                                       \
            float sf = 0.f, sb = 0.f;                                                                                                                                        \
            _Pragma("unroll") for (int i = 0; i < 8; ++i) { sf += R.gf[i]; R.gf[i] = sf; }                                                                                     \
            _Pragma("unroll") for (int i = 7; i >= 0; --i) { sb += R.gb[i]; R.gb[i] = sb; }                                                                                    \
            float* tp = tot + (par) * 1024; tp[o * 64 + l] = sf; tp[512 + o * 64 + l] = sb;                                                                                    \
            __syncthreads();                                                                                                                                                 \
            float offf = 0.f, offb = 0.f, allf = 0.f, allb = 0.f;                                                                                                            \
            _Pragma("unroll") for (int oo = 0; oo < 8; ++oo) { const float a_ = tp[oo * 64 + l], b_ = tp[512 + oo * 64 + l]; offf += (oo < o) ? a_ : 0.f; offb += (oo > o) ? b_ : 0.f; allf += a_; allb += b_; } \
            unsigned pf[4], pb[4];                                                                                                                                           \
            _Pragma("unroll") for (int i = 0; i < 8; i += 2) { float kdf[2], kdb[2];                                                                                          \
                _Pragma("unroll") for (int u = 0; u < 2; ++u) { const size_t of = off0 + (size_t)(i + u) * 512; const float ef = __expf(offf + R.gf[i + u]), eb = __expf(offb + R.gb[i + u]); \
                    const float qv = bf2f(R.q[i + u]), kv = bf2f(R.k[i + u]);                                                                                                 \
                    kdf[u] = kv * __builtin_amdgcn_rcpf(ef); kdb[u] = kv * __builtin_amdgcn_rcpf(eb);                                                                         \
                    QDF[of] = f2bf(qv * ef); QDB[of] = f2bf(qv * eb); KDF[of] = f2bf(kdf[u]); KDB[of] = f2bf(kdb[u]); }                                                      \
                pf[i >> 1] = cvt_pk_bf16(kdf[0], kdf[1]); pb[i >> 1] = cvt_pk_bf16(kdb[0], kdb[1]); }                                                                          \
            *(u32x4*)(KTF + (size_t)ch * T + t0) = (u32x4){pf[0], pf[1], pf[2], pf[3]};                                                                                       \
            *(u32x4*)(KTB + (size_t)ch * T + t0) = (u32x4){pb[0], pb[1], pb[2], pb[3]};                                                                                       \
            if (o == 0) { EGL[(size_t)c * 512 + ch] = __expf(allf); EGL[(size_t)(GNC + c) * 512 + ch] = __expf(allb); } } while (0)
#pragma unroll
        for (int cb = 0; cb < 8; cb += 2) {
            prep_load(RB, Q0, K0, GF, GB, base0 + (cb + 1) * 64); PREP_STEP(RA, cb, 0);
            if (cb + 2 < 8) prep_load(RA, Q0, K0, GF, GB, base0 + (cb + 2) * 64); PREP_STEP(RB, cb + 1, 1);
        }
#undef PREP_STEP
    }
    __syncthreads();
}
__device__ __forceinline__ void ph_gla_u(const Ctx& C, const bf16_t* VT, const bf16_t* KTF, const bf16_t* KTB, const float* EGL, bf16_t* U) {
    const int r = C.lane & 31, hh = C.lane >> 5;
    for (int it = C.gw; it < 2 * GH * GNC * 8; it += C.ngw) { const int w = it & 7, unit = it >> 3, c = unit % GNC, h = (unit / GNC) % GH, dir = unit / (GNC * GH); const int t0 = c * GC;
        const bf16_t* KT = dir ? KTB : KTF; const bf16_t* bp = VT + (size_t)(256 * h + 32 * w + r) * T + t0 + 8 * hh;
        bf16x8 b[4];
#pragma unroll
        for (int s = 0; s < 4; ++s) b[s] = ldfrag(bp + 16 * s);
        bf16_t* Ub = U + ((size_t)(dir * GH + h) * GNC + c) * (GDV * GDK); const float* eg = EGL + (size_t)(dir * GNC + c) * 512 + 128 * h;
#pragma unroll
        for (int j = 0; j < 4; ++j) { f32x16 acc = {}; const bf16_t* ap = KT + (size_t)(128 * h + 32 * j + r) * T + t0 + 8 * hh;
#pragma unroll
            for (int s = 0; s < 4; ++s) acc = MFMA32(ldfrag(ap + 16 * s), b[s], acc);
#pragma unroll
            for (int g = 0; g < 4; ++g) { const f32x4 e4 = *(const f32x4*)(eg + 32 * j + 8 * g + 4 * hh);
                u32x2 o; o.x = cvt_pk_bf16(acc[4 * g] * e4[0], acc[4 * g + 1] * e4[1]); o.y = cvt_pk_bf16(acc[4 * g + 2] * e4[2], acc[4 * g + 3] * e4[3]);
                *(u32x2*)(Ub + ((w * 8 + 2 * j + (g >> 1)) * 64 + (g & 1) * 32 + r) * 8 + 4 * hh) = o; } }
    }
}
__device__ __forceinline__ void ph_gla_scan(const Ctx& C, const bf16_t* U, const float* EGL, bf16_t* ST) {
    if (C.tid >= 256) return;
    for (int el = C.bid * 256 + C.tid; el < 2 * GH * GDV * (GDK / 4); el += C.nb * 256) { const int p = 4 * (el & 8191), h = (el >> 13) & 3, dir = el >> 15;
        const int dk = 16 * ((p >> 9) & 7) + 8 * ((p >> 8) & 1) + (p & 7);
        const size_t eb = (size_t)(dir * GH + h) * GNC * (GDV * GDK) + p; const float* eg = EGL + (size_t)dir * GNC * 512 + 128 * h + dk;
        float s0 = 0.f, s1 = 0.f, s2 = 0.f, s3 = 0.f;
#pragma unroll 32
        for (int i = 0; i < GNC; ++i) { const int c = dir ? GNC - 1 - i : i; const size_t o = eb + (size_t)c * (GDV * GDK);
            const u32x2 u = *(const u32x2*)(U + o); const f32x4 d = *(const f32x4*)(eg + (size_t)c * 512);
            u32x2 w; w.x = cvt_pk_bf16(s0, s1); w.y = cvt_pk_bf16(s2, s3); *(u32x2*)(ST + o) = w;
            s0 = d[0] * s0 + bf_lo(u.x); s1 = d[1] * s1 + bf_hi(u.x); s2 = d[2] * s2 + bf_lo(u.y); s3 = d[3] * s3 + bf_hi(u.y); }
    }
}
__device__ __forceinline__ void ph_gla_out(const Ctx& C, const bf16_t* QDF, const bf16_t* QDB, const bf16_t* KDF, const bf16_t* KDB, const bf16_t* VT, const bf16_t* ST,
                                           const bf16_t* SR, const float* hnorm, bf16_t* OG) {
    constexpr int ACS = 72, TS = 272, TB = 64 * TS;
    unsigned char* TL = C.lds;
    bf16_t* AC = (bf16_t*)(C.lds + 4 * TB); float* SSQ = (float*)(C.lds + 4 * TB + 64 * ACS * 2);
    const int w = C.wave, r = C.lane & 31, hh = C.lane >> 5;
    const float gn = hnorm[32 * w + r];
    bf16x8 bs[2][8], bv[4]; u32x4 tv[8];
#define GO_LOAD(unit_) do { const int h_ = (unit_) / GNC, c_ = (unit_) % GNC, t0_ = c_ * GC;                                                               \
        _Pragma("unroll") for (int dir = 0; dir < 2; ++dir) { const bf16_t* sp = ST + ((size_t)(dir * GH + h_) * GNC + c_) * (GDV * GDK) + (size_t)w * 4096 + C.lane * 8; \
            _Pragma("unroll") for (int s_ = 0; s_ < 8; ++s_) bs[dir][s_] = ldfrag(sp + 512 * s_); }                 \
        { const bf16_t* vp = VT + (size_t)(256 * h_ + 32 * w + r) * T + t0_ + 8 * hh; _Pragma("unroll") for (int s_ = 0; s_ < 4; ++s_) bv[s_] = ldfrag(vp + 16 * s_); } \
        _Pragma("unroll") for (int q = 0; q < 8; ++q) { const int tile = q >> 1, ck = C.tid + 512 * (q & 1), row = ck >> 4, cc = ck & 15; const bf16_t* src = tile == 0 ? QDF : tile == 1 ? QDB : tile == 2 ? KDF : KDB; \
            tv[q] = *(const u32x4*)(src + (size_t)(t0_ + row) * 512 + 128 * h_ + 8 * cc); } } while (0)
    int unit = C.bid; if (unit < GH * GNC) GO_LOAD(unit);
    for (; unit < GH * GNC; unit += C.nb) { const int h = unit / GNC, c = unit % GNC, t0 = c * GC;
#pragma unroll
        for (int q = 0; q < 8; ++q) { const int tile = q >> 1, ck = C.tid + 512 * (q & 1), row = ck >> 4, cc = ck & 15; *(u32x4*)(TL + tile * TB + row * TS + 16 * cc) = tv[q]; }
        __syncthreads();
        {
            const int dir = w >> 2, ti = (w >> 1) & 1, si = w & 1;
            if (!((dir == 0 && ti == 0 && si == 1) || (dir == 1 && ti == 1 && si == 0))) {
                const unsigned char* qp = TL + dir * TB + (32 * ti + r) * TS + 16 * hh; const unsigned char* kp = TL + (2 + dir) * TB + (32 * si + r) * TS + 16 * hh;
                f32x16 acc = {};
#pragma unroll
                for (int s = 0; s < 8; ++s) acc = MFMA32(*(const bf16x8*)(qp + 32 * s), *(const bf16x8*)(kp + 32 * s), acc);
#pragma unroll
                for (int q = 0; q < 16; ++q) { const int tl = 32 * ti + crow(q, hh), sl = 32 * si + r; const bool keep = dir ? (sl > tl) : (sl <= tl); if (keep) AC[tl * ACS + sl] = f2bf(acc[q]); }
            }
        }
        __syncthreads();
        f32x16 o0 = {}, o1 = {};
#pragma unroll
        for (int dir = 0; dir < 2; ++dir) { const unsigned char* qp = TL + dir * TB + r * TS + 16 * hh;
#pragma unroll
            for (int s = 0; s < 8; ++s) { o0 = MFMA32(*(const bf16x8*)(qp + 32 * s), bs[dir][s], o0); o1 = MFMA32(*(const bf16x8*)(qp + 32 * TS + 32 * s), bs[dir][s], o1); } }
#pragma unroll
        for (int s = 0; s < 4; ++s) { o0 = MFMA32(ldfrag(AC + r * ACS + 16 * s + 8 * hh), bv[s], o0); o1 = MFMA32(ldfrag(AC + (32 + r) * ACS + 16 * s + 8 * hh), bv[s], o1); }
        if (unit + C.nb < GH * GNC) GO_LOAD(unit + C.nb);
#pragma unroll
        for (int q = 0; q < 16; ++q) { float a = o0[q] * o0[q], b = o1[q] * o1[q];
#pragma unroll
            for (int of = 1; of < 32; of <<= 1) { a += __shfl_xor(a, of); b += __shfl_xor(b, of); }
            if (r == 0) { SSQ[w * 64 + crow(q, hh)] = a; SSQ[w * 64 + 32 + crow(q, hh)] = b; } }
        __syncthreads();
        if (C.tid < 64) { float sa = 0.f;
#pragma unroll
            for (int ww = 0; ww < 8; ++ww) sa += SSQ[ww * 64 + C.tid];
            SSQ[512 + C.tid] = __builtin_amdgcn_rsqf(sa * (1.0f / 256.0f) + RMS_EPS); }
        __syncthreads();
#pragma unroll
        for (int q = 0; q < 16; ++q) { const int tl = crow(q, hh); const float ra = SSQ[512 + tl], rb = SSQ[512 + 32 + tl];
            const size_t oa = (size_t)(t0 + tl) * 1024 + 256 * h + 32 * w + r, ob = oa + 32 * 1024;
            OG[oa] = f2bf(o0[q] * ra * gn * bf2f(SR[oa])); OG[ob] = f2bf(o1[q] * rb * gn * bf2f(SR[ob])); }
        __syncthreads();
    }
#undef GO_LOAD
}


constexpr int GC2 = 256, GNC2 = T / GC2;
__device__ __forceinline__ void ph_gla_prep2(const Ctx& C, const bf16_t* Q0, const bf16_t* K0, const float* GF, const float* GB,
                                             bf16_t* QDF, bf16_t* QDB, bf16_t* KDF, bf16_t* KDB, bf16_t* KTF, bf16_t* KTB, float* EGL) {
    float* tot = (float*)C.lds;
    const int o = C.wave, l = C.lane; int par = 0;
    for (int it = C.bid; it < GNC2 * 4; it += C.nb) { const int m = it >> 2, cq = it & 3, t0 = m * GC2 + 32 * o;
        for (int cb = 0; cb < 2; ++cb, par ^= 1) { const int ch = 128 * cq + 64 * cb + l; const size_t off0 = (size_t)t0 * 512 + ch;
            float gf[32], gb[32];
#pragma unroll
            for (int i = 0; i < 32; ++i) { const size_t of = off0 + (size_t)i * 512; gf[i] = GF[of]; gb[i] = GB[of]; }
            unsigned short qa[8], ka[8], qb2[8], kb2[8];
#pragma unroll
            for (int i = 0; i < 8; ++i) { const size_t of = off0 + (size_t)i * 512; qa[i] = Q0[of]; ka[i] = K0[of]; }
            float sf = 0.f, sb = 0.f;
#pragma unroll
            for (int i = 0; i < 32; ++i) { sf += gf[i]; gf[i] = sf; }
#pragma unroll
            for (int i = 31; i >= 0; --i) { sb += gb[i]; gb[i] = sb; }
            float* tp = tot + par * 1024; tp[o * 64 + l] = sf; tp[512 + o * 64 + l] = sb;
            __syncthreads();
            float offf = 0.f, offb = 0.f, allf = 0.f, allb = 0.f;
#pragma unroll
            for (int oo = 0; oo < 8; ++oo) { const float a_ = tp[oo * 64 + l], b_ = tp[512 + oo * 64 + l]; offf += (oo < o) ? a_ : 0.f; offb += (oo > o) ? b_ : 0.f; allf += a_; allb += b_; }
#define PREP_OCT(QV, KV, i8) do { unsigned pf[4], pb[4];                                                                                                            \
                _Pragma("unroll") for (int i = 0; i < 8; i += 2) { float kdf[2], kdb[2];                                                                              \
                    _Pragma("unroll") for (int u = 0; u < 2; ++u) { const int ii = 8 * (i8) + i + u; const size_t of = off0 + (size_t)ii * 512; const float ef = __expf(offf + gf[ii]), eb = __expf(offb + gb[ii]); \
                        const float q = bf2f(QV[i + u]), k = bf2f(KV[i + u]);                                                                                         \
                        kdf[u] = k * __builtin_amdgcn_rcpf(ef); kdb[u] = k * __builtin_amdgcn_rcpf(eb);                                                               \
                        QDF[of] = f2bf(q * ef); QDB[of] = f2bf(q * eb); KDF[of] = f2bf(kdf[u]); KDB[of] = f2bf(kdb[u]); }                                            \
                    pf[i >> 1] = cvt_pk_bf16(kdf[0], kdf[1]); pb[i >> 1] = cvt_pk_bf16(kdb[0], kdb[1]); }                                                              \
                *(u32x4*)(KTF + (size_t)ch * T + t0 + 8 * (i8)) = (u32x4){pf[0], pf[1], pf[2], pf[3]};                                                               \
                *(u32x4*)(KTB + (size_t)ch * T + t0 + 8 * (i8)) = (u32x4){pb[0], pb[1], pb[2], pb[3]}; } while (0)
#define PREP_LDQK(QV, KV, i8) do { _Pragma("unroll") for (int i = 0; i < 8; ++i) { const size_t of = off0 + (size_t)(8 * (i8) + i) * 512; QV[i] = Q0[of]; KV[i] = K0[of]; } } while (0)
            PREP_LDQK(qb2, kb2, 1); PREP_OCT(qa, ka, 0);
            PREP_LDQK(qa, ka, 2);   PREP_OCT(qb2, kb2, 1);
            PREP_LDQK(qb2, kb2, 3); PREP_OCT(qa, ka, 2);
            PREP_OCT(qb2, kb2, 3);
#undef PREP_OCT
#undef PREP_LDQK
            if (o == 0) { EGL[(size_t)m * 512 + ch] = __expf(allf); EGL[(size_t)(GNC2 + m) * 512 + ch] = __expf(allb); }
        }
    }
    __syncthreads();
}
__device__ __forceinline__ void ph_gla_u2(const Ctx& C, const bf16_t* VT, const bf16_t* KTF, const bf16_t* KTB, const float* EGL, bf16_t* U) {
    const int r = C.lane & 31, hh = C.lane >> 5, w = C.wave;
    for (int unit = C.bid; unit < GH * GNC2; unit += C.nb) { const int h = unit & 3, m = unit >> 2, t0 = m * GC2;
        const bf16_t* bp = VT + (size_t)(256 * h + 32 * w + r) * T + t0 + 8 * hh;
        bf16x8 b[16];
#pragma unroll
        for (int s = 0; s < 16; ++s) b[s] = ldfrag(bp + 16 * s);
#pragma unroll
        for (int dir = 0; dir < 2; ++dir) { const bf16_t* KT = dir ? KTB : KTF;
#pragma unroll
            for (int i = 0; i < 8; ++i) { const int rp = w * 8 + i, row = 2 * rp + hh, c = r ^ (row & 15);
                __builtin_amdgcn_global_load_lds((const unsigned*)(KT + (size_t)(128 * h + row) * T + t0 + 8 * c), (LAS unsigned*)((LAS unsigned char*)C.lds + dir * 65536 + rp * 1024), 16, 0, 0); } }
        asm volatile("s_waitcnt vmcnt(0)" ::: "memory");
        __syncthreads();
#pragma unroll
        for (int dir = 0; dir < 2; ++dir) {
            bf16_t* Ub = U + ((size_t)(dir * GH + h) * GNC2 + m) * (GDV * GDK); const float* eg = EGL + (size_t)(dir * GNC2 + m) * 512 + 128 * h;
            const unsigned char* ab = C.lds + dir * 65536 + r * 512; const int y = hh ^ (r & 15);
#pragma unroll
            for (int j = 0; j < 4; ++j) { f32x16 acc = {};
#pragma unroll
                for (int s = 0; s < 16; ++s) acc = MFMA32(*(const bf16x8*)(ab + j * 16384 + 16 * ((2 * s) ^ y)), b[s], acc);
#pragma unroll
                for (int g = 0; g < 4; ++g) { const f32x4 e4 = *(const f32x4*)(eg + 32 * j + 8 * g + 4 * hh);
                    u32x2 o; o.x = cvt_pk_bf16(acc[4 * g] * e4[0], acc[4 * g + 1] * e4[1]); o.y = cvt_pk_bf16(acc[4 * g + 2] * e4[2], acc[4 * g + 3] * e4[3]);
                    *(u32x2*)(Ub + ((w * 8 + 2 * j + (g >> 1)) * 64 + (g & 1) * 32 + r) * 8 + 4 * hh) = o; } } }
        __syncthreads();
    }
}
__device__ __forceinline__ void ph_gla_scan2(const Ctx& C, const bf16_t* U, const float* EGL, bf16_t* ST) {
    for (int el = C.bid * 512 + C.tid; el < 2 * GH * GDV * (GDK / 2); el += C.nb * 512) { const int p = 2 * (el & 16383), h = (el >> 14) & 3, dir = el >> 16;
        const int dk = 16 * ((p >> 9) & 7) + 8 * ((p >> 8) & 1) + (p & 7);
        const size_t eb = (size_t)(dir * GH + h) * GNC2 * (GDV * GDK) + p; const float* eg = EGL + (size_t)dir * GNC2 * 512 + 128 * h + dk;
        float s0 = 0.f, s1 = 0.f;
#pragma unroll 32
        for (int i = 0; i < GNC2; ++i) { const int c = dir ? GNC2 - 1 - i : i; const size_t o = eb + (size_t)c * (GDV * GDK);
            const unsigned u = *(const unsigned*)(U + o); const f32x2 d = *(const f32x2*)(eg + (size_t)c * 512);
            *(unsigned*)(ST + o) = cvt_pk_bf16(s0, s1);
            s0 = d[0] * s0 + bf_lo(u); s1 = d[1] * s1 + bf_hi(u); }
    }
}
__device__ __forceinline__ void ph_gla_out2(const Ctx& C, const bf16_t* QDF, const bf16_t* QDB, const bf16_t* KDF, const bf16_t* KDB, const bf16_t* VT, const bf16_t* ST,
                                            const bf16_t* SR, const float* hnorm, bf16_t* OG) {
    constexpr int VS = 528;
    unsigned char* VL = C.lds;
    const int w = C.wave, r = C.lane & 31, hh = C.lane >> 5;
    for (int unit = C.bid; unit < GH * GNC2; unit += C.nb) { const int h = unit / GNC2, m = unit % GNC2, t0 = m * GC2, T0 = t0 + 32 * w;
#pragma unroll
        for (int dir = 0; dir < 2; ++dir) { const bf16_t* sg = ST + ((size_t)(dir * GH + h) * GNC2 + m) * (GDV * GDK) + C.lane * 8;
#pragma unroll
            for (int i = 0; i < 8; ++i) { const int fg = w + 8 * i;
                __builtin_amdgcn_global_load_lds((const unsigned*)(sg + (size_t)fg * 512), (LAS unsigned*)((LAS unsigned char*)C.lds + dir * 65536 + fg * 1024), 16, 0, 0); } }
        asm volatile("" ::: "memory");
        u32x4 sv[8];
#pragma unroll
        for (int q = 0; q < 8; ++q) { const int ck = C.tid + 512 * q, row = ck >> 5, cc = ck & 31; sv[q] = *(const u32x4*)(VT + (size_t)(256 * h + row) * T + t0 + 8 * cc); }
        asm volatile("s_waitcnt vmcnt(8)" ::: "memory");
        __syncthreads();
        f32x16 o[8];
#pragma unroll
        for (int d = 0; d < 8; ++d) o[d] = f32x16{};
#pragma unroll
        for (int dir = 0; dir < 2; ++dir) { const bf16_t* qp = (dir ? QDB : QDF) + (size_t)(T0 + r) * 512 + 128 * h + 8 * hh;
            const unsigned char* sl = C.lds + dir * 65536 + C.lane * 16;
#pragma unroll
            for (int s = 0; s < 8; ++s) { const bf16x8 a = ldfrag(qp + 16 * s);
#pragma unroll
                for (int d = 0; d < 8; ++d) o[d] = MFMA32(a, *(const bf16x8*)(sl + (d * 8 + s) * 1024), o[d]); } }
        __syncthreads();
#pragma unroll
        for (int q = 0; q < 8; ++q) { const int ck = C.tid + 512 * q, row = ck >> 5, cc = ck & 31; *(u32x4*)(VL + row * VS + 16 * cc) = sv[q]; }
#pragma unroll
        for (int q = 0; q < 8; ++q) { const int ck = C.tid + 512 * (8 + q), row = ck >> 5, cc = ck & 31; sv[q] = *(const u32x4*)(VT + (size_t)(256 * h + row) * T + t0 + 8 * cc); }
        bf16x8 kf[8], qf[8];
#define LOADKQ(KD, QD, sb_) do { const bf16_t* kp_ = (KD) + (size_t)(t0 + 32 * (sb_) + r) * 512 + 128 * h + 8 * hh; const bf16_t* qp_ = (QD) + (size_t)(T0 + r) * 512 + 128 * h + 8 * hh; \
            _Pragma("unroll") for (int s_ = 0; s_ < 8; ++s_) { kf[s_] = ldfrag(kp_ + 16 * s_); qf[s_] = ldfrag(qp_ + 16 * s_); } } while (0)
        LOADKQ(KDF, QDF, 0);
#pragma unroll
        for (int q = 0; q < 8; ++q) { const int ck = C.tid + 512 * (8 + q), row = ck >> 5, cc = ck & 31; *(u32x4*)(VL + row * VS + 16 * cc) = sv[q]; }
        __syncthreads();
        for (int sb = 0; sb < 8; ++sb) {
            f32x16 xt = f32x16{};
#pragma unroll
            for (int s = 0; s < 8; ++s) xt = MFMA32(kf[s], qf[s], xt);
            if (sb == w) {
                LOADKQ(KDB, QDB, sb);
                f32x16 xb = f32x16{};
#pragma unroll
                for (int s = 0; s < 8; ++s) xb = MFMA32(kf[s], qf[s], xb);
#pragma unroll
                for (int q = 0; q < 16; ++q) xt[q] = (crow(q, hh) <= r) ? xt[q] : xb[q]; }
            bf16x8 xa[2];
#pragma unroll
            for (int ks = 0; ks < 2; ++ks) { u32x4 wv; wv.x = cvt_pk_bf16(xt[8 * ks], xt[8 * ks + 1]); wv.y = cvt_pk_bf16(xt[8 * ks + 2], xt[8 * ks + 3]); wv.z = cvt_pk_bf16(xt[8 * ks + 4], xt[8 * ks + 5]); wv.w = cvt_pk_bf16(xt[8 * ks + 6], xt[8 * ks + 7]);
                xa[ks] = *reinterpret_cast<bf16x8*>(&wv); }
            if (sb + 1 < 8) { if (sb + 1 <= w) LOADKQ(KDF, QDF, sb + 1); else LOADKQ(KDB, QDB, sb + 1); }
#pragma unroll
            for (int d = 0; d < 8; ++d) { const unsigned char* vp = VL + (32 * d + r) * VS + (32 * sb + 4 * hh) * 2;
#pragma unroll
                for (int ks = 0; ks < 2; ++ks) { const u32x2 lo = *(const u32x2*)(vp + 32 * ks), hi2 = *(const u32x2*)(vp + 32 * ks + 16); const u32x4 bw = {lo.x, lo.y, hi2.x, hi2.y};
                    o[d] = MFMA32(xa[ks], *reinterpret_cast<const bf16x8*>(&bw), o[d]); } }
        }
#undef LOADKQ
        float rs[16];
#pragma unroll
        for (int q = 0; q < 16; ++q) { float a = 0.f;
#pragma unroll
            for (int d = 0; d < 8; ++d) a += o[d][q] * o[d][q];
#pragma unroll
            for (int of = 1; of < 32; of <<= 1) a += __shfl_xor(a, of);
            rs[q] = __builtin_amdgcn_rsqf(a * (1.0f / 256.0f) + RMS_EPS); }
        __syncthreads();
        bf16_t* slab = (bf16_t*)(VL + w * (32 * VS));
#pragma unroll
        for (int d = 0; d < 8; ++d) { const float gn = hnorm[32 * d + r];
#pragma unroll
            for (int q = 0; q < 16; ++q) slab[crow(q, hh) * (VS / 2) + 32 * d + r] = f2bf(o[d][q] * rs[q] * gn); }
        asm volatile("s_waitcnt lgkmcnt(0)" ::: "memory");
#pragma unroll 4
        for (int i = 0; i < 16; ++i) { const int ck = C.lane + 64 * i, row = ck >> 5, cc = ck & 31;
            const u32x4 ov = *(const u32x4*)((const unsigned char*)slab + row * VS + 16 * cc); const size_t oa = (size_t)(T0 + row) * 1024 + 256 * h + 8 * cc; const u32x4 gv = *(const u32x4*)(SR + oa);
            u32x4 res; res.x = cvt_pk_bf16(bf_lo(ov.x) * bf_lo(gv.x), bf_hi(ov.x) * bf_hi(gv.x)); res.y = cvt_pk_bf16(bf_lo(ov.y) * bf_lo(gv.y), bf_hi(ov.y) * bf_hi(gv.y));
            res.z = cvt_pk_bf16(bf_lo(ov.z) * bf_lo(gv.z), bf_hi(ov.z) * bf_hi(gv.z)); res.w = cvt_pk_bf16(bf_lo(ov.w) * bf_lo(gv.w), bf_hi(ov.w) * bf_hi(gv.w));
            *(u32x4*)(OG + oa) = res; }
        __syncthreads();
    }
}

__device__ __forceinline__ void ph_mla_tok(const Ctx& C, const float* CIN, const int* pos, const float* qn, const float* kvn, const float* invf, bf16_t* CQN, bf16_t* CKVN, float* CS, bf16_t* K) {
    const int l = C.lane;
    f32x4 g0, g1;
    if (l < 32) { g0 = *(const f32x4*)(qn + 8 * l); g1 = *(const f32x4*)(qn + 8 * l + 4); }
    else if (l < 48) { g0 = *(const f32x4*)(kvn + 8 * (l - 32)); g1 = *(const f32x4*)(kvn + 8 * (l - 32) + 4); }
    else { g0 = (f32x4){1.f, 1.f, 1.f, 1.f}; g1 = g0; }
    const float fr = invf[l & 31];
    for (int t = C.gw; t < T; t += C.ngw) {
        const float* row = CIN + (size_t)t * 512; const f32x4 a = *(const f32x4*)(row + 8 * l), b = *(const f32x4*)(row + 8 * l + 4);
        const float ss = (a[0] * a[0] + a[1] * a[1]) + (a[2] * a[2] + a[3] * a[3]) + (b[0] * b[0] + b[1] * b[1]) + (b[2] * b[2] + b[3] * b[3]);
        const float sq = wave_sum(l < 32 ? ss : 0.f), sk = wave_sum((l >= 32 && l < 48) ? ss : 0.f);
        const float rq = 1.0f / sqrtf(sq * (1.0f / 256.0f) + RMS_EPS), rk = 1.0f / sqrtf(sk * (1.0f / 128.0f) + RMS_EPS);
        const float ang = (float)pos[t] * fr; const double rev = (double)ang * 0.15915494309189533577; const float fr01 = (float)(rev - rint(rev));
        const float cv = __builtin_amdgcn_cosf(fr01), sv = __builtin_amdgcn_sinf(fr01);
        if (l < 32) { CS[(size_t)t * 64 + l] = cv; CS[(size_t)t * 64 + 32 + l] = sv; }
        if (l < 32) store8bf(CQN + (size_t)t * 256 + 8 * l, a * rq * g0, b * rq * g1);
        else if (l < 48) store8bf(CKVN + (size_t)t * 256 + 8 * (l - 32), a * rk * g0, b * rk * g1);
        else { const u32x4 z = {0u, 0u, 0u, 0u}; *(u32x4*)(CKVN + (size_t)t * 256 + 128 + 8 * (l - 48)) = z; }
        f32x4 xa = a, xb = b;
        f32x4 pa, pb;
#pragma unroll
        for (int j = 0; j < 4; ++j) { pa[j] = __shfl(xa[j], (l + 4) & 63); pb[j] = __shfl(xb[j], (l + 4) & 63); }
        f32x4 c0, c1, s0, s1;
#pragma unroll
        for (int j = 0; j < 4; ++j) { const int i = 8 * (l & 3) + j; c0[j] = __shfl(cv, i); c1[j] = __shfl(cv, i + 4); s0[j] = __shfl(sv, i); s1[j] = __shfl(sv, i + 4); }
        if (l >= 48 && l < 52) {
            const f32x4 o1a = xa * c0 - pa * s0, o2a = xa * s0 + pa * c0, o1b = xb * c1 - pb * s1, o2b = xb * s1 + pb * c1;
            u32x4 w0, w1; w0.x = cvt_pk_bf16(o1a[0], o1a[1]); w0.y = cvt_pk_bf16(o1a[2], o1a[3]); w0.z = cvt_pk_bf16(o2a[0], o2a[1]); w0.w = cvt_pk_bf16(o2a[2], o2a[3]);
            w1.x = cvt_pk_bf16(o1b[0], o1b[1]); w1.y = cvt_pk_bf16(o1b[2], o1b[3]); w1.z = cvt_pk_bf16(o2b[0], o2b[1]); w1.w = cvt_pk_bf16(o2b[2], o2b[3]);
            if (ATT_FP8) { u32x4 w8; w8.x = pk4fp8(o1a[0], o1a[1], o1a[2], o1a[3]); w8.y = pk4fp8(o2a[0], o2a[1], o2a[2], o2a[3]); w8.z = pk4fp8(o1b[0], o1b[1], o1b[2], o1b[3]); w8.w = pk4fp8(o2b[0], o2b[1], o2b[2], o2b[3]);
#pragma unroll
                for (int h = 0; h < MH; ++h) *(u32x4*)((unsigned char*)K + ((size_t)h * T + t) * MDK + 128 + 16 * (l & 3)) = w8; }
            else {
#pragma unroll
            for (int h = 0; h < MH; ++h) { bf16_t* kp = K + ((size_t)h * T + t) * MDK + 128 + 16 * (l & 3); *(u32x4*)kp = w0; *(u32x4*)(kp + 8) = w1; } }
        }
    }
}

#if MLA_ABSORB
__device__ __forceinline__ void ph_mla_tok_abs(const Ctx& C, const float* CIN, const int* pos, const float* qn, const float* kvn, const float* invf, bf16_t* CQN, float* CS, unsigned char* K8, unsigned char* V8T) {
    const int l = C.lane;
    f32x4 g0, g1;
    if (l < 32) { g0 = *(const f32x4*)(qn + 8 * l); g1 = *(const f32x4*)(qn + 8 * l + 4); }
    else if (l < 48) { g0 = *(const f32x4*)(kvn + 8 * (l - 32)); g1 = *(const f32x4*)(kvn + 8 * (l - 32) + 4); }
    else { g0 = (f32x4){1.f, 1.f, 1.f, 1.f}; g1 = g0; }
    const float fr = invf[l & 31];
    unsigned char* VT = C.lds;
    for (int g = C.bid; g < T / 64; g += C.nb) {
        for (int i = 0; i < 8; ++i) { const int tau = C.wave * 8 + i, t = 64 * g + tau, ps = 32 * ((tau >> 2) & 1) + (tau & 3) + 4 * ((tau >> 3) & 3) + 16 * (tau >> 5);
            const float* row = CIN + (size_t)t * 512; const f32x4 a = *(const f32x4*)(row + 8 * l), b = *(const f32x4*)(row + 8 * l + 4);
            const float ss = (a[0] * a[0] + a[1] * a[1]) + (a[2] * a[2] + a[3] * a[3]) + (b[0] * b[0] + b[1] * b[1]) + (b[2] * b[2] + b[3] * b[3]);
            const float sq = wave_sum(l < 32 ? ss : 0.f), sk = wave_sum((l >= 32 && l < 48) ? ss : 0.f);
            const float rq = 1.0f / sqrtf(sq * (1.0f / 256.0f) + RMS_EPS), rk = 1.0f / sqrtf(sk * (1.0f / 128.0f) + RMS_EPS);
            const float ang = (float)pos[t] * fr; const double rev = (double)ang * 0.15915494309189533577; const float fr01 = (float)(rev - rint(rev));
            const float cv = __builtin_amdgcn_cosf(fr01), sv = __builtin_amdgcn_sinf(fr01);
            if (l < 32) { CS[(size_t)t * 64 + l] = cv; CS[(size_t)t * 64 + 32 + l] = sv; }
            if (l < 32) store8bf(CQN + (size_t)t * 256 + 8 * l, a * rq * g0, b * rq * g1);
            else if (l < 48) { const f32x4 va = a * rk * g0, vb = b * rk * g1; u32x2 w; w.x = pk4fp8(va[0], va[1], va[2], va[3]); w.y = pk4fp8(vb[0], vb[1], vb[2], vb[3]);
                if (ATT8_DMA) { const int c_ = (l - 32) >> 1; *(u32x2*)(K8 + (size_t)g * (64 * MDK) + (tau * 12 + (c_ & ~3) + (((c_ & 3) + ((tau >> 2) & 3)) & 3)) * 16 + 8 * ((l - 32) & 1)) = w; }
                else *(u32x2*)(K8 + (size_t)t * MDK + 8 * (l - 32)) = w;
                unsigned char* vp = VT + (8 * (l - 32)) * 64 + ps;
#pragma unroll
                for (int e = 0; e < 4; ++e) { vp[e * 64] = (unsigned char)((w.x >> (8 * e)) & 0xffu); vp[(4 + e) * 64] = (unsigned char)((w.y >> (8 * e)) & 0xffu); } }
            f32x4 xa = a, xb = b, pa, pb;
#pragma unroll
            for (int j = 0; j < 4; ++j) { pa[j] = __shfl(xa[j], (l + 4) & 63); pb[j] = __shfl(xb[j], (l + 4) & 63); }
            f32x4 c0, c1, s0, s1;
#pragma unroll
            for (int j = 0; j < 4; ++j) { const int ii = 8 * (l & 3) + j; c0[j] = __shfl(cv, ii); c1[j] = __shfl(cv, ii + 4); s0[j] = __shfl(sv, ii); s1[j] = __shfl(sv, ii + 4); }
            if (l >= 48 && l < 52) {
                const f32x4 o1a = xa * c0 - pa * s0, o2a = xa * s0 + pa * c0, o1b = xb * c1 - pb * s1, o2b = xb * s1 + pb * c1;
                u32x4 w8; w8.x = pk4fp8(o1a[0], o1a[1], o1a[2], o1a[3]); w8.y = pk4fp8(o2a[0], o2a[1], o2a[2], o2a[3]); w8.z = pk4fp8(o1b[0], o1b[1], o1b[2], o1b[3]); w8.w = pk4fp8(o2b[0], o2b[1], o2b[2], o2b[3]);
                if (ATT8_DMA) *(u32x4*)(K8 + (size_t)g * (64 * MDK) + (tau * 12 + 8 + (((l & 3) + ((tau >> 2) & 3)) & 3)) * 16) = w8;
                else *(u32x4*)(K8 + (size_t)t * MDK + 128 + 16 * (l & 3)) = w8; }
        }
        __syncthreads();
        { const int c = C.tid >> 2, pc = C.tid & 3;
          if (ATT8_DMA) *(u32x4*)(V8T + (size_t)g * (MDV * 64) + (c * 4 + ((pc + ((c >> 2) & 3)) & 3)) * 16) = *(const u32x4*)(VT + c * 64 + 16 * pc);
          else *(u32x4*)(V8T + (size_t)c * T + 64 * g + 16 * pc) = *(const u32x4*)(VT + c * 64 + 16 * pc); }
        __syncthreads();
    }
}
#endif

namespace att {
constexpr int NW = 8, QBLK = 32, KVBLK = 64;
#ifndef ATT_PVSPLIT
#define ATT_PVSPLIT 0
#endif
#ifndef ATT_SDEPTH
#define ATT_SDEPTH 1
#endif
constexpr int SDEPTH = ATT_SDEPTH;
constexpr float THR2 = 11.5f;
constexpr int SHM_V = KVBLK * MDV * 2, SHM_K = KVBLK * 400, SHM_ATTN = 2 * SHM_V + 2 * SHM_K + NW * 64 * 4;
#define KSWZ(row, colB) ((row) * 400 + (colB))
#define SBAR() __builtin_amdgcn_sched_barrier(0)
__device__ __forceinline__ unsigned cvtpk(float lo, float hi) { unsigned r; asm volatile("v_cvt_pk_bf16_f32 %0, %1, %2" : "=v"(r) : "v"(lo), "v"(hi)); return r; }
__device__ __forceinline__ void partialSM(f32x16& p0, f32x16& p1, float& m_reg, float& mn, float& alpha) {
  float pmax = p0[0];
#pragma unroll
  for (int r = 1; r < 16; ++r) pmax = fmaxf(pmax, p0[r]);
#pragma unroll
  for (int r = 0; r < 16; ++r) pmax = fmaxf(pmax, p1[r]);
  { auto rr = __builtin_amdgcn_permlane32_swap(__float_as_uint(pmax), __float_as_uint(pmax), false, false);
    pmax = fmaxf(__uint_as_float(rr[0]), __uint_as_float(rr[1])); }
  if (__builtin_expect(__all(pmax - m_reg <= THR2), 1)) { mn = m_reg; alpha = 1.f; }
  else { mn = fmaxf(m_reg, pmax); alpha = __builtin_amdgcn_exp2f(m_reg - mn); m_reg = mn; }
#pragma unroll
  for (int r = 0; r < 16; ++r) p0[r] = p0[r] - mn;
#pragma unroll
  for (int r = 0; r < 16; ++r) p1[r] = p1[r] - mn;
#pragma unroll
  for (int r = 0; r < 16; ++r) p0[r] = __builtin_amdgcn_exp2f(p0[r]);
}
__device__ __forceinline__ void finishSM(f32x16& p0, f32x16& p1, float alpha, float& l_reg, bf16x8& pa0, bf16x8& pa1, bf16x8& pa2, bf16x8& pa3) {
#pragma unroll
  for (int r = 0; r < 16; ++r) p1[r] = __builtin_amdgcn_exp2f(p1[r]);
  float ps = 0;
#pragma unroll
  for (int r = 0; r < 16; ++r) ps += p0[r];
#pragma unroll
  for (int r = 0; r < 16; ++r) ps += p1[r];
  { auto rr = __builtin_amdgcn_permlane32_swap(__float_as_uint(ps), __float_as_uint(ps), false, false);
    ps = __uint_as_float(rr[0]) + __uint_as_float(rr[1]); }
  l_reg = l_reg * alpha + ps;
#define PK4(P, BASE, OUT) do { unsigned a0 = cvtpk(P[BASE + 0], P[BASE + 1]), a1 = cvtpk(P[BASE + 2], P[BASE + 3]);   \
    unsigned b0 = cvtpk(P[BASE + 4], P[BASE + 5]), b1 = cvtpk(P[BASE + 6], P[BASE + 7]);                              \
    auto r0 = __builtin_amdgcn_permlane32_swap(a0, b0, false, false); auto r1 = __builtin_amdgcn_permlane32_swap(a1, b1, false, false); \
    u32x4 w = {r0[0], r1[0], r0[1], r1[1]}; OUT = *reinterpret_cast<bf16x8*>(&w); } while (0)
  PK4(p0, 0, pa0); PK4(p0, 8, pa1); PK4(p1, 0, pa2); PK4(p1, 8, pa3);
#undef PK4
}
__device__ __forceinline__ void qkt(f32x16& p0, f32x16& p1, const char* Ks, const bf16x8* qr, int r32, int hi) {
  p0 = f32x16{}; p1 = f32x16{};
#pragma unroll
  for (int d0 = 0; d0 < 12; ++d0) { const int cb = (d0 * 16 + hi * 8) * 2;
    const bf16x8 b0 = *reinterpret_cast<const bf16x8*>(Ks + KSWZ(r32, cb));
    const bf16x8 b1 = *reinterpret_cast<const bf16x8*>(Ks + KSWZ(32 + r32, cb));
    p0 = __builtin_amdgcn_mfma_f32_32x32x16_bf16(b0, qr[d0], p0, 0, 0, 0);
    p1 = __builtin_amdgcn_mfma_f32_32x32x16_bf16(b1, qr[d0], p1, 0, 0, 0); }
}
__device__ __forceinline__ int v_st(int k, int c) { const int kk = (k & ~0xC) | ((k & 4) << 1) | ((k & 8) >> 1); return ((kk >> 3) * 4 + (c >> 5)) * 512 + ((kk & 7) * 32 + (c & 31)) * 2; }
__device__ __forceinline__ int v_rd_base(int lane) { return ((lane & 3) << 3) | (((lane >> 2) & 3) << 6) | (((lane >> 4) & 1) << 5) | (((lane >> 5) & 1) << 8); }
constexpr int v_rd_off(int d0, int ks, int half) { return d0 * 512 + ks * 4096 + half * 2048; }
template <int OFF> __device__ __forceinline__ s16x4 tr_read(int vb) {
  s16x4 r; asm volatile("ds_read_b64_tr_b16 %0, %1 offset:%2" : "=&v"(r) : "v"(vb), "i"(OFF) : "memory"); return r;
}
template <int D0> __device__ __forceinline__ void pv_one(f32x16& od, int vb, bf16x8 pa0, bf16x8 pa1, bf16x8 pa2, bf16x8 pa3) {
#if ATT_PVSPLIT
#define PK(L, H) (bf16x8){L[0], L[1], L[2], L[3], H[0], H[1], H[2], H[3]}
  { const s16x4 l0 = tr_read<v_rd_off(D0, 0, 0)>(vb), h0 = tr_read<v_rd_off(D0, 0, 1)>(vb), l1 = tr_read<v_rd_off(D0, 1, 0)>(vb), h1 = tr_read<v_rd_off(D0, 1, 1)>(vb);
    asm volatile("s_waitcnt lgkmcnt(0)" ::: "memory"); SBAR();
    od = __builtin_amdgcn_mfma_f32_32x32x16_bf16(pa0, PK(l0, h0), od, 0, 0, 0);
    od = __builtin_amdgcn_mfma_f32_32x32x16_bf16(pa1, PK(l1, h1), od, 0, 0, 0); }
  { const s16x4 l2 = tr_read<v_rd_off(D0, 2, 0)>(vb), h2 = tr_read<v_rd_off(D0, 2, 1)>(vb), l3 = tr_read<v_rd_off(D0, 3, 0)>(vb), h3 = tr_read<v_rd_off(D0, 3, 1)>(vb);
    asm volatile("s_waitcnt lgkmcnt(0)" ::: "memory"); SBAR();
    od = __builtin_amdgcn_mfma_f32_32x32x16_bf16(pa2, PK(l2, h2), od, 0, 0, 0);
    od = __builtin_amdgcn_mfma_f32_32x32x16_bf16(pa3, PK(l3, h3), od, 0, 0, 0); }
#undef PK
#else
  const s16x4 l0 = tr_read<v_rd_off(D0, 0, 0)>(vb), h0 = tr_read<v_rd_off(D0, 0, 1)>(vb), l1 = tr_read<v_rd_off(D0, 1, 0)>(vb), h1 = tr_read<v_rd_off(D0, 1, 1)>(vb);
  const s16x4 l2 = tr_read<v_rd_off(D0, 2, 0)>(vb), h2 = tr_read<v_rd_off(D0, 2, 1)>(vb), l3 = tr_read<v_rd_off(D0, 3, 0)>(vb), h3 = tr_read<v_rd_off(D0, 3, 1)>(vb);
  asm volatile("s_waitcnt lgkmcnt(0)" ::: "memory"); SBAR();
#define PK(L, H) (bf16x8){L[0], L[1], L[2], L[3], H[0], H[1], H[2], H[3]}
  od = __builtin_amdgcn_mfma_f32_32x32x16_bf16(pa0, PK(l0, h0), od, 0, 0, 0);
  od = __builtin_amdgcn_mfma_f32_32x32x16_bf16(pa1, PK(l1, h1), od, 0, 0, 0);
  od = __builtin_amdgcn_mfma_f32_32x32x16_bf16(pa2, PK(l2, h2), od, 0, 0, 0);
  od = __builtin_amdgcn_mfma_f32_32x32x16_bf16(pa3, PK(l3, h3), od, 0, 0, 0);
#undef PK
#endif
}
__device__ __forceinline__ void pv_d0(f32x16* o, int vb, bf16x8 pa0, bf16x8 pa1, bf16x8 pa2, bf16x8 pa3) {
  pv_one<0>(o[0], vb, pa0, pa1, pa2, pa3); pv_one<1>(o[1], vb, pa0, pa1, pa2, pa3); pv_one<2>(o[2], vb, pa0, pa1, pa2, pa3); pv_one<3>(o[3], vb, pa0, pa1, pa2, pa3);
}
__device__ __forceinline__ void attn_body(const bf16_t* __restrict__ Qb, const bf16_t* __restrict__ Kh, const bf16_t* __restrict__ Vh, bf16_t* __restrict__ Ob, int ldo, int seq, char* lds) {
  const int tid = threadIdx.x, wid = tid >> 6, lane = tid & 63, r32 = lane & 31, hi = lane >> 5;
  char* V_lds = lds; char* K_lds = lds + 2 * SHM_V;
  float* ws = (float*)(lds + 2 * SHM_V + 2 * SHM_K) + wid * 64; float* li_l = ws; float* al_l = ws + 32;
  float m_reg = -1e30f, l_reg = 0; f32x16 o[4] = {}; bf16x8 qr[12];
  const bf16_t* Qw = Qb + (size_t)(wid * QBLK + r32) * MDK + hi * 8;
#pragma unroll
  for (int d0 = 0; d0 < 12; ++d0) qr[d0] = *reinterpret_cast<const bf16x8*>(Qw + d0 * 16);
  const int sr = tid >> 4, sc = (tid & 15) * 8, vst0 = v_st(sr, sc), vst1 = v_st(32 + sr, sc);
  int kst[3];
#pragma unroll
  for (int i = 0; i < 3; ++i) { const int ck = tid + 512 * i, row = ck / 24, cc = ck - row * 24; kst[i] = KSWZ(row, cc * 16); }
  const int vb0 = (int)(uintptr_t)V_lds + v_rd_base(lane);
  const unsigned vo0 = (unsigned)(sr * MDV + sc), ko0 = (unsigned)(tid * 8);
  struct { bf16x8 vs0, vs1, ks0, ks1, ks2; } sr_[SDEPTH];
#define SLOAD(i, k0) do { const bf16_t* vt_ = Vh + (size_t)(k0) * MDV; const bf16_t* kt_ = Kh + (size_t)(k0) * MDK;                                         \
    sr_[i].vs0 = *reinterpret_cast<const bf16x8*>(vt_ + vo0); sr_[i].vs1 = *reinterpret_cast<const bf16x8*>(vt_ + 32 * MDV + vo0);                               \
    sr_[i].ks0 = *reinterpret_cast<const bf16x8*>(kt_ + ko0); sr_[i].ks1 = *reinterpret_cast<const bf16x8*>(kt_ + 4096 + ko0); sr_[i].ks2 = *reinterpret_cast<const bf16x8*>(kt_ + 8192 + ko0); } while (0)
#define SWRITE(b, i) do { *(bf16x8*)(V_lds + (b) * SHM_V + vst0) = sr_[i].vs0; *(bf16x8*)(V_lds + (b) * SHM_V + vst1) = sr_[i].vs1;               \
    *(bf16x8*)(K_lds + (b) * SHM_K + kst[0]) = sr_[i].ks0; *(bf16x8*)(K_lds + (b) * SHM_K + kst[1]) = sr_[i].ks1; *(bf16x8*)(K_lds + (b) * SHM_K + kst[2]) = sr_[i].ks2; } while (0)
#define SWAIT() do { if constexpr (SDEPTH == 2) asm volatile("s_waitcnt vmcnt(5)" ::: "memory"); else asm volatile("s_waitcnt vmcnt(0)" ::: "memory"); } while (0)
#define RESC(a) do { if (__any((a) < 1.f)) { if (hi == 0) al_l[r32] = (a); asm volatile("s_waitcnt lgkmcnt(0)" ::: "memory"); \
    _Pragma("unroll") for (int d = 0; d < 4; ++d) _Pragma("unroll") for (int r = 0; r < 16; ++r) o[d][r] *= al_l[crow(r, hi)]; } } while (0)
  f32x16 pA0, pA1, pB0, pB1; float mnA, mnB, alA, alB; bf16x8 pa0, pa1, pa2, pa3; const int NT = seq / KVBLK;
  constexpr int SE = 0, SO = SDEPTH - 1;
  SLOAD(SE, 0); asm volatile("s_waitcnt vmcnt(0)" ::: "memory"); SWRITE(0, SE); __syncthreads();
  qkt(pA0, pA1, K_lds, qr, r32, hi); partialSM(pA0, pA1, m_reg, mnA, alA);
  SLOAD(SO, KVBLK); if constexpr (SDEPTH == 2) { if (2 < NT) SLOAD(SE, 2 * KVBLK); }
  SWAIT(); SWRITE(1, SO); __syncthreads();
  for (int j = 1; j + 1 < NT; j += 2) {
    SBAR(); qkt(pB0, pB1, K_lds + SHM_K, qr, r32, hi);
    finishSM(pA0, pA1, alA, l_reg, pa0, pa1, pa2, pa3); SBAR();
    SLOAD(SO, (j + SDEPTH) * KVBLK); SBAR();
    pv_d0(o, vb0, pa0, pa1, pa2, pa3); partialSM(pB0, pB1, m_reg, mnB, alB);
    __syncthreads(); SWAIT(); SWRITE(0, SE);
    RESC(alB); __syncthreads();
    SBAR(); qkt(pA0, pA1, K_lds, qr, r32, hi);
    finishSM(pB0, pB1, alB, l_reg, pa0, pa1, pa2, pa3); SBAR();
    if (SDEPTH == 1 || j + 3 < NT) SLOAD(SE, (j + 1 + SDEPTH) * KVBLK); SBAR();
    pv_d0(o, vb0 + SHM_V, pa0, pa1, pa2, pa3); partialSM(pA0, pA1, m_reg, mnA, alA);
    __syncthreads(); SWAIT(); SWRITE(1, SO);
    RESC(alA); __syncthreads();
  }
  SBAR(); qkt(pB0, pB1, K_lds + SHM_K, qr, r32, hi);
  finishSM(pA0, pA1, alA, l_reg, pa0, pa1, pa2, pa3); SBAR();
  pv_d0(o, vb0, pa0, pa1, pa2, pa3); partialSM(pB0, pB1, m_reg, mnB, alB);
  __syncthreads(); RESC(alB);
  finishSM(pB0, pB1, alB, l_reg, pa0, pa1, pa2, pa3); SBAR();
  pv_d0(o, vb0 + SHM_V, pa0, pa1, pa2, pa3);
  if (hi == 0) li_l[r32] = l_reg; asm volatile("s_waitcnt lgkmcnt(0)" ::: "memory");
  float rli[16];
#pragma unroll
  for (int r = 0; r < 16; ++r) rli[r] = __builtin_amdgcn_rcpf(li_l[crow(r, hi)]);
  bf16_t* Ow = Ob + (size_t)(wid * QBLK) * ldo;
#pragma unroll
  for (int r = 0; r < 16; ++r) { const int orow = crow(r, hi);
#pragma unroll
    for (int d0 = 0; d0 < 4; ++d0) Ow[(size_t)orow * ldo + d0 * 32 + r32] = f2bf(o[d0][r] * rli[r]); }
#undef SLOAD
#undef SWRITE
#undef SWAIT
#undef RESC
}
}


namespace att8 {
constexpr int NW = 8, QBLK = 32, KVBLK = 64, KST = 208, VST = 80;
#ifndef ATT8_SDEPTH
#define ATT8_SDEPTH 1
#endif
constexpr int SDEPTH = ATT8_SDEPTH;
constexpr float THR8 = 8.f; constexpr int THR8I = 0x41000000;
#ifndef ATT8_RING3
#define ATT8_RING3 0
#endif
#ifndef ATT8_QUAD
#define ATT8_QUAD 0
#endif
constexpr int NBUF = ATT8_QUAD ? 4 : (ATT8_RING3 ? 3 : 2);
constexpr int SHM_K = KVBLK * KST, SHM_V = MDV * VST, SHM_ATTN = NBUF * SHM_K + NBUF * SHM_V + NW * 64 * 4;
#define SBAR() __builtin_amdgcn_sched_barrier(0)
#define SGB(mask, n) __builtin_amdgcn_sched_group_barrier((mask), (n), 0)
#ifndef ATT8_EARLYLD
#define ATT8_EARLYLD 1
#endif
#ifndef ATT8_ONEBAR
#define ATT8_ONEBAR 1
#endif
#ifndef ATT8_ILV
#define ATT8_ILV 1
#endif
#ifndef ATT8_ONES
#define ATT8_ONES 1
#endif
#ifndef ILV_NQ
#define ILV_NQ 6
#endif
#ifndef ILV_NP
#define ILV_NP 6
#endif
#define PIN2(a, b) asm volatile("" : "+v"(a), "+v"(b))
#define PIN4(o) asm volatile("" : "+v"(o[0]), "+v"(o[1]), "+v"(o[2]), "+v"(o[3]), "+v"(lacc))
#define ILV_QK() do { if (ATT8_ILV) { SGB(0x100, 4); _Pragma("unroll") for (int i_ = 0; i_ < 6; ++i_) { SGB(0x008, 1); SGB(0x002, ILV_NQ); if (i_ < 4) SGB(0x100, 2); } } } while (0)
#define ILV_PV() do { if (ATT8_ILV) { SGB(0x100, 4); _Pragma("unroll") for (int i_ = 0; i_ < 4 + ATT8_ONES; ++i_) { SGB(0x008, 1); SGB(0x002, ILV_NP); if (i_ < 2) SGB(0x100, 2); } } } while (0)
#define MFMA8(a, b, c) __builtin_amdgcn_mfma_scale_f32_32x32x64_f8f6f4((a), (b), (c), 0, 0, 0, 0x7f7f7f7f, 0, 0x7f7f7f7f)
#define MFMA8Q(a, b, c) __builtin_amdgcn_mfma_scale_f32_32x32x64_f8f6f4((a), (b), (c), 0, 0, 0, 0x7f7f7f7f, 0, 0x7c7c7c7c)
__device__ __forceinline__ i32x8 ld32(const char* p) { const u32x4 a = *(const u32x4*)p, b = *(const u32x4*)(p + 16); return (i32x8){(int)a.x, (int)a.y, (int)a.z, (int)a.w, (int)b.x, (int)b.y, (int)b.z, (int)b.w}; }
typedef short v2i16 __attribute__((ext_vector_type(2)));
#ifndef ATT8_ONES
#define ATT8_ONES 1
#endif
__device__ __forceinline__ float rowmax32(const f32x16& p0, const f32x16& p1) {
  float pmax = fmaxf(fmaxf(p0[0], p0[1]), p0[2]);
#pragma unroll
  for (int r = 3; r < 15; r += 2) pmax = fmaxf(fmaxf(pmax, p0[r]), p0[r + 1]);
  pmax = fmaxf(fmaxf(pmax, p0[15]), p1[0]);
#pragma unroll
  for (int r = 1; r < 15; r += 2) pmax = fmaxf(fmaxf(pmax, p1[r]), p1[r + 1]);
  pmax = fmaxf(pmax, p1[15]);
  auto rr = __builtin_amdgcn_permlane32_swap(__float_as_uint(pmax), __float_as_uint(pmax), false, false);
  return fmaxf(__uint_as_float(rr[0]), __uint_as_float(rr[1]));
}
__device__ __forceinline__ int rowmax32i(const f32x16& p0, const f32x16& p1) {
#define FI_(x) __float_as_int(x)
  int pm = max(max(FI_(p0[0]), FI_(p0[1])), FI_(p0[2]));
#pragma unroll
  for (int r = 3; r < 15; r += 2) pm = max(max(pm, FI_(p0[r])), FI_(p0[r + 1]));
  pm = max(max(pm, FI_(p0[15])), FI_(p1[0]));
#pragma unroll
  for (int r = 1; r < 15; r += 2) pm = max(max(pm, FI_(p1[r])), FI_(p1[r + 1]));
  pm = max(pm, FI_(p1[15]));
#undef FI_
  auto rr = __builtin_amdgcn_permlane32_swap((unsigned)pm, (unsigned)pm, false, false);
  return max((int)rr[0], (int)rr[1]);
}
__device__ __forceinline__ void partialSMi(f32x16& p0, f32x16& p1, int& pmi) {
  pmi = rowmax32i(p0, p1);
#pragma unroll
  for (int r = 0; r < 16; ++r) p0[r] = __builtin_amdgcn_exp2f(p0[r]);
}
template <bool FIRST>
__device__ __forceinline__ void partialSM(f32x16& p0, f32x16& p1, float& m_reg, f32x16& mt, float& alpha, float& sc, float& dsh) {
  const float pmax = rowmax32(p0, p1);
  if constexpr (FIRST) { m_reg += pmax; p0 = p0 - pmax; p1 = p1 - pmax; mt = mt - pmax; alpha = 1.f; sc = 1.f; dsh = 0.f; }
  else { const bool keep = __all(pmax <= THR8); const float d = keep ? 0.f : ceilf(fmaxf(pmax, 0.f));     alpha = __builtin_amdgcn_exp2f(-d); sc = __builtin_amdgcn_exp2f(d); m_reg += d; dsh = d; }
#pragma unroll
  for (int r = 0; r < 16; ++r) p0[r] = __builtin_amdgcn_exp2f(p0[r]);
}
__device__ __forceinline__ void finishSM(f32x16& p0, f32x16& p1, float alpha, float sc, float& l_reg, i32x8& pa) {
#pragma unroll
  for (int r = 0; r < 16; ++r) p1[r] = __builtin_amdgcn_exp2f(p1[r]);
#if !ATT8_ONES
  float ps = 0;
#pragma unroll
  for (int r = 0; r < 16; ++r) ps += p0[r];
#pragma unroll
  for (int r = 0; r < 16; ++r) ps += p1[r];
  { auto rr = __builtin_amdgcn_permlane32_swap(__float_as_uint(ps), __float_as_uint(ps), false, false);
    ps = __uint_as_float(rr[0]) + __uint_as_float(rr[1]); }
  l_reg = (l_reg + ps) * alpha;
#endif
#pragma unroll
  for (int j = 0; j < 4; ++j) { int w_, u_; asm volatile("" : "=v"(w_)); asm volatile("" : "=v"(u_)); v2i16 w = __builtin_bit_cast(v2i16, w_);
    w = __builtin_amdgcn_cvt_scalef32_pk_fp8_f32(w, p0[4 * j], p0[4 * j + 1], sc, false); w = __builtin_amdgcn_cvt_scalef32_pk_fp8_f32(w, p0[4 * j + 2], p0[4 * j + 3], sc, true); pa[j] = __builtin_bit_cast(int, w);
    v2i16 u = __builtin_bit_cast(v2i16, u_);
    u = __builtin_amdgcn_cvt_scalef32_pk_fp8_f32(u, p1[4 * j], p1[4 * j + 1], sc, false); u = __builtin_amdgcn_cvt_scalef32_pk_fp8_f32(u, p1[4 * j + 2], p1[4 * j + 3], sc, true); pa[4 + j] = __builtin_bit_cast(int, u); }
}
__device__ __forceinline__ void qkt(f32x16& p0, f32x16& p1, const char* Ks, const i32x8* qr, const f32x16& mt, int r32, int hi) {
  const char* k0 = Ks + r32 * KST + hi * 32;
  { const i32x8 a0 = ld32(k0), a1 = ld32(k0 + 32 * KST); p0 = MFMA8Q(a0, qr[0], mt); p1 = MFMA8Q(a1, qr[0], mt); }
#pragma unroll
  for (int s = 1; s < 3; ++s) { const i32x8 a0 = ld32(k0 + 64 * s), a1 = ld32(k0 + 32 * KST + 64 * s);
    p0 = MFMA8Q(a0, qr[s], p0); p1 = MFMA8Q(a1, qr[s], p1); }
}
__device__ __forceinline__ void pv(f32x16* o, f32x4& lacc, const char* Vs, const i32x8 pa, const i32x8& ones, int r32, int hi) {
  const char* v0 = Vs + r32 * VST + hi * 32;
#pragma unroll
  for (int d0 = 0; d0 < 4; ++d0) { const i32x8 b = ld32(v0 + d0 * 32 * VST); o[d0] = MFMA8(pa, b, o[d0]); }
  lacc = __builtin_amdgcn_mfma_scale_f32_16x16x128_f8f6f4(pa, ones, lacc, 0, 0, 0, 0x7f7f7f7f, 0, 0x7f7f7f7f);
}
__device__ __forceinline__ void attn_body(const unsigned char* __restrict__ Qb, const unsigned char* __restrict__ Kh, const unsigned char* __restrict__ Vt, bf16_t* __restrict__ Ob, int ldo, int seq, char* lds) {
  const int tid = threadIdx.x, wid = __builtin_amdgcn_readfirstlane(tid >> 6), lane = tid & 63, r32 = lane & 31, hi = lane >> 5;
  char* K_lds = lds; char* V_lds = lds + NBUF * SHM_K;
  float* ws = (float*)(lds + NBUF * SHM_K + NBUF * SHM_V) + wid * 64; float* li_l = ws; float* al_l = ws + 32;
  float m_reg = 0.f, l_reg = 0; f32x16 o[4] = {}; f32x4 lacc = {}; f32x16 mt = {}; i32x8 qr[3]; const int lsl = 4 * (lane >> 4) + 16 * ((lane >> 3) & 1);
  i32x8 ones; { int w1 = (((lane >> 4) & 1) == ((lane >> 3) & 1)) ? 0x38383838 : 0; asm volatile("" : "+v"(w1)); ones = (i32x8){w1, w1, w1, w1, w1, w1, w1, w1}; }
  { const char* Qw = (const char*)Qb + (size_t)(wid * QBLK + r32) * MDK + hi * 32;
#pragma unroll
    for (int s = 0; s < 3; ++s) qr[s] = ld32(Qw + 64 * s); }
  const int kd0 = (tid / 12) * KST + (tid % 12) * 16, kd1 = ((512 + tid) / 12) * KST + ((512 + tid) % 12) * 16, vd = (tid >> 2) * VST + (tid & 3) * 16;
  struct { u32x4 k0, k1, v; } sr_[SDEPTH]; const unsigned ko_ = (unsigned)tid * 16u, vo_ = ((unsigned)(tid >> 2) << 14) | ((unsigned)(tid & 3) << 4);
#define SLOAD(i, t0) do { const unsigned char* kt_ = Kh + (size_t)(t0) * MDK; const unsigned char* kt2_ = kt_ + 8192; const unsigned char* vt_ = Vt + (t0);     \
    asm volatile("global_load_dwordx4 %0, %1, %2" : "=v"(sr_[i].k0) : "v"(ko_), "s"(kt_)); \
    if (wid < 4) asm volatile("global_load_dwordx4 %0, %1, %2" : "=v"(sr_[i].k1) : "v"(ko_), "s"(kt2_)); \
    asm volatile("global_load_dwordx4 %0, %1, %2" : "=v"(sr_[i].v) : "v"(vo_), "s"(vt_)); } while (0)
#define SWRITE_K(b, i) do { *(u32x4*)(K_lds + (b) * SHM_K + kd0) = sr_[i].k0; if (wid < 4) *(u32x4*)(K_lds + (b) * SHM_K + kd1) = sr_[i].k1; } while (0)
#define SWRITE_V(b, i) do { *(u32x4*)(V_lds + (b) * SHM_V + vd) = sr_[i].v; } while (0)
#define SWRITE(b, i) do { SWRITE_K(b, i); SWRITE_V(b, i); } while (0)
#define SWAIT() do { if constexpr (SDEPTH == 2) asm volatile("s_waitcnt vmcnt(3)" ::: "memory"); else asm volatile("s_waitcnt vmcnt(0)" ::: "memory"); } while (0)
#define RESC(pmi, sc) do { (sc) = 1.f; if (!__all((pmi) <= THR8I)) { const float d_ = ceilf(__int_as_float(max((pmi), 0)));     \
    const float a_ = __builtin_amdgcn_exp2f(-d_); (sc) = __builtin_amdgcn_exp2f(d_); mt = mt - d_; if (hi == 0) al_l[r32] = a_; asm volatile("s_waitcnt lgkmcnt(0)" ::: "memory"); \
    lacc *= *(const f32x4*)(al_l + lsl); \
    _Pragma("unroll") for (int d = 0; d < 4; ++d) _Pragma("unroll") for (int r = 0; r < 16; ++r) o[d][r] *= al_l[crow(r, hi)]; } } while (0)
  f32x16 pA0, pA1, pB0, pB1; float alA, alB, scA, scB, dA, dB; int pmA, pmB; i32x8 pa; const int NT = seq / KVBLK;
#if ATT8_QUAD
  {
    const unsigned ko = (unsigned)tid * 16u, vo = ((unsigned)(tid >> 2) << 14) | ((unsigned)(tid & 3) << 4);
    u32x4 pk0[3], pk1[3], pv_[3];
#pragma unroll
    for (int t = 0; t < 3; ++t) { const unsigned char* kt_ = Kh + (size_t)(t * KVBLK) * MDK; pk0[t] = *(const u32x4*)(kt_ + ko); if (wid < 4) pk1[t] = *(const u32x4*)(kt_ + 8192 + ko); pv_[t] = *(const u32x4*)(Vt + t * KVBLK + vo); }
#pragma unroll
    for (int t = 0; t < 3; ++t) { *(u32x4*)(K_lds + t * SHM_K + kd0) = pk0[t]; if (wid < 4) *(u32x4*)(K_lds + t * SHM_K + kd1) = pk1[t]; *(u32x4*)(V_lds + t * SHM_V + vd) = pv_[t]; }
    __syncthreads(); }
  qkt(pA0, pA1, K_lds, qr, mt, r32, hi); partialSM<true>(pA0, pA1, m_reg, mt, alA, scA);
  bool pendV = false;
  for (int j = 1; j + 1 < NT; j += 2) {
    if (pendV) SWRITE_V((j + 1) & 3, 0);
    SBAR(); if (j + 2 < NT) { SLOAD(0, (j + 2) * KVBLK); } SBAR();
    qkt(pB0, pB1, K_lds + (j & 3) * SHM_K, qr, mt, r32, hi);
    finishSM(pA0, pA1, alA, scA, l_reg, pa); ILV_QK(); PIN2(pB0, pB1); SBAR();
    pv(o, V_lds + ((j - 1) & 3) * SHM_V, pa, ones, r32, hi); partialSM<false>(pB0, pB1, m_reg, mt, alB, scB); ILV_PV(); PIN4(o); PIN2(pB0, pB1); SBAR();
    if (j + 2 < NT) { SWRITE((j + 2) & 3, 0); }
    RESC(alB);
    SBAR(); if (j + 3 < NT) { SLOAD(0, (j + 3) * KVBLK); } SBAR();
    qkt(pA0, pA1, K_lds + ((j + 1) & 3) * SHM_K, qr, mt, r32, hi);
    finishSM(pB0, pB1, alB, scB, l_reg, pa); ILV_QK(); PIN2(pA0, pA1); SBAR();
    pv(o, V_lds + (j & 3) * SHM_V, pa, ones, r32, hi); partialSM<false>(pA0, pA1, m_reg, mt, alA, scA); ILV_PV(); PIN4(o); PIN2(pA0, pA1); SBAR();
    pendV = (j + 3 < NT); if (pendV) { SWRITE_K((j + 3) & 3, 0); }
    RESC(alA);
    __syncthreads();
  }
  SBAR(); qkt(pB0, pB1, K_lds + ((NT - 1) & 3) * SHM_K, qr, mt, r32, hi);
  finishSM(pA0, pA1, alA, scA, l_reg, pa); SBAR();
  pv(o, V_lds + ((NT - 2) & 3) * SHM_V, pa, ones, r32, hi); partialSM<false>(pB0, pB1, m_reg, mt, alB, scB);
  RESC(alB);
  finishSM(pB0, pB1, alB, scB, l_reg, pa); SBAR();
  pv(o, V_lds + ((NT - 1) & 3) * SHM_V, pa, ones, r32, hi);
#elif ATT8_RING3
  SLOAD(0, 0); asm volatile("s_waitcnt vmcnt(0)" ::: "memory"); SWRITE(0, 0);
  SLOAD(0, KVBLK); asm volatile("s_waitcnt vmcnt(0)" ::: "memory"); SWRITE(1, 0); __syncthreads();
  qkt(pA0, pA1, K_lds, qr, mt, r32, hi); partialSM<true>(pA0, pA1, m_reg, mt, alA, scA);
  int b0 = 0, b1 = 1, b2 = 2;
#define STEP(c0, c1, alc, scc, n0, n1, aln, scn, jj) do {                                                                     \
    SBAR(); qkt(n0, n1, K_lds + b1 * SHM_K, qr, mt, r32, hi);                                                                  \
    finishSM(c0, c1, alc, scc, l_reg, pa); ILV_QK(); PIN2(n0, n1); SBAR();                                                     \
    SLOAD(0, (((jj) + 2 < NT) ? (jj) + 2 : 0) * KVBLK); SBAR();                                                                \
    pv(o, V_lds + b0 * SHM_V, pa, ones, r32, hi); partialSM<false>(n0, n1, m_reg, mt, aln, scn); ILV_PV(); PIN4(o); PIN2(n0, n1); SBAR(); \
    SWRITE(b2, 0);                                                                                                            \
    RESC(aln);                                                                                                                \
    __syncthreads(); { const int t_ = b0; b0 = b1; b1 = b2; b2 = t_; } } while (0)
  for (int j = 0; j + 2 < NT; j += 2) { STEP(pA0, pA1, alA, scA, pB0, pB1, alB, scB, j); STEP(pB0, pB1, alB, scB, pA0, pA1, alA, scA, j + 1); }
  SBAR(); qkt(pB0, pB1, K_lds + b1 * SHM_K, qr, mt, r32, hi);
  finishSM(pA0, pA1, alA, scA, l_reg, pa); SBAR();
  pv(o, V_lds + b0 * SHM_V, pa, ones, r32, hi); partialSM<false>(pB0, pB1, m_reg, mt, alB, scB);
  RESC(alB);
  finishSM(pB0, pB1, alB, scB, l_reg, pa); SBAR();
  pv(o, V_lds + b1 * SHM_V, pa, ones, r32, hi);
#undef STEP
#else
  constexpr int SE = 0, SO = SDEPTH - 1;
  SLOAD(SE, 0); asm volatile("s_waitcnt vmcnt(0)" ::: "memory"); SWRITE(0, SE);
  if constexpr (SDEPTH == 1) SLOAD(SO, KVBLK);
  __syncthreads();
  qkt(pA0, pA1, K_lds, qr, mt, r32, hi); partialSM<true>(pA0, pA1, m_reg, mt, alA, scA, dA);
  if constexpr (SDEPTH == 2) { SLOAD(SO, KVBLK); if (2 < NT) SLOAD(SE, 2 * KVBLK); }
  SWAIT(); SWRITE(1, SO); __syncthreads();
  for (int j = 1; j + 1 < NT; j += 2) {
    SBAR(); if (ATT8_EARLYLD) { SLOAD(SO, (j + SDEPTH) * KVBLK); SBAR(); } qkt(pB0, pB1, K_lds + SHM_K, qr, mt, r32, hi);
    finishSM(pA0, pA1, alA, scA, l_reg, pa); ILV_QK(); PIN2(pB0, pB1); SBAR();
    if (!ATT8_EARLYLD) { SLOAD(SO, (j + SDEPTH) * KVBLK); SBAR(); }
    pv(o, lacc, V_lds, pa, ones, r32, hi); partialSMi(pB0, pB1, pmB); ILV_PV(); PIN4(o); PIN2(pB0, pB1); SBAR();
#if ATT8_ONEBAR
    SWAIT(); SWRITE_K(0, SE); __syncthreads(); SWRITE_V(0, SE); RESC(pmB, scB);
#else
    __syncthreads(); SWAIT(); SWRITE(0, SE);
    RESC(pmB, scB); __syncthreads();
#endif
    SBAR(); if (ATT8_EARLYLD) { if (SDEPTH == 1 || j + 3 < NT) SLOAD(SE, (j + 1 + SDEPTH) * KVBLK); SBAR(); } qkt(pA0, pA1, K_lds, qr, mt, r32, hi);
    finishSM(pB0, pB1, alB, scB, l_reg, pa); ILV_QK(); PIN2(pA0, pA1); SBAR();
    if (!ATT8_EARLYLD) { if (SDEPTH == 1 || j + 3 < NT) SLOAD(SE, (j + 1 + SDEPTH) * KVBLK); SBAR(); }
    pv(o, lacc, V_lds + SHM_V, pa, ones, r32, hi); partialSMi(pA0, pA1, pmA); ILV_PV(); PIN4(o); PIN2(pA0, pA1); SBAR();
#if ATT8_ONEBAR
    SWAIT(); SWRITE_K(1, SO); __syncthreads(); SWRITE_V(1, SO); RESC(pmA, scA);
#else
    __syncthreads(); SWAIT(); SWRITE(1, SO);
    RESC(pmA, scA); __syncthreads();
#endif
  }
  SBAR(); qkt(pB0, pB1, K_lds + SHM_K, qr, mt, r32, hi);
  finishSM(pA0, pA1, alA, scA, l_reg, pa); SBAR();
  pv(o, lacc, V_lds, pa, ones, r32, hi); partialSMi(pB0, pB1, pmB);
  __syncthreads(); RESC(pmB, scB);
  finishSM(pB0, pB1, alB, scB, l_reg, pa); SBAR();
  pv(o, lacc, V_lds + SHM_V, pa, ones, r32, hi);
#endif
  float rli[16];
  { if ((lane & 7) == 0) *(f32x4*)(li_l + lsl) = lacc; asm volatile("s_waitcnt lgkmcnt(0)" ::: "memory");
#pragma unroll
    for (int r = 0; r < 16; ++r) rli[r] = __builtin_amdgcn_rcpf(li_l[crow(r, hi)]); }
  bf16_t* Ow = Ob + (size_t)(wid * QBLK) * ldo;
#pragma unroll
  for (int r = 0; r < 16; ++r) { const int orow = crow(r, hi);
#pragma unroll
    for (int d0 = 0; d0 < 4; ++d0) { const float ov = o[d0][r] * rli[r];
      if (MLA_FP8) { const float o64 = ov * 64.f;
        ((unsigned char*)Ob)[(size_t)(wid * QBLK + orow) * ldo + d0 * 32 + r32] = (unsigned char)(pk4fp8(o64, o64, o64, o64) & 0xffu); }
      else Ow[(size_t)orow * ldo + d0 * 32 + r32] = f2bf(ov); } }
#undef SLOAD
#undef SWRITE
#undef SWRITE_K
#undef SWRITE_V
#undef SWAIT
#undef RESC
}
#ifndef ATT8_DMA
#define ATT8_DMA 1
#endif
#if ATT8_DMA && MLA_ABSORB
constexpr int DK_T = KVBLK * MDK, DV_T = MDV * KVBLK;
__device__ __forceinline__ int kslot(int row, int c) { return row * 12 + (c & ~3) + (((c & 3) + ((row >> 2) & 3)) & 3); }
__device__ __forceinline__ int vslot(int row, int c) { return row * 4 + ((c + ((row >> 2) & 3)) & 3); }
__device__ __forceinline__ i32x8 ld32s(const char* p0, const char* p1) { const u32x4 a = *(const u32x4*)p0, b = *(const u32x4*)p1; return (i32x8){(int)a.x, (int)a.y, (int)a.z, (int)a.w, (int)b.x, (int)b.y, (int)b.z, (int)b.w}; }
__device__ __forceinline__ void qkt_d(f32x16& p0, f32x16& p1, const char* Ks, int ka0, int ka1, const i32x8* qr, const f32x16& mt) {
  { const i32x8 a0 = ld32s(Ks + ka0, Ks + ka1), a1 = ld32s(Ks + 6144 + ka0, Ks + 6144 + ka1); p0 = MFMA8Q(a0, qr[0], mt); p1 = MFMA8Q(a1, qr[0], mt); }
#pragma unroll
  for (int s = 1; s < 3; ++s) { const i32x8 a0 = ld32s(Ks + 64 * s + ka0, Ks + 64 * s + ka1), a1 = ld32s(Ks + 6144 + 64 * s + ka0, Ks + 6144 + 64 * s + ka1);
    p0 = MFMA8Q(a0, qr[s], p0); p1 = MFMA8Q(a1, qr[s], p1); }
}
__device__ __forceinline__ void pv_d(f32x16* o, f32x4& lacc, const char* Vs, int va0, int va1, const i32x8 pa, const i32x8& ones) {
#pragma unroll
  for (int d0 = 0; d0 < 4; ++d0) { const i32x8 b = ld32s(Vs + 2048 * d0 + va0, Vs + 2048 * d0 + va1); o[d0] = MFMA8(pa, b, o[d0]); }
  lacc = __builtin_amdgcn_mfma_scale_f32_16x16x128_f8f6f4(pa, ones, lacc, 0, 0, 0, 0x7f7f7f7f, 0, 0x7f7f7f7f);
}
__device__ __forceinline__ void attn_body_dma(const unsigned char* __restrict__ Qb, const unsigned char* __restrict__ Kt, const unsigned char* __restrict__ Vt, unsigned char* __restrict__ Ob, int ldo, char* lds) {
  const int tid = threadIdx.x, wid = __builtin_amdgcn_readfirstlane(tid >> 6), lane = tid & 63, r32 = lane & 31, hi = lane >> 5;
  char* K_lds = lds; char* V_lds = lds + 2 * DK_T;
  float* ws = (float*)(lds + 2 * DK_T + 3 * DV_T) + wid * 64; float* li_l = ws; float* al_l = ws + 32;
  float m_reg = 0.f, l_reg = 0; f32x16 o[4] = {}; f32x4 lacc = {}; f32x16 mt = {}; i32x8 qr[3]; const int lsl = 4 * (lane >> 4) + 16 * ((lane >> 3) & 1);
  i32x8 ones; { int w1 = (((lane >> 4) & 1) == ((lane >> 3) & 1)) ? 0x38383838 : 0; asm volatile("" : "+v"(w1)); ones = (i32x8){w1, w1, w1, w1, w1, w1, w1, w1}; }
  { const char* Qw = (const char*)Qb + (size_t)(wid * QBLK + r32) * MDK + hi * 32;
#pragma unroll
    for (int s = 0; s < 3; ++s) qr[s] = ld32(Qw + 64 * s); }
  const int g4 = (r32 >> 2) & 3;
  const int ka0 = r32 * MDK + 16 * ((2 * hi + g4) & 3), ka1 = r32 * MDK + 16 * ((2 * hi + 1 + g4) & 3);
  const int va0 = r32 * 64 + 16 * ((2 * hi + g4) & 3), va1 = r32 * 64 + 16 * ((2 * hi + 1 + g4) & 3);
  constexpr int NT = T / KVBLK; const unsigned dvo_ = (unsigned)lane * 16u + (unsigned)wid * 1024u;
#define KVDMA(t_, kb_, vb_) do { const unsigned char* kg_ = Kt + (size_t)(t_) * DK_T; const unsigned char* vg_ = Vt + (size_t)(t_) * DV_T; asm volatile("" : "+s"(kg_), "+s"(vg_));     \
    __builtin_amdgcn_global_load_lds((const unsigned*)(kg_ + dvo_), (LAS unsigned*)((LAS unsigned char*)K_lds + (kb_) * DK_T + wid * 1024), 16, 0, 0);                                           \
    if (wid < 4) __builtin_amdgcn_global_load_lds((const unsigned*)(kg_ + 8192 + dvo_), (LAS unsigned*)((LAS unsigned char*)K_lds + (kb_) * DK_T + 8192 + wid * 1024), 16, 0, 0);                \
    __builtin_amdgcn_global_load_lds((const unsigned*)(vg_ + dvo_), (LAS unsigned*)((LAS unsigned char*)V_lds + (vb_) + wid * 1024), 16, 0, 0); } while (0)
#define DWAIT() asm volatile("s_waitcnt vmcnt(0)" ::: "memory")
#define RESC(pmi, sc) do { (sc) = 1.f; if (!__all((pmi) <= THR8I)) { const float d_ = ceilf(__int_as_float(max((pmi), 0)));     \
    const float a_ = __builtin_amdgcn_exp2f(-d_); (sc) = __builtin_amdgcn_exp2f(d_); mt = mt - d_; if (hi == 0) al_l[r32] = a_; asm volatile("s_waitcnt lgkmcnt(0)" ::: "memory"); \
    lacc *= *(const f32x4*)(al_l + lsl); \
    _Pragma("unroll") for (int d = 0; d < 4; ++d) _Pragma("unroll") for (int r = 0; r < 16; ++r) o[d][r] *= al_l[crow(r, hi)]; } } while (0)
  f32x16 pA0, pA1, pB0, pB1; float alA, scA, scB, dA; int pmA, pmB; i32x8 pa;
  KVDMA(0, 0, 0); KVDMA(1, 1, DV_T);
  if (wid < 4) asm volatile("s_waitcnt vmcnt(3)" ::: "memory"); else asm volatile("s_waitcnt vmcnt(2)" ::: "memory");
  __syncthreads();
  qkt_d(pA0, pA1, K_lds, ka0, ka1, qr, mt); partialSM<true>(pA0, pA1, m_reg, mt, alA, scA, dA);
  DWAIT(); __syncthreads();
#define HS(KB, VR, VW, c0, c1, scc, n0, n1, pmn, scn, jj) do {                                                                                     \
    SBAR(); KVDMA((jj) + 1, (KB) ^ 1, (VW) * DV_T); SBAR();                                                                                         \
    qkt_d(n0, n1, K_lds + (KB) * DK_T, ka0, ka1, qr, mt); finishSM(c0, c1, 1.f, scc, l_reg, pa); ILV_QK(); PIN2(n0, n1); SBAR();                      \
    pv_d(o, lacc, V_lds + (VR) * DV_T, va0, va1, pa, ones); partialSMi(n0, n1, pmn); ILV_PV(); PIN4(o); PIN2(n0, n1); SBAR();                          \
    DWAIT(); __syncthreads(); RESC(pmn, scn); } while (0)
  int j = 1;
  for (; j + 5 < NT - 1; j += 6) {
    HS(1, 0, 2, pA0, pA1, scA, pB0, pB1, pmB, scB, j);     HS(0, 1, 0, pB0, pB1, scB, pA0, pA1, pmA, scA, j + 1);
    HS(1, 2, 1, pA0, pA1, scA, pB0, pB1, pmB, scB, j + 2); HS(0, 0, 2, pB0, pB1, scB, pA0, pA1, pmA, scA, j + 3);
    HS(1, 1, 0, pA0, pA1, scA, pB0, pB1, pmB, scB, j + 4); HS(0, 2, 1, pB0, pB1, scB, pA0, pA1, pmA, scA, j + 5); }
  HS(1, 0, 2, pA0, pA1, scA, pB0, pB1, pmB, scB, j); HS(0, 1, 0, pB0, pB1, scB, pA0, pA1, pmA, scA, j + 1);
  { SBAR(); qkt_d(pB0, pB1, K_lds + DK_T, ka0, ka1, qr, mt);
    finishSM(pA0, pA1, 1.f, scA, l_reg, pa); SBAR();
    pv_d(o, lacc, V_lds + 2 * DV_T, va0, va1, pa, ones); partialSMi(pB0, pB1, pmB);
    RESC(pmB, scB);
    finishSM(pB0, pB1, 1.f, scB, l_reg, pa); SBAR();
    pv_d(o, lacc, V_lds, va0, va1, pa, ones); }
#undef HS
  float rli[16];
  { if ((lane & 7) == 0) *(f32x4*)(li_l + lsl) = lacc; asm volatile("s_waitcnt lgkmcnt(0)" ::: "memory");
#pragma unroll
    for (int r = 0; r < 16; ++r) rli[r] = __builtin_amdgcn_rcpf(li_l[crow(r, hi)]); }
#pragma unroll
  for (int r = 0; r < 16; ++r) { const int orow = crow(r, hi);
#pragma unroll
    for (int d0 = 0; d0 < 4; ++d0) { const float o64 = o[d0][r] * rli[r] * 64.f;
      Ob[(size_t)(wid * QBLK + orow) * ldo + d0 * 32 + r32] = (unsigned char)(pk4fp8(o64, o64, o64, o64) & 0xffu); } }
#undef KVDMA
#undef DWAIT
#undef RESC
}
#endif
#undef SBAR
#undef SGB
#undef MFMA8
}

#ifdef DBG
constexpr size_t WS_DBG = 256 * 1024;
__device__ __forceinline__ unsigned hash32(unsigned x) { x ^= x >> 16; x *= 0x7feb352dU; x ^= x >> 15; x *= 0x846ca68bU; x ^= x >> 16; return x; }
__device__ __forceinline__ void dbg_acc(float* acc, int slot, float got, float ref) { const float d = got - ref; atomicAdd(acc + 2 * slot, d * d); atomicAdd(acc + 2 * slot + 1, ref * ref); }
__device__ __forceinline__ float dotA(const bf16_t* a, const float* W, int K, int ldw, int n) { float s = 0.f; for (int k = 0; k < K; ++k) s += bf2f(a[k]) * W[(size_t)k * ldw + n]; return s; }
__device__ __forceinline__ float dotA8(const unsigned char* a, const float* W, int K, int ldw, int n) { float s = 0.f; for (int k = 0; k < K; ++k) s += fp8f(a + k) * W[(size_t)k * ldw + n]; return s; }
__device__ __forceinline__ void chk_p1(const Ctx& C, const Args& a, unsigned char* ws, float* acc) {
    const int gt = C.bid * 512 + C.tid; if (gt >= 6144) return;
    const unsigned hs = hash32(gt * 7919u + 13u); const int t = hs % T, kind = gt % 6; const unsigned c0 = hs >> 14;
    const bf16_t* xn = (const bf16_t*)(ws + WS_XN) + (size_t)t * 1024; const float* w_in = (const float*)a.in[5];
    if (kind == 0) { const int c = c0 % 512; dbg_acc(acc, 0, bf2f(((const bf16_t*)(ws + AR_Q0))[(size_t)t * 512 + c]), dotA(xn, w_in, 1024, 3104, c) * 0.08838834764831845f); }
    else if (kind == 1) { const int c = c0 % 512; dbg_acc(acc, 0, bf2f(((const bf16_t*)(ws + AR_K0))[(size_t)t * 512 + c]), dotA(xn, w_in, 1024, 3104, 512 + c)); }
    else if (kind == 2) { const int c = c0 % 1024; dbg_acc(acc, 0, bf2f(((const bf16_t*)(ws + AR_VT))[(size_t)c * T + t]), dotA(xn, w_in, 1024, 3104, 1024 + c)); }
    else if (kind == 3) { const int c = c0 % 1024; dbg_acc(acc, 0, bf2f(((const bf16_t*)(ws + AR_SR))[(size_t)t * 1024 + c]), siluf(dotA(xn, w_in, 1024, 3104, 2048 + c))); }
    else { const int dir = kind - 4, c = c0 % 512; const float* wg = (const float*)a.in[dir ? 8 : 6]; const float* bg = (const float*)a.in[dir ? 9 : 7]; float lg = bg[c];
        for (int j = 0; j < 16; ++j) lg += dotA(xn, w_in, 1024, 3104, 3072 + 16 * dir + j) * wg[j * 512 + c];
        dbg_acc(acc, 1, ((const float*)(ws + (dir ? AR_GB : AR_GF)))[(size_t)t * 512 + c], logsigf(lg) * 0.0625f); }
}
__device__ __forceinline__ void chk_gla(const Ctx& C, const Args& a, unsigned char* ws, float* acc) {
    if (C.bid >= 64) return;
    float* A = (float*)C.lds; float* O = A + 4096; float* red = O + 512;
    const unsigned hs = hash32(C.bid * 977u + 5u); const int t = hs % T, h = (hs >> 14) & 3;
    const bf16_t* Q0 = (const bf16_t*)(ws + AR_Q0); const bf16_t* K0 = (const bf16_t*)(ws + AR_K0); const float* GF = (const float*)(ws + AR_GF); const float* GB = (const float*)(ws + AR_GB);
    const bf16_t* VT = (const bf16_t*)(ws + AR_VT); const bf16_t* SR = (const bf16_t*)(ws + AR_SR); const bf16_t* OG = (const bf16_t*)(ws + WS_XN);
    for (int i = C.tid; i < 4096; i += 512) A[i] = 0.f;
    __syncthreads();
    const int dir = C.tid >> 8, sub = C.tid & 255;
    if (sub < 128) { const int k = sub, ch = 128 * h + k; const float q = bf2f(Q0[(size_t)t * 512 + ch]); float Dk = dir ? __expf(GB[(size_t)t * 512 + ch]) : 1.f;
        for (int i = 0; i < 2048; ++i) { const int s = dir ? t + 1 + i : t - i; const bool valid = s >= 0 && s < T; float w = 0.f;
            if (valid) { w = q * Dk * bf2f(K0[(size_t)s * 512 + ch]); Dk *= __expf((dir ? GB : GF)[(size_t)s * 512 + ch]); }
            w = wave_sum(w); if (C.lane == 0) atomicAdd(&A[dir * 2048 + i], w); } }
    __syncthreads();
    { float o = 0.f; for (int i = 0; i < 2048; ++i) { const int s = dir ? t + 1 + i : t - i; if (s >= 0 && s < T) o += A[dir * 2048 + i] * bf2f(VT[(size_t)(256 * h + sub) * T + s]); } O[dir * 256 + sub] = o; }
    __syncthreads();
    if (C.tid < 256) { const float o = O[C.tid] + O[256 + C.tid]; float ss = wave_sum(o * o); if (C.lane == 0) red[C.wave] = ss; }
    __syncthreads();
    if (C.tid < 256) { const float o = O[C.tid] + O[256 + C.tid]; const float ss = red[0] + red[1] + red[2] + red[3]; const float r = 1.0f / sqrtf(ss * (1.0f / 256.0f) + RMS_EPS);
        const size_t oi = (size_t)t * 1024 + 256 * h + C.tid; dbg_acc(acc, 2, bf2f(OG[oi]), o * r * ((const float*)a.in[10])[C.tid] * bf2f(SR[oi])); }
    __syncthreads();
}
__device__ __forceinline__ void chk_resid(const Ctx& C, const float* base, const bf16_t* A, int K, const float* W, const float* HAp, float* acc, int slot) {
    const int gt = C.bid * 512 + C.tid; if (gt >= 4096) return;
    const unsigned hs = hash32(gt * 31u + slot); const int t = hs % T, n = (hs >> 14) % 1024;
    const float dv = (slot == 14 && ATT_FP8 && MLA_FP8) ? dotA8((const unsigned char*)A + (size_t)t * K, W, K, 1024, n) * (1.0f / 64.f) : dotA(A + (size_t)t * K, W, K, 1024, n);
    dbg_acc(acc, slot, HAp[(size_t)t * 1024 + n] - base[(size_t)t * 1024 + n], dv); return;
    dbg_acc(acc, slot, HAp[(size_t)t * 1024 + n], base[(size_t)t * 1024 + n] + dotA(A + (size_t)t * K, W, K, 1024, n));
}
__device__ __forceinline__ void chk_router(const Ctx& C, const float* Hin, const float* gain, const float* Wr, const bf16_t* XN, const float* AFF, float* acc, int slot) {
    const int gt = C.bid * 512 + C.tid; if (gt >= 512) return;
    const int t = hash32(gt * 101u + 7u) % T; const float* hr = Hin + (size_t)t * 1024; float ss = 0.f; for (int k = 0; k < 1024; ++k) ss += hr[k] * hr[k];
    const float r = 1.0f / sqrtf(ss / 1024.0f + RMS_EPS); float lg[16]; for (int e = 0; e < 16; ++e) lg[e] = 0.f;
    for (int k = 0; k < 1024; ++k) { const float xv = hr[k] * r * gain[k]; for (int e = 0; e < 16; ++e) lg[e] += xv * Wr[k * 16 + e]; if ((k & 63) == (gt & 63)) dbg_acc(acc, slot, bf2f(XN[(size_t)t * 1024 + k]), xv); }
    float mx = lg[0]; for (int e = 1; e < 16; ++e) mx = fmaxf(mx, lg[e]); float s = 0.f; for (int e = 0; e < 16; ++e) { lg[e] = expf(lg[e] - mx); s += lg[e]; }
    for (int e = 0; e < 16; ++e) dbg_acc(acc, slot, AFF[(size_t)t * 16 + e], lg[e] / s);
}
__device__ __forceinline__ void chk_select(const Ctx& C, const float* AFF, const int* SEL, const int* IDX, unsigned* dw) {
    const int gt = C.bid * 512 + C.tid;
    for (int p = gt; p < T * 16; p += C.nb * 512) { const int t = p >> 4, e = p & 15; const int s = SEL[p]; const unsigned b = __float_as_uint(AFF[p]);
        if (s > 0) { atomicAdd(&dw[e], 1u); atomicMax(&dw[16 + e], ~b); if (s > CAP || IDX[e * CAP + s - 1] != t) atomicAdd(&dw[48], 1u); } else { atomicMax(&dw[32 + e], b); if (s < 0) atomicAdd(&dw[48], 1u); } }
}
__device__ __forceinline__ void chk_moe_h(const Ctx& C, const Args& a, unsigned char* ws, int layer, float* acc, int slot) {
    const int gt = C.bid * 512 + C.tid; if (gt >= 2048) return;
    const unsigned hs = hash32(gt * 53u + 3u); const int e = hs & 15, sl = (hs >> 4) % CAP, f = (hs >> 15) % FF; const int t = ((const int*)(ws + WS_IDX))[e * CAP + sl];
    if (t < 0 || t >= T) { dbg_acc(acc, slot, 1e3f, 0.f); return; }
    const size_t wo = (size_t)(layer * NE + e) * 1024 * 2048; const size_t row = (size_t)e * CAP + sl;
#if MOE_FP8
    const unsigned char* xn = ws + AR_XN8 + (size_t)t * 1024;
    const float g = dotA8(xn, (const float*)a.in[19] + wo, 1024, 2048, f), u = dotA8(xn, (const float*)a.in[20] + wo, 1024, 2048, f);
    dbg_acc(acc, slot, fp8f(ws + AR_H + row * FF + f), siluf(g) * u);
    dbg_acc(acc, slot, fp8f(ws + AR_XS + row * 1024 + (f & 1023)), fp8f(xn + (f & 1023)));
#else
    const bf16_t* xn = (const bf16_t*)(ws + WS_XN) + (size_t)t * 1024;
    const float g = dotA(xn, (const float*)a.in[19] + wo, 1024, 2048, f), u = dotA(xn, (const float*)a.in[20] + wo, 1024, 2048, f);
    dbg_acc(acc, slot, bf2f(((const bf16_t*)(ws + AR_H))[row * FF + f]), siluf(g) * u);
    dbg_acc(acc, slot, bf2f(((const bf16_t*)(ws + AR_XS))[row * 1024 + (f & 1023)]), bf2f(xn[f & 1023]));
#endif
}
__device__ __forceinline__ void chk_moe_y(const Ctx& C, const Args& a, unsigned char* ws, int layer, float* acc, int slot) {
    const int gt = C.bid * 512 + C.tid; if (gt >= 2048) return;
    const unsigned hs = hash32(gt * 59u + 11u); const int e = hs & 15, sl = (hs >> 4) % CAP, n = (hs >> 15) % 1024; const size_t row = (size_t)e * CAP + sl; const float* wd = (const float*)a.in[21] + (size_t)(layer * NE + e) * 2048 * 1024;
#if MOE_FP8
    const float ref = dotA8(ws + AR_H + row * FF, wd, 2048, 1024, n);
#else
    const float ref = dotA((const bf16_t*)(ws + AR_H) + row * FF, wd, 2048, 1024, n);
#endif
    dbg_acc(acc, slot, bf2f(((const bf16_t*)(ws + AR_Y))[row * 1024 + n]), ref);
}
__device__ __forceinline__ void chk_combine(const Ctx& C, unsigned char* ws, const float* Hin, const float* Hout, float* acc, int slot) {
    const int gt = C.bid * 512 + C.tid; if (gt >= 4096) return;
    const unsigned hs = hash32(gt * 67u + 1u); const int t = hs % T, n = (hs >> 14) % 1024; float ref = Hin[(size_t)t * 1024 + n];
    for (int e = 0; e < 16; ++e) { const int s = ((const int*)(ws + WS_SEL))[t * 16 + e]; if (s > 0) ref += ((const float*)(ws + WS_AFF))[t * 16 + e] * bf2f(((const bf16_t*)(ws + AR_Y))[((size_t)e * CAP + s - 1) * 1024 + n]); }
    dbg_acc(acc, slot, Hout[(size_t)t * 1024 + n], ref);
}
__device__ __forceinline__ void chk_cin(const Ctx& C, const Args& a, unsigned char* ws, float* acc) {
    const int gt = C.bid * 512 + C.tid; if (gt >= 4096) return;
    const unsigned hs = hash32(gt * 71u + 9u); const int t = hs % T, n = (hs >> 14) % 448;
    dbg_acc(acc, 10, ((const float*)(ws + AR_CIN))[(size_t)t * 512 + n], (ATT_FP8 && MLA_FP8) ? dotA8(ws + WS_XN + (size_t)t * 1024, (const float*)a.in[12], 1024, 448, n) : dotA((const bf16_t*)(ws + WS_XN) + (size_t)t * 1024, (const float*)a.in[12], 1024, 448, n));
}
__device__ __forceinline__ void chk_tok(const Ctx& C, const Args& a, unsigned char* ws, float* acc) {
    const int gt = C.bid * 512 + C.tid; if (gt >= 1024) return;
    const unsigned hs = hash32(gt * 73u + 19u); const int t = hs % T, h = (hs >> 14) & 15; const float* row = (const float*)(ws + AR_CIN) + (size_t)t * 512;
    float sq = 0.f, sk = 0.f; for (int i = 0; i < 256; ++i) sq += row[i] * row[i]; for (int i = 0; i < 128; ++i) sk += row[256 + i] * row[256 + i];
    const float rq = 1.0f / sqrtf(sq / 256.0f + RMS_EPS), rk = 1.0f / sqrtf(sk / 128.0f + RMS_EPS);
    const int i = (hs >> 18) % 256; dbg_acc(acc, 11, bf2f(((const bf16_t*)(ws + AR_CQN))[(size_t)t * 256 + i]), row[i] * rq * ((const float*)a.in[13])[i]);
    const int j = i & 127; dbg_acc(acc, 11, bf2f(((const bf16_t*)(ws + AR_CKVN))[(size_t)t * 256 + j]), row[256 + j] * rk * ((const float*)a.in[15])[j]);
    dbg_acc(acc, 11, 1.f + bf2f(((const bf16_t*)(ws + AR_CKVN))[(size_t)t * 256 + 128 + j]), 1.f);
    const int f = i & 31; const float ang = (float)((const int*)a.in[1])[t] * a.invf[f]; double xr = (double)ang * 0.15915494309189533577; xr = (xr - rint(xr)) * 6.283185307179586477; double cd = 1.0, sd = xr, tc = 1.0, ts = xr; for (int n = 1; n < 16; ++n) { tc *= -xr * xr / ((2.0 * n - 1.0) * (2.0 * n)); ts *= -xr * xr / ((2.0 * n) * (2.0 * n + 1.0)); cd += tc; sd += ts; } const float cr = (float)cd, sr = (float)sd;
    dbg_acc(acc, 11, ((const float*)(ws + WS_CS))[(size_t)t * 64 + f], cr); dbg_acc(acc, 11, ((const float*)(ws + WS_CS))[(size_t)t * 64 + 32 + f], sr);
    const float x1 = row[384 + f], x2 = row[416 + f]; const bf16_t* kp = (const bf16_t*)(ws + AR_K) + ((size_t)h * T + t) * MDK + 128 + 8 * (f >> 2) + (f & 3);
    dbg_acc(acc, 11, bf2f(kp[0]), x1 * cr - x2 * sr); dbg_acc(acc, 11, bf2f(kp[4]), x1 * sr + x2 * cr);
}
__device__ __forceinline__ void chk_qkv(const Ctx& C, const Args& a, unsigned char* ws, float* acc) {
    const int gt = C.bid * 512 + C.tid; if (gt >= 4096) return;
    const unsigned hs = hash32(gt * 79u + 29u); const int t = hs % T, h = (hs >> 14) & 15, j = (hs >> 18) & 127, kind = gt & 3; const float QS = (ATT_FP8 ? 8.0f : 1.0f) * 0.07216878364870322f * 1.4426950408889634f;
    const bf16_t* cq = (const bf16_t*)(ws + AR_CQN) + (size_t)t * 256; const bf16_t* ck = (const bf16_t*)(ws + AR_CKVN) + (size_t)t * 256;
    const size_t qo = ((size_t)h * T + t) * MDK; const int tau = t & 63, pos = 32 * ((tau >> 2) & 1) + (tau & 3) + 4 * ((tau >> 3) & 3) + 16 * (tau >> 5);
#if ATT_FP8
#define QV(i) fp8f(ws + AR_Q8 + qo + (i))
#define KV(i) fp8f(ws + AR_K8 + qo + (i))
#define VV(i) fp8f(ws + AR_V8T + ((size_t)h * MDV + (i)) * T + (t & ~63) + pos)
#else
#define QV(i) bf2f(((const bf16_t*)(ws + AR_Q))[qo + (i)])
#define KV(i) bf2f(((const bf16_t*)(ws + AR_K))[qo + (i)])
#define VV(i) bf2f(((const bf16_t*)(ws + AR_V))[((size_t)h * T + t) * MDV + (i)])
#endif
    if (kind == 0) dbg_acc(acc, 12, QV(j), dotA(cq, (const float*)a.in[14], 256, 3072, 192 * h + j) * QS);
    else if (kind == 1) { const int f = j & 31; const float x1 = dotA(cq, (const float*)a.in[14], 256, 3072, 192 * h + 128 + f), x2 = dotA(cq, (const float*)a.in[14], 256, 3072, 192 * h + 160 + f);
        const float cr = ((const float*)(ws + WS_CS))[(size_t)t * 64 + f], sr = ((const float*)(ws + WS_CS))[(size_t)t * 64 + 32 + f]; const int qp = 128 + 8 * (f >> 2) + (f & 3);
        dbg_acc(acc, 12, QV(qp), (x1 * cr - x2 * sr) * QS); dbg_acc(acc, 12, QV(qp + 4), (x1 * sr + x2 * cr) * QS);
        const float* row = (const float*)(ws + AR_CIN) + (size_t)t * 512; const float k1 = row[384 + f], k2 = row[416 + f];
        dbg_acc(acc, 12, KV(qp), k1 * cr - k2 * sr); dbg_acc(acc, 12, KV(qp + 4), k1 * sr + k2 * cr); }
    else if (kind == 2) dbg_acc(acc, 12, KV(j), dotA(ck, (const float*)a.in[16], 128, 4096, 256 * h + j));
    else dbg_acc(acc, 12, VV(j), dotA(ck, (const float*)a.in[16], 128, 4096, 256 * h + 128 + j));
#undef QV
#undef KV
#undef VV
}
__device__ __forceinline__ void chk_attn(const Ctx& C, unsigned char* ws, float* acc) {
    if (C.bid >= 64) return;
    float* P = (float*)C.lds; float* red = P + T; float* qs = red + 32;
    const unsigned hs = hash32(C.bid * 991u + 77u); const int t = hs % T, h = (hs >> 14) & 15;
#if ATT_FP8
    const unsigned char* Q = ws + AR_Q8 + ((size_t)h * T + t) * MDK; const unsigned char* K = ws + AR_K8 + (size_t)h * T * MDK; const unsigned char* V = ws + AR_V8T + (size_t)h * MDV * T; const float SC = 0.125f;
    if (C.tid < MDK) qs[C.tid] = fp8f(Q + C.tid);
#define KEL(j, d) fp8f(K + (size_t)(j) * MDK + (d))
#define VEL(j, d) fp8f(V + (size_t)(d) * T + ((j) & ~63) + 32 * ((((j) & 63) >> 2) & 1) + ((j) & 3) + 4 * ((((j) & 63) >> 3) & 3) + 16 * (((j) & 63) >> 5))
#else
    const bf16_t* Q = (const bf16_t*)(ws + AR_Q) + ((size_t)h * T + t) * MDK; const bf16_t* K = (const bf16_t*)(ws + AR_K) + (size_t)h * T * MDK; const bf16_t* V = (const bf16_t*)(ws + AR_V) + (size_t)h * T * MDV; const float SC = 1.0f;
    if (C.tid < MDK) qs[C.tid] = bf2f(Q[C.tid]);
#define KEL(j, d) bf2f(K[(size_t)(j) * MDK + (d)])
#define VEL(j, d) bf2f(V[(size_t)(j) * MDV + (d)])
#endif
    __syncthreads();
    float mx = -1e30f;
    for (int j = C.tid; j < T; j += 512) { float s = 0.f; for (int d = 0; d < MDK; ++d) s += qs[d] * KEL(j, d); s *= SC; P[j] = s; mx = fmaxf(mx, s); }
    mx = wave_max(mx); if (C.lane == 0) red[C.wave] = mx;
    __syncthreads();
    mx = red[0]; for (int w = 1; w < 8; ++w) mx = fmaxf(mx, red[w]);
    float sm = 0.f; for (int j = C.tid; j < T; j += 512) { const float p = exp2f(P[j] - mx); P[j] = p; sm += p; }
    sm = wave_sum(sm);
    __syncthreads();
    if (C.lane == 0) red[8 + C.wave] = sm;
    __syncthreads();
    sm = 0.f; for (int w = 0; w < 8; ++w) sm += red[8 + w];
    if (C.tid < MDV) { float o = 0.f; for (int j = 0; j < T; ++j) o += P[j] * VEL(j, C.tid); const float got = (ATT_FP8 && MLA_FP8) ? fp8f(ws + AR_O + (size_t)t * 2048 + 128 * h + C.tid) * (1.0f / 64.f) : bf2f(((const bf16_t*)(ws + AR_O))[(size_t)t * 2048 + 128 * h + C.tid]); dbg_acc(acc, 13, got * 100.f, o / sm * 100.f); }
    __syncthreads();
#undef KEL
#undef VEL
}
__device__ __forceinline__ void dbg_report(const Ctx& C, unsigned char* ws, float* out, int lo, int hi) {
    const float* acc = (const float*)(ws + WS_DBG); const unsigned* dw = (const unsigned*)(ws + WS_DBG + 1024);
    int code = 90;
    for (int s = lo; s < hi && code == 90; ++s) { float num = __hip_atomic_load(acc + 2 * s, __ATOMIC_RELAXED, __HIP_MEMORY_SCOPE_AGENT), den = __hip_atomic_load(acc + 2 * s + 1, __ATOMIC_RELAXED, __HIP_MEMORY_SCOPE_AGENT);
        if (s == 5) { unsigned viol = __hip_atomic_load(dw + 48, __ATOMIC_RELAXED, __HIP_MEMORY_SCOPE_AGENT); for (int e = 0; e < 16; ++e) { const unsigned cnt = __hip_atomic_load(dw + e, __ATOMIC_RELAXED, __HIP_MEMORY_SCOPE_AGENT), mn = ~__hip_atomic_load(dw + 16 + e, __ATOMIC_RELAXED, __HIP_MEMORY_SCOPE_AGENT), mxu = __hip_atomic_load(dw + 32 + e, __ATOMIC_RELAXED, __HIP_MEMORY_SCOPE_AGENT); if (cnt != CAP) viol += 1000; if (mn < mxu) viol += 1; }
            num = (float)viol; den = 1.f; if (viol == 0) continue; code = 10 * (s - lo) + (viol >= 1000 ? 0 : (viol >= 100 ? 1 : (viol >= 10 ? 2 : 3))); break; }
        if (den == 0.f && num == 0.f) continue;
        const float e = sqrtf(num / den);
        if (!(e < 0.03f)) { const int b = !(e < 1.f) ? 0 : (e >= 0.3f ? 1 : (e >= 0.1f ? 2 : 3)); code = 10 * (s - lo) + b; } }
    if (code == 90) { float worst = 0.f; for (int s = lo; s < hi; ++s) { if (s == 5) continue; const float num = acc[2 * s], den = acc[2 * s + 1]; if (den > 0.f) worst = fmaxf(worst, sqrtf(num / den)); }
        code = 90 + (worst >= 0.01f ? 1 : (worst >= 0.003f ? 2 : 3)); }
#ifdef DBGSLOT
    { const int sl = DBGSLOT; const float num = acc[2 * sl], den = acc[2 * sl + 1]; const float e = sqrtf(num / den); code = !(e > 0.f) ? 99 : (e >= 1.f ? 0 : (int)fminf(89.f, -20.f * log10f(e))); }
#endif
    if (DBG >= 2) { const int sl = DBG == 2 ? 13 : 12; const float num = acc[2 * sl], den = acc[2 * sl + 1]; const float e = sqrtf(num / den); code = !(e > 0.f) ? 99 : (e >= 1.f ? 0 : (int)fminf(89.f, -20.f * log10f(e))); }
    const float c = sqrtf((float)code);
    for (size_t i = (size_t)C.bid * 512 + C.tid; i < (size_t)T * D; i += (size_t)C.nb * 512) out[i] = c;
}
#endif

constexpr int NPHASE = 24;
__global__ void __launch_bounds__(512, 2) mk_fwd(Args args) {
    extern __shared__ __attribute__((aligned(16))) unsigned char lds[];
    Ctx C; C.tid = threadIdx.x; C.lane = C.tid & 63; C.wave = __builtin_amdgcn_readfirstlane(C.tid >> 6); C.bid = blockIdx.x; C.nb = gridDim.x;
    C.gw = C.bid * 8 + C.wave; C.ngw = C.nb * 8; C.lds = lds;
    unsigned char* ws = args.ws;
    volatile LAS unsigned* MISC = (volatile LAS unsigned*)((LAS unsigned char*)lds + LDS_MISC);
    if (C.tid < 32) MISC[C.tid] = 0u;
    __syncthreads();
    XcdBarrier bar = xcd_barrier_post((unsigned*)(ws + WS_CTL) + 4096 + args.li * XCD_BAR_WORDS, MISC + 8);
    const int lo = args.ph_lo, hi = args.ph_hi;
#if defined(PH_MASK)
#define IN(k) ((((PH_MASK) >> (k)) & 1u) && lo <= (k) && (k) < hi)
#elif defined(PH_ONLY)
#define IN(k) ((k) == PH_ONLY && lo <= (k) && (k) < hi)
#else
#define IN(k) (lo <= (k) && (k) < hi)
#endif
#ifndef PROBE_MUL
#define PROBE_MUL 3
#endif
#ifdef PROBE_PH
    volatile LAS unsigned long long* tpw_ = (volatile LAS unsigned long long*)((LAS unsigned char*)lds + LDS_MISC + 64);
#define PROBE_T0(k) do { if ((k) == PROBE_PH && C.bid == 0 && C.tid == 0) tpw_[0] = wall_clock64(); } while (0)
#define SEAM(k) do { if (IN((k) + 1)) xcd_barrier(bar); if ((k) == PROBE_PH && C.bid == 0 && C.tid == 0) tpw_[1] += wall_clock64() - tpw_[0]; } while (0)
#else
#define PROBE_T0(k) do { } while (0)
#define SEAM(k) do { if (IN((k) + 1)) xcd_barrier(bar); } while (0)
#endif
#ifndef REPMASK
#define REPMASK 0u
#endif
#define NREP(k) ((((REPMASK) >> (k)) & 1u) ? 2 : 1)
#ifdef DBG
    float* dacc = (float*)(ws + WS_DBG); unsigned* ddw = (unsigned*)(ws + WS_DBG + 1024);
#define DBGCHK(page, call) do { if ((DBG >= 2 ? 1 : DBG) == (page)) { call; xcd_barrier(bar); } } while (0)
#else
#define DBGCHK(page, call) do { } while (0)
#endif
    PG8_LAS unsigned char* glds = (PG8_LAS unsigned char*)lds;
    const float* x = (const float*)args.in[0];
#define HA (args.out)
#define HB ((float*)(ws + WS_HB))
#define XN ((bf16_t*)(ws + WS_XN))
#define AFF ((float*)(ws + WS_AFF))
#define SEL ((int*)(ws + WS_SEL))
#define IDX ((int*)(ws + WS_IDX))
#define WGU ((bf16_t*)(ws + WS_WGU))
#define WD ((bf16_t*)(ws + WS_WD))
#define XS ((bf16_t*)(ws + AR_XS))
#define HH ((bf16_t*)(ws + AR_H))
#define YY ((bf16_t*)(ws + AR_Y))

    if (IN(0)) { PROBE_T0(0); if (MLA_ABSORB) ph_mla_absorb(C, args, ws); ph_convert_small(C, args, ws); ph_convert_moe(C, args, ws, 0, NREP(0), 0, CV_NIT, C.gw, C.ngw); ph_norm(C, x, (const float*)args.in[2], XN); SEAM(0); }
    if (IN(1)) { PROBE_T0(1);
        { pg8::Gemm g{XN, (const bf16_t*)(ws + WS_WGIN), T, 3072, 1024}; pg8::StaticOrder S; S.init(T, 3072, C.nb, C.bid); S.rep = NREP(1);
          pg8::EpiGlaIn E{(bf16_t*)(ws + AR_Q0), (bf16_t*)(ws + AR_K0), (bf16_t*)(ws + AR_SR), (float*)(ws + AR_GF), (float*)(ws + AR_GB), (const float*)args.in[7], (const float*)args.in[9]};
          pg8::gemm_phase<pg8::EpiGlaIn, pg8::StaticOrder, false, PG8_SP2>(glds, g, S, E); }
        { pg8::Gemm g{(const bf16_t*)(ws + WS_WV), XN, 1024, T, 1024}; pg8::StaticOrder S; S.init(1024, T, C.nb, C.bid); S.rep = NREP(1);
          pg8::EpiBf E{(bf16_t*)(ws + AR_VT), T};
          pg8::gemm_phase<pg8::EpiBf, pg8::StaticOrder, PG8_ALIGN, PG8_SP2>(glds, g, S, E); }
        SEAM(1); } DBGCHK(0, chk_p1(C, args, ws, dacc));
#if GLA256
    if (IN(2)) { PROBE_T0(2); ph_gla_prep2(C, (const bf16_t*)(ws + AR_Q0), (const bf16_t*)(ws + AR_K0), (const float*)(ws + AR_GF), (const float*)(ws + AR_GB), (bf16_t*)(ws + AR_QDF), (bf16_t*)(ws + AR_QDB),
                             (bf16_t*)(ws + AR_KDF), (bf16_t*)(ws + AR_KDB), (bf16_t*)(ws + AR_KTF), (bf16_t*)(ws + AR_KTB), (float*)(ws + WS_EGL));
        if (IN(3) && C.nb == GH * GNC2) { asm volatile("s_waitcnt vmcnt(0)" ::: "memory"); __syncthreads(); }
        else SEAM(2); }
    if (IN(3)) { PROBE_T0(3); ph_gla_u2(C, (const bf16_t*)(ws + AR_VT), (const bf16_t*)(ws + AR_KTF), (const bf16_t*)(ws + AR_KTB), (const float*)(ws + WS_EGL), (bf16_t*)(ws + AR_U)); SEAM(3); }
    if (IN(4)) { PROBE_T0(4); ph_gla_scan2(C, (const bf16_t*)(ws + AR_U), (const float*)(ws + WS_EGL), (bf16_t*)(ws + AR_ST)); SEAM(4); }
    if (IN(5)) { PROBE_T0(5); ph_gla_out2(C, (const bf16_t*)(ws + AR_QDF), (const bf16_t*)(ws + AR_QDB), (const bf16_t*)(ws + AR_KDF), (const bf16_t*)(ws + AR_KDB), (const bf16_t*)(ws + AR_VT), (const bf16_t*)(ws + AR_ST),
                            (const bf16_t*)(ws + AR_SR), (const float*)args.in[10], XN); SEAM(5); } DBGCHK(0, chk_gla(C, args, ws, dacc));
#else
    if (IN(2)) for (int rep_ = 0; rep_ < NREP(2); ++rep_) { PROBE_T0(2); ph_gla_prep(C, (const bf16_t*)(ws + AR_Q0), (const bf16_t*)(ws + AR_K0), (const float*)(ws + AR_GF), (const float*)(ws + AR_GB), (bf16_t*)(ws + AR_QDF), (bf16_t*)(ws + AR_QDB),
                             (bf16_t*)(ws + AR_KDF), (bf16_t*)(ws + AR_KDB), (bf16_t*)(ws + AR_KTF), (bf16_t*)(ws + AR_KTB), (float*)(ws + WS_EGL)); SEAM(2); }
    if (IN(3)) for (int rep_ = 0; rep_ < NREP(3); ++rep_) { PROBE_T0(3); ph_gla_u(C, (const bf16_t*)(ws + AR_VT), (const bf16_t*)(ws + AR_KTF), (const bf16_t*)(ws + AR_KTB), (const float*)(ws + WS_EGL), (bf16_t*)(ws + AR_U)); SEAM(3); }
    if (IN(4)) for (int rep_ = 0; rep_ < NREP(4); ++rep_) { PROBE_T0(4); ph_gla_scan(C, (const bf16_t*)(ws + AR_U), (const float*)(ws + WS_EGL), (bf16_t*)(ws + AR_ST)); SEAM(4); }
    if (IN(5)) for (int rep_ = 0; rep_ < NREP(5); ++rep_) { PROBE_T0(5); ph_gla_out(C, (const bf16_t*)(ws + AR_QDF), (const bf16_t*)(ws + AR_QDB), (const bf16_t*)(ws + AR_KDF), (const bf16_t*)(ws + AR_KDB), (const bf16_t*)(ws + AR_VT), (const bf16_t*)(ws + AR_ST),
                            (const bf16_t*)(ws + AR_SR), (const float*)args.in[10], XN); SEAM(5); } DBGCHK(0, chk_gla(C, args, ws, dacc));
#endif
    if (IN(6)) { PROBE_T0(6); pg8::Gemm g{XN, (const bf16_t*)(ws + WS_WGOUT), T, 1024, 1024}; pg8::StaticOrder S; S.init(T, 1024, C.nb, C.bid); S.rep = NREP(6);
        pg8::EpiF32 E{HA, x, 1024, 1.0f}; pg8::gemm_phase<pg8::EpiF32, pg8::StaticOrder, false, PG8_SP2>(glds, g, S, E); SEAM(6); } DBGCHK(0, chk_resid(C, x, XN, 1024, (const float*)args.in[11], HA, dacc, 3));
#define MOE_LAYER(P, L, HIN, TAILMODE, HOUT, GAIN2, OUTP)                                                                                         \
    if (IN(P)) for (int rep_ = 0; rep_ < NREP(P); ++rep_) { PROBE_T0(P); ph_router(C, HIN, (const float*)args.in[3] + (L) * 1024, (const float*)args.in[18] + (L) * 1024 * 16, XN, AFF, (float*)(ws + WS_AFFT), ws + AR_XN8); SEAM(P); if ((P) == 7) DBGCHK(0, chk_router(C, HIN, (const float*)args.in[3] + (L) * 1024, (const float*)args.in[18] + (L) * 1024 * 16, XN, AFF, dacc, 4)); }       \
    if (IN(P + 1)) for (int rep_ = 0; rep_ < NREP(P + 1); ++rep_) { PROBE_T0(P + 1); ph_select(C, (const float*)(ws + WS_AFFT), SEL, IDX); if ((P) == 7 && CV_X1 > 0 && C.bid >= NE && C.nb == 256) ph_convert_moe(C, args, ws, 1, 1, 0, CV_X1, (C.bid - NE) * 8 + C.wave, (256 - NE) * 8); SEAM(P + 1); if ((P) == 7) DBGCHK(0, chk_select(C, AFF, SEL, IDX, ddw)); }                                                                                 \
    if (IN(P + 2)) for (int rep_ = 0; rep_ < NREP(P + 2); ++rep_) { PROBE_T0(P + 2); ph_gather(C, IDX, XN, XS, ws + AR_XN8); SEAM(P + 2); }                                                                                   \
    if (IN(P + 3)) { PROBE_T0(P + 3); pg8::Gemm g{XS, (const bf16_t*)((const unsigned char*)WGU + (size_t)((MOE_FP8 && CONV_OVERLAP) ? (L) : 0) * (64 * MiB)), NE * CAP, 4096, MOE_FP8 ? 512 : 1024}; pg8::GroupedOrder S; S.init(NE * CAP, 4096, C.nb, C.bid); S.rep = NREP(P + 3); pg8::EpiMoe1 E{HH};     \
        pg8::gemm_phase<pg8::EpiMoe1, pg8::GroupedOrder, PG8_ALIGN, false, MOE_FP8 != 0>(glds, g, S, E); SEAM(P + 3); if ((P) == 7) DBGCHK(0, chk_moe_h(C, args, ws, L, dacc, 6)); }                                       \
    if (IN(P + 4)) { PROBE_T0(P + 4); pg8::Gemm g{HH, (const bf16_t*)((const unsigned char*)WD + (size_t)((MOE_FP8 && CONV_OVERLAP) ? (L) : 0) * (32 * MiB)), NE * CAP, 1024, MOE_FP8 ? 1024 : 2048}; pg8::GroupedOrder S; S.init(NE * CAP, 1024, C.nb, C.bid); S.rep = NREP(P + 4); pg8::EpiMoe2 E{YY};      \
        pg8::gemm_phase<pg8::EpiMoe2, pg8::GroupedOrder, PG8_ALIGN, false, MOE_FP8 != 0>(glds, g, S, E); SEAM(P + 4); if ((P) == 7) DBGCHK(0, chk_moe_y(C, args, ws, L, dacc, 7)); }                                       \
    if (IN(P + 5)) for (int rep_ = 0; rep_ < NREP(P + 5); ++rep_) { PROBE_T0(P + 5); ph_combine<TAILMODE>(C, HIN, AFF, SEL, YY, HOUT, GAIN2, XN, OUTP); SEAM(P + 5); if ((P) == 7) DBGCHK(0, chk_combine(C, ws, HIN, HOUT, dacc, 8)); }

    MOE_LAYER(7, 0, HA, 1, HB, (const float*)args.in[2] + 1024, nullptr)
    if (IN(13)) { PROBE_T0(13); pg8::Gemm g{XN, (const bf16_t*)(ws + WS_WMIN), T, 512, MLA_FP8 ? 512 : 1024}; pg8::StaticOrder S; S.init(T, 512, C.nb, C.bid); S.rep = NREP(13);
        pg8::EpiF32 E{(float*)(ws + AR_CIN), nullptr, 512, MLA_FP8 ? 0.03125f : 1.0f}; pg8::gemm_phase<pg8::EpiF32, pg8::StaticOrder, false, false, MLA_FP8 != 0>(glds, g, S, E);
        if (CV_X2 > CV_X1 && C.bid >= 128 && C.nb == 256) ph_convert_moe(C, args, ws, 1, 1, CV_X1, CV_X2, (C.bid - 128) * 8 + C.wave, 128 * 8); SEAM(13); } DBGCHK(1, chk_cin(C, args, ws, dacc));
    if (IN(14)) { PROBE_T0(14);
#if MLA_ABSORB
        ph_mla_tok_abs(C, (const float*)(ws + AR_CIN), (const int*)args.in[1], (const float*)args.in[13], (const float*)args.in[15], args.invf, (bf16_t*)(ws + AR_CQN), (float*)(ws + WS_CS), ws + AR_K8, ws + AR_V8T);
#else
        ph_mla_tok(C, (const float*)(ws + AR_CIN), (const int*)args.in[1], (const float*)args.in[13], (const float*)args.in[15], args.invf, (bf16_t*)(ws + AR_CQN), (bf16_t*)(ws + AR_CKVN),
                             (float*)(ws + WS_CS), (bf16_t*)(ws + AR_K));
#endif
        ph_convert_moe(C, args, ws, 1, 1, C.nb == 256 ? CV_X2 : 0, CV_NIT, C.gw, C.ngw); SEAM(14); } DBGCHK(1, chk_tok(C, args, ws, dacc));
    if (IN(15)) { PROBE_T0(15);
#if ATT_FP8
        { constexpr int NQ_ = MLA_ABSORB ? 3072 : 4096; pg8::Gemm g{(const bf16_t*)(ws + AR_CQN), (const bf16_t*)(ws + WS_WUQ), T, NQ_, 256}; pg8::StaticOrder S; S.init(T, NQ_, C.nb, C.bid); S.rep = NREP(15);
          pg8::EpiQ8 E{ws + AR_Q8, (const float*)(ws + WS_CS)}; pg8::gemm_phase<pg8::EpiQ8, pg8::StaticOrder, PG8_ALIGN, PG8_SP2>(glds, g, S, E); }
        if (!MLA_ABSORB) { pg8::Gemm g{(const bf16_t*)(ws + AR_CKVN), (const bf16_t*)(ws + WS_WUKV), T, 2048, 256}; pg8::StaticOrder S; S.init(T, 2048, C.nb, C.bid); S.rep = NREP(15);
          pg8::EpiK8 E{ws + AR_K8}; pg8::gemm_phase<pg8::EpiK8, pg8::StaticOrder, PG8_ALIGN, PG8_SP2>(glds, g, S, E); }
        if (!MLA_ABSORB) { pg8::Gemm g{(const bf16_t*)(ws + WS_WUKV) + (size_t)2048 * 256, (const bf16_t*)(ws + AR_CKVN), 2048, T, 256}; pg8::StaticOrder S; S.init(2048, T, C.nb, C.bid); S.rep = NREP(15);
          pg8::EpiV8T E{ws + AR_V8T}; pg8::gemm_phase<pg8::EpiV8T, pg8::StaticOrder, PG8_ALIGN, PG8_SP2>(glds, g, S, E); }
#else
        { pg8::Gemm g{(const bf16_t*)(ws + AR_CQN), (const bf16_t*)(ws + WS_WUQ), T, 4096, 256}; pg8::StaticOrder S; S.init(T, 4096, C.nb, C.bid); S.rep = NREP(15);
          pg8::EpiQup E{(bf16_t*)(ws + AR_Q), (const float*)(ws + WS_CS)}; pg8::gemm_phase<pg8::EpiQup, pg8::StaticOrder, PG8_ALIGN, PG8_SP2>(glds, g, S, E); }
        { pg8::Gemm g{(const bf16_t*)(ws + AR_CKVN), (const bf16_t*)(ws + WS_WUKV), T, 4096, 256}; pg8::StaticOrder S; S.init(T, 4096, C.nb, C.bid); S.rep = NREP(15);
          pg8::EpiKVup E{(bf16_t*)(ws + AR_K), (bf16_t*)(ws + AR_V)}; pg8::gemm_phase<pg8::EpiKVup, pg8::StaticOrder, PG8_ALIGN, PG8_SP2>(glds, g, S, E); }
#endif
        SEAM(15); } DBGCHK(1, chk_qkv(C, args, ws, dacc));
    if (IN(16)) { PROBE_T0(16);
        const int nun = MH * (T / 256);
        for (int ii = 0; ii * C.nb + C.bid < nun * NREP(16); ++ii) { const int i = ii % (nun / C.nb);
            int h, qb; if (C.nb == 256) { h = (C.bid & 7) + 8 * (i >> 1); qb = (i & 1) * 32 + (C.bid >> 3); } else { const int u = i * C.nb + C.bid; h = u >> 6; qb = u & 63; }
#if ATT_FP8 && ATT8_DMA && MLA_ABSORB
            att8::attn_body_dma(ws + AR_Q8 + ((size_t)h * T + (size_t)qb * 256) * MDK, ws + AR_K8, ws + AR_V8T, ws + AR_O + (size_t)qb * 256 * 2048 + 128 * h, 2048, (char*)lds);
#elif ATT_FP8
            att8::attn_body(ws + AR_Q8 + ((size_t)h * T + (size_t)qb * 256) * MDK, ws + AR_K8 + (MLA_ABSORB ? (size_t)0 : (size_t)h * T * MDK), ws + AR_V8T + (MLA_ABSORB ? (size_t)0 : (size_t)h * MDV * T),
                            MLA_FP8 ? (bf16_t*)(ws + AR_O + (size_t)qb * 256 * 2048 + 128 * h) : (bf16_t*)(ws + AR_O) + (size_t)qb * 256 * 2048 + 128 * h, 2048, T, (char*)lds);
#else
            const bf16_t* Qb = (const bf16_t*)(ws + AR_Q) + ((size_t)h * T + (size_t)qb * 256) * MDK;
            att::attn_body(Qb, (const bf16_t*)(ws + AR_K) + (size_t)h * T * MDK, (const bf16_t*)(ws + AR_V) + (size_t)h * T * MDV, (bf16_t*)(ws + AR_O) + (size_t)qb * 256 * 2048 + 128 * h, 2048, T, (char*)lds);
#endif
            __syncthreads();
        }
        SEAM(16); } DBGCHK(1, chk_attn(C, ws, dacc));
    if (IN(17)) { PROBE_T0(17); pg8::Gemm g{(const bf16_t*)(ws + AR_O), (const bf16_t*)(ws + WS_WMOUT), T, 1024, MLA_FP8 ? 1024 : 2048}; pg8::StaticOrder S; S.init(T, 1024, C.nb, C.bid); S.rep = NREP(17);
        pg8::EpiF32 E{HA, HB, 1024, MLA_FP8 ? 0.03125f / 64.f : 1.0f}; pg8::gemm_phase<pg8::EpiF32, pg8::StaticOrder, false, false, MLA_FP8 != 0>(glds, g, S, E); SEAM(17); } DBGCHK(1, chk_resid(C, HB, (const bf16_t*)(ws + AR_O), 2048, (const float*)args.in[17], HA, dacc, 14));
    MOE_LAYER(18, 1, HA, 2, nullptr, (const float*)args.in[4], args.out)
#ifdef PROBE_PH
    if (C.bid == 0 && C.tid == 0) { const unsigned long long t_ = wall_clock64(), d_ = (unsigned long long)PROBE_MUL * tpw_[1]; while (wall_clock64() - t_ < d_) __builtin_amdgcn_s_sleep(32); }
    __syncthreads();
#endif
#ifdef DBG
    xcd_barrier(bar); dbg_report(C, ws, args.out, DBG == 0 ? 0 : 10, DBG == 0 ? 10 : 20);
#endif
#undef IN
#undef SEAM
#undef HA
#undef HB
#undef XN
#undef AFF
#undef SEL
#undef IDX
#undef WGU
#undef WD
#undef XS
#undef HH
#undef YY
}

#ifndef MK_N_LAUNCHES
#define MK_N_LAUNCHES 1
#endif
extern "C" void kernel_launch(void* const* d_in, const int* in_sizes, int n_in, void* d_out, int out_size, void* d_ws, size_t ws_size, hipStream_t stream) {
    static int grid = 0;
    if (grid == 0) {
        if (n_in != 22 || out_size != T * D || ws_size < WS_END) { fprintf(stderr, "kernel_launch: unexpected shapes (n_in %d out %d ws %zu, need ws >= %zu)\n", n_in, out_size, ws_size, (size_t)WS_END); grid = -1; return; }
        int dev = 0, cus = 0, per_cu = 0;
        if (hipGetDevice(&dev) != hipSuccess || hipDeviceGetAttribute(&cus, hipDeviceAttributeMultiprocessorCount, dev) != hipSuccess) { grid = -1; return; }
        if (hipFuncSetAttribute((const void*)mk_fwd, hipFuncAttributeMaxDynamicSharedMemorySize, LDS_BYTES) != hipSuccess) { fprintf(stderr, "kernel_launch: hipFuncSetAttribute failed\n"); grid = -1; return; }
        if (hipOccupancyMaxActiveBlocksPerMultiprocessor(&per_cu, (const void*)mk_fwd, 512, LDS_BYTES) != hipSuccess || per_cu < 1) fprintf(stderr, "kernel_launch: occupancy query says %d\n", per_cu);
        (void)hipGetLastError();
        grid = cus;
    }
    if (grid < 0) return;
    (void)hipMemsetAsync((char*)d_ws + WS_CTL, 0, CTL_ZERO_BYTES, stream);
    Args a{};
    for (int i = 0; i < 22; ++i) a.in[i] = d_in[i];
    a.out = (float*)d_out; a.ws = (unsigned char*)d_ws;
    for (int i = 0; i < 32; ++i) a.invf[i] = powf(10000.0f, -(float)i / 32.0f);
    if (MK_N_LAUNCHES == 1) { a.ph_lo = 0; a.ph_hi = NPHASE; a.li = 0; hipLaunchKernelGGL(mk_fwd, dim3(grid), dim3(512), LDS_BYTES, stream, a); }
    else { for (int p = 0; p < NPHASE; ++p) { a.ph_lo = p; a.ph_hi = p + 1; a.li = p; hipLaunchKernelGGL(mk_fwd, dim3(grid), dim3(512), LDS_BYTES, stream, a); } }
}
```

```cpp
#include <hip/hip_runtime.h>
#include <cstdio>
#include <cstdint>
#include <cmath>

constexpr int T = 16384, D = 1024, NE = 16, CAP = 2048, FF = 2048;
constexpr int GH = 4, GDK = 128, GDV = 256, GC = 64, GNC = T / GC;
constexpr int MH = 16, MDK = 192, MDV = 128;
constexpr float RMS_EPS = 1e-6f;

typedef unsigned short bf16_t;
typedef short bf16x8 __attribute__((ext_vector_type(8)));
typedef short s16x4 __attribute__((ext_vector_type(4)));
typedef float f32x4 __attribute__((ext_vector_type(4)));
typedef float f32x2 __attribute__((ext_vector_type(2)));
typedef float f32x16 __attribute__((ext_vector_type(16)));
typedef unsigned u32x4 __attribute__((ext_vector_type(4)));
typedef unsigned u32x2 __attribute__((ext_vector_type(2)));
typedef int i32x8 __attribute__((ext_vector_type(8)));
#ifndef MOE_FP8
#define MOE_FP8 1
#endif
#ifndef CONV_OVERLAP
#define CONV_OVERLAP 1
#endif
#ifndef GLA256
#define GLA256 1
#endif
#ifndef MLA_FP8
#define MLA_FP8 1
#endif
#ifndef MLA_ABSORB
#define MLA_ABSORB 1
#endif
#ifndef ATT8_DMA
#define ATT8_DMA 1
#endif
#ifndef ATT_FP8
#define ATT_FP8 1
#endif

constexpr size_t MiB = 1u << 20;
constexpr size_t WS_CTL = 0, CTL_ZERO_BYTES = 512 * 1024;
constexpr size_t WS_WGIN = 1 * MiB;
constexpr size_t WS_WV = 7 * MiB;
constexpr size_t WS_WGOUT = 9 * MiB;
constexpr size_t WS_WMIN = 11 * MiB;
constexpr size_t WS_WUQ = 12 * MiB;
constexpr size_t WS_WUKV = 14 * MiB;
constexpr size_t WS_WMOUT = 16 * MiB;
constexpr size_t WS_WGU = 20 * MiB;
constexpr size_t WS_WD = 148 * MiB;
constexpr size_t WS_AFF = 212 * MiB;
constexpr size_t WS_SEL = 213 * MiB;
constexpr size_t WS_IDX = 214 * MiB;
constexpr size_t WS_EGL = 215 * MiB;
constexpr size_t WS_CS = 216 * MiB;
constexpr size_t WS_XN = 220 * MiB;
constexpr size_t WS_HB = 252 * MiB;
constexpr size_t WS_AR = 316 * MiB;
constexpr size_t WS_AFFT = 828 * MiB;
constexpr size_t WS_END = 829 * MiB;
constexpr size_t AR_Q0 = WS_AR, AR_K0 = WS_AR + 16 * MiB, AR_GF = WS_AR + 32 * MiB, AR_GB = WS_AR + 64 * MiB, AR_SR = WS_AR + 96 * MiB, AR_VT = WS_AR + 128 * MiB;
constexpr size_t AR_QDF = WS_AR + 160 * MiB, AR_QDB = WS_AR + 176 * MiB, AR_KDF = WS_AR + 192 * MiB, AR_KDB = WS_AR + 208 * MiB, AR_KTF = WS_AR + 224 * MiB, AR_KTB = WS_AR + 240 * MiB;
constexpr size_t AR_U = WS_AR + 256 * MiB, AR_ST = WS_AR + 384 * MiB;
constexpr size_t AR_XS = WS_AR, AR_H = WS_AR + 64 * MiB, AR_Y = WS_AR + 192 * MiB, AR_XN8 = WS_AR + 256 * MiB;
constexpr size_t AR_CIN = WS_AR, AR_CQN = WS_AR + 32 * MiB, AR_CKVN = WS_AR + 40 * MiB, AR_Q = WS_AR + 48 * MiB, AR_K = WS_AR + 144 * MiB, AR_V = WS_AR + 240 * MiB, AR_O = WS_AR + 304 * MiB;

constexpr size_t AR_Q8 = AR_Q, AR_K8 = AR_K, AR_V8T = AR_V;
constexpr int LDS_BYTES = 147456;
constexpr int LDS_MISC = 135168;

__device__ __forceinline__ unsigned cvt_pk_bf16(float lo, float hi) { unsigned r; asm volatile("v_cvt_pk_bf16_f32 %0, %1, %2" : "=v"(r) : "v"(lo), "v"(hi)); return r; }
__device__ __forceinline__ float bf_lo(unsigned w) { return __uint_as_float(w << 16); }
__device__ __forceinline__ float bf_hi(unsigned w) { return __uint_as_float(w & 0xffff0000u); }
__device__ __forceinline__ float bf2f(bf16_t b) { return __uint_as_float(((unsigned)b) << 16); }
__device__ __forceinline__ bf16_t f2bf(float f) { return (bf16_t)(cvt_pk_bf16(f, 0.f) & 0xffffu); }
__device__ __forceinline__ float siluf(float x) { return x * __builtin_amdgcn_rcpf(1.f + __expf(-x)); }
__device__ __forceinline__ float logsigf(float x) { return fminf(x, 0.f) - __logf(1.f + __expf(-fabsf(x))); }
__device__ __forceinline__ void store8bf(bf16_t* p, f32x4 v0, f32x4 v1) {
    u32x4 w; w.x = cvt_pk_bf16(v0[0], v0[1]); w.y = cvt_pk_bf16(v0[2], v0[3]); w.z = cvt_pk_bf16(v1[0], v1[1]); w.w = cvt_pk_bf16(v1[2], v1[3]); *(u32x4*)p = w; }
__device__ __forceinline__ unsigned pk4fp8(float a, float b, float c, float d) { int w = __builtin_amdgcn_cvt_pk_fp8_f32(a, b, 0, false); w = __builtin_amdgcn_cvt_pk_fp8_f32(c, d, w, true); return (unsigned)w; }
__device__ __forceinline__ void store8fp8(unsigned char* p, f32x4 v0, f32x4 v1) { u32x2 w; w.x = pk4fp8(v0[0], v0[1], v0[2], v0[3]); w.y = pk4fp8(v1[0], v1[1], v1[2], v1[3]); *(u32x2*)p = w; }
__device__ __forceinline__ float fp8f(const unsigned char* p) { const unsigned w = *(const unsigned*)((size_t)p & ~(size_t)3); const int b = (int)((size_t)p & 3);
    return b == 0 ? __builtin_amdgcn_cvt_f32_fp8((int)w, 0) : b == 1 ? __builtin_amdgcn_cvt_f32_fp8((int)w, 1) : b == 2 ? __builtin_amdgcn_cvt_f32_fp8((int)w, 2) : __builtin_amdgcn_cvt_f32_fp8((int)w, 3); }
__device__ __forceinline__ float wave_sum(float v) {
#pragma unroll
    for (int o = 1; o < 64; o <<= 1) v += __shfl_xor(v, o);
    return v; }
__device__ __forceinline__ float wave_max(float v) {
#pragma unroll
    for (int o = 1; o < 64; o <<= 1) v = fmaxf(v, __shfl_xor(v, o));
    return v; }
#define LAS __attribute__((address_space(3)))
#define LDS_WAIT() asm volatile("s_waitcnt lgkmcnt(0)" ::: "memory")
#define VM_WAIT() asm volatile("s_waitcnt vmcnt(0)" ::: "memory")

namespace pg8 {
#define PG8_LAS __attribute__((address_space(3)))
typedef unsigned short bf16_t;
typedef short bf16x8 __attribute__((ext_vector_type(8)));
typedef float f32x4 __attribute__((ext_vector_type(4)));
typedef unsigned u32x4 __attribute__((ext_vector_type(4)));
constexpr int BM = 256, BK = 64, HALF = 128, HTB = HALF * BK * 2  , STAGE_BYTES = 8 * HTB, NXCD = 8, WGM = 8;

__host__ __device__ __forceinline__ int lds_byte(int r, int c) { const int st = (r >> 4) * 2 + (c >> 5), rr = r & 15, cc = c & 31, ob = rr * 64 + cc * 2; return st * 1024 + (ob ^ (((ob >> 9) & 1) << 5)); }
__host__ __device__ __forceinline__ void stage_rc(int b, int& R, int& C) { const int st = b / 1024, sb = b % 1024, swz = sb ^ (((sb >> 9) & 1) << 5); R = (st >> 1) * 16 + swz / 64; C = (st & 1) * 32 + (swz % 64) / 2; }
__host__ __device__ __forceinline__ int perm32(int rho) { const int n = rho >> 4, i = rho & 15; return 8 * (i >> 2) + 4 * n + (i & 3); }

struct Unit { int pm, pn; };
struct Gemm { const bf16_t* A; const bf16_t* Bt; int M, N, K; const int* gidx = nullptr; };

struct StaticOrder {
    int nM, nN, nwg, G, c, rep;
    __host__ __device__ void init(int M, int N, int G_, int c_) { nM = M / BM; nN = N / BM; nwg = nM * nN; G = G_; c = c_; rep = 1; }
    __host__ __device__ bool next(int i, Unit& u) const {
        if (rep > 1) { const int cnt = (nwg - c + G - 1) / G; if (cnt <= 0 || i >= cnt * rep) return false; i = i % cnt; }
        const long L = (long)i * G + c; if (L >= nwg) return false;
        int wgid = (int)L; { const int q = nwg / NXCD, r = nwg % NXCD, xcd = wgid % NXCD, off = wgid / NXCD; wgid = (xcd < r ? xcd * (q + 1) : r * (q + 1) + (xcd - r) * q) + off; }
        const int nig = WGM * nN, gid = wgid / nig, fm = gid * WGM, gsz = (nM - fm) < WGM ? (nM - fm) : WGM;
        u.pm = fm + ((wgid % nig) % gsz); u.pn = (wgid % nig) / gsz; return true;
    }
    __device__ __forceinline__ void a_ready(const Unit&) const {}
    __device__ __forceinline__ void done(const Unit&) const {}
};

struct GroupedOrder : StaticOrder {
    int nNl;
    __host__ __device__ void init(int Mtot, int Nper, int G_, int c_) { StaticOrder::init(Mtot, Nper, G_, c_); nNl = Nper / BM; }
    __host__ __device__ bool next(int i, Unit& u) const { if (!StaticOrder::next(i, u)) return false; u.pn += (u.pm >> 3) * nNl; return true; }
};

#define EPI_LOOP_ROWS for (int ai = 0; ai < 2; ++ai) _Pragma("unroll") for (int m = 0; m < 4; ++m)

struct EpiGlaIn {
    static constexpr bool PERM = true, AFTER_DRAIN = false;
    bf16_t *Q0, *K0, *SR; float *GF, *GB; const float *bF, *bB;
    __device__ __forceinline__ void operator()(const f32x4 (&acc)[2][2][4][2], const Unit& u, int wr, int wc, int fr, int fq) const {
        const int row0 = u.pm * BM + wr * 64 + fr, pn = u.pn;
#pragma unroll
        EPI_LOOP_ROWS { const size_t row = (size_t)(row0 + ai * HALF + m * 16);
#pragma unroll
            for (int bj = 0; bj < 2; ++bj) { const int cl = bj * HALF + wc * 32 + 8 * fq; f32x4 v0 = acc[ai][bj][m][0], v1 = acc[ai][bj][m][1];
                if (pn < 2) { const float s = 0.08838834764831845f; store8bf(Q0 + row * 512 + pn * 256 + cl, v0 * s, v1 * s); }
                else if (pn < 4) { store8bf(K0 + row * 512 + (pn - 2) * 256 + cl, v0, v1); }
                else if (pn < 8) {
#pragma unroll
                    for (int j = 0; j < 4; ++j) { v0[j] = siluf(v0[j]); v1[j] = siluf(v1[j]); }
                    store8bf(SR + row * 1024 + (pn - 4) * 256 + cl, v0, v1); }
                else { float* G = pn < 10 ? GF : GB; const float* b = pn < 10 ? bF : bB; const int c = ((pn - 8) & 1) * 256 + cl;
                    const f32x4 b0 = *(const f32x4*)(b + c), b1 = *(const f32x4*)(b + c + 4); f32x4 o0, o1;
#pragma unroll
                    for (int j = 0; j < 4; ++j) { o0[j] = logsigf(v0[j] + b0[j]) * 0.0625f; o1[j] = logsigf(v1[j] + b1[j]) * 0.0625f; }
                    *(f32x4*)(G + row * 512 + c) = o0; *(f32x4*)(G + row * 512 + c + 4) = o1; } } }
    }
};
struct EpiBf {
    static constexpr bool PERM = true, AFTER_DRAIN = false;
    bf16_t* O; int ldc;
    __device__ __forceinline__ void operator()(const f32x4 (&acc)[2][2][4][2], const Unit& u, int wr, int wc, int fr, int fq) const {
        const int row0 = u.pm * BM + wr * 64 + fr;
#pragma unroll
        EPI_LOOP_ROWS { bf16_t* rowp = O + (size_t)(row0 + ai * HALF + m * 16) * ldc + u.pn * BM + wc * 32 + 8 * fq;
#pragma unroll
            for (int bj = 0; bj < 2; ++bj) store8bf(rowp + bj * HALF, acc[ai][bj][m][0], acc[ai][bj][m][1]); }
    }
};
struct EpiF32 {
    static constexpr bool PERM = false, AFTER_DRAIN = false;
    float* C; const float* base; int ldc; float sc;
    __device__ __forceinline__ void operator()(const f32x4 (&acc)[2][2][4][2], const Unit& u, int wr, int wc, int fr, int fq) const {
        const int row0 = u.pm * BM + wr * 64 + fr, col0 = u.pn * BM + wc * 32 + 4 * fq;
#pragma unroll
        EPI_LOOP_ROWS { const size_t off = (size_t)(row0 + ai * HALF + m * 16) * ldc + col0;
#pragma unroll
            for (int bj = 0; bj < 2; ++bj)
#pragma unroll
                for (int n = 0; n < 2; ++n) { f32x4 v = acc[ai][bj][m][n] * sc; if (base) v = v + *(const f32x4*)(base + off + bj * HALF + n * 16); *(f32x4*)(C + off + bj * HALF + n * 16) = v; } }
    }
};
struct EpiQup {
    static constexpr bool PERM = true, AFTER_DRAIN = false;
    bf16_t* Q; const float* CS;
    __device__ __forceinline__ void operator()(const f32x4 (&acc)[2][2][4][2], const Unit& u, int wr, int wc, int fr, int fq) const {
        const int row0 = u.pm * BM + wr * 64 + fr, h = u.pn; const float QS = 0.07216878364870322f * 1.4426950408889634f;
#pragma unroll
        EPI_LOOP_ROWS { const size_t row = (size_t)(row0 + ai * HALF + m * 16); bf16_t* qrow = Q + ((size_t)h * T + row) * MDK;
            store8bf(qrow + wc * 32 + 8 * fq, acc[ai][0][m][0] * QS, acc[ai][0][m][1] * QS);
            if (wc < 2) { const int i0 = wc * 16 + 4 * fq; const f32x4 c = *(const f32x4*)(CS + row * 64 + i0), s = *(const f32x4*)(CS + row * 64 + 32 + i0);
                const f32x4 x1 = acc[ai][1][m][0], x2 = acc[ai][1][m][1];
                store8bf(qrow + 128 + wc * 32 + 8 * fq, (x1 * c - x2 * s) * QS, (x1 * s + x2 * c) * QS); } }
    }
};
struct EpiKVup {
    static constexpr bool PERM = true, AFTER_DRAIN = false;
    bf16_t *K, *V;
    __device__ __forceinline__ void operator()(const f32x4 (&acc)[2][2][4][2], const Unit& u, int wr, int wc, int fr, int fq) const {
        const int row0 = u.pm * BM + wr * 64 + fr, h = u.pn;
#pragma unroll
        EPI_LOOP_ROWS { const size_t row = (size_t)h * T + (size_t)(row0 + ai * HALF + m * 16);
            store8bf(K + row * MDK + wc * 32 + 8 * fq, acc[ai][0][m][0], acc[ai][0][m][1]);
            store8bf(V + row * MDV + wc * 32 + 8 * fq, acc[ai][1][m][0], acc[ai][1][m][1]); }
    }
};
struct EpiMoe1 {
    static constexpr bool PERM = true, AFTER_DRAIN = false;
    bf16_t* H;
    __device__ __forceinline__ void operator()(const f32x4 (&acc)[2][2][4][2], const Unit& u, int wr, int wc, int fr, int fq) const {
        const int row0 = u.pm * BM + wr * 64 + fr, j = u.pn & 15;
#pragma unroll
        EPI_LOOP_ROWS { const size_t eo = (size_t)(row0 + ai * HALF + m * 16) * FF + 128 * j + 16 * wc + 4 * fq; bf16_t* rowp = H + eo;
#pragma unroll
            for (int bj = 0; bj < 2; ++bj) { f32x4 g = acc[ai][bj][m][0], uu = acc[ai][bj][m][1];
                if (MOE_FP8) { g = g * 0.03125f; uu = uu * 0.03125f; *(unsigned*)((unsigned char*)H + eo + 64 * bj) = pk4fp8(siluf(g[0]) * uu[0], siluf(g[1]) * uu[1], siluf(g[2]) * uu[2], siluf(g[3]) * uu[3]); continue; }
                u32x2 w; w.x = cvt_pk_bf16(siluf(g[0]) * uu[0], siluf(g[1]) * uu[1]); w.y = cvt_pk_bf16(siluf(g[2]) * uu[2], siluf(g[3]) * uu[3]);
                *(u32x2*)(rowp + 64 * bj) = w; } }
    }
};
struct EpiMoe2 {
    static constexpr bool PERM = true, AFTER_DRAIN = false;
    bf16_t* Y;
    __device__ __forceinline__ void operator()(const f32x4 (&acc)[2][2][4][2], const Unit& u, int wr, int wc, int fr, int fq) const {
        const int row0 = u.pm * BM + wr * 64 + fr, j = u.pn & 3;
#pragma unroll
        EPI_LOOP_ROWS { bf16_t* rowp = Y + (size_t)(row0 + ai * HALF + m * 16) * D + 256 * j + wc * 32 + 8 * fq;
#pragma unroll
            for (int bj = 0; bj < 2; ++bj) { const float sc = MOE_FP8 ? 0.03125f : 1.0f; store8bf(rowp + bj * HALF, acc[ai][bj][m][0] * sc, acc[ai][bj][m][1] * sc); } }
    }
};

struct EpiQ8 {
    static constexpr bool PERM = true, AFTER_DRAIN = false;
    unsigned char* Q; const float* CS;
    __device__ __forceinline__ void operator()(const f32x4 (&acc)[2][2][4][2], const Unit& u, int wr, int wc, int fr, int fq) const {
        const int row0 = u.pm * BM + wr * 64 + fr, h = u.pn; const float QS = 8.0f * 0.07216878364870322f * 1.4426950408889634f;
#pragma unroll
        EPI_LOOP_ROWS { const size_t row = (size_t)(row0 + ai * HALF + m * 16); unsigned char* qrow = Q + ((size_t)h * T + row) * MDK;
            if (MLA_ABSORB) {
#pragma unroll
                for (int bj = 0; bj < 2; ++bj) { const int n = u.pn * 256 + bj * 128 + wc * 32 + 8 * fq, hh = n / 192, j0 = n - 192 * hh; unsigned char* qr_ = Q + ((size_t)hh * T + row) * MDK + j0;
                    if (j0 < 128) store8fp8(qr_, acc[ai][bj][m][0] * QS, acc[ai][bj][m][1] * QS);
                    else { const int i0 = (j0 - 128) >> 1; const f32x4 c = *(const f32x4*)(CS + row * 64 + i0), s = *(const f32x4*)(CS + row * 64 + 32 + i0); const f32x4 x1 = acc[ai][bj][m][0], x2 = acc[ai][bj][m][1];
                        store8fp8(qr_, (x1 * c - x2 * s) * QS, (x1 * s + x2 * c) * QS); } }
                continue; }
            store8fp8(qrow + wc * 32 + 8 * fq, acc[ai][0][m][0] * QS, acc[ai][0][m][1] * QS);
            if (wc < 2) { const int i0 = wc * 16 + 4 * fq; const f32x4 c = *(const f32x4*)(CS + row * 64 + i0), s = *(const f32x4*)(CS + row * 64 + 32 + i0);
                const f32x4 x1 = acc[ai][1][m][0], x2 = acc[ai][1][m][1];
                store8fp8(qrow + 128 + wc * 32 + 8 * fq, (x1 * c - x2 * s) * QS, (x1 * s + x2 * c) * QS); } }
    }
};
struct EpiK8 {
    static constexpr bool PERM = true, AFTER_DRAIN = false;
    unsigned char* K;
    __device__ __forceinline__ void operator()(const f32x4 (&acc)[2][2][4][2], const Unit& u, int wr, int wc, int fr, int fq) const {
        const int row0 = u.pm * BM + wr * 64 + fr;
#pragma unroll
        EPI_LOOP_ROWS { const size_t row = (size_t)(row0 + ai * HALF + m * 16);
#pragma unroll
            for (int bj = 0; bj < 2; ++bj) store8fp8(K + ((size_t)(2 * u.pn + bj) * T + row) * MDK + wc * 32 + 8 * fq, acc[ai][bj][m][0], acc[ai][bj][m][1]); }
    }
};
struct EpiV8T {
    static constexpr bool PERM = true, AFTER_DRAIN = false;
    unsigned char* V;
    __device__ __forceinline__ void operator()(const f32x4 (&acc)[2][2][4][2], const Unit& u, int wr, int wc, int fr, int fq) const {
        const int row0 = u.pm * BM + wr * 64 + fr;
#pragma unroll
        EPI_LOOP_ROWS { unsigned char* rowp = V + (size_t)(row0 + ai * HALF + m * 16) * T + u.pn * BM + 64 * (wc >> 1) + 16 * (wc & 1) + 4 * fq;
#pragma unroll
            for (int bj = 0; bj < 2; ++bj) { const f32x4 a = acc[ai][bj][m][0], b = acc[ai][bj][m][1];
                *(unsigned*)(rowp + bj * HALF) = pk4fp8(a[0], a[1], a[2], a[3]); *(unsigned*)(rowp + bj * HALF + 32) = pk4fp8(b[0], b[1], b[2], b[3]); } }
    }
};

typedef int i32x4g __attribute__((ext_vector_type(4)));
template <class Epi, class Sched, bool ALIGN_EPI = false, bool SP2 = false, bool F8 = false, bool GATHER = false>
__device__ __forceinline__ void gemm_phase(PG8_LAS unsigned char* lds, const Gemm g, const Sched& S, const Epi& E) {
    const int tid = threadIdx.x, wid = __builtin_amdgcn_readfirstlane(tid >> 6), lane = tid & 63, wr = wid >> 2, wc = wid & 3, fr = lane & 15, fq = lane >> 4;
    int K = g.K; asm volatile("" : "+s"(K));
    const int nt = K / BK;
    unsigned voffA[2], voffB[2];
#pragma unroll
    for (int i = 0; i < 2; ++i) { int R, C; stage_rc(tid * 16 + i * 8192, R, C); const int Rb = Epi::PERM ? ((R & ~31) + perm32(R & 31)) : R;
        voffA[i] = (unsigned)(R * K + C) * 2u; voffB[i] = (unsigned)(Rb * K + C) * 2u; }
    constexpr int GTAB = 137216;
    unsigned vAc[2][2], vAn[2][2], v23[2][2]; int gR[2]; unsigned gC[2];
    if constexpr (GATHER) {
#pragma unroll
        for (int i = 0; i < 2; ++i) { int R, C; stage_rc(tid * 16 + i * 8192, R, C); gR[i] = R; gC[i] = (unsigned)C * 2u; }
        for (int u_ = 0; u_ < 8; ++u_) { Unit uu; if (!S.next(u_, uu)) break; if (tid < 256) ((PG8_LAS int*)(lds + GTAB))[u_ * 256 + tid] = g.gidx[uu.pm * 256 + tid]; }
        asm volatile("s_waitcnt vmcnt(0) lgkmcnt(0)" ::: "memory"); __builtin_amdgcn_s_barrier(); }
#define PG8_GLOAD(dst, ui_) do { _Pragma("unroll") for (int h_ = 0; h_ < 2; ++h_) _Pragma("unroll") for (int i_ = 0; i_ < 2; ++i_) \
        dst[h_][i_] = (unsigned)((PG8_LAS const int*)(lds + GTAB))[(ui_) * 256 + h_ * 128 + gR[i_]] * (unsigned)(K * 2) + gC[i_]; } while (0)
#define VA_CUR(h) (GATHER ? vAc[h] : voffA)
#define VA_23(h) (GATHER ? v23[h] : voffA)
    const size_t kstep = (size_t)(BK * 2);
    const size_t hstep = (size_t)HALF * K * 2;
    const size_t tstep = 2 * hstep;
    const size_t hstepA = GATHER ? (size_t)0 : hstep, tstepA = GATHER ? (size_t)0 : tstep;
    const unsigned ldsw = (unsigned)wid * 1024u;
    const int aoff = lds_byte(wr * 64 + fr, fq * 8), boff = lds_byte(wc * 32 + fr, fq * 8);
    PG8_LAS unsigned char* const ldsA = lds + aoff; PG8_LAS unsigned char* const ldsB = lds + 4 * HTB + boff;
#define PG8_SA(b, h) (((b) * 2 + (h)) * HTB)
#define PG8_SB(b, h) ((4 + (b) * 2 + (h)) * HTB)
#define PG8_STAGE(bufoff, gbase, voff) do { _Pragma("unroll") for (int _i = 0; _i < 2; ++_i) \
        __builtin_amdgcn_global_load_lds((const unsigned*)((const char*)(gbase) + (voff)[_i]), (PG8_LAS unsigned*)(lds + (bufoff) + ldsw + _i * 8192), 16, 0, 0); } while (0)
#define PG8_LD8(base, off) __builtin_shufflevector(*(const PG8_LAS i32x4g*)((base) + (off)), *(const PG8_LAS i32x4g*)((base) + (off) + 1024), 0, 1, 2, 3, 4, 5, 6, 7)
#define PG8_LDA(dst, b, h) do { _Pragma("unroll") for (int m = 0; m < 4; ++m) { if constexpr (F8) dst##8[m] = PG8_LD8(ldsA, PG8_SA(b, h) + m * 2048); else { _Pragma("unroll") for (int k = 0; k < 2; ++k) dst[m][k] = *(const PG8_LAS bf16x8*)(lds + PG8_SA(b, h) + aoff + m * 2048 + k * 1024); } } } while (0)
#define PG8_LDB(dst, b, h) do { _Pragma("unroll") for (int n = 0; n < 2; ++n) { if constexpr (F8) dst##8[n] = PG8_LD8(ldsB, PG8_SA(b, h) + n * 2048); else { _Pragma("unroll") for (int k = 0; k < 2; ++k) dst[n][k] = *(const PG8_LAS bf16x8*)(lds + PG8_SB(b, h) + boff + n * 2048 + k * 1024); } } } while (0)
#define PG8_CAT(x, y) __builtin_shufflevector((i32x4g)(x), (i32x4g)(y), 0, 1, 2, 3, 4, 5, 6, 7)
#define PG8_MMA(ai, bj, At, Bt) do { __builtin_amdgcn_s_setprio(1); _Pragma("unroll") for (int m = 0; m < 4; ++m) _Pragma("unroll") for (int n = 0; n < 2; ++n) { \
        if constexpr (F8) asm volatile("v_mfma_scale_f32_16x16x128_f8f6f4 %0, %1, %2, %0, %3, %3 op_sel_hi:[0,0,0]" : "+v"(acc[ai][bj][m][n]) : "v"(Bt##8[n]), "v"(At##8[m]), "v"(scl8));     \
        else { _Pragma("unroll") for (int k = 0; k < 2; ++k) acc[ai][bj][m][n] = __builtin_amdgcn_mfma_f32_16x16x32_bf16(Bt[n][k], At[m][k], acc[ai][bj][m][n], 0, 0, 0); } } \
        __builtin_amdgcn_s_setprio(0); } while (0)
#define PG8_WAIT_V(n) asm volatile("s_waitcnt vmcnt(" #n ")" ::: "memory")
#define PG8_WAIT_L(n) asm volatile("s_waitcnt lgkmcnt(" #n ")" ::: "memory")
#define PG8_BAR __builtin_amdgcn_s_barrier()
#define PG8_SCHED __builtin_amdgcn_sched_barrier(0)
    Unit cur, nxt; int ui = 0;
    if (!S.next(0, cur)) return;
    f32x4 acc[2][2][4][2];
#pragma unroll
    for (int a = 0; a < 2; ++a)
#pragma unroll
        for (int b = 0; b < 2; ++b)
#pragma unroll
            for (int m = 0; m < 4; ++m)
#pragma unroll
                for (int n = 0; n < 2; ++n) acc[a][b][m][n] = (f32x4){0.f, 0.f, 0.f, 0.f};
    unsigned scl8 = 0x7f7f7f7fu; asm volatile("" : "+v"(scl8));
    bf16x8 At[4][2], B0[2][2], B1[2][2]; i32x8 At8[4], B08[2], B18[2];
    const char* cA = (const char*)g.A + (size_t)cur.pm * tstepA; const char* cB = (const char*)g.Bt + (size_t)cur.pn * tstep;
    S.a_ready(cur);
    if constexpr (GATHER) { PG8_GLOAD(vAc, 0); }
    if constexpr (SP2) {
        PG8_STAGE(PG8_SB(0, 0), cB, voffB); PG8_STAGE(PG8_SB(0, 1), cB + hstep, voffB); PG8_STAGE(PG8_SA(0, 0), cA, VA_CUR(0)); PG8_STAGE(PG8_SA(0, 1), cA + hstepA, VA_CUR(1));
        if (wr == 1) PG8_BAR;
        PG8_WAIT_V(2); PG8_BAR;
        PG8_STAGE(PG8_SB(1, 0), cB + kstep, voffB); PG8_STAGE(PG8_SA(1, 0), cA + kstep, VA_CUR(0)); PG8_STAGE(PG8_SB(1, 1), cB + hstep + kstep, voffB);
        PG8_WAIT_V(6); PG8_BAR;
    } else {
        PG8_STAGE(PG8_SB(0, 0), cB, voffB); PG8_STAGE(PG8_SA(0, 0), cA, VA_CUR(0)); PG8_STAGE(PG8_SB(0, 1), cB + hstep, voffB); PG8_STAGE(PG8_SA(0, 1), cA + hstepA, VA_CUR(1));
        if (wr == 1) PG8_BAR;
        PG8_WAIT_V(4); PG8_BAR;
        PG8_STAGE(PG8_SB(1, 0), cB + kstep, voffB); PG8_STAGE(PG8_SA(1, 0), cA + kstep, VA_CUR(0)); PG8_STAGE(PG8_SB(1, 1), cB + hstep + kstep, voffB);
        PG8_WAIT_V(6); PG8_BAR;
    }
    for (;;) {
        const bool has_next = S.next(ui + 1, nxt);
        const char* nA = has_next ? (const char*)g.A + (size_t)nxt.pm * tstepA : cA; const char* nB = has_next ? (const char*)g.Bt + (size_t)nxt.pn * tstep : cB;
        if constexpr (GATHER) { if (has_next) { PG8_GLOAD(vAn, ui + 1); } else {
#pragma unroll
            for (int h_ = 0; h_ < 2; ++h_) { vAn[h_][0] = vAc[h_][0]; vAn[h_][1] = vAc[h_][1]; } } }
        for (int t = 0; t < nt; t += 2) {
            const bool last = (t == nt - 2);
            const char* a1 = cA + (size_t)(t + 1) * kstep;
            const char* a2 = last ? nA : cA + (size_t)(t + 2) * kstep; const char* b2 = last ? nB : cB + (size_t)(t + 2) * kstep;
            const char* a3 = a2 + kstep; const char* b3 = b2 + kstep;
            if (last && has_next) S.a_ready(nxt);
            if constexpr (GATHER) {
#pragma unroll
                for (int h_ = 0; h_ < 2; ++h_) { v23[h_][0] = last ? vAn[h_][0] : vAc[h_][0]; v23[h_][1] = last ? vAn[h_][1] : vAc[h_][1]; } }
            if constexpr (SP2) {
            PG8_LDB(B0, 0, 0); PG8_LDB(B1, 0, 1); PG8_SCHED; PG8_LDA(At, 0, 0); PG8_STAGE(PG8_SA(1, 1), a1 + hstepA, VA_CUR(1));
            PG8_WAIT_V(8); PG8_WAIT_L(0); PG8_BAR; PG8_MMA(0, 0, At, B0); PG8_MMA(0, 1, At, B1); PG8_BAR; PG8_SCHED;
            PG8_LDA(At, 0, 1); PG8_STAGE(PG8_SB(0, 0), b2, voffB); PG8_STAGE(PG8_SB(0, 1), b2 + hstep, voffB); PG8_STAGE(PG8_SA(0, 0), a2, VA_23(0));
            PG8_WAIT_V(8); PG8_WAIT_L(0); PG8_BAR; PG8_MMA(1, 0, At, B0); PG8_MMA(1, 1, At, B1); PG8_BAR; PG8_SCHED;
            PG8_LDB(B0, 1, 0); PG8_LDB(B1, 1, 1); PG8_SCHED; PG8_LDA(At, 1, 0); PG8_STAGE(PG8_SA(0, 1), a2 + hstepA, VA_23(1));
            PG8_WAIT_V(8); PG8_WAIT_L(0); PG8_BAR; PG8_MMA(0, 0, At, B0); PG8_MMA(0, 1, At, B1); PG8_BAR; PG8_SCHED;
            PG8_LDA(At, 1, 1); PG8_STAGE(PG8_SB(1, 0), b3, voffB); PG8_STAGE(PG8_SB(1, 1), b3 + hstep, voffB); PG8_STAGE(PG8_SA(1, 0), a3, VA_23(0));
            PG8_WAIT_V(8); PG8_WAIT_L(0); PG8_BAR; PG8_MMA(1, 0, At, B0); PG8_MMA(1, 1, At, B1); PG8_BAR; PG8_SCHED;
            } else {
            PG8_LDB(B0, 0, 0); PG8_SCHED; PG8_LDA(At, 0, 0); PG8_STAGE(PG8_SA(1, 1), a1 + hstepA, VA_CUR(1));
            PG8_WAIT_L(8); PG8_BAR; PG8_WAIT_L(0); PG8_MMA(0, 0, At, B0); PG8_BAR; PG8_SCHED;
            PG8_LDB(B1, 0, 1); PG8_STAGE(PG8_SB(0, 0), b2, voffB);
            PG8_BAR; PG8_WAIT_L(0); PG8_MMA(0, 1, At, B1); PG8_BAR;
            PG8_LDA(At, 0, 1); PG8_STAGE(PG8_SA(0, 0), a2, VA_23(0));
            PG8_BAR; PG8_WAIT_L(0); PG8_MMA(1, 0, At, B0); PG8_BAR; PG8_SCHED;
            PG8_STAGE(PG8_SB(0, 1), b2 + hstep, voffB);
            PG8_WAIT_V(6); PG8_BAR; PG8_MMA(1, 1, At, B1); PG8_BAR;
            PG8_LDB(B0, 1, 0); PG8_SCHED; PG8_LDA(At, 1, 0); PG8_STAGE(PG8_SA(0, 1), a2 + hstepA, VA_23(1));
            PG8_WAIT_L(8); PG8_BAR; PG8_WAIT_L(0); PG8_MMA(0, 0, At, B0); PG8_BAR; PG8_SCHED;
            PG8_LDB(B1, 1, 1); PG8_STAGE(PG8_SB(1, 0), b3, voffB);
            PG8_BAR; PG8_WAIT_L(0); PG8_MMA(0, 1, At, B1); PG8_BAR;
            PG8_LDA(At, 1, 1); PG8_STAGE(PG8_SA(1, 0), a3, VA_23(0));
            PG8_BAR; PG8_WAIT_L(0); PG8_MMA(1, 0, At, B0); PG8_BAR; PG8_SCHED;
            PG8_STAGE(PG8_SB(1, 1), b3 + hstep, voffB);
            PG8_WAIT_V(6); PG8_BAR; PG8_MMA(1, 1, At, B1); PG8_BAR;
            }
        }
        if constexpr (F8) asm volatile("s_nop 15\n\ts_nop 15" ::: "memory");
        if constexpr (ALIGN_EPI) { if (wr == 0) PG8_BAR; }
        if constexpr (!Epi::AFTER_DRAIN) { E(acc, cur, wr, wc, fr, fq); S.done(cur); }
        if (!has_next) break;
#pragma unroll
        for (int a = 0; a < 2; ++a)
#pragma unroll
            for (int b = 0; b < 2; ++b)
#pragma unroll
                for (int m = 0; m < 4; ++m)
#pragma unroll
                    for (int n = 0; n < 2; ++n) acc[a][b][m][n] = (f32x4){0.f, 0.f, 0.f, 0.f};
        cur = nxt; cA = nA; cB = nB; ++ui;
        if constexpr (GATHER) {
#pragma unroll
            for (int h_ = 0; h_ < 2; ++h_) { vAc[h_][0] = vAn[h_][0]; vAc[h_][1] = vAn[h_][1]; } }
        if constexpr (ALIGN_EPI) { if (wr == 1) PG8_BAR; }
    }
    PG8_WAIT_V(0);
    if constexpr (!ALIGN_EPI) { if (wr == 0) PG8_BAR; }
    PG8_BAR;
    if constexpr (Epi::AFTER_DRAIN) { E.fused(acc, cur, wr, wc, fr, fq, lds, wid, lane); S.done(cur); }
#undef PG8_SA
#undef PG8_SB
#undef PG8_STAGE
#undef PG8_GLOAD
#undef VA_CUR
#undef VA_23
#undef PG8_LDA
#undef PG8_LD8
#undef PG8_LDB
#undef PG8_MMA
#undef PG8_CAT
#undef PG8_WAIT_V
#undef PG8_WAIT_L
#undef PG8_BAR
#undef PG8_SCHED
}
}
#define XB_TMO      128
#define XB_XCNT(j)  (256  + 64 * (j))
#define XB_XSUB(j)  (1280 + 64 * (j))
#define XB_XGEN(j)  (2304 + 64 * (j))
#define XB_TOP      3328
#define XB_TOPGEN   3392
#define XCD_BAR_WORDS 3456
#define XB_SPIN_CAP (1u << 18)

__device__ __forceinline__ unsigned xb_ld(unsigned* p)              { return __hip_atomic_load(p, __ATOMIC_RELAXED, __HIP_MEMORY_SCOPE_AGENT); }
__device__ __forceinline__ unsigned xb_add(unsigned* p, unsigned v) { return __hip_atomic_fetch_add(p, v, __ATOMIC_RELAXED, __HIP_MEMORY_SCOPE_AGENT); }
__device__ __forceinline__ unsigned xb_xcc_id() { return (unsigned)__builtin_amdgcn_s_getreg((3 << 11) | 20) & 0xFu; }
#define XB_SPIN(cond, bar) do { unsigned _sp = 0; while (cond) { __builtin_amdgcn_s_sleep(1); \
    if ((++_sp & 255u) == 0u) { if (xb_ld(&(bar)[XB_TMO])) break; if (_sp > XB_SPIN_CAP) { atomicAdd(&(bar)[XB_TMO], 1u); break; } } } } while (0)

struct XcdBarrier {
    unsigned* bar; unsigned x;
    volatile LAS unsigned* st;
};

__device__ __forceinline__ XcdBarrier xcd_barrier_post(unsigned* bar, volatile LAS unsigned* st) {
    XcdBarrier b; b.bar = bar; b.x = xb_xcc_id(); b.st = st;
    if (threadIdx.x == 0) (void)xb_add(&bar[XB_XCNT(b.x)], 1u);
    return b;
}
__device__ __forceinline__ void xcd_barrier_complete(unsigned* bar, unsigned x, unsigned& nloc, unsigned& nx) {
    const unsigned G = gridDim.x * gridDim.y * gridDim.z;
    unsigned sum, cnt, mine, sp = 0u;
    for (;;) {
        sum = 0u; cnt = 0u; mine = 0u;
#pragma unroll
        for (unsigned j = 0; j < 16; ++j) { const unsigned c = xb_ld(&bar[XB_XCNT(j)]); sum += c; cnt += (c > 0u) ? 1u : 0u; mine = (j == x) ? c : mine; }
        if (sum == G) break;
        __builtin_amdgcn_s_sleep(1);
        if ((++sp & 255u) == 0u) { if (xb_ld(&bar[XB_TMO])) break; if (sp > XB_SPIN_CAP) { atomicAdd(&bar[XB_TMO], 1u); break; } }
    }
    nloc = mine > 0u ? mine : 1u; nx = cnt > 0u ? cnt : 1u;
}

__device__ __forceinline__ void xcd_barrier(const XcdBarrier& b) {
    asm volatile("s_waitcnt vmcnt(0)" ::: "memory");
    __syncthreads();
    if (threadIdx.x == 0) {
        unsigned* bar = b.bar;
        __builtin_amdgcn_s_waitcnt(0);
        unsigned nloc = b.st[0], nx = b.st[1];
        if (nloc == 0u) { xcd_barrier_complete(bar, b.x, nloc, nx); b.st[0] = nloc; b.st[1] = nx; }
        const unsigned old = xb_add(&bar[XB_XSUB(b.x)], 1u);
        const unsigned gen = old / nloc;
        if (old + 1u == (gen + 1u) * nloc) {
            __builtin_amdgcn_fence(__ATOMIC_RELEASE, "agent");
            asm volatile("s_waitcnt vmcnt(0)" ::: "memory");
            const unsigned og = xb_add(&bar[XB_TOP], 1u);
            const unsigned tg = og / nx;
            if (og + 1u == (tg + 1u) * nx) xb_add(&bar[XB_TOPGEN], 1u);
            else XB_SPIN(xb_ld(&bar[XB_TOPGEN]) == tg, bar);
            __builtin_amdgcn_fence(__ATOMIC_ACQUIRE, "agent");
            xb_add(&bar[XB_XGEN(b.x)], 1u);
            asm volatile("s_waitcnt vmcnt(0)" ::: "memory");
        } else {
            XB_SPIN(xb_ld(&bar[XB_XGEN(b.x)]) == gen, bar);
            __builtin_amdgcn_fence(__ATOMIC_ACQUIRE, "agent");
            asm volatile("s_waitcnt vmcnt(0)" ::: "memory");
        }
    }
    __syncthreads();
}

#ifndef PG8_SP2
#define PG8_SP2 true
#endif
#ifndef PG8_ALIGN
#define PG8_ALIGN true
#endif

struct Args { const void* in[22]; float* out; unsigned char* ws; float invf[32]; int ph_lo, ph_hi, li, pad; };
struct Ctx { int tid, lane, wave, gw, ngw, bid, nb; unsigned char* lds; };

struct MapId { int off; __device__ __forceinline__ int operator()(int n) const { return off + n; } };
struct MapGU { int which; __device__ __forceinline__ int operator()(int f) const { return 8 * (f >> 2) + 4 * which + (f & 3); } };
struct MapUkv { __device__ __forceinline__ int operator()(int n) const { const int h = n >> 8, j = n & 255; return ATT_FP8 ? (j < 128 ? 128 * h + j : 2048 + 128 * h + (j - 128)) : n; } };
struct MapUq { __device__ __forceinline__ int operator()(int n) const { const int h = n / 192, j = n - h * 192;
    if (j < 128) return 256 * h + j; if (j < 160) { const int i = j - 128; return 256 * h + 128 + 8 * (i >> 2) + (i & 3); } const int i = j - 160; return 256 * h + 128 + 8 * (i >> 2) + 4 + (i & 3); } };
constexpr int TR_SCR = 16896;
__device__ __forceinline__ void tr_load(const float* W, int ldw, int k0, int n0, f32x4 (&v)[16], int lane) {
#pragma unroll
    for (int i = 0; i < 16; ++i) v[i] = __builtin_nontemporal_load((const f32x4*)(W + (size_t)(k0 + (lane >> 4) + 4 * i) * ldw + n0 + 4 * (lane & 15)));
}
template <class RM, bool F8 = false>
__device__ __forceinline__ void tr_flush(const f32x4 (&v)[16], bf16_t* WT, int ldt, int k0, int nloc0, const RM& rm, float* scr, int lane) {
    const int nb = 4 * (lane & 15), kq = lane >> 4;
#pragma unroll
    for (int i = 0; i < 16; ++i) { float* d = scr + nb * 65 + kq + 4 * i; d[0] = v[i][0]; d[65] = v[i][1]; d[130] = v[i][2]; d[195] = v[i][3]; }
    LDS_WAIT();
    const int c = lane & 7;
#pragma unroll
    for (int j = 0; j < 8; ++j) { const int n = (lane >> 3) + 8 * j; const float* q = scr + n * 65 + 8 * c;
        if constexpr (F8) { u32x2 o; o.x = pk4fp8(q[0] * 32.f, q[1] * 32.f, q[2] * 32.f, q[3] * 32.f); o.y = pk4fp8(q[4] * 32.f, q[5] * 32.f, q[6] * 32.f, q[7] * 32.f);
            *(u32x2*)((unsigned char*)WT + (size_t)rm(nloc0 + n) * ldt + k0 + 8 * c) = o; }
        else { u32x4 o; o.x = cvt_pk_bf16(q[0], q[1]); o.y = cvt_pk_bf16(q[2], q[3]); o.z = cvt_pk_bf16(q[4], q[5]); o.w = cvt_pk_bf16(q[6], q[7]);
        *(u32x4*)(WT + (size_t)rm(nloc0 + n) * ldt + k0 + 8 * c) = o; } }
    LDS_WAIT();
}
template <class RM, bool F8 = false>
__device__ __forceinline__ void tr_job(const Ctx& C, int& base, const float* W, int ldw, int K, int ncol0, int ncols, bf16_t* WT, int ldt, const RM& rm) {
    const int nblk = ncols / 64, items = (K / 64) * nblk; float* scr = (float*)(C.lds + C.wave * TR_SCR);
    int first = (C.gw - base % C.ngw + C.ngw) % C.ngw;
    for (int it = first; it < items; it += C.ngw) { const int kb = it / nblk, nb = it - kb * nblk; f32x4 v[16]; tr_load(W, ldw, 64 * kb, ncol0 + 64 * nb, v, C.lane); tr_flush<RM, F8>(v, WT, ldt, 64 * kb, 64 * nb, rm, scr, C.lane); }
    base += items;
}
struct MapUqRope { int h; __device__ __forceinline__ int operator()(int n) const { const int i = n & 31; return 192 * h + 128 + 8 * (i >> 2) + ((n >> 5) ? 4 : 0) + (i & 3); } };
#if MLA_ABSORB
__device__ __forceinline__ void ph_mla_absorb(const Ctx& C, const Args& a, unsigned char* ws) {
    const float* w_uq = (const float*)a.in[14]; const float* w_ukv = (const float*)a.in[16]; const float* w_out = (const float*)a.in[17];
    const int tid = C.tid;
    for (int it = C.bid; it < 256; it += C.nb) { const int h = it >> 4, nb = it & 15;
        float* LA = (float*)C.lds; float* LB = (float*)(C.lds + 65536);
#pragma unroll
        for (int i = 0; i < 8; ++i) { const int idx = tid + 512 * i, c = idx >> 5, d4 = idx & 31; *(f32x4*)(LA + c * 128 + 4 * d4) = *(const f32x4*)(w_ukv + (size_t)c * 4096 + 256 * h + 128 + 4 * d4); }
#pragma unroll
        for (int i = 0; i < 4; ++i) { const int idx = tid + 512 * i, d = idx >> 4, n4 = idx & 15; *(f32x4*)(LB + d * 64 + 4 * n4) = *(const f32x4*)(w_out + (size_t)(128 * h + d) * 1024 + 64 * nb + 4 * n4); }
        __syncthreads();
        const int n = tid & 63, cq = C.wave; float acc[16];
#pragma unroll
        for (int i = 0; i < 16; ++i) acc[i] = 0.f;
        for (int d = 0; d < 128; d += 4) { const float b0 = LB[d * 64 + n], b1 = LB[(d + 1) * 64 + n], b2 = LB[(d + 2) * 64 + n], b3 = LB[(d + 3) * 64 + n];
#pragma unroll
            for (int i = 0; i < 16; ++i) { const f32x4 av = *(const f32x4*)(LA + (cq * 16 + i) * 128 + d); acc[i] += (av[0] * b0 + av[1] * b1) + (av[2] * b2 + av[3] * b3); } }
        u32x4 o; o.x = pk4fp8(acc[0] * 32.f, acc[1] * 32.f, acc[2] * 32.f, acc[3] * 32.f); o.y = pk4fp8(acc[4] * 32.f, acc[5] * 32.f, acc[6] * 32.f, acc[7] * 32.f);
        o.z = pk4fp8(acc[8] * 32.f, acc[9] * 32.f, acc[10] * 32.f, acc[11] * 32.f); o.w = pk4fp8(acc[12] * 32.f, acc[13] * 32.f, acc[14] * 32.f, acc[15] * 32.f);
        *(u32x4*)(ws + WS_WMOUT + (size_t)(64 * nb + n) * 2048 + 128 * h + 16 * cq) = o;
        __syncthreads(); }
    for (int it = C.bid; it < 256; it += C.nb) { const int h = it >> 4, rb = it & 15;
        float* LA = (float*)C.lds; float* LB = (float*)(C.lds + 8192);
        { const int r = tid >> 5, j4 = tid & 31; *(f32x4*)(LA + r * 128 + 4 * j4) = *(const f32x4*)(w_uq + (size_t)(16 * rb + r) * 3072 + 192 * h + 4 * j4); }
#pragma unroll
        for (int i = 0; i < 8; ++i) { const int idx = tid + 512 * i, c = idx >> 5, j4 = idx & 31; const f32x4 v = *(const f32x4*)(w_ukv + (size_t)c * 4096 + 256 * h + 4 * j4);
            float* d = LB + c * 129 + 4 * j4; d[0] = v[0]; d[1] = v[1]; d[2] = v[2]; d[3] = v[3]; }
        __syncthreads();
        const int c = tid & 127, rq = C.wave >> 1; float acc[4];
#pragma unroll
        for (int i = 0; i < 4; ++i) acc[i] = 0.f;
        for (int j = 0; j < 128; j += 4) { const float* bp = LB + c * 129 + j; const float b0 = bp[0], b1 = bp[1], b2 = bp[2], b3 = bp[3];
#pragma unroll
            for (int i = 0; i < 4; ++i) { const f32x4 av = *(const f32x4*)(LA + (rq * 4 + i) * 128 + j); acc[i] += (av[0] * b0 + av[1] * b1) + (av[2] * b2 + av[3] * b3); } }
        bf16_t* dst = (bf16_t*)(ws + WS_WUQ) + (size_t)(192 * h + c) * 256 + 16 * rb + 4 * rq;
        u32x2 o; o.x = cvt_pk_bf16(acc[0], acc[1]); o.y = cvt_pk_bf16(acc[2], acc[3]);
        *(u32x2*)dst = o;
        __syncthreads(); }
}
#endif
__device__ __forceinline__ void ph_convert_small(const Ctx& C, const Args& a, unsigned char* ws) {
    const float* w_in = (const float*)a.in[5]; int base = 0;
    bf16_t* WGIN = (bf16_t*)(ws + WS_WGIN);
    tr_job(C, base, w_in, 3104, 1024, 0, 1024, WGIN, 1024, MapId{0});
    tr_job(C, base, w_in, 3104, 1024, 1024, 1024, (bf16_t*)(ws + WS_WV), 1024, MapId{0});
    tr_job(C, base, w_in, 3104, 1024, 2048, 1024, WGIN, 1024, MapId{1024});
    tr_job(C, base, (const float*)a.in[11], 1024, 1024, 0, 1024, (bf16_t*)(ws + WS_WGOUT), 1024, MapId{0});
    tr_job<MapId, MLA_FP8 != 0>(C, base, (const float*)a.in[12], 448, 1024, 0, 448, (bf16_t*)(ws + WS_WMIN), 1024, MapId{0});
#if MLA_ABSORB
    for (int h = 0; h < MH; ++h) tr_job(C, base, (const float*)a.in[14], 3072, 256, 192 * h + 128, 64, (bf16_t*)(ws + WS_WUQ), 256, MapUqRope{h});
#else
    tr_job(C, base, (const float*)a.in[14], 3072, 256, 0, 3072, (bf16_t*)(ws + WS_WUQ), 256, MapUq{});
    tr_job(C, base, (const float*)a.in[16], 4096, 128, 0, 4096, (bf16_t*)(ws + WS_WUKV), 256, MapUkv{});
    tr_job<MapId, MLA_FP8 != 0>(C, base, (const float*)a.in[17], 1024, 2048, 0, 1024, (bf16_t*)(ws + WS_WMOUT), 2048, MapId{0});
#endif
    const int gt = C.bid * 512 + C.tid, ngt = C.nb * 512;
    for (int it = gt; it < 1024 * 128; it += ngt) { const int cp = it >> 7, k8 = it & 127, dir = cp >> 9, c = cp & 511;
        const float* wg = (const float*)a.in[dir ? 8 : 6]; float wj[16];
#pragma unroll
        for (int j = 0; j < 16; ++j) wj[j] = wg[j * 512 + c];
        float o[8];
#pragma unroll
        for (int kk = 0; kk < 8; ++kk) { const float* wr = w_in + (size_t)(8 * k8 + kk) * 3104 + 3072 + 16 * dir; float s = 0.f;
#pragma unroll
            for (int j4 = 0; j4 < 4; ++j4) { const f32x4 x = *(const f32x4*)(wr + 4 * j4); s += x[0] * wj[4 * j4] + x[1] * wj[4 * j4 + 1] + x[2] * wj[4 * j4 + 2] + x[3] * wj[4 * j4 + 3]; }
            o[kk] = s; }
        u32x4 w; w.x = cvt_pk_bf16(o[0], o[1]); w.y = cvt_pk_bf16(o[2], o[3]); w.z = cvt_pk_bf16(o[4], o[5]); w.w = cvt_pk_bf16(o[6], o[7]);
        *(u32x4*)(WGIN + (size_t)(2048 + cp) * 1024 + 8 * k8) = w; }
    const u32x4 z = {0u, 0u, 0u, 0u};
    if (MLA_FP8) { for (int it = gt; it < 64 * 64; it += ngt) *(u32x4*)(ws + WS_WMIN + (size_t)448 * 1024 + (size_t)it * 16) = z; }
    else for (int it = gt; it < 64 * 128; it += ngt) *(u32x4*)((bf16_t*)(ws + WS_WMIN) + (size_t)448 * 1024 + (size_t)it * 8) = z;
    if (!MLA_ABSORB) for (int it = gt; it < 16 * 64 * 32; it += ngt) { const int h = it >> 11, r = (it >> 5) & 63, c8 = it & 31; *(u32x4*)((bf16_t*)(ws + WS_WUQ) + (size_t)(256 * h + 192 + r) * 256 + c8 * 8) = z; }
    if (!MLA_ABSORB) for (int it = gt; it < 4096 * 16; it += ngt) { const int r = it >> 4, c8 = it & 15; *(u32x4*)((bf16_t*)(ws + WS_WUKV) + (size_t)r * 256 + 128 + c8 * 8) = z; }
}
struct MapMoe { int kind; __device__ __forceinline__ int operator()(int f) const { return kind < 2 ? 8 * (f >> 2) + 4 * kind + (f & 3) : f; } };
struct MoeItem { const float* src; bf16_t* dst; int ldw, ldt, k0, n0, kind; };
__device__ __forceinline__ MoeItem moe_item(const Args& a, unsigned char* ws, int layer, int it) {
    const int e = it / 1536, r = it - e * 1536, which = r >> 9, j = r & 511; const size_t le = (size_t)(layer * NE + e); MoeItem m; m.kind = which;
    if (which < 2) { m.src = (const float*)a.in[19 + which] + le * 1024 * 2048; m.ldw = 2048; m.dst = (bf16_t*)(ws + WS_WGU + (size_t)((MOE_FP8 && CONV_OVERLAP) ? layer : 0) * (64 * MiB) + (size_t)e * 4096 * 1024 * (MOE_FP8 ? 1 : 2)); m.ldt = 1024; m.k0 = 64 * (j >> 5); m.n0 = 64 * (j & 31); }
    else { m.src = (const float*)a.in[21] + le * 2048 * 1024; m.ldw = 1024; m.dst = (bf16_t*)(ws + WS_WD + (size_t)((MOE_FP8 && CONV_OVERLAP) ? layer : 0) * (32 * MiB) + (size_t)e * 1024 * 2048 * (MOE_FP8 ? 1 : 2)); m.ldt = 2048; m.k0 = 64 * (j >> 4); m.n0 = 64 * (j & 15); }
    return m;
}
__device__ __forceinline__ void ph_convert_moe(const Ctx& C, const Args& a, unsigned char* ws, int layer, int rep, int it0, int it1, int wk, int nwk) {
    constexpr int NIT1 = NE * 1536; const int NIT = it0 + (it1 - it0) * rep; float* scr = (float*)(C.lds + C.wave * TR_SCR);
    int it = it0 + wk; if (it >= NIT) return;
#define MI_(x) moe_item(a, ws, layer, rep > 1 ? (x) % NIT1 : (x))
    f32x4 va[16], vb[16]; MoeItem ma = MI_(it), mb = ma; tr_load(ma.src, ma.ldw, ma.k0, ma.n0, va, C.lane);
    for (;;) {
        int nx = it + nwk; if (nx < NIT) { mb = MI_(nx); tr_load(mb.src, mb.ldw, mb.k0, mb.n0, vb, C.lane); }
        tr_flush<MapMoe, MOE_FP8 != 0>(va, ma.dst, ma.ldt, ma.k0, ma.n0, MapMoe{ma.kind}, scr, C.lane);
        it = nx; if (it >= NIT) break;
        nx = it + nwk; if (nx < NIT) { ma = MI_(nx); tr_load(ma.src, ma.ldw, ma.k0, ma.n0, va, C.lane); }
        tr_flush<MapMoe, MOE_FP8 != 0>(vb, mb.dst, mb.ldt, mb.k0, mb.n0, MapMoe{mb.kind}, scr, C.lane);
        it = nx; if (it >= NIT) break;
    }
#undef MI_
}
constexpr int CV_NIT = NE * 1536, CV_X1 = (MOE_FP8 && CONV_OVERLAP) ? 2816 : 0, CV_X2 = (MOE_FP8 && CONV_OVERLAP) ? 2816 + 2048 : 0, CV_Y0 = (MOE_FP8 && CONV_OVERLAP) ? CV_NIT - 2816 : CV_NIT;

__device__ __forceinline__ void row_load(const float* row, int lane, f32x4 (&v)[4]) {
#pragma unroll
    for (int j = 0; j < 4; ++j) v[j] = *(const f32x4*)(row + 256 * j + 4 * lane); }
__device__ __forceinline__ float row_rstd(const f32x4 (&v)[4]) { float s = 0.f;
#pragma unroll
    for (int j = 0; j < 4; ++j) s += (v[j][0] * v[j][0] + v[j][1] * v[j][1]) + (v[j][2] * v[j][2] + v[j][3] * v[j][3]);
    return 1.0f / sqrtf(wave_sum(s) * (1.0f / 1024.0f) + RMS_EPS); }
__device__ __forceinline__ void row_store_bf(bf16_t* row, int lane, const f32x4 (&v)[4]) {
#pragma unroll
    for (int j = 0; j < 4; ++j) { u32x2 w; w.x = cvt_pk_bf16(v[j][0], v[j][1]); w.y = cvt_pk_bf16(v[j][2], v[j][3]); *(u32x2*)(row + 256 * j + 4 * lane) = w; } }

__device__ __forceinline__ void ph_norm(const Ctx& C, const float* src, const float* gain, bf16_t* XN) {
    f32x4 g[4]; row_load(gain, C.lane, g);
    for (int t = C.gw; t < T; t += C.ngw) { f32x4 v[4]; row_load(src + (size_t)t * D, C.lane, v); const float r = row_rstd(v);
#pragma unroll
        for (int j = 0; j < 4; ++j) v[j] = v[j] * r * g[j];
        row_store_bf(XN + (size_t)t * D, C.lane, v); }
}
template <int M, int HALF_>
__device__ __forceinline__ void router_step(float (&q)[16], int lane) { const bool up = (lane & M) != 0;
#pragma unroll
    for (int i = 0; i < HALF_; ++i) { const float keep = up ? q[i + HALF_] : q[i], send = up ? q[i] : q[i + HALF_]; q[i] = keep + __shfl_xor(send, M); } }
__device__ __forceinline__ float router_reduce16(float (&q)[16], int lane) {
    router_step<32, 8>(q, lane); router_step<16, 4>(q, lane); router_step<8, 2>(q, lane); router_step<4, 1>(q, lane);
    float r = q[0]; r += __shfl_xor(r, 1); r += __shfl_xor(r, 2); return r;
}
__device__ __forceinline__ float router_softmax(float logit) {
    float mx = logit;
#pragma unroll
    for (int M = 4; M < 64; M <<= 1) mx = fmaxf(mx, __shfl_xor(mx, M));
    const float ex = expf(logit - mx); float sm = ex;
#pragma unroll
    for (int M = 4; M < 64; M <<= 1) sm += __shfl_xor(sm, M);
    return ex / sm;
}
__device__ __forceinline__ void ph_router(const Ctx& C, const float* Hin, const float* gain, const float* Wr, bf16_t* XN, float* AFF, float* AFFT, unsigned char* XN8) {
    f32x4* Wl = (f32x4*)C.lds;
    for (int idx = C.tid; idx < 4096; idx += 512) { const int l = idx & 63, e4 = (idx >> 6) & 3, i = (idx >> 8) & 3, j = idx >> 10; Wl[idx] = *(const f32x4*)(Wr + (size_t)(256 * j + 4 * l + i) * 16 + 4 * e4); }
    __syncthreads();
    f32x4 g[4]; row_load(gain, C.lane, g);
    f32x4 na[4], nb[4]; if (C.gw < T) { row_load(Hin + (size_t)C.gw * D, C.lane, na); row_load(Hin + (size_t)(C.gw + C.ngw) * D, C.lane, nb); }
    for (int t = C.gw; t < T; t += 2 * C.ngw) { const int t2 = t + C.ngw;
        f32x4 va[4], vb[4];
#pragma unroll
        for (int j = 0; j < 4; ++j) { va[j] = na[j]; vb[j] = nb[j]; }
        if (t + 2 * C.ngw < T) { row_load(Hin + (size_t)(t + 2 * C.ngw) * D, C.lane, na); row_load(Hin + (size_t)(t2 + 2 * C.ngw) * D, C.lane, nb); }
        const float ra = row_rstd(va), rb = row_rstd(vb);
#pragma unroll
        for (int j = 0; j < 4; ++j) { va[j] = va[j] * ra * g[j]; vb[j] = vb[j] * rb * g[j]; }
#if MOE_FP8
#pragma unroll
        for (int j = 0; j < 4; ++j) { *(unsigned*)(XN8 + (size_t)t * D + 256 * j + 4 * C.lane) = pk4fp8(va[j][0], va[j][1], va[j][2], va[j][3]);
                                      *(unsigned*)(XN8 + (size_t)t2 * D + 256 * j + 4 * C.lane) = pk4fp8(vb[j][0], vb[j][1], vb[j][2], vb[j][3]); }
#ifdef DBG
        row_store_bf(XN + (size_t)t * D, C.lane, va); row_store_bf(XN + (size_t)t2 * D, C.lane, vb);
#endif
#else
        row_store_bf(XN + (size_t)t * D, C.lane, va); row_store_bf(XN + (size_t)t2 * D, C.lane, vb);
#endif
        float pa[16], pb[16];
#pragma unroll
        for (int e = 0; e < 16; ++e) { pa[e] = 0.f; pb[e] = 0.f; }
#pragma unroll
        for (int j = 0; j < 4; ++j)
#pragma unroll
            for (int i = 0; i < 4; ++i) { const float xa = va[j][i], xb = vb[j][i];
#pragma unroll
                for (int e4 = 0; e4 < 4; ++e4) { const f32x4 w = Wl[((j * 4 + i) * 4 + e4) * 64 + C.lane];
                    pa[4 * e4] += xa * w[0]; pa[4 * e4 + 1] += xa * w[1]; pa[4 * e4 + 2] += xa * w[2]; pa[4 * e4 + 3] += xa * w[3];
                    pb[4 * e4] += xb * w[0]; pb[4 * e4 + 1] += xb * w[1]; pb[4 * e4 + 2] += xb * w[2]; pb[4 * e4 + 3] += xb * w[3]; }  asm volatile("" ::: "memory"); }
        const float la = router_reduce16(pa, C.lane), lb = router_reduce16(pb, C.lane);
        const float fa = router_softmax(la), fb = router_softmax(lb);
        if ((C.lane & 3) == 0) { const int e = C.lane >> 2; AFF[(size_t)t * 16 + e] = fa; AFFT[(size_t)e * T + t] = fa; AFF[(size_t)t2 * 16 + e] = fb; AFFT[(size_t)e * T + t2] = fb; }
    }
    __syncthreads();
}
__device__ __forceinline__ void ph_select(const Ctx& C, const float* AFFT, int* SEL, int* IDX) {
    if (C.bid >= NE) return;
    const int e = C.bid; unsigned* vals = (unsigned*)C.lds; unsigned* hist = vals + T; unsigned* sh = hist + 256;
    for (int i = C.tid; i < T; i += 512) vals[i] = __float_as_uint(AFFT[(size_t)e * T + i]);
    __syncthreads();
    unsigned prefix = 0u, mask = 0u, remaining = CAP;
    for (int pass = 0; pass < 4; ++pass) { const int shift = 24 - 8 * pass;
        if (C.tid < 256) hist[C.tid] = 0u;
        __syncthreads();
        if (pass == 0) {
            for (int i = C.tid; i < T; i += 512) { const unsigned bin = (vals[i] >> 24) & 255u; unsigned long long m_ = __ballot(1);
                while (m_) { const int ld_ = __builtin_amdgcn_readfirstlane(__ffsll((long long)m_) - 1); const unsigned b0_ = __builtin_amdgcn_readlane(bin, ld_);
                    const unsigned long long same_ = __ballot(bin == b0_) & m_; if (C.lane == ld_) atomicAdd(&hist[b0_], (unsigned)__popcll(same_)); m_ &= ~same_; } } }
        else for (int i = C.tid; i < T; i += 512) { const unsigned v = vals[i]; if ((v & mask) == prefix) atomicAdd(&hist[(v >> shift) & 255u], 1u); }
        __syncthreads();
        if (C.wave == 0) {
            unsigned cb[4]; unsigned tl = 0u;
#pragma unroll
            for (int j = 0; j < 4; ++j) { cb[j] = hist[255 - (4 * C.lane + j)]; tl += cb[j]; }
            unsigned incl = tl;
#pragma unroll
            for (int o = 1; o < 64; o <<= 1) { const unsigned tt = __shfl_up(incl, o); if (C.lane >= o) incl += tt; }
            unsigned cum = incl - tl;
            if (cum < remaining && remaining <= incl) {
#pragma unroll
                for (int j = 0; j < 4; ++j) { if (cum < remaining && cum + cb[j] >= remaining) { sh[0] = (unsigned)(255 - (4 * C.lane + j)); sh[1] = remaining - cum; } cum += cb[j]; } } }
        __syncthreads();
        prefix |= sh[0] << shift; mask |= 255u << shift; remaining = sh[1];
        __syncthreads();
    }
    const unsigned thr = prefix, ntie = remaining;
    unsigned cg = 0u, ce = 0u;
    for (int i = 0; i < 32; ++i) { const unsigned v = vals[C.tid + 512 * i]; cg += v > thr; ce += v == thr; }
    unsigned sg = cg, se = ce;
#pragma unroll
    for (int o = 1; o < 64; o <<= 1) { const unsigned tg = __shfl_up(sg, o), te = __shfl_up(se, o); if (C.lane >= o) { sg += tg; se += te; } }
    if (C.lane == 63) { sh[16 + C.wave] = sg; sh[32 + C.wave] = se; }
    __syncthreads();
    unsigned og = 0u, oe = 0u, totg = 0u;
    for (int w = 0; w < 8; ++w) { const unsigned a = sh[16 + w], b = sh[32 + w]; if (w < C.wave) { og += a; oe += b; } totg += a; }
    unsigned pg = og + sg - cg, pe = oe + se - ce;
    for (int i = 0; i < 32; ++i) { const int t = C.tid + 512 * i; const unsigned v = vals[t]; int slot = -1;
        if (v > thr) slot = (int)pg++; else if (v == thr) { if (pe < ntie) slot = (int)(totg + pe); ++pe; }
        SEL[(size_t)e * T + t] = slot + 1; if (slot >= 0) IDX[e * CAP + slot] = t; }
}
__device__ __forceinline__ void ph_gather(const Ctx& C, const int* IDX, const bf16_t* XN, bf16_t* XS, const unsigned char* XN8) {
    for (int r = C.gw; r < NE * CAP; r += C.ngw) { const int t = IDX[r];
        if (MOE_FP8) { ((u32x4*)((unsigned char*)XS + (size_t)r * D))[C.lane] = ((const u32x4*)(XN8 + (size_t)t * D))[C.lane]; }
        else { const u32x4* s = (const u32x4*)(XN + (size_t)t * D); u32x4* d = (u32x4*)(XS + (size_t)r * D); const u32x4 a = s[C.lane], b = s[C.lane + 64]; d[C.lane] = a; d[C.lane + 64] = b; } }
}
template <int MODE>
__device__ __forceinline__ void ph_combine(const Ctx& C, const float* Hin, const float* AFF, const int* SEL, const bf16_t* Y, float* Hout, const float* gain, bf16_t* XN, float* OUT) {
    f32x4 g[4]; row_load(gain, C.lane, g);
    f32x4 nv[4]; int nsel = 0; float naf = 0.f;
    if (C.gw < T) { row_load(Hin + (size_t)C.gw * D, C.lane, nv); nsel = SEL[(size_t)(C.lane & 15) * T + C.gw]; naf = AFF[(size_t)C.gw * 16 + (C.lane & 15)]; }
    for (int t = C.gw; t < T; t += C.ngw) {
        f32x4 v[4];
#pragma unroll
        for (int j = 0; j < 4; ++j) v[j] = nv[j];
        const int sel = nsel; const float af = naf;
        if (t + C.ngw < T) { const size_t tn = (size_t)(t + C.ngw); row_load(Hin + tn * D, C.lane, nv); nsel = SEL[(size_t)(C.lane & 15) * T + tn]; naf = AFF[tn * 16 + (C.lane & 15)]; }
#pragma unroll
        for (int e = 0; e < 16; ++e) { const int s = __builtin_amdgcn_readlane(sel, e);
            if (s) { const float a = __uint_as_float(__builtin_amdgcn_readlane(__float_as_uint(af), e)); const bf16_t* y = Y + ((size_t)e * CAP + (s - 1)) * D + 4 * C.lane;
#pragma unroll
                for (int j = 0; j < 4; ++j) { const u32x2 w = *(const u32x2*)(y + 256 * j); v[j][0] += a * bf_lo(w.x); v[j][1] += a * bf_hi(w.x); v[j][2] += a * bf_lo(w.y); v[j][3] += a * bf_hi(w.y); } } }
        if (MODE == 1) {
#pragma unroll
            for (int j = 0; j < 4; ++j) *(f32x4*)(Hout + (size_t)t * D + 256 * j + 4 * C.lane) = v[j]; }
        const float r = row_rstd(v);
#pragma unroll
        for (int j = 0; j < 4; ++j) v[j] = v[j] * r * g[j];
        if (MODE == 1) { if (MLA_FP8) {
#pragma unroll
                for (int j = 0; j < 4; ++j) *(unsigned*)((unsigned char*)XN + (size_t)t * D + 256 * j + 4 * C.lane) = pk4fp8(v[j][0], v[j][1], v[j][2], v[j][3]); }
            else row_store_bf(XN + (size_t)t * D, C.lane, v); }
        else {
#pragma unroll
            for (int j = 0; j < 4; ++j) *(f32x4*)(OUT + (size_t)t * D + 256 * j + 4 * C.lane) = v[j]; }
    }
}

#define MFMA32(a, b, c) __builtin_amdgcn_mfma_f32_32x32x16_bf16((a), (b), (c), 0, 0, 0)
__device__ __forceinline__ int crow(int r, int hi) { return (r & 3) + 8 * (r >> 2) + 4 * hi; }
__device__ __forceinline__ bf16x8 ldfrag(const bf16_t* p) { return *(const bf16x8*)p; }

struct PrepRegs { float gf[8], gb[8]; unsigned short q[8], k[8]; };
__device__ __forceinline__ void prep_load(PrepRegs& R, const bf16_t* Q0, const bf16_t* K0, const float* GF, const float* GB, size_t off0) {
#pragma unroll
    for (int i = 0; i < 8; ++i) { const size_t of = off0 + (size_t)i * 512; R.gf[i] = GF[of]; R.gb[i] = GB[of]; R.q[i] = Q0[of]; R.k[i] = K0[of]; }
}
__device__ __forceinline__ void ph_gla_prep(const Ctx& C, const bf16_t* Q0, const bf16_t* K0, const float* GF, const float* GB,
                                            bf16_t* QDF, bf16_t* QDB, bf16_t* KDF, bf16_t* KDB, bf16_t* KTF, bf16_t* KTB, float* EGL) {
    float* tot = (float*)C.lds;
    const int o = C.wave, l = C.lane;
    for (int c = C.bid; c < GNC; c += C.nb) { const int t0 = c * GC + 8 * o; const size_t base0 = (size_t)t0 * 512 + l;
        PrepRegs RA, RB; prep_load(RA, Q0, K0, GF, GB, base0);
#define PREP_STEP(R, cb, par) do { const int ch = (cb) * 64 + l; const size_t off0 = base0 + (cb) * 64;                                                                       \
            float sf = 0.f, sb = 0.f;                                                                                                                                        \
            _Pragma("unroll") for (int i = 0; i < 8; ++i) { sf += R.gf[i]; R.gf[i] = sf; }                                                                                     \
            _Pragma("unroll") for (int i = 7; i >= 0; --i) { sb += R.gb[i]; R.gb[i] = sb; }                                                                                    \
            float* tp = tot + (par) * 1024; tp[o * 64 + l] = sf; tp[512 + o * 64 + l] = sb;                                                                                    \
            __syncthreads();                                                                                                                                                 \
            float offf = 0.f, offb = 0.f, allf = 0.f, allb = 0.f;                                                                                                            \
            _Pragma("unroll") for (int oo = 0; oo < 8; ++oo) { const float a_ = tp[oo * 64 + l], b_ = tp[512 + oo * 64 + l]; offf += (oo < o) ? a_ : 0.f; offb += (oo > o) ? b_ : 0.f; allf += a_; allb += b_; } \
            unsigned pf[4], pb[4];                                                                                                                                           \
            _Pragma("unroll") for (int i = 0; i < 8; i += 2) { float kdf[2], kdb[2];                                                                                          \
                _Pragma("unroll") for (int u = 0; u < 2; ++u) { const size_t of = off0 + (size_t)(i + u) * 512; const float ef = __expf(offf + R.gf[i + u]), eb = __expf(offb + R.gb[i + u]); \
                    const float qv = bf2f(R.q[i + u]), kv = bf2f(R.k[i + u]);                                                                                                 \
                    kdf[u] = kv * __builtin_amdgcn_rcpf(ef); kdb[u] = kv * __builtin_amdgcn_rcpf(eb);                                                                         \
                    QDF[of] = f2bf(qv * ef); QDB[of] = f2bf(qv * eb); KDF[of] = f2bf(kdf[u]); KDB[of] = f2bf(kdb[u]); }                                                      \
                pf[i >> 1] = cvt_pk_bf16(kdf[0], kdf[1]); pb[i >> 1] = cvt_pk_bf16(kdb[0], kdb[1]); }                                                                          \
            *(u32x4*)(KTF + (size_t)ch * T + t0) = (u32x4){pf[0], pf[1], pf[2], pf[3]};                                                                                       \
            *(u32x4*)(KTB + (size_t)ch * T + t0) = (u32x4){pb[0], pb[1], pb[2], pb[3]};                                                                                       \
            if (o == 0) { EGL[(size_t)c * 512 + ch] = __expf(allf); EGL[(size_t)(GNC + c) * 512 + ch] = __expf(allb); } } while (0)
#pragma unroll
        for (int cb = 0; cb < 8; cb += 2) {
            prep_load(RB, Q0, K0, GF, GB, base0 + (cb + 1) * 64); PREP_STEP(RA, cb, 0);
            if (cb + 2 < 8) prep_load(RA, Q0, K0, GF, GB, base0 + (cb + 2) * 64); PREP_STEP(RB, cb + 1, 1);
        }
#undef PREP_STEP
    }
    __syncthreads();
}
__device__ __forceinline__ void ph_gla_u(const Ctx& C, const bf16_t* VT, const bf16_t* KTF, const bf16_t* KTB, const float* EGL, bf16_t* U) {
    const int r = C.lane & 31, hh = C.lane >> 5;
    for (int it = C.gw; it < 2 * GH * GNC * 8; it += C.ngw) { const int w = it & 7, unit = it >> 3, c = unit % GNC, h = (unit / GNC) % GH, dir = unit / (GNC * GH); const int t0 = c * GC;
        const bf16_t* KT = dir ? KTB : KTF; const bf16_t* bp = VT + (size_t)(256 * h + 32 * w + r) * T + t0 + 8 * hh;
        bf16x8 b[4];
#pragma unroll
        for (int s = 0; s < 4; ++s) b[s] = ldfrag(bp + 16 * s);
        bf16_t* Ub = U + ((size_t)(dir * GH + h) * GNC + c) * (GDV * GDK); const float* eg = EGL + (size_t)(dir * GNC + c) * 512 + 128 * h;
#pragma unroll
        for (int j = 0; j < 4; ++j) { f32x16 acc = {}; const bf16_t* ap = KT + (size_t)(128 * h + 32 * j + r) * T + t0 + 8 * hh;
#pragma unroll
            for (int s = 0; s < 4; ++s) acc = MFMA32(ldfrag(ap + 16 * s), b[s], acc);
#pragma unroll
            for (int g = 0; g < 4; ++g) { const f32x4 e4 = *(const f32x4*)(eg + 32 * j + 8 * g + 4 * hh);
                u32x2 o; o.x = cvt_pk_bf16(acc[4 * g] * e4[0], acc[4 * g + 1] * e4[1]); o.y = cvt_pk_bf16(acc[4 * g + 2] * e4[2], acc[4 * g + 3] * e4[3]);
                *(u32x2*)(Ub + ((w * 8 + 2 * j + (g >> 1)) * 64 + (g & 1) * 32 + r) * 8 + 4 * hh) = o; } }
    }
}
__device__ __forceinline__ void ph_gla_scan(const Ctx& C, const bf16_t* U, const float* EGL, bf16_t* ST) {
    if (C.tid >= 256) return;
    for (int el = C.bid * 256 + C.tid; el < 2 * GH * GDV * (GDK / 4); el += C.nb * 256) { const int p = 4 * (el & 8191), h = (el >> 13) & 3, dir = el >> 15;
        const int dk = 16 * ((p >> 9) & 7) + 8 * ((p >> 8) & 1) + (p & 7);
        const size_t eb = (size_t)(dir * GH + h) * GNC * (GDV * GDK) + p; const float* eg = EGL + (size_t)dir * GNC * 512 + 128 * h + dk;
        float s0 = 0.f, s1 = 0.f, s2 = 0.f, s3 = 0.f;
#pragma unroll 32
        for (int i = 0; i < GNC; ++i) { const int c = dir ? GNC - 1 - i : i; const size_t o = eb + (size_t)c * (GDV * GDK);
            const u32x2 u = *(const u32x2*)(U + o); const f32x4 d = *(const f32x4*)(eg + (size_t)c * 512);
            u32x2 w; w.x = cvt_pk_bf16(s0, s1); w.y = cvt_pk_bf16(s2, s3); *(u32x2*)(ST + o) = w;
            s0 = d[0] * s0 + bf_lo(u.x); s1 = d[1] * s1 + bf_hi(u.x); s2 = d[2] * s2 + bf_lo(u.y); s3 = d[3] * s3 + bf_hi(u.y); }
    }
}
__device__ __forceinline__ void ph_gla_out(const Ctx& C, const bf16_t* QDF, const bf16_t* QDB, const bf16_t* KDF, const bf16_t* KDB, const bf16_t* VT, const bf16_t* ST,
                                           const bf16_t* SR, const float* hnorm, bf16_t* OG) {
    constexpr int ACS = 72, TS = 272, TB = 64 * TS;
    unsigned char* TL = C.lds;
    bf16_t* AC = (bf16_t*)(C.lds + 4 * TB); float* SSQ = (float*)(C.lds + 4 * TB + 64 * ACS * 2);
    const int w = C.wave, r = C.lane & 31, hh = C.lane >> 5;
    const float gn = hnorm[32 * w + r];
    bf16x8 bs[2][8], bv[4]; u32x4 tv[8];
#define GO_LOAD(unit_) do { const int h_ = (unit_) / GNC, c_ = (unit_) % GNC, t0_ = c_ * GC;                                                               \
        _Pragma("unroll") for (int dir = 0; dir < 2; ++dir) { const bf16_t* sp = ST + ((size_t)(dir * GH + h_) * GNC + c_) * (GDV * GDK) + (size_t)w * 4096 + C.lane * 8; \
            _Pragma("unroll") for (int s_ = 0; s_ < 8; ++s_) bs[dir][s_] = ldfrag(sp + 512 * s_); }                 \
        { const bf16_t* vp = VT + (size_t)(256 * h_ + 32 * w + r) * T + t0_ + 8 * hh; _Pragma("unroll") for (int s_ = 0; s_ < 4; ++s_) bv[s_] = ldfrag(vp + 16 * s_); } \
        _Pragma("unroll") for (int q = 0; q < 8; ++q) { const int tile = q >> 1, ck = C.tid + 512 * (q & 1), row = ck >> 4, cc = ck & 15; const bf16_t* src = tile == 0 ? QDF : tile == 1 ? QDB : tile == 2 ? KDF : KDB; \
            tv[q] = *(const u32x4*)(src + (size_t)(t0_ + row) * 512 + 128 * h_ + 8 * cc); } } while (0)
    int unit = C.bid; if (unit < GH * GNC) GO_LOAD(unit);
    for (; unit < GH * GNC; unit += C.nb) { const int h = unit / GNC, c = unit % GNC, t0 = c * GC;
#pragma unroll
        for (int q = 0; q < 8; ++q) { const int tile = q >> 1, ck = C.tid + 512 * (q & 1), row = ck >> 4, cc = ck & 15; *(u32x4*)(TL + tile * TB + row * TS + 16 * cc) = tv[q]; }
        __syncthreads();
        {
            const int dir = w >> 2, ti = (w >> 1) & 1, si = w & 1;
            if (!((dir == 0 && ti == 0 && si == 1) || (dir == 1 && ti == 1 && si == 0))) {
                const unsigned char* qp = TL + dir * TB + (32 * ti + r) * TS + 16 * hh; const unsigned char* kp = TL + (2 + dir) * TB + (32 * si + r) * TS + 16 * hh;
                f32x16 acc = {};
#pragma unroll
                for (int s = 0; s < 8; ++s) acc = MFMA32(*(const bf16x8*)(qp + 32 * s), *(const bf16x8*)(kp + 32 * s), acc);
#pragma unroll
                for (int q = 0; q < 16; ++q) { const int tl = 32 * ti + crow(q, hh), sl = 32 * si + r; const bool keep = dir ? (sl > tl) : (sl <= tl); if (keep) AC[tl * ACS + sl] = f2bf(acc[q]); }
            }
        }
        __syncthreads();
        f32x16 o0 = {}, o1 = {};
#pragma unroll
        for (int dir = 0; dir < 2; ++dir) { const unsigned char* qp = TL + dir * TB + r * TS + 16 * hh;
#pragma unroll
            for (int s = 0; s < 8; ++s) { o0 = MFMA32(*(const bf16x8*)(qp + 32 * s), bs[dir][s], o0); o1 = MFMA32(*(const bf16x8*)(qp + 32 * TS + 32 * s), bs[dir][s], o1); } }
#pragma unroll
        for (int s = 0; s < 4; ++s) { o0 = MFMA32(ldfrag(AC + r * ACS + 16 * s + 8 * hh), bv[s], o0); o1 = MFMA32(ldfrag(AC + (32 + r) * ACS + 16 * s + 8 * hh), bv[s], o1); }
        if (unit + C.nb < GH * GNC) GO_LOAD(unit + C.nb);
#pragma unroll
        for (int q = 0; q < 16; ++q) { float a = o0[q] * o0[q], b = o1[q] * o1[q];
#pragma unroll
            for (int of = 1; of < 32; of <<= 1) { a += __shfl_xor(a, of); b += __shfl_xor(b, of); }
            if (r == 0) { SSQ[w * 64 + crow(q, hh)] = a; SSQ[w * 64 + 32 + crow(q, hh)] = b; } }
        __syncthreads();
        if (C.tid < 64) { float sa = 0.f;
#pragma unroll
            for (int ww = 0; ww < 8; ++ww) sa += SSQ[ww * 64 + C.tid];
            SSQ[512 + C.tid] = __builtin_amdgcn_rsqf(sa * (1.0f / 256.0f) + RMS_EPS); }
        __syncthreads();
#pragma unroll
        for (int q = 0; q < 16; ++q) { const int tl = crow(q, hh); const float ra = SSQ[512 + tl], rb = SSQ[512 + 32 + tl];
            const size_t oa = (size_t)(t0 + tl) * 1024 + 256 * h + 32 * w + r, ob = oa + 32 * 1024;
            OG[oa] = f2bf(o0[q] * ra * gn * bf2f(SR[oa])); OG[ob] = f2bf(o1[q] * rb * gn * bf2f(SR[ob])); }
        __syncthreads();
    }
#undef GO_LOAD
}


constexpr int GC2 = 256, GNC2 = T / GC2;
__device__ __forceinline__ void ph_gla_prep2(const Ctx& C, const bf16_t* Q0, const bf16_t* K0, const float* GF, const float* GB,
                                             bf16_t* QDF, bf16_t* QDB, bf16_t* KDF, bf16_t* KDB, bf16_t* KTF, bf16_t* KTB, float* EGL) {
    float* tot = (float*)C.lds;
    const int o = C.wave, l = C.lane; int par = 0;
    for (int it = C.bid; it < GNC2 * 4; it += C.nb) { const int m = it >> 2, cq = it & 3, t0 = m * GC2 + 32 * o;
        for (int cb = 0; cb < 2; ++cb, par ^= 1) { const int ch = 128 * cq + 64 * cb + l; const size_t off0 = (size_t)t0 * 512 + ch;
            float gf[32], gb[32];
#pragma unroll
            for (int i = 0; i < 32; ++i) { const size_t of = off0 + (size_t)i * 512; gf[i] = GF[of]; gb[i] = GB[of]; }
            unsigned short qa[8], ka[8], qb2[8], kb2[8];
#pragma unroll
            for (int i = 0; i < 8; ++i) { const size_t of = off0 + (size_t)i * 512; qa[i] = Q0[of]; ka[i] = K0[of]; }
            float sf = 0.f, sb = 0.f;
#pragma unroll
            for (int i = 0; i < 32; ++i) { sf += gf[i]; gf[i] = sf; }
#pragma unroll
            for (int i = 31; i >= 0; --i) { sb += gb[i]; gb[i] = sb; }
            float* tp = tot + par * 1024; tp[o * 64 + l] = sf; tp[512 + o * 64 + l] = sb;
            __syncthreads();
            float offf = 0.f, offb = 0.f, allf = 0.f, allb = 0.f;
#pragma unroll
            for (int oo = 0; oo < 8; ++oo) { const float a_ = tp[oo * 64 + l], b_ = tp[512 + oo * 64 + l]; offf += (oo < o) ? a_ : 0.f; offb += (oo > o) ? b_ : 0.f; allf += a_; allb += b_; }
#define PREP_OCT(QV, KV, i8) do { unsigned pf[4], pb[4];                                                                                                            \
                _Pragma("unroll") for (int i = 0; i < 8; i += 2) { float kdf[2], kdb[2];                                                                              \
                    _Pragma("unroll") for (int u = 0; u < 2; ++u) { const int ii = 8 * (i8) + i + u; const size_t of = off0 + (size_t)ii * 512; const float ef = __expf(offf + gf[ii]), eb = __expf(offb + gb[ii]); \
                        const float q = bf2f(QV[i + u]), k = bf2f(KV[i + u]);                                                                                         \
                        kdf[u] = k * __builtin_amdgcn_rcpf(ef); kdb[u] = k * __builtin_amdgcn_rcpf(eb);                                                               \
                        QDF[of] = f2bf(q * ef); QDB[of] = f2bf(q * eb); KDF[of] = f2bf(kdf[u]); KDB[of] = f2bf(kdb[u]); }                                            \
                    pf[i >> 1] = cvt_pk_bf16(kdf[0], kdf[1]); pb[i >> 1] = cvt_pk_bf16(kdb[0], kdb[1]); }                                                              \
                *(u32x4*)(KTF + (size_t)ch * T + t0 + 8 * (i8)) = (u32x4){pf[0], pf[1], pf[2], pf[3]};                                                               \
                *(u32x4*)(KTB + (size_t)ch * T + t0 + 8 * (i8)) = (u32x4){pb[0], pb[1], pb[2], pb[3]}; } while (0)
#define PREP_LDQK(QV, KV, i8) do { _Pragma("unroll") for (int i = 0; i < 8; ++i) { const size_t of = off0 + (size_t)(8 * (i8) + i) * 512; QV[i] = Q0[of]; KV[i] = K0[of]; } } while (0)
            PREP_LDQK(qb2, kb2, 1); PREP_OCT(qa, ka, 0);
            PREP_LDQK(qa, ka, 2);   PREP_OCT(qb2, kb2, 1);
            PREP_LDQK(qb2, kb2, 3); PREP_OCT(qa, ka, 2);
            PREP_OCT(qb2, kb2, 3);
#undef PREP_OCT
#undef PREP_LDQK
            if (o == 0) { EGL[(size_t)m * 512 + ch] = __expf(allf); EGL[(size_t)(GNC2 + m) * 512 + ch] = __expf(allb); }
        }
    }
    __syncthreads();
}
__device__ __forceinline__ void ph_gla_u2(const Ctx& C, const bf16_t* VT, const bf16_t* KTF, const bf16_t* KTB, const float* EGL, bf16_t* U) {
    const int r = C.lane & 31, hh = C.lane >> 5, w = C.wave;
    for (int unit = C.bid; unit < GH * GNC2; unit += C.nb) { const int h = unit / GNC2, m = unit % GNC2, t0 = m * GC2;
        const bf16_t* bp = VT + (size_t)(256 * h + 32 * w + r) * T + t0 + 8 * hh;
        bf16x8 b[16];
#pragma unroll
        for (int s = 0; s < 16; ++s) b[s] = ldfrag(bp + 16 * s);
#pragma unroll
        for (int dir = 0; dir < 2; ++dir) { const bf16_t* KT = dir ? KTB : KTF;
#pragma unroll
            for (int i = 0; i < 8; ++i) { const int rp = w * 8 + i, row = 2 * rp + hh, c = r ^ (row & 15);
                __builtin_amdgcn_global_load_lds((const unsigned*)(KT + (size_t)(128 * h + row) * T + t0 + 8 * c), (LAS unsigned*)((LAS unsigned char*)C.lds + dir * 65536 + rp * 1024), 16, 0, 0); } }
        asm volatile("s_waitcnt vmcnt(0)" ::: "memory");
        __syncthreads();
#pragma unroll
        for (int dir = 0; dir < 2; ++dir) {
            bf16_t* Ub = U + ((size_t)(dir * GH + h) * GNC2 + m) * (GDV * GDK); const float* eg = EGL + (size_t)(dir * GNC2 + m) * 512 + 128 * h;
            const unsigned char* ab = C.lds + dir * 65536 + r * 512; const int y = hh ^ (r & 15);
#pragma unroll
            for (int j = 0; j < 4; ++j) { f32x16 acc = {};
#pragma unroll
                for (int s = 0; s < 16; ++s) acc = MFMA32(*(const bf16x8*)(ab + j * 16384 + 16 * ((2 * s) ^ y)), b[s], acc);
#pragma unroll
                for (int g = 0; g < 4; ++g) { const f32x4 e4 = *(const f32x4*)(eg + 32 * j + 8 * g + 4 * hh);
                    u32x2 o; o.x = cvt_pk_bf16(acc[4 * g] * e4[0], acc[4 * g + 1] * e4[1]); o.y = cvt_pk_bf16(acc[4 * g + 2] * e4[2], acc[4 * g + 3] * e4[3]);
                    *(u32x2*)(Ub + ((w * 8 + 2 * j + (g >> 1)) * 64 + (g & 1) * 32 + r) * 8 + 4 * hh) = o; } } }
        __syncthreads();
    }
}
__device__ __forceinline__ void ph_gla_scan2(const Ctx& C, const bf16_t* U, const float* EGL, bf16_t* ST) {
    for (int el = C.bid * 512 + C.tid; el < 2 * GH * GDV * (GDK / 2); el += C.nb * 512) { const int p = 2 * (el & 16383), h = (el >> 14) & 3, dir = el >> 16;
        const int dk = 16 * ((p >> 9) & 7) + 8 * ((p >> 8) & 1) + (p & 7);
        const size_t eb = (size_t)(dir * GH + h) * GNC2 * (GDV * GDK) + p; const float* eg = EGL + (size_t)dir * GNC2 * 512 + 128 * h + dk;
        float s0 = 0.f, s1 = 0.f;
#pragma unroll 32
        for (int i = 0; i < GNC2; ++i) { const int c = dir ? GNC2 - 1 - i : i; const size_t o = eb + (size_t)c * (GDV * GDK);
            const unsigned u = *(const unsigned*)(U + o); const f32x2 d = *(const f32x2*)(eg + (size_t)c * 512);
            *(unsigned*)(ST + o) = cvt_pk_bf16(s0, s1);
            s0 = d[0] * s0 + bf_lo(u); s1 = d[1] * s1 + bf_hi(u); }
    }
}
__device__ __forceinline__ void ph_gla_out2(const Ctx& C, const bf16_t* QDF, const bf16_t* QDB, const bf16_t* KDF, const bf16_t* KDB, const bf16_t* VT, const bf16_t* ST,
                                            const bf16_t* SR, const float* hnorm, bf16_t* OG) {
    constexpr int VS = 528;
    unsigned char* VL = C.lds;
    const int w = C.wave, r = C.lane & 31, hh = C.lane >> 5;
    for (int unit = C.bid; unit < GH * GNC2; unit += C.nb) { const int h = unit / GNC2, m = unit % GNC2, t0 = m * GC2, T0 = t0 + 32 * w;
#pragma unroll
        for (int dir = 0; dir < 2; ++dir) { const bf16_t* sg = ST + ((size_t)(dir * GH + h) * GNC2 + m) * (GDV * GDK) + C.lane * 8;
#pragma unroll
            for (int i = 0; i < 8; ++i) { const int fg = w + 8 * i;
                __builtin_amdgcn_global_load_lds((const unsigned*)(sg + (size_t)fg * 512), (LAS unsigned*)((LAS unsigned char*)C.lds + dir * 65536 + fg * 1024), 16, 0, 0); } }
        asm volatile("" ::: "memory");
        u32x4 sv[8];
#pragma unroll
        for (int q = 0; q < 8; ++q) { const int ck = C.tid + 512 * q, row = ck >> 5, cc = ck & 31; sv[q] = *(const u32x4*)(VT + (size_t)(256 * h + row) * T + t0 + 8 * cc); }
        asm volatile("s_waitcnt vmcnt(8)" ::: "memory");
        __syncthreads();
        f32x16 o[8];
#pragma unroll
        for (int d = 0; d < 8; ++d) o[d] = f32x16{};
#pragma unroll
        for (int dir = 0; dir < 2; ++dir) { const bf16_t* qp = (dir ? QDB : QDF) + (size_t)(T0 + r) * 512 + 128 * h + 8 * hh;
            const unsigned char* sl = C.lds + dir * 65536 + C.lane * 16;
#pragma unroll
            for (int s = 0; s < 8; ++s) { const bf16x8 a = ldfrag(qp + 16 * s);
#pragma unroll
                for (int d = 0; d < 8; ++d) o[d] = MFMA32(a, *(const bf16x8*)(sl + (d * 8 + s) * 1024), o[d]); } }
        __syncthreads();
#pragma unroll
        for (int q = 0; q < 8; ++q) { const int ck = C.tid + 512 * q, row = ck >> 5, cc = ck & 31; *(u32x4*)(VL + row * VS + 16 * cc) = sv[q]; }
#pragma unroll
        for (int q = 0; q < 8; ++q) { const int ck = C.tid + 512 * (8 + q), row = ck >> 5, cc = ck & 31; sv[q] = *(const u32x4*)(VT + (size_t)(256 * h + row) * T + t0 + 8 * cc); }
        bf16x8 kf[8], qf[8];
#define LOADKQ(KD, QD, sb_) do { const bf16_t* kp_ = (KD) + (size_t)(t0 + 32 * (sb_) + r) * 512 + 128 * h + 8 * hh; const bf16_t* qp_ = (QD) + (size_t)(T0 + r) * 512 + 128 * h + 8 * hh; \
            _Pragma("unroll") for (int s_ = 0; s_ < 8; ++s_) { kf[s_] = ldfrag(kp_ + 16 * s_); qf[s_] = ldfrag(qp_ + 16 * s_); } } while (0)
        LOADKQ(KDF, QDF, 0);
#pragma unroll
        for (int q = 0; q < 8; ++q) { const int ck = C.tid + 512 * (8 + q), row = ck >> 5, cc = ck & 31; *(u32x4*)(VL + row * VS + 16 * cc) = sv[q]; }
        __syncthreads();
        for (int sb = 0; sb < 8; ++sb) {
            f32x16 xt = f32x16{};
#pragma unroll
            for (int s = 0; s < 8; ++s) xt = MFMA32(kf[s], qf[s], xt);
            if (sb == w) {
                LOADKQ(KDB, QDB, sb);
                f32x16 xb = f32x16{};
#pragma unroll
                for (int s = 0; s < 8; ++s) xb = MFMA32(kf[s], qf[s], xb);
#pragma unroll
                for (int q = 0; q < 16; ++q) xt[q] = (crow(q, hh) <= r) ? xt[q] : xb[q]; }
            bf16x8 xa[2];
#pragma unroll
            for (int ks = 0; ks < 2; ++ks) { u32x4 wv; wv.x = cvt_pk_bf16(xt[8 * ks], xt[8 * ks + 1]); wv.y = cvt_pk_bf16(xt[8 * ks + 2], xt[8 * ks + 3]); wv.z = cvt_pk_bf16(xt[8 * ks + 4], xt[8 * ks + 5]); wv.w = cvt_pk_bf16(xt[8 * ks + 6], xt[8 * ks + 7]);
                xa[ks] = *reinterpret_cast<bf16x8*>(&wv); }
            if (sb + 1 < 8) { if (sb + 1 <= w) LOADKQ(KDF, QDF, sb + 1); else LOADKQ(KDB, QDB, sb + 1); }
#pragma unroll
            for (int d = 0; d < 8; ++d) { const unsigned char* vp = VL + (32 * d + r) * VS + (32 * sb + 4 * hh) * 2;
#pragma unroll
                for (int ks = 0; ks < 2; ++ks) { const u32x2 lo = *(const u32x2*)(vp + 32 * ks), hi2 = *(const u32x2*)(vp + 32 * ks + 16); const u32x4 bw = {lo.x, lo.y, hi2.x, hi2.y};
                    o[d] = MFMA32(xa[ks], *reinterpret_cast<const bf16x8*>(&bw), o[d]); } }
        }
#undef LOADKQ
        float rs[16];
#pragma unroll
        for (int q = 0; q < 16; ++q) { float a = 0.f;
#pragma unroll
            for (int d = 0; d < 8; ++d) a += o[d][q] * o[d][q];
#pragma unroll
            for (int of = 1; of < 32; of <<= 1) a += __shfl_xor(a, of);
            rs[q] = __builtin_amdgcn_rsqf(a * (1.0f / 256.0f) + RMS_EPS); }
        __syncthreads();
        bf16_t* slab = (bf16_t*)(VL + w * (32 * VS));
#pragma unroll
        for (int d = 0; d < 8; ++d) { const float gn = hnorm[32 * d + r];
#pragma unroll
            for (int q = 0; q < 16; ++q) slab[crow(q, hh) * (VS / 2) + 32 * d + r] = f2bf(o[d][q] * rs[q] * gn); }
        asm volatile("s_waitcnt lgkmcnt(0)" ::: "memory");
#pragma unroll 4
        for (int i = 0; i < 16; ++i) { const int ck = C.lane + 64 * i, row = ck >> 5, cc = ck & 31;
            const u32x4 ov = *(const u32x4*)((const unsigned char*)slab + row * VS + 16 * cc); const size_t oa = (size_t)(T0 + row) * 1024 + 256 * h + 8 * cc; const u32x4 gv = *(const u32x4*)(SR + oa);
            u32x4 res; res.x = cvt_pk_bf16(bf_lo(ov.x) * bf_lo(gv.x), bf_hi(ov.x) * bf_hi(gv.x)); res.y = cvt_pk_bf16(bf_lo(ov.y) * bf_lo(gv.y), bf_hi(ov.y) * bf_hi(gv.y));
            res.z = cvt_pk_bf16(bf_lo(ov.z) * bf_lo(gv.z), bf_hi(ov.z) * bf_hi(gv.z)); res.w = cvt_pk_bf16(bf_lo(ov.w) * bf_lo(gv.w), bf_hi(ov.w) * bf_hi(gv.w));
            *(u32x4*)(OG + oa) = res; }
        __syncthreads();
    }
}

__device__ __forceinline__ void ph_mla_tok(const Ctx& C, const float* CIN, const int* pos, const float* qn, const float* kvn, const float* invf, bf16_t* CQN, bf16_t* CKVN, float* CS, bf16_t* K) {
    const int l = C.lane;
    f32x4 g0, g1;
    if (l < 32) { g0 = *(const f32x4*)(qn + 8 * l); g1 = *(const f32x4*)(qn + 8 * l + 4); }
    else if (l < 48) { g0 = *(const f32x4*)(kvn + 8 * (l - 32)); g1 = *(const f32x4*)(kvn + 8 * (l - 32) + 4); }
    else { g0 = (f32x4){1.f, 1.f, 1.f, 1.f}; g1 = g0; }
    const float fr = invf[l & 31];
    for (int t = C.gw; t < T; t += C.ngw) {
        const float* row = CIN + (size_t)t * 512; const f32x4 a = *(const f32x4*)(row + 8 * l), b = *(const f32x4*)(row + 8 * l + 4);
        const float ss = (a[0] * a[0] + a[1] * a[1]) + (a[2] * a[2] + a[3] * a[3]) + (b[0] * b[0] + b[1] * b[1]) + (b[2] * b[2] + b[3] * b[3]);
        const float sq = wave_sum(l < 32 ? ss : 0.f), sk = wave_sum((l >= 32 && l < 48) ? ss : 0.f);
        const float rq = 1.0f / sqrtf(sq * (1.0f / 256.0f) + RMS_EPS), rk = 1.0f / sqrtf(sk * (1.0f / 128.0f) + RMS_EPS);
        const float ang = (float)pos[t] * fr; const double rev = (double)ang * 0.15915494309189533577; const float fr01 = (float)(rev - rint(rev));
        const float cv = __builtin_amdgcn_cosf(fr01), sv = __builtin_amdgcn_sinf(fr01);
        if (l < 32) { CS[(size_t)t * 64 + l] = cv; CS[(size_t)t * 64 + 32 + l] = sv; }
        if (l < 32) store8bf(CQN + (size_t)t * 256 + 8 * l, a * rq * g0, b * rq * g1);
        else if (l < 48) store8bf(CKVN + (size_t)t * 256 + 8 * (l - 32), a * rk * g0, b * rk * g1);
        else { const u32x4 z = {0u, 0u, 0u, 0u}; *(u32x4*)(CKVN + (size_t)t * 256 + 128 + 8 * (l - 48)) = z; }
        f32x4 xa = a, xb = b;
        f32x4 pa, pb;
#pragma unroll
        for (int j = 0; j < 4; ++j) { pa[j] = __shfl(xa[j], (l + 4) & 63); pb[j] = __shfl(xb[j], (l + 4) & 63); }
        f32x4 c0, c1, s0, s1;
#pragma unroll
        for (int j = 0; j < 4; ++j) { const int i = 8 * (l & 3) + j; c0[j] = __shfl(cv, i); c1[j] = __shfl(cv, i + 4); s0[j] = __shfl(sv, i); s1[j] = __shfl(sv, i + 4); }
        if (l >= 48 && l < 52) {
            const f32x4 o1a = xa * c0 - pa * s0, o2a = xa * s0 + pa * c0, o1b = xb * c1 - pb * s1, o2b = xb * s1 + pb * c1;
            u32x4 w0, w1; w0.x = cvt_pk_bf16(o1a[0], o1a[1]); w0.y = cvt_pk_bf16(o1a[2], o1a[3]); w0.z = cvt_pk_bf16(o2a[0], o2a[1]); w0.w = cvt_pk_bf16(o2a[2], o2a[3]);
            w1.x = cvt_pk_bf16(o1b[0], o1b[1]); w1.y = cvt_pk_bf16(o1b[2], o1b[3]); w1.z = cvt_pk_bf16(o2b[0], o2b[1]); w1.w = cvt_pk_bf16(o2b[2], o2b[3]);
            if (ATT_FP8) { u32x4 w8; w8.x = pk4fp8(o1a[0], o1a[1], o1a[2], o1a[3]); w8.y = pk4fp8(o2a[0], o2a[1], o2a[2], o2a[3]); w8.z = pk4fp8(o1b[0], o1b[1], o1b[2], o1b[3]); w8.w = pk4fp8(o2b[0], o2b[1], o2b[2], o2b[3]);
#pragma unroll
                for (int h = 0; h < MH; ++h) *(u32x4*)((unsigned char*)K + ((size_t)h * T + t) * MDK + 128 + 16 * (l & 3)) = w8; }
            else {
#pragma unroll
            for (int h = 0; h < MH; ++h) { bf16_t* kp = K + ((size_t)h * T + t) * MDK + 128 + 16 * (l & 3); *(u32x4*)kp = w0; *(u32x4*)(kp + 8) = w1; } }
        }
    }
}

#if MLA_ABSORB
__device__ __forceinline__ void ph_mla_tok_abs(const Ctx& C, const float* CIN, const int* pos, const float* qn, const float* kvn, const float* invf, bf16_t* CQN, float* CS, unsigned char* K8, unsigned char* V8T) {
    const int l = C.lane;
    f32x4 g0, g1;
    if (l < 32) { g0 = *(const f32x4*)(qn + 8 * l); g1 = *(const f32x4*)(qn + 8 * l + 4); }
    else if (l < 48) { g0 = *(const f32x4*)(kvn + 8 * (l - 32)); g1 = *(const f32x4*)(kvn + 8 * (l - 32) + 4); }
    else { g0 = (f32x4){1.f, 1.f, 1.f, 1.f}; g1 = g0; }
    const float fr = invf[l & 31];
    unsigned char* VT = C.lds;
    for (int g = C.bid; g < T / 64; g += C.nb) {
        for (int i = 0; i < 8; ++i) { const int tau = C.wave * 8 + i, t = 64 * g + tau, ps = 32 * ((tau >> 2) & 1) + (tau & 3) + 4 * ((tau >> 3) & 3) + 16 * (tau >> 5);
            const float* row = CIN + (size_t)t * 512; const f32x4 a = *(const f32x4*)(row + 8 * l), b = *(const f32x4*)(row + 8 * l + 4);
            const float ss = (a[0] * a[0] + a[1] * a[1]) + (a[2] * a[2] + a[3] * a[3]) + (b[0] * b[0] + b[1] * b[1]) + (b[2] * b[2] + b[3] * b[3]);
            const float sq = wave_sum(l < 32 ? ss : 0.f), sk = wave_sum((l >= 32 && l < 48) ? ss : 0.f);
            const float rq = 1.0f / sqrtf(sq * (1.0f / 256.0f) + RMS_EPS), rk = 1.0f / sqrtf(sk * (1.0f / 128.0f) + RMS_EPS);
            const float ang = (float)pos[t] * fr; const double rev = (double)ang * 0.15915494309189533577; const float fr01 = (float)(rev - rint(rev));
            const float cv = __builtin_amdgcn_cosf(fr01), sv = __builtin_amdgcn_sinf(fr01);
            if (l < 32) { CS[(size_t)t * 64 + l] = cv; CS[(size_t)t * 64 + 32 + l] = sv; }
            if (l < 32) store8bf(CQN + (size_t)t * 256 + 8 * l, a * rq * g0, b * rq * g1);
            else if (l < 48) { const f32x4 va = a * rk * g0, vb = b * rk * g1; u32x2 w; w.x = pk4fp8(va[0], va[1], va[2], va[3]); w.y = pk4fp8(vb[0], vb[1], vb[2], vb[3]);
                if (ATT8_DMA) { const int c_ = (l - 32) >> 1; *(u32x2*)(K8 + (size_t)g * (64 * MDK) + (tau * 12 + (c_ & ~3) + (((c_ & 3) + ((tau >> 2) & 3)) & 3)) * 16 + 8 * ((l - 32) & 1)) = w; }
                else *(u32x2*)(K8 + (size_t)t * MDK + 8 * (l - 32)) = w;
                unsigned char* vp = VT + (8 * (l - 32)) * 64 + ps;
#pragma unroll
                for (int e = 0; e < 4; ++e) { vp[e * 64] = (unsigned char)((w.x >> (8 * e)) & 0xffu); vp[(4 + e) * 64] = (unsigned char)((w.y >> (8 * e)) & 0xffu); } }
            f32x4 xa = a, xb = b, pa, pb;
#pragma unroll
            for (int j = 0; j < 4; ++j) { pa[j] = __shfl(xa[j], (l + 4) & 63); pb[j] = __shfl(xb[j], (l + 4) & 63); }
            f32x4 c0, c1, s0, s1;
#pragma unroll
            for (int j = 0; j < 4; ++j) { const int ii = 8 * (l & 3) + j; c0[j] = __shfl(cv, ii); c1[j] = __shfl(cv, ii + 4); s0[j] = __shfl(sv, ii); s1[j] = __shfl(sv, ii + 4); }
            if (l >= 48 && l < 52) {
                const f32x4 o1a = xa * c0 - pa * s0, o2a = xa * s0 + pa * c0, o1b = xb * c1 - pb * s1, o2b = xb * s1 + pb * c1;
                u32x4 w8; w8.x = pk4fp8(o1a[0], o1a[1], o1a[2], o1a[3]); w8.y = pk4fp8(o2a[0], o2a[1], o2a[2], o2a[3]); w8.z = pk4fp8(o1b[0], o1b[1], o1b[2], o1b[3]); w8.w = pk4fp8(o2b[0], o2b[1], o2b[2], o2b[3]);
                if (ATT8_DMA) *(u32x4*)(K8 + (size_t)g * (64 * MDK) + (tau * 12 + 8 + (((l & 3) + ((tau >> 2) & 3)) & 3)) * 16) = w8;
                else *(u32x4*)(K8 + (size_t)t * MDK + 128 + 16 * (l & 3)) = w8; }
        }
        __syncthreads();
        { const int c = C.tid >> 2, pc = C.tid & 3;
          if (ATT8_DMA) *(u32x4*)(V8T + (size_t)g * (MDV * 64) + (c * 4 + ((pc + ((c >> 2) & 3)) & 3)) * 16) = *(const u32x4*)(VT + c * 64 + 16 * pc);
          else *(u32x4*)(V8T + (size_t)c * T + 64 * g + 16 * pc) = *(const u32x4*)(VT + c * 64 + 16 * pc); }
        __syncthreads();
    }
}
#endif

namespace att {
constexpr int NW = 8, QBLK = 32, KVBLK = 64;
#ifndef ATT_PVSPLIT
#define ATT_PVSPLIT 0
#endif
#ifndef ATT_SDEPTH
#define ATT_SDEPTH 1
#endif
constexpr int SDEPTH = ATT_SDEPTH;
constexpr float THR2 = 11.5f;
constexpr int SHM_V = KVBLK * MDV * 2, SHM_K = KVBLK * 400, SHM_ATTN = 2 * SHM_V + 2 * SHM_K + NW * 64 * 4;
#define KSWZ(row, colB) ((row) * 400 + (colB))
#define SBAR() __builtin_amdgcn_sched_barrier(0)
__device__ __forceinline__ unsigned cvtpk(float lo, float hi) { unsigned r; asm volatile("v_cvt_pk_bf16_f32 %0, %1, %2" : "=v"(r) : "v"(lo), "v"(hi)); return r; }
__device__ __forceinline__ void partialSM(f32x16& p0, f32x16& p1, float& m_reg, float& mn, float& alpha) {
  float pmax = p0[0];
#pragma unroll
  for (int r = 1; r < 16; ++r) pmax = fmaxf(pmax, p0[r]);
#pragma unroll
  for (int r = 0; r < 16; ++r) pmax = fmaxf(pmax, p1[r]);
  { auto rr = __builtin_amdgcn_permlane32_swap(__float_as_uint(pmax), __float_as_uint(pmax), false, false);
    pmax = fmaxf(__uint_as_float(rr[0]), __uint_as_float(rr[1])); }
  if (__builtin_expect(__all(pmax - m_reg <= THR2), 1)) { mn = m_reg; alpha = 1.f; }
  else { mn = fmaxf(m_reg, pmax); alpha = __builtin_amdgcn_exp2f(m_reg - mn); m_reg = mn; }
#pragma unroll
  for (int r = 0; r < 16; ++r) p0[r] = p0[r] - mn;
#pragma unroll
  for (int r = 0; r < 16; ++r) p1[r] = p1[r] - mn;
#pragma unroll
  for (int r = 0; r < 16; ++r) p0[r] = __builtin_amdgcn_exp2f(p0[r]);
}
__device__ __forceinline__ void finishSM(f32x16& p0, f32x16& p1, float alpha, float& l_reg, bf16x8& pa0, bf16x8& pa1, bf16x8& pa2, bf16x8& pa3) {
#pragma unroll
  for (int r = 0; r < 16; ++r) p1[r] = __builtin_amdgcn_exp2f(p1[r]);
  float ps = 0;
#pragma unroll
  for (int r = 0; r < 16; ++r) ps += p0[r];
#pragma unroll
  for (int r = 0; r < 16; ++r) ps += p1[r];
  { auto rr = __builtin_amdgcn_permlane32_swap(__float_as_uint(ps), __float_as_uint(ps), false, false);
    ps = __uint_as_float(rr[0]) + __uint_as_float(rr[1]); }
  l_reg = l_reg * alpha + ps;
#define PK4(P, BASE, OUT) do { unsigned a0 = cvtpk(P[BASE + 0], P[BASE + 1]), a1 = cvtpk(P[BASE + 2], P[BASE + 3]);   \
    unsigned b0 = cvtpk(P[BASE + 4], P[BASE + 5]), b1 = cvtpk(P[BASE + 6], P[BASE + 7]);                              \
    auto r0 = __builtin_amdgcn_permlane32_swap(a0, b0, false, false); auto r1 = __builtin_amdgcn_permlane32_swap(a1, b1, false, false); \
    u32x4 w = {r0[0], r1[0], r0[1], r1[1]}; OUT = *reinterpret_cast<bf16x8*>(&w); } while (0)
  PK4(p0, 0, pa0); PK4(p0, 8, pa1); PK4(p1, 0, pa2); PK4(p1, 8, pa3);
#undef PK4
}
__device__ __forceinline__ void qkt(f32x16& p0, f32x16& p1, const char* Ks, const bf16x8* qr, int r32, int hi) {
  p0 = f32x16{}; p1 = f32x16{};
#pragma unroll
  for (int d0 = 0; d0 < 12; ++d0) { const int cb = (d0 * 16 + hi * 8) * 2;
    const bf16x8 b0 = *reinterpret_cast<const bf16x8*>(Ks + KSWZ(r32, cb));
    const bf16x8 b1 = *reinterpret_cast<const bf16x8*>(Ks + KSWZ(32 + r32, cb));
    p0 = __builtin_amdgcn_mfma_f32_32x32x16_bf16(b0, qr[d0], p0, 0, 0, 0);
    p1 = __builtin_amdgcn_mfma_f32_32x32x16_bf16(b1, qr[d0], p1, 0, 0, 0); }
}
__device__ __forceinline__ int v_st(int k, int c) { const int kk = (k & ~0xC) | ((k & 4) << 1) | ((k & 8) >> 1); return ((kk >> 3) * 4 + (c >> 5)) * 512 + ((kk & 7) * 32 + (c & 31)) * 2; }
__device__ __forceinline__ int v_rd_base(int lane) { return ((lane & 3) << 3) | (((lane >> 2) & 3) << 6) | (((lane >> 4) & 1) << 5) | (((lane >> 5) & 1) << 8); }
constexpr int v_rd_off(int d0, int ks, int half) { return d0 * 512 + ks * 4096 + half * 2048; }
template <int OFF> __device__ __forceinline__ s16x4 tr_read(int vb) {
  s16x4 r; asm volatile("ds_read_b64_tr_b16 %0, %1 offset:%2" : "=&v"(r) : "v"(vb), "i"(OFF) : "memory"); return r;
}
template <int D0> __device__ __forceinline__ void pv_one(f32x16& od, int vb, bf16x8 pa0, bf16x8 pa1, bf16x8 pa2, bf16x8 pa3) {
#if ATT_PVSPLIT
#define PK(L, H) (bf16x8){L[0], L[1], L[2], L[3], H[0], H[1], H[2], H[3]}
  { const s16x4 l0 = tr_read<v_rd_off(D0, 0, 0)>(vb), h0 = tr_read<v_rd_off(D0, 0, 1)>(vb), l1 = tr_read<v_rd_off(D0, 1, 0)>(vb), h1 = tr_read<v_rd_off(D0, 1, 1)>(vb);
    asm volatile("s_waitcnt lgkmcnt(0)" ::: "memory"); SBAR();
    od = __builtin_amdgcn_mfma_f32_32x32x16_bf16(pa0, PK(l0, h0), od, 0, 0, 0);
    od = __builtin_amdgcn_mfma_f32_32x32x16_bf16(pa1, PK(l1, h1), od, 0, 0, 0); }
  { const s16x4 l2 = tr_read<v_rd_off(D0, 2, 0)>(vb), h2 = tr_read<v_rd_off(D0, 2, 1)>(vb), l3 = tr_read<v_rd_off(D0, 3, 0)>(vb), h3 = tr_read<v_rd_off(D0, 3, 1)>(vb);
    asm volatile("s_waitcnt lgkmcnt(0)" ::: "memory"); SBAR();
    od = __builtin_amdgcn_mfma_f32_32x32x16_bf16(pa2, PK(l2, h2), od, 0, 0, 0);
    od = __builtin_amdgcn_mfma_f32_32x32x16_bf16(pa3, PK(l3, h3), od, 0, 0, 0); }
#undef PK
#else
  const s16x4 l0 = tr_read<v_rd_off(D0, 0, 0)>(vb), h0 = tr_read<v_rd_off(D0, 0, 1)>(vb), l1 = tr_read<v_rd_off(D0, 1, 0)>(vb), h1 = tr_read<v_rd_off(D0, 1, 1)>(vb);
  const s16x4 l2 = tr_read<v_rd_off(D0, 2, 0)>(vb), h2 = tr_read<v_rd_off(D0, 2, 1)>(vb), l3 = tr_read<v_rd_off(D0, 3, 0)>(vb), h3 = tr_read<v_rd_off(D0, 3, 1)>(vb);
  asm volatile("s_waitcnt lgkmcnt(0)" ::: "memory"); SBAR();
#define PK(L, H) (bf16x8){L[0], L[1], L[2], L[3], H[0], H[1], H[2], H[3]}
  od = __builtin_amdgcn_mfma_f32_32x32x16_bf16(pa0, PK(l0, h0), od, 0, 0, 0);
  od = __builtin_amdgcn_mfma_f32_32x32x16_bf16(pa1, PK(l1, h1), od, 0, 0, 0);
  od = __builtin_amdgcn_mfma_f32_32x32x16_bf16(pa2, PK(l2, h2), od, 0, 0, 0);
  od = __builtin_amdgcn_mfma_f32_32x32x16_bf16(pa3, PK(l3, h3), od, 0, 0, 0);
#undef PK
#endif
}
__device__ __forceinline__ void pv_d0(f32x16* o, int vb, bf16x8 pa0, bf16x8 pa1, bf16x8 pa2, bf16x8 pa3) {
  pv_one<0>(o[0], vb, pa0, pa1, pa2, pa3); pv_one<1>(o[1], vb, pa0, pa1, pa2, pa3); pv_one<2>(o[2], vb, pa0, pa1, pa2, pa3); pv_one<3>(o[3], vb, pa0, pa1, pa2, pa3);
}
__device__ __forceinline__ void attn_body(const bf16_t* __restrict__ Qb, const bf16_t* __restrict__ Kh, const bf16_t* __restrict__ Vh, bf16_t* __restrict__ Ob, int ldo, int seq, char* lds) {
  const int tid = threadIdx.x, wid = tid >> 6, lane = tid & 63, r32 = lane & 31, hi = lane >> 5;
  char* V_lds = lds; char* K_lds = lds + 2 * SHM_V;
  float* ws = (float*)(lds + 2 * SHM_V + 2 * SHM_K) + wid * 64; float* li_l = ws; float* al_l = ws + 32;
  float m_reg = -1e30f, l_reg = 0; f32x16 o[4] = {}; bf16x8 qr[12];
  const bf16_t* Qw = Qb + (size_t)(wid * QBLK + r32) * MDK + hi * 8;
#pragma unroll
  for (int d0 = 0; d0 < 12; ++d0) qr[d0] = *reinterpret_cast<const bf16x8*>(Qw + d0 * 16);
  const int sr = tid >> 4, sc = (tid & 15) * 8, vst0 = v_st(sr, sc), vst1 = v_st(32 + sr, sc);
  int kst[3];
#pragma unroll
  for (int i = 0; i < 3; ++i) { const int ck = tid + 512 * i, row = ck / 24, cc = ck - row * 24; kst[i] = KSWZ(row, cc * 16); }
  const int vb0 = (int)(uintptr_t)V_lds + v_rd_base(lane);
  const unsigned vo0 = (unsigned)(sr * MDV + sc), ko0 = (unsigned)(tid * 8);
  struct { bf16x8 vs0, vs1, ks0, ks1, ks2; } sr_[SDEPTH];
#define SLOAD(i, k0) do { const bf16_t* vt_ = Vh + (size_t)(k0) * MDV; const bf16_t* kt_ = Kh + (size_t)(k0) * MDK;                                         \
    sr_[i].vs0 = *reinterpret_cast<const bf16x8*>(vt_ + vo0); sr_[i].vs1 = *reinterpret_cast<const bf16x8*>(vt_ + 32 * MDV + vo0);                               \
    sr_[i].ks0 = *reinterpret_cast<const bf16x8*>(kt_ + ko0); sr_[i].ks1 = *reinterpret_cast<const bf16x8*>(kt_ + 4096 + ko0); sr_[i].ks2 = *reinterpret_cast<const bf16x8*>(kt_ + 8192 + ko0); } while (0)
#define SWRITE(b, i) do { *(bf16x8*)(V_lds + (b) * SHM_V + vst0) = sr_[i].vs0; *(bf16x8*)(V_lds + (b) * SHM_V + vst1) = sr_[i].vs1;               \
    *(bf16x8*)(K_lds + (b) * SHM_K + kst[0]) = sr_[i].ks0; *(bf16x8*)(K_lds + (b) * SHM_K + kst[1]) = sr_[i].ks1; *(bf16x8*)(K_lds + (b) * SHM_K + kst[2]) = sr_[i].ks2; } while (0)
#define SWAIT() do { if constexpr (SDEPTH == 2) asm volatile("s_waitcnt vmcnt(5)" ::: "memory"); else asm volatile("s_waitcnt vmcnt(0)" ::: "memory"); } while (0)
#define RESC(a) do { if (__any((a) < 1.f)) { if (hi == 0) al_l[r32] = (a); asm volatile("s_waitcnt lgkmcnt(0)" ::: "memory"); \
    _Pragma("unroll") for (int d = 0; d < 4; ++d) _Pragma("unroll") for (int r = 0; r < 16; ++r) o[d][r] *= al_l[crow(r, hi)]; } } while (0)
  f32x16 pA0, pA1, pB0, pB1; float mnA, mnB, alA, alB; bf16x8 pa0, pa1, pa2, pa3; const int NT = seq / KVBLK;
  constexpr int SE = 0, SO = SDEPTH - 1;
  SLOAD(SE, 0); asm volatile("s_waitcnt vmcnt(0)" ::: "memory"); SWRITE(0, SE); __syncthreads();
  qkt(pA0, pA1, K_lds, qr, r32, hi); partialSM(pA0, pA1, m_reg, mnA, alA);
  SLOAD(SO, KVBLK); if constexpr (SDEPTH == 2) { if (2 < NT) SLOAD(SE, 2 * KVBLK); }
  SWAIT(); SWRITE(1, SO); __syncthreads();
  for (int j = 1; j + 1 < NT; j += 2) {
    SBAR(); qkt(pB0, pB1, K_lds + SHM_K, qr, r32, hi);
    finishSM(pA0, pA1, alA, l_reg, pa0, pa1, pa2, pa3); SBAR();
    SLOAD(SO, (j + SDEPTH) * KVBLK); SBAR();
    pv_d0(o, vb0, pa0, pa1, pa2, pa3); partialSM(pB0, pB1, m_reg, mnB, alB);
    __syncthreads(); SWAIT(); SWRITE(0, SE);
    RESC(alB); __syncthreads();
    SBAR(); qkt(pA0, pA1, K_lds, qr, r32, hi);
    finishSM(pB0, pB1, alB, l_reg, pa0, pa1, pa2, pa3); SBAR();
    if (SDEPTH == 1 || j + 3 < NT) SLOAD(SE, (j + 1 + SDEPTH) * KVBLK); SBAR();
    pv_d0(o, vb0 + SHM_V, pa0, pa1, pa2, pa3); partialSM(pA0, pA1, m_reg, mnA, alA);
    __syncthreads(); SWAIT(); SWRITE(1, SO);
    RESC(alA); __syncthreads();
  }
  SBAR(); qkt(pB0, pB1, K_lds + SHM_K, qr, r32, hi);
  finishSM(pA0, pA1, alA, l_reg, pa0, pa1, pa2, pa3); SBAR();
  pv_d0(o, vb0, pa0, pa1, pa2, pa3); partialSM(pB0, pB1, m_reg, mnB, alB);
  __syncthreads(); RESC(alB);
  finishSM(pB0, pB1, alB, l_reg, pa0, pa1, pa2, pa3); SBAR();
  pv_d0(o, vb0 + SHM_V, pa0, pa1, pa2, pa3);
  if (hi == 0) li_l[r32] = l_reg; asm volatile("s_waitcnt lgkmcnt(0)" ::: "memory");
  float rli[16];
#pragma unroll
  for (int r = 0; r < 16; ++r) rli[r] = __builtin_amdgcn_rcpf(li_l[crow(r, hi)]);
  bf16_t* Ow = Ob + (size_t)(wid * QBLK) * ldo;
#pragma unroll
  for (int r = 0; r < 16; ++r) { const int orow = crow(r, hi);
#pragma unroll
    for (int d0 = 0; d0 < 4; ++d0) Ow[(size_t)orow * ldo + d0 * 32 + r32] = f2bf(o[d0][r] * rli[r]); }
#undef SLOAD
#undef SWRITE
#undef SWAIT
#undef RESC
}
}


namespace att8 {
constexpr int NW = 8, QBLK = 32, KVBLK = 64, KST = 208, VST = 80;
#ifndef ATT8_SDEPTH
#define ATT8_SDEPTH 1
#endif
constexpr int SDEPTH = ATT8_SDEPTH;
constexpr float THR8 = 8.f; constexpr int THR8I = 0x41000000;
#ifndef ATT8_RING3
#define ATT8_RING3 0
#endif
#ifndef ATT8_QUAD
#define ATT8_QUAD 0
#endif
constexpr int NBUF = ATT8_QUAD ? 4 : (ATT8_RING3 ? 3 : 2);
constexpr int SHM_K = KVBLK * KST, SHM_V = MDV * VST, SHM_ATTN = NBUF * SHM_K + NBUF * SHM_V + NW * 64 * 4;
#define SBAR() __builtin_amdgcn_sched_barrier(0)
#define SGB(mask, n) __builtin_amdgcn_sched_group_barrier((mask), (n), 0)
#ifndef ATT8_EARLYLD
#define ATT8_EARLYLD 1
#endif
#ifndef ATT8_ONEBAR
#define ATT8_ONEBAR 1
#endif
#ifndef ATT8_ILV
#define ATT8_ILV 1
#endif
#ifndef ATT8_ONES
#define ATT8_ONES 1
#endif
#ifndef ILV_NQ
#define ILV_NQ 6
#endif
#ifndef ILV_NP
#define ILV_NP 6
#endif
#define PIN2(a, b) asm volatile("" : "+v"(a), "+v"(b))
#define PIN4(o) asm volatile("" : "+v"(o[0]), "+v"(o[1]), "+v"(o[2]), "+v"(o[3]), "+v"(lacc))
#define ILV_QK() do { if (ATT8_ILV) { SGB(0x100, 4); _Pragma("unroll") for (int i_ = 0; i_ < 6; ++i_) { SGB(0x008, 1); SGB(0x002, ILV_NQ); if (i_ < 4) SGB(0x100, 2); } } } while (0)
#define ILV_PV() do { if (ATT8_ILV) { SGB(0x100, 4); _Pragma("unroll") for (int i_ = 0; i_ < 4 + ATT8_ONES; ++i_) { SGB(0x008, 1); SGB(0x002, ILV_NP); if (i_ < 2) SGB(0x100, 2); } } } while (0)
#define MFMA8(a, b, c) __builtin_amdgcn_mfma_scale_f32_32x32x64_f8f6f4((a), (b), (c), 0, 0, 0, 0x7f7f7f7f, 0, 0x7f7f7f7f)
#define MFMA8Q(a, b, c) __builtin_amdgcn_mfma_scale_f32_32x32x64_f8f6f4((a), (b), (c), 0, 0, 0, 0x7f7f7f7f, 0, 0x7c7c7c7c)
__device__ __forceinline__ i32x8 ld32(const char* p) { const u32x4 a = *(const u32x4*)p, b = *(const u32x4*)(p + 16); return (i32x8){(int)a.x, (int)a.y, (int)a.z, (int)a.w, (int)b.x, (int)b.y, (int)b.z, (int)b.w}; }
typedef short v2i16 __attribute__((ext_vector_type(2)));
#ifndef ATT8_ONES
#define ATT8_ONES 1
#endif
__device__ __forceinline__ float rowmax32(const f32x16& p0, const f32x16& p1) {
  float pmax = fmaxf(fmaxf(p0[0], p0[1]), p0[2]);
#pragma unroll
  for (int r = 3; r < 15; r += 2) pmax = fmaxf(fmaxf(pmax, p0[r]), p0[r + 1]);
  pmax = fmaxf(fmaxf(pmax, p0[15]), p1[0]);
#pragma unroll
  for (int r = 1; r < 15; r += 2) pmax = fmaxf(fmaxf(pmax, p1[r]), p1[r + 1]);
  pmax = fmaxf(pmax, p1[15]);
  auto rr = __builtin_amdgcn_permlane32_swap(__float_as_uint(pmax), __float_as_uint(pmax), false, false);
  return fmaxf(__uint_as_float(rr[0]), __uint_as_float(rr[1]));
}
__device__ __forceinline__ int rowmax32i(const f32x16& p0, const f32x16& p1) {
#define FI_(x) __float_as_int(x)
  int pm = max(max(FI_(p0[0]), FI_(p0[1])), FI_(p0[2]));
#pragma unroll
  for (int r = 3; r < 15; r += 2) pm = max(max(pm, FI_(p0[r])), FI_(p0[r + 1]));
  pm = max(max(pm, FI_(p0[15])), FI_(p1[0]));
#pragma unroll
  for (int r = 1; r < 15; r += 2) pm = max(max(pm, FI_(p1[r])), FI_(p1[r + 1]));
  pm = max(pm, FI_(p1[15]));
#undef FI_
  auto rr = __builtin_amdgcn_permlane32_swap((unsigned)pm, (unsigned)pm, false, false);
  return max((int)rr[0], (int)rr[1]);
}
__device__ __forceinline__ void partialSMi(f32x16& p0, f32x16& p1, int& pmi) {
  pmi = rowmax32i(p0, p1);
#pragma unroll
  for (int r = 0; r < 16; ++r) p0[r] = __builtin_amdgcn_exp2f(p0[r]);
}
template <bool FIRST>
__device__ __forceinline__ void partialSM(f32x16& p0, f32x16& p1, float& m_reg, f32x16& mt, float& alpha, float& sc, float& dsh) {
  const float pmax = rowmax32(p0, p1);
  if constexpr (FIRST) { m_reg += pmax; p0 = p0 - pmax; p1 = p1 - pmax; mt = mt - pmax; alpha = 1.f; sc = 1.f; dsh = 0.f; }
  else { const bool keep = __all(pmax <= THR8); const float d = keep ? 0.f : ceilf(fmaxf(pmax, 0.f));     alpha = __builtin_amdgcn_exp2f(-d); sc = __builtin_amdgcn_exp2f(d); m_reg += d; dsh = d; }
#pragma unroll
  for (int r = 0; r < 16; ++r) p0[r] = __builtin_amdgcn_exp2f(p0[r]);
}
__device__ __forceinline__ void finishSM(f32x16& p0, f32x16& p1, float alpha, float sc, float& l_reg, i32x8& pa) {
#pragma unroll
  for (int r = 0; r < 16; ++r) p1[r] = __builtin_amdgcn_exp2f(p1[r]);
#if !ATT8_ONES
  float ps = 0;
#pragma unroll
  for (int r = 0; r < 16; ++r) ps += p0[r];
#pragma unroll
  for (int r = 0; r < 16; ++r) ps += p1[r];
  { auto rr = __builtin_amdgcn_permlane32_swap(__float_as_uint(ps), __float_as_uint(ps), false, false);
    ps = __uint_as_float(rr[0]) + __uint_as_float(rr[1]); }
  l_reg = (l_reg + ps) * alpha;
#endif
#pragma unroll
  for (int j = 0; j < 4; ++j) { int w_, u_; asm volatile("" : "=v"(w_)); asm volatile("" : "=v"(u_)); v2i16 w = __builtin_bit_cast(v2i16, w_);
    w = __builtin_amdgcn_cvt_scalef32_pk_fp8_f32(w, p0[4 * j], p0[4 * j + 1], sc, false); w = __builtin_amdgcn_cvt_scalef32_pk_fp8_f32(w, p0[4 * j + 2], p0[4 * j + 3], sc, true); pa[j] = __builtin_bit_cast(int, w);
    v2i16 u = __builtin_bit_cast(v2i16, u_);
    u = __builtin_amdgcn_cvt_scalef32_pk_fp8_f32(u, p1[4 * j], p1[4 * j + 1], sc, false); u = __builtin_amdgcn_cvt_scalef32_pk_fp8_f32(u, p1[4 * j + 2], p1[4 * j + 3], sc, true); pa[4 + j] = __builtin_bit_cast(int, u); }
}
__device__ __forceinline__ void qkt(f32x16& p0, f32x16& p1, const char* Ks, const i32x8* qr, const f32x16& mt, int r32, int hi) {
  const char* k0 = Ks + r32 * KST + hi * 32;
  { const i32x8 a0 = ld32(k0), a1 = ld32(k0 + 32 * KST); p0 = MFMA8Q(a0, qr[0], mt); p1 = MFMA8Q(a1, qr[0], mt); }
#pragma unroll
  for (int s = 1; s < 3; ++s) { const i32x8 a0 = ld32(k0 + 64 * s), a1 = ld32(k0 + 32 * KST + 64 * s);
    p0 = MFMA8Q(a0, qr[s], p0); p1 = MFMA8Q(a1, qr[s], p1); }
}
__device__ __forceinline__ void pv(f32x16* o, f32x4& lacc, const char* Vs, const i32x8 pa, const i32x8& ones, int r32, int hi) {
  const char* v0 = Vs + r32 * VST + hi * 32;
#pragma unroll
  for (int d0 = 0; d0 < 4; ++d0) { const i32x8 b = ld32(v0 + d0 * 32 * VST); o[d0] = MFMA8(pa, b, o[d0]); }
  lacc = __builtin_amdgcn_mfma_scale_f32_16x16x128_f8f6f4(pa, ones, lacc, 0, 0, 0, 0x7f7f7f7f, 0, 0x7f7f7f7f);
}
__device__ __forceinline__ void attn_body(const unsigned char* __restrict__ Qb, const unsigned char* __restrict__ Kh, const unsigned char* __restrict__ Vt, bf16_t* __restrict__ Ob, int ldo, int seq, char* lds) {
  const int tid = threadIdx.x, wid = __builtin_amdgcn_readfirstlane(tid >> 6), lane = tid & 63, r32 = lane & 31, hi = lane >> 5;
  char* K_lds = lds; char* V_lds = lds + NBUF * SHM_K;
  float* ws = (float*)(lds + NBUF * SHM_K + NBUF * SHM_V) + wid * 64; float* li_l = ws; float* al_l = ws + 32;
  float m_reg = 0.f, l_reg = 0; f32x16 o[4] = {}; f32x4 lacc = {}; f32x16 mt = {}; i32x8 qr[3]; const int lsl = 4 * (lane >> 4) + 16 * ((lane >> 3) & 1);
  i32x8 ones; { int w1 = (((lane >> 4) & 1) == ((lane >> 3) & 1)) ? 0x38383838 : 0; asm volatile("" : "+v"(w1)); ones = (i32x8){w1, w1, w1, w1, w1, w1, w1, w1}; }
  { const char* Qw = (const char*)Qb + (size_t)(wid * QBLK + r32) * MDK + hi * 32;
#pragma unroll
    for (int s = 0; s < 3; ++s) qr[s] = ld32(Qw + 64 * s); }
  const int kd0 = (tid / 12) * KST + (tid % 12) * 16, kd1 = ((512 + tid) / 12) * KST + ((512 + tid) % 12) * 16, vd = (tid >> 2) * VST + (tid & 3) * 16;
  struct { u32x4 k0, k1, v; } sr_[SDEPTH]; const unsigned ko_ = (unsigned)tid * 16u, vo_ = ((unsigned)(tid >> 2) << 14) | ((unsigned)(tid & 3) << 4);
#define SLOAD(i, t0) do { const unsigned char* kt_ = Kh + (size_t)(t0) * MDK; const unsigned char* kt2_ = kt_ + 8192; const unsigned char* vt_ = Vt + (t0);     \
    asm volatile("global_load_dwordx4 %0, %1, %2" : "=v"(sr_[i].k0) : "v"(ko_), "s"(kt_)); \
    if (wid < 4) asm volatile("global_load_dwordx4 %0, %1, %2" : "=v"(sr_[i].k1) : "v"(ko_), "s"(kt2_)); \
    asm volatile("global_load_dwordx4 %0, %1, %2" : "=v"(sr_[i].v) : "v"(vo_), "s"(vt_)); } while (0)
#define SWRITE_K(b, i) do { *(u32x4*)(K_lds + (b) * SHM_K + kd0) = sr_[i].k0; if (wid < 4) *(u32x4*)(K_lds + (b) * SHM_K + kd1) = sr_[i].k1; } while (0)
#define SWRITE_V(b, i) do { *(u32x4*)(V_lds + (b) * SHM_V + vd) = sr_[i].v; } while (0)
#define SWRITE(b, i) do { SWRITE_K(b, i); SWRITE_V(b, i); } while (0)
#define SWAIT() do { if constexpr (SDEPTH == 2) asm volatile("s_waitcnt vmcnt(3)" ::: "memory"); else asm volatile("s_waitcnt vmcnt(0)" ::: "memory"); } while (0)
#define RESC(pmi, sc) do { (sc) = 1.f; if (!__all((pmi) <= THR8I)) { const float d_ = ceilf(__int_as_float(max((pmi), 0)));     \
    const float a_ = __builtin_amdgcn_exp2f(-d_); (sc) = __builtin_amdgcn_exp2f(d_); mt = mt - d_; if (hi == 0) al_l[r32] = a_; asm volatile("s_waitcnt lgkmcnt(0)" ::: "memory"); \
    lacc *= *(const f32x4*)(al_l + lsl); \
    _Pragma("unroll") for (int d = 0; d < 4; ++d) _Pragma("unroll") for (int r = 0; r < 16; ++r) o[d][r] *= al_l[crow(r, hi)]; } } while (0)
  f32x16 pA0, pA1, pB0, pB1; float alA, alB, scA, scB, dA, dB; int pmA, pmB; i32x8 pa; const int NT = seq / KVBLK;
#if ATT8_QUAD
  {
    const unsigned ko = (unsigned)tid * 16u, vo = ((unsigned)(tid >> 2) << 14) | ((unsigned)(tid & 3) << 4);
    u32x4 pk0[3], pk1[3], pv_[3];
#pragma unroll
    for (int t = 0; t < 3; ++t) { const unsigned char* kt_ = Kh + (size_t)(t * KVBLK) * MDK; pk0[t] = *(const u32x4*)(kt_ + ko); if (wid < 4) pk1[t] = *(const u32x4*)(kt_ + 8192 + ko); pv_[t] = *(const u32x4*)(Vt + t * KVBLK + vo); }
#pragma unroll
    for (int t = 0; t < 3; ++t) { *(u32x4*)(K_lds + t * SHM_K + kd0) = pk0[t]; if (wid < 4) *(u32x4*)(K_lds + t * SHM_K + kd1) = pk1[t]; *(u32x4*)(V_lds + t * SHM_V + vd) = pv_[t]; }
    __syncthreads(); }
  qkt(pA0, pA1, K_lds, qr, mt, r32, hi); partialSM<true>(pA0, pA1, m_reg, mt, alA, scA);
  bool pendV = false;
  for (int j = 1; j + 1 < NT; j += 2) {
    if (pendV) SWRITE_V((j + 1) & 3, 0);
    SBAR(); if (j + 2 < NT) { SLOAD(0, (j + 2) * KVBLK); } SBAR();
    qkt(pB0, pB1, K_lds + (j & 3) * SHM_K, qr, mt, r32, hi);
    finishSM(pA0, pA1, alA, scA, l_reg, pa); ILV_QK(); PIN2(pB0, pB1); SBAR();
    pv(o, V_lds + ((j - 1) & 3) * SHM_V, pa, ones, r32, hi); partialSM<false>(pB0, pB1, m_reg, mt, alB, scB); ILV_PV(); PIN4(o); PIN2(pB0, pB1); SBAR();
    if (j + 2 < NT) { SWRITE((j + 2) & 3, 0); }
    RESC(alB);
    SBAR(); if (j + 3 < NT) { SLOAD(0, (j + 3) * KVBLK); } SBAR();
    qkt(pA0, pA1, K_lds + ((j + 1) & 3) * SHM_K, qr, mt, r32, hi);
    finishSM(pB0, pB1, alB, scB, l_reg, pa); ILV_QK(); PIN2(pA0, pA1); SBAR();
    pv(o, V_lds + (j & 3) * SHM_V, pa, ones, r32, hi); partialSM<false>(pA0, pA1, m_reg, mt, alA, scA); ILV_PV(); PIN4(o); PIN2(pA0, pA1); SBAR();
    pendV = (j + 3 < NT); if (pendV) { SWRITE_K((j + 3) & 3, 0); }
    RESC(alA);
    __syncthreads();
  }
  SBAR(); qkt(pB0, pB1, K_lds + ((NT - 1) & 3) * SHM_K, qr, mt, r32, hi);
  finishSM(pA0, pA1, alA, scA, l_reg, pa); SBAR();
  pv(o, V_lds + ((NT - 2) & 3) * SHM_V, pa, ones, r32, hi); partialSM<false>(pB0, pB1, m_reg, mt, alB, scB);
  RESC(alB);
  finishSM(pB0, pB1, alB, scB, l_reg, pa); SBAR();
  pv(o, V_lds + ((NT - 1) & 3) * SHM_V, pa, ones, r32, hi);
#elif ATT8_RING3
  SLOAD(0, 0); asm volatile("s_waitcnt vmcnt(0)" ::: "memory"); SWRITE(0, 0);
  SLOAD(0, KVBLK); asm volatile("s_waitcnt vmcnt(0)" ::: "memory"); SWRITE(1, 0); __syncthreads();
  qkt(pA0, pA1, K_lds, qr, mt, r32, hi); partialSM<true>(pA0, pA1, m_reg, mt, alA, scA);
  int b0 = 0, b1 = 1, b2 = 2;
#define STEP(c0, c1, alc, scc, n0, n1, aln, scn, jj) do {                                                                     \
    SBAR(); qkt(n0, n1, K_lds + b1 * SHM_K, qr, mt, r32, hi);                                                                  \
    finishSM(c0, c1, alc, scc, l_reg, pa); ILV_QK(); PIN2(n0, n1); SBAR();                                                     \
    SLOAD(0, (((jj) + 2 < NT) ? (jj) + 2 : 0) * KVBLK); SBAR();                                                                \
    pv(o, V_lds + b0 * SHM_V, pa, ones, r32, hi); partialSM<false>(n0, n1, m_reg, mt, aln, scn); ILV_PV(); PIN4(o); PIN2(n0, n1); SBAR(); \
    SWRITE(b2, 0);                                                                                                            \
    RESC(aln);                                                                                                                \
    __syncthreads(); { const int t_ = b0; b0 = b1; b1 = b2; b2 = t_; } } while (0)
  for (int j = 0; j + 2 < NT; j += 2) { STEP(pA0, pA1, alA, scA, pB0, pB1, alB, scB, j); STEP(pB0, pB1, alB, scB, pA0, pA1, alA, scA, j + 1); }
  SBAR(); qkt(pB0, pB1, K_lds + b1 * SHM_K, qr, mt, r32, hi);
  finishSM(pA0, pA1, alA, scA, l_reg, pa); SBAR();
  pv(o, V_lds + b0 * SHM_V, pa, ones, r32, hi); partialSM<false>(pB0, pB1, m_reg, mt, alB, scB);
  RESC(alB);
  finishSM(pB0, pB1, alB, scB, l_reg, pa); SBAR();
  pv(o, V_lds + b1 * SHM_V, pa, ones, r32, hi);
#undef STEP
#else
  constexpr int SE = 0, SO = SDEPTH - 1;
  SLOAD(SE, 0); asm volatile("s_waitcnt vmcnt(0)" ::: "memory"); SWRITE(0, SE);
  if constexpr (SDEPTH == 1) SLOAD(SO, KVBLK);
  __syncthreads();
  qkt(pA0, pA1, K_lds, qr, mt, r32, hi); partialSM<true>(pA0, pA1, m_reg, mt, alA, scA, dA);
  if constexpr (SDEPTH == 2) { SLOAD(SO, KVBLK); if (2 < NT) SLOAD(SE, 2 * KVBLK); }
  SWAIT(); SWRITE(1, SO); __syncthreads();
  for (int j = 1; j + 1 < NT; j += 2) {
    SBAR(); if (ATT8_EARLYLD) { SLOAD(SO, (j + SDEPTH) * KVBLK); SBAR(); } qkt(pB0, pB1, K_lds + SHM_K, qr, mt, r32, hi);
    finishSM(pA0, pA1, alA, scA, l_reg, pa); ILV_QK(); PIN2(pB0, pB1); SBAR();
    if (!ATT8_EARLYLD) { SLOAD(SO, (j + SDEPTH) * KVBLK); SBAR(); }
    pv(o, lacc, V_lds, pa, ones, r32, hi); partialSMi(pB0, pB1, pmB); ILV_PV(); PIN4(o); PIN2(pB0, pB1); SBAR();
#if ATT8_ONEBAR
    SWAIT(); SWRITE_K(0, SE); __syncthreads(); SWRITE_V(0, SE); RESC(pmB, scB);
#else
    __syncthreads(); SWAIT(); SWRITE(0, SE);
    RESC(pmB, scB); __syncthreads();
#endif
    SBAR(); if (ATT8_EARLYLD) { if (SDEPTH == 1 || j + 3 < NT) SLOAD(SE, (j + 1 + SDEPTH) * KVBLK); SBAR(); } qkt(pA0, pA1, K_lds, qr, mt, r32, hi);
    finishSM(pB0, pB1, alB, scB, l_reg, pa); ILV_QK(); PIN2(pA0, pA1); SBAR();
    if (!ATT8_EARLYLD) { if (SDEPTH == 1 || j + 3 < NT) SLOAD(SE, (j + 1 + SDEPTH) * KVBLK); SBAR(); }
    pv(o, lacc, V_lds + SHM_V, pa, ones, r32, hi); partialSMi(pA0, pA1, pmA); ILV_PV(); PIN4(o); PIN2(pA0, pA1); SBAR();
#if ATT8_ONEBAR
    SWAIT(); SWRITE_K(1, SO); __syncthreads(); SWRITE_V(1, SO); RESC(pmA, scA);
#else
    __syncthreads(); SWAIT(); SWRITE(1, SO);
    RESC(pmA, scA); __syncthreads();
#endif
  }
  SBAR(); qkt(pB0, pB1, K_lds + SHM_K, qr, mt, r32, hi);
  finishSM(pA0, pA1, alA, scA, l_reg, pa); SBAR();
  pv(o, lacc, V_lds, pa, ones, r32, hi); partialSMi(pB0, pB1, pmB);
  __syncthreads(); RESC(pmB, scB);
  finishSM(pB0, pB1, alB, scB, l_reg, pa); SBAR();
  pv(o, lacc, V_lds + SHM_V, pa, ones, r32, hi);
#endif
  float rli[16];
  { if ((lane & 7) == 0) *(f32x4*)(li_l + lsl) = lacc; asm volatile("s_waitcnt lgkmcnt(0)" ::: "memory");
#pragma unroll
    for (int r = 0; r < 16; ++r) rli[r] = __builtin_amdgcn_rcpf(li_l[crow(r, hi)]); }
  bf16_t* Ow = Ob + (size_t)(wid * QBLK) * ldo;
#pragma unroll
  for (int r = 0; r < 16; ++r) { const int orow = crow(r, hi);
#pragma unroll
    for (int d0 = 0; d0 < 4; ++d0) { const float ov = o[d0][r] * rli[r];
      if (MLA_FP8) { const float o64 = ov * 64.f;
        ((unsigned char*)Ob)[(size_t)(wid * QBLK + orow) * ldo + d0 * 32 + r32] = (unsigned char)(pk4fp8(o64, o64, o64, o64) & 0xffu); }
      else Ow[(size_t)orow * ldo + d0 * 32 + r32] = f2bf(ov); } }
#undef SLOAD
#undef SWRITE
#undef SWRITE_K
#undef SWRITE_V
#undef SWAIT
#undef RESC
}
#ifndef ATT8_DMA
#define ATT8_DMA 1
#endif
#if ATT8_DMA && MLA_ABSORB
constexpr int DK_T = KVBLK * MDK, DV_T = MDV * KVBLK;
__device__ __forceinline__ int kslot(int row, int c) { return row * 12 + (c & ~3) + (((c & 3) + ((row >> 2) & 3)) & 3); }
__device__ __forceinline__ int vslot(int row, int c) { return row * 4 + ((c + ((row >> 2) & 3)) & 3); }
__device__ __forceinline__ i32x8 ld32s(const char* p0, const char* p1) { const u32x4 a = *(const u32x4*)p0, b = *(const u32x4*)p1; return (i32x8){(int)a.x, (int)a.y, (int)a.z, (int)a.w, (int)b.x, (int)b.y, (int)b.z, (int)b.w}; }
__device__ __forceinline__ void qkt_d(f32x16& p0, f32x16& p1, const char* Ks, int ka0, int ka1, const i32x8* qr, const f32x16& mt) {
  { const i32x8 a0 = ld32s(Ks + ka0, Ks + ka1), a1 = ld32s(Ks + 6144 + ka0, Ks + 6144 + ka1); p0 = MFMA8Q(a0, qr[0], mt); p1 = MFMA8Q(a1, qr[0], mt); }
#pragma unroll
  for (int s = 1; s < 3; ++s) { const i32x8 a0 = ld32s(Ks + 64 * s + ka0, Ks + 64 * s + ka1), a1 = ld32s(Ks + 6144 + 64 * s + ka0, Ks + 6144 + 64 * s + ka1);
    p0 = MFMA8Q(a0, qr[s], p0); p1 = MFMA8Q(a1, qr[s], p1); }
}
__device__ __forceinline__ void pv_d(f32x16* o, f32x4& lacc, const char* Vs, int va0, int va1, const i32x8 pa, const i32x8& ones) {
#pragma unroll
  for (int d0 = 0; d0 < 4; ++d0) { const i32x8 b = ld32s(Vs + 2048 * d0 + va0, Vs + 2048 * d0 + va1); o[d0] = MFMA8(pa, b, o[d0]); }
  lacc = __builtin_amdgcn_mfma_scale_f32_16x16x128_f8f6f4(pa, ones, lacc, 0, 0, 0, 0x7f7f7f7f, 0, 0x7f7f7f7f);
}
__device__ __forceinline__ void attn_body_dma(const unsigned char* __restrict__ Qb, const unsigned char* __restrict__ Kt, const unsigned char* __restrict__ Vt, unsigned char* __restrict__ Ob, int ldo, char* lds) {
  const int tid = threadIdx.x, wid = __builtin_amdgcn_readfirstlane(tid >> 6), lane = tid & 63, r32 = lane & 31, hi = lane >> 5;
  char* K_lds = lds; char* V_lds = lds + 2 * DK_T;
  float* ws = (float*)(lds + 2 * DK_T + 3 * DV_T) + wid * 64; float* li_l = ws; float* al_l = ws + 32;
  float m_reg = 0.f, l_reg = 0; f32x16 o[4] = {}; f32x4 lacc = {}; f32x16 mt = {}; i32x8 qr[3]; const int lsl = 4 * (lane >> 4) + 16 * ((lane >> 3) & 1);
  i32x8 ones; { int w1 = (((lane >> 4) & 1) == ((lane >> 3) & 1)) ? 0x38383838 : 0; asm volatile("" : "+v"(w1)); ones = (i32x8){w1, w1, w1, w1, w1, w1, w1, w1}; }
  { const char* Qw = (const char*)Qb + (size_t)(wid * QBLK + r32) * MDK + hi * 32;
#pragma unroll
    for (int s = 0; s < 3; ++s) qr[s] = ld32(Qw + 64 * s); }
  const int g4 = (r32 >> 2) & 3;
  const int ka0 = r32 * MDK + 16 * ((2 * hi + g4) & 3), ka1 = r32 * MDK + 16 * ((2 * hi + 1 + g4) & 3);
  const int va0 = r32 * 64 + 16 * ((2 * hi + g4) & 3), va1 = r32 * 64 + 16 * ((2 * hi + 1 + g4) & 3);
  constexpr int NT = T / KVBLK; const unsigned dvo_ = (unsigned)lane * 16u + (unsigned)wid * 1024u;
#define KVDMA(t_, kb_, vb_) do { const unsigned char* kg_ = Kt + (size_t)(t_) * DK_T; const unsigned char* vg_ = Vt + (size_t)(t_) * DV_T; asm volatile("" : "+s"(kg_), "+s"(vg_));     \
    __builtin_amdgcn_global_load_lds((const unsigned*)(kg_ + dvo_), (LAS unsigned*)((LAS unsigned char*)K_lds + (kb_) * DK_T + wid * 1024), 16, 0, 0);                                           \
    if (wid < 4) __builtin_amdgcn_global_load_lds((const unsigned*)(kg_ + 8192 + dvo_), (LAS unsigned*)((LAS unsigned char*)K_lds + (kb_) * DK_T + 8192 + wid * 1024), 16, 0, 0);                \
    __builtin_amdgcn_global_load_lds((const unsigned*)(vg_ + dvo_), (LAS unsigned*)((LAS unsigned char*)V_lds + (vb_) + wid * 1024), 16, 0, 0); } while (0)
#define DWAIT() asm volatile("s_waitcnt vmcnt(0)" ::: "memory")
#define RESC(pmi, sc) do { (sc) = 1.f; if (!__all((pmi) <= THR8I)) { const float d_ = ceilf(__int_as_float(max((pmi), 0)));     \
    const float a_ = __builtin_amdgcn_exp2f(-d_); (sc) = __builtin_amdgcn_exp2f(d_); mt = mt - d_; if (hi == 0) al_l[r32] = a_; asm volatile("s_waitcnt lgkmcnt(0)" ::: "memory"); \
    lacc *= *(const f32x4*)(al_l + lsl); \
    _Pragma("unroll") for (int d = 0; d < 4; ++d) _Pragma("unroll") for (int r = 0; r < 16; ++r) o[d][r] *= al_l[crow(r, hi)]; } } while (0)
  f32x16 pA0, pA1, pB0, pB1; float alA, scA, scB, dA; int pmA, pmB; i32x8 pa;
  KVDMA(0, 0, 0); DWAIT(); __syncthreads();
  KVDMA(1, 1, DV_T);
  qkt_d(pA0, pA1, K_lds, ka0, ka1, qr, mt); partialSM<true>(pA0, pA1, m_reg, mt, alA, scA, dA);
  DWAIT(); __syncthreads();
#define HS(KB, VR, VW, c0, c1, scc, n0, n1, pmn, scn, jj) do {                                                                                     \
    SBAR(); KVDMA((jj) + 1, (KB) ^ 1, (VW) * DV_T); SBAR();                                                                                         \
    qkt_d(n0, n1, K_lds + (KB) * DK_T, ka0, ka1, qr, mt); finishSM(c0, c1, 1.f, scc, l_reg, pa); ILV_QK(); PIN2(n0, n1); SBAR();                      \
    pv_d(o, lacc, V_lds + (VR) * DV_T, va0, va1, pa, ones); partialSMi(n0, n1, pmn); ILV_PV(); PIN4(o); PIN2(n0, n1); SBAR();                          \
    DWAIT(); __syncthreads(); RESC(pmn, scn); } while (0)
  int j = 1;
  for (; j + 5 < NT - 1; j += 6) {
    HS(1, 0, 2, pA0, pA1, scA, pB0, pB1, pmB, scB, j);     HS(0, 1, 0, pB0, pB1, scB, pA0, pA1, pmA, scA, j + 1);
    HS(1, 2, 1, pA0, pA1, scA, pB0, pB1, pmB, scB, j + 2); HS(0, 0, 2, pB0, pB1, scB, pA0, pA1, pmA, scA, j + 3);
    HS(1, 1, 0, pA0, pA1, scA, pB0, pB1, pmB, scB, j + 4); HS(0, 2, 1, pB0, pB1, scB, pA0, pA1, pmA, scA, j + 5); }
  HS(1, 0, 2, pA0, pA1, scA, pB0, pB1, pmB, scB, j); HS(0, 1, 0, pB0, pB1, scB, pA0, pA1, pmA, scA, j + 1);
  { SBAR(); qkt_d(pB0, pB1, K_lds + DK_T, ka0, ka1, qr, mt);
    finishSM(pA0, pA1, 1.f, scA, l_reg, pa); SBAR();
    pv_d(o, lacc, V_lds + 2 * DV_T, va0, va1, pa, ones); partialSMi(pB0, pB1, pmB);
    RESC(pmB, scB);
    finishSM(pB0, pB1, 1.f, scB, l_reg, pa); SBAR();
    pv_d(o, lacc, V_lds, va0, va1, pa, ones); }
#undef HS
  float rli[16];
  { if ((lane & 7) == 0) *(f32x4*)(li_l + lsl) = lacc; asm volatile("s_waitcnt lgkmcnt(0)" ::: "memory");
#pragma unroll
    for (int r = 0; r < 16; ++r) rli[r] = __builtin_amdgcn_rcpf(li_l[crow(r, hi)]); }
#pragma unroll
  for (int r = 0; r < 16; ++r) { const int orow = crow(r, hi);
#pragma unroll
    for (int d0 = 0; d0 < 4; ++d0) { const float o64 = o[d0][r] * rli[r] * 64.f;
      Ob[(size_t)(wid * QBLK + orow) * ldo + d0 * 32 + r32] = (unsigned char)(pk4fp8(o64, o64, o64, o64) & 0xffu); } }
#undef KVDMA
#undef DWAIT
#undef RESC
}
#endif
#undef SBAR
#undef SGB
#undef MFMA8
}

#ifdef DBG
constexpr size_t WS_DBG = 256 * 1024;
__device__ __forceinline__ unsigned hash32(unsigned x) { x ^= x >> 16; x *= 0x7feb352dU; x ^= x >> 15; x *= 0x846ca68bU; x ^= x >> 16; return x; }
__device__ __forceinline__ void dbg_acc(float* acc, int slot, float got, float ref) { const float d = got - ref; atomicAdd(acc + 2 * slot, d * d); atomicAdd(acc + 2 * slot + 1, ref * ref); }
__device__ __forceinline__ float dotA(const bf16_t* a, const float* W, int K, int ldw, int n) { float s = 0.f; for (int k = 0; k < K; ++k) s += bf2f(a[k]) * W[(size_t)k * ldw + n]; return s; }
__device__ __forceinline__ float dotA8(const unsigned char* a, const float* W, int K, int ldw, int n) { float s = 0.f; for (int k = 0; k < K; ++k) s += fp8f(a + k) * W[(size_t)k * ldw + n]; return s; }
__device__ __forceinline__ void chk_p1(const Ctx& C, const Args& a, unsigned char* ws, float* acc) {
    const int gt = C.bid * 512 + C.tid; if (gt >= 6144) return;
    const unsigned hs = hash32(gt * 7919u + 13u); const int t = hs % T, kind = gt % 6; const unsigned c0 = hs >> 14;
    const bf16_t* xn = (const bf16_t*)(ws + WS_XN) + (size_t)t * 1024; const float* w_in = (const float*)a.in[5];
    if (kind == 0) { const int c = c0 % 512; dbg_acc(acc, 0, bf2f(((const bf16_t*)(ws + AR_Q0))[(size_t)t * 512 + c]), dotA(xn, w_in, 1024, 3104, c) * 0.08838834764831845f); }
    else if (kind == 1) { const int c = c0 % 512; dbg_acc(acc, 0, bf2f(((const bf16_t*)(ws + AR_K0))[(size_t)t * 512 + c]), dotA(xn, w_in, 1024, 3104, 512 + c)); }
    else if (kind == 2) { const int c = c0 % 1024; dbg_acc(acc, 0, bf2f(((const bf16_t*)(ws + AR_VT))[(size_t)c * T + t]), dotA(xn, w_in, 1024, 3104, 1024 + c)); }
    else if (kind == 3) { const int c = c0 % 1024; dbg_acc(acc, 0, bf2f(((const bf16_t*)(ws + AR_SR))[(size_t)t * 1024 + c]), siluf(dotA(xn, w_in, 1024, 3104, 2048 + c))); }
    else { const int dir = kind - 4, c = c0 % 512; const float* wg = (const float*)a.in[dir ? 8 : 6]; const float* bg = (const float*)a.in[dir ? 9 : 7]; float lg = bg[c];
        for (int j = 0; j < 16; ++j) lg += dotA(xn, w_in, 1024, 3104, 3072 + 16 * dir + j) * wg[j * 512 + c];
        dbg_acc(acc, 1, ((const float*)(ws + (dir ? AR_GB : AR_GF)))[(size_t)t * 512 + c], logsigf(lg) * 0.0625f); }
}
__device__ __forceinline__ void chk_gla(const Ctx& C, const Args& a, unsigned char* ws, float* acc) {
    if (C.bid >= 64) return;
    float* A = (float*)C.lds; float* O = A + 4096; float* red = O + 512;
    const unsigned hs = hash32(C.bid * 977u + 5u); const int t = hs % T, h = (hs >> 14) & 3;
    const bf16_t* Q0 = (const bf16_t*)(ws + AR_Q0); const bf16_t* K0 = (const bf16_t*)(ws + AR_K0); const float* GF = (const float*)(ws + AR_GF); const float* GB = (const float*)(ws + AR_GB);
    const bf16_t* VT = (const bf16_t*)(ws + AR_VT); const bf16_t* SR = (const bf16_t*)(ws + AR_SR); const bf16_t* OG = (const bf16_t*)(ws + WS_XN);
    for (int i = C.tid; i < 4096; i += 512) A[i] = 0.f;
    __syncthreads();
    const int dir = C.tid >> 8, sub = C.tid & 255;
    if (sub < 128) { const int k = sub, ch = 128 * h + k; const float q = bf2f(Q0[(size_t)t * 512 + ch]); float Dk = dir ? __expf(GB[(size_t)t * 512 + ch]) : 1.f;
        for (int i = 0; i < 2048; ++i) { const int s = dir ? t + 1 + i : t - i; const bool valid = s >= 0 && s < T; float w = 0.f;
            if (valid) { w = q * Dk * bf2f(K0[(size_t)s * 512 + ch]); Dk *= __expf((dir ? GB : GF)[(size_t)s * 512 + ch]); }
            w = wave_sum(w); if (C.lane == 0) atomicAdd(&A[dir * 2048 + i], w); } }
    __syncthreads();
    { float o = 0.f; for (int i = 0; i < 2048; ++i) { const int s = dir ? t + 1 + i : t - i; if (s >= 0 && s < T) o += A[dir * 2048 + i] * bf2f(VT[(size_t)(256 * h + sub) * T + s]); } O[dir * 256 + sub] = o; }
    __syncthreads();
    if (C.tid < 256) { const float o = O[C.tid] + O[256 + C.tid]; float ss = wave_sum(o * o); if (C.lane == 0) red[C.wave] = ss; }
    __syncthreads();
    if (C.tid < 256) { const float o = O[C.tid] + O[256 + C.tid]; const float ss = red[0] + red[1] + red[2] + red[3]; const float r = 1.0f / sqrtf(ss * (1.0f / 256.0f) + RMS_EPS);
        const size_t oi = (size_t)t * 1024 + 256 * h + C.tid; dbg_acc(acc, 2, bf2f(OG[oi]), o * r * ((const float*)a.in[10])[C.tid] * bf2f(SR[oi])); }
    __syncthreads();
}
__device__ __forceinline__ void chk_resid(const Ctx& C, const float* base, const bf16_t* A, int K, const float* W, const float* HAp, float* acc, int slot) {
    const int gt = C.bid * 512 + C.tid; if (gt >= 4096) return;
    const unsigned hs = hash32(gt * 31u + slot); const int t = hs % T, n = (hs >> 14) % 1024;
    const float dv = (slot == 14 && ATT_FP8 && MLA_FP8) ? dotA8((const unsigned char*)A + (size_t)t * K, W, K, 1024, n) * (1.0f / 64.f) : dotA(A + (size_t)t * K, W, K, 1024, n);
    dbg_acc(acc, slot, HAp[(size_t)t * 1024 + n] - base[(size_t)t * 1024 + n], dv); return;
    dbg_acc(acc, slot, HAp[(size_t)t * 1024 + n], base[(size_t)t * 1024 + n] + dotA(A + (size_t)t * K, W, K, 1024, n));
}
__device__ __forceinline__ void chk_router(const Ctx& C, const float* Hin, const float* gain, const float* Wr, const bf16_t* XN, const float* AFF, float* acc, int slot) {
    const int gt = C.bid * 512 + C.tid; if (gt >= 512) return;
    const int t = hash32(gt * 101u + 7u) % T; const float* hr = Hin + (size_t)t * 1024; float ss = 0.f; for (int k = 0; k < 1024; ++k) ss += hr[k] * hr[k];
    const float r = 1.0f / sqrtf(ss / 1024.0f + RMS_EPS); float lg[16]; for (int e = 0; e < 16; ++e) lg[e] = 0.f;
    for (int k = 0; k < 1024; ++k) { const float xv = hr[k] * r * gain[k]; for (int e = 0; e < 16; ++e) lg[e] += xv * Wr[k * 16 + e]; if ((k & 63) == (gt & 63)) dbg_acc(acc, slot, bf2f(XN[(size_t)t * 1024 + k]), xv); }
    float mx = lg[0]; for (int e = 1; e < 16; ++e) mx = fmaxf(mx, lg[e]); float s = 0.f; for (int e = 0; e < 16; ++e) { lg[e] = expf(lg[e] - mx); s += lg[e]; }
    for (int e = 0; e < 16; ++e) dbg_acc(acc, slot, AFF[(size_t)t * 16 + e], lg[e] / s);
}
__device__ __forceinline__ void chk_select(const Ctx& C, const float* AFF, const int* SEL, const int* IDX, unsigned* dw) {
    const int gt = C.bid * 512 + C.tid;
    for (int p = gt; p < T * 16; p += C.nb * 512) { const int t = p >> 4, e = p & 15; const int s = SEL[p]; const unsigned b = __float_as_uint(AFF[p]);
        if (s > 0) { atomicAdd(&dw[e], 1u); atomicMax(&dw[16 + e], ~b); if (s > CAP || IDX[e * CAP + s - 1] != t) atomicAdd(&dw[48], 1u); } else { atomicMax(&dw[32 + e], b); if (s < 0) atomicAdd(&dw[48], 1u); } }
}
__device__ __forceinline__ void chk_moe_h(const Ctx& C, const Args& a, unsigned char* ws, int layer, float* acc, int slot) {
    const int gt = C.bid * 512 + C.tid; if (gt >= 2048) return;
    const unsigned hs = hash32(gt * 53u + 3u); const int e = hs & 15, sl = (hs >> 4) % CAP, f = (hs >> 15) % FF; const int t = ((const int*)(ws + WS_IDX))[e * CAP + sl];
    if (t < 0 || t >= T) { dbg_acc(acc, slot, 1e3f, 0.f); return; }
    const size_t wo = (size_t)(layer * NE + e) * 1024 * 2048; const size_t row = (size_t)e * CAP + sl;
#if MOE_FP8
    const unsigned char* xn = ws + AR_XN8 + (size_t)t * 1024;
    const float g = dotA8(xn, (const float*)a.in[19] + wo, 1024, 2048, f), u = dotA8(xn, (const float*)a.in[20] + wo, 1024, 2048, f);
    dbg_acc(acc, slot, fp8f(ws + AR_H + row * FF + f), siluf(g) * u);
    dbg_acc(acc, slot, fp8f(ws + AR_XS + row * 1024 + (f & 1023)), fp8f(xn + (f & 1023)));
#else
    const bf16_t* xn = (const bf16_t*)(ws + WS_XN) + (size_t)t * 1024;
    const float g = dotA(xn, (const float*)a.in[19] + wo, 1024, 2048, f), u = dotA(xn, (const float*)a.in[20] + wo, 1024, 2048, f);
    dbg_acc(acc, slot, bf2f(((const bf16_t*)(ws + AR_H))[row * FF + f]), siluf(g) * u);
    dbg_acc(acc, slot, bf2f(((const bf16_t*)(ws + AR_XS))[row * 1024 + (f & 1023)]), bf2f(xn[f & 1023]));
#endif
}
__device__ __forceinline__ void chk_moe_y(const Ctx& C, const Args& a, unsigned char* ws, int layer, float* acc, int slot) {
    const int gt = C.bid * 512 + C.tid; if (gt >= 2048) return;
    const unsigned hs = hash32(gt * 59u + 11u); const int e = hs & 15, sl = (hs >> 4) % CAP, n = (hs >> 15) % 1024; const size_t row = (size_t)e * CAP + sl; const float* wd = (const float*)a.in[21] + (size_t)(layer * NE + e) * 2048 * 1024;
#if MOE_FP8
    const float ref = dotA8(ws + AR_H + row * FF, wd, 2048, 1024, n);
#else
    const float ref = dotA((const bf16_t*)(ws + AR_H) + row * FF, wd, 2048, 1024, n);
#endif
    dbg_acc(acc, slot, bf2f(((const bf16_t*)(ws + AR_Y))[row * 1024 + n]), ref);
}
__device__ __forceinline__ void chk_combine(const Ctx& C, unsigned char* ws, const float* Hin, const float* Hout, float* acc, int slot) {
    const int gt = C.bid * 512 + C.tid; if (gt >= 4096) return;
    const unsigned hs = hash32(gt * 67u + 1u); const int t = hs % T, n = (hs >> 14) % 1024; float ref = Hin[(size_t)t * 1024 + n];
    for (int e = 0; e < 16; ++e) { const int s = ((const int*)(ws + WS_SEL))[t * 16 + e]; if (s > 0) ref += ((const float*)(ws + WS_AFF))[t * 16 + e] * bf2f(((const bf16_t*)(ws + AR_Y))[((size_t)e * CAP + s - 1) * 1024 + n]); }
    dbg_acc(acc, slot, Hout[(size_t)t * 1024 + n], ref);
}
__device__ __forceinline__ void chk_cin(const Ctx& C, const Args& a, unsigned char* ws, float* acc) {
    const int gt = C.bid * 512 + C.tid; if (gt >= 4096) return;
    const unsigned hs = hash32(gt * 71u + 9u); const int t = hs % T, n = (hs >> 14) % 448;
    dbg_acc(acc, 10, ((const float*)(ws + AR_CIN))[(size_t)t * 512 + n], (ATT_FP8 && MLA_FP8) ? dotA8(ws + WS_XN + (size_t)t * 1024, (const float*)a.in[12], 1024, 448, n) : dotA((const bf16_t*)(ws + WS_XN) + (size_t)t * 1024, (const float*)a.in[12], 1024, 448, n));
}
__device__ __forceinline__ void chk_tok(const Ctx& C, const Args& a, unsigned char* ws, float* acc) {
    const int gt = C.bid * 512 + C.tid; if (gt >= 1024) return;
    const unsigned hs = hash32(gt * 73u + 19u); const int t = hs % T, h = (hs >> 14) & 15; const float* row = (const float*)(ws + AR_CIN) + (size_t)t * 512;
    float sq = 0.f, sk = 0.f; for (int i = 0; i < 256; ++i) sq += row[i] * row[i]; for (int i = 0; i < 128; ++i) sk += row[256 + i] * row[256 + i];
    const float rq = 1.0f / sqrtf(sq / 256.0f + RMS_EPS), rk = 1.0f / sqrtf(sk / 128.0f + RMS_EPS);
    const int i = (hs >> 18) % 256; dbg_acc(acc, 11, bf2f(((const bf16_t*)(ws + AR_CQN))[(size_t)t * 256 + i]), row[i] * rq * ((const float*)a.in[13])[i]);
    const int j = i & 127; dbg_acc(acc, 11, bf2f(((const bf16_t*)(ws + AR_CKVN))[(size_t)t * 256 + j]), row[256 + j] * rk * ((const float*)a.in[15])[j]);
    dbg_acc(acc, 11, 1.f + bf2f(((const bf16_t*)(ws + AR_CKVN))[(size_t)t * 256 + 128 + j]), 1.f);
    const int f = i & 31; const float ang = (float)((const int*)a.in[1])[t] * a.invf[f]; double xr = (double)ang * 0.15915494309189533577; xr = (xr - rint(xr)) * 6.283185307179586477; double cd = 1.0, sd = xr, tc = 1.0, ts = xr; for (int n = 1; n < 16; ++n) { tc *= -xr * xr / ((2.0 * n - 1.0) * (2.0 * n)); ts *= -xr * xr / ((2.0 * n) * (2.0 * n + 1.0)); cd += tc; sd += ts; } const float cr = (float)cd, sr = (float)sd;
    dbg_acc(acc, 11, ((const float*)(ws + WS_CS))[(size_t)t * 64 + f], cr); dbg_acc(acc, 11, ((const float*)(ws + WS_CS))[(size_t)t * 64 + 32 + f], sr);
    const float x1 = row[384 + f], x2 = row[416 + f]; const bf16_t* kp = (const bf16_t*)(ws + AR_K) + ((size_t)h * T + t) * MDK + 128 + 8 * (f >> 2) + (f & 3);
    dbg_acc(acc, 11, bf2f(kp[0]), x1 * cr - x2 * sr); dbg_acc(acc, 11, bf2f(kp[4]), x1 * sr + x2 * cr);
}
__device__ __forceinline__ void chk_qkv(const Ctx& C, const Args& a, unsigned char* ws, float* acc) {
    const int gt = C.bid * 512 + C.tid; if (gt >= 4096) return;
    const unsigned hs = hash32(gt * 79u + 29u); const int t = hs % T, h = (hs >> 14) & 15, j = (hs >> 18) & 127, kind = gt & 3; const float QS = (ATT_FP8 ? 8.0f : 1.0f) * 0.07216878364870322f * 1.4426950408889634f;
    const bf16_t* cq = (const bf16_t*)(ws + AR_CQN) + (size_t)t * 256; const bf16_t* ck = (const bf16_t*)(ws + AR_CKVN) + (size_t)t * 256;
    const size_t qo = ((size_t)h * T + t) * MDK; const int tau = t & 63, pos = 32 * ((tau >> 2) & 1) + (tau & 3) + 4 * ((tau >> 3) & 3) + 16 * (tau >> 5);
#if ATT_FP8
#define QV(i) fp8f(ws + AR_Q8 + qo + (i))
#define KV(i) fp8f(ws + AR_K8 + qo + (i))
#define VV(i) fp8f(ws + AR_V8T + ((size_t)h * MDV + (i)) * T + (t & ~63) + pos)
#else
#define QV(i) bf2f(((const bf16_t*)(ws + AR_Q))[qo + (i)])
#define KV(i) bf2f(((const bf16_t*)(ws + AR_K))[qo + (i)])
#define VV(i) bf2f(((const bf16_t*)(ws + AR_V))[((size_t)h * T + t) * MDV + (i)])
#endif
    if (kind == 0) dbg_acc(acc, 12, QV(j), dotA(cq, (const float*)a.in[14], 256, 3072, 192 * h + j) * QS);
    else if (kind == 1) { const int f = j & 31; const float x1 = dotA(cq, (const float*)a.in[14], 256, 3072, 192 * h + 128 + f), x2 = dotA(cq, (const float*)a.in[14], 256, 3072, 192 * h + 160 + f);
        const float cr = ((const float*)(ws + WS_CS))[(size_t)t * 64 + f], sr = ((const float*)(ws + WS_CS))[(size_t)t * 64 + 32 + f]; const int qp = 128 + 8 * (f >> 2) + (f & 3);
        dbg_acc(acc, 12, QV(qp), (x1 * cr - x2 * sr) * QS); dbg_acc(acc, 12, QV(qp + 4), (x1 * sr + x2 * cr) * QS);
        const float* row = (const float*)(ws + AR_CIN) + (size_t)t * 512; const float k1 = row[384 + f], k2 = row[416 + f];
        dbg_acc(acc, 12, KV(qp), k1 * cr - k2 * sr); dbg_acc(acc, 12, KV(qp + 4), k1 * sr + k2 * cr); }
    else if (kind == 2) dbg_acc(acc, 12, KV(j), dotA(ck, (const float*)a.in[16], 128, 4096, 256 * h + j));
    else dbg_acc(acc, 12, VV(j), dotA(ck, (const float*)a.in[16], 128, 4096, 256 * h + 128 + j));
#undef QV
#undef KV
#undef VV
}
__device__ __forceinline__ void chk_attn(const Ctx& C, unsigned char* ws, float* acc) {
    if (C.bid >= 64) return;
    float* P = (float*)C.lds; float* red = P + T; float* qs = red + 32;
    const unsigned hs = hash32(C.bid * 991u + 77u); const int t = hs % T, h = (hs >> 14) & 15;
#if ATT_FP8
    const unsigned char* Q = ws + AR_Q8 + ((size_t)h * T + t) * MDK; const unsigned char* K = ws + AR_K8 + (size_t)h * T * MDK; const unsigned char* V = ws + AR_V8T + (size_t)h * MDV * T; const float SC = 0.125f;
    if (C.tid < MDK) qs[C.tid] = fp8f(Q + C.tid);
#define KEL(j, d) fp8f(K + (size_t)(j) * MDK + (d))
#define VEL(j, d) fp8f(V + (size_t)(d) * T + ((j) & ~63) + 32 * ((((j) & 63) >> 2) & 1) + ((j) & 3) + 4 * ((((j) & 63) >> 3) & 3) + 16 * (((j) & 63) >> 5))
#else
    const bf16_t* Q = (const bf16_t*)(ws + AR_Q) + ((size_t)h * T + t) * MDK; const bf16_t* K = (const bf16_t*)(ws + AR_K) + (size_t)h * T * MDK; const bf16_t* V = (const bf16_t*)(ws + AR_V) + (size_t)h * T * MDV; const float SC = 1.0f;
    if (C.tid < MDK) qs[C.tid] = bf2f(Q[C.tid]);
#define KEL(j, d) bf2f(K[(size_t)(j) * MDK + (d)])
#define VEL(j, d) bf2f(V[(size_t)(j) * MDV + (d)])
#endif
    __syncthreads();
    float mx = -1e30f;
    for (int j = C.tid; j < T; j += 512) { float s = 0.f; for (int d = 0; d < MDK; ++d) s += qs[d] * KEL(j, d); s *= SC; P[j] = s; mx = fmaxf(mx, s); }
    mx = wave_max(mx); if (C.lane == 0) red[C.wave] = mx;
    __syncthreads();
    mx = red[0]; for (int w = 1; w < 8; ++w) mx = fmaxf(mx, red[w]);
    float sm = 0.f; for (int j = C.tid; j < T; j += 512) { const float p = exp2f(P[j] - mx); P[j] = p; sm += p; }
    sm = wave_sum(sm);
    __syncthreads();
    if (C.lane == 0) red[8 + C.wave] = sm;
    __syncthreads();
    sm = 0.f; for (int w = 0; w < 8; ++w) sm += red[8 + w];
    if (C.tid < MDV) { float o = 0.f; for (int j = 0; j < T; ++j) o += P[j] * VEL(j, C.tid); const float got = (ATT_FP8 && MLA_FP8) ? fp8f(ws + AR_O + (size_t)t * 2048 + 128 * h + C.tid) * (1.0f / 64.f) : bf2f(((const bf16_t*)(ws + AR_O))[(size_t)t * 2048 + 128 * h + C.tid]); dbg_acc(acc, 13, got * 100.f, o / sm * 100.f); }
    __syncthreads();
#undef KEL
#undef VEL
}
__device__ __forceinline__ void dbg_report(const Ctx& C, unsigned char* ws, float* out, int lo, int hi) {
    const float* acc = (const float*)(ws + WS_DBG); const unsigned* dw = (const unsigned*)(ws + WS_DBG + 1024);
    int code = 90;
    for (int s = lo; s < hi && code == 90; ++s) { float num = __hip_atomic_load(acc + 2 * s, __ATOMIC_RELAXED, __HIP_MEMORY_SCOPE_AGENT), den = __hip_atomic_load(acc + 2 * s + 1, __ATOMIC_RELAXED, __HIP_MEMORY_SCOPE_AGENT);
        if (s == 5) { unsigned viol = __hip_atomic_load(dw + 48, __ATOMIC_RELAXED, __HIP_MEMORY_SCOPE_AGENT); for (int e = 0; e < 16; ++e) { const unsigned cnt = __hip_atomic_load(dw + e, __ATOMIC_RELAXED, __HIP_MEMORY_SCOPE_AGENT), mn = ~__hip_atomic_load(dw + 16 + e, __ATOMIC_RELAXED, __HIP_MEMORY_SCOPE_AGENT), mxu = __hip_atomic_load(dw + 32 + e, __ATOMIC_RELAXED, __HIP_MEMORY_SCOPE_AGENT); if (cnt != CAP) viol += 1000; if (mn < mxu) viol += 1; }
            num = (float)viol; den = 1.f; if (viol == 0) continue; code = 10 * (s - lo) + (viol >= 1000 ? 0 : (viol >= 100 ? 1 : (viol >= 10 ? 2 : 3))); break; }
        if (den == 0.f && num == 0.f) continue;
        const float e = sqrtf(num / den);
        if (!(e < 0.03f)) { const int b = !(e < 1.f) ? 0 : (e >= 0.3f ? 1 : (e >= 0.1f ? 2 : 3)); code = 10 * (s - lo) + b; } }
    if (code == 90) { float worst = 0.f; for (int s = lo; s < hi; ++s) { if (s == 5) continue; const float num = acc[2 * s], den = acc[2 * s + 1]; if (den > 0.f) worst = fmaxf(worst, sqrtf(num / den)); }
        code = 90 + (worst >= 0.01f ? 1 : (worst >= 0.003f ? 2 : 3)); }
#ifdef DBGSLOT
    { const int sl = DBGSLOT; const float num = acc[2 * sl], den = acc[2 * sl + 1]; const float e = sqrtf(num / den); code = !(e > 0.f) ? 99 : (e >= 1.f ? 0 : (int)fminf(89.f, -20.f * log10f(e))); }
#endif
    if (DBG >= 2) { const int sl = DBG == 2 ? 13 : 12; const float num = acc[2 * sl], den = acc[2 * sl + 1]; const float e = sqrtf(num / den); code = !(e > 0.f) ? 99 : (e >= 1.f ? 0 : (int)fminf(89.f, -20.f * log10f(e))); }
    const float c = sqrtf((float)code);
    for (size_t i = (size_t)C.bid * 512 + C.tid; i < (size_t)T * D; i += (size_t)C.nb * 512) out[i] = c;
}
#endif

constexpr int NPHASE = 24;
__global__ void __launch_bounds__(512, 2) mk_fwd(Args args) {
    extern __shared__ __attribute__((aligned(16))) unsigned char lds[];
    Ctx C; C.tid = threadIdx.x; C.lane = C.tid & 63; C.wave = __builtin_amdgcn_readfirstlane(C.tid >> 6); C.bid = blockIdx.x; C.nb = gridDim.x;
    C.gw = C.bid * 8 + C.wave; C.ngw = C.nb * 8; C.lds = lds;
    unsigned char* ws = args.ws;
    volatile LAS unsigned* MISC = (volatile LAS unsigned*)((LAS unsigned char*)lds + LDS_MISC);
    if (C.tid < 32) MISC[C.tid] = 0u;
    __syncthreads();
    XcdBarrier bar = xcd_barrier_post((unsigned*)(ws + WS_CTL) + 4096 + args.li * XCD_BAR_WORDS, MISC + 8);
    const int lo = args.ph_lo, hi = args.ph_hi;
#if defined(PH_MASK)
#define IN(k) ((((PH_MASK) >> (k)) & 1u) && lo <= (k) && (k) < hi)
#elif defined(PH_ONLY)
#define IN(k) ((k) == PH_ONLY && lo <= (k) && (k) < hi)
#else
#define IN(k) (lo <= (k) && (k) < hi)
#endif
#ifndef PROBE_MUL
#define PROBE_MUL 3
#endif
#ifdef PROBE_PH
    volatile LAS unsigned long long* tpw_ = (volatile LAS unsigned long long*)((LAS unsigned char*)lds + LDS_MISC + 64);
#define PROBE_T0(k) do { if ((k) == PROBE_PH && C.bid == 0 && C.tid == 0) tpw_[0] = wall_clock64(); } while (0)
#define SEAM(k) do { if (IN((k) + 1)) xcd_barrier(bar); if ((k) == PROBE_PH && C.bid == 0 && C.tid == 0) tpw_[1] += wall_clock64() - tpw_[0]; } while (0)
#else
#define PROBE_T0(k) do { } while (0)
#define SEAM(k) do { if (IN((k) + 1)) xcd_barrier(bar); } while (0)
#endif
#ifndef REPMASK
#define REPMASK 0u
#endif
#define NREP(k) ((((REPMASK) >> (k)) & 1u) ? 2 : 1)
#ifdef DBG
    float* dacc = (float*)(ws + WS_DBG); unsigned* ddw = (unsigned*)(ws + WS_DBG + 1024);
#define DBGCHK(page, call) do { if ((DBG >= 2 ? 1 : DBG) == (page)) { call; xcd_barrier(bar); } } while (0)
#else
#define DBGCHK(page, call) do { } while (0)
#endif
    PG8_LAS unsigned char* glds = (PG8_LAS unsigned char*)lds;
    const float* x = (const float*)args.in[0];
#define HA (args.out)
#define HB ((float*)(ws + WS_HB))
#define XN ((bf16_t*)(ws + WS_XN))
#define AFF ((float*)(ws + WS_AFF))
#define SEL ((int*)(ws + WS_SEL))
#define IDX ((int*)(ws + WS_IDX))
#define WGU ((bf16_t*)(ws + WS_WGU))
#define WD ((bf16_t*)(ws + WS_WD))
#define XS ((bf16_t*)(ws + AR_XS))
#define HH ((bf16_t*)(ws + AR_H))
#define YY ((bf16_t*)(ws + AR_Y))

    if (IN(0)) { PROBE_T0(0); if (MLA_ABSORB) ph_mla_absorb(C, args, ws); ph_convert_small(C, args, ws); ph_convert_moe(C, args, ws, 0, NREP(0), 0, CV_NIT, C.gw, C.ngw); ph_norm(C, x, (const float*)args.in[2], XN); SEAM(0); }
    if (IN(1)) { PROBE_T0(1);
        { pg8::Gemm g{XN, (const bf16_t*)(ws + WS_WGIN), T, 3072, 1024}; pg8::StaticOrder S; S.init(T, 3072, C.nb, C.bid); S.rep = NREP(1);
          pg8::EpiGlaIn E{(bf16_t*)(ws + AR_Q0), (bf16_t*)(ws + AR_K0), (bf16_t*)(ws + AR_SR), (float*)(ws + AR_GF), (float*)(ws + AR_GB), (const float*)args.in[7], (const float*)args.in[9]};
          pg8::gemm_phase<pg8::EpiGlaIn, pg8::StaticOrder, false, PG8_SP2>(glds, g, S, E); }
        { pg8::Gemm g{(const bf16_t*)(ws + WS_WV), XN, 1024, T, 1024}; pg8::StaticOrder S; S.init(1024, T, C.nb, C.bid); S.rep = NREP(1);
          pg8::EpiBf E{(bf16_t*)(ws + AR_VT), T};
          pg8::gemm_phase<pg8::EpiBf, pg8::StaticOrder, PG8_ALIGN, PG8_SP2>(glds, g, S, E); }
        SEAM(1); } DBGCHK(0, chk_p1(C, args, ws, dacc));
#if GLA256
    if (IN(2)) { PROBE_T0(2); ph_gla_prep2(C, (const bf16_t*)(ws + AR_Q0), (const bf16_t*)(ws + AR_K0), (const float*)(ws + AR_GF), (const float*)(ws + AR_GB), (bf16_t*)(ws + AR_QDF), (bf16_t*)(ws + AR_QDB),
                             (bf16_t*)(ws + AR_KDF), (bf16_t*)(ws + AR_KDB), (bf16_t*)(ws + AR_KTF), (bf16_t*)(ws + AR_KTB), (float*)(ws + WS_EGL)); SEAM(2); }
    if (IN(3)) { PROBE_T0(3); ph_gla_u2(C, (const bf16_t*)(ws + AR_VT), (const bf16_t*)(ws + AR_KTF), (const bf16_t*)(ws + AR_KTB), (const float*)(ws + WS_EGL), (bf16_t*)(ws + AR_U)); SEAM(3); }
    if (IN(4)) { PROBE_T0(4); ph_gla_scan2(C, (const bf16_t*)(ws + AR_U), (const float*)(ws + WS_EGL), (bf16_t*)(ws + AR_ST)); SEAM(4); }
    if (IN(5)) { PROBE_T0(5); ph_gla_out2(C, (const bf16_t*)(ws + AR_QDF), (const bf16_t*)(ws + AR_QDB), (const bf16_t*)(ws + AR_KDF), (const bf16_t*)(ws + AR_KDB), (const bf16_t*)(ws + AR_VT), (const bf16_t*)(ws + AR_ST),
                            (const bf16_t*)(ws + AR_SR), (const float*)args.in[10], XN); SEAM(5); } DBGCHK(0, chk_gla(C, args, ws, dacc));
#else
    if (IN(2)) for (int rep_ = 0; rep_ < NREP(2); ++rep_) { PROBE_T0(2); ph_gla_prep(C, (const bf16_t*)(ws + AR_Q0), (const bf16_t*)(ws + AR_K0), (const float*)(ws + AR_GF), (const float*)(ws + AR_GB), (bf16_t*)(ws + AR_QDF), (bf16_t*)(ws + AR_QDB),
                             (bf16_t*)(ws + AR_KDF), (bf16_t*)(ws + AR_KDB), (bf16_t*)(ws + AR_KTF), (bf16_t*)(ws + AR_KTB), (float*)(ws + WS_EGL)); SEAM(2); }
    if (IN(3)) for (int rep_ = 0; rep_ < NREP(3); ++rep_) { PROBE_T0(3); ph_gla_u(C, (const bf16_t*)(ws + AR_VT), (const bf16_t*)(ws + AR_KTF), (const bf16_t*)(ws + AR_KTB), (const float*)(ws + WS_EGL), (bf16_t*)(ws + AR_U)); SEAM(3); }
    if (IN(4)) for (int rep_ = 0; rep_ < NREP(4); ++rep_) { PROBE_T0(4); ph_gla_scan(C, (const bf16_t*)(ws + AR_U), (const float*)(ws + WS_EGL), (bf16_t*)(ws + AR_ST)); SEAM(4); }
    if (IN(5)) for (int rep_ = 0; rep_ < NREP(5); ++rep_) { PROBE_T0(5); ph_gla_out(C, (const bf16_t*)(ws + AR_QDF), (const bf16_t*)(ws + AR_QDB), (const bf16_t*)(ws + AR_KDF), (const bf16_t*)(ws + AR_KDB), (const bf16_t*)(ws + AR_VT), (const bf16_t*)(ws + AR_ST),
                            (const bf16_t*)(ws + AR_SR), (const float*)args.in[10], XN); SEAM(5); } DBGCHK(0, chk_gla(C, args, ws, dacc));
#endif
    if (IN(6)) { PROBE_T0(6); pg8::Gemm g{XN, (const bf16_t*)(ws + WS_WGOUT), T, 1024, 1024}; pg8::StaticOrder S; S.init(T, 1024, C.nb, C.bid); S.rep = NREP(6);
        pg8::EpiF32 E{HA, x, 1024, 1.0f}; pg8::gemm_phase<pg8::EpiF32, pg8::StaticOrder, false, PG8_SP2>(glds, g, S, E); SEAM(6); } DBGCHK(0, chk_resid(C, x, XN, 1024, (const float*)args.in[11], HA, dacc, 3));
#define MOE_LAYER(P, L, HIN, TAILMODE, HOUT, GAIN2, OUTP)                                                                                         \
    if (IN(P)) for (int rep_ = 0; rep_ < NREP(P); ++rep_) { PROBE_T0(P); ph_router(C, HIN, (const float*)args.in[3] + (L) * 1024, (const float*)args.in[18] + (L) * 1024 * 16, XN, AFF, (float*)(ws + WS_AFFT), ws + AR_XN8); SEAM(P); if ((P) == 7) DBGCHK(0, chk_router(C, HIN, (const float*)args.in[3] + (L) * 1024, (const float*)args.in[18] + (L) * 1024 * 16, XN, AFF, dacc, 4)); }       \
    if (IN(P + 1)) for (int rep_ = 0; rep_ < NREP(P + 1); ++rep_) { PROBE_T0(P + 1); ph_select(C, (const float*)(ws + WS_AFFT), SEL, IDX); if ((P) == 7 && CV_X1 > 0 && C.bid >= NE && C.nb == 256) ph_convert_moe(C, args, ws, 1, 1, 0, CV_X1, (C.bid - NE) * 8 + C.wave, (256 - NE) * 8); if ((P) == 18 && CV_Y0 < CV_NIT && C.bid >= NE && C.nb == 256) ph_convert_moe(C, args, ws, 1, 1, CV_Y0, CV_NIT, (C.bid - NE) * 8 + C.wave, (256 - NE) * 8);     SEAM(P + 1); if ((P) == 7) DBGCHK(0, chk_select(C, AFF, SEL, IDX, ddw)); }                                                                                 \
                                                                                                        \
    if (!MOE_FP8 && IN(P + 2)) for (int rep_ = 0; rep_ < NREP(P + 2); ++rep_) { PROBE_T0(P + 2); ph_gather(C, IDX, XN, XS, ws + AR_XN8); SEAM(P + 2); }                                                                                   \
    if (IN(P + 3)) { PROBE_T0(P + 3); pg8::Gemm g{MOE_FP8 ? (const bf16_t*)(ws + AR_XN8) : XS, (const bf16_t*)((const unsigned char*)WGU + (size_t)((MOE_FP8 && CONV_OVERLAP) ? (L) : 0) * (64 * MiB)), NE * CAP, 4096, MOE_FP8 ? 512 : 1024, MOE_FP8 ? IDX : nullptr}; pg8::GroupedOrder S; S.init(NE * CAP, 4096, C.nb, C.bid); S.rep = NREP(P + 3); pg8::EpiMoe1 E{HH};     \
        pg8::gemm_phase<pg8::EpiMoe1, pg8::GroupedOrder, PG8_ALIGN, false, MOE_FP8 != 0, MOE_FP8 != 0>(glds, g, S, E); SEAM(P + 3); if ((P) == 7) DBGCHK(0, chk_moe_h(C, args, ws, L, dacc, 6)); }                                       \
    if (IN(P + 4)) { PROBE_T0(P + 4); pg8::Gemm g{HH, (const bf16_t*)((const unsigned char*)WD + (size_t)((MOE_FP8 && CONV_OVERLAP) ? (L) : 0) * (32 * MiB)), NE * CAP, 1024, MOE_FP8 ? 1024 : 2048}; pg8::GroupedOrder S; S.init(NE * CAP, 1024, C.nb, C.bid); S.rep = NREP(P + 4); pg8::EpiMoe2 E{YY};      \
        pg8::gemm_phase<pg8::EpiMoe2, pg8::GroupedOrder, PG8_ALIGN, false, MOE_FP8 != 0>(glds, g, S, E); SEAM(P + 4); if ((P) == 7) DBGCHK(0, chk_moe_y(C, args, ws, L, dacc, 7)); }                                       \
    if (IN(P + 5)) for (int rep_ = 0; rep_ < NREP(P + 5); ++rep_) { PROBE_T0(P + 5); ph_combine<TAILMODE>(C, HIN, AFF, SEL, YY, HOUT, GAIN2, XN, OUTP); SEAM(P + 5); if ((P) == 7) DBGCHK(0, chk_combine(C, ws, HIN, HOUT, dacc, 8)); }

    MOE_LAYER(7, 0, HA, 1, HB, (const float*)args.in[2] + 1024, nullptr)
    if (IN(13)) { PROBE_T0(13); pg8::Gemm g{XN, (const bf16_t*)(ws + WS_WMIN), T, 512, MLA_FP8 ? 512 : 1024}; pg8::StaticOrder S; S.init(T, 512, C.nb, C.bid); S.rep = NREP(13);
        pg8::EpiF32 E{(float*)(ws + AR_CIN), nullptr, 512, MLA_FP8 ? 0.03125f : 1.0f}; pg8::gemm_phase<pg8::EpiF32, pg8::StaticOrder, false, false, MLA_FP8 != 0>(glds, g, S, E);
        if (CV_X2 > CV_X1 && C.bid >= 128 && C.nb == 256) ph_convert_moe(C, args, ws, 1, 1, CV_X1, CV_X2, (C.bid - 128) * 8 + C.wave, 128 * 8); SEAM(13); } DBGCHK(1, chk_cin(C, args, ws, dacc));
    if (IN(14)) { PROBE_T0(14);
#if MLA_ABSORB
        ph_mla_tok_abs(C, (const float*)(ws + AR_CIN), (const int*)args.in[1], (const float*)args.in[13], (const float*)args.in[15], args.invf, (bf16_t*)(ws + AR_CQN), (float*)(ws + WS_CS), ws + AR_K8, ws + AR_V8T);
#else
        ph_mla_tok(C, (const float*)(ws + AR_CIN), (const int*)args.in[1], (const float*)args.in[13], (const float*)args.in[15], args.invf, (bf16_t*)(ws + AR_CQN), (bf16_t*)(ws + AR_CKVN),
                             (float*)(ws + WS_CS), (bf16_t*)(ws + AR_K));
#endif
        ph_convert_moe(C, args, ws, 1, 1, C.nb == 256 ? CV_X2 : 0, C.nb == 256 ? CV_Y0 : CV_NIT, C.gw, C.ngw); SEAM(14); } DBGCHK(1, chk_tok(C, args, ws, dacc));
    if (IN(15)) { PROBE_T0(15);
#if ATT_FP8
        { constexpr int NQ_ = MLA_ABSORB ? 3072 : 4096; pg8::Gemm g{(const bf16_t*)(ws + AR_CQN), (const bf16_t*)(ws + WS_WUQ), T, NQ_, 256}; pg8::StaticOrder S; S.init(T, NQ_, C.nb, C.bid); S.rep = NREP(15);
          pg8::EpiQ8 E{ws + AR_Q8, (const float*)(ws + WS_CS)}; pg8::gemm_phase<pg8::EpiQ8, pg8::StaticOrder, PG8_ALIGN, PG8_SP2>(glds, g, S, E); }
        if (!MLA_ABSORB) { pg8::Gemm g{(const bf16_t*)(ws + AR_CKVN), (const bf16_t*)(ws + WS_WUKV), T, 2048, 256}; pg8::StaticOrder S; S.init(T, 2048, C.nb, C.bid); S.rep = NREP(15);
          pg8::EpiK8 E{ws + AR_K8}; pg8::gemm_phase<pg8::EpiK8, pg8::StaticOrder, PG8_ALIGN, PG8_SP2>(glds, g, S, E); }
        if (!MLA_ABSORB) { pg8::Gemm g{(const bf16_t*)(ws + WS_WUKV) + (size_t)2048 * 256, (const bf16_t*)(ws + AR_CKVN), 2048, T, 256}; pg8::StaticOrder S; S.init(2048, T, C.nb, C.bid); S.rep = NREP(15);
          pg8::EpiV8T E{ws + AR_V8T}; pg8::gemm_phase<pg8::EpiV8T, pg8::StaticOrder, PG8_ALIGN, PG8_SP2>(glds, g, S, E); }
#else
        { pg8::Gemm g{(const bf16_t*)(ws + AR_CQN), (const bf16_t*)(ws + WS_WUQ), T, 4096, 256}; pg8::StaticOrder S; S.init(T, 4096, C.nb, C.bid); S.rep = NREP(15);
          pg8::EpiQup E{(bf16_t*)(ws + AR_Q), (const float*)(ws + WS_CS)}; pg8::gemm_phase<pg8::EpiQup, pg8::StaticOrder, PG8_ALIGN, PG8_SP2>(glds, g, S, E); }
        { pg8::Gemm g{(const bf16_t*)(ws + AR_CKVN), (const bf16_t*)(ws + WS_WUKV), T, 4096, 256}; pg8::StaticOrder S; S.init(T, 4096, C.nb, C.bid); S.rep = NREP(15);
          pg8::EpiKVup E{(bf16_t*)(ws + AR_K), (bf16_t*)(ws + AR_V)}; pg8::gemm_phase<pg8::EpiKVup, pg8::StaticOrder, PG8_ALIGN, PG8_SP2>(glds, g, S, E); }
#endif
        SEAM(15); } DBGCHK(1, chk_qkv(C, args, ws, dacc));
    if (IN(16)) { PROBE_T0(16);
        const int nun = MH * (T / 256);
        for (int ii = 0; ii * C.nb + C.bid < nun * NREP(16); ++ii) { const int i = ii % (nun / C.nb);
            int h, qb; if (C.nb == 256) { h = (C.bid & 7) + 8 * (i >> 1); qb = (i & 1) * 32 + (C.bid >> 3); } else { const int u = i * C.nb + C.bid; h = u >> 6; qb = u & 63; }
#if ATT_FP8 && ATT8_DMA && MLA_ABSORB
            att8::attn_body_dma(ws + AR_Q8 + ((size_t)h * T + (size_t)qb * 256) * MDK, ws + AR_K8, ws + AR_V8T, ws + AR_O + (size_t)qb * 256 * 2048 + 128 * h, 2048, (char*)lds);
#elif ATT_FP8
            att8::attn_body(ws + AR_Q8 + ((size_t)h * T + (size_t)qb * 256) * MDK, ws + AR_K8 + (MLA_ABSORB ? (size_t)0 : (size_t)h * T * MDK), ws + AR_V8T + (MLA_ABSORB ? (size_t)0 : (size_t)h * MDV * T),
                            MLA_FP8 ? (bf16_t*)(ws + AR_O + (size_t)qb * 256 * 2048 + 128 * h) : (bf16_t*)(ws + AR_O) + (size_t)qb * 256 * 2048 + 128 * h, 2048, T, (char*)lds);
#else
            const bf16_t* Qb = (const bf16_t*)(ws + AR_Q) + ((size_t)h * T + (size_t)qb * 256) * MDK;
            att::attn_body(Qb, (const bf16_t*)(ws + AR_K) + (size_t)h * T * MDK, (const bf16_t*)(ws + AR_V) + (size_t)h * T * MDV, (bf16_t*)(ws + AR_O) + (size_t)qb * 256 * 2048 + 128 * h, 2048, T, (char*)lds);
#endif
            __syncthreads();
        }
        SEAM(16); } DBGCHK(1, chk_attn(C, ws, dacc));
    if (IN(17)) { PROBE_T0(17); pg8::Gemm g{(const bf16_t*)(ws + AR_O), (const bf16_t*)(ws + WS_WMOUT), T, 1024, MLA_FP8 ? 1024 : 2048}; pg8::StaticOrder S; S.init(T, 1024, C.nb, C.bid); S.rep = NREP(17);
        pg8::EpiF32 E{HA, HB, 1024, MLA_FP8 ? 0.03125f / 64.f : 1.0f}; pg8::gemm_phase<pg8::EpiF32, pg8::StaticOrder, false, false, MLA_FP8 != 0>(glds, g, S, E); SEAM(17); } DBGCHK(1, chk_resid(C, HB, (const bf16_t*)(ws + AR_O), 2048, (const float*)args.in[17], HA, dacc, 14));
    MOE_LAYER(18, 1, HA, 2, nullptr, (const float*)args.in[4], args.out)
#ifdef PROBE_PH
    if (C.bid == 0 && C.tid == 0) { const unsigned long long t_ = wall_clock64(), d_ = (unsigned long long)PROBE_MUL * tpw_[1]; while (wall_clock64() - t_ < d_) __builtin_amdgcn_s_sleep(32); }
    __syncthreads();
#endif
#ifdef DBG
    xcd_barrier(bar); dbg_report(C, ws, args.out, DBG == 0 ? 0 : 10, DBG == 0 ? 10 : 20);
#endif
#undef IN
#undef SEAM
#undef HA
#undef HB
#undef XN
#undef AFF
#undef SEL
#undef IDX
#undef WGU
#undef WD
#undef XS
#undef HH
#undef YY
}

#ifndef MK_N_LAUNCHES
#define MK_N_LAUNCHES 1
#endif
extern "C" void kernel_launch(void* const* d_in, const int* in_sizes, int n_in, void* d_out, int out_size, void* d_ws, size_t ws_size, hipStream_t stream) {
    static int grid = 0;
    if (grid == 0) {
        if (n_in != 22 || out_size != T * D || ws_size < WS_END) { fprintf(stderr, "kernel_launch: unexpected shapes (n_in %d out %d ws %zu, need ws >= %zu)\n", n_in, out_size, ws_size, (size_t)WS_END); grid = -1; return; }
        int dev = 0, cus = 0, per_cu = 0;
        if (hipGetDevice(&dev) != hipSuccess || hipDeviceGetAttribute(&cus, hipDeviceAttributeMultiprocessorCount, dev) != hipSuccess) { grid = -1; return; }
        if (hipFuncSetAttribute((const void*)mk_fwd, hipFuncAttributeMaxDynamicSharedMemorySize, LDS_BYTES) != hipSuccess) { fprintf(stderr, "kernel_launch: hipFuncSetAttribute failed\n"); grid = -1; return; }
        if (hipOccupancyMaxActiveBlocksPerMultiprocessor(&per_cu, (const void*)mk_fwd, 512, LDS_BYTES) != hipSuccess || per_cu < 1) fprintf(stderr, "kernel_launch: occupancy query says %d\n", per_cu);
        (void)hipGetLastError();
        grid = cus;
    }
    if (grid < 0) return;
    (void)hipMemsetAsync((char*)d_ws + WS_CTL, 0, CTL_ZERO_BYTES, stream);
    Args a{};
    for (int i = 0; i < 22; ++i) a.in[i] = d_in[i];
    a.out = (float*)d_out; a.ws = (unsigned char*)d_ws;
    for (int i = 0; i < 32; ++i) a.invf[i] = powf(10000.0f, -(float)i / 32.0f);
    if (MK_N_LAUNCHES == 1) { a.ph_lo = 0; a.ph_hi = NPHASE; a.li = 0; hipLaunchKernelGGL(mk_fwd, dim3(grid), dim3(512), LDS_BYTES, stream, a); }
    else { for (int p = 0; p < NPHASE; ++p) { a.ph_lo = p; a.ph_hi = p + 1; a.li = p; hipLaunchKernelGGL(mk_fwd, dim3(grid), dim3(512), LDS_BYTES, stream, a); } }
}
```
